# Optimizing an MI355X kernel written in HIP

```python
import jax
import jax.numpy as jnp
from jax import lax
import numpy as np

D_MODEL = 1024
BATCH = 8
SEQ = 2048
DEPTH = 2
DEC_BATCH = 128
DEC_SEQ = 1
PAST_LEN = 16384
PAGE_SIZE = 128

D_PLE = 256
EPS = 1e-6
CONV_W = 4
D_A = D_MODEL
A_BLOCKS = 8
A_BLK = D_A // A_BLOCKS
LRU_C = 8.0
D_B = D_MODEL
HD_B = 64
H_B = D_B // HD_B
N_B = 128
G_B = 2
CONV_DIM_B = D_B + 2 * G_B * N_B
CHUNK_B = 128
D_C = 2 * D_MODEL
H_C = 16
DK_C = 128
DV_C = D_C // H_C
HK_C = H_C * DK_C
CHUNK_C = 64
SUB_C = 16
N_AB = (DEPTH + 1) // 2
N_C = DEPTH // 2
IN_AB = 2 * D_A + D_B + CONV_DIM_B + H_B
IN_C = 2 * HK_C + 2 * D_C

kernel_name = 'hybrid_rglru_ssd_hgrn2_decode_step'

F32 = jnp.float32


def rmsnorm(x, w):
    xf = x.astype(F32)
    y = xf * lax.rsqrt(jnp.mean(xf * xf, axis=-1, keepdims=True) + EPS)
    return (y * w.astype(F32)).astype(x.dtype)


def causal_conv(x, buf, w, b):
    L = x.shape[1]
    xp = jnp.concatenate([buf.astype(x.dtype), x], axis=1).astype(F32)
    w = w.astype(F32)
    y = b.astype(F32) + xp[:, 0:L] * w[0]
    for kk in range(1, CONV_W):
        y = y + xp[:, kk:kk + L] * w[kk]
    return y, xp[:, L:].astype(x.dtype)


def rg_lru(x, h0, w_r, b_r, w_i, b_i, lam):
    Bsz, L, _ = x.shape
    xb = x.reshape(Bsz, L, A_BLOCKS, A_BLK)
    r = jax.nn.sigmoid(jnp.einsum('blkc,kcd->blkd', xb, w_r.astype(F32)).reshape(Bsz, L, D_A) + b_r.astype(F32))
    gi = jax.nn.sigmoid(jnp.einsum('blkc,kcd->blkd', xb, w_i.astype(F32)).reshape(Bsz, L, D_A) + b_i.astype(F32))
    log_a = -LRU_C * r * jax.nn.softplus(-lam.astype(F32))
    a = jnp.exp(log_a)
    u = jnp.sqrt(-jnp.expm1(2.0 * log_a)) * (gi * x)

    def combine(lhs, rhs):
        a1, b1 = lhs
        a2, b2 = rhs
        return a1 * a2, a2 * b1 + b2

    a_cum, h_part = lax.associative_scan(combine, (a, u), axis=1)
    h = h_part + a_cum * h0.astype(F32)[:, None]
    return h, h[:, -1]


def ssd_scan(x, dt, a_neg, bm, cm, s0):
    Bsz, L = x.shape[:2]
    qc = CHUNK_B if L >= CHUNK_B else L
    lp = -(-L // qc) * qc
    nc = lp // qc
    hg = H_B // G_B

    def padt(t):
        return jnp.pad(t, [(0, 0), (0, lp - L)] + [(0, 0)] * (t.ndim - 2))

    xc = padt(x).reshape(Bsz, nc, qc, G_B, hg, HD_B)
    dtc = padt(dt).reshape(Bsz, nc, qc, G_B, hg)
    bc = padt(bm).reshape(Bsz, nc, qc, G_B, N_B)
    cc = padt(cm).reshape(Bsz, nc, qc, G_B, N_B)
    acs = jnp.cumsum(dtc * a_neg.reshape(G_B, hg), axis=2)
    tri = jnp.tril(jnp.ones((qc, qc), bool))
    seg = jnp.where(tri[:, :, None, None], acs[:, :, :, None] - acs[:, :, None], -jnp.inf)
    cb = jnp.einsum('bctgn,bcsgn->bctsg', cc, bc)
    wts = cb[..., None] * jnp.exp(seg) * dtc[:, :, None]
    y_diag = jnp.einsum('bctsgh,bcsghp->bctghp', wts, xc)
    a_last = acs[:, :, -1]
    st = jnp.einsum('bcsgn,bcsgh,bcsghp->bcghpn', bc, jnp.exp(a_last[:, :, None] - acs) * dtc, xc)

    def step(s, inp):
        st_c, al = inp
        return jnp.exp(al)[..., None, None] * s + st_c, s

    s_fin, s_start = lax.scan(step, s0.reshape(Bsz, G_B, hg, HD_B, N_B),
                              (st.transpose(1, 0, 2, 3, 4, 5), a_last.transpose(1, 0, 2, 3)))
    y_off = jnp.einsum('bctgn,cbghpn,bctgh->bctghp', cc, s_start, jnp.exp(acs))
    y = (y_diag + y_off).reshape(Bsz, lp, H_B, HD_B)[:, :L]
    return y, s_fin.reshape(Bsz, H_B, HD_B, N_B)


def hgrn2_scan(q, k, v, g, s0):
    Bsz, L = q.shape[:2]
    ss = SUB_C if L >= SUB_C else L
    qc = CHUNK_C if L >= CHUNK_C else -(-L // ss) * ss
    lp = -(-L // qc) * qc
    nc = lp // qc
    ns = qc // ss

    def chunks(t):
        t = jnp.pad(t, ((0, 0), (0, lp - L), (0, 0), (0, 0)))
        return t.reshape(Bsz, nc, ns, ss, H_C, t.shape[-1]).transpose(1, 0, 4, 2, 3, 5)

    tri = jnp.tril(jnp.ones((ss, ss), bool))
    off = jnp.tril(jnp.ones((ns, ns), bool), -1)
    eye = jnp.eye(ns, dtype=F32)

    def step(S, inp):
        qs, ks, vs, gs = inp
        bcum = jnp.cumsum(gs.reshape(Bsz, H_C, qc, DK_C), axis=2).reshape(Bsz, H_C, ns, ss, DK_C)
        b0 = bcum[:, :, :, :1] - gs[:, :, :, :1]
        o_inter = jnp.einsum('bhitk,bhkv->bhitv', qs * jnp.exp(bcum), S)
        q_t = qs * jnp.exp(bcum - b0)
        e_off = jnp.where(off[:, :, None, None], b0[:, :, :, None] - bcum[:, :, None], -jnp.inf)
        a_off = jnp.einsum('bhitk,bhijsk->bhijts', q_t, ks[:, :, None] * jnp.exp(e_off))
        e_diag = jnp.where(tri[:, :, None], bcum[:, :, :, :, None] - bcum[:, :, :, None], -jnp.inf)
        a_diag = jnp.einsum('bhitk,bhisk,bhitsk->bhits', qs, ks, jnp.exp(e_diag))
        a_all = a_off + eye[:, :, None, None] * a_diag[:, :, :, None]
        o_intra = jnp.einsum('bhijts,bhjsv->bhitv', a_all, vs)
        b_last = bcum[:, :, -1, -1]
        k_dec = ks * jnp.exp(b_last[:, :, None, None] - bcum)
        S_new = jnp.exp(b_last)[..., None] * S + jnp.einsum('bhisk,bhisv->bhkv', k_dec, vs)
        return S_new, o_inter + o_intra

    S_fin, o = lax.scan(step, s0.astype(F32), (chunks(q), chunks(k), chunks(v), chunks(g)))
    o = o.transpose(1, 0, 3, 4, 2, 5).reshape(Bsz, lp, H_C, DV_C)[:, :L]
    return o, S_fin


def per_layer_embed(h, p, w_proj, w_gate):
    gate = jax.nn.sigmoid((h @ w_gate).astype(F32))
    return h + (gate * (p @ w_proj).astype(F32)).astype(h.dtype)


def layer_ab(h, p, s_ah, s_ac, s_bs, s_bc, norm_w, w_in, a_conv_w, a_conv_b, a_w_r, a_b_r, a_w_i, a_b_i,
             a_lam, b_conv_w, b_conv_b, b_dt_bias, b_a_log, b_d, b_norm_w, w_out, ple_w, ple_g):
    Bsz, L, _ = h.shape
    u = rmsnorm(h, norm_w) @ w_in
    a_x, a_gate, b_z, b_xbc, b_dt = jnp.split(
        u, [D_A, 2 * D_A, 2 * D_A + D_B, 2 * D_A + D_B + CONV_DIM_B], axis=-1)
    a_xc, new_ac = causal_conv(a_x, s_ac, a_conv_w, a_conv_b)
    a_y, new_ah = rg_lru(a_xc, s_ah, a_w_r, a_b_r, a_w_i, a_b_i, a_lam)
    a_out = a_y * jax.nn.silu(a_gate.astype(F32))
    xbc, new_bc = causal_conv(b_xbc, s_bc, b_conv_w, b_conv_b)
    xbc = jax.nn.silu(xbc)
    bx, bb, bcm = jnp.split(xbc, [D_B, D_B + G_B * N_B], axis=-1)
    dt = jax.nn.softplus(b_dt.astype(F32) + b_dt_bias.astype(F32))
    a_neg = -jnp.exp(b_a_log.astype(F32))
    bx4 = bx.reshape(Bsz, L, H_B, HD_B)
    y, new_bs = ssd_scan(bx4, dt, a_neg, bb.reshape(Bsz, L, G_B, N_B), bcm.reshape(Bsz, L, G_B, N_B),
                         s_bs.astype(F32))
    y = (y + b_d.astype(F32)[:, None] * bx4).reshape(Bsz, L, D_B) * jax.nn.silu(b_z.astype(F32))
    yg = y.reshape(Bsz, L, G_B, D_B // G_B)
    yg = yg * lax.rsqrt(jnp.mean(yg * yg, axis=-1, keepdims=True) + EPS)
    b_out = yg.reshape(Bsz, L, D_B) * b_norm_w.astype(F32)
    mix = jnp.concatenate([a_out, b_out], axis=-1).astype(h.dtype) @ w_out
    h = h + mix
    h = per_layer_embed(h, p, ple_w, ple_g)
    return h, new_ah, new_ac, new_bs, new_bc


def layer_c(h, p, s_c, lb, norm_w, w_in, c_norm_w, w_out, ple_w, ple_g):
    Bsz, L, _ = h.shape
    u = rmsnorm(h, norm_w) @ w_in
    q, fx, v, gate = jnp.split(u, [HK_C, 2 * HK_C, 2 * HK_C + D_C], axis=-1)
    fx = fx.astype(F32)
    g = jnp.logaddexp(jnp.log(lb), jnp.log1p(-lb) + jax.nn.log_sigmoid(fx))
    k = (1.0 - lb) * jax.nn.sigmoid(-fx)
    shp = (Bsz, L, H_C, DK_C)
    o, new_c = hgrn2_scan(q.astype(F32).reshape(shp) * (DK_C ** -0.5), k.reshape(shp),
                          v.astype(F32).reshape(Bsz, L, H_C, DV_C), g.reshape(shp), s_c)
    o = o * lax.rsqrt(jnp.mean(o * o, axis=-1, keepdims=True) + EPS)
    o = o.reshape(Bsz, L, D_C) * c_norm_w.astype(F32) * jax.nn.silu(gate.astype(F32))
    h = h + o.astype(h.dtype) @ w_out
    h = per_layer_embed(h, p, ple_w, ple_g)
    return h, new_c


def setup_inputs(seed: int = 0) -> dict:
    key = jax.random.key(seed)
    ks = jax.random.split(key, 40)

    def nrm(k, shape, s):
        return s * jax.random.normal(k, shape, F32)

    a0 = jax.random.uniform(ks[15], (N_AB, D_A), F32, 0.9, 0.999)
    sa = a0 ** (1.0 / LRU_C)
    a_lam = jnp.log(sa) - jnp.log1p(-sa)
    dt0 = jnp.exp(jax.random.uniform(ks[18], (N_AB, H_B), F32, np.log(1e-3), np.log(0.1)))
    b_dt_bias = dt0 + jnp.log(-jnp.expm1(-dt0))
    b_a_log = jnp.log(jax.random.uniform(ks[19], (N_AB, H_B), F32, 1.0, 16.0))
    return {
        'x_prompt': nrm(ks[0], (BATCH, SEQ, D_MODEL), 1.0),
        'x_sample': nrm(ks[1], (DEC_BATCH, DEC_SEQ, D_MODEL), 1.0),
        'p_prompt': nrm(ks[2], (DEPTH, BATCH, SEQ, D_PLE), 1.0),
        'p_sample': nrm(ks[3], (DEPTH, DEC_BATCH, DEC_SEQ, D_PLE), 1.0),
        'state_a_h': nrm(ks[4], (N_AB, DEC_BATCH, D_A), 0.5),
        'state_a_conv': nrm(ks[5], (N_AB, DEC_BATCH, CONV_W - 1, D_A), 1.0),
        'state_b_ssm': nrm(ks[6], (N_AB, DEC_BATCH, H_B, HD_B, N_B), 0.3),
        'state_b_conv': nrm(ks[7], (N_AB, DEC_BATCH, CONV_W - 1, CONV_DIM_B), 1.0),
        'state_c': nrm(ks[8], (N_C, DEC_BATCH, H_C, DK_C, DV_C), 0.3),
        'norm_w': 1.0 + nrm(ks[9], (DEPTH, D_MODEL), 0.02),
        'norm_f': 1.0 + nrm(ks[10], (D_MODEL,), 0.02),
        'ab_w_in': nrm(ks[11], (N_AB, D_MODEL, IN_AB), D_MODEL ** -0.5),
        'a_conv_w': nrm(ks[12], (N_AB, CONV_W, D_A), 0.5),
        'a_conv_b': nrm(ks[13], (N_AB, D_A), 0.01),
        'a_w_r': nrm(ks[14], (N_AB, A_BLOCKS, A_BLK, A_BLK), A_BLK ** -0.5),
        'a_b_r': nrm(ks[16], (N_AB, D_A), 0.01),
        'a_w_i': nrm(ks[17], (N_AB, A_BLOCKS, A_BLK, A_BLK), A_BLK ** -0.5),
        'a_b_i': nrm(ks[20], (N_AB, D_A), 0.01),
        'a_lam': a_lam,
        'b_conv_w': nrm(ks[21], (N_AB, CONV_W, CONV_DIM_B), 0.5),
        'b_conv_b': nrm(ks[22], (N_AB, CONV_DIM_B), 0.01),
        'b_dt_bias': b_dt_bias,
        'b_a_log': b_a_log,
        'b_d': 1.0 + nrm(ks[23], (N_AB, H_B), 0.02),
        'b_norm_w': 1.0 + nrm(ks[24], (N_AB, D_B), 0.02),
        'ab_w_out': nrm(ks[25], (N_AB, D_A + D_B, D_MODEL), (D_A + D_B) ** -0.5),
        'c_w_in': nrm(ks[26], (N_C, D_MODEL, IN_C), D_MODEL ** -0.5),
        'c_lb': nrm(ks[27], (DEPTH, HK_C), 0.1),
        'c_norm_w': 1.0 + nrm(ks[28], (N_C, D_C), 0.02),
        'c_w_out': nrm(ks[29], (N_C, D_C, D_MODEL), D_C ** -0.5),
        'ple_proj': nrm(ks[30], (DEPTH, D_PLE, D_MODEL), D_PLE ** -0.5),
        'ple_gate': nrm(ks[31], (DEPTH, D_MODEL, D_MODEL), D_MODEL ** -0.5),
    }


def reference(x_prompt, x_sample, p_prompt, p_sample, state_a_h, state_a_conv, state_b_ssm, state_b_conv,
              state_c, norm_w, norm_f, ab_w_in, a_conv_w, a_conv_b, a_w_r, a_b_r, a_w_i, a_b_i, a_lam,
              b_conv_w, b_conv_b, b_dt_bias, b_a_log, b_d, b_norm_w, ab_w_out, c_w_in, c_lb, c_norm_w,
              c_w_out, ple_proj, ple_gate):
    lb_tab = jnp.cumsum(jax.nn.softmax(c_lb.astype(F32), axis=0), axis=0)
    lb_tab = lb_tab - lb_tab[:1]
    bp = x_prompt.shape[0]
    hp, hs = x_prompt, x_sample
    ah_p, ac_p, bs_p, bc_p, c_p = [], [], [], [], []
    ah_s, ac_s, bs_s, bc_s, c_s = [], [], [], [], []
    for i in range(DEPTH):
        j = i // 2
        if i % 2 == 0:
            w = (norm_w[i], ab_w_in[j], a_conv_w[j], a_conv_b[j], a_w_r[j], a_b_r[j], a_w_i[j], a_b_i[j],
                 a_lam[j], b_conv_w[j], b_conv_b[j], b_dt_bias[j], b_a_log[j], b_d[j], b_norm_w[j],
                 ab_w_out[j], ple_proj[i], ple_gate[i])
            hp, s1, s2, s3, s4 = layer_ab(
                hp, p_prompt[i], jnp.zeros((bp, D_A), F32), jnp.zeros((bp, CONV_W - 1, D_A), x_prompt.dtype),
                jnp.zeros((bp, H_B, HD_B, N_B), F32), jnp.zeros((bp, CONV_W - 1, CONV_DIM_B), x_prompt.dtype), *w)
            ah_p.append(s1); ac_p.append(s2); bs_p.append(s3); bc_p.append(s4)
            hs, s1, s2, s3, s4 = layer_ab(hs, p_sample[i], state_a_h[j], state_a_conv[j], state_b_ssm[j],
                                          state_b_conv[j], *w)
            ah_s.append(s1); ac_s.append(s2); bs_s.append(s3); bc_s.append(s4)
        else:
            lb = lb_tab[i]
            w = (norm_w[i], c_w_in[j], c_norm_w[j], c_w_out[j], ple_proj[i], ple_gate[i])
            hp, s1 = layer_c(hp, p_prompt[i], jnp.zeros((bp, H_C, DK_C, DV_C), F32), lb, *w)
            c_p.append(s1)
            hs, s1 = layer_c(hs, p_sample[i], state_c[j], lb, *w)
            c_s.append(s1)
    y_prompt = rmsnorm(hp, norm_f)
    y_sample = rmsnorm(hs, norm_f)
    return (y_prompt, y_sample,
            jnp.stack(ah_p), jnp.stack(ac_p), jnp.stack(bs_p), jnp.stack(bc_p), jnp.stack(c_p),
            jnp.stack(ah_s), jnp.stack(ac_s), jnp.stack(bs_s), jnp.stack(bc_s), jnp.stack(c_s))
```

```cpp
#include <hip/hip_runtime.h>
#include <hip/hip_cooperative_groups.h>
#include <cstdio>
namespace cg = cooperative_groups;

#define LAS __attribute__((address_space(3)))
#define DI __device__ __forceinline__
typedef unsigned short bf16_t;
typedef short bf16x8 __attribute__((ext_vector_type(8)));
typedef float f32x4 __attribute__((ext_vector_type(4)));
typedef float f32x16 __attribute__((ext_vector_type(16)));

constexpr int MP = 16384, MS = 128, MV = MP + MS, MPAD = 16640;
constexpr int DM = 1024, INAB = 4624, N0 = 4608, INC = 8192;
constexpr float EPSF = 1e-6f;
constexpr size_t O_Y = 0, O_AHP = 16908288, O_ACP = 16916480, O_BSP = 16941056, O_BCP = 17989632, O_CP = 18026496,
                 O_AHS = 20123648, O_ACS = 20254720, O_BSS = 20647936, O_BCS = 37425152, O_CS = 38014976;
constexpr size_t al256(size_t x) { return (x + 255) & ~size_t(255); }
constexpr size_t OFF_CTL = 0;
constexpr size_t OFF_SS1 = 256;
constexpr size_t OFF_SS2 = OFF_SS1 + al256((size_t)MPAD * 4);
constexpr size_t OFF_SSB = OFF_SS2 + al256((size_t)MPAD * 4);
constexpr size_t OFF_DT  = OFF_SSB + al256((size_t)MPAD * 8);
constexpr size_t OFF_W0T = OFF_DT + al256((size_t)MV * 16 * 4);
constexpr size_t OFF_WO0T = OFF_W0T + (size_t)N0 * 1024 * 2;
constexpr size_t OFF_WG0T = OFF_WO0T + (size_t)1024 * 2048 * 2;
constexpr size_t OFF_WP0T = OFF_WG0T + (size_t)1024 * 1024 * 2;
constexpr size_t OFF_W1T  = OFF_WP0T + (size_t)1024 * 256 * 2;
constexpr size_t OFF_WO1T = OFF_W1T + (size_t)INC * 1024 * 2;
constexpr size_t OFF_WG1T = OFF_WO1T + (size_t)1024 * 2048 * 2;
constexpr size_t OFF_WP1T = OFF_WG1T + (size_t)1024 * 1024 * 2;
constexpr size_t OFF_WRT  = OFF_WP1T + (size_t)1024 * 256 * 2;
constexpr size_t OFF_WIT  = OFF_WRT + (size_t)128 * 1024 * 2;
constexpr size_t OFF_XN   = OFF_WIT + (size_t)128 * 1024 * 2;
constexpr size_t OFF_MIX  = OFF_XN + (size_t)MPAD * 1024 * 2;
constexpr size_t OFF_H    = OFF_MIX + (size_t)MPAD * 2048 * 2;
constexpr size_t OFF_U    = OFF_H + al256((size_t)MV * 1024 * 4);
constexpr size_t OFF_HB   = OFF_U;
constexpr size_t OFF_PB   = OFF_U + (size_t)MPAD * 1024 * 2;
constexpr size_t WS_END   = OFF_U + al256((size_t)MV * INC * 2);
constexpr int LDS_BYTES = 144 * 1024;

struct Params { const float* in[32]; float* out; unsigned char* ws; };
#define WSP(T, off) ((T*)(P.ws + (off)))

DI bf16_t f2bf(float f) { unsigned u = __float_as_uint(f); u += 0x7FFFu + ((u >> 16) & 1u); return (bf16_t)(u >> 16); }
DI float bf2f(bf16_t b) { return __uint_as_float(((unsigned)b) << 16); }
DI unsigned pack2(float lo, float hi) { return (unsigned)f2bf(lo) | ((unsigned)f2bf(hi) << 16); }
DI float bflo(unsigned w) { return __uint_as_float(w << 16); }
DI float bfhi(unsigned w) { return __uint_as_float(w & 0xFFFF0000u); }
DI float sigm(float x) { return 1.f / (1.f + __expf(-x)); }
DI float silu(float x) { return x / (1.f + __expf(-x)); }
DI float softplus(float x) { return x > 20.f ? x : log1pf(__expf(x)); }
DI float wave_sum(float v) { for (int o = 32; o > 0; o >>= 1) v += __shfl_xor(v, o); return v; }
DI int otid() { int t = threadIdx.x; asm volatile("" : "+v"(t)); return t; }
DI int crow(int reg, int hh) { return (reg & 3) + 8 * (reg >> 2) + 4 * hh; }
DI void ld4bf(const bf16_t* p, float (&o)[4]) { uint2 w = *(const uint2*)p; o[0] = bflo(w.x); o[1] = bfhi(w.x); o[2] = bflo(w.y); o[3] = bfhi(w.y); }
DI uint2 pack4(float a, float b, float c, float d) { uint2 r; r.x = pack2(a, b); r.y = pack2(c, d); return r; }
#define MFMA32(a, b, c) __builtin_amdgcn_mfma_f32_32x32x16_bf16((a), (b), (c), 0, 0, 0)
#define MFMA16(a, b, c) __builtin_amdgcn_mfma_f32_16x16x32_bf16((a), (b), (c), 0, 0, 0)
DI bf16x8 ldfrag(const bf16_t* base, int ld, int row0, int k0, int lane) { return *(const bf16x8*)(base + (row0 + (lane & 31)) * ld + k0 + 8 * (lane >> 5)); }
DI bf16x8 ldfrag16(const bf16_t* base, int ld, int row0, int k0, int lane) { return *(const bf16x8*)(base + (row0 + (lane & 15)) * ld + k0 + 8 * (lane >> 4)); }

namespace pg8 {
constexpr int BM = 256, BK = 64, HALF = 128, HTB = HALF * BK * 2, STAGE_BYTES = 8 * HTB, NXCD = 8, WGM = 8;
DI int lds_byte(int r, int c) { const int st = (r >> 4) * 2 + (c >> 5), rr = r & 15, cc = c & 31, ob = rr * 64 + cc * 2; return st * 1024 + (ob ^ (((ob >> 9) & 1) << 5)); }
DI void stage_rc(int b, int& R, int& C) { const int st = b / 1024, sb = b % 1024, swz = sb ^ (((sb >> 9) & 1) << 5); R = (st >> 1) * 16 + swz / 64; C = (st & 1) * 32 + (swz % 64) / 2; }
DI int perm32(int rho) { const int n = rho >> 4, i = rho & 15; return 8 * (i >> 2) + 4 * n + (i & 3); }
struct Unit { int pm, pn; };
struct Gemm { const bf16_t* A; const bf16_t* Bt; int M, N, K; };
struct StaticOrder {
    int nM, nN, nwg, G, c;
    DI void init(int M, int N, int G_, int c_) { nM = M / BM; nN = N / BM; nwg = nM * nN; G = G_; c = c_; }
    DI bool next(int i, Unit& u) const {
        const long L = (long)i * G + c; if (L >= nwg) return false;
        int wgid = (int)L; { const int q = nwg / NXCD, r = nwg % NXCD, xcd = wgid % NXCD, off = wgid / NXCD; wgid = (xcd < r ? xcd * (q + 1) : r * (q + 1) + (xcd - r) * q) + off; }
        const int nig = WGM * nN, gid = wgid / nig, fm = gid * WGM, gsz = (nM - fm) < WGM ? (nM - fm) : WGM;
        u.pm = fm + ((wgid % nig) % gsz); u.pn = (wgid % nig) / gsz; return true;
    }
};

template <class Epi>
DI void gemm_phase(LAS unsigned char* lds, const Gemm g, const StaticOrder& S, const Epi& E) {
    const int tid = otid(), wid = __builtin_amdgcn_readfirstlane(tid >> 6), lane = tid & 63, wr = wid >> 2, wc = wid & 3, fr = lane & 15, fq = lane >> 4;
    const int K = g.K, nt = K / BK;
    unsigned voffA[2], voffB[2];
#pragma unroll
    for (int i = 0; i < 2; ++i) { int R, C; stage_rc(tid * 16 + i * 8192, R, C); const int Rb = Epi::PERM ? ((R & ~31) + perm32(R & 31)) : R;
        voffA[i] = (unsigned)(R * K + C) * 2u; voffB[i] = (unsigned)(Rb * K + C) * 2u; }
    const size_t kstep = (size_t)(BK * 2);
    const size_t hstep = (size_t)HALF * K * 2;
    const size_t tstep = 2 * hstep;
    const unsigned ldsw = (unsigned)wid * 1024u;
    const int aoff = lds_byte(wr * 64 + fr, fq * 8), boff = lds_byte(wc * 32 + fr, fq * 8);
#define PG8_SA(b, h) (((b) * 2 + (h)) * HTB)
#define PG8_SB(b, h) ((4 + (b) * 2 + (h)) * HTB)
#define PG8_STAGE(bufoff, gbase, voff) do { _Pragma("unroll") for (int _i = 0; _i < 2; ++_i) \
        __builtin_amdgcn_global_load_lds((const unsigned*)((const char*)(gbase) + (voff)[_i]), (LAS unsigned*)(lds + (bufoff) + ldsw + _i * 8192), 16, 0, 0); } while (0)
#define PG8_LDA(dst, b, h) do { _Pragma("unroll") for (int m = 0; m < 4; ++m) _Pragma("unroll") for (int k = 0; k < 2; ++k) dst[m][k] = *(const LAS bf16x8*)(lds + PG8_SA(b, h) + aoff + m * 2048 + k * 1024); } while (0)
#define PG8_LDB(dst, b, h) do { _Pragma("unroll") for (int n = 0; n < 2; ++n) _Pragma("unroll") for (int k = 0; k < 2; ++k) dst[n][k] = *(const LAS bf16x8*)(lds + PG8_SB(b, h) + boff + n * 2048 + k * 1024); } while (0)
#define PG8_MMA(ai, bj, At, Bt) do { __builtin_amdgcn_s_setprio(1); _Pragma("unroll") for (int m = 0; m < 4; ++m) _Pragma("unroll") for (int n = 0; n < 2; ++n) _Pragma("unroll") for (int k = 0; k < 2; ++k) \
        acc[ai][bj][m][n] = __builtin_amdgcn_mfma_f32_16x16x32_bf16(Bt[n][k], At[m][k], acc[ai][bj][m][n], 0, 0, 0); __builtin_amdgcn_s_setprio(0); } while (0)
#define PG8_WAIT_V(n) asm volatile("s_waitcnt vmcnt(" #n ")" ::: "memory")
#define PG8_WAIT_L(n) asm volatile("s_waitcnt lgkmcnt(" #n ")" ::: "memory")
#define PG8_BAR __builtin_amdgcn_s_barrier()
#define PG8_SCHED __builtin_amdgcn_sched_barrier(0)
    Unit cur, nxt; int ui = 0;
    if (!S.next(0, cur)) return;
    f32x4 acc[2][2][4][2];
#pragma unroll
    for (int a = 0; a < 2; ++a)
#pragma unroll
        for (int b = 0; b < 2; ++b)
#pragma unroll
            for (int m = 0; m < 4; ++m)
#pragma unroll
                for (int n = 0; n < 2; ++n) acc[a][b][m][n] = (f32x4){0.f, 0.f, 0.f, 0.f};
    bf16x8 At[4][2], B0[2][2], B1[2][2];
    const char* cA = (const char*)g.A + (size_t)cur.pm * tstep; const char* cB = (const char*)g.Bt + (size_t)cur.pn * tstep;
    PG8_STAGE(PG8_SB(0, 0), cB, voffB); PG8_STAGE(PG8_SA(0, 0), cA, voffA); PG8_STAGE(PG8_SB(0, 1), cB + hstep, voffB); PG8_STAGE(PG8_SA(0, 1), cA + hstep, voffA);
    if (wr == 1) PG8_BAR;
    PG8_WAIT_V(4); PG8_BAR;
    PG8_STAGE(PG8_SB(1, 0), cB + kstep, voffB); PG8_STAGE(PG8_SA(1, 0), cA + kstep, voffA); PG8_STAGE(PG8_SB(1, 1), cB + hstep + kstep, voffB);
    PG8_WAIT_V(6); PG8_BAR;
    for (;;) {
        const bool has_next = S.next(ui + 1, nxt);
        const char* nA = has_next ? (const char*)g.A + (size_t)nxt.pm * tstep : cA; const char* nB = has_next ? (const char*)g.Bt + (size_t)nxt.pn * tstep : cB;
        for (int t = 0; t < nt; t += 2) {
            const bool last = (t == nt - 2);
            const char* a1 = cA + (size_t)(t + 1) * kstep;
            const char* a2 = last ? nA : cA + (size_t)(t + 2) * kstep; const char* b2 = last ? nB : cB + (size_t)(t + 2) * kstep;
            const char* a3 = a2 + kstep; const char* b3 = b2 + kstep;
            PG8_LDB(B0, 0, 0); PG8_SCHED; PG8_LDA(At, 0, 0); PG8_STAGE(PG8_SA(1, 1), a1 + hstep, voffA);
            PG8_WAIT_L(8); PG8_BAR; PG8_WAIT_L(0); PG8_MMA(0, 0, At, B0); PG8_BAR; PG8_SCHED;
            PG8_LDB(B1, 0, 1); PG8_STAGE(PG8_SB(0, 0), b2, voffB);
            PG8_BAR; PG8_WAIT_L(0); PG8_MMA(0, 1, At, B1); PG8_BAR;
            PG8_LDA(At, 0, 1); PG8_STAGE(PG8_SA(0, 0), a2, voffA);
            PG8_BAR; PG8_WAIT_L(0); PG8_MMA(1, 0, At, B0); PG8_BAR; PG8_SCHED;
            PG8_STAGE(PG8_SB(0, 1), b2 + hstep, voffB);
            PG8_WAIT_V(6); PG8_BAR; PG8_MMA(1, 1, At, B1); PG8_BAR;
            PG8_LDB(B0, 1, 0); PG8_SCHED; PG8_LDA(At, 1, 0); PG8_STAGE(PG8_SA(0, 1), a2 + hstep, voffA);
            PG8_WAIT_L(8); PG8_BAR; PG8_WAIT_L(0); PG8_MMA(0, 0, At, B0); PG8_BAR; PG8_SCHED;
            PG8_LDB(B1, 1, 1); PG8_STAGE(PG8_SB(1, 0), b3, voffB);
            PG8_BAR; PG8_WAIT_L(0); PG8_MMA(0, 1, At, B1); PG8_BAR;
            PG8_LDA(At, 1, 1); PG8_STAGE(PG8_SA(1, 0), a3, voffA);
            PG8_BAR; PG8_WAIT_L(0); PG8_MMA(1, 0, At, B0); PG8_BAR; PG8_SCHED;
            PG8_STAGE(PG8_SB(1, 1), b3 + hstep, voffB);
            PG8_WAIT_V(6); PG8_BAR; PG8_MMA(1, 1, At, B1); PG8_BAR;
        }
        E(acc, cur, wr, wc, fr, fq);
        if (!has_next) break;
#pragma unroll
        for (int a = 0; a < 2; ++a)
#pragma unroll
            for (int b = 0; b < 2; ++b)
#pragma unroll
                for (int m = 0; m < 4; ++m)
#pragma unroll
                    for (int n = 0; n < 2; ++n) acc[a][b][m][n] = (f32x4){0.f, 0.f, 0.f, 0.f};
        cur = nxt; cA = nA; cB = nB; ++ui;
    }
    PG8_WAIT_V(0);
    if (wr == 0) PG8_BAR;
    PG8_BAR;
#undef PG8_SA
#undef PG8_SB
#undef PG8_STAGE
#undef PG8_LDA
#undef PG8_LDB
#undef PG8_MMA
#undef PG8_WAIT_V
#undef PG8_WAIT_L
#undef PG8_BAR
#undef PG8_SCHED
}
}

struct EpiStoreBf16 {
    static constexpr bool PERM = true;
    bf16_t* O; int ldc; const float* ss;
    DI void operator()(const f32x4 (&acc)[2][2][4][2], const pg8::Unit& u, int wr, int wc, int fr, int fq) const {
        const int row0 = u.pm * 256 + wr * 64 + fr, col0 = u.pn * 256 + wc * 32 + 8 * fq;
#pragma unroll
        for (int ai = 0; ai < 2; ++ai)
#pragma unroll
            for (int m = 0; m < 4; ++m) {
                const int row = row0 + ai * 128 + m * 16;
                if (row < MV) {
                    const float sc = ss ? rsqrtf(ss[row] * (1.f / 1024.f) + EPSF) : 1.f;
                    bf16_t* rp = O + (size_t)row * ldc + col0;
#pragma unroll
                    for (int bj = 0; bj < 2; ++bj) {
                        const f32x4 v0 = acc[ai][bj][m][0] * sc, v1 = acc[ai][bj][m][1] * sc;
                        uint4 w; w.x = pack2(v0[0], v0[1]); w.y = pack2(v0[2], v0[3]); w.z = pack2(v1[0], v1[1]); w.w = pack2(v1[2], v1[3]);
                        *(uint4*)(rp + bj * 128) = w;
                    }
                }
            }
    }
};
struct EpiResid {
    static constexpr bool PERM = false;
    const float* rp_prompt; const float* rp_sample;
    float* H; bf16_t* HB;
    DI void operator()(const f32x4 (&acc)[2][2][4][2], const pg8::Unit& u, int wr, int wc, int fr, int fq) const {
        const int row0 = u.pm * 256 + wr * 64 + fr, col0 = u.pn * 256 + wc * 32 + 4 * fq;
#pragma unroll
        for (int ai = 0; ai < 2; ++ai)
#pragma unroll
            for (int m = 0; m < 4; ++m) {
                const int row = row0 + ai * 128 + m * 16;
                if (row < MV) {
                    const float* rs = (row < MP ? rp_prompt + (size_t)row * 1024 : rp_sample + (size_t)(row - MP) * 1024) + col0;
                    float* hp = H + (size_t)row * 1024 + col0; bf16_t* bp = HB + (size_t)row * 1024 + col0;
#pragma unroll
                    for (int bj = 0; bj < 2; ++bj)
#pragma unroll
                        for (int n = 0; n < 2; ++n) {
                            const int co = bj * 128 + n * 16;
                            const f32x4 v = acc[ai][bj][m][n] + *(const f32x4*)(rs + co);
                            *(f32x4*)(hp + co) = v; *(uint2*)(bp + co) = pack4(v[0], v[1], v[2], v[3]);
                        }
                }
            }
    }
};
struct EpiGate {
    static constexpr bool PERM = false;
    float* Gt;
    DI void operator()(const f32x4 (&acc)[2][2][4][2], const pg8::Unit& u, int wr, int wc, int fr, int fq) const {
        const int row0 = u.pm * 256 + wr * 64 + fr, col0 = u.pn * 256 + wc * 32 + 4 * fq;
#pragma unroll
        for (int ai = 0; ai < 2; ++ai)
#pragma unroll
            for (int m = 0; m < 4; ++m) {
                const int row = row0 + ai * 128 + m * 16;
                if (row < MV) {
                    float* gp = Gt + (size_t)row * 1024 + col0;
#pragma unroll
                    for (int bj = 0; bj < 2; ++bj)
#pragma unroll
                        for (int n = 0; n < 2; ++n) {
                            const f32x4 a = acc[ai][bj][m][n];
                            *(f32x4*)(gp + bj * 128 + n * 16) = (f32x4){sigm(a[0]), sigm(a[1]), sigm(a[2]), sigm(a[3])};
                        }
                }
            }
    }
};
struct EpiPle {
    static constexpr bool PERM = false;
    float* H; const float* Gt; bf16_t* XN; const float* nw; float* SS;
    DI void operator()(const f32x4 (&acc)[2][2][4][2], const pg8::Unit& u, int wr, int wc, int fr, int fq) const {
        const int row0 = u.pm * 256 + wr * 64 + fr, col0 = u.pn * 256 + wc * 32 + 4 * fq;
#pragma unroll
        for (int ai = 0; ai < 2; ++ai)
#pragma unroll
            for (int m = 0; m < 4; ++m) {
                const int row = row0 + ai * 128 + m * 16;
                float ssum = 0.f;
                if (row < MV) {
                    float* hp = H + (size_t)row * 1024 + col0; const float* gp = Gt + (size_t)row * 1024 + col0;
#pragma unroll
                    for (int bj = 0; bj < 2; ++bj)
#pragma unroll
                        for (int n = 0; n < 2; ++n) {
                            const int co = bj * 128 + n * 16;
                            const f32x4 v = *(const f32x4*)(hp + co) + *(const f32x4*)(gp + co) * acc[ai][bj][m][n];
                            *(f32x4*)(hp + co) = v;
                            ssum += v[0] * v[0] + v[1] * v[1] + v[2] * v[2] + v[3] * v[3];
                            if (XN) { const f32x4 w = *(const f32x4*)(nw + col0 + co); *(uint2*)(XN + (size_t)row * 1024 + col0 + co) = pack4(v[0] * w[0], v[1] * w[1], v[2] * w[2], v[3] * w[3]); }
                        }
                }
                ssum += __shfl_xor(ssum, 16); ssum += __shfl_xor(ssum, 32);
                if (fq == 0 && row < MV) atomicAdd(SS + row, ssum);
            }
    }
};

DI void transpose_tile(const float* src, int lds_, bf16_t* dst, int ldd, int k0, int n0, float* tile) {
    const int tid = otid();
    __syncthreads();
#pragma unroll
    for (int p = 0; p < 8; ++p) { const int r = (tid >> 6) + p * 8, j = tid & 63; tile[r * 65 + j] = src[(size_t)(k0 + r) * lds_ + n0 + j]; }
    __syncthreads();
    const int nn = tid >> 3, kk = (tid & 7) * 8;
    uint4 w;
    w.x = pack2(tile[(kk + 0) * 65 + nn], tile[(kk + 1) * 65 + nn]); w.y = pack2(tile[(kk + 2) * 65 + nn], tile[(kk + 3) * 65 + nn]);
    w.z = pack2(tile[(kk + 4) * 65 + nn], tile[(kk + 5) * 65 + nn]); w.w = pack2(tile[(kk + 6) * 65 + nn], tile[(kk + 7) * 65 + nn]);
    *(uint4*)(dst + (size_t)(n0 + nn) * ldd + k0 + kk) = w;
}
DI void transpose_job(const float* src, int lds_, bf16_t* dst, int ldd, int K, int N, int& base, float* tile) {
    const int G = gridDim.x, ntn = N / 64, nt = (K / 64) * ntn;
    int first = ((int)blockIdx.x - (base % G) + G) % G;
    for (int t = first; t < nt; t += G) transpose_tile(src, lds_, dst, ldd, (t / ntn) * 64, (t % ntn) * 64, tile);
    base += nt;
}
DI void phase_prep(const Params& P, unsigned char* L) {
    const int tid = otid(), lane = tid & 63;
    { float* z = WSP(float, OFF_SS1); const int n = (int)((OFF_DT - OFF_SS1) / 4);
      for (int i = blockIdx.x * 512 + tid; i < n; i += gridDim.x * 512) z[i] = 0.f;
      if (blockIdx.x == 0 && tid < 64) WSP(unsigned, OFF_CTL)[tid] = 0u; }
    { float* tile = (float*)L; int base = 0;
      transpose_job(P.in[11], INAB, WSP(bf16_t, OFF_W0T), 1024, 1024, N0, base, tile);
      transpose_job(P.in[25], 1024, WSP(bf16_t, OFF_WO0T), 2048, 2048, 1024, base, tile);
      transpose_job(P.in[31], 1024, WSP(bf16_t, OFF_WG0T), 1024, 1024, 1024, base, tile);
      transpose_job(P.in[30], 1024, WSP(bf16_t, OFF_WP0T), 256, 256, 1024, base, tile);
      transpose_job(P.in[26], INC, WSP(bf16_t, OFF_W1T), 1024, 1024, INC, base, tile);
      transpose_job(P.in[29], 1024, WSP(bf16_t, OFF_WO1T), 2048, 2048, 1024, base, tile);
      transpose_job(P.in[31] + 1024 * 1024, 1024, WSP(bf16_t, OFF_WG1T), 1024, 1024, 1024, base, tile);
      transpose_job(P.in[30] + 256 * 1024, 1024, WSP(bf16_t, OFF_WP1T), 256, 256, 1024, base, tile);
      transpose_job(P.in[14], 128, WSP(bf16_t, OFF_WRT), 1024, 1024, 128, base, tile);
      transpose_job(P.in[16], 128, WSP(bf16_t, OFF_WIT), 1024, 1024, 128, base, tile); }
    { const int gw = blockIdx.x * 8 + (tid >> 6), nwv = gridDim.x * 8;
      const float* nwp = P.in[9]; const float* Wdt = P.in[11] + N0;
      bf16_t* XN = WSP(bf16_t, OFF_XN); float* DT = WSP(float, OFF_DT);
      f32x4 w4[4];
#pragma unroll
      for (int i = 0; i < 4; ++i) w4[i] = *(const f32x4*)(nwp + lane * 4 + 256 * i);
      for (int r = gw; r < MV; r += nwv) {
          const float* src = r < MP ? P.in[0] + (size_t)r * 1024 : P.in[1] + (size_t)(r - MP) * 1024;
          f32x4 x[4]; float ss = 0.f;
#pragma unroll
          for (int i = 0; i < 4; ++i) { x[i] = *(const f32x4*)(src + lane * 4 + 256 * i); ss += x[i][0] * x[i][0] + x[i][1] * x[i][1] + x[i][2] * x[i][2] + x[i][3] * x[i][3]; }
          ss = wave_sum(ss); const float rstd = rsqrtf(ss * (1.f / 1024.f) + EPSF);
          float dacc[16];
#pragma unroll
          for (int j = 0; j < 16; ++j) dacc[j] = 0.f;
#pragma unroll
          for (int i = 0; i < 4; ++i) {
              x[i] = x[i] * rstd * w4[i];
              *(uint2*)(XN + (size_t)r * 1024 + lane * 4 + 256 * i) = pack4(x[i][0], x[i][1], x[i][2], x[i][3]);
#pragma unroll
              for (int e = 0; e < 4; ++e) {
                  const f32x4* wp = (const f32x4*)(Wdt + (size_t)(lane * 4 + 256 * i + e) * INAB);
#pragma unroll
                  for (int q = 0; q < 4; ++q) { const f32x4 w = wp[q]; dacc[4 * q + 0] += x[i][e] * w[0]; dacc[4 * q + 1] += x[i][e] * w[1]; dacc[4 * q + 2] += x[i][e] * w[2]; dacc[4 * q + 3] += x[i][e] * w[3]; }
              }
          }
          float mine = 0.f;
#pragma unroll
          for (int j = 0; j < 16; ++j) { const float v = wave_sum(dacc[j]); mine = (lane == j) ? v : mine; }
          if (lane < 16) DT[(size_t)r * 16 + lane] = mine;
      } }
}
DI void convert_p(const Params& P, int layer) {
    bf16_t* PB = WSP(bf16_t, OFF_PB);
    const float* pp = P.in[2] + (size_t)layer * MP * 256; const float* ps = P.in[3] + (size_t)layer * MS * 256;
    for (int i = blockIdx.x * 512 + threadIdx.x; i < MV * 64; i += gridDim.x * 512) {
        const int row = i >> 6, c4 = (i & 63) * 4;
        const f32x4 v = *(const f32x4*)((row < MP ? pp + (size_t)row * 256 : ps + (size_t)(row - MP) * 256) + c4);
        *(uint2*)(PB + (size_t)row * 256 + c4) = pack4(v[0], v[1], v[2], v[3]);
    }
}

DI void ssd_prompt_item(const Params& P, unsigned char* L, int item) {
    const int b = item >> 4, h = item & 15, g = h >> 3;
    const int tid = otid(), lane = tid & 63, wid = tid >> 6, hh = lane >> 5, l31 = lane & 31;
    bf16_t* Cs = (bf16_t*)L;
    bf16_t* Bs = Cs + 128 * 136;
    bf16_t* BwT = Bs + 128 * 136;
    bf16_t* XsT = BwT + 128 * 136;
    bf16_t* St = XsT + 64 * 136;
    float* dtv = (float*)(St + 64 * 136); float* acs = dtv + 128; float* wv = acs + 128; float* tot = wv + 128;
    const bf16_t* U = WSP(bf16_t, OFF_U); const float* DT = WSP(float, OFF_DT); bf16_t* MIX = WSP(bf16_t, OFF_MIX); float* SSB = WSP(float, OFF_SSB);
    const float a_neg = -__expf(P.in[22][h]), dtb = P.in[21][h], Dh = P.in[23][h];
    f32x16 accS;
#pragma unroll
    for (int i = 0; i < 16; ++i) accS[i] = 0.f;
    __syncthreads();
    for (int i = tid; i < 64 * 136; i += 512) St[i] = 0;
    const int cq = tid % 80, cseg = tid / 80;
    int cch = 0;
    if (cq < 16) cch = h * 64 + cq * 4; else if (cq < 48) cch = 1024 + g * 128 + (cq - 16) * 4; else cch = 1280 + g * 128 + (cq - 48) * 4;
    float cw[4][4], cbias[4];
    if (tid < 320) {
#pragma unroll
        for (int kk = 0; kk < 4; ++kk)
#pragma unroll
            for (int e = 0; e < 4; ++e) cw[kk][e] = P.in[19][kk * 1536 + cch + e];
#pragma unroll
        for (int e = 0; e < 4; ++e) cbias[e] = P.in[20][cch + e];
    }
    for (int c = 0; c < 16; ++c) {
        const int row0 = b * 2048 + c * 128;
        __syncthreads();
        if (tid < 128) {
            const float d = softplus(DT[(size_t)(row0 + tid) * 16 + h] + dtb);
            float v = d * a_neg;
#pragma unroll
            for (int o = 1; o < 64; o <<= 1) { const float n = __shfl_up(v, o); if (lane >= o) v += n; }
            dtv[tid] = d; acs[tid] = v; if (tid == 63) tot[0] = v;
        }
        __syncthreads();
        if (tid >= 64 && tid < 128) acs[tid] += tot[0];
        __syncthreads();
        const float a_last = acs[127];
        if (tid < 128) wv[tid] = __expf(a_last - acs[tid]) * dtv[tid];
        __syncthreads();
        if (tid < 320) {
            const int t0 = cseg * 32;
            float r0[4], r1[4], r2[4], cur[4];
            { const int tg = c * 128 + t0;
              const bf16_t* up = U + (size_t)(row0 + t0) * N0 + 3072 + cch;
              if (tg >= 3) { ld4bf(up - 3 * N0, r0); ld4bf(up - 2 * N0, r1); ld4bf(up - N0, r2); }
              else {
#pragma unroll
                  for (int e = 0; e < 4; ++e) { r0[e] = 0.f; r1[e] = 0.f; r2[e] = 0.f; } } }
            for (int t = t0; t < t0 + 32; ++t) {
                ld4bf(U + (size_t)(row0 + t) * N0 + 3072 + cch, cur);
                float y[4];
#pragma unroll
                for (int e = 0; e < 4; ++e) { y[e] = silu(cbias[e] + cw[0][e] * r0[e] + cw[1][e] * r1[e] + cw[2][e] * r2[e] + cw[3][e] * cur[e]); r0[e] = r1[e]; r1[e] = r2[e]; r2[e] = cur[e]; }
                if (cq < 16) {
#pragma unroll
                    for (int e = 0; e < 4; ++e) XsT[(cq * 4 + e) * 136 + t] = f2bf(y[e]);
                } else if (cq < 48) {
                    const int n0 = (cq - 16) * 4; const float w = wv[t];
                    *(uint2*)(Bs + t * 136 + n0) = pack4(y[0], y[1], y[2], y[3]);
#pragma unroll
                    for (int e = 0; e < 4; ++e) BwT[(n0 + e) * 136 + t] = f2bf(y[e] * w);
                } else {
                    const int n0 = (cq - 48) * 4;
                    *(uint2*)(Cs + t * 136 + n0) = pack4(y[0], y[1], y[2], y[3]);
                }
            }
        }
        __syncthreads();
        {
            const int rb = (wid >> 1) * 32, cb0 = (wid & 1) * 64;
            f32x16 cbA[2];
#pragma unroll
            for (int i = 0; i < 16; ++i) { cbA[0][i] = 0.f; cbA[1][i] = 0.f; }
#pragma unroll
            for (int ks = 0; ks < 8; ++ks) {
                const bf16x8 a = ldfrag(Cs, 136, rb, ks * 16, lane);
                cbA[0] = MFMA32(a, ldfrag(Bs, 136, cb0, ks * 16, lane), cbA[0]);
                cbA[1] = MFMA32(a, ldfrag(Bs, 136, cb0 + 32, ks * 16, lane), cbA[1]);
            }
            __syncthreads();
            bf16_t* Ws = Bs;
#pragma unroll
            for (int j = 0; j < 2; ++j) {
                const int s = cb0 + j * 32 + l31; const float as = acs[s], ds = dtv[s];
#pragma unroll
                for (int reg = 0; reg < 16; ++reg) {
                    const int t = rb + crow(reg, hh);
                    const float v = (s <= t) ? cbA[j][reg] * __expf(acs[t] - as) * ds : 0.f;
                    Ws[t * 136 + s] = f2bf(v);
                }
            }
        }
        __syncthreads();
        {
            const bf16_t* Ws = Bs;
            const int tb = (wid >> 1) * 32, pb = (wid & 1) * 32;
            f32x16 y;
#pragma unroll
            for (int i = 0; i < 16; ++i) y[i] = 0.f;
#pragma unroll
            for (int ks = 0; ks < 8; ++ks) y = MFMA32(ldfrag(Cs, 136, tb, ks * 16, lane), ldfrag(St, 136, pb, ks * 16, lane), y);
#pragma unroll
            for (int reg = 0; reg < 16; ++reg) y[reg] *= __expf(acs[tb + crow(reg, hh)]);
#pragma unroll
            for (int ks = 0; ks < 8; ++ks) y = MFMA32(ldfrag(Ws, 136, tb, ks * 16, lane), ldfrag(XsT, 136, pb, ks * 16, lane), y);
            const int p = pb + l31, ch = h * 64 + p; const float nwv = P.in[24][ch];
#pragma unroll
            for (int reg = 0; reg < 16; ++reg) {
                const int t = tb + crow(reg, hh); const size_t row = (size_t)(row0 + t);
                const float xv = bf2f(XsT[p * 136 + t]); const float z = bf2f(U[row * N0 + 2048 + ch]);
                const float yy = (y[reg] + Dh * xv) * silu(z);
                float ss = yy * yy;
                ss += __shfl_xor(ss, 1); ss += __shfl_xor(ss, 2); ss += __shfl_xor(ss, 4); ss += __shfl_xor(ss, 8); ss += __shfl_xor(ss, 16);
                if (l31 == 0) atomicAdd(SSB + row * 2 + g, ss);
                MIX[row * 2048 + 1024 + ch] = f2bf(yy * nwv);
            }
            const int pb2 = (wid >> 2) * 32, nb = (wid & 3) * 32;
            const float ea = __expf(a_last);
#pragma unroll
            for (int reg = 0; reg < 16; ++reg) accS[reg] *= ea;
#pragma unroll
            for (int ks = 0; ks < 8; ++ks) accS = MFMA32(ldfrag(XsT, 136, pb2, ks * 16, lane), ldfrag(BwT, 136, nb, ks * 16, lane), accS);
            __syncthreads();
#pragma unroll
            for (int reg = 0; reg < 16; ++reg) St[(pb2 + crow(reg, hh)) * 136 + nb + l31] = f2bf(accS[reg]);
        }
    }
    {
        const int pb2 = (wid >> 2) * 32, nb = (wid & 3) * 32;
        float* o = P.out + O_BSP + (size_t)(b * 16 + h) * 64 * 128;
#pragma unroll
        for (int reg = 0; reg < 16; ++reg) o[(pb2 + crow(reg, hh)) * 128 + nb + l31] = accS[reg];
    }
}
DI void ssd_sample_item(const Params& P, unsigned char* L, int item) {
    const int b = item >> 4, h = item & 15, g = h >> 3, tid = otid(), lane = tid & 63;
    float* xs = (float*)L; float* Bv = xs + 64; float* Cv = Bv + 128; float* yv = Cv + 128;
    const bf16_t* U = WSP(bf16_t, OFF_U); bf16_t* MIX = WSP(bf16_t, OFF_MIX); float* SSB = WSP(float, OFF_SSB);
    const size_t row = (size_t)(MP + b);
    __syncthreads();
    if (tid < 320) {
        int cc; if (tid < 64) cc = h * 64 + tid; else if (tid < 192) cc = 1024 + g * 128 + (tid - 64); else cc = 1280 + g * 128 + (tid - 192);
        const float* buf = P.in[7] + (size_t)b * 3 * 1536 + cc;
        const float v = P.in[20][cc] + P.in[19][cc] * buf[0] + P.in[19][1536 + cc] * buf[1536] + P.in[19][2 * 1536 + cc] * buf[2 * 1536] + P.in[19][3 * 1536 + cc] * bf2f(U[row * N0 + 3072 + cc]);
        xs[tid] = silu(v);
    }
    const float dt = softplus(WSP(float, OFF_DT)[row * 16 + h] + P.in[21][h]);
    const float dA = __expf(-dt * __expf(P.in[22][h]));
    __syncthreads();
    const float* s0 = P.in[6] + (size_t)(b * 16 + h) * 64 * 128; float* s1 = P.out + O_BSS + (size_t)(b * 16 + h) * 64 * 128;
    const int n4 = (tid & 31) * 4;
    const f32x4 Bq = *(const f32x4*)(Bv + n4), Cq = *(const f32x4*)(Cv + n4);
#pragma unroll
    for (int j = 0; j < 4; ++j) {
        const int p = (tid >> 5) + 16 * j;
        const f32x4 s = *(const f32x4*)(s0 + p * 128 + n4);
        const float dx = dt * xs[p];
        const f32x4 sn = s * dA + Bq * dx;
        *(f32x4*)(s1 + p * 128 + n4) = sn;
        float yp = sn[0] * Cq[0] + sn[1] * Cq[1] + sn[2] * Cq[2] + sn[3] * Cq[3];
        yp += __shfl_xor(yp, 1); yp += __shfl_xor(yp, 2); yp += __shfl_xor(yp, 4); yp += __shfl_xor(yp, 8); yp += __shfl_xor(yp, 16);
        if ((tid & 31) == 0) yv[p] = yp;
    }
    __syncthreads();
    if (tid < 64) {
        const int ch = h * 64 + tid;
        const float yy = (yv[tid] + P.in[23][h] * xs[tid]) * silu(bf2f(U[row * N0 + 2048 + ch]));
        const float ss = wave_sum(yy * yy);
        if (lane == 0) atomicAdd(SSB + row * 2 + g, ss);
        MIX[row * 2048 + 1024 + ch] = f2bf(yy * P.in[24][ch]);
    }
}
template <bool SAMPLE>
DI void rglru_item(const Params& P, unsigned char* L, int item) {
    const int tid = otid(), lane = tid & 63, wid = tid >> 6;
    const int b = SAMPLE ? 0 : (item >> 5), k = (item >> 2) & 7, dq = item & 3;
    bf16_t* Xs = (bf16_t*)L;
    bf16_t* Wg = Xs + 128 * 136;
    float* Xf = (float*)(Wg + 64 * 136);
    float* Aa = Xf + 128 * 32; float* Uu = Aa + 128 * 32; float* segA = Uu + 128 * 32; float* segH = segA + 512; float* hc = segH + 512;
    const bf16_t* U = WSP(bf16_t, OFF_U); bf16_t* MIX = WSP(bf16_t, OFF_MIX);
    __syncthreads();
    {
        const bf16_t* WRT = WSP(bf16_t, OFF_WRT); const bf16_t* WIT = WSP(bf16_t, OFF_WIT);
#pragma unroll
        for (int i = 0; i < 2; ++i) {
            const int chk = tid + i * 512, r = chk >> 4, c8 = (chk & 15) * 8;
            const bf16_t* src = (r < 32 ? WRT + (size_t)(dq * 32 + r) * 1024 : WIT + (size_t)(dq * 32 + r - 32) * 1024) + k * 128 + c8;
            *(uint4*)(Wg + r * 136 + c8) = *(const uint4*)src;
        }
        if (tid < 32) hc[tid] = 0.f;
    }
    float sp[2], br[2], bi[2];
#pragma unroll
    for (int ct = 0; ct < 2; ++ct) { const int chd = k * 128 + dq * 32 + ct * 16 + (lane & 15); sp[ct] = softplus(-P.in[18][chd]); br[ct] = P.in[15][chd]; bi[ct] = P.in[17][chd]; }
    const int quad = tid & 31, seg = tid >> 5, ch0 = k * 128 + quad * 4;
    float cw[4][4], cbias[4];
#pragma unroll
    for (int kk = 0; kk < 4; ++kk)
#pragma unroll
        for (int e = 0; e < 4; ++e) cw[kk][e] = P.in[12][kk * 1024 + ch0 + e];
#pragma unroll
    for (int e = 0; e < 4; ++e) cbias[e] = P.in[13][ch0 + e];
    const int sd = tid & 31, sch = k * 128 + dq * 32 + sd;
    const int ntiles = SAMPLE ? 1 : 16;
    for (int tile = 0; tile < ntiles; ++tile) {
        const int row0 = SAMPLE ? MP : b * 2048 + tile * 128;
        __syncthreads();
        if (SAMPLE) {
            for (int t = 0; t < 8; ++t) {
                const int bb = seg * 8 + t;
                const float* buf = P.in[5] + (size_t)bb * 3 * 1024 + ch0;
                const f32x4 p0 = *(const f32x4*)buf, p1 = *(const f32x4*)(buf + 1024), p2 = *(const f32x4*)(buf + 2048);
                float cur[4]; ld4bf(U + (size_t)(MP + bb) * N0 + ch0, cur);
                float y[4];
#pragma unroll
                for (int e = 0; e < 4; ++e) y[e] = cbias[e] + cw[0][e] * p0[e] + cw[1][e] * p1[e] + cw[2][e] * p2[e] + cw[3][e] * cur[e];
                *(uint2*)(Xs + bb * 136 + quad * 4) = pack4(y[0], y[1], y[2], y[3]);
                if ((quad >> 3) == dq) *(f32x4*)(Xf + bb * 32 + (quad & 7) * 4) = (f32x4){y[0], y[1], y[2], y[3]};
            }
        } else {
            float r0[4], r1[4], r2[4], cur[4];
            const int tl = seg * 8, tg = tile * 128 + tl;
            const bf16_t* up = U + (size_t)(row0 + tl) * N0 + ch0;
            if (tg >= 3) { ld4bf(up - 3 * N0, r0); ld4bf(up - 2 * N0, r1); ld4bf(up - N0, r2); }
            else {
#pragma unroll
                for (int e = 0; e < 4; ++e) { r0[e] = 0.f; r1[e] = 0.f; r2[e] = 0.f; } }
#pragma unroll
            for (int t = 0; t < 8; ++t) {
                ld4bf(up + (size_t)t * N0, cur);
                float y[4];
#pragma unroll
                for (int e = 0; e < 4; ++e) { y[e] = cbias[e] + cw[0][e] * r0[e] + cw[1][e] * r1[e] + cw[2][e] * r2[e] + cw[3][e] * cur[e]; r0[e] = r1[e]; r1[e] = r2[e]; r2[e] = cur[e]; }
                *(uint2*)(Xs + (tl + t) * 136 + quad * 4) = pack4(y[0], y[1], y[2], y[3]);
                if ((quad >> 3) == dq) *(f32x4*)(Xf + (tl + t) * 32 + (quad & 7) * 4) = (f32x4){y[0], y[1], y[2], y[3]};
            }
        }
        __syncthreads();
        {
            f32x4 acc[4];
#pragma unroll
            for (int i = 0; i < 4; ++i) acc[i] = (f32x4){0.f, 0.f, 0.f, 0.f};
#pragma unroll
            for (int ks = 0; ks < 4; ++ks) {
                const bf16x8 a = ldfrag16(Xs, 136, wid * 16, ks * 32, lane);
#pragma unroll
                for (int tl = 0; tl < 4; ++tl) acc[tl] = MFMA16(a, ldfrag16(Wg, 136, tl * 16, ks * 32, lane), acc[tl]);
            }
#pragma unroll
            for (int ct = 0; ct < 2; ++ct)
#pragma unroll
                for (int reg = 0; reg < 4; ++reg) {
                    const int t = wid * 16 + (lane >> 4) * 4 + reg, d = ct * 16 + (lane & 15);
                    const float r = sigm(acc[ct][reg] + br[ct]), gi = sigm(acc[2 + ct][reg] + bi[ct]);
                    const float la = -8.f * r * sp[ct];
                    const float a = __expf(la), uu = sqrtf(-expm1f(2.f * la)) * gi * Xf[t * 32 + d];
                    if (SAMPLE) {
                        const int chd = k * 128 + dq * 32 + d;
                        const float hn = a * P.in[4][(size_t)t * 1024 + chd] + uu;
                        P.out[O_AHS + (size_t)t * 1024 + chd] = hn;
                        const float gt = bf2f(U[(size_t)(MP + t) * N0 + 1024 + chd]);
                        MIX[(size_t)(MP + t) * 2048 + chd] = f2bf(hn * silu(gt));
                    } else { Aa[t * 32 + d] = a; Uu[t * 32 + d] = uu; }
                }
        }
        if (!SAMPLE) {
            __syncthreads();
            float av[8], uv[8], Ap = 1.f, Hp = 0.f;
#pragma unroll
            for (int t = 0; t < 8; ++t) { av[t] = Aa[(seg * 8 + t) * 32 + sd]; uv[t] = Uu[(seg * 8 + t) * 32 + sd]; Hp = av[t] * Hp + uv[t]; Ap *= av[t]; }
            segA[seg * 32 + sd] = Ap; segH[seg * 32 + sd] = Hp;
            __syncthreads();
            float hin = hc[sd];
            for (int s = 0; s < seg; ++s) hin = segA[s * 32 + sd] * hin + segH[s * 32 + sd];
#pragma unroll
            for (int t = 0; t < 8; ++t) {
                hin = av[t] * hin + uv[t];
                const size_t row = (size_t)(row0 + seg * 8 + t);
                const float gt = bf2f(U[row * N0 + 1024 + sch]);
                MIX[row * 2048 + sch] = f2bf(hin * silu(gt));
            }
            __syncthreads();
            if (seg == 15) hc[sd] = hin;
        }
    }
    if (!SAMPLE) { __syncthreads(); if (tid < 32) P.out[O_AHP + (size_t)b * 1024 + k * 128 + dq * 32 + tid] = hc[tid]; }
}
DI void phase_mix0(const Params& P, unsigned char* L) {
    const int tid = otid(), bid = blockIdx.x, G = gridDim.x;
    { const bf16_t* U = WSP(bf16_t, OFF_U);
      for (int i = bid * 512 + tid; i < 8 * 3 * 1024; i += G * 512) { const int c = i & 1023, j = (i >> 10) % 3, b = i / 3072; P.out[O_ACP + i] = bf2f(U[(size_t)(b * 2048 + 2045 + j) * N0 + c]); }
      for (int i = bid * 512 + tid; i < 8 * 3 * 1536; i += G * 512) { const int c = i % 1536, j = (i / 1536) % 3, b = i / 4608; P.out[O_BCP + i] = bf2f(U[(size_t)(b * 2048 + 2045 + j) * N0 + 3072 + c]); }
      for (int i = bid * 512 + tid; i < 128 * 3 * 1024; i += G * 512) { const int c = i & 1023, j = (i >> 10) % 3, b = i / 3072; P.out[O_ACS + i] = j < 2 ? P.in[5][(size_t)(b * 3 + j + 1) * 1024 + c] : bf2f(U[(size_t)(MP + b) * N0 + c]); }
      for (int i = bid * 512 + tid; i < 128 * 3 * 1536; i += G * 512) { const int c = i % 1536, j = (i / 1536) % 3, b = i / 4608; P.out[O_BCS + i] = j < 2 ? P.in[7][(size_t)(b * 3 + j + 1) * 1536 + c] : bf2f(U[(size_t)(MP + b) * N0 + 3072 + c]); } }
    if (bid < 128) ssd_prompt_item(P, L, bid);
    else { for (int it = bid - 128; it < 256; it += (G - 128)) rglru_item<false>(P, L, it); }
    unsigned* ctr = WSP(unsigned, OFF_CTL);
    unsigned* bc = (unsigned*)(L + LDS_BYTES - 16);
    for (;;) {
        __syncthreads();
        if (tid == 0) bc[0] = atomicAdd(ctr, 1u);
        __syncthreads();
        const unsigned it = bc[0];
        if (it >= 32u + 2048u) break;
        if (it < 32u) rglru_item<true>(P, L, (int)it); else ssd_sample_item(P, L, (int)(it - 32u));
    }
}
DI void phase_norm0(const Params& P) {
    bf16_t* MIX = WSP(bf16_t, OFF_MIX); const float* SSB = WSP(float, OFF_SSB);
    for (int i = blockIdx.x * 512 + threadIdx.x; i < MV * 128; i += gridDim.x * 512) {
        const int row = i >> 7, c8 = (i & 127) * 8, g = c8 >> 9;
        const float sc = rsqrtf(SSB[(size_t)row * 2 + g] * (1.f / 512.f) + EPSF);
        uint4* p = (uint4*)(MIX + (size_t)row * 2048 + 1024 + c8); uint4 w = *p;
        w.x = pack2(bflo(w.x) * sc, bfhi(w.x) * sc); w.y = pack2(bflo(w.y) * sc, bfhi(w.y) * sc); w.z = pack2(bflo(w.z) * sc, bfhi(w.z) * sc); w.w = pack2(bflo(w.w) * sc, bfhi(w.w) * sc);
        *p = w;
    }
}

DI void hgrn_prompt_item(const Params& P, unsigned char* L, int item) {
    const int b = item >> 4, h = item & 15;
    const int tid = otid(), lane = tid & 63, wid = tid >> 6, hh = lane >> 5, l31 = lane & 31;
    bf16_t* Qs = (bf16_t*)L;
    bf16_t* Ks = Qs + 64 * 136;
    float* Of = (float*)L;
    bf16_t* KsT = Ks + 64 * 136;
    bf16_t* VsT = KsT + 128 * 72;
    bf16_t* SsT = VsT + 128 * 72;
    bf16_t* As = SsT + 128 * 136;
    float* Gseg = (float*)(As + 64 * 72);
    float* E1 = Gseg + 16 * 128; float* E2 = E1 + 128;
    const bf16_t* U = WSP(bf16_t, OFF_U); bf16_t* MIX = WSP(bf16_t, OFF_MIX);
    const int kq = tid & 31, ts = tid >> 5;
    float lb[4];
#pragma unroll
    for (int e = 0; e < 4; ++e) { const int ch = h * 128 + kq * 4 + e; lb[e] = sigm(P.in[27][2048 + ch] - P.in[27][ch]); }
    const int kb = (wid >> 1) * 32, vb0 = (wid & 1) * 64;
    f32x16 accS[2];
#pragma unroll
    for (int i = 0; i < 16; ++i) { accS[0][i] = 0.f; accS[1][i] = 0.f; }
    uint2 rq[4], rf[4], rv[4];
#define HG_LOAD(cc) do { _Pragma("unroll") for (int i = 0; i < 4; ++i) { const bf16_t* bp = U + (size_t)(b * 2048 + (cc) * 64 + ts * 4 + i) * INC + h * 128 + kq * 4; \
        rq[i] = *(const uint2*)bp; rf[i] = *(const uint2*)(bp + 2048); rv[i] = *(const uint2*)(bp + 4096); } } while (0)
    HG_LOAD(0);
    __syncthreads();
    for (int c = 0; c < 32; ++c) {
        float kk[4][4], cs[4][4];
#pragma unroll
        for (int i = 0; i < 4; ++i) {
            const float fx[4] = {bflo(rf[i].x), bfhi(rf[i].x), bflo(rf[i].y), bfhi(rf[i].y)};
#pragma unroll
            for (int e = 0; e < 4; ++e) {
                const float sg = sigm(fx[e]); const float kv = (1.f - lb[e]) * (1.f - sg);
                kk[i][e] = kv; const float gl = __logf(1.f - kv);
                cs[i][e] = (i == 0 ? 0.f : cs[i - 1][e]) + gl;
            }
        }
        *(f32x4*)(Gseg + ts * 128 + kq * 4) = (f32x4){cs[3][0], cs[3][1], cs[3][2], cs[3][3]};
        __syncthreads();
        f32x4 off = {0.f, 0.f, 0.f, 0.f}, gmid = off, glast = off;
#pragma unroll
        for (int s = 0; s < 16; ++s) { const f32x4 v = *(const f32x4*)(Gseg + s * 128 + kq * 4); if (s < ts) off += v; if (s < 8) gmid += v; glast += v; }
        {
            float qt[4][4], kt[4][4], vt[4][4];
#pragma unroll
            for (int i = 0; i < 4; ++i) {
                const float q[4] = {bflo(rq[i].x), bfhi(rq[i].x), bflo(rq[i].y), bfhi(rq[i].y)};
                vt[i][0] = bflo(rv[i].x); vt[i][1] = bfhi(rv[i].x); vt[i][2] = bflo(rv[i].y); vt[i][3] = bfhi(rv[i].y);
#pragma unroll
                for (int e = 0; e < 4; ++e) { const float Gv = off[e] + cs[i][e]; qt[i][e] = q[e] * 0.08838834764831845f * __expf(Gv - gmid[e]); kt[i][e] = kk[i][e] * __expf(gmid[e] - Gv); }
                *(uint2*)(Qs + (ts * 4 + i) * 136 + kq * 4) = pack4(qt[i][0], qt[i][1], qt[i][2], qt[i][3]);
                *(uint2*)(Ks + (ts * 4 + i) * 136 + kq * 4) = pack4(kt[i][0], kt[i][1], kt[i][2], kt[i][3]);
            }
#pragma unroll
            for (int e = 0; e < 4; ++e) {
                *(uint2*)(KsT + (kq * 4 + e) * 72 + ts * 4) = pack4(kt[0][e], kt[1][e], kt[2][e], kt[3][e]);
                *(uint2*)(VsT + (kq * 4 + e) * 72 + ts * 4) = pack4(vt[0][e], vt[1][e], vt[2][e], vt[3][e]);
            }
            if (ts == 0) {
#pragma unroll
                for (int e = 0; e < 4; ++e) { E1[kq * 4 + e] = __expf(gmid[e]); E2[kq * 4 + e] = __expf(glast[e] - gmid[e]); }
            }
        }
        if (c + 1 < 32) HG_LOAD(c + 1);
        __syncthreads();
#pragma unroll
        for (int j = 0; j < 2; ++j) {
#pragma unroll
            for (int reg = 0; reg < 16; ++reg) accS[j][reg] *= E1[kb + crow(reg, hh)];
            const int v = vb0 + j * 32 + l31;
#pragma unroll
            for (int rg = 0; rg < 4; ++rg) *(uint2*)(SsT + v * 136 + kb + 8 * rg + 4 * hh) = pack4(accS[j][4 * rg], accS[j][4 * rg + 1], accS[j][4 * rg + 2], accS[j][4 * rg + 3]);
        }
        if (wid < 4) {
            const int tb = (wid >> 1) * 32, sb = (wid & 1) * 32;
            f32x16 aa;
#pragma unroll
            for (int i = 0; i < 16; ++i) aa[i] = 0.f;
#pragma unroll
            for (int ks = 0; ks < 8; ++ks) aa = MFMA32(ldfrag(Qs, 136, tb, ks * 16, lane), ldfrag(Ks, 136, sb, ks * 16, lane), aa);
            const int s = sb + l31;
#pragma unroll
            for (int reg = 0; reg < 16; ++reg) { const int t = tb + crow(reg, hh); As[t * 72 + s] = f2bf(s <= t ? aa[reg] : 0.f); }
        }
        __syncthreads();
        const int tb2 = (wid >> 2) * 32, vb2 = (wid & 3) * 32;
        f32x16 o;
#pragma unroll
        for (int i = 0; i < 16; ++i) o[i] = 0.f;
#pragma unroll
        for (int ks = 0; ks < 8; ++ks) o = MFMA32(ldfrag(Qs, 136, tb2, ks * 16, lane), ldfrag(SsT, 136, vb2, ks * 16, lane), o);
#pragma unroll
        for (int ks = 0; ks < 4; ++ks) o = MFMA32(ldfrag(As, 72, tb2, ks * 16, lane), ldfrag(VsT, 72, vb2, ks * 16, lane), o);
#pragma unroll
        for (int j = 0; j < 2; ++j) {
#pragma unroll
            for (int ks = 0; ks < 4; ++ks) accS[j] = MFMA32(ldfrag(KsT, 72, kb, ks * 16, lane), ldfrag(VsT, 72, vb0 + j * 32, ks * 16, lane), accS[j]);
#pragma unroll
            for (int reg = 0; reg < 16; ++reg) accS[j][reg] *= E2[kb + crow(reg, hh)];
        }
        __syncthreads();
#pragma unroll
        for (int reg = 0; reg < 16; ++reg) Of[(tb2 + crow(reg, hh)) * 132 + vb2 + l31] = o[reg];
        __syncthreads();
        {
            const int t = tid >> 3, vs = tid & 7;
            const size_t row = (size_t)(b * 2048 + c * 64 + t);
            f32x4 ov[4]; float ss = 0.f;
#pragma unroll
            for (int i = 0; i < 4; ++i) { ov[i] = *(const f32x4*)(Of + t * 132 + vs * 16 + i * 4); ss += ov[i][0] * ov[i][0] + ov[i][1] * ov[i][1] + ov[i][2] * ov[i][2] + ov[i][3] * ov[i][3]; }
            ss += __shfl_xor(ss, 1); ss += __shfl_xor(ss, 2); ss += __shfl_xor(ss, 4);
            const float rstd = rsqrtf(ss * (1.f / 128.f) + EPSF);
            const bf16_t* gp = U + row * INC + 6144 + h * 128 + vs * 16; const float* nwp = P.in[28] + h * 128 + vs * 16;
            const uint4 g0 = *(const uint4*)gp, g1 = *(const uint4*)(gp + 8);
            const unsigned gw[8] = {g0.x, g0.y, g0.z, g0.w, g1.x, g1.y, g1.z, g1.w};
            unsigned ow[8];
#pragma unroll
            for (int i = 0; i < 4; ++i) {
                const f32x4 w = *(const f32x4*)(nwp + i * 4);
                ow[2 * i] = pack2(ov[i][0] * rstd * w[0] * silu(bflo(gw[2 * i])), ov[i][1] * rstd * w[1] * silu(bfhi(gw[2 * i])));
                ow[2 * i + 1] = pack2(ov[i][2] * rstd * w[2] * silu(bflo(gw[2 * i + 1])), ov[i][3] * rstd * w[3] * silu(bfhi(gw[2 * i + 1])));
            }
            bf16_t* op = MIX + row * 2048 + h * 128 + vs * 16;
            *(uint4*)op = make_uint4(ow[0], ow[1], ow[2], ow[3]); *(uint4*)(op + 8) = make_uint4(ow[4], ow[5], ow[6], ow[7]);
        }
        __syncthreads();
    }
#undef HG_LOAD
    float* so = P.out + O_CP + (size_t)(b * 16 + h) * 128 * 128;
#pragma unroll
    for (int j = 0; j < 2; ++j)
#pragma unroll
        for (int reg = 0; reg < 16; ++reg) so[(kb + crow(reg, hh)) * 128 + vb0 + j * 32 + l31] = accS[j][reg];
}
DI void hgrn_sample_item(const Params& P, unsigned char* L, int item) {
    const int b = item >> 4, h = item & 15, tid = otid(), lane = tid & 63;
    float* qv = (float*)L; float* egv = qv + 128; float* kkv = egv + 128; float* vv = kkv + 128; float* part = vv + 128; float* red = part + 16 * 128;
    const bf16_t* U = WSP(bf16_t, OFF_U); bf16_t* MIX = WSP(bf16_t, OFF_MIX);
    const size_t row = (size_t)(MP + b); const bf16_t* ub = U + row * INC + h * 128;
    __syncthreads();
    if (tid < 128) {
        const int ch = h * 128 + tid;
        const float lbv = sigm(P.in[27][2048 + ch] - P.in[27][ch]);
        const float sg = sigm(bf2f(ub[2048 + tid])); const float kv = (1.f - lbv) * (1.f - sg);
        qv[tid] = bf2f(ub[tid]) * 0.08838834764831845f; egv[tid] = 1.f - kv; kkv[tid] = kv;
    } else if (tid < 256) vv[tid - 128] = bf2f(ub[4096 + tid - 128]);
    __syncthreads();
    const float* s0 = P.in[8] + (size_t)(b * 16 + h) * 128 * 128; float* s1 = P.out + O_CS + (size_t)(b * 16 + h) * 128 * 128;
    const int v4 = (tid & 31) * 4; const f32x4 vq = *(const f32x4*)(vv + v4);
    f32x4 op = {0.f, 0.f, 0.f, 0.f};
#pragma unroll
    for (int j = 0; j < 8; ++j) {
        const int k = (tid >> 5) + 16 * j;
        const f32x4 s = *(const f32x4*)(s0 + k * 128 + v4);
        const f32x4 sn = s * egv[k] + vq * kkv[k];
        *(f32x4*)(s1 + k * 128 + v4) = sn;
        op += sn * qv[k];
    }
    *(f32x4*)(part + (tid >> 5) * 128 + v4) = op;
    __syncthreads();
    float o = 0.f;
    if (tid < 128) {
#pragma unroll
        for (int i = 0; i < 16; ++i) o += part[i * 128 + tid];
        const float ss = wave_sum(o * o);
        if (lane == 0) red[tid >> 6] = ss;
    }
    __syncthreads();
    if (tid < 128) {
        const float rstd = rsqrtf((red[0] + red[1]) * (1.f / 128.f) + EPSF);
        const int ch = h * 128 + tid;
        MIX[row * 2048 + ch] = f2bf(o * rstd * P.in[28][ch] * silu(bf2f(ub[6144 + tid])));
    }
}
DI void phase_mix1(const Params& P, unsigned char* L) {
    const int tid = otid(), bid = blockIdx.x;
    if (bid < 128) hgrn_prompt_item(P, L, bid);
    unsigned* ctr = WSP(unsigned, OFF_CTL) + 16;
    unsigned* bc = (unsigned*)(L + LDS_BYTES - 16);
    for (;;) {
        __syncthreads();
        if (tid == 0) bc[0] = atomicAdd(ctr, 1u);
        __syncthreads();
        const unsigned it = bc[0];
        if (it >= 2048u) break;
        hgrn_sample_item(P, L, (int)it);
    }
}
DI void phase_final(const Params& P) {
    const int lane = threadIdx.x & 63, gw = blockIdx.x * 8 + (threadIdx.x >> 6), nwv = gridDim.x * 8;
    const float* H = WSP(float, OFF_H); const float* SS = WSP(float, OFF_SS2); const float* nf = P.in[10];
    f32x4 w4[4];
#pragma unroll
    for (int i = 0; i < 4; ++i) w4[i] = *(const f32x4*)(nf + lane * 4 + 256 * i);
    for (int r = gw; r < MV; r += nwv) {
        const float rstd = rsqrtf(SS[r] * (1.f / 1024.f) + EPSF);
#pragma unroll
        for (int i = 0; i < 4; ++i) { const f32x4 v = *(const f32x4*)(H + (size_t)r * 1024 + lane * 4 + 256 * i); *(f32x4*)(P.out + O_Y + (size_t)r * 1024 + lane * 4 + 256 * i) = v * rstd * w4[i]; }
    }
}

#ifndef PHM
#define PHM 0xFFFF
#endif
typedef const __attribute__((address_space(4))) Params* ParamsK;
DI Params getp() {
    ParamsK pp = (ParamsK)__builtin_amdgcn_kernarg_segment_ptr(); asm volatile("" : "+s"(pp));
    Params P;
#pragma unroll
    for (int i = 0; i < 32; ++i) P.in[i] = pp->in[i];
    P.out = pp->out; P.ws = pp->ws; return P;
}
#define GETP() const Params P = getp()
__global__ void __launch_bounds__(512, 2) fwd_kernel(Params Parg) {
    extern __shared__ __attribute__((aligned(16))) unsigned char lds[];
    cg::grid_group grid = cg::this_grid();
    unsigned char* L = (unsigned char*)lds;
    LAS unsigned char* LL = (LAS unsigned char*)lds;
    if (PHM & 1) { GETP(); phase_prep(P, L); }
    grid.sync();
    if (PHM & 2) { GETP(); pg8::StaticOrder S; S.init(MPAD, N0, gridDim.x, blockIdx.x); pg8::Gemm g{WSP(bf16_t, OFF_XN), WSP(bf16_t, OFF_W0T), MPAD, N0, 1024};
      EpiStoreBf16 E{WSP(bf16_t, OFF_U), N0, nullptr}; pg8::gemm_phase(LL, g, S, E); }
    grid.sync();
    if (PHM & 4) { GETP(); phase_mix0(P, L); }
    grid.sync();
    { GETP(); phase_norm0(P); }
    grid.sync();
    { GETP(); convert_p(P, 0); }
    __syncthreads();
    if (PHM & 8) { GETP(); pg8::StaticOrder S; S.init(MPAD, 1024, gridDim.x, blockIdx.x); pg8::Gemm g{WSP(bf16_t, OFF_MIX), WSP(bf16_t, OFF_WO0T), MPAD, 1024, 2048};
      EpiResid E{P.in[0], P.in[1], WSP(float, OFF_H), WSP(bf16_t, OFF_HB)}; pg8::gemm_phase(LL, g, S, E); }
    grid.sync();
    if (PHM & 16) { GETP(); pg8::StaticOrder S; S.init(MPAD, 1024, gridDim.x, blockIdx.x);
      pg8::Gemm g1{WSP(bf16_t, OFF_HB), WSP(bf16_t, OFF_WG0T), MPAD, 1024, 1024}; EpiGate E1{WSP(float, OFF_MIX)}; pg8::gemm_phase(LL, g1, S, E1); }
    if (PHM & 16) { GETP(); pg8::StaticOrder S; S.init(MPAD, 1024, gridDim.x, blockIdx.x);
      pg8::Gemm g2{WSP(bf16_t, OFF_PB), WSP(bf16_t, OFF_WP0T), MPAD, 1024, 256};
      EpiPle E2{WSP(float, OFF_H), WSP(float, OFF_MIX), WSP(bf16_t, OFF_XN), P.in[9] + 1024, WSP(float, OFF_SS1)}; pg8::gemm_phase(LL, g2, S, E2); }
    grid.sync();
    if (PHM & 32) { GETP(); pg8::StaticOrder S; S.init(MPAD, INC, gridDim.x, blockIdx.x); pg8::Gemm g{WSP(bf16_t, OFF_XN), WSP(bf16_t, OFF_W1T), MPAD, INC, 1024};
      EpiStoreBf16 E{WSP(bf16_t, OFF_U), INC, WSP(float, OFF_SS1)}; pg8::gemm_phase(LL, g, S, E); }
    grid.sync();
    if (PHM & 64) { GETP(); phase_mix1(P, L); }
    grid.sync();
    { GETP(); convert_p(P, 1); }
    __syncthreads();
    if (PHM & 128) { GETP(); pg8::StaticOrder S; S.init(MPAD, 1024, gridDim.x, blockIdx.x); pg8::Gemm g{WSP(bf16_t, OFF_MIX), WSP(bf16_t, OFF_WO1T), MPAD, 1024, 2048};
      EpiResid E{WSP(float, OFF_H), WSP(float, OFF_H) + (size_t)MP * 1024, WSP(float, OFF_H), WSP(bf16_t, OFF_HB)}; pg8::gemm_phase(LL, g, S, E); }
    grid.sync();
    if (PHM & 256) { GETP(); pg8::StaticOrder S; S.init(MPAD, 1024, gridDim.x, blockIdx.x);
      pg8::Gemm g1{WSP(bf16_t, OFF_HB), WSP(bf16_t, OFF_WG1T), MPAD, 1024, 1024}; EpiGate E1{WSP(float, OFF_MIX)}; pg8::gemm_phase(LL, g1, S, E1); }
    if (PHM & 256) { GETP(); pg8::StaticOrder S; S.init(MPAD, 1024, gridDim.x, blockIdx.x);
      pg8::Gemm g2{WSP(bf16_t, OFF_PB), WSP(bf16_t, OFF_WP1T), MPAD, 1024, 256};
      EpiPle E2{WSP(float, OFF_H), WSP(float, OFF_MIX), nullptr, nullptr, WSP(float, OFF_SS2)}; pg8::gemm_phase(LL, g2, S, E2); }
    grid.sync();
    { GETP(); phase_final(P); }
}

extern "C" void kernel_launch(void* const* d_in, const int* in_sizes, int n_in, void* d_out, int out_size, void* d_ws, size_t ws_size, hipStream_t stream) {
    static int grid = 0;
    if (grid == 0) {
        if (n_in != 32 || ws_size < WS_END) { fprintf(stderr, "kernel_launch: need 32 inputs and %zu bytes of workspace (got %d, %zu)\n", (size_t)WS_END, n_in, ws_size); grid = -1; return; }
        int dev = 0, cus = 0, per_cu = 0;
        (void)hipGetDevice(&dev); (void)hipDeviceGetAttribute(&cus, hipDeviceAttributeMultiprocessorCount, dev);
        if (hipFuncSetAttribute((const void*)fwd_kernel, hipFuncAttributeMaxDynamicSharedMemorySize, LDS_BYTES) != hipSuccess) { fprintf(stderr, "kernel_launch: hipFuncSetAttribute failed\n"); grid = -1; return; }
        if (hipOccupancyMaxActiveBlocksPerMultiprocessor(&per_cu, (const void*)fwd_kernel, 512, LDS_BYTES) != hipSuccess || per_cu < 1) { fprintf(stderr, "kernel_launch: occupancy query says %d\n", per_cu); per_cu = 1; }
        (void)hipGetLastError();
        grid = cus;
    }
    if (grid < 0) return;
    Params p{};
    for (int i = 0; i < 32; ++i) p.in[i] = (const float*)d_in[i];
    p.out = (float*)d_out; p.ws = (unsigned char*)d_ws;
    void* args[] = {&p};
    hipError_t e = hipLaunchCooperativeKernel((const void*)fwd_kernel, dim3(grid), dim3(512), args, LDS_BYTES, stream);
    if (e != hipSuccess) fprintf(stderr, "cooperative launch failed: %s (grid %d)\n", hipGetErrorString(e), grid);
}
```

```cpp
#include <hip/hip_runtime.h>
#include <hip/hip_cooperative_groups.h>
#include <cstdio>
namespace cg = cooperative_groups;

#define LAS __attribute__((address_space(3)))
#define DI __device__ __forceinline__
typedef unsigned short bf16_t;
typedef short bf16x8 __attribute__((ext_vector_type(8)));
typedef float f32x4 __attribute__((ext_vector_type(4)));
typedef float f32x16 __attribute__((ext_vector_type(16)));

constexpr int MP = 16384, MS = 128, MV = MP + MS, MPAD = 16640;
constexpr int DM = 1024, INAB = 4624, N0 = 4608, INC = 8192;
constexpr float EPSF = 1e-6f;
constexpr size_t O_Y = 0, O_AHP = 16908288, O_ACP = 16916480, O_BSP = 16941056, O_BCP = 17989632, O_CP = 18026496,
                 O_AHS = 20123648, O_ACS = 20254720, O_BSS = 20647936, O_BCS = 37425152, O_CS = 38014976;
constexpr size_t al256(size_t x) { return (x + 255) & ~size_t(255); }
constexpr size_t OFF_CTL = 0;
constexpr size_t OFF_SS1 = 256;
constexpr size_t OFF_SS2 = OFF_SS1 + al256((size_t)MPAD * 4);
constexpr size_t OFF_SSB = OFF_SS2 + al256((size_t)MPAD * 4);
constexpr size_t OFF_DT  = OFF_SSB + al256((size_t)MPAD * 8);
constexpr size_t OFF_W0T = OFF_DT + al256((size_t)MV * 16 * 4);
constexpr size_t OFF_WO0T = OFF_W0T + (size_t)(N0 + 256) * 1024 * 2;
constexpr size_t OFF_WG0T = OFF_WO0T + (size_t)1024 * 2048 * 2;
constexpr size_t OFF_WP0T = OFF_WG0T + (size_t)1024 * 1024 * 2;
constexpr size_t OFF_W1T  = OFF_WP0T + (size_t)1024 * 256 * 2;
constexpr size_t OFF_WO1T = OFF_W1T + (size_t)INC * 1024 * 2;
constexpr size_t OFF_WG1T = OFF_WO1T + (size_t)1024 * 2048 * 2;
constexpr size_t OFF_WP1T = OFF_WG1T + (size_t)1024 * 1024 * 2;
constexpr size_t OFF_WRT  = OFF_WP1T + (size_t)1024 * 256 * 2;
constexpr size_t OFF_WIT  = OFF_WRT + (size_t)128 * 1024 * 2;
constexpr size_t OFF_XN   = OFF_WIT + (size_t)128 * 1024 * 2;
constexpr size_t OFF_MIX  = OFF_XN + (size_t)MPAD * 1024 * 2;
constexpr size_t OFF_H    = OFF_MIX + (size_t)MPAD * 2048 * 2;
constexpr size_t OFF_U    = OFF_H + al256((size_t)MV * 1024 * 4);
constexpr size_t OFF_HB   = OFF_U;
constexpr size_t OFF_PB   = OFF_U + (size_t)MPAD * 1024 * 2;
constexpr size_t WS_END   = OFF_U + al256((size_t)MV * INC * 2);
constexpr int LDS_BYTES = 144 * 1024;

struct Params { const float* in[32]; float* out; unsigned char* ws; };
#define WSP(T, off) ((T*)(P.ws + (off)))

typedef __bf16 bf16v2_t __attribute__((ext_vector_type(2)));
typedef float f32v2_t __attribute__((ext_vector_type(2)));
DI unsigned pack2(float lo, float hi) { f32v2_t v = {lo, hi}; bf16v2_t b = __builtin_convertvector(v, bf16v2_t); return __builtin_bit_cast(unsigned, b); }
DI bf16_t f2bf(float f) { return __builtin_bit_cast(bf16_t, (__bf16)f); }
DI float bf2f(bf16_t b) { return __uint_as_float(((unsigned)b) << 16); }
DI float bflo(unsigned w) { return __uint_as_float(w << 16); }
DI float bfhi(unsigned w) { return __uint_as_float(w & 0xFFFF0000u); }
DI float frcp(float x) { return __builtin_amdgcn_rcpf(x); }
DI float sigm(float x) { return frcp(1.f + __expf(-x)); }
DI float silu(float x) { return x * frcp(1.f + __expf(-x)); }
DI float softplus(float x) { return x > 20.f ? x : log1pf(__expf(x)); }
DI float wave_sum(float v) { for (int o = 32; o > 0; o >>= 1) v += __shfl_xor(v, o); return v; }
DI int otid() { int t = threadIdx.x; asm volatile("" : "+v"(t)); return t; }
DI int crow(int reg, int hh) { return (reg & 3) + 8 * (reg >> 2) + 4 * hh; }
DI void ld4bf(const bf16_t* p, float (&o)[4]) { uint2 w = *(const uint2*)p; o[0] = bflo(w.x); o[1] = bfhi(w.x); o[2] = bflo(w.y); o[3] = bfhi(w.y); }
typedef unsigned u32x2 __attribute__((ext_vector_type(2)));
DI u32x2 pack4v(float a, float b, float c, float d) { u32x2 r; r.x = pack2(a, b); r.y = pack2(c, d); return r; }
DI uint2 pack4(float a, float b, float c, float d) { uint2 r; r.x = pack2(a, b); r.y = pack2(c, d); return r; }
#define MFMA32(a, b, c) __builtin_amdgcn_mfma_f32_32x32x16_bf16((a), (b), (c), 0, 0, 0)
#define MFMA16(a, b, c) __builtin_amdgcn_mfma_f32_16x16x32_bf16((a), (b), (c), 0, 0, 0)
DI bf16x8 ldfrag(const bf16_t* base, int ld, int row0, int k0, int lane) { return *(const bf16x8*)(base + (row0 + (lane & 31)) * ld + k0 + 8 * (lane >> 5)); }
DI bf16x8 ldfrag16(const bf16_t* base, int ld, int row0, int k0, int lane) { return *(const bf16x8*)(base + (row0 + (lane & 15)) * ld + k0 + 8 * (lane >> 4)); }

namespace pg8 {
constexpr int BM = 256, BK = 64, HALF = 128, HTB = HALF * BK * 2, STAGE_BYTES = 8 * HTB, NXCD = 8, WGM = 8;
DI int lds_byte(int r, int c) { const int st = (r >> 4) * 2 + (c >> 5), rr = r & 15, cc = c & 31, ob = rr * 64 + cc * 2; return st * 1024 + (ob ^ (((ob >> 9) & 1) << 5)); }
DI void stage_rc(int b, int& R, int& C) { const int st = b / 1024, sb = b % 1024, swz = sb ^ (((sb >> 9) & 1) << 5); R = (st >> 1) * 16 + swz / 64; C = (st & 1) * 32 + (swz % 64) / 2; }
DI int perm32(int rho) { const int n = rho >> 4, i = rho & 15; return 8 * (i >> 2) + 4 * n + (i & 3); }
struct Unit { int pm, pn; };
struct Gemm { const bf16_t* A; const bf16_t* Bt; int M, N, K; };
struct StaticOrder {
    int nM, nN, nwg, G, c;
    DI void init(int M, int N, int G_, int c_) { nM = M / BM; nN = N / BM; nwg = nM * nN; G = G_; c = c_; }
    DI bool next(int i, Unit& u) const {
        const long L = (long)i * G + c; if (L >= nwg) return false;
        int wgid = (int)L; { const int q = nwg / NXCD, r = nwg % NXCD, xcd = wgid % NXCD, off = wgid / NXCD; wgid = (xcd < r ? xcd * (q + 1) : r * (q + 1) + (xcd - r) * q) + off; }
        const int nig = WGM * nN, gid = wgid / nig, fm = gid * WGM, gsz = (nM - fm) < WGM ? (nM - fm) : WGM;
        u.pm = fm + ((wgid % nig) % gsz); u.pn = (wgid % nig) / gsz; return true;
    }
};

template <class Epi>
DI void gemm_phase(LAS unsigned char* lds, const Gemm g, const StaticOrder& S, const Epi& E) {
    const int tid = otid(), wid = __builtin_amdgcn_readfirstlane(tid >> 6), lane = tid & 63, wr = wid >> 2, wc = wid & 3, fr = lane & 15, fq = lane >> 4;
    const int K = g.K, nt = K / BK;
    unsigned voffA[2], voffB[2];
#pragma unroll
    for (int i = 0; i < 2; ++i) { int R, C; stage_rc(tid * 16 + i * 8192, R, C); const int Rb = Epi::PERM ? ((R & ~31) + perm32(R & 31)) : R;
        voffA[i] = (unsigned)(R * K + C) * 2u; voffB[i] = (unsigned)(Rb * K + C) * 2u; }
    const size_t kstep = (size_t)(BK * 2);
    const size_t hstep = (size_t)HALF * K * 2;
    const size_t tstep = 2 * hstep;
    const unsigned ldsw = (unsigned)wid * 1024u;
    const int aoff = lds_byte(wr * 64 + fr, fq * 8), boff = lds_byte(wc * 32 + fr, fq * 8);
#define PG8_SA(b, h) (((b) * 2 + (h)) * HTB)
#define PG8_SB(b, h) ((4 + (b) * 2 + (h)) * HTB)
#define PG8_STAGE(bufoff, gbase, voff) do { _Pragma("unroll") for (int _i = 0; _i < 2; ++_i) \
        __builtin_amdgcn_global_load_lds((const unsigned*)((const char*)(gbase) + (voff)[_i]), (LAS unsigned*)(lds + (bufoff) + ldsw + _i * 8192), 16, 0, 0); } while (0)
#define PG8_LDA(dst, b, h) do { _Pragma("unroll") for (int m = 0; m < 4; ++m) _Pragma("unroll") for (int k = 0; k < 2; ++k) dst[m][k] = *(const LAS bf16x8*)(lds + PG8_SA(b, h) + aoff + m * 2048 + k * 1024); } while (0)
#define PG8_LDB(dst, b, h) do { _Pragma("unroll") for (int n = 0; n < 2; ++n) _Pragma("unroll") for (int k = 0; k < 2; ++k) dst[n][k] = *(const LAS bf16x8*)(lds + PG8_SB(b, h) + boff + n * 2048 + k * 1024); } while (0)
#define PG8_MMA(ai, bj, At, Bt) do { __builtin_amdgcn_s_setprio(1); _Pragma("unroll") for (int m = 0; m < 4; ++m) _Pragma("unroll") for (int n = 0; n < 2; ++n) _Pragma("unroll") for (int k = 0; k < 2; ++k) \
        acc[ai][bj][m][n] = __builtin_amdgcn_mfma_f32_16x16x32_bf16(Bt[n][k], At[m][k], acc[ai][bj][m][n], 0, 0, 0); __builtin_amdgcn_s_setprio(0); } while (0)
#define PG8_WAIT_V(n) asm volatile("s_waitcnt vmcnt(" #n ")" ::: "memory")
#define PG8_WAIT_L(n) asm volatile("s_waitcnt lgkmcnt(" #n ")" ::: "memory")
#define PG8_BAR __builtin_amdgcn_s_barrier()
#define PG8_SCHED __builtin_amdgcn_sched_barrier(0)
    Unit cur, nxt; int ui = 0;
    if (!S.next(0, cur)) return;
    f32x4 acc[2][2][4][2];
#pragma unroll
    for (int a = 0; a < 2; ++a)
#pragma unroll
        for (int b = 0; b < 2; ++b)
#pragma unroll
            for (int m = 0; m < 4; ++m)
#pragma unroll
                for (int n = 0; n < 2; ++n) acc[a][b][m][n] = (f32x4){0.f, 0.f, 0.f, 0.f};
    bf16x8 At[4][2], B0[2][2], B1[2][2];
    const char* cA = (const char*)g.A + (size_t)cur.pm * tstep; const char* cB = (const char*)g.Bt + (size_t)cur.pn * tstep;
    PG8_STAGE(PG8_SB(0, 0), cB, voffB); PG8_STAGE(PG8_SA(0, 0), cA, voffA); PG8_STAGE(PG8_SB(0, 1), cB + hstep, voffB); PG8_STAGE(PG8_SA(0, 1), cA + hstep, voffA);
    if (wr == 1) PG8_BAR;
    PG8_WAIT_V(4); PG8_BAR;
    PG8_STAGE(PG8_SB(1, 0), cB + kstep, voffB); PG8_STAGE(PG8_SA(1, 0), cA + kstep, voffA); PG8_STAGE(PG8_SB(1, 1), cB + hstep + kstep, voffB);
    PG8_WAIT_V(6); PG8_BAR;
    for (;;) {
        const bool has_next = S.next(ui + 1, nxt);
        const char* nA = has_next ? (const char*)g.A + (size_t)nxt.pm * tstep : cA; const char* nB = has_next ? (const char*)g.Bt + (size_t)nxt.pn * tstep : cB;
        for (int t = 0; t < nt; t += 2) {
            const bool last = (t == nt - 2);
            const char* a1 = cA + (size_t)(t + 1) * kstep;
            const char* a2 = last ? nA : cA + (size_t)(t + 2) * kstep; const char* b2 = last ? nB : cB + (size_t)(t + 2) * kstep;
            const char* a3 = a2 + kstep; const char* b3 = b2 + kstep;
            PG8_LDB(B0, 0, 0); PG8_SCHED; PG8_LDA(At, 0, 0); PG8_STAGE(PG8_SA(1, 1), a1 + hstep, voffA);
            PG8_WAIT_L(8); PG8_BAR; PG8_WAIT_L(0); PG8_MMA(0, 0, At, B0); PG8_BAR; PG8_SCHED;
            PG8_LDB(B1, 0, 1); PG8_STAGE(PG8_SB(0, 0), b2, voffB);
            PG8_BAR; PG8_WAIT_L(0); PG8_MMA(0, 1, At, B1); PG8_BAR;
            PG8_LDA(At, 0, 1); PG8_STAGE(PG8_SA(0, 0), a2, voffA);
            PG8_BAR; PG8_WAIT_L(0); PG8_MMA(1, 0, At, B0); PG8_BAR; PG8_SCHED;
            PG8_STAGE(PG8_SB(0, 1), b2 + hstep, voffB);
            PG8_WAIT_V(6); PG8_BAR; PG8_MMA(1, 1, At, B1); PG8_BAR;
            PG8_LDB(B0, 1, 0); PG8_SCHED; PG8_LDA(At, 1, 0); PG8_STAGE(PG8_SA(0, 1), a2 + hstep, voffA);
            PG8_WAIT_L(8); PG8_BAR; PG8_WAIT_L(0); PG8_MMA(0, 0, At, B0); PG8_BAR; PG8_SCHED;
            PG8_LDB(B1, 1, 1); PG8_STAGE(PG8_SB(1, 0), b3, voffB);
            PG8_BAR; PG8_WAIT_L(0); PG8_MMA(0, 1, At, B1); PG8_BAR;
            PG8_LDA(At, 1, 1); PG8_STAGE(PG8_SA(1, 0), a3, voffA);
            PG8_BAR; PG8_WAIT_L(0); PG8_MMA(1, 0, At, B0); PG8_BAR; PG8_SCHED;
            PG8_STAGE(PG8_SB(1, 1), b3 + hstep, voffB);
            PG8_WAIT_V(6); PG8_BAR; PG8_MMA(1, 1, At, B1); PG8_BAR;
        }
        E(acc, cur, wr, wc, fr, fq);
        if (!has_next) break;
#pragma unroll
        for (int a = 0; a < 2; ++a)
#pragma unroll
            for (int b = 0; b < 2; ++b)
#pragma unroll
                for (int m = 0; m < 4; ++m)
#pragma unroll
                    for (int n = 0; n < 2; ++n) acc[a][b][m][n] = (f32x4){0.f, 0.f, 0.f, 0.f};
        cur = nxt; cA = nA; cB = nB; ++ui;
    }
    PG8_WAIT_V(0);
    if (wr == 0) PG8_BAR;
    PG8_BAR;
#undef PG8_SA
#undef PG8_SB
#undef PG8_STAGE
#undef PG8_LDA
#undef PG8_LDB
#undef PG8_MMA
#undef PG8_WAIT_V
#undef PG8_WAIT_L
#undef PG8_BAR
#undef PG8_SCHED
}
}

struct EpiStoreBf16 {
    static constexpr bool PERM = true;
    bf16_t* O; int ldc; const float* ss; float* DT;
    DI void operator()(const f32x4 (&acc)[2][2][4][2], const pg8::Unit& u, int wr, int wc, int fr, int fq) const {
        const int row0 = u.pm * 256 + wr * 64 + fr, col0 = u.pn * 256 + wc * 32 + 8 * fq;
        if (u.pn * 256 >= ldc) {
            if (wc == 0 && fq < 2) {
#pragma unroll
                for (int ai = 0; ai < 2; ++ai)
#pragma unroll
                    for (int m = 0; m < 4; ++m) { const int row = row0 + ai * 128 + m * 16;
                        if (row < MV) { *(f32x4*)(DT + (size_t)row * 16 + 8 * fq) = acc[ai][0][m][0]; *(f32x4*)(DT + (size_t)row * 16 + 8 * fq + 4) = acc[ai][0][m][1]; } }
            }
            return;
        }
#pragma unroll
        for (int ai = 0; ai < 2; ++ai)
#pragma unroll
            for (int m = 0; m < 4; ++m) {
                const int row = row0 + ai * 128 + m * 16;
                if (row < MV) {
                    const float sc = ss ? rsqrtf(ss[row] * (1.f / 1024.f) + EPSF) : 1.f;
                    bf16_t* rp = O + (size_t)row * ldc + col0;
#pragma unroll
                    for (int bj = 0; bj < 2; ++bj) {
                        const f32x4 v0 = acc[ai][bj][m][0] * sc, v1 = acc[ai][bj][m][1] * sc;
                        uint4 w; w.x = pack2(v0[0], v0[1]); w.y = pack2(v0[2], v0[3]); w.z = pack2(v1[0], v1[1]); w.w = pack2(v1[2], v1[3]);
                        *(uint4*)(rp + bj * 128) = w;
                    }
                }
            }
    }
};
struct EpiResid {
    static constexpr bool PERM = false;
    const float* rp_prompt; const float* rp_sample;
    float* H; bf16_t* HB;
    DI void operator()(const f32x4 (&acc)[2][2][4][2], const pg8::Unit& u, int wr, int wc, int fr, int fq) const {
        const int row0 = u.pm * 256 + wr * 64 + fr, col0 = u.pn * 256 + wc * 32 + 4 * fq;
#pragma unroll
        for (int ai = 0; ai < 2; ++ai)
#pragma unroll
            for (int m = 0; m < 4; ++m) {
                const int row = row0 + ai * 128 + m * 16;
                if (row < MV) {
                    const float* rs = (row < MP ? rp_prompt + (size_t)row * 1024 : rp_sample + (size_t)(row - MP) * 1024) + col0;
                    float* hp = H + (size_t)row * 1024 + col0; bf16_t* bp = HB + (size_t)row * 1024 + col0;
#pragma unroll
                    for (int bj = 0; bj < 2; ++bj)
#pragma unroll
                        for (int n = 0; n < 2; ++n) {
                            const int co = bj * 128 + n * 16;
                            const f32x4 v = acc[ai][bj][m][n] + *(const f32x4*)(rs + co);
                            *(f32x4*)(hp + co) = v; *(uint2*)(bp + co) = pack4(v[0], v[1], v[2], v[3]);
                        }
                }
            }
    }
};
struct EpiGate {
    static constexpr bool PERM = false;
    float* Gt;
    DI void operator()(const f32x4 (&acc)[2][2][4][2], const pg8::Unit& u, int wr, int wc, int fr, int fq) const {
        const int row0 = u.pm * 256 + wr * 64 + fr, col0 = u.pn * 256 + wc * 32 + 4 * fq;
#pragma unroll
        for (int ai = 0; ai < 2; ++ai)
#pragma unroll
            for (int m = 0; m < 4; ++m) {
                const int row = row0 + ai * 128 + m * 16;
                if (row < MV) {
                    float* gp = Gt + (size_t)row * 1024 + col0;
#pragma unroll
                    for (int bj = 0; bj < 2; ++bj)
#pragma unroll
                        for (int n = 0; n < 2; ++n) {
                            const f32x4 a = acc[ai][bj][m][n];
                            *(f32x4*)(gp + bj * 128 + n * 16) = (f32x4){sigm(a[0]), sigm(a[1]), sigm(a[2]), sigm(a[3])};
                        }
                }
            }
    }
};
struct EpiPle {
    static constexpr bool PERM = false;
    float* H; const float* Gt; bf16_t* XN; const float* nw; float* SS;
    DI void operator()(const f32x4 (&acc)[2][2][4][2], const pg8::Unit& u, int wr, int wc, int fr, int fq) const {
        const int row0 = u.pm * 256 + wr * 64 + fr, col0 = u.pn * 256 + wc * 32 + 4 * fq;
#pragma unroll
        for (int ai = 0; ai < 2; ++ai)
#pragma unroll
            for (int m = 0; m < 4; ++m) {
                const int row = row0 + ai * 128 + m * 16;
                float ssum = 0.f;
                if (row < MV) {
                    float* hp = H + (size_t)row * 1024 + col0; const float* gp = Gt + (size_t)row * 1024 + col0;
#pragma unroll
                    for (int bj = 0; bj < 2; ++bj)
#pragma unroll
                        for (int n = 0; n < 2; ++n) {
                            const int co = bj * 128 + n * 16;
                            const f32x4 v = *(const f32x4*)(hp + co) + *(const f32x4*)(gp + co) * acc[ai][bj][m][n];
                            *(f32x4*)(hp + co) = v;
                            ssum += v[0] * v[0] + v[1] * v[1] + v[2] * v[2] + v[3] * v[3];
                            if (XN) { const f32x4 w = *(const f32x4*)(nw + col0 + co); *(uint2*)(XN + (size_t)row * 1024 + col0 + co) = pack4(v[0] * w[0], v[1] * w[1], v[2] * w[2], v[3] * w[3]); }
                        }
                }
                ssum += __shfl_xor(ssum, 16); ssum += __shfl_xor(ssum, 32);
                if (fq == 0 && row < MV) atomicAdd(SS + row, ssum);
            }
    }
};

DI void transpose_tile_w(const float* src, int lds_, bf16_t* dst, int ldd, int k0, int n0, int nvalid, float* tile, int lane) {
    const float* sp = src + (size_t)k0 * lds_ + n0 + lane;
#pragma unroll
    for (int bt = 0; bt < 4; ++bt) {
        float v[16];
#pragma unroll
        for (int r = 0; r < 16; ++r) v[r] = (lane < nvalid) ? sp[(size_t)(bt * 16 + r) * lds_] : 0.f;
#pragma unroll
        for (int r = 0; r < 16; ++r) tile[(bt * 16 + r) * 65 + lane] = v[r];
    }
    const int koct = lane & 7;
#pragma unroll
    for (int p = 0; p < 8; ++p) {
        const int nn = (lane >> 3) + 8 * p;
        const float* tp = tile + (koct * 8) * 65 + nn;
        uint4 w;
        w.x = pack2(tp[0], tp[65]); w.y = pack2(tp[2 * 65], tp[3 * 65]); w.z = pack2(tp[4 * 65], tp[5 * 65]); w.w = pack2(tp[6 * 65], tp[7 * 65]);
        *(uint4*)(dst + (size_t)(n0 + nn) * ldd + k0 + koct * 8) = w;
    }
}
DI void transpose_job(const float* src, int lds_, bf16_t* dst, int ldd, int K, int N, int nvalid_last, int& base, float* tile, int gw, int nwv, int lane) {
    const int ntn = (N + 63) / 64, nt = (K / 64) * ntn;
    const int first = (gw - (base % nwv) + nwv) % nwv;
    for (int t = first; t < nt; t += nwv) { const int tn = t % ntn; transpose_tile_w(src, lds_, dst, ldd, (t / ntn) * 64, tn * 64, (tn == ntn - 1) ? nvalid_last : 64, tile, lane); }
    base += nt;
}
DI void phase_prep(const Params& P, unsigned char* L) {
    const int tid = otid(), lane = tid & 63, wid = tid >> 6;
    const int gw = blockIdx.x * 8 + wid, nwv = gridDim.x * 8;
    { float* z = WSP(float, OFF_SS1); const int n = (int)((OFF_DT - OFF_SS1) / 4);
      for (int i = blockIdx.x * 512 + tid; i < n; i += gridDim.x * 512) z[i] = 0.f;
      if (blockIdx.x == 0 && tid < 64) WSP(unsigned, OFF_CTL)[tid] = 0u; }
    { float* tile = (float*)L + wid * (64 * 65); int base = 0;
      transpose_job(P.in[26], INC, WSP(bf16_t, OFF_W1T), 1024, 1024, INC, 64, base, tile, gw, nwv, lane);
      transpose_job(P.in[11], INAB, WSP(bf16_t, OFF_W0T), 1024, 1024, N0, 64, base, tile, gw, nwv, lane);
      transpose_job(P.in[11] + N0, INAB, WSP(bf16_t, OFF_W0T) + (size_t)N0 * 1024, 1024, 1024, 16, 16, base, tile, gw, nwv, lane);
      transpose_job(P.in[25], 1024, WSP(bf16_t, OFF_WO0T), 2048, 2048, 1024, 64, base, tile, gw, nwv, lane);
      transpose_job(P.in[31], 1024, WSP(bf16_t, OFF_WG0T), 1024, 1024, 1024, 64, base, tile, gw, nwv, lane);
      transpose_job(P.in[30], 1024, WSP(bf16_t, OFF_WP0T), 256, 256, 1024, 64, base, tile, gw, nwv, lane);
      transpose_job(P.in[29], 1024, WSP(bf16_t, OFF_WO1T), 2048, 2048, 1024, 64, base, tile, gw, nwv, lane);
      transpose_job(P.in[31] + 1024 * 1024, 1024, WSP(bf16_t, OFF_WG1T), 1024, 1024, 1024, 64, base, tile, gw, nwv, lane);
      transpose_job(P.in[30] + 256 * 1024, 1024, WSP(bf16_t, OFF_WP1T), 256, 256, 1024, 64, base, tile, gw, nwv, lane);
      transpose_job(P.in[14], 128, WSP(bf16_t, OFF_WRT), 1024, 1024, 128, 64, base, tile, gw, nwv, lane);
      transpose_job(P.in[16], 128, WSP(bf16_t, OFF_WIT), 1024, 1024, 128, 64, base, tile, gw, nwv, lane); }
    { const float* nwp = P.in[9]; bf16_t* XN = WSP(bf16_t, OFF_XN);
      f32x4 w4[4];
#pragma unroll
      for (int i = 0; i < 4; ++i) w4[i] = *(const f32x4*)(nwp + lane * 4 + 256 * i);
      for (int r0 = gw * 2; r0 < MV; r0 += nwv * 2) {
          f32x4 x[2][4];
#pragma unroll
          for (int q = 0; q < 2; ++q) { const int r = r0 + q; const float* src = r < MP ? P.in[0] + (size_t)r * 1024 : P.in[1] + (size_t)(r - MP) * 1024;
#pragma unroll
              for (int i = 0; i < 4; ++i) x[q][i] = *(const f32x4*)(src + lane * 4 + 256 * i); }
#pragma unroll
          for (int q = 0; q < 2; ++q) {
              float ss = 0.f;
#pragma unroll
              for (int i = 0; i < 4; ++i) ss += x[q][i][0] * x[q][i][0] + x[q][i][1] * x[q][i][1] + x[q][i][2] * x[q][i][2] + x[q][i][3] * x[q][i][3];
              ss = wave_sum(ss); const float rstd = rsqrtf(ss * (1.f / 1024.f) + EPSF);
#pragma unroll
              for (int i = 0; i < 4; ++i) { const f32x4 v = x[q][i] * rstd * w4[i]; *(uint2*)(XN + (size_t)(r0 + q) * 1024 + lane * 4 + 256 * i) = pack4(v[0], v[1], v[2], v[3]); }
          }
      } }
}
DI void convert_p(const Params& P, int layer) {
    bf16_t* PB = WSP(bf16_t, OFF_PB);
    const float* pp = P.in[2] + (size_t)layer * MP * 256; const float* ps = P.in[3] + (size_t)layer * MS * 256;
    for (int i = blockIdx.x * 512 + threadIdx.x; i < MV * 64; i += gridDim.x * 512) {
        const int row = i >> 6, c4 = (i & 63) * 4;
        const f32x4 v = *(const f32x4*)((row < MP ? pp + (size_t)row * 256 : ps + (size_t)(row - MP) * 256) + c4);
        *(uint2*)(PB + (size_t)row * 256 + c4) = pack4(v[0], v[1], v[2], v[3]);
    }
}

DI void ssd_prompt_item(const Params& P, unsigned char* L, int item) {
    const int b = item >> 4, h = item & 15, g = h >> 3;
    const int tid = otid(), lane = tid & 63, wid = tid >> 6, hh = lane >> 5, l31 = lane & 31;
    bf16_t* Cs = (bf16_t*)L;
    bf16_t* Bs = Cs + 128 * 136;
    bf16_t* BwT = Bs + 128 * 136;
    bf16_t* XsT = BwT + 128 * 136;
    bf16_t* St = XsT + 64 * 136;
    float* dtv = (float*)(St + 64 * 136); float* acs = dtv + 128; float* wv = acs + 128; float* tot = wv + 128;
    const bf16_t* U = WSP(bf16_t, OFF_U); const float* DT = WSP(float, OFF_DT); bf16_t* MIX = WSP(bf16_t, OFF_MIX); float* SSB = WSP(float, OFF_SSB);
    const float a_neg = -__expf(P.in[22][h]), dtb = P.in[21][h], Dh = P.in[23][h];
    f32x16 accS;
#pragma unroll
    for (int i = 0; i < 16; ++i) accS[i] = 0.f;
    __syncthreads();
    for (int i = tid; i < 64 * 136; i += 512) St[i] = 0;
    const int cq = tid % 80, cseg = tid / 80;
    const int ct0 = cseg * 22, ctn = (cseg < 5) ? 22 : 18;
    int cch = 0;
    if (cq < 16) cch = h * 64 + cq * 4; else if (cq < 48) cch = 1024 + g * 128 + (cq - 16) * 4; else cch = 1280 + g * 128 + (cq - 48) * 4;
    float cw[4][4], cbias[4];
    if (tid < 480) {
#pragma unroll
        for (int kk = 0; kk < 4; ++kk)
#pragma unroll
            for (int e = 0; e < 4; ++e) cw[kk][e] = P.in[19][kk * 1536 + cch + e];
#pragma unroll
        for (int e = 0; e < 4; ++e) cbias[e] = P.in[20][cch + e];
    }
    uint2 raw[25]; float dtraw = 0.f;
#define SSD_LOAD(cc) do { if (tid < 480) { const unsigned voff_ = (unsigned)((b * 2048 + (cc) * 128 + ct0) * N0 + 3072 + cch); \
        _Pragma("unroll") for (int j = 0; j < 25; ++j) { const int t = ct0 - 3 + j; \
            raw[j] = (j < ctn + 3 && (cc) * 128 + t >= 0) ? *(const uint2*)((U + (j - 3) * N0) + voff_) : make_uint2(0u, 0u); } } } while (0)
    if (tid < 128) dtraw = DT[(size_t)(b * 2048 + tid) * 16 + h];
    for (int c = 0; c < 16; ++c) {
        const int row0 = b * 2048 + c * 128;
        __syncthreads();
        const float dtcur = dtraw;
        if (tid < 128 && c + 1 < 16) dtraw = DT[(size_t)(row0 + 128 + tid) * 16 + h];
        SSD_LOAD(c);
        if (tid < 128) {
            const float d = softplus(dtcur + dtb);
            float v = d * a_neg;
#pragma unroll
            for (int o = 1; o < 64; o <<= 1) { const float n = __shfl_up(v, o); if (lane >= o) v += n; }
            dtv[tid] = d; acs[tid] = v; if (tid == 63) tot[0] = v;
        }
        __syncthreads();
        if (tid >= 64 && tid < 128) acs[tid] += tot[0];
        __syncthreads();
        const float a_last = acs[127];
        if (tid < 128) wv[tid] = __expf(a_last - acs[tid]) * dtv[tid];
        __syncthreads();
        if (tid < 480) {
            LAS bf16_t* xb = (LAS bf16_t*)XsT + (cq * 4) * 136 + ct0;
            LAS bf16_t* bb = (LAS bf16_t*)Bs + ct0 * 136 + (cq - 16) * 4;
            LAS bf16_t* bt = (LAS bf16_t*)BwT + ((cq - 16) * 4) * 136 + ct0;
            LAS bf16_t* cb = (LAS bf16_t*)Cs + ct0 * 136 + (cq - 48) * 4;
            LAS const float* wvp = (LAS const float*)wv + ct0;
            asm volatile("" : "+v"(xb), "+v"(bb), "+v"(bt), "+v"(cb), "+v"(wvp));
#pragma unroll
            for (int j = 0; j < 22; ++j) {
                if (j < ctn) {
                    const float x0[4] = {bflo(raw[j].x), bfhi(raw[j].x), bflo(raw[j].y), bfhi(raw[j].y)};
                    const float x1[4] = {bflo(raw[j + 1].x), bfhi(raw[j + 1].x), bflo(raw[j + 1].y), bfhi(raw[j + 1].y)};
                    const float x2[4] = {bflo(raw[j + 2].x), bfhi(raw[j + 2].x), bflo(raw[j + 2].y), bfhi(raw[j + 2].y)};
                    const float x3[4] = {bflo(raw[j + 3].x), bfhi(raw[j + 3].x), bflo(raw[j + 3].y), bfhi(raw[j + 3].y)};
                    float y[4];
#pragma unroll
                    for (int e = 0; e < 4; ++e) y[e] = silu(cbias[e] + cw[0][e] * x0[e] + cw[1][e] * x1[e] + cw[2][e] * x2[e] + cw[3][e] * x3[e]);
                    if (cq < 16) {
#pragma unroll
                        for (int e = 0; e < 4; ++e) xb[e * 136 + j] = f2bf(y[e]);
                    } else if (cq < 48) {
                        const float w = wvp[j];
                        *(LAS u32x2*)(bb + j * 136) = pack4v(y[0], y[1], y[2], y[3]);
#pragma unroll
                        for (int e = 0; e < 4; ++e) bt[e * 136 + j] = f2bf(y[e] * w);
                    } else {
                        *(LAS u32x2*)(cb + j * 136) = pack4v(y[0], y[1], y[2], y[3]);
                    }
                }
            }
        }
        bf16_t zr[16];
        {
            const unsigned zoff = (unsigned)((row0 + (wid >> 1) * 32 + 4 * hh) * N0 + 2048 + h * 64 + (wid & 1) * 32 + l31);
#pragma unroll
            for (int reg = 0; reg < 16; ++reg) zr[reg] = (U + ((reg & 3) + 8 * (reg >> 2)) * N0)[zoff];
        }
        __syncthreads();
        {
            const int rb = (wid >> 1) * 32, cb0 = (wid & 1) * 64;
            f32x16 cbA[2];
#pragma unroll
            for (int i = 0; i < 16; ++i) { cbA[0][i] = 0.f; cbA[1][i] = 0.f; }
#pragma unroll
            for (int ks = 0; ks < 8; ++ks) {
                const bf16x8 a = ldfrag(Cs, 136, rb, ks * 16, lane);
                cbA[0] = MFMA32(a, ldfrag(Bs, 136, cb0, ks * 16, lane), cbA[0]);
                cbA[1] = MFMA32(a, ldfrag(Bs, 136, cb0 + 32, ks * 16, lane), cbA[1]);
            }
            __syncthreads();
            bf16_t* Ws = Bs;
#pragma unroll
            for (int j = 0; j < 2; ++j) {
                const int s = cb0 + j * 32 + l31; const float as = acs[s], ds = dtv[s];
#pragma unroll
                for (int reg = 0; reg < 16; ++reg) {
                    const int t = rb + crow(reg, hh);
                    const float v = (s <= t) ? cbA[j][reg] * __expf(acs[t] - as) * ds : 0.f;
                    Ws[t * 136 + s] = f2bf(v);
                }
            }
        }
        __syncthreads();
        {
            const bf16_t* Ws = Bs;
            const int tb = (wid >> 1) * 32, pb = (wid & 1) * 32;
            f32x16 y;
#pragma unroll
            for (int i = 0; i < 16; ++i) y[i] = 0.f;
#pragma unroll
            for (int ks = 0; ks < 8; ++ks) y = MFMA32(ldfrag(Cs, 136, tb, ks * 16, lane), ldfrag(St, 136, pb, ks * 16, lane), y);
#pragma unroll
            for (int reg = 0; reg < 16; ++reg) y[reg] *= __expf(acs[tb + crow(reg, hh)]);
#pragma unroll
            for (int ks = 0; ks < 8; ++ks) y = MFMA32(ldfrag(Ws, 136, tb, ks * 16, lane), ldfrag(XsT, 136, pb, ks * 16, lane), y);
            const int p = pb + l31, ch = h * 64 + p; const float nwv = P.in[24][ch];
#pragma unroll
            for (int reg = 0; reg < 16; ++reg) {
                const int t = tb + crow(reg, hh); const size_t row = (size_t)(row0 + t);
                const float xv = bf2f(XsT[p * 136 + t]); const float z = bf2f(zr[reg]);
                const float yy = (y[reg] + Dh * xv) * silu(z);
                float ss = yy * yy;
                ss += __shfl_xor(ss, 1); ss += __shfl_xor(ss, 2); ss += __shfl_xor(ss, 4); ss += __shfl_xor(ss, 8); ss += __shfl_xor(ss, 16);
                if (l31 == 0) atomicAdd(SSB + row * 2 + g, ss);
                MIX[row * 2048 + 1024 + ch] = f2bf(yy * nwv);
            }
            const int pb2 = (wid >> 2) * 32, nb = (wid & 3) * 32;
            const float ea = __expf(a_last);
#pragma unroll
            for (int reg = 0; reg < 16; ++reg) accS[reg] *= ea;
#pragma unroll
            for (int ks = 0; ks < 8; ++ks) accS = MFMA32(ldfrag(XsT, 136, pb2, ks * 16, lane), ldfrag(BwT, 136, nb, ks * 16, lane), accS);
            __syncthreads();
#pragma unroll
            for (int reg = 0; reg < 16; ++reg) St[(pb2 + crow(reg, hh)) * 136 + nb + l31] = f2bf(accS[reg]);
        }
    }
    {
        const int pb2 = (wid >> 2) * 32, nb = (wid & 3) * 32;
        float* o = P.out + O_BSP + (size_t)(b * 16 + h) * 64 * 128;
#pragma unroll
        for (int reg = 0; reg < 16; ++reg) o[(pb2 + crow(reg, hh)) * 128 + nb + l31] = accS[reg];
    }
}
#undef SSD_LOAD
DI void ssd_sample_item(const Params& P, unsigned char* L, int item) {
    const int b = item >> 4, h = item & 15, g = h >> 3, tid = otid(), lane = tid & 63;
    float* xs = (float*)L; float* Bv = xs + 64; float* Cv = Bv + 128; float* yv = Cv + 128;
    const bf16_t* U = WSP(bf16_t, OFF_U); bf16_t* MIX = WSP(bf16_t, OFF_MIX); float* SSB = WSP(float, OFF_SSB);
    const size_t row = (size_t)(MP + b);
    __syncthreads();
    if (tid < 320) {
        int cc; if (tid < 64) cc = h * 64 + tid; else if (tid < 192) cc = 1024 + g * 128 + (tid - 64); else cc = 1280 + g * 128 + (tid - 192);
        const float* buf = P.in[7] + (size_t)b * 3 * 1536 + cc;
        const float v = P.in[20][cc] + P.in[19][cc] * buf[0] + P.in[19][1536 + cc] * buf[1536] + P.in[19][2 * 1536 + cc] * buf[2 * 1536] + P.in[19][3 * 1536 + cc] * bf2f(U[row * N0 + 3072 + cc]);
        xs[tid] = silu(v);
    }
    const float dt = softplus(WSP(float, OFF_DT)[row * 16 + h] + P.in[21][h]);
    const float dA = __expf(-dt * __expf(P.in[22][h]));
    __syncthreads();
    const float* s0 = P.in[6] + (size_t)(b * 16 + h) * 64 * 128; float* s1 = P.out + O_BSS + (size_t)(b * 16 + h) * 64 * 128;
    const int n4 = (tid & 31) * 4;
    const f32x4 Bq = *(const f32x4*)(Bv + n4), Cq = *(const f32x4*)(Cv + n4);
#pragma unroll
    for (int j = 0; j < 4; ++j) {
        const int p = (tid >> 5) + 16 * j;
        const f32x4 s = *(const f32x4*)(s0 + p * 128 + n4);
        const float dx = dt * xs[p];
        const f32x4 sn = s * dA + Bq * dx;
        *(f32x4*)(s1 + p * 128 + n4) = sn;
        float yp = sn[0] * Cq[0] + sn[1] * Cq[1] + sn[2] * Cq[2] + sn[3] * Cq[3];
        yp += __shfl_xor(yp, 1); yp += __shfl_xor(yp, 2); yp += __shfl_xor(yp, 4); yp += __shfl_xor(yp, 8); yp += __shfl_xor(yp, 16);
        if ((tid & 31) == 0) yv[p] = yp;
    }
    __syncthreads();
    if (tid < 64) {
        const int ch = h * 64 + tid;
        const float yy = (yv[tid] + P.in[23][h] * xs[tid]) * silu(bf2f(U[row * N0 + 2048 + ch]));
        const float ss = wave_sum(yy * yy);
        if (lane == 0) atomicAdd(SSB + row * 2 + g, ss);
        MIX[row * 2048 + 1024 + ch] = f2bf(yy * P.in[24][ch]);
    }
}
template <bool SAMPLE>
DI void rglru_item(const Params& P, unsigned char* L, int item) {
    const int tid = otid(), lane = tid & 63, wid = tid >> 6;
    const int b = SAMPLE ? 0 : (item >> 5), k = (item >> 2) & 7, dq = item & 3;
    bf16_t* Xs = (bf16_t*)L;
    bf16_t* Wg = Xs + 128 * 136;
    float* Xf = (float*)(Wg + 64 * 136);
    float* Aa = Xf + 128 * 32; float* Uu = Aa + 128 * 32; float* segA = Uu + 128 * 32; float* segH = segA + 512; float* hc = segH + 512;
    const bf16_t* U = WSP(bf16_t, OFF_U); bf16_t* MIX = WSP(bf16_t, OFF_MIX);
    __syncthreads();
    {
        const bf16_t* WRT = WSP(bf16_t, OFF_WRT); const bf16_t* WIT = WSP(bf16_t, OFF_WIT);
#pragma unroll
        for (int i = 0; i < 2; ++i) {
            const int chk = tid + i * 512, r = chk >> 4, c8 = (chk & 15) * 8;
            const bf16_t* src = (r < 32 ? WRT + (size_t)(dq * 32 + r) * 1024 : WIT + (size_t)(dq * 32 + r - 32) * 1024) + k * 128 + c8;
            *(uint4*)(Wg + r * 136 + c8) = *(const uint4*)src;
        }
        if (tid < 32) hc[tid] = 0.f;
    }
    float sp[2], br[2], bi[2];
#pragma unroll
    for (int ct = 0; ct < 2; ++ct) { const int chd = k * 128 + dq * 32 + ct * 16 + (lane & 15); sp[ct] = softplus(-P.in[18][chd]); br[ct] = P.in[15][chd]; bi[ct] = P.in[17][chd]; }
    const int quad = tid & 31, seg = tid >> 5, ch0 = k * 128 + quad * 4;
    float cw[4][4], cbias[4];
#pragma unroll
    for (int kk = 0; kk < 4; ++kk)
#pragma unroll
        for (int e = 0; e < 4; ++e) cw[kk][e] = P.in[12][kk * 1024 + ch0 + e];
#pragma unroll
    for (int e = 0; e < 4; ++e) cbias[e] = P.in[13][ch0 + e];
    const int sd = tid & 31, sch = k * 128 + dq * 32 + sd;
    const int ntiles = SAMPLE ? 1 : 16;
    for (int tile = 0; tile < ntiles; ++tile) {
        const int row0 = SAMPLE ? MP : b * 2048 + tile * 128;
        __syncthreads();
        if (SAMPLE) {
            for (int t = 0; t < 8; ++t) {
                const int bb = seg * 8 + t;
                const float* buf = P.in[5] + (size_t)bb * 3 * 1024 + ch0;
                const f32x4 p0 = *(const f32x4*)buf, p1 = *(const f32x4*)(buf + 1024), p2 = *(const f32x4*)(buf + 2048);
                float cur[4]; ld4bf(U + (size_t)(MP + bb) * N0 + ch0, cur);
                float y[4];
#pragma unroll
                for (int e = 0; e < 4; ++e) y[e] = cbias[e] + cw[0][e] * p0[e] + cw[1][e] * p1[e] + cw[2][e] * p2[e] + cw[3][e] * cur[e];
                *(uint2*)(Xs + bb * 136 + quad * 4) = pack4(y[0], y[1], y[2], y[3]);
                if ((quad >> 3) == dq) *(f32x4*)(Xf + bb * 32 + (quad & 7) * 4) = (f32x4){y[0], y[1], y[2], y[3]};
            }
        } else {
            float r0[4], r1[4], r2[4], cur[4];
            const int tl = seg * 8, tg = tile * 128 + tl;
            const bf16_t* up = U + (size_t)(row0 + tl) * N0 + ch0;
            if (tg >= 3) { ld4bf(up - 3 * N0, r0); ld4bf(up - 2 * N0, r1); ld4bf(up - N0, r2); }
            else {
#pragma unroll
                for (int e = 0; e < 4; ++e) { r0[e] = 0.f; r1[e] = 0.f; r2[e] = 0.f; } }
#pragma unroll
            for (int t = 0; t < 8; ++t) {
                ld4bf(up + (size_t)t * N0, cur);
                float y[4];
#pragma unroll
                for (int e = 0; e < 4; ++e) { y[e] = cbias[e] + cw[0][e] * r0[e] + cw[1][e] * r1[e] + cw[2][e] * r2[e] + cw[3][e] * cur[e]; r0[e] = r1[e]; r1[e] = r2[e]; r2[e] = cur[e]; }
                *(uint2*)(Xs + (tl + t) * 136 + quad * 4) = pack4(y[0], y[1], y[2], y[3]);
                if ((quad >> 3) == dq) *(f32x4*)(Xf + (tl + t) * 32 + (quad & 7) * 4) = (f32x4){y[0], y[1], y[2], y[3]};
            }
        }
        __syncthreads();
        {
            f32x4 acc[4];
#pragma unroll
            for (int i = 0; i < 4; ++i) acc[i] = (f32x4){0.f, 0.f, 0.f, 0.f};
#pragma unroll
            for (int ks = 0; ks < 4; ++ks) {
                const bf16x8 a = ldfrag16(Xs, 136, wid * 16, ks * 32, lane);
#pragma unroll
                for (int tl = 0; tl < 4; ++tl) acc[tl] = MFMA16(a, ldfrag16(Wg, 136, tl * 16, ks * 32, lane), acc[tl]);
            }
#pragma unroll
            for (int ct = 0; ct < 2; ++ct)
#pragma unroll
                for (int reg = 0; reg < 4; ++reg) {
                    const int t = wid * 16 + (lane >> 4) * 4 + reg, d = ct * 16 + (lane & 15);
                    const float r = sigm(acc[ct][reg] + br[ct]), gi = sigm(acc[2 + ct][reg] + bi[ct]);
                    const float la = -8.f * r * sp[ct];
                    const float a = __expf(la), uu = sqrtf(-expm1f(2.f * la)) * gi * Xf[t * 32 + d];
                    if (SAMPLE) {
                        const int chd = k * 128 + dq * 32 + d;
                        const float hn = a * P.in[4][(size_t)t * 1024 + chd] + uu;
                        P.out[O_AHS + (size_t)t * 1024 + chd] = hn;
                        const float gt = bf2f(U[(size_t)(MP + t) * N0 + 1024 + chd]);
                        MIX[(size_t)(MP + t) * 2048 + chd] = f2bf(hn * silu(gt));
                    } else { Aa[t * 32 + d] = a; Uu[t * 32 + d] = uu; }
                }
        }
        if (!SAMPLE) {
            __syncthreads();
            float av[8], uv[8], Ap = 1.f, Hp = 0.f;
#pragma unroll
            for (int t = 0; t < 8; ++t) { av[t] = Aa[(seg * 8 + t) * 32 + sd]; uv[t] = Uu[(seg * 8 + t) * 32 + sd]; Hp = av[t] * Hp + uv[t]; Ap *= av[t]; }
            segA[seg * 32 + sd] = Ap; segH[seg * 32 + sd] = Hp;
            __syncthreads();
            float hin = hc[sd];
            for (int s = 0; s < seg; ++s) hin = segA[s * 32 + sd] * hin + segH[s * 32 + sd];
#pragma unroll
            for (int t = 0; t < 8; ++t) {
                hin = av[t] * hin + uv[t];
                const size_t row = (size_t)(row0 + seg * 8 + t);
                const float gt = bf2f(U[row * N0 + 1024 + sch]);
                MIX[row * 2048 + sch] = f2bf(hin * silu(gt));
            }
            __syncthreads();
            if (seg == 15) hc[sd] = hin;
        }
    }
    if (!SAMPLE) { __syncthreads(); if (tid < 32) P.out[O_AHP + (size_t)b * 1024 + k * 128 + dq * 32 + tid] = hc[tid]; }
}
DI void phase_mix0(const Params& P, unsigned char* L) {
    const int tid = otid(), bid = blockIdx.x, G = gridDim.x;
    { const bf16_t* U = WSP(bf16_t, OFF_U);
      for (int i = bid * 512 + tid; i < 8 * 3 * 1024; i += G * 512) { const int c = i & 1023, j = (i >> 10) % 3, b = i / 3072; P.out[O_ACP + i] = bf2f(U[(size_t)(b * 2048 + 2045 + j) * N0 + c]); }
      for (int i = bid * 512 + tid; i < 8 * 3 * 1536; i += G * 512) { const int c = i % 1536, j = (i / 1536) % 3, b = i / 4608; P.out[O_BCP + i] = bf2f(U[(size_t)(b * 2048 + 2045 + j) * N0 + 3072 + c]); }
      for (int i = bid * 512 + tid; i < 128 * 3 * 1024; i += G * 512) { const int c = i & 1023, j = (i >> 10) % 3, b = i / 3072; P.out[O_ACS + i] = j < 2 ? P.in[5][(size_t)(b * 3 + j + 1) * 1024 + c] : bf2f(U[(size_t)(MP + b) * N0 + c]); }
      for (int i = bid * 512 + tid; i < 128 * 3 * 1536; i += G * 512) { const int c = i % 1536, j = (i / 1536) % 3, b = i / 4608; P.out[O_BCS + i] = j < 2 ? P.in[7][(size_t)(b * 3 + j + 1) * 1536 + c] : bf2f(U[(size_t)(MP + b) * N0 + 3072 + c]); } }
    unsigned* ctr = WSP(unsigned, OFF_CTL);
    unsigned* bc = (unsigned*)(L + LDS_BYTES - 16);
    for (;;) {
        __syncthreads();
        if (tid == 0) bc[0] = atomicAdd(ctr, 1u);
        __syncthreads();
        const unsigned it = bc[0];
        if (it >= 128u + 256u + 32u + 2048u) break;
#ifndef MIXSEL
#define MIXSEL 15
#endif
        if (it < 128u) { if (MIXSEL & 1) ssd_prompt_item(P, L, (int)it); }
        else if (it < 384u) { if (MIXSEL & 2) rglru_item<false>(P, L, (int)(it - 128u)); }
        else if (it < 416u) { if (MIXSEL & 4) rglru_item<true>(P, L, (int)(it - 384u)); }
        else { if (MIXSEL & 8) ssd_sample_item(P, L, (int)(it - 416u)); }
    }
}
DI void phase_norm0(const Params& P) {
    bf16_t* MIX = WSP(bf16_t, OFF_MIX); const float* SSB = WSP(float, OFF_SSB);
    for (int i = blockIdx.x * 512 + threadIdx.x; i < MV * 128; i += gridDim.x * 512) {
        const int row = i >> 7, c8 = (i & 127) * 8, g = c8 >> 9;
        const float sc = rsqrtf(SSB[(size_t)row * 2 + g] * (1.f / 512.f) + EPSF);
        uint4* p = (uint4*)(MIX + (size_t)row * 2048 + 1024 + c8); uint4 w = *p;
        w.x = pack2(bflo(w.x) * sc, bfhi(w.x) * sc); w.y = pack2(bflo(w.y) * sc, bfhi(w.y) * sc); w.z = pack2(bflo(w.z) * sc, bfhi(w.z) * sc); w.w = pack2(bflo(w.w) * sc, bfhi(w.w) * sc);
        *p = w;
    }
}

DI void hgrn_prompt_item(const Params& P, unsigned char* L, int item) {
    const int b = item >> 4, h = item & 15;
    const int tid = otid(), lane = tid & 63, wid = tid >> 6, hh = lane >> 5, l31 = lane & 31;
    bf16_t* Qs = (bf16_t*)L;
    bf16_t* Ks = Qs + 64 * 136;
    float* Of = (float*)L;
    bf16_t* KsT = Ks + 64 * 136;
    bf16_t* VsT = KsT + 128 * 72;
    bf16_t* SsT = VsT + 128 * 72;
    bf16_t* As = SsT + 128 * 136;
    float* Gseg = (float*)(As + 64 * 72);
    float* E1 = Gseg + 16 * 128; float* E2 = E1 + 128;
    const bf16_t* U = WSP(bf16_t, OFF_U); bf16_t* MIX = WSP(bf16_t, OFF_MIX);
    const int kq = tid & 31, ts = tid >> 5;
    float lb[4];
#pragma unroll
    for (int e = 0; e < 4; ++e) { const int ch = h * 128 + kq * 4 + e; lb[e] = sigm(P.in[27][2048 + ch] - P.in[27][ch]); }
    const int kb = (wid >> 1) * 32, vb0 = (wid & 1) * 64;
    f32x16 accS[2];
#pragma unroll
    for (int i = 0; i < 16; ++i) { accS[0][i] = 0.f; accS[1][i] = 0.f; }
    uint2 rq[4], rf[4], rv[4];
#define HG_LOAD(cc) do { _Pragma("unroll") for (int i = 0; i < 4; ++i) { const bf16_t* bp = U + (size_t)(b * 2048 + (cc) * 64 + ts * 4 + i) * INC + h * 128 + kq * 4; \
        rq[i] = *(const uint2*)bp; rf[i] = *(const uint2*)(bp + 2048); rv[i] = *(const uint2*)(bp + 4096); } } while (0)
    HG_LOAD(0);
    __syncthreads();
    for (int c = 0; c < 32; ++c) {
        float kk[4][4], cs[4][4];
#pragma unroll
        for (int i = 0; i < 4; ++i) {
            const float fx[4] = {bflo(rf[i].x), bfhi(rf[i].x), bflo(rf[i].y), bfhi(rf[i].y)};
#pragma unroll
            for (int e = 0; e < 4; ++e) {
                const float sg = sigm(fx[e]); const float kv = (1.f - lb[e]) * (1.f - sg);
                kk[i][e] = kv; const float gl = __logf(1.f - kv);
                cs[i][e] = (i == 0 ? 0.f : cs[i - 1][e]) + gl;
            }
        }
        *(f32x4*)(Gseg + ts * 128 + kq * 4) = (f32x4){cs[3][0], cs[3][1], cs[3][2], cs[3][3]};
        __syncthreads();
        f32x4 off = {0.f, 0.f, 0.f, 0.f}, gmid = off, glast = off;
#pragma unroll
        for (int s = 0; s < 16; ++s) { const f32x4 v = *(const f32x4*)(Gseg + s * 128 + kq * 4); if (s < ts) off += v; if (s < 8) gmid += v; glast += v; }
        {
            float qt[4][4], kt[4][4], vt[4][4];
#pragma unroll
            for (int i = 0; i < 4; ++i) {
                const float q[4] = {bflo(rq[i].x), bfhi(rq[i].x), bflo(rq[i].y), bfhi(rq[i].y)};
                vt[i][0] = bflo(rv[i].x); vt[i][1] = bfhi(rv[i].x); vt[i][2] = bflo(rv[i].y); vt[i][3] = bfhi(rv[i].y);
#pragma unroll
                for (int e = 0; e < 4; ++e) { const float Gv = off[e] + cs[i][e]; qt[i][e] = q[e] * 0.08838834764831845f * __expf(Gv - gmid[e]); kt[i][e] = kk[i][e] * __expf(gmid[e] - Gv); }
                *(uint2*)(Qs + (ts * 4 + i) * 136 + kq * 4) = pack4(qt[i][0], qt[i][1], qt[i][2], qt[i][3]);
                *(uint2*)(Ks + (ts * 4 + i) * 136 + kq * 4) = pack4(kt[i][0], kt[i][1], kt[i][2], kt[i][3]);
            }
#pragma unroll
            for (int e = 0; e < 4; ++e) {
                *(uint2*)(KsT + (kq * 4 + e) * 72 + ts * 4) = pack4(kt[0][e], kt[1][e], kt[2][e], kt[3][e]);
                *(uint2*)(VsT + (kq * 4 + e) * 72 + ts * 4) = pack4(vt[0][e], vt[1][e], vt[2][e], vt[3][e]);
            }
            if (ts == 0) {
#pragma unroll
                for (int e = 0; e < 4; ++e) { E1[kq * 4 + e] = __expf(gmid[e]); E2[kq * 4 + e] = __expf(glast[e] - gmid[e]); }
            }
        }
        if (c + 1 < 32) HG_LOAD(c + 1);
        __syncthreads();
#pragma unroll
        for (int j = 0; j < 2; ++j) {
#pragma unroll
            for (int reg = 0; reg < 16; ++reg) accS[j][reg] *= E1[kb + crow(reg, hh)];
            const int v = vb0 + j * 32 + l31;
#pragma unroll
            for (int rg = 0; rg < 4; ++rg) *(uint2*)(SsT + v * 136 + kb + 8 * rg + 4 * hh) = pack4(accS[j][4 * rg], accS[j][4 * rg + 1], accS[j][4 * rg + 2], accS[j][4 * rg + 3]);
        }
        if (wid < 4) {
            const int tb = (wid >> 1) * 32, sb = (wid & 1) * 32;
            f32x16 aa;
#pragma unroll
            for (int i = 0; i < 16; ++i) aa[i] = 0.f;
#pragma unroll
            for (int ks = 0; ks < 8; ++ks) aa = MFMA32(ldfrag(Qs, 136, tb, ks * 16, lane), ldfrag(Ks, 136, sb, ks * 16, lane), aa);
            const int s = sb + l31;
#pragma unroll
            for (int reg = 0; reg < 16; ++reg) { const int t = tb + crow(reg, hh); As[t * 72 + s] = f2bf(s <= t ? aa[reg] : 0.f); }
        }
        __syncthreads();
        const int tb2 = (wid >> 2) * 32, vb2 = (wid & 3) * 32;
        f32x16 o;
#pragma unroll
        for (int i = 0; i < 16; ++i) o[i] = 0.f;
#pragma unroll
        for (int ks = 0; ks < 8; ++ks) o = MFMA32(ldfrag(Qs, 136, tb2, ks * 16, lane), ldfrag(SsT, 136, vb2, ks * 16, lane), o);
#pragma unroll
        for (int ks = 0; ks < 4; ++ks) o = MFMA32(ldfrag(As, 72, tb2, ks * 16, lane), ldfrag(VsT, 72, vb2, ks * 16, lane), o);
#pragma unroll
        for (int j = 0; j < 2; ++j) {
#pragma unroll
            for (int ks = 0; ks < 4; ++ks) accS[j] = MFMA32(ldfrag(KsT, 72, kb, ks * 16, lane), ldfrag(VsT, 72, vb0 + j * 32, ks * 16, lane), accS[j]);
#pragma unroll
            for (int reg = 0; reg < 16; ++reg) accS[j][reg] *= E2[kb + crow(reg, hh)];
        }
        __syncthreads();
#pragma unroll
        for (int reg = 0; reg < 16; ++reg) Of[(tb2 + crow(reg, hh)) * 132 + vb2 + l31] = o[reg];
        __syncthreads();
        {
            const int t = tid >> 3, vs = tid & 7;
            const size_t row = (size_t)(b * 2048 + c * 64 + t);
            f32x4 ov[4]; float ss = 0.f;
#pragma unroll
            for (int i = 0; i < 4; ++i) { ov[i] = *(const f32x4*)(Of + t * 132 + vs * 16 + i * 4); ss += ov[i][0] * ov[i][0] + ov[i][1] * ov[i][1] + ov[i][2] * ov[i][2] + ov[i][3] * ov[i][3]; }
            ss += __shfl_xor(ss, 1); ss += __shfl_xor(ss, 2); ss += __shfl_xor(ss, 4);
            const float rstd = rsqrtf(ss * (1.f / 128.f) + EPSF);
            const bf16_t* gp = U + row * INC + 6144 + h * 128 + vs * 16; const float* nwp = P.in[28] + h * 128 + vs * 16;
            const uint4 g0 = *(const uint4*)gp, g1 = *(const uint4*)(gp + 8);
            const unsigned gw[8] = {g0.x, g0.y, g0.z, g0.w, g1.x, g1.y, g1.z, g1.w};
            unsigned ow[8];
#pragma unroll
            for (int i = 0; i < 4; ++i) {
                const f32x4 w = *(const f32x4*)(nwp + i * 4);
                ow[2 * i] = pack2(ov[i][0] * rstd * w[0] * silu(bflo(gw[2 * i])), ov[i][1] * rstd * w[1] * silu(bfhi(gw[2 * i])));
                ow[2 * i + 1] = pack2(ov[i][2] * rstd * w[2] * silu(bflo(gw[2 * i + 1])), ov[i][3] * rstd * w[3] * silu(bfhi(gw[2 * i + 1])));
            }
            bf16_t* op = MIX + row * 2048 + h * 128 + vs * 16;
            *(uint4*)op = make_uint4(ow[0], ow[1], ow[2], ow[3]); *(uint4*)(op + 8) = make_uint4(ow[4], ow[5], ow[6], ow[7]);
        }
        __syncthreads();
    }
#undef HG_LOAD
    float* so = P.out + O_CP + (size_t)(b * 16 + h) * 128 * 128;
#pragma unroll
    for (int j = 0; j < 2; ++j)
#pragma unroll
        for (int reg = 0; reg < 16; ++reg) so[(kb + crow(reg, hh)) * 128 + vb0 + j * 32 + l31] = accS[j][reg];
}
DI void hgrn_sample_item(const Params& P, unsigned char* L, int item) {
    const int b = item >> 4, h = item & 15, tid = otid(), lane = tid & 63;
    float* qv = (float*)L; float* egv = qv + 128; float* kkv = egv + 128; float* vv = kkv + 128; float* part = vv + 128; float* red = part + 16 * 128;
    const bf16_t* U = WSP(bf16_t, OFF_U); bf16_t* MIX = WSP(bf16_t, OFF_MIX);
    const size_t row = (size_t)(MP + b); const bf16_t* ub = U + row * INC + h * 128;
    __syncthreads();
    if (tid < 128) {
        const int ch = h * 128 + tid;
        const float lbv = sigm(P.in[27][2048 + ch] - P.in[27][ch]);
        const float sg = sigm(bf2f(ub[2048 + tid])); const float kv = (1.f - lbv) * (1.f - sg);
        qv[tid] = bf2f(ub[tid]) * 0.08838834764831845f; egv[tid] = 1.f - kv; kkv[tid] = kv;
    } else if (tid < 256) vv[tid - 128] = bf2f(ub[4096 + tid - 128]);
    __syncthreads();
    const float* s0 = P.in[8] + (size_t)(b * 16 + h) * 128 * 128; float* s1 = P.out + O_CS + (size_t)(b * 16 + h) * 128 * 128;
    const int v4 = (tid & 31) * 4; const f32x4 vq = *(const f32x4*)(vv + v4);
    f32x4 op = {0.f, 0.f, 0.f, 0.f};
#pragma unroll
    for (int j = 0; j < 8; ++j) {
        const int k = (tid >> 5) + 16 * j;
        const f32x4 s = *(const f32x4*)(s0 + k * 128 + v4);
        const f32x4 sn = s * egv[k] + vq * kkv[k];
        *(f32x4*)(s1 + k * 128 + v4) = sn;
        op += sn * qv[k];
    }
    *(f32x4*)(part + (tid >> 5) * 128 + v4) = op;
    __syncthreads();
    float o = 0.f;
    if (tid < 128) {
#pragma unroll
        for (int i = 0; i < 16; ++i) o += part[i * 128 + tid];
        const float ss = wave_sum(o * o);
        if (lane == 0) red[tid >> 6] = ss;
    }
    __syncthreads();
    if (tid < 128) {
        const float rstd = rsqrtf((red[0] + red[1]) * (1.f / 128.f) + EPSF);
        const int ch = h * 128 + tid;
        MIX[row * 2048 + ch] = f2bf(o * rstd * P.in[28][ch] * silu(bf2f(ub[6144 + tid])));
    }
}
DI void phase_mix1(const Params& P, unsigned char* L) {
    const int tid = otid(), bid = blockIdx.x;
    if (bid < 128) hgrn_prompt_item(P, L, bid);
    unsigned* ctr = WSP(unsigned, OFF_CTL) + 16;
    unsigned* bc = (unsigned*)(L + LDS_BYTES - 16);
    for (;;) {
        __syncthreads();
        if (tid == 0) bc[0] = atomicAdd(ctr, 1u);
        __syncthreads();
        const unsigned it = bc[0];
        if (it >= 2048u) break;
        hgrn_sample_item(P, L, (int)it);
    }
}
DI void phase_final(const Params& P) {
    const int lane = threadIdx.x & 63, gw = blockIdx.x * 8 + (threadIdx.x >> 6), nwv = gridDim.x * 8;
    const float* H = WSP(float, OFF_H); const float* SS = WSP(float, OFF_SS2); const float* nf = P.in[10];
    f32x4 w4[4];
#pragma unroll
    for (int i = 0; i < 4; ++i) w4[i] = *(const f32x4*)(nf + lane * 4 + 256 * i);
    for (int r = gw; r < MV; r += nwv) {
        const float rstd = rsqrtf(SS[r] * (1.f / 1024.f) + EPSF);
#pragma unroll
        for (int i = 0; i < 4; ++i) { const f32x4 v = *(const f32x4*)(H + (size_t)r * 1024 + lane * 4 + 256 * i); *(f32x4*)(P.out + O_Y + (size_t)r * 1024 + lane * 4 + 256 * i) = v * rstd * w4[i]; }
    }
}

#ifndef PHM
#define PHM 0xFFFF
#endif
typedef const __attribute__((address_space(4))) Params* ParamsK;
DI Params getp() {
    ParamsK pp = (ParamsK)__builtin_amdgcn_kernarg_segment_ptr(); asm volatile("" : "+s"(pp));
    Params P;
#pragma unroll
    for (int i = 0; i < 32; ++i) P.in[i] = pp->in[i];
    P.out = pp->out; P.ws = pp->ws; return P;
}
#define GETP() const Params P = getp()
__global__ void __launch_bounds__(512, 2) fwd_kernel(Params Parg) {
    extern __shared__ __attribute__((aligned(16))) unsigned char lds[];
    cg::grid_group grid = cg::this_grid();
    unsigned char* L = (unsigned char*)lds;
    LAS unsigned char* LL = (LAS unsigned char*)lds;
    if (PHM & 1) { GETP(); phase_prep(P, L); }
    grid.sync();
    if (PHM & 2) { GETP(); pg8::StaticOrder S; S.init(MPAD, N0 + 256, gridDim.x, blockIdx.x); pg8::Gemm g{WSP(bf16_t, OFF_XN), WSP(bf16_t, OFF_W0T), MPAD, N0 + 256, 1024};
      EpiStoreBf16 E{WSP(bf16_t, OFF_U), N0, nullptr, WSP(float, OFF_DT)}; pg8::gemm_phase(LL, g, S, E); }
    grid.sync();
    if (PHM & 4) { GETP(); phase_mix0(P, L); }
    grid.sync();
    { GETP(); phase_norm0(P); }
    grid.sync();
    { GETP(); convert_p(P, 0); }
    __syncthreads();
    if (PHM & 8) { GETP(); pg8::StaticOrder S; S.init(MPAD, 1024, gridDim.x, blockIdx.x); pg8::Gemm g{WSP(bf16_t, OFF_MIX), WSP(bf16_t, OFF_WO0T), MPAD, 1024, 2048};
      EpiResid E{P.in[0], P.in[1], WSP(float, OFF_H), WSP(bf16_t, OFF_HB)}; pg8::gemm_phase(LL, g, S, E); }
    grid.sync();
    if (PHM & 16) { GETP(); pg8::StaticOrder S; S.init(MPAD, 1024, gridDim.x, blockIdx.x);
      pg8::Gemm g1{WSP(bf16_t, OFF_HB), WSP(bf16_t, OFF_WG0T), MPAD, 1024, 1024}; EpiGate E1{WSP(float, OFF_MIX)}; pg8::gemm_phase(LL, g1, S, E1); }
    if (PHM & 16) { GETP(); pg8::StaticOrder S; S.init(MPAD, 1024, gridDim.x, blockIdx.x);
      pg8::Gemm g2{WSP(bf16_t, OFF_PB), WSP(bf16_t, OFF_WP0T), MPAD, 1024, 256};
      EpiPle E2{WSP(float, OFF_H), WSP(float, OFF_MIX), WSP(bf16_t, OFF_XN), P.in[9] + 1024, WSP(float, OFF_SS1)}; pg8::gemm_phase(LL, g2, S, E2); }
    grid.sync();
    if (PHM & 32) { GETP(); pg8::StaticOrder S; S.init(MPAD, INC, gridDim.x, blockIdx.x); pg8::Gemm g{WSP(bf16_t, OFF_XN), WSP(bf16_t, OFF_W1T), MPAD, INC, 1024};
      EpiStoreBf16 E{WSP(bf16_t, OFF_U), INC, WSP(float, OFF_SS1), nullptr}; pg8::gemm_phase(LL, g, S, E); }
    grid.sync();
    if (PHM & 64) { GETP(); phase_mix1(P, L); }
    grid.sync();
    { GETP(); convert_p(P, 1); }
    __syncthreads();
    if (PHM & 128) { GETP(); pg8::StaticOrder S; S.init(MPAD, 1024, gridDim.x, blockIdx.x); pg8::Gemm g{WSP(bf16_t, OFF_MIX), WSP(bf16_t, OFF_WO1T), MPAD, 1024, 2048};
      EpiResid E{WSP(float, OFF_H), WSP(float, OFF_H) + (size_t)MP * 1024, WSP(float, OFF_H), WSP(bf16_t, OFF_HB)}; pg8::gemm_phase(LL, g, S, E); }
    grid.sync();
    if (PHM & 256) { GETP(); pg8::StaticOrder S; S.init(MPAD, 1024, gridDim.x, blockIdx.x);
      pg8::Gemm g1{WSP(bf16_t, OFF_HB), WSP(bf16_t, OFF_WG1T), MPAD, 1024, 1024}; EpiGate E1{WSP(float, OFF_MIX)}; pg8::gemm_phase(LL, g1, S, E1); }
    if (PHM & 256) { GETP(); pg8::StaticOrder S; S.init(MPAD, 1024, gridDim.x, blockIdx.x);
      pg8::Gemm g2{WSP(bf16_t, OFF_PB), WSP(bf16_t, OFF_WP1T), MPAD, 1024, 256};
      EpiPle E2{WSP(float, OFF_H), WSP(float, OFF_MIX), nullptr, nullptr, WSP(float, OFF_SS2)}; pg8::gemm_phase(LL, g2, S, E2); }
    grid.sync();
    { GETP(); phase_final(P); }
}

extern "C" void kernel_launch(void* const* d_in, const int* in_sizes, int n_in, void* d_out, int out_size, void* d_ws, size_t ws_size, hipStream_t stream) {
    static int grid = 0;
    if (grid == 0) {
        if (n_in != 32 || ws_size < WS_END) { fprintf(stderr, "kernel_launch: need 32 inputs and %zu bytes of workspace (got %d, %zu)\n", (size_t)WS_END, n_in, ws_size); grid = -1; return; }
        int dev = 0, cus = 0, per_cu = 0;
        (void)hipGetDevice(&dev); (void)hipDeviceGetAttribute(&cus, hipDeviceAttributeMultiprocessorCount, dev);
        if (hipFuncSetAttribute((const void*)fwd_kernel, hipFuncAttributeMaxDynamicSharedMemorySize, LDS_BYTES) != hipSuccess) { fprintf(stderr, "kernel_launch: hipFuncSetAttribute failed\n"); grid = -1; return; }
        if (hipOccupancyMaxActiveBlocksPerMultiprocessor(&per_cu, (const void*)fwd_kernel, 512, LDS_BYTES) != hipSuccess || per_cu < 1) { fprintf(stderr, "kernel_launch: occupancy query says %d\n", per_cu); per_cu = 1; }
        (void)hipGetLastError();
        grid = cus;
    }
    if (grid < 0) return;
    Params p{};
    for (int i = 0; i < 32; ++i) p.in[i] = (const float*)d_in[i];
    p.out = (float*)d_out; p.ws = (unsigned char*)d_ws;
    void* args[] = {&p};
    hipError_t e = hipLaunchCooperativeKernel((const void*)fwd_kernel, dim3(grid), dim3(512), args, LDS_BYTES, stream);
    if (e != hipSuccess) fprintf(stderr, "cooperative launch failed: %s (grid %d)\n", hipGetErrorString(e), grid);
}
```

```cpp
#include <hip/hip_runtime.h>
#include <hip/hip_cooperative_groups.h>
#include <cstdio>
namespace cg = cooperative_groups;

#define LAS __attribute__((address_space(3)))
#define DI __device__ __forceinline__
typedef unsigned short bf16_t;
typedef short bf16x8 __attribute__((ext_vector_type(8)));
typedef float f32x4 __attribute__((ext_vector_type(4)));
typedef float f32x16 __attribute__((ext_vector_type(16)));

constexpr int MP = 16384, MS = 128, MV = MP + MS, MPAD = 16640;
constexpr int DM = 1024, INAB = 4624, N0 = 4608, INC = 8192;
constexpr float EPSF = 1e-6f;
constexpr size_t O_Y = 0, O_AHP = 16908288, O_ACP = 16916480, O_BSP = 16941056, O_BCP = 17989632, O_CP = 18026496,
                 O_AHS = 20123648, O_ACS = 20254720, O_BSS = 20647936, O_BCS = 37425152, O_CS = 38014976;
constexpr size_t al256(size_t x) { return (x + 255) & ~size_t(255); }
constexpr size_t OFF_CTL = 0;
constexpr size_t OFF_BAR = 256;
constexpr size_t OFF_SS1 = 256 + 16384;
constexpr size_t OFF_SS2 = OFF_SS1 + al256((size_t)MPAD * 4);
constexpr size_t OFF_SSB = OFF_SS2 + al256((size_t)MPAD * 4);
constexpr size_t OFF_DT  = OFF_SSB + al256((size_t)MPAD * 8);
constexpr size_t OFF_W0T = OFF_DT + al256((size_t)MV * 16 * 4);
constexpr size_t OFF_WO0T = OFF_W0T + (size_t)(N0 + 256) * 1024 * 2;
constexpr size_t OFF_WG0T = OFF_WO0T + (size_t)1024 * 2048 * 2;
constexpr size_t OFF_WP0T = OFF_WG0T + (size_t)1024 * 1024 * 2;
constexpr size_t OFF_W1T  = OFF_WP0T + (size_t)1024 * 256 * 2;
constexpr size_t OFF_WO1T = OFF_W1T + (size_t)INC * 1024 * 2;
constexpr size_t OFF_WG1T = OFF_WO1T + (size_t)1024 * 2048 * 2;
constexpr size_t OFF_WP1T = OFF_WG1T + (size_t)1024 * 1024 * 2;
constexpr size_t OFF_WRT  = OFF_WP1T + (size_t)1024 * 256 * 2;
constexpr size_t OFF_WIT  = OFF_WRT + (size_t)128 * 1024 * 2;
constexpr size_t OFF_XN   = OFF_WIT + (size_t)128 * 1024 * 2;
constexpr size_t OFF_MIX  = OFF_XN + (size_t)MPAD * 1024 * 2;
constexpr size_t OFF_H    = OFF_MIX + (size_t)MPAD * 2048 * 2;
constexpr size_t OFF_U    = OFF_H + al256((size_t)MV * 1024 * 4);
constexpr size_t OFF_HB   = OFF_U;
constexpr size_t OFF_PB   = OFF_U + (size_t)MPAD * 1024 * 2;
constexpr size_t WS_END   = OFF_U + al256((size_t)MV * INC * 2);
constexpr int LDS_BYTES = 144 * 1024;

struct Params { const float* in[32]; float* out; unsigned char* ws; };
#define WSP(T, off) ((T*)(P.ws + (off)))

typedef __bf16 bf16v2_t __attribute__((ext_vector_type(2)));
typedef float f32v2_t __attribute__((ext_vector_type(2)));
DI unsigned pack2(float lo, float hi) { f32v2_t v = {lo, hi}; bf16v2_t b = __builtin_convertvector(v, bf16v2_t); return __builtin_bit_cast(unsigned, b); }
DI bf16_t f2bf(float f) { return __builtin_bit_cast(bf16_t, (__bf16)f); }
DI float bf2f(bf16_t b) { return __uint_as_float(((unsigned)b) << 16); }
DI float bflo(unsigned w) { return __uint_as_float(w << 16); }
DI float bfhi(unsigned w) { return __uint_as_float(w & 0xFFFF0000u); }
DI float frcp(float x) { return __builtin_amdgcn_rcpf(x); }
DI float sigm(float x) { return frcp(1.f + __expf(-x)); }
DI float silu(float x) { return x * frcp(1.f + __expf(-x)); }
DI float softplus(float x) { return x > 20.f ? x : log1pf(__expf(x)); }
DI float wave_sum(float v) { for (int o = 32; o > 0; o >>= 1) v += __shfl_xor(v, o); return v; }
DI int otid() { int t = threadIdx.x; asm volatile("" : "+v"(t)); return t; }
DI int crow(int reg, int hh) { return (reg & 3) + 8 * (reg >> 2) + 4 * hh; }
DI void ld4bf(const bf16_t* p, float (&o)[4]) { uint2 w = *(const uint2*)p; o[0] = bflo(w.x); o[1] = bfhi(w.x); o[2] = bflo(w.y); o[3] = bfhi(w.y); }
typedef unsigned u32x2 __attribute__((ext_vector_type(2)));
typedef unsigned u32x4 __attribute__((ext_vector_type(4)));
DI u32x2 pack4v(float a, float b, float c, float d) { u32x2 r; r.x = pack2(a, b); r.y = pack2(c, d); return r; }
DI uint2 pack4(float a, float b, float c, float d) { uint2 r; r.x = pack2(a, b); r.y = pack2(c, d); return r; }
#define MFMA32(a, b, c) __builtin_amdgcn_mfma_f32_32x32x16_bf16((a), (b), (c), 0, 0, 0)
#define MFMA16(a, b, c) __builtin_amdgcn_mfma_f32_16x16x32_bf16((a), (b), (c), 0, 0, 0)
DI bf16x8 ldfrag(const bf16_t* base, int ld, int row0, int k0, int lane) { return *(const bf16x8*)(base + (row0 + (lane & 31)) * ld + k0 + 8 * (lane >> 5)); }
DI bf16x8 ldfrag16(const bf16_t* base, int ld, int row0, int k0, int lane) { return *(const bf16x8*)(base + (row0 + (lane & 15)) * ld + k0 + 8 * (lane >> 4)); }

namespace pg8 {
constexpr int BM = 256, BK = 64, HALF = 128, HTB = HALF * BK * 2, STAGE_BYTES = 8 * HTB, NXCD = 8, WGM = 8;
DI int lds_byte(int r, int c) { const int st = (r >> 4) * 2 + (c >> 5), rr = r & 15, cc = c & 31, ob = rr * 64 + cc * 2; return st * 1024 + (ob ^ (((ob >> 9) & 1) << 5)); }
DI void stage_rc(int b, int& R, int& C) { const int st = b / 1024, sb = b % 1024, swz = sb ^ (((sb >> 9) & 1) << 5); R = (st >> 1) * 16 + swz / 64; C = (st & 1) * 32 + (swz % 64) / 2; }
DI int perm32(int rho) { const int n = rho >> 4, i = rho & 15; return 8 * (i >> 2) + 4 * n + (i & 3); }
struct Unit { int pm, pn; };
struct Gemm { const bf16_t* A; const bf16_t* Bt; int M, N, K; };
struct StaticOrder {
    int nM, nN, nwg, G, c;
    DI void init(int M, int N, int G_, int c_) { nM = M / BM; nN = N / BM; nwg = nM * nN; G = G_; c = c_; }
    DI bool next(int i, Unit& u) const {
        const long L = (long)i * G + c; if (L >= nwg) return false;
        int wgid = (int)L; { const int q = nwg / NXCD, r = nwg % NXCD, xcd = wgid % NXCD, off = wgid / NXCD; wgid = (xcd < r ? xcd * (q + 1) : r * (q + 1) + (xcd - r) * q) + off; }
        const int nig = WGM * nN, gid = wgid / nig, fm = gid * WGM, gsz = (nM - fm) < WGM ? (nM - fm) : WGM;
        u.pm = fm + ((wgid % nig) % gsz); u.pn = (wgid % nig) / gsz; return true;
    }
};

template <class Epi>
DI void gemm_phase(LAS unsigned char* lds, const Gemm g, const StaticOrder& S, const Epi& E) {
    const int tid = otid(), wid = __builtin_amdgcn_readfirstlane(tid >> 6), lane = tid & 63, wr = wid >> 2, wc = wid & 3, fr = lane & 15, fq = lane >> 4;
    const int K = g.K, nt = K / BK;
    unsigned voffA[2], voffB[2];
#pragma unroll
    for (int i = 0; i < 2; ++i) { int R, C; stage_rc(tid * 16 + i * 8192, R, C); const int Rb = Epi::PERM ? ((R & ~31) + perm32(R & 31)) : R;
        voffA[i] = (unsigned)(R * K + C) * 2u; voffB[i] = (unsigned)(Rb * K + C) * 2u; }
    const size_t kstep = (size_t)(BK * 2);
    const size_t hstep = (size_t)HALF * K * 2;
    const size_t tstep = 2 * hstep;
    const unsigned ldsw = (unsigned)wid * 1024u;
    const int aoff = lds_byte(wr * 64 + fr, fq * 8), boff = lds_byte(wc * 32 + fr, fq * 8);
#define PG8_SA(b, h) (((b) * 2 + (h)) * HTB)
#define PG8_SB(b, h) ((4 + (b) * 2 + (h)) * HTB)
#define PG8_STAGE(bufoff, gbase, voff) do { _Pragma("unroll") for (int _i = 0; _i < 2; ++_i) \
        __builtin_amdgcn_global_load_lds((const unsigned*)((const char*)(gbase) + (voff)[_i]), (LAS unsigned*)(lds + (bufoff) + ldsw + _i * 8192), 16, 0, 0); } while (0)
#define PG8_LDA(dst, b, h) do { _Pragma("unroll") for (int m = 0; m < 4; ++m) _Pragma("unroll") for (int k = 0; k < 2; ++k) dst[m][k] = *(const LAS bf16x8*)(lds + PG8_SA(b, h) + aoff + m * 2048 + k * 1024); } while (0)
#define PG8_LDB(dst, b, h) do { _Pragma("unroll") for (int n = 0; n < 2; ++n) _Pragma("unroll") for (int k = 0; k < 2; ++k) dst[n][k] = *(const LAS bf16x8*)(lds + PG8_SB(b, h) + boff + n * 2048 + k * 1024); } while (0)
#define PG8_MMA(ai, bj, At, Bt) do { __builtin_amdgcn_s_setprio(1); _Pragma("unroll") for (int m = 0; m < 4; ++m) _Pragma("unroll") for (int n = 0; n < 2; ++n) _Pragma("unroll") for (int k = 0; k < 2; ++k) \
        acc[ai][bj][m][n] = __builtin_amdgcn_mfma_f32_16x16x32_bf16(Bt[n][k], At[m][k], acc[ai][bj][m][n], 0, 0, 0); __builtin_amdgcn_s_setprio(0); } while (0)
#define PG8_WAIT_V(n) asm volatile("s_waitcnt vmcnt(" #n ")" ::: "memory")
#define PG8_WAIT_L(n) asm volatile("s_waitcnt lgkmcnt(" #n ")" ::: "memory")
#define PG8_BAR __builtin_amdgcn_s_barrier()
#define PG8_SCHED __builtin_amdgcn_sched_barrier(0)
    Unit cur, nxt; int ui = 0;
    if (!S.next(0, cur)) return;
    f32x4 acc[2][2][4][2];
#pragma unroll
    for (int a = 0; a < 2; ++a)
#pragma unroll
        for (int b = 0; b < 2; ++b)
#pragma unroll
            for (int m = 0; m < 4; ++m)
#pragma unroll
                for (int n = 0; n < 2; ++n) acc[a][b][m][n] = (f32x4){0.f, 0.f, 0.f, 0.f};
    bf16x8 At[4][2], B0[2][2], B1[2][2];
    const char* cA = (const char*)g.A + (size_t)cur.pm * tstep; const char* cB = (const char*)g.Bt + (size_t)cur.pn * tstep;
    PG8_STAGE(PG8_SB(0, 0), cB, voffB); PG8_STAGE(PG8_SA(0, 0), cA, voffA); PG8_STAGE(PG8_SB(0, 1), cB + hstep, voffB); PG8_STAGE(PG8_SA(0, 1), cA + hstep, voffA);
    if (wr == 1) PG8_BAR;
    PG8_WAIT_V(4); PG8_BAR;
    PG8_STAGE(PG8_SB(1, 0), cB + kstep, voffB); PG8_STAGE(PG8_SA(1, 0), cA + kstep, voffA); PG8_STAGE(PG8_SB(1, 1), cB + hstep + kstep, voffB);
    PG8_WAIT_V(6); PG8_BAR;
    for (;;) {
        const bool has_next = S.next(ui + 1, nxt);
        const char* nA = has_next ? (const char*)g.A + (size_t)nxt.pm * tstep : cA; const char* nB = has_next ? (const char*)g.Bt + (size_t)nxt.pn * tstep : cB;
        for (int t = 0; t < nt; t += 2) {
            const bool last = (t == nt - 2);
            const char* a1 = cA + (size_t)(t + 1) * kstep;
            const char* a2 = last ? nA : cA + (size_t)(t + 2) * kstep; const char* b2 = last ? nB : cB + (size_t)(t + 2) * kstep;
            const char* a3 = a2 + kstep; const char* b3 = b2 + kstep;
            PG8_LDB(B0, 0, 0); PG8_SCHED; PG8_LDA(At, 0, 0); PG8_STAGE(PG8_SA(1, 1), a1 + hstep, voffA);
            PG8_WAIT_L(8); PG8_BAR; PG8_WAIT_L(0); PG8_MMA(0, 0, At, B0); PG8_BAR; PG8_SCHED;
            PG8_LDB(B1, 0, 1); PG8_STAGE(PG8_SB(0, 0), b2, voffB);
            PG8_BAR; PG8_WAIT_L(0); PG8_MMA(0, 1, At, B1); PG8_BAR;
            PG8_LDA(At, 0, 1); PG8_STAGE(PG8_SA(0, 0), a2, voffA);
            PG8_BAR; PG8_WAIT_L(0); PG8_MMA(1, 0, At, B0); PG8_BAR; PG8_SCHED;
            PG8_STAGE(PG8_SB(0, 1), b2 + hstep, voffB);
            PG8_WAIT_V(6); PG8_BAR; PG8_MMA(1, 1, At, B1); PG8_BAR;
            PG8_LDB(B0, 1, 0); PG8_SCHED; PG8_LDA(At, 1, 0); PG8_STAGE(PG8_SA(0, 1), a2 + hstep, voffA);
            PG8_WAIT_L(8); PG8_BAR; PG8_WAIT_L(0); PG8_MMA(0, 0, At, B0); PG8_BAR; PG8_SCHED;
            PG8_LDB(B1, 1, 1); PG8_STAGE(PG8_SB(1, 0), b3, voffB);
            PG8_BAR; PG8_WAIT_L(0); PG8_MMA(0, 1, At, B1); PG8_BAR;
            PG8_LDA(At, 1, 1); PG8_STAGE(PG8_SA(1, 0), a3, voffA);
            PG8_BAR; PG8_WAIT_L(0); PG8_MMA(1, 0, At, B0); PG8_BAR; PG8_SCHED;
            PG8_STAGE(PG8_SB(1, 1), b3 + hstep, voffB);
            PG8_WAIT_V(6); PG8_BAR; PG8_MMA(1, 1, At, B1); PG8_BAR;
        }
        E(acc, cur, wr, wc, fr, fq);
        if (!has_next) break;
#pragma unroll
        for (int a = 0; a < 2; ++a)
#pragma unroll
            for (int b = 0; b < 2; ++b)
#pragma unroll
                for (int m = 0; m < 4; ++m)
#pragma unroll
                    for (int n = 0; n < 2; ++n) acc[a][b][m][n] = (f32x4){0.f, 0.f, 0.f, 0.f};
        cur = nxt; cA = nA; cB = nB; ++ui;
    }
    PG8_WAIT_V(0);
    if (wr == 0) PG8_BAR;
    PG8_BAR;
#undef PG8_SA
#undef PG8_SB
#undef PG8_STAGE
#undef PG8_LDA
#undef PG8_LDB
#undef PG8_MMA
#undef PG8_WAIT_V
#undef PG8_WAIT_L
#undef PG8_BAR
#undef PG8_SCHED
}
}

struct EpiStoreBf16 {
    static constexpr bool PERM = true;
    bf16_t* O; int ldc; const float* ss; float* DT;
    DI void operator()(const f32x4 (&acc)[2][2][4][2], const pg8::Unit& u, int wr, int wc, int fr, int fq) const {
        const int row0 = u.pm * 256 + wr * 64 + fr, col0 = u.pn * 256 + wc * 32 + 8 * fq;
        if (u.pn * 256 >= ldc) {
            if (wc == 0 && fq < 2) {
#pragma unroll
                for (int ai = 0; ai < 2; ++ai)
#pragma unroll
                    for (int m = 0; m < 4; ++m) { const int row = row0 + ai * 128 + m * 16;
                        if (row < MV) { *(f32x4*)(DT + (size_t)row * 16 + 8 * fq) = acc[ai][0][m][0]; *(f32x4*)(DT + (size_t)row * 16 + 8 * fq + 4) = acc[ai][0][m][1]; } }
            }
            return;
        }
#pragma unroll
        for (int ai = 0; ai < 2; ++ai)
#pragma unroll
            for (int m = 0; m < 4; ++m) {
                const int row = row0 + ai * 128 + m * 16;
                if (row < MV) {
                    const float sc = ss ? rsqrtf(ss[row] * (1.f / 1024.f) + EPSF) : 1.f;
                    bf16_t* rp = O + (size_t)row * ldc + col0;
#pragma unroll
                    for (int bj = 0; bj < 2; ++bj) {
                        const f32x4 v0 = acc[ai][bj][m][0] * sc, v1 = acc[ai][bj][m][1] * sc;
                        uint4 w; w.x = pack2(v0[0], v0[1]); w.y = pack2(v0[2], v0[3]); w.z = pack2(v1[0], v1[1]); w.w = pack2(v1[2], v1[3]);
                        *(uint4*)(rp + bj * 128) = w;
                    }
                }
            }
    }
};
struct EpiResid {
    static constexpr bool PERM = false;
    const float* rp_prompt; const float* rp_sample;
    float* H; bf16_t* HB;
    DI void operator()(const f32x4 (&acc)[2][2][4][2], const pg8::Unit& u, int wr, int wc, int fr, int fq) const {
        const int row0 = u.pm * 256 + wr * 64 + fr, col0 = u.pn * 256 + wc * 32 + 4 * fq;
#pragma unroll
        for (int ai = 0; ai < 2; ++ai)
#pragma unroll
            for (int m = 0; m < 4; ++m) {
                const int row = row0 + ai * 128 + m * 16;
                if (row < MV) {
                    const float* rs = (row < MP ? rp_prompt + (size_t)row * 1024 : rp_sample + (size_t)(row - MP) * 1024) + col0;
                    float* hp = H + (size_t)row * 1024 + col0; bf16_t* bp = HB + (size_t)row * 1024 + col0;
#pragma unroll
                    for (int bj = 0; bj < 2; ++bj)
#pragma unroll
                        for (int n = 0; n < 2; ++n) {
                            const int co = bj * 128 + n * 16;
                            const f32x4 v = acc[ai][bj][m][n] + *(const f32x4*)(rs + co);
                            *(f32x4*)(hp + co) = v; *(uint2*)(bp + co) = pack4(v[0], v[1], v[2], v[3]);
                        }
                }
            }
    }
};
struct EpiGate {
    static constexpr bool PERM = false;
    float* Gt;
    DI void operator()(const f32x4 (&acc)[2][2][4][2], const pg8::Unit& u, int wr, int wc, int fr, int fq) const {
        const int row0 = u.pm * 256 + wr * 64 + fr, col0 = u.pn * 256 + wc * 32 + 4 * fq;
#pragma unroll
        for (int ai = 0; ai < 2; ++ai)
#pragma unroll
            for (int m = 0; m < 4; ++m) {
                const int row = row0 + ai * 128 + m * 16;
                if (row < MV) {
                    float* gp = Gt + (size_t)row * 1024 + col0;
#pragma unroll
                    for (int bj = 0; bj < 2; ++bj)
#pragma unroll
                        for (int n = 0; n < 2; ++n) {
                            const f32x4 a = acc[ai][bj][m][n];
                            *(f32x4*)(gp + bj * 128 + n * 16) = (f32x4){sigm(a[0]), sigm(a[1]), sigm(a[2]), sigm(a[3])};
                        }
                }
            }
    }
};
struct EpiPle {
    static constexpr bool PERM = false;
    float* H; const float* Gt; bf16_t* XN; const float* nw; float* SS;
    DI void operator()(const f32x4 (&acc)[2][2][4][2], const pg8::Unit& u, int wr, int wc, int fr, int fq) const {
        const int row0 = u.pm * 256 + wr * 64 + fr, col0 = u.pn * 256 + wc * 32 + 4 * fq;
#pragma unroll
        for (int ai = 0; ai < 2; ++ai)
#pragma unroll
            for (int m = 0; m < 4; ++m) {
                const int row = row0 + ai * 128 + m * 16;
                float ssum = 0.f;
                if (row < MV) {
                    float* hp = H + (size_t)row * 1024 + col0; const float* gp = Gt + (size_t)row * 1024 + col0;
#pragma unroll
                    for (int bj = 0; bj < 2; ++bj)
#pragma unroll
                        for (int n = 0; n < 2; ++n) {
                            const int co = bj * 128 + n * 16;
                            const f32x4 v = *(const f32x4*)(hp + co) + *(const f32x4*)(gp + co) * acc[ai][bj][m][n];
                            *(f32x4*)(hp + co) = v;
                            ssum += v[0] * v[0] + v[1] * v[1] + v[2] * v[2] + v[3] * v[3];
                            if (XN) { const f32x4 w = *(const f32x4*)(nw + col0 + co); *(uint2*)(XN + (size_t)row * 1024 + col0 + co) = pack4(v[0] * w[0], v[1] * w[1], v[2] * w[2], v[3] * w[3]); }
                        }
                }
                ssum += __shfl_xor(ssum, 16); ssum += __shfl_xor(ssum, 32);
                if (fq == 0 && row < MV) atomicAdd(SS + row, ssum);
            }
    }
};

template <class F>
DI void sgemm(const bf16_t* A, const bf16_t* Bt, int K, int ntask, int nwg_main, const F& f) {
    const int tid = otid(), lane = tid & 63, wid = tid >> 6;
    const int G = gridDim.x, off = nwg_main % G;
    int li = blockIdx.x, nl = G;
    if (off != 0) { if ((int)blockIdx.x < off) return; li = blockIdx.x - off; nl = G - off; }
    for (int t = li; t < ntask; t += nl) {
        const bf16_t* ap = A + (size_t)(MP + wid * 16 + (lane & 15)) * K + 8 * (lane >> 4);
        const bf16_t* bp0 = Bt + (size_t)(t * 32 + (lane & 15)) * K + 8 * (lane >> 4);
        const bf16_t* bp1 = bp0 + (size_t)16 * K;
        f32x4 acc0 = {0.f, 0.f, 0.f, 0.f}, acc1 = {0.f, 0.f, 0.f, 0.f};
        for (int k0 = 0; k0 < K; k0 += 256) {
            bf16x8 a[8], b0[8], b1[8];
#pragma unroll
            for (int q = 0; q < 8; ++q) { a[q] = *(const bf16x8*)(ap + k0 + q * 32); b0[q] = *(const bf16x8*)(bp0 + k0 + q * 32); b1[q] = *(const bf16x8*)(bp1 + k0 + q * 32); }
#pragma unroll
            for (int q = 0; q < 8; ++q) { acc0 = MFMA16(a[q], b0[q], acc0); acc1 = MFMA16(a[q], b1[q], acc1); }
        }
#pragma unroll
        for (int reg = 0; reg < 4; ++reg) {
            const int row = MP + wid * 16 + (lane >> 4) * 4 + reg, col = t * 32 + (lane & 15);
            f(row, col, acc0[reg], lane); f(row, col + 16, acc1[reg], lane);
        }
    }
}
struct SfU { bf16_t* O; int ldc; const float* ss; float* DT;
    DI void operator()(int row, int col, float v, int) const {
        if (col >= ldc) { if (col < ldc + 16) DT[(size_t)row * 16 + col - ldc] = v; return; }
        const float sc = ss ? rsqrtf(ss[row] * (1.f / 1024.f) + EPSF) : 1.f; O[(size_t)row * ldc + col] = f2bf(v * sc); } };
struct SfResid { const float* rs; float* H; bf16_t* HB;
    DI void operator()(int row, int col, float v, int) const { const float h = rs[(size_t)(row - MP) * 1024 + col] + v; H[(size_t)row * 1024 + col] = h; HB[(size_t)row * 1024 + col] = f2bf(h); } };
struct SfGate { float* Gt; DI void operator()(int row, int col, float v, int) const { Gt[(size_t)row * 1024 + col] = sigm(v); } };
struct SfPle { float* H; const float* Gt; bf16_t* XN; const float* nw; float* SS;
    DI void operator()(int row, int col, float v, int lane) const {
        const size_t o = (size_t)row * 1024 + col; const float h = H[o] + Gt[o] * v; H[o] = h;
        if (XN) XN[o] = f2bf(h * nw[col]);
        float ss = h * h; ss += __shfl_xor(ss, 1); ss += __shfl_xor(ss, 2); ss += __shfl_xor(ss, 4); ss += __shfl_xor(ss, 8);
        if ((lane & 15) == 0) atomicAdd(SS + row, ss); } };

DI void transpose_tile_w(const float* src, int lds_, bf16_t* dst, int ldd, int k0, int n0, int nvalid, float* tile, int lane) {
    const float* sp = src + (size_t)k0 * lds_ + n0 + lane;
#pragma unroll
    for (int bt = 0; bt < 4; ++bt) {
        float v[16];
#pragma unroll
        for (int r = 0; r < 16; ++r) v[r] = (lane < nvalid) ? sp[(size_t)(bt * 16 + r) * lds_] : 0.f;
#pragma unroll
        for (int r = 0; r < 16; ++r) tile[(bt * 16 + r) * 65 + lane] = v[r];
    }
    const int koct = lane & 7;
#pragma unroll
    for (int p = 0; p < 8; ++p) {
        const int nn = (lane >> 3) + 8 * p;
        const float* tp = tile + (koct * 8) * 65 + nn;
        uint4 w;
        w.x = pack2(tp[0], tp[65]); w.y = pack2(tp[2 * 65], tp[3 * 65]); w.z = pack2(tp[4 * 65], tp[5 * 65]); w.w = pack2(tp[6 * 65], tp[7 * 65]);
        *(uint4*)(dst + (size_t)(n0 + nn) * ldd + k0 + koct * 8) = w;
    }
}
DI void transpose_job(const float* src, int lds_, bf16_t* dst, int ldd, int K, int N, int nvalid_last, int& base, float* tile, int gw, int nwv, int lane) {
    const int ntn = (N + 63) / 64, nt = (K / 64) * ntn;
    const int first = (gw - (base % nwv) + nwv) % nwv;
    for (int t = first; t < nt; t += nwv) { const int tn = t % ntn; transpose_tile_w(src, lds_, dst, ldd, (t / ntn) * 64, tn * 64, (tn == ntn - 1) ? nvalid_last : 64, tile, lane); }
    base += nt;
}
DI void phase_prep(const Params& P, unsigned char* L) {
    const int tid = otid(), lane = tid & 63, wid = tid >> 6;
    const int gw = blockIdx.x * 8 + wid, nwv = gridDim.x * 8;
    { float* z = WSP(float, OFF_SS1); const int n = (int)((OFF_DT - OFF_SS1) / 4);
      for (int i = blockIdx.x * 512 + tid; i < n; i += gridDim.x * 512) z[i] = 0.f;
      if (blockIdx.x == 0 && tid < 64) WSP(unsigned, OFF_CTL)[tid] = 0u; }
    { float* tile = (float*)L + wid * (64 * 65); int base = 0;
      transpose_job(P.in[26], INC, WSP(bf16_t, OFF_W1T), 1024, 1024, INC, 64, base, tile, gw, nwv, lane);
      transpose_job(P.in[11], INAB, WSP(bf16_t, OFF_W0T), 1024, 1024, N0, 64, base, tile, gw, nwv, lane);
      transpose_job(P.in[11] + N0, INAB, WSP(bf16_t, OFF_W0T) + (size_t)N0 * 1024, 1024, 1024, 16, 16, base, tile, gw, nwv, lane);
      transpose_job(P.in[25], 1024, WSP(bf16_t, OFF_WO0T), 2048, 2048, 1024, 64, base, tile, gw, nwv, lane);
      transpose_job(P.in[31], 1024, WSP(bf16_t, OFF_WG0T), 1024, 1024, 1024, 64, base, tile, gw, nwv, lane);
      transpose_job(P.in[30], 1024, WSP(bf16_t, OFF_WP0T), 256, 256, 1024, 64, base, tile, gw, nwv, lane);
      transpose_job(P.in[29], 1024, WSP(bf16_t, OFF_WO1T), 2048, 2048, 1024, 64, base, tile, gw, nwv, lane);
      transpose_job(P.in[31] + 1024 * 1024, 1024, WSP(bf16_t, OFF_WG1T), 1024, 1024, 1024, 64, base, tile, gw, nwv, lane);
      transpose_job(P.in[30] + 256 * 1024, 1024, WSP(bf16_t, OFF_WP1T), 256, 256, 1024, 64, base, tile, gw, nwv, lane);
      transpose_job(P.in[14], 128, WSP(bf16_t, OFF_WRT), 1024, 1024, 128, 64, base, tile, gw, nwv, lane);
      transpose_job(P.in[16], 128, WSP(bf16_t, OFF_WIT), 1024, 1024, 128, 64, base, tile, gw, nwv, lane); }
    { const float* nwp = P.in[9]; bf16_t* XN = WSP(bf16_t, OFF_XN);
      f32x4 w4[4];
#pragma unroll
      for (int i = 0; i < 4; ++i) w4[i] = *(const f32x4*)(nwp + lane * 4 + 256 * i);
      for (int r0 = gw * 2; r0 < MV; r0 += nwv * 2) {
          f32x4 x[2][4];
#pragma unroll
          for (int q = 0; q < 2; ++q) { const int r = r0 + q; const float* src = r < MP ? P.in[0] + (size_t)r * 1024 : P.in[1] + (size_t)(r - MP) * 1024;
#pragma unroll
              for (int i = 0; i < 4; ++i) x[q][i] = *(const f32x4*)(src + lane * 4 + 256 * i); }
#pragma unroll
          for (int q = 0; q < 2; ++q) {
              float ss = 0.f;
#pragma unroll
              for (int i = 0; i < 4; ++i) ss += x[q][i][0] * x[q][i][0] + x[q][i][1] * x[q][i][1] + x[q][i][2] * x[q][i][2] + x[q][i][3] * x[q][i][3];
              ss = wave_sum(ss); const float rstd = rsqrtf(ss * (1.f / 1024.f) + EPSF);
#pragma unroll
              for (int i = 0; i < 4; ++i) { const f32x4 v = x[q][i] * rstd * w4[i]; *(uint2*)(XN + (size_t)(r0 + q) * 1024 + lane * 4 + 256 * i) = pack4(v[0], v[1], v[2], v[3]); }
          }
      } }
}
DI void convert_p(const Params& P, int layer) {
    bf16_t* PB = WSP(bf16_t, OFF_PB);
    const float* pp = P.in[2] + (size_t)layer * MP * 256; const float* ps = P.in[3] + (size_t)layer * MS * 256;
    for (int i = blockIdx.x * 512 + threadIdx.x; i < MV * 64; i += gridDim.x * 512) {
        const int row = i >> 6, c4 = (i & 63) * 4;
        const f32x4 v = *(const f32x4*)((row < MP ? pp + (size_t)row * 256 : ps + (size_t)(row - MP) * 256) + c4);
        *(uint2*)(PB + (size_t)row * 256 + c4) = pack4(v[0], v[1], v[2], v[3]);
    }
}

constexpr size_t OFF_XT = OFF_XN;
constexpr size_t OFF_CN = OFF_H;
constexpr size_t OFF_BN = OFF_CN + (size_t)MP * 256 * 2;
constexpr size_t OFF_BT = OFF_BN + (size_t)MP * 256 * 2;
DI void phase_convbc(const Params& P) {
    const bf16_t* U = WSP(bf16_t, OFF_U);
    bf16_t* XT = WSP(bf16_t, OFF_XT); bf16_t* CN = WSP(bf16_t, OFF_CN); bf16_t* BN = WSP(bf16_t, OFF_BN); bf16_t* BT = WSP(bf16_t, OFF_BT);
    for (int idx = blockIdx.x * 512 + otid(); idx < 2048 * 384; idx += gridDim.x * 512) {
        const int quad = idx % 384, tgp = idx / 384, b = tgp >> 8, t0 = (tgp & 255) * 8, cch = quad * 4;
        float cw[4][4], cbias[4];
#pragma unroll
        for (int kk = 0; kk < 4; ++kk) { const f32x4 w = *(const f32x4*)(P.in[19] + kk * 1536 + cch); cw[kk][0] = w[0]; cw[kk][1] = w[1]; cw[kk][2] = w[2]; cw[kk][3] = w[3]; }
        { const f32x4 w = *(const f32x4*)(P.in[20] + cch); cbias[0] = w[0]; cbias[1] = w[1]; cbias[2] = w[2]; cbias[3] = w[3]; }
        const unsigned voff = (unsigned)((b * 2048 + t0) * N0 + 3072 + cch);
        uint2 raw[11];
#pragma unroll
        for (int j = 0; j < 11; ++j) raw[j] = (t0 + j - 3 >= 0) ? *(const uint2*)((U + (j - 3) * N0) + voff) : make_uint2(0u, 0u);
        float y[8][4];
#pragma unroll
        for (int j = 0; j < 8; ++j) {
            const float x0[4] = {bflo(raw[j].x), bfhi(raw[j].x), bflo(raw[j].y), bfhi(raw[j].y)};
            const float x1[4] = {bflo(raw[j + 1].x), bfhi(raw[j + 1].x), bflo(raw[j + 1].y), bfhi(raw[j + 1].y)};
            const float x2[4] = {bflo(raw[j + 2].x), bfhi(raw[j + 2].x), bflo(raw[j + 2].y), bfhi(raw[j + 2].y)};
            const float x3[4] = {bflo(raw[j + 3].x), bfhi(raw[j + 3].x), bflo(raw[j + 3].y), bfhi(raw[j + 3].y)};
#pragma unroll
            for (int e = 0; e < 4; ++e) y[j][e] = silu(cbias[e] + cw[0][e] * x0[e] + cw[1][e] * x1[e] + cw[2][e] * x2[e] + cw[3][e] * x3[e]);
        }
        const int c = t0 >> 7, tl = t0 & 127;
        if (cch < 1024) {
#pragma unroll
            for (int e = 0; e < 4; ++e) { uint4 w; w.x = pack2(y[0][e], y[1][e]); w.y = pack2(y[2][e], y[3][e]); w.z = pack2(y[4][e], y[5][e]); w.w = pack2(y[6][e], y[7][e]);
                *(uint4*)(XT + ((size_t)((b * 16 + c) * 1024 + cch + e)) * 128 + tl) = w; }
        } else {
            const int cc = cch - 1024, isC = cc >= 256, g = (cc & 255) >> 7, n0 = cc & 127;
            bf16_t* nat = (isC ? CN : BN) + ((size_t)(((b * 16 + c) * 2 + g) * 128 + tl)) * 128 + n0;
#pragma unroll
            for (int j = 0; j < 8; ++j) *(uint2*)(nat + j * 128) = pack4(y[j][0], y[j][1], y[j][2], y[j][3]);
            if (!isC) {
#pragma unroll
                for (int e = 0; e < 4; ++e) { uint4 w; w.x = pack2(y[0][e], y[1][e]); w.y = pack2(y[2][e], y[3][e]); w.z = pack2(y[4][e], y[5][e]); w.w = pack2(y[6][e], y[7][e]);
                    *(uint4*)(BT + ((size_t)(((b * 16 + c) * 2 + g) * 128 + n0 + e)) * 128 + tl) = w; }
            }
        }
    }
}
DI void ssd_prompt_item(const Params& P, unsigned char* L, int item) {
    const int b = item >> 4, h = item & 15, g = h >> 3;
    const int tid0 = otid(), wid = tid0 >> 6;
    bf16_t* Cs = (bf16_t*)L;
    bf16_t* Bs = Cs + 128 * 136;
    bf16_t* BsT = Bs + 128 * 136;
    bf16_t* XsT = BsT + 128 * 136;
    bf16_t* St = XsT + 64 * 136;
    float* dtv = (float*)(St + 64 * 136); float* acs = dtv + 128; float* wv = acs + 128; float* tot = wv + 128;
    const bf16_t* U = WSP(bf16_t, OFF_U); const float* DT = WSP(float, OFF_DT); bf16_t* MIX = WSP(bf16_t, OFF_MIX); float* SSB = WSP(float, OFF_SSB);
    const float a_neg = -__expf(P.in[22][h]), dtb = P.in[21][h], Dh = P.in[23][h];
    f32x16 accS;
#pragma unroll
    for (int i = 0; i < 16; ++i) accS[i] = 0.f;
    __syncthreads();
    for (int i = tid0; i < 64 * 136; i += 512) St[i] = 0;
    float dtraw = 0.f;
    if (tid0 < 128) dtraw = DT[(size_t)(b * 2048 + tid0) * 16 + h];
    for (int c = 0; c < 16; ++c) {
        const int row0 = b * 2048 + c * 128;
        __syncthreads();
        int zv = 0; asm volatile("" : "+v"(zv));
        const int tid = tid0 + zv, lane = tid & 63, hh = lane >> 5, l31 = lane & 31;
        const int prow = tid >> 4, pcol = (tid & 15) * 8;
        const float dtcur = dtraw;
        if (tid < 128 && c + 1 < 16) dtraw = DT[(size_t)(row0 + 128 + tid) * 16 + h];
        u32x4 tC[4], tB[4], tT[4], tX[2];
        {
            const size_t tb_ = ((size_t)((b * 16 + c) * 2 + g)) * 128 * 128 + (size_t)prow * 128 + pcol;
            const u32x4* pc = (const u32x4*)(WSP(bf16_t, OFF_CN) + tb_); const u32x4* pb = (const u32x4*)(WSP(bf16_t, OFF_BN) + tb_); const u32x4* pt = (const u32x4*)(WSP(bf16_t, OFF_BT) + tb_);
            const u32x4* px = (const u32x4*)(WSP(bf16_t, OFF_XT) + ((size_t)((b * 16 + c) * 1024 + h * 64 + prow)) * 128 + pcol);
#pragma unroll
            for (int i = 0; i < 4; ++i) { tC[i] = pc[i * 512]; tB[i] = pb[i * 512]; tT[i] = pt[i * 512]; }
            tX[0] = px[0]; tX[1] = px[512];
        }
        if (tid < 128) {
            const float d = softplus(dtcur + dtb);
            float v = d * a_neg;
#pragma unroll
            for (int o = 1; o < 64; o <<= 1) { const float n = __shfl_up(v, o); if (lane >= o) v += n; }
            dtv[tid] = d; acs[tid] = v; if (tid == 63) tot[0] = v;
        }
        __syncthreads();
        if (tid >= 64 && tid < 128) acs[tid] += tot[0];
        __syncthreads();
        const float a_last = acs[127];
        if (tid < 128) wv[tid] = __expf(a_last - acs[tid]) * dtv[tid];
#pragma unroll
        for (int i = 0; i < 4; ++i) {
            *(u32x4*)(Cs + (prow + 32 * i) * 136 + pcol) = tC[i]; *(u32x4*)(Bs + (prow + 32 * i) * 136 + pcol) = tB[i]; *(u32x4*)(BsT + (prow + 32 * i) * 136 + pcol) = tT[i];
        }
        *(u32x4*)(XsT + prow * 136 + pcol) = tX[0]; *(u32x4*)(XsT + (prow + 32) * 136 + pcol) = tX[1];
        bf16_t zr[16];
        {
            const unsigned zoff = (unsigned)((row0 + (wid >> 1) * 32 + 4 * hh) * N0 + 2048 + h * 64 + (wid & 1) * 32 + l31);
#pragma unroll
            for (int reg = 0; reg < 16; ++reg) zr[reg] = (U + ((reg & 3) + 8 * (reg >> 2)) * N0)[zoff];
        }
        __syncthreads();
        {
            const int rb = (wid >> 1) * 32, cb0 = (wid & 1) * 64;
            f32x16 cbA[2];
#pragma unroll
            for (int i = 0; i < 16; ++i) { cbA[0][i] = 0.f; cbA[1][i] = 0.f; }
#pragma unroll
            for (int ks = 0; ks < 8; ++ks) {
                const bf16x8 a = ldfrag(Cs, 136, rb, ks * 16, lane);
                cbA[0] = MFMA32(a, ldfrag(Bs, 136, cb0, ks * 16, lane), cbA[0]);
                cbA[1] = MFMA32(a, ldfrag(Bs, 136, cb0 + 32, ks * 16, lane), cbA[1]);
            }
            __syncthreads();
            bf16_t* Ws = Bs;
#pragma unroll
            for (int j = 0; j < 2; ++j) {
                const int s = cb0 + j * 32 + l31; const float as = acs[s], ds = dtv[s];
#pragma unroll
                for (int reg = 0; reg < 16; ++reg) {
                    const int t = rb + crow(reg, hh);
                    const float v = (s <= t) ? cbA[j][reg] * __expf(acs[t] - as) * ds : 0.f;
                    Ws[t * 136 + s] = f2bf(v);
                }
            }
        }
        __syncthreads();
        {
            const bf16_t* Ws = Bs;
            const int tb = (wid >> 1) * 32, pb = (wid & 1) * 32;
            f32x16 y;
#pragma unroll
            for (int i = 0; i < 16; ++i) y[i] = 0.f;
#pragma unroll
            for (int ks = 0; ks < 8; ++ks) y = MFMA32(ldfrag(Cs, 136, tb, ks * 16, lane), ldfrag(St, 136, pb, ks * 16, lane), y);
#pragma unroll
            for (int reg = 0; reg < 16; ++reg) y[reg] *= __expf(acs[tb + crow(reg, hh)]);
#pragma unroll
            for (int ks = 0; ks < 8; ++ks) y = MFMA32(ldfrag(Ws, 136, tb, ks * 16, lane), ldfrag(XsT, 136, pb, ks * 16, lane), y);
            __syncthreads();
            {
                bf16_t* XwT = Cs;
                const uint4 xa = *(const uint4*)(XsT + prow * 136 + pcol), xb_ = *(const uint4*)(XsT + (prow + 32) * 136 + pcol);
                const f32x4 w0 = *(const f32x4*)(wv + pcol), w1 = *(const f32x4*)(wv + pcol + 4);
                uint4 oa, ob;
                oa.x = pack2(bflo(xa.x) * w0[0], bfhi(xa.x) * w0[1]); oa.y = pack2(bflo(xa.y) * w0[2], bfhi(xa.y) * w0[3]); oa.z = pack2(bflo(xa.z) * w1[0], bfhi(xa.z) * w1[1]); oa.w = pack2(bflo(xa.w) * w1[2], bfhi(xa.w) * w1[3]);
                ob.x = pack2(bflo(xb_.x) * w0[0], bfhi(xb_.x) * w0[1]); ob.y = pack2(bflo(xb_.y) * w0[2], bfhi(xb_.y) * w0[3]); ob.z = pack2(bflo(xb_.z) * w1[0], bfhi(xb_.z) * w1[1]); ob.w = pack2(bflo(xb_.w) * w1[2], bfhi(xb_.w) * w1[3]);
                *(uint4*)(XwT + prow * 136 + pcol) = oa; *(uint4*)(XwT + (prow + 32) * 136 + pcol) = ob;
            }
            const int p = pb + l31, ch = h * 64 + p; const float nwv = P.in[24][ch];
#pragma unroll
            for (int reg = 0; reg < 16; ++reg) {
                const int t = tb + crow(reg, hh); const size_t row = (size_t)(row0 + t);
                const float xv = bf2f(XsT[p * 136 + t]); const float z = bf2f(zr[reg]);
                const float yy = (y[reg] + Dh * xv) * silu(z);
                float ss = yy * yy;
                ss += __shfl_xor(ss, 1); ss += __shfl_xor(ss, 2); ss += __shfl_xor(ss, 4); ss += __shfl_xor(ss, 8); ss += __shfl_xor(ss, 16);
                if (l31 == 0) atomicAdd(SSB + row * 2 + g, ss);
                MIX[row * 2048 + 1024 + ch] = f2bf(yy * nwv);
            }
            __syncthreads();
            const int pb2 = (wid >> 2) * 32, nb = (wid & 3) * 32;
            const float ea = __expf(a_last);
#pragma unroll
            for (int reg = 0; reg < 16; ++reg) accS[reg] *= ea;
#pragma unroll
            for (int ks = 0; ks < 8; ++ks) accS = MFMA32(ldfrag(Cs, 136, pb2, ks * 16, lane), ldfrag(BsT, 136, nb, ks * 16, lane), accS);
#pragma unroll
            for (int reg = 0; reg < 16; ++reg) St[(pb2 + crow(reg, hh)) * 136 + nb + l31] = f2bf(accS[reg]);
        }
    }
    {
        const int lane = tid0 & 63, hh = lane >> 5, l31 = lane & 31;
        const int pb2 = (wid >> 2) * 32, nb = (wid & 3) * 32;
        float* o = P.out + O_BSP + (size_t)(b * 16 + h) * 64 * 128;
#pragma unroll
        for (int reg = 0; reg < 16; ++reg) o[(pb2 + crow(reg, hh)) * 128 + nb + l31] = accS[reg];
    }
}
DI void ssd_sample_item(const Params& P, unsigned char* L, int item) {
    const int b = item >> 4, h = item & 15, g = h >> 3, tid = otid(), lane = tid & 63;
    float* xs = (float*)L; float* Bv = xs + 64; float* Cv = Bv + 128; float* yv = Cv + 128;
    const bf16_t* U = WSP(bf16_t, OFF_U); bf16_t* MIX = WSP(bf16_t, OFF_MIX); float* SSB = WSP(float, OFF_SSB);
    const size_t row = (size_t)(MP + b);
    __syncthreads();
    if (tid < 320) {
        int cc; if (tid < 64) cc = h * 64 + tid; else if (tid < 192) cc = 1024 + g * 128 + (tid - 64); else cc = 1280 + g * 128 + (tid - 192);
        const float* buf = P.in[7] + (size_t)b * 3 * 1536 + cc;
        const float v = P.in[20][cc] + P.in[19][cc] * buf[0] + P.in[19][1536 + cc] * buf[1536] + P.in[19][2 * 1536 + cc] * buf[2 * 1536] + P.in[19][3 * 1536 + cc] * bf2f(U[row * N0 + 3072 + cc]);
        xs[tid] = silu(v);
    }
    const float dt = softplus(WSP(float, OFF_DT)[row * 16 + h] + P.in[21][h]);
    const float dA = __expf(-dt * __expf(P.in[22][h]));
    __syncthreads();
    const float* s0 = P.in[6] + (size_t)(b * 16 + h) * 64 * 128; float* s1 = P.out + O_BSS + (size_t)(b * 16 + h) * 64 * 128;
    const int n4 = (tid & 31) * 4;
    const f32x4 Bq = *(const f32x4*)(Bv + n4), Cq = *(const f32x4*)(Cv + n4);
#pragma unroll
    for (int j = 0; j < 4; ++j) {
        const int p = (tid >> 5) + 16 * j;
        const f32x4 s = *(const f32x4*)(s0 + p * 128 + n4);
        const float dx = dt * xs[p];
        const f32x4 sn = s * dA + Bq * dx;
        *(f32x4*)(s1 + p * 128 + n4) = sn;
        float yp = sn[0] * Cq[0] + sn[1] * Cq[1] + sn[2] * Cq[2] + sn[3] * Cq[3];
        yp += __shfl_xor(yp, 1); yp += __shfl_xor(yp, 2); yp += __shfl_xor(yp, 4); yp += __shfl_xor(yp, 8); yp += __shfl_xor(yp, 16);
        if ((tid & 31) == 0) yv[p] = yp;
    }
    __syncthreads();
    if (tid < 64) {
        const int ch = h * 64 + tid;
        const float yy = (yv[tid] + P.in[23][h] * xs[tid]) * silu(bf2f(U[row * N0 + 2048 + ch]));
        const float ss = wave_sum(yy * yy);
        if (lane == 0) atomicAdd(SSB + row * 2 + g, ss);
        MIX[row * 2048 + 1024 + ch] = f2bf(yy * P.in[24][ch]);
    }
}
template <bool SAMPLE>
DI void rglru_item(const Params& P, unsigned char* L, int item) {
    const int tid0 = otid(), wid = tid0 >> 6;
    const int b = SAMPLE ? 0 : (item >> 4), k = (item >> 1) & 7, dh = item & 1;
    bf16_t* Xs = (bf16_t*)L;
    bf16_t* Wg = Xs + 128 * 136;
    float* Aa = (float*)(Wg + 128 * 136);
    float* Uu = Aa + 128 * 64; float* segA = Uu + 128 * 64; float* segH = segA + 512; float* hc = segH + 512;
    const bf16_t* U = WSP(bf16_t, OFF_U); bf16_t* MIX = WSP(bf16_t, OFF_MIX);
    __syncthreads();
    {
        const bf16_t* WRT = WSP(bf16_t, OFF_WRT); const bf16_t* WIT = WSP(bf16_t, OFF_WIT);
#pragma unroll
        for (int i = 0; i < 4; ++i) {
            const int chk = tid0 + i * 512, r = chk >> 4, c8 = (chk & 15) * 8;
            const bf16_t* src = (r < 64 ? WRT + (size_t)(dh * 64 + r) * 1024 : WIT + (size_t)(dh * 64 + r - 64) * 1024) + k * 128 + c8;
            *(u32x4*)(Wg + r * 136 + c8) = *(const u32x4*)src;
        }
        if (tid0 < 64) hc[tid0] = 0.f;
    }
    float sp[4], br[4], bi[4];
#pragma unroll
    for (int ct = 0; ct < 4; ++ct) { const int chd = k * 128 + dh * 64 + ct * 16 + (tid0 & 15); sp[ct] = softplus(-P.in[18][chd]); br[ct] = P.in[15][chd]; bi[ct] = P.in[17][chd]; }
    const int ch0 = k * 128 + (tid0 & 31) * 4;
    float cw[4][4], cbias[4];
#pragma unroll
    for (int kk = 0; kk < 4; ++kk)
#pragma unroll
        for (int e = 0; e < 4; ++e) cw[kk][e] = P.in[12][kk * 1024 + ch0 + e];
#pragma unroll
    for (int e = 0; e < 4; ++e) cbias[e] = P.in[13][ch0 + e];
    u32x2 raw[11];
#define RG_LOAD(tl_) do { const int tg_ = (tl_) * 128 + (tid0 >> 5) * 8; const unsigned vo_ = (unsigned)((b * 2048 + tg_) * N0 + ch0); \
        _Pragma("unroll") for (int j = 0; j < 11; ++j) raw[j] = (tg_ + j - 3 >= 0) ? *(const u32x2*)((U + (j - 3) * N0) + vo_) : (u32x2){0u, 0u}; } while (0)
    if (!SAMPLE) RG_LOAD(0);
    const int ntiles = SAMPLE ? 1 : 16;
    for (int tile = 0; tile < ntiles; ++tile) {
        const int row0 = SAMPLE ? MP : b * 2048 + tile * 128;
        __syncthreads();
        int zv = 0; asm volatile("" : "+v"(zv));
        const int tid = tid0 + zv, lane = tid & 63, quad = tid & 31, seg = tid >> 5;
        const int sd = tid & 63, sseg = wid, sch = k * 128 + dh * 64 + sd;
        bf16_t gt[16];
        if (!SAMPLE) {
            const unsigned goff = (unsigned)((row0 + sseg * 16) * N0 + 1024 + sch);
#pragma unroll
            for (int t = 0; t < 16; ++t) gt[t] = (U + t * N0)[goff];
        }
        if (SAMPLE) {
#pragma unroll
            for (int t = 0; t < 8; ++t) {
                const int bb = seg * 8 + t;
                const float* buf = P.in[5] + (size_t)bb * 3 * 1024 + ch0;
                const f32x4 p0 = *(const f32x4*)buf, p1 = *(const f32x4*)(buf + 1024), p2 = *(const f32x4*)(buf + 2048);
                float cur[4]; ld4bf(U + (size_t)(MP + bb) * N0 + ch0, cur);
                float y[4];
#pragma unroll
                for (int e = 0; e < 4; ++e) y[e] = cbias[e] + cw[0][e] * p0[e] + cw[1][e] * p1[e] + cw[2][e] * p2[e] + cw[3][e] * cur[e];
                *(u32x2*)(Xs + bb * 136 + quad * 4) = pack4v(y[0], y[1], y[2], y[3]);
            }
        } else {
#pragma unroll
            for (int j = 0; j < 8; ++j) {
                const float x0[4] = {bflo(raw[j].x), bfhi(raw[j].x), bflo(raw[j].y), bfhi(raw[j].y)};
                const float x1[4] = {bflo(raw[j + 1].x), bfhi(raw[j + 1].x), bflo(raw[j + 1].y), bfhi(raw[j + 1].y)};
                const float x2[4] = {bflo(raw[j + 2].x), bfhi(raw[j + 2].x), bflo(raw[j + 2].y), bfhi(raw[j + 2].y)};
                const float x3[4] = {bflo(raw[j + 3].x), bfhi(raw[j + 3].x), bflo(raw[j + 3].y), bfhi(raw[j + 3].y)};
                float y[4];
#pragma unroll
                for (int e = 0; e < 4; ++e) y[e] = cbias[e] + cw[0][e] * x0[e] + cw[1][e] * x1[e] + cw[2][e] * x2[e] + cw[3][e] * x3[e];
                *(u32x2*)(Xs + (seg * 8 + j) * 136 + quad * 4) = pack4v(y[0], y[1], y[2], y[3]);
            }
            if (tile + 1 < 16) RG_LOAD(tile + 1);
        }
        __syncthreads();
        {
            f32x4 acc[8];
#pragma unroll
            for (int i = 0; i < 8; ++i) acc[i] = (f32x4){0.f, 0.f, 0.f, 0.f};
#pragma unroll
            for (int ks = 0; ks < 4; ++ks) {
                const bf16x8 a = ldfrag16(Xs, 136, wid * 16, ks * 32, lane);
#pragma unroll
                for (int tl = 0; tl < 8; ++tl) acc[tl] = MFMA16(a, ldfrag16(Wg, 136, tl * 16, ks * 32, lane), acc[tl]);
            }
#pragma unroll
            for (int ct = 0; ct < 4; ++ct)
#pragma unroll
                for (int reg = 0; reg < 4; ++reg) {
                    const int t = wid * 16 + (lane >> 4) * 4 + reg, d = ct * 16 + (lane & 15);
                    const float r = sigm(acc[ct][reg] + br[ct]), gi = sigm(acc[4 + ct][reg] + bi[ct]);
                    const float a = __expf(-8.f * r * sp[ct]);
                    const float uu = __builtin_amdgcn_sqrtf(fmaxf(1.f - a * a, 0.f)) * gi * bf2f(Xs[t * 136 + dh * 64 + d]);
                    if (SAMPLE) {
                        const int chd = k * 128 + dh * 64 + d;
                        const float hn = a * P.in[4][(size_t)t * 1024 + chd] + uu;
                        P.out[O_AHS + (size_t)t * 1024 + chd] = hn;
                        const float gv = bf2f(U[(size_t)(MP + t) * N0 + 1024 + chd]);
                        MIX[(size_t)(MP + t) * 2048 + chd] = f2bf(hn * silu(gv));
                    } else { Aa[t * 64 + d] = a; Uu[t * 64 + d] = uu; }
                }
        }
        if (!SAMPLE) {
            __syncthreads();
            float av[16], uv[16], Ap = 1.f, Hp = 0.f;
#pragma unroll
            for (int t = 0; t < 16; ++t) { av[t] = Aa[(sseg * 16 + t) * 64 + sd]; uv[t] = Uu[(sseg * 16 + t) * 64 + sd]; Hp = av[t] * Hp + uv[t]; Ap *= av[t]; }
            segA[sseg * 64 + sd] = Ap; segH[sseg * 64 + sd] = Hp;
            __syncthreads();
            float hin = hc[sd];
            for (int s2 = 0; s2 < sseg; ++s2) hin = segA[s2 * 64 + sd] * hin + segH[s2 * 64 + sd];
            const unsigned moff = (unsigned)((row0 + sseg * 16) * 2048 + sch);
#pragma unroll
            for (int t = 0; t < 16; ++t) {
                hin = av[t] * hin + uv[t];
                (MIX + t * 2048)[moff] = f2bf(hin * silu(bf2f(gt[t])));
            }
            __syncthreads();
            if (sseg == 7) hc[sd] = hin;
        }
    }
#undef RG_LOAD
    if (!SAMPLE) { __syncthreads(); if (tid0 < 64) P.out[O_AHP + (size_t)b * 1024 + k * 128 + dh * 64 + tid0] = hc[tid0]; }
}
DI void phase_mix0(const Params& P, unsigned char* L) {
    const int tid = otid(), bid = blockIdx.x, G = gridDim.x;
    { const bf16_t* U = WSP(bf16_t, OFF_U);
      for (int i = bid * 512 + tid; i < 8 * 3 * 1024; i += G * 512) { const int c = i & 1023, j = (i >> 10) % 3, b = i / 3072; P.out[O_ACP + i] = bf2f(U[(size_t)(b * 2048 + 2045 + j) * N0 + c]); }
      for (int i = bid * 512 + tid; i < 8 * 3 * 1536; i += G * 512) { const int c = i % 1536, j = (i / 1536) % 3, b = i / 4608; P.out[O_BCP + i] = bf2f(U[(size_t)(b * 2048 + 2045 + j) * N0 + 3072 + c]); }
      for (int i = bid * 512 + tid; i < 128 * 3 * 1024; i += G * 512) { const int c = i & 1023, j = (i >> 10) % 3, b = i / 3072; P.out[O_ACS + i] = j < 2 ? P.in[5][(size_t)(b * 3 + j + 1) * 1024 + c] : bf2f(U[(size_t)(MP + b) * N0 + c]); }
      for (int i = bid * 512 + tid; i < 128 * 3 * 1536; i += G * 512) { const int c = i % 1536, j = (i / 1536) % 3, b = i / 4608; P.out[O_BCS + i] = j < 2 ? P.in[7][(size_t)(b * 3 + j + 1) * 1536 + c] : bf2f(U[(size_t)(MP + b) * N0 + 3072 + c]); } }
    if (bid < 128) rglru_item<false>(P, L, bid); else if (bid < 256) ssd_prompt_item(P, L, bid - 128);
    for (int it = bid; it < 16; it += G) rglru_item<true>(P, L, it);
    for (int it = (bid + 128) % G; it < 2048; it += G) ssd_sample_item(P, L, it);
}
DI void phase_norm0(const Params& P) {
    bf16_t* MIX = WSP(bf16_t, OFF_MIX); const float* SSB = WSP(float, OFF_SSB);
    for (int i = blockIdx.x * 512 + threadIdx.x; i < MV * 128; i += gridDim.x * 512) {
        const int row = i >> 7, c8 = (i & 127) * 8, g = c8 >> 9;
        const float sc = rsqrtf(SSB[(size_t)row * 2 + g] * (1.f / 512.f) + EPSF);
        uint4* p = (uint4*)(MIX + (size_t)row * 2048 + 1024 + c8); uint4 w = *p;
        w.x = pack2(bflo(w.x) * sc, bfhi(w.x) * sc); w.y = pack2(bflo(w.y) * sc, bfhi(w.y) * sc); w.z = pack2(bflo(w.z) * sc, bfhi(w.z) * sc); w.w = pack2(bflo(w.w) * sc, bfhi(w.w) * sc);
        *p = w;
    }
}

DI void hgrn_prompt_item(const Params& P, unsigned char* L, int item) {
    const int b = item >> 4, h = item & 15;
    const int tid = otid(), lane = tid & 63, wid = tid >> 6, hh = lane >> 5, l31 = lane & 31;
    bf16_t* Qs = (bf16_t*)L;
    bf16_t* Ks = Qs + 64 * 136;
    float* Of = (float*)L;
    bf16_t* KsT = Ks + 64 * 136;
    bf16_t* VsT = KsT + 128 * 72;
    bf16_t* SsT = VsT + 128 * 72;
    bf16_t* As = SsT + 128 * 136;
    float* Gseg = (float*)(As + 64 * 72);
    float* E1 = Gseg + 16 * 128; float* E2 = E1 + 128;
    const bf16_t* U = WSP(bf16_t, OFF_U); bf16_t* MIX = WSP(bf16_t, OFF_MIX);
    const int kq = tid & 31, ts = tid >> 5;
    float lb[4];
#pragma unroll
    for (int e = 0; e < 4; ++e) { const int ch = h * 128 + kq * 4 + e; lb[e] = sigm(P.in[27][2048 + ch] - P.in[27][ch]); }
    const int kb = (wid >> 1) * 32, vb0 = (wid & 1) * 64;
    f32x16 accS[2];
#pragma unroll
    for (int i = 0; i < 16; ++i) { accS[0][i] = 0.f; accS[1][i] = 0.f; }
    uint2 rq[4], rf[4], rv[4];
#define HG_LOAD(cc) do { _Pragma("unroll") for (int i = 0; i < 4; ++i) { const bf16_t* bp = U + (size_t)(b * 2048 + (cc) * 64 + ts * 4 + i) * INC + h * 128 + kq * 4; \
        rq[i] = *(const uint2*)bp; rf[i] = *(const uint2*)(bp + 2048); rv[i] = *(const uint2*)(bp + 4096); } } while (0)
    HG_LOAD(0);
    __syncthreads();
    for (int c = 0; c < 32; ++c) {
        float kk[4][4], cs[4][4];
#pragma unroll
        for (int i = 0; i < 4; ++i) {
            const float fx[4] = {bflo(rf[i].x), bfhi(rf[i].x), bflo(rf[i].y), bfhi(rf[i].y)};
#pragma unroll
            for (int e = 0; e < 4; ++e) {
                const float sg = sigm(fx[e]); const float kv = (1.f - lb[e]) * (1.f - sg);
                kk[i][e] = kv; const float gl = __logf(1.f - kv);
                cs[i][e] = (i == 0 ? 0.f : cs[i - 1][e]) + gl;
            }
        }
        *(f32x4*)(Gseg + ts * 128 + kq * 4) = (f32x4){cs[3][0], cs[3][1], cs[3][2], cs[3][3]};
        __syncthreads();
        f32x4 off = {0.f, 0.f, 0.f, 0.f}, gmid = off, glast = off;
#pragma unroll
        for (int s = 0; s < 16; ++s) { const f32x4 v = *(const f32x4*)(Gseg + s * 128 + kq * 4); if (s < ts) off += v; if (s < 8) gmid += v; glast += v; }
        {
            float qt[4][4], kt[4][4], vt[4][4];
#pragma unroll
            for (int i = 0; i < 4; ++i) {
                const float q[4] = {bflo(rq[i].x), bfhi(rq[i].x), bflo(rq[i].y), bfhi(rq[i].y)};
                vt[i][0] = bflo(rv[i].x); vt[i][1] = bfhi(rv[i].x); vt[i][2] = bflo(rv[i].y); vt[i][3] = bfhi(rv[i].y);
#pragma unroll
                for (int e = 0; e < 4; ++e) { const float Gv = off[e] + cs[i][e]; qt[i][e] = q[e] * 0.08838834764831845f * __expf(Gv - gmid[e]); kt[i][e] = kk[i][e] * __expf(gmid[e] - Gv); }
                *(uint2*)(Qs + (ts * 4 + i) * 136 + kq * 4) = pack4(qt[i][0], qt[i][1], qt[i][2], qt[i][3]);
                *(uint2*)(Ks + (ts * 4 + i) * 136 + kq * 4) = pack4(kt[i][0], kt[i][1], kt[i][2], kt[i][3]);
            }
#pragma unroll
            for (int e = 0; e < 4; ++e) {
                *(uint2*)(KsT + (kq * 4 + e) * 72 + ts * 4) = pack4(kt[0][e], kt[1][e], kt[2][e], kt[3][e]);
                *(uint2*)(VsT + (kq * 4 + e) * 72 + ts * 4) = pack4(vt[0][e], vt[1][e], vt[2][e], vt[3][e]);
            }
            if (ts == 0) {
#pragma unroll
                for (int e = 0; e < 4; ++e) { E1[kq * 4 + e] = __expf(gmid[e]); E2[kq * 4 + e] = __expf(glast[e] - gmid[e]); }
            }
        }
        if (c + 1 < 32) HG_LOAD(c + 1);
        __syncthreads();
#pragma unroll
        for (int j = 0; j < 2; ++j) {
#pragma unroll
            for (int reg = 0; reg < 16; ++reg) accS[j][reg] *= E1[kb + crow(reg, hh)];
            const int v = vb0 + j * 32 + l31;
#pragma unroll
            for (int rg = 0; rg < 4; ++rg) *(uint2*)(SsT + v * 136 + kb + 8 * rg + 4 * hh) = pack4(accS[j][4 * rg], accS[j][4 * rg + 1], accS[j][4 * rg + 2], accS[j][4 * rg + 3]);
        }
        if (wid < 4) {
            const int tb = (wid >> 1) * 32, sb = (wid & 1) * 32;
            f32x16 aa;
#pragma unroll
            for (int i = 0; i < 16; ++i) aa[i] = 0.f;
#pragma unroll
            for (int ks = 0; ks < 8; ++ks) aa = MFMA32(ldfrag(Qs, 136, tb, ks * 16, lane), ldfrag(Ks, 136, sb, ks * 16, lane), aa);
            const int s = sb + l31;
#pragma unroll
            for (int reg = 0; reg < 16; ++reg) { const int t = tb + crow(reg, hh); As[t * 72 + s] = f2bf(s <= t ? aa[reg] : 0.f); }
        }
        __syncthreads();
        const int tb2 = (wid >> 2) * 32, vb2 = (wid & 3) * 32;
        f32x16 o;
#pragma unroll
        for (int i = 0; i < 16; ++i) o[i] = 0.f;
#pragma unroll
        for (int ks = 0; ks < 8; ++ks) o = MFMA32(ldfrag(Qs, 136, tb2, ks * 16, lane), ldfrag(SsT, 136, vb2, ks * 16, lane), o);
#pragma unroll
        for (int ks = 0; ks < 4; ++ks) o = MFMA32(ldfrag(As, 72, tb2, ks * 16, lane), ldfrag(VsT, 72, vb2, ks * 16, lane), o);
#pragma unroll
        for (int j = 0; j < 2; ++j) {
#pragma unroll
            for (int ks = 0; ks < 4; ++ks) accS[j] = MFMA32(ldfrag(KsT, 72, kb, ks * 16, lane), ldfrag(VsT, 72, vb0 + j * 32, ks * 16, lane), accS[j]);
#pragma unroll
            for (int reg = 0; reg < 16; ++reg) accS[j][reg] *= E2[kb + crow(reg, hh)];
        }
        __syncthreads();
#pragma unroll
        for (int reg = 0; reg < 16; ++reg) Of[(tb2 + crow(reg, hh)) * 132 + vb2 + l31] = o[reg];
        __syncthreads();
        {
            const int t = tid >> 3, vs = tid & 7;
            const size_t row = (size_t)(b * 2048 + c * 64 + t);
            f32x4 ov[4]; float ss = 0.f;
#pragma unroll
            for (int i = 0; i < 4; ++i) { ov[i] = *(const f32x4*)(Of + t * 132 + vs * 16 + i * 4); ss += ov[i][0] * ov[i][0] + ov[i][1] * ov[i][1] + ov[i][2] * ov[i][2] + ov[i][3] * ov[i][3]; }
            ss += __shfl_xor(ss, 1); ss += __shfl_xor(ss, 2); ss += __shfl_xor(ss, 4);
            const float rstd = rsqrtf(ss * (1.f / 128.f) + EPSF);
            const bf16_t* gp = U + row * INC + 6144 + h * 128 + vs * 16; const float* nwp = P.in[28] + h * 128 + vs * 16;
            const uint4 g0 = *(const uint4*)gp, g1 = *(const uint4*)(gp + 8);
            const unsigned gw[8] = {g0.x, g0.y, g0.z, g0.w, g1.x, g1.y, g1.z, g1.w};
            unsigned ow[8];
#pragma unroll
            for (int i = 0; i < 4; ++i) {
                const f32x4 w = *(const f32x4*)(nwp + i * 4);
                ow[2 * i] = pack2(ov[i][0] * rstd * w[0] * silu(bflo(gw[2 * i])), ov[i][1] * rstd * w[1] * silu(bfhi(gw[2 * i])));
                ow[2 * i + 1] = pack2(ov[i][2] * rstd * w[2] * silu(bflo(gw[2 * i + 1])), ov[i][3] * rstd * w[3] * silu(bfhi(gw[2 * i + 1])));
            }
            bf16_t* op = MIX + row * 2048 + h * 128 + vs * 16;
            *(uint4*)op = make_uint4(ow[0], ow[1], ow[2], ow[3]); *(uint4*)(op + 8) = make_uint4(ow[4], ow[5], ow[6], ow[7]);
        }
        __syncthreads();
    }
#undef HG_LOAD
    float* so = P.out + O_CP + (size_t)(b * 16 + h) * 128 * 128;
#pragma unroll
    for (int j = 0; j < 2; ++j)
#pragma unroll
        for (int reg = 0; reg < 16; ++reg) so[(kb + crow(reg, hh)) * 128 + vb0 + j * 32 + l31] = accS[j][reg];
}
DI void hgrn_sample_item(const Params& P, unsigned char* L, int item) {
    const int b = item >> 4, h = item & 15, tid = otid(), lane = tid & 63;
    float* qv = (float*)L; float* egv = qv + 128; float* kkv = egv + 128; float* vv = kkv + 128; float* part = vv + 128; float* red = part + 16 * 128;
    const bf16_t* U = WSP(bf16_t, OFF_U); bf16_t* MIX = WSP(bf16_t, OFF_MIX);
    const size_t row = (size_t)(MP + b); const bf16_t* ub = U + row * INC + h * 128;
    __syncthreads();
    if (tid < 128) {
        const int ch = h * 128 + tid;
        const float lbv = sigm(P.in[27][2048 + ch] - P.in[27][ch]);
        const float sg = sigm(bf2f(ub[2048 + tid])); const float kv = (1.f - lbv) * (1.f - sg);
        qv[tid] = bf2f(ub[tid]) * 0.08838834764831845f; egv[tid] = 1.f - kv; kkv[tid] = kv;
    } else if (tid < 256) vv[tid - 128] = bf2f(ub[4096 + tid - 128]);
    __syncthreads();
    const float* s0 = P.in[8] + (size_t)(b * 16 + h) * 128 * 128; float* s1 = P.out + O_CS + (size_t)(b * 16 + h) * 128 * 128;
    const int v4 = (tid & 31) * 4; const f32x4 vq = *(const f32x4*)(vv + v4);
    f32x4 op = {0.f, 0.f, 0.f, 0.f};
#pragma unroll
    for (int j = 0; j < 8; ++j) {
        const int k = (tid >> 5) + 16 * j;
        const f32x4 s = *(const f32x4*)(s0 + k * 128 + v4);
        const f32x4 sn = s * egv[k] + vq * kkv[k];
        *(f32x4*)(s1 + k * 128 + v4) = sn;
        op += sn * qv[k];
    }
    *(f32x4*)(part + (tid >> 5) * 128 + v4) = op;
    __syncthreads();
    float o = 0.f;
    if (tid < 128) {
#pragma unroll
        for (int i = 0; i < 16; ++i) o += part[i * 128 + tid];
        const float ss = wave_sum(o * o);
        if (lane == 0) red[tid >> 6] = ss;
    }
    __syncthreads();
    if (tid < 128) {
        const float rstd = rsqrtf((red[0] + red[1]) * (1.f / 128.f) + EPSF);
        const int ch = h * 128 + tid;
        MIX[row * 2048 + ch] = f2bf(o * rstd * P.in[28][ch] * silu(bf2f(ub[6144 + tid])));
    }
}
DI void phase_mix1(const Params& P, unsigned char* L) {
    const int tid = otid(), bid = blockIdx.x;
    if (bid < 128) hgrn_prompt_item(P, L, bid);
    else { const int nb = gridDim.x - 128; for (int it = bid - 128; it < 2048; it += nb) hgrn_sample_item(P, L, it); }
}
DI void phase_final(const Params& P) {
    const int lane = threadIdx.x & 63, gw = blockIdx.x * 8 + (threadIdx.x >> 6), nwv = gridDim.x * 8;
    const float* H = WSP(float, OFF_H); const float* SS = WSP(float, OFF_SS2); const float* nf = P.in[10];
    f32x4 w4[4];
#pragma unroll
    for (int i = 0; i < 4; ++i) w4[i] = *(const f32x4*)(nf + lane * 4 + 256 * i);
    for (int r = gw; r < MV; r += nwv) {
        const float rstd = rsqrtf(SS[r] * (1.f / 1024.f) + EPSF);
#pragma unroll
        for (int i = 0; i < 4; ++i) { const f32x4 v = *(const f32x4*)(H + (size_t)r * 1024 + lane * 4 + 256 * i); *(f32x4*)(P.out + O_Y + (size_t)r * 1024 + lane * 4 + 256 * i) = v * rstd * w4[i]; }
    }
}

#define XB_TMO      128
#define XB_XCNT(j)  (256  + 64 * (j))
#define XB_XSUB(j)  (1280 + 64 * (j))
#define XB_XGEN(j)  (2304 + 64 * (j))
#define XB_TOP      3328
#define XB_TOPGEN   3392
#define XCD_BAR_WORDS 3456
#define XB_SPIN_CAP (1u << 18)

__device__ __forceinline__ unsigned xb_ld(unsigned* p)              { return __hip_atomic_load(p, __ATOMIC_RELAXED, __HIP_MEMORY_SCOPE_AGENT); }
__device__ __forceinline__ unsigned xb_add(unsigned* p, unsigned v) { return __hip_atomic_fetch_add(p, v, __ATOMIC_RELAXED, __HIP_MEMORY_SCOPE_AGENT); }
__device__ __forceinline__ unsigned xb_xcc_id() { return (unsigned)__builtin_amdgcn_s_getreg((3 << 11) | 20) & 0xFu; }
#define XB_SPIN(cond, bar) do { unsigned _sp = 0; while (cond) { __builtin_amdgcn_s_sleep(1); \
    if ((++_sp & 255u) == 0u) { if (xb_ld(&(bar)[XB_TMO])) break; if (_sp > XB_SPIN_CAP) { atomicAdd(&(bar)[XB_TMO], 1u); break; } } } } while (0)

struct XcdBarrier {
    unsigned* bar; unsigned x;
    volatile LAS unsigned* st;
};

__device__ __forceinline__ XcdBarrier xcd_barrier_post(unsigned* bar, volatile LAS unsigned* st) {
    XcdBarrier b; b.bar = bar; b.x = xb_xcc_id(); b.st = st;
    if (threadIdx.x == 0) (void)xb_add(&bar[XB_XCNT(b.x)], 1u);
    return b;
}
__device__ __forceinline__ void xcd_barrier_complete(unsigned* bar, unsigned x, unsigned& nloc, unsigned& nx) {
    const unsigned G = gridDim.x * gridDim.y * gridDim.z;
    unsigned sum, cnt, mine, sp = 0u;
    for (;;) {
        sum = 0u; cnt = 0u; mine = 0u;
#pragma unroll
        for (unsigned j = 0; j < 16; ++j) { const unsigned c = xb_ld(&bar[XB_XCNT(j)]); sum += c; cnt += (c > 0u) ? 1u : 0u; mine = (j == x) ? c : mine; }
        if (sum == G) break;
        __builtin_amdgcn_s_sleep(1);
        if ((++sp & 255u) == 0u) { if (xb_ld(&bar[XB_TMO])) break; if (sp > XB_SPIN_CAP) { atomicAdd(&bar[XB_TMO], 1u); break; } }
    }
    nloc = mine > 0u ? mine : 1u; nx = cnt > 0u ? cnt : 1u;
}

__device__ __forceinline__ void xcd_barrier(const XcdBarrier& b) {
    asm volatile("s_waitcnt vmcnt(0)" ::: "memory");
    __syncthreads();
    if (threadIdx.x == 0) {
        unsigned* bar = b.bar;
        __builtin_amdgcn_s_waitcnt(0);
        unsigned nloc = b.st[0], nx = b.st[1];
        if (nloc == 0u) { xcd_barrier_complete(bar, b.x, nloc, nx); b.st[0] = nloc; b.st[1] = nx; }
        const unsigned old = xb_add(&bar[XB_XSUB(b.x)], 1u);
        const unsigned gen = old / nloc;
        if (old + 1u == (gen + 1u) * nloc) {
            __builtin_amdgcn_fence(__ATOMIC_RELEASE, "agent");
            asm volatile("s_waitcnt vmcnt(0)" ::: "memory");
            const unsigned og = xb_add(&bar[XB_TOP], 1u);
            const unsigned tg = og / nx;
            if (og + 1u == (tg + 1u) * nx) xb_add(&bar[XB_TOPGEN], 1u);
            else XB_SPIN(xb_ld(&bar[XB_TOPGEN]) == tg, bar);
            __builtin_amdgcn_fence(__ATOMIC_ACQUIRE, "agent");
            xb_add(&bar[XB_XGEN(b.x)], 1u);
            asm volatile("s_waitcnt vmcnt(0)" ::: "memory");
        } else {
            XB_SPIN(xb_ld(&bar[XB_XGEN(b.x)]) == gen, bar);
            __builtin_amdgcn_fence(__ATOMIC_ACQUIRE, "agent");
            asm volatile("s_waitcnt vmcnt(0)" ::: "memory");
        }
    }
    __syncthreads();
}


#ifndef PHM
#define PHM 0xFFFF
#endif
typedef const __attribute__((address_space(4))) Params* ParamsK;
DI Params getp() {
    ParamsK pp = (ParamsK)__builtin_amdgcn_kernarg_segment_ptr(); asm volatile("" : "+s"(pp));
    Params P;
#pragma unroll
    for (int i = 0; i < 32; ++i) P.in[i] = pp->in[i];
    P.out = pp->out; P.ws = pp->ws; return P;
}
#define GETP() const Params P = getp()
__global__ void __launch_bounds__(512, 2) fwd_kernel(Params Parg) {
    extern __shared__ __attribute__((aligned(16))) unsigned char lds[];
    cg::grid_group grid = cg::this_grid();
    unsigned char* L = (unsigned char*)lds;
    LAS unsigned char* LL = (LAS unsigned char*)lds;
    volatile LAS unsigned* xst = (volatile LAS unsigned*)(LL + LDS_BYTES - 32);
    if (threadIdx.x < 2) xst[threadIdx.x] = 0u;
    __syncthreads();
    XcdBarrier xb;
    { GETP(); xb = xcd_barrier_post(WSP(unsigned, OFF_BAR), xst); }
    if (PHM & 1) { GETP(); phase_prep(P, L); }
    grid.sync();
    if (PHM & 2) { GETP(); pg8::StaticOrder S; S.init(MP, N0 + 256, gridDim.x, blockIdx.x); pg8::Gemm g{WSP(bf16_t, OFF_XN), WSP(bf16_t, OFF_W0T), MP, N0 + 256, 1024};
      EpiStoreBf16 E{WSP(bf16_t, OFF_U), N0, nullptr, WSP(float, OFF_DT)}; pg8::gemm_phase(LL, g, S, E); }
    { GETP(); SfU f{WSP(bf16_t, OFF_U), N0, nullptr, WSP(float, OFF_DT)}; sgemm(WSP(bf16_t, OFF_XN), WSP(bf16_t, OFF_W0T), 1024, 145, 64 * 19, f); }
    xcd_barrier(xb);
    { GETP(); phase_convbc(P); }
    xcd_barrier(xb);
    if (PHM & 4) { GETP(); phase_mix0(P, L); }
    xcd_barrier(xb);
    { GETP(); phase_norm0(P); }
    xcd_barrier(xb);
    { GETP(); convert_p(P, 0); }
    __syncthreads();
    if (PHM & 8) { GETP(); pg8::StaticOrder S; S.init(MP, 1024, gridDim.x, blockIdx.x); pg8::Gemm g{WSP(bf16_t, OFF_MIX), WSP(bf16_t, OFF_WO0T), MP, 1024, 2048};
      EpiResid E{P.in[0], P.in[1], WSP(float, OFF_H), WSP(bf16_t, OFF_HB)}; pg8::gemm_phase(LL, g, S, E); }
    { GETP(); SfResid f{P.in[1], WSP(float, OFF_H), WSP(bf16_t, OFF_HB)}; sgemm(WSP(bf16_t, OFF_MIX), WSP(bf16_t, OFF_WO0T), 2048, 32, 256, f); }
    xcd_barrier(xb);
    if (PHM & 16) { GETP(); pg8::StaticOrder S; S.init(MP, 1024, gridDim.x, blockIdx.x);
      pg8::Gemm g1{WSP(bf16_t, OFF_HB), WSP(bf16_t, OFF_WG0T), MP, 1024, 1024}; EpiGate E1{WSP(float, OFF_MIX)}; pg8::gemm_phase(LL, g1, S, E1); }
    { GETP(); SfGate f{WSP(float, OFF_MIX)}; sgemm(WSP(bf16_t, OFF_HB), WSP(bf16_t, OFF_WG0T), 1024, 32, 256, f); }
    if (PHM & 16) { GETP(); pg8::StaticOrder S; S.init(MP, 1024, gridDim.x, blockIdx.x);
      pg8::Gemm g2{WSP(bf16_t, OFF_PB), WSP(bf16_t, OFF_WP0T), MP, 1024, 256};
      EpiPle E2{WSP(float, OFF_H), WSP(float, OFF_MIX), WSP(bf16_t, OFF_XN), P.in[9] + 1024, WSP(float, OFF_SS1)}; pg8::gemm_phase(LL, g2, S, E2); }
    { GETP(); SfPle f{WSP(float, OFF_H), WSP(float, OFF_MIX), WSP(bf16_t, OFF_XN), P.in[9] + 1024, WSP(float, OFF_SS1)}; sgemm(WSP(bf16_t, OFF_PB), WSP(bf16_t, OFF_WP0T), 256, 32, 256, f); }
    xcd_barrier(xb);
    if (PHM & 32) { GETP(); pg8::StaticOrder S; S.init(MP, INC, gridDim.x, blockIdx.x); pg8::Gemm g{WSP(bf16_t, OFF_XN), WSP(bf16_t, OFF_W1T), MP, INC, 1024};
      EpiStoreBf16 E{WSP(bf16_t, OFF_U), INC, WSP(float, OFF_SS1), nullptr}; pg8::gemm_phase(LL, g, S, E); }
    { GETP(); SfU f{WSP(bf16_t, OFF_U), INC, WSP(float, OFF_SS1), nullptr}; sgemm(WSP(bf16_t, OFF_XN), WSP(bf16_t, OFF_W1T), 1024, 256, 64 * 32, f); }
    xcd_barrier(xb);
    if (PHM & 64) { GETP(); phase_mix1(P, L); }
    xcd_barrier(xb);
    { GETP(); convert_p(P, 1); }
    __syncthreads();
    if (PHM & 128) { GETP(); pg8::StaticOrder S; S.init(MP, 1024, gridDim.x, blockIdx.x); pg8::Gemm g{WSP(bf16_t, OFF_MIX), WSP(bf16_t, OFF_WO1T), MP, 1024, 2048};
      EpiResid E{WSP(float, OFF_H), WSP(float, OFF_H) + (size_t)MP * 1024, WSP(float, OFF_H), WSP(bf16_t, OFF_HB)}; pg8::gemm_phase(LL, g, S, E); }
    { GETP(); SfResid f{WSP(float, OFF_H) + (size_t)MP * 1024, WSP(float, OFF_H), WSP(bf16_t, OFF_HB)}; sgemm(WSP(bf16_t, OFF_MIX), WSP(bf16_t, OFF_WO1T), 2048, 32, 256, f); }
    xcd_barrier(xb);
    if (PHM & 256) { GETP(); pg8::StaticOrder S; S.init(MP, 1024, gridDim.x, blockIdx.x);
      pg8::Gemm g1{WSP(bf16_t, OFF_HB), WSP(bf16_t, OFF_WG1T), MP, 1024, 1024}; EpiGate E1{WSP(float, OFF_MIX)}; pg8::gemm_phase(LL, g1, S, E1); }
    { GETP(); SfGate f{WSP(float, OFF_MIX)}; sgemm(WSP(bf16_t, OFF_HB), WSP(bf16_t, OFF_WG1T), 1024, 32, 256, f); }
    if (PHM & 256) { GETP(); pg8::StaticOrder S; S.init(MP, 1024, gridDim.x, blockIdx.x);
      pg8::Gemm g2{WSP(bf16_t, OFF_PB), WSP(bf16_t, OFF_WP1T), MP, 1024, 256};
      EpiPle E2{WSP(float, OFF_H), WSP(float, OFF_MIX), nullptr, nullptr, WSP(float, OFF_SS2)}; pg8::gemm_phase(LL, g2, S, E2); }
    { GETP(); SfPle f{WSP(float, OFF_H), WSP(float, OFF_MIX), nullptr, nullptr, WSP(float, OFF_SS2)}; sgemm(WSP(bf16_t, OFF_PB), WSP(bf16_t, OFF_WP1T), 256, 32, 256, f); }
    xcd_barrier(xb);
    { GETP(); phase_final(P); }
}

extern "C" void kernel_launch(void* const* d_in, const int* in_sizes, int n_in, void* d_out, int out_size, void* d_ws, size_t ws_size, hipStream_t stream) {
    static int grid = 0;
    if (grid == 0) {
        if (n_in != 32 || ws_size < WS_END) { fprintf(stderr, "kernel_launch: need 32 inputs and %zu bytes of workspace (got %d, %zu)\n", (size_t)WS_END, n_in, ws_size); grid = -1; return; }
        int dev = 0, cus = 0, per_cu = 0;
        (void)hipGetDevice(&dev); (void)hipDeviceGetAttribute(&cus, hipDeviceAttributeMultiprocessorCount, dev);
        if (hipFuncSetAttribute((const void*)fwd_kernel, hipFuncAttributeMaxDynamicSharedMemorySize, LDS_BYTES) != hipSuccess) { fprintf(stderr, "kernel_launch: hipFuncSetAttribute failed\n"); grid = -1; return; }
        if (hipOccupancyMaxActiveBlocksPerMultiprocessor(&per_cu, (const void*)fwd_kernel, 512, LDS_BYTES) != hipSuccess || per_cu < 1) { fprintf(stderr, "kernel_launch: occupancy query says %d\n", per_cu); per_cu = 1; }
        (void)hipGetLastError();
        grid = cus;
    }
    if (grid < 0) return;
    Params p{};
    for (int i = 0; i < 32; ++i) p.in[i] = (const float*)d_in[i];
    p.out = (float*)d_out; p.ws = (unsigned char*)d_ws;
    if (hipMemsetAsync((char*)d_ws + OFF_BAR, 0, 16384, stream) != hipSuccess) { fprintf(stderr, "kernel_launch: memset of barrier words failed\n"); return; }
    void* args[] = {&p};
    hipError_t e = hipLaunchCooperativeKernel((const void*)fwd_kernel, dim3(grid), dim3(512), args, LDS_BYTES, stream);
    if (e != hipSuccess) fprintf(stderr, "cooperative launch failed: %s (grid %d)\n", hipGetErrorString(e), grid);
}
```

```cpp
#include <hip/hip_runtime.h>
#include <hip/hip_cooperative_groups.h>
#include <cstdio>
namespace cg = cooperative_groups;

#define LAS __attribute__((address_space(3)))
#define DI __device__ __forceinline__
typedef unsigned short bf16_t;
typedef short bf16x8 __attribute__((ext_vector_type(8)));
typedef float f32x4 __attribute__((ext_vector_type(4)));
typedef float f32x16 __attribute__((ext_vector_type(16)));

constexpr int MP = 16384, MS = 128, MV = MP + MS, MPAD = 16640;
constexpr int DM = 1024, INAB = 4624, N0 = 4608, INC = 8192;
constexpr float EPSF = 1e-6f;
constexpr size_t O_Y = 0, O_AHP = 16908288, O_ACP = 16916480, O_BSP = 16941056, O_BCP = 17989632, O_CP = 18026496,
                 O_AHS = 20123648, O_ACS = 20254720, O_BSS = 20647936, O_BCS = 37425152, O_CS = 38014976;
constexpr size_t al256(size_t x) { return (x + 255) & ~size_t(255); }
constexpr size_t OFF_CTL = 0;
constexpr size_t OFF_BAR = 256;
constexpr size_t OFF_SS1 = 256 + 16384;
constexpr size_t OFF_SS2 = OFF_SS1 + al256((size_t)MPAD * 4);
constexpr size_t OFF_SSB = OFF_SS2 + al256((size_t)MPAD * 4);
constexpr size_t OFF_DT  = OFF_SSB + al256((size_t)MPAD * 8);
constexpr size_t OFF_W0T = OFF_DT + al256((size_t)MV * 16 * 4);
constexpr size_t OFF_WO0T = OFF_W0T + (size_t)(N0 + 256) * 1024 * 2;
constexpr size_t OFF_WG0T = OFF_WO0T + (size_t)1024 * 2048 * 2;
constexpr size_t OFF_WP0T = OFF_WG0T + (size_t)1024 * 1024 * 2;
constexpr size_t OFF_W1T  = OFF_WP0T + (size_t)1024 * 256 * 2;
constexpr size_t OFF_WO1T = OFF_W1T + (size_t)INC * 1024 * 2;
constexpr size_t OFF_WG1T = OFF_WO1T + (size_t)1024 * 2048 * 2;
constexpr size_t OFF_WP1T = OFF_WG1T + (size_t)1024 * 1024 * 2;
constexpr size_t OFF_WRT  = OFF_WP1T + (size_t)1024 * 256 * 2;
constexpr size_t OFF_WIT  = OFF_WRT + (size_t)128 * 1024 * 2;
constexpr size_t OFF_XN   = OFF_WIT + (size_t)128 * 1024 * 2;
constexpr size_t OFF_MIX  = OFF_XN + (size_t)MPAD * 1024 * 2;
constexpr size_t OFF_H    = OFF_MIX + (size_t)MPAD * 2048 * 2;
constexpr size_t OFF_U    = OFF_H + al256((size_t)MV * 1024 * 4);
constexpr size_t OFF_HB   = OFF_U;
constexpr size_t OFF_PB   = OFF_U + (size_t)MPAD * 1024 * 2;
constexpr size_t WS_END   = OFF_U + al256((size_t)MV * INC * 2);
constexpr int LDS_BYTES = 144 * 1024;

struct Params { const float* in[32]; float* out; unsigned char* ws; };
#define WSP(T, off) ((T*)(P.ws + (off)))

typedef __bf16 bf16v2_t __attribute__((ext_vector_type(2)));
typedef float f32v2_t __attribute__((ext_vector_type(2)));
DI unsigned pack2(float lo, float hi) { f32v2_t v = {lo, hi}; bf16v2_t b = __builtin_convertvector(v, bf16v2_t); return __builtin_bit_cast(unsigned, b); }
DI bf16_t f2bf(float f) { return __builtin_bit_cast(bf16_t, (__bf16)f); }
DI float bf2f(bf16_t b) { return __uint_as_float(((unsigned)b) << 16); }
DI float bflo(unsigned w) { return __uint_as_float(w << 16); }
DI float bfhi(unsigned w) { return __uint_as_float(w & 0xFFFF0000u); }
DI float frcp(float x) { return __builtin_amdgcn_rcpf(x); }
DI float sigm(float x) { return frcp(1.f + __expf(-x)); }
DI float silu(float x) { return x * frcp(1.f + __expf(-x)); }
DI float softplus(float x) { return x > 20.f ? x : log1pf(__expf(x)); }
DI float wave_sum(float v) { for (int o = 32; o > 0; o >>= 1) v += __shfl_xor(v, o); return v; }
DI int otid() { int t = threadIdx.x; asm volatile("" : "+v"(t)); return t; }
DI void lds_barrier() { asm volatile("s_waitcnt lgkmcnt(0)" ::: "memory"); __builtin_amdgcn_s_barrier(); asm volatile("" ::: "memory"); }
DI int crow(int reg, int hh) { return (reg & 3) + 8 * (reg >> 2) + 4 * hh; }
DI void ld4bf(const bf16_t* p, float (&o)[4]) { uint2 w = *(const uint2*)p; o[0] = bflo(w.x); o[1] = bfhi(w.x); o[2] = bflo(w.y); o[3] = bfhi(w.y); }
typedef unsigned u32x2 __attribute__((ext_vector_type(2)));
typedef unsigned u32x4 __attribute__((ext_vector_type(4)));
DI u32x2 pack4v(float a, float b, float c, float d) { u32x2 r; r.x = pack2(a, b); r.y = pack2(c, d); return r; }
DI uint2 pack4(float a, float b, float c, float d) { uint2 r; r.x = pack2(a, b); r.y = pack2(c, d); return r; }
#define MFMA32(a, b, c) __builtin_amdgcn_mfma_f32_32x32x16_bf16((a), (b), (c), 0, 0, 0)
#define MFMA16(a, b, c) __builtin_amdgcn_mfma_f32_16x16x32_bf16((a), (b), (c), 0, 0, 0)
DI bf16x8 ldfrag(const bf16_t* base, int ld, int row0, int k0, int lane) { return *(const bf16x8*)(base + (row0 + (lane & 31)) * ld + k0 + 8 * (lane >> 5)); }
DI bf16x8 ldfrag16(const bf16_t* base, int ld, int row0, int k0, int lane) { return *(const bf16x8*)(base + (row0 + (lane & 15)) * ld + k0 + 8 * (lane >> 4)); }

namespace pg8 {
constexpr int BM = 256, BK = 64, HALF = 128, HTB = HALF * BK * 2, STAGE_BYTES = 8 * HTB, NXCD = 8, WGM = 8;
DI int lds_byte(int r, int c) { const int st = (r >> 4) * 2 + (c >> 5), rr = r & 15, cc = c & 31, ob = rr * 64 + cc * 2; return st * 1024 + (ob ^ (((ob >> 9) & 1) << 5)); }
DI void stage_rc(int b, int& R, int& C) { const int st = b / 1024, sb = b % 1024, swz = sb ^ (((sb >> 9) & 1) << 5); R = (st >> 1) * 16 + swz / 64; C = (st & 1) * 32 + (swz % 64) / 2; }
DI int perm32(int rho) { const int n = rho >> 4, i = rho & 15; return 8 * (i >> 2) + 4 * n + (i & 3); }
struct Unit { int pm, pn; };
struct Gemm { const bf16_t* A; const bf16_t* Bt; int M, N, K; };
struct StaticOrder {
    int nM, nN, nwg, G, c;
    DI void init(int M, int N, int G_, int c_) { nM = M / BM; nN = N / BM; nwg = nM * nN; G = G_; c = c_; }
    DI bool next(int i, Unit& u) const {
        const long L = (long)i * G + c; if (L >= nwg) return false;
        int wgid = (int)L; { const int q = nwg / NXCD, r = nwg % NXCD, xcd = wgid % NXCD, off = wgid / NXCD; wgid = (xcd < r ? xcd * (q + 1) : r * (q + 1) + (xcd - r) * q) + off; }
        const int nig = WGM * nN, gid = wgid / nig, fm = gid * WGM, gsz = (nM - fm) < WGM ? (nM - fm) : WGM;
        u.pm = fm + ((wgid % nig) % gsz); u.pn = (wgid % nig) / gsz; return true;
    }
};

template <class Epi>
DI void gemm_phase(LAS unsigned char* lds, const Gemm g, const StaticOrder& S, const Epi& E) {
    const int tid = otid(), wid = __builtin_amdgcn_readfirstlane(tid >> 6), lane = tid & 63, wr = wid >> 2, wc = wid & 3, fr = lane & 15, fq = lane >> 4;
    const int K = g.K, nt = K / BK;
    unsigned voffA[2], voffB[2];
#pragma unroll
    for (int i = 0; i < 2; ++i) { int R, C; stage_rc(tid * 16 + i * 8192, R, C); const int Rb = Epi::PERM ? ((R & ~31) + perm32(R & 31)) : R;
        voffA[i] = (unsigned)(R * K + C) * 2u; voffB[i] = (unsigned)(Rb * K + C) * 2u; }
    const size_t kstep = (size_t)(BK * 2);
    const size_t hstep = (size_t)HALF * K * 2;
    const size_t tstep = 2 * hstep;
    const unsigned ldsw = (unsigned)wid * 1024u;
    const int aoff = lds_byte(wr * 64 + fr, fq * 8), boff = lds_byte(wc * 32 + fr, fq * 8);
#define PG8_SA(b, h) (((b) * 2 + (h)) * HTB)
#define PG8_SB(b, h) ((4 + (b) * 2 + (h)) * HTB)
#define PG8_STAGE(bufoff, gbase, voff) do { _Pragma("unroll") for (int _i = 0; _i < 2; ++_i) \
        __builtin_amdgcn_global_load_lds((const unsigned*)((const char*)(gbase) + (voff)[_i]), (LAS unsigned*)(lds + (bufoff) + ldsw + _i * 8192), 16, 0, 0); } while (0)
#define PG8_LDA(dst, b, h) do { _Pragma("unroll") for (int m = 0; m < 4; ++m) _Pragma("unroll") for (int k = 0; k < 2; ++k) dst[m][k] = *(const LAS bf16x8*)(lds + PG8_SA(b, h) + aoff + m * 2048 + k * 1024); } while (0)
#define PG8_LDB(dst, b, h) do { _Pragma("unroll") for (int n = 0; n < 2; ++n) _Pragma("unroll") for (int k = 0; k < 2; ++k) dst[n][k] = *(const LAS bf16x8*)(lds + PG8_SB(b, h) + boff + n * 2048 + k * 1024); } while (0)
#define PG8_MMA(ai, bj, At, Bt) do { __builtin_amdgcn_s_setprio(1); _Pragma("unroll") for (int m = 0; m < 4; ++m) _Pragma("unroll") for (int n = 0; n < 2; ++n) _Pragma("unroll") for (int k = 0; k < 2; ++k) \
        acc[ai][bj][m][n] = __builtin_amdgcn_mfma_f32_16x16x32_bf16(Bt[n][k], At[m][k], acc[ai][bj][m][n], 0, 0, 0); __builtin_amdgcn_s_setprio(0); } while (0)
#define PG8_WAIT_V(n) asm volatile("s_waitcnt vmcnt(" #n ")" ::: "memory")
#define PG8_WAIT_L(n) asm volatile("s_waitcnt lgkmcnt(" #n ")" ::: "memory")
#define PG8_BAR __builtin_amdgcn_s_barrier()
#define PG8_SCHED __builtin_amdgcn_sched_barrier(0)
    Unit cur, nxt; int ui = 0;
    if (!S.next(0, cur)) return;
    f32x4 acc[2][2][4][2];
#pragma unroll
    for (int a = 0; a < 2; ++a)
#pragma unroll
        for (int b = 0; b < 2; ++b)
#pragma unroll
            for (int m = 0; m < 4; ++m)
#pragma unroll
                for (int n = 0; n < 2; ++n) acc[a][b][m][n] = (f32x4){0.f, 0.f, 0.f, 0.f};
    bf16x8 At[4][2], B0[2][2], B1[2][2];
    const char* cA = (const char*)g.A + (size_t)cur.pm * tstep; const char* cB = (const char*)g.Bt + (size_t)cur.pn * tstep;
    PG8_STAGE(PG8_SB(0, 0), cB, voffB); PG8_STAGE(PG8_SA(0, 0), cA, voffA); PG8_STAGE(PG8_SB(0, 1), cB + hstep, voffB); PG8_STAGE(PG8_SA(0, 1), cA + hstep, voffA);
    if (wr == 1) PG8_BAR;
    PG8_WAIT_V(4); PG8_BAR;
    PG8_STAGE(PG8_SB(1, 0), cB + kstep, voffB); PG8_STAGE(PG8_SA(1, 0), cA + kstep, voffA); PG8_STAGE(PG8_SB(1, 1), cB + hstep + kstep, voffB);
    PG8_WAIT_V(6); PG8_BAR;
    for (;;) {
        const bool has_next = S.next(ui + 1, nxt);
        const char* nA = has_next ? (const char*)g.A + (size_t)nxt.pm * tstep : cA; const char* nB = has_next ? (const char*)g.Bt + (size_t)nxt.pn * tstep : cB;
        for (int t = 0; t < nt; t += 2) {
            const bool last = (t == nt - 2);
            const char* a1 = cA + (size_t)(t + 1) * kstep;
            const char* a2 = last ? nA : cA + (size_t)(t + 2) * kstep; const char* b2 = last ? nB : cB + (size_t)(t + 2) * kstep;
            const char* a3 = a2 + kstep; const char* b3 = b2 + kstep;
            PG8_LDB(B0, 0, 0); PG8_SCHED; PG8_LDA(At, 0, 0); PG8_STAGE(PG8_SA(1, 1), a1 + hstep, voffA);
            PG8_WAIT_L(8); PG8_BAR; PG8_WAIT_L(0); PG8_MMA(0, 0, At, B0); PG8_BAR; PG8_SCHED;
            PG8_LDB(B1, 0, 1); PG8_STAGE(PG8_SB(0, 0), b2, voffB);
            PG8_BAR; PG8_WAIT_L(0); PG8_MMA(0, 1, At, B1); PG8_BAR;
            PG8_LDA(At, 0, 1); PG8_STAGE(PG8_SA(0, 0), a2, voffA);
            PG8_BAR; PG8_WAIT_L(0); PG8_MMA(1, 0, At, B0); PG8_BAR; PG8_SCHED;
            PG8_STAGE(PG8_SB(0, 1), b2 + hstep, voffB);
            PG8_WAIT_V(6); PG8_BAR; PG8_MMA(1, 1, At, B1); PG8_BAR;
            PG8_LDB(B0, 1, 0); PG8_SCHED; PG8_LDA(At, 1, 0); PG8_STAGE(PG8_SA(0, 1), a2 + hstep, voffA);
            PG8_WAIT_L(8); PG8_BAR; PG8_WAIT_L(0); PG8_MMA(0, 0, At, B0); PG8_BAR; PG8_SCHED;
            PG8_LDB(B1, 1, 1); PG8_STAGE(PG8_SB(1, 0), b3, voffB);
            PG8_BAR; PG8_WAIT_L(0); PG8_MMA(0, 1, At, B1); PG8_BAR;
            PG8_LDA(At, 1, 1); PG8_STAGE(PG8_SA(1, 0), a3, voffA);
            PG8_BAR; PG8_WAIT_L(0); PG8_MMA(1, 0, At, B0); PG8_BAR; PG8_SCHED;
            PG8_STAGE(PG8_SB(1, 1), b3 + hstep, voffB);
            PG8_WAIT_V(6); PG8_BAR; PG8_MMA(1, 1, At, B1); PG8_BAR;
        }
        E(acc, cur, wr, wc, fr, fq);
        if (!has_next) break;
#pragma unroll
        for (int a = 0; a < 2; ++a)
#pragma unroll
            for (int b = 0; b < 2; ++b)
#pragma unroll
                for (int m = 0; m < 4; ++m)
#pragma unroll
                    for (int n = 0; n < 2; ++n) acc[a][b][m][n] = (f32x4){0.f, 0.f, 0.f, 0.f};
        cur = nxt; cA = nA; cB = nB; ++ui;
    }
    PG8_WAIT_V(0);
    if (wr == 0) PG8_BAR;
    PG8_BAR;
#undef PG8_SA
#undef PG8_SB
#undef PG8_STAGE
#undef PG8_LDA
#undef PG8_LDB
#undef PG8_MMA
#undef PG8_WAIT_V
#undef PG8_WAIT_L
#undef PG8_BAR
#undef PG8_SCHED
}
}

struct EpiStoreBf16 {
    static constexpr bool PERM = true;
    bf16_t* O; int ldc; const float* ss; float* DT;
    DI void operator()(const f32x4 (&acc)[2][2][4][2], const pg8::Unit& u, int wr, int wc, int fr, int fq) const {
        const int row0 = u.pm * 256 + wr * 64 + fr, col0 = u.pn * 256 + wc * 32 + 8 * fq;
        if (u.pn * 256 >= ldc) {
            if (wc == 0 && fq < 2) {
#pragma unroll
                for (int ai = 0; ai < 2; ++ai)
#pragma unroll
                    for (int m = 0; m < 4; ++m) { const int row = row0 + ai * 128 + m * 16;
                        if (row < MV) { *(f32x4*)(DT + (size_t)row * 16 + 8 * fq) = acc[ai][0][m][0]; *(f32x4*)(DT + (size_t)row * 16 + 8 * fq + 4) = acc[ai][0][m][1]; } }
            }
            return;
        }
#pragma unroll
        for (int ai = 0; ai < 2; ++ai)
#pragma unroll
            for (int m = 0; m < 4; ++m) {
                const int row = row0 + ai * 128 + m * 16;
                if (row < MV) {
                    const float sc = ss ? rsqrtf(ss[row] * (1.f / 1024.f) + EPSF) : 1.f;
                    bf16_t* rp = O + (size_t)row * ldc + col0;
#pragma unroll
                    for (int bj = 0; bj < 2; ++bj) {
                        const f32x4 v0 = acc[ai][bj][m][0] * sc, v1 = acc[ai][bj][m][1] * sc;
                        uint4 w; w.x = pack2(v0[0], v0[1]); w.y = pack2(v0[2], v0[3]); w.z = pack2(v1[0], v1[1]); w.w = pack2(v1[2], v1[3]);
                        *(uint4*)(rp + bj * 128) = w;
                    }
                }
            }
    }
};
struct EpiResid {
    static constexpr bool PERM = false;
    const float* rp_prompt; const float* rp_sample;
    float* H; bf16_t* HB;
    DI void operator()(const f32x4 (&acc)[2][2][4][2], const pg8::Unit& u, int wr, int wc, int fr, int fq) const {
        const int row0 = u.pm * 256 + wr * 64 + fr, col0 = u.pn * 256 + wc * 32 + 4 * fq;
#pragma unroll
        for (int ai = 0; ai < 2; ++ai)
#pragma unroll
            for (int m = 0; m < 4; ++m) {
                const int row = row0 + ai * 128 + m * 16;
                if (row < MV) {
                    const float* rs = (row < MP ? rp_prompt + (size_t)row * 1024 : rp_sample + (size_t)(row - MP) * 1024) + col0;
                    float* hp = H + (size_t)row * 1024 + col0; bf16_t* bp = HB + (size_t)row * 1024 + col0;
#pragma unroll
                    for (int bj = 0; bj < 2; ++bj)
#pragma unroll
                        for (int n = 0; n < 2; ++n) {
                            const int co = bj * 128 + n * 16;
                            const f32x4 v = acc[ai][bj][m][n] + *(const f32x4*)(rs + co);
                            *(f32x4*)(hp + co) = v; *(uint2*)(bp + co) = pack4(v[0], v[1], v[2], v[3]);
                        }
                }
            }
    }
};
struct EpiGate {
    static constexpr bool PERM = false;
    float* Gt;
    DI void operator()(const f32x4 (&acc)[2][2][4][2], const pg8::Unit& u, int wr, int wc, int fr, int fq) const {
        const int row0 = u.pm * 256 + wr * 64 + fr, col0 = u.pn * 256 + wc * 32 + 4 * fq;
#pragma unroll
        for (int ai = 0; ai < 2; ++ai)
#pragma unroll
            for (int m = 0; m < 4; ++m) {
                const int row = row0 + ai * 128 + m * 16;
                if (row < MV) {
                    float* gp = Gt + (size_t)row * 1024 + col0;
#pragma unroll
                    for (int bj = 0; bj < 2; ++bj)
#pragma unroll
                        for (int n = 0; n < 2; ++n) {
                            const f32x4 a = acc[ai][bj][m][n];
                            *(f32x4*)(gp + bj * 128 + n * 16) = (f32x4){sigm(a[0]), sigm(a[1]), sigm(a[2]), sigm(a[3])};
                        }
                }
            }
    }
};
struct EpiPle {
    static constexpr bool PERM = false;
    float* H; const float* Gt; bf16_t* XN; const float* nw; float* SS;
    DI void operator()(const f32x4 (&acc)[2][2][4][2], const pg8::Unit& u, int wr, int wc, int fr, int fq) const {
        const int row0 = u.pm * 256 + wr * 64 + fr, col0 = u.pn * 256 + wc * 32 + 4 * fq;
#pragma unroll
        for (int ai = 0; ai < 2; ++ai)
#pragma unroll
            for (int m = 0; m < 4; ++m) {
                const int row = row0 + ai * 128 + m * 16;
                float ssum = 0.f;
                if (row < MV) {
                    float* hp = H + (size_t)row * 1024 + col0; const float* gp = Gt + (size_t)row * 1024 + col0;
#pragma unroll
                    for (int bj = 0; bj < 2; ++bj)
#pragma unroll
                        for (int n = 0; n < 2; ++n) {
                            const int co = bj * 128 + n * 16;
                            const f32x4 v = *(const f32x4*)(hp + co) + *(const f32x4*)(gp + co) * acc[ai][bj][m][n];
                            *(f32x4*)(hp + co) = v;
                            ssum += v[0] * v[0] + v[1] * v[1] + v[2] * v[2] + v[3] * v[3];
                            if (XN) { const f32x4 w = *(const f32x4*)(nw + col0 + co); *(uint2*)(XN + (size_t)row * 1024 + col0 + co) = pack4(v[0] * w[0], v[1] * w[1], v[2] * w[2], v[3] * w[3]); }
                        }
                }
                ssum += __shfl_xor(ssum, 16); ssum += __shfl_xor(ssum, 32);
                if (fq == 0 && row < MV) atomicAdd(SS + row, ssum);
            }
    }
};

template <class F>
DI void sgemm(const bf16_t* A, const bf16_t* Bt, int K, int ntask, int nwg_main, const F& f) {
    const int tid = otid(), lane = tid & 63, wid = tid >> 6;
    const int G = gridDim.x, off = nwg_main % G;
    int li = blockIdx.x, nl = G;
    if (off != 0) { if ((int)blockIdx.x < off) return; li = blockIdx.x - off; nl = G - off; }
    for (int t = li; t < ntask; t += nl) {
        const bf16_t* ap = A + (size_t)(MP + wid * 16 + (lane & 15)) * K + 8 * (lane >> 4);
        const bf16_t* bp0 = Bt + (size_t)(t * 32 + (lane & 15)) * K + 8 * (lane >> 4);
        const bf16_t* bp1 = bp0 + (size_t)16 * K;
        f32x4 acc0 = {0.f, 0.f, 0.f, 0.f}, acc1 = {0.f, 0.f, 0.f, 0.f};
        for (int k0 = 0; k0 < K; k0 += 256) {
            bf16x8 a[8], b0[8], b1[8];
#pragma unroll
            for (int q = 0; q < 8; ++q) { a[q] = *(const bf16x8*)(ap + k0 + q * 32); b0[q] = *(const bf16x8*)(bp0 + k0 + q * 32); b1[q] = *(const bf16x8*)(bp1 + k0 + q * 32); }
#pragma unroll
            for (int q = 0; q < 8; ++q) { acc0 = MFMA16(a[q], b0[q], acc0); acc1 = MFMA16(a[q], b1[q], acc1); }
        }
#pragma unroll
        for (int reg = 0; reg < 4; ++reg) {
            const int row = MP + wid * 16 + (lane >> 4) * 4 + reg, col = t * 32 + (lane & 15);
            f(row, col, acc0[reg], lane); f(row, col + 16, acc1[reg], lane);
        }
    }
}
struct SfU { bf16_t* O; int ldc; const float* ss; float* DT;
    DI void operator()(int row, int col, float v, int) const {
        if (col >= ldc) { if (col < ldc + 16) DT[(size_t)row * 16 + col - ldc] = v; return; }
        const float sc = ss ? rsqrtf(ss[row] * (1.f / 1024.f) + EPSF) : 1.f; O[(size_t)row * ldc + col] = f2bf(v * sc); } };
struct SfResid { const float* rs; float* H; bf16_t* HB;
    DI void operator()(int row, int col, float v, int) const { const float h = rs[(size_t)(row - MP) * 1024 + col] + v; H[(size_t)row * 1024 + col] = h; HB[(size_t)row * 1024 + col] = f2bf(h); } };
struct SfGate { float* Gt; DI void operator()(int row, int col, float v, int) const { Gt[(size_t)row * 1024 + col] = sigm(v); } };
struct SfPle { float* H; const float* Gt; bf16_t* XN; const float* nw; float* SS;
    DI void operator()(int row, int col, float v, int lane) const {
        const size_t o = (size_t)row * 1024 + col; const float h = H[o] + Gt[o] * v; H[o] = h;
        if (XN) XN[o] = f2bf(h * nw[col]);
        float ss = h * h; ss += __shfl_xor(ss, 1); ss += __shfl_xor(ss, 2); ss += __shfl_xor(ss, 4); ss += __shfl_xor(ss, 8);
        if ((lane & 15) == 0) atomicAdd(SS + row, ss); } };

DI void transpose_tile_w(const float* src, int lds_, bf16_t* dst, int ldd, int k0, int n0, int nvalid, float* tile, int lane) {
    const float* sp = src + (size_t)k0 * lds_ + n0 + lane;
#pragma unroll
    for (int bt = 0; bt < 4; ++bt) {
        float v[16];
#pragma unroll
        for (int r = 0; r < 16; ++r) v[r] = (lane < nvalid) ? sp[(size_t)(bt * 16 + r) * lds_] : 0.f;
#pragma unroll
        for (int r = 0; r < 16; ++r) tile[(bt * 16 + r) * 65 + lane] = v[r];
    }
    const int koct = lane & 7;
#pragma unroll
    for (int p = 0; p < 8; ++p) {
        const int nn = (lane >> 3) + 8 * p;
        const float* tp = tile + (koct * 8) * 65 + nn;
        uint4 w;
        w.x = pack2(tp[0], tp[65]); w.y = pack2(tp[2 * 65], tp[3 * 65]); w.z = pack2(tp[4 * 65], tp[5 * 65]); w.w = pack2(tp[6 * 65], tp[7 * 65]);
        *(uint4*)(dst + (size_t)(n0 + nn) * ldd + k0 + koct * 8) = w;
    }
}
DI void transpose_job(const float* src, int lds_, bf16_t* dst, int ldd, int K, int N, int nvalid_last, int& base, float* tile, int gw, int nwv, int lane) {
    const int ntn = (N + 63) / 64, nt = (K / 64) * ntn;
    const int first = (gw - (base % nwv) + nwv) % nwv;
    for (int t = first; t < nt; t += nwv) { const int tn = t % ntn; transpose_tile_w(src, lds_, dst, ldd, (t / ntn) * 64, tn * 64, (tn == ntn - 1) ? nvalid_last : 64, tile, lane); }
    base += nt;
}
DI void phase_prep(const Params& P, unsigned char* L) {
    const int tid = otid(), lane = tid & 63, wid = tid >> 6;
    const int gw = blockIdx.x * 8 + wid, nwv = gridDim.x * 8;
    { float* z = WSP(float, OFF_SS1); const int n = (int)((OFF_DT - OFF_SS1) / 4);
      for (int i = blockIdx.x * 512 + tid; i < n; i += gridDim.x * 512) z[i] = 0.f;
      if (blockIdx.x == 0 && tid < 64) WSP(unsigned, OFF_CTL)[tid] = 0u; }
    { float* tile = (float*)L + wid * (64 * 65); int base = 0;
      transpose_job(P.in[26], INC, WSP(bf16_t, OFF_W1T), 1024, 1024, INC, 64, base, tile, gw, nwv, lane);
      transpose_job(P.in[11], INAB, WSP(bf16_t, OFF_W0T), 1024, 1024, N0, 64, base, tile, gw, nwv, lane);
      transpose_job(P.in[11] + N0, INAB, WSP(bf16_t, OFF_W0T) + (size_t)N0 * 1024, 1024, 1024, 16, 16, base, tile, gw, nwv, lane);
      transpose_job(P.in[25], 1024, WSP(bf16_t, OFF_WO0T), 2048, 2048, 1024, 64, base, tile, gw, nwv, lane);
      transpose_job(P.in[31], 1024, WSP(bf16_t, OFF_WG0T), 1024, 1024, 1024, 64, base, tile, gw, nwv, lane);
      transpose_job(P.in[30], 1024, WSP(bf16_t, OFF_WP0T), 256, 256, 1024, 64, base, tile, gw, nwv, lane);
      transpose_job(P.in[29], 1024, WSP(bf16_t, OFF_WO1T), 2048, 2048, 1024, 64, base, tile, gw, nwv, lane);
      transpose_job(P.in[31] + 1024 * 1024, 1024, WSP(bf16_t, OFF_WG1T), 1024, 1024, 1024, 64, base, tile, gw, nwv, lane);
      transpose_job(P.in[30] + 256 * 1024, 1024, WSP(bf16_t, OFF_WP1T), 256, 256, 1024, 64, base, tile, gw, nwv, lane);
      transpose_job(P.in[14], 128, WSP(bf16_t, OFF_WRT), 1024, 1024, 128, 64, base, tile, gw, nwv, lane);
      transpose_job(P.in[16], 128, WSP(bf16_t, OFF_WIT), 1024, 1024, 128, 64, base, tile, gw, nwv, lane); }
    { const float* nwp = P.in[9]; bf16_t* XN = WSP(bf16_t, OFF_XN);
      f32x4 w4[4];
#pragma unroll
      for (int i = 0; i < 4; ++i) w4[i] = *(const f32x4*)(nwp + lane * 4 + 256 * i);
      for (int r0 = gw * 2; r0 < MV; r0 += nwv * 2) {
          f32x4 x[2][4];
#pragma unroll
          for (int q = 0; q < 2; ++q) { const int r = r0 + q; const float* src = r < MP ? P.in[0] + (size_t)r * 1024 : P.in[1] + (size_t)(r - MP) * 1024;
#pragma unroll
              for (int i = 0; i < 4; ++i) x[q][i] = *(const f32x4*)(src + lane * 4 + 256 * i); }
#pragma unroll
          for (int q = 0; q < 2; ++q) {
              float ss = 0.f;
#pragma unroll
              for (int i = 0; i < 4; ++i) ss += x[q][i][0] * x[q][i][0] + x[q][i][1] * x[q][i][1] + x[q][i][2] * x[q][i][2] + x[q][i][3] * x[q][i][3];
              ss = wave_sum(ss); const float rstd = rsqrtf(ss * (1.f / 1024.f) + EPSF);
#pragma unroll
              for (int i = 0; i < 4; ++i) { const f32x4 v = x[q][i] * rstd * w4[i]; *(uint2*)(XN + (size_t)(r0 + q) * 1024 + lane * 4 + 256 * i) = pack4(v[0], v[1], v[2], v[3]); }
          }
      } }
}
DI void convert_p(const Params& P, int layer) {
    bf16_t* PB = WSP(bf16_t, OFF_PB);
    const float* pp = P.in[2] + (size_t)layer * MP * 256; const float* ps = P.in[3] + (size_t)layer * MS * 256;
    for (int i = blockIdx.x * 512 + threadIdx.x; i < MV * 64; i += gridDim.x * 512) {
        const int row = i >> 6, c4 = (i & 63) * 4;
        const f32x4 v = *(const f32x4*)((row < MP ? pp + (size_t)row * 256 : ps + (size_t)(row - MP) * 256) + c4);
        *(uint2*)(PB + (size_t)row * 256 + c4) = pack4(v[0], v[1], v[2], v[3]);
    }
}

constexpr size_t OFF_XT = OFF_XN;
constexpr size_t OFF_CN = OFF_H;
constexpr size_t OFF_BN = OFF_CN + (size_t)MP * 256 * 2;
constexpr size_t OFF_BT = OFF_BN + (size_t)MP * 256 * 2;
DI void phase_convbc(const Params& P) {
    const bf16_t* U = WSP(bf16_t, OFF_U);
    bf16_t* XT = WSP(bf16_t, OFF_XT); bf16_t* CN = WSP(bf16_t, OFF_CN); bf16_t* BN = WSP(bf16_t, OFF_BN); bf16_t* BT = WSP(bf16_t, OFF_BT);
    for (int idx = blockIdx.x * 512 + otid(); idx < 2048 * 384; idx += gridDim.x * 512) {
        const int quad = idx % 384, tgp = idx / 384, b = tgp >> 8, t0 = (tgp & 255) * 8, cch = quad * 4;
        float cw[4][4], cbias[4];
#pragma unroll
        for (int kk = 0; kk < 4; ++kk) { const f32x4 w = *(const f32x4*)(P.in[19] + kk * 1536 + cch); cw[kk][0] = w[0]; cw[kk][1] = w[1]; cw[kk][2] = w[2]; cw[kk][3] = w[3]; }
        { const f32x4 w = *(const f32x4*)(P.in[20] + cch); cbias[0] = w[0]; cbias[1] = w[1]; cbias[2] = w[2]; cbias[3] = w[3]; }
        const unsigned voff = (unsigned)((b * 2048 + t0) * N0 + 3072 + cch);
        uint2 raw[11];
#pragma unroll
        for (int j = 0; j < 11; ++j) raw[j] = (t0 + j - 3 >= 0) ? *(const uint2*)((U + (j - 3) * N0) + voff) : make_uint2(0u, 0u);
        float y[8][4];
#pragma unroll
        for (int j = 0; j < 8; ++j) {
            const float x0[4] = {bflo(raw[j].x), bfhi(raw[j].x), bflo(raw[j].y), bfhi(raw[j].y)};
            const float x1[4] = {bflo(raw[j + 1].x), bfhi(raw[j + 1].x), bflo(raw[j + 1].y), bfhi(raw[j + 1].y)};
            const float x2[4] = {bflo(raw[j + 2].x), bfhi(raw[j + 2].x), bflo(raw[j + 2].y), bfhi(raw[j + 2].y)};
            const float x3[4] = {bflo(raw[j + 3].x), bfhi(raw[j + 3].x), bflo(raw[j + 3].y), bfhi(raw[j + 3].y)};
#pragma unroll
            for (int e = 0; e < 4; ++e) y[j][e] = silu(cbias[e] + cw[0][e] * x0[e] + cw[1][e] * x1[e] + cw[2][e] * x2[e] + cw[3][e] * x3[e]);
        }
        const int c = t0 >> 7, tl = t0 & 127;
        if (cch < 1024) {
#pragma unroll
            for (int e = 0; e < 4; ++e) { uint4 w; w.x = pack2(y[0][e], y[1][e]); w.y = pack2(y[2][e], y[3][e]); w.z = pack2(y[4][e], y[5][e]); w.w = pack2(y[6][e], y[7][e]);
                *(uint4*)(XT + ((size_t)((b * 16 + c) * 1024 + cch + e)) * 128 + tl) = w; }
        } else {
            const int cc = cch - 1024, isC = cc >= 256, g = (cc & 255) >> 7, n0 = cc & 127;
            bf16_t* nat = (isC ? CN : BN) + ((size_t)(((b * 16 + c) * 2 + g) * 128 + tl)) * 128 + n0;
#pragma unroll
            for (int j = 0; j < 8; ++j) *(uint2*)(nat + j * 128) = pack4(y[j][0], y[j][1], y[j][2], y[j][3]);
            if (!isC) {
#pragma unroll
                for (int e = 0; e < 4; ++e) { uint4 w; w.x = pack2(y[0][e], y[1][e]); w.y = pack2(y[2][e], y[3][e]); w.z = pack2(y[4][e], y[5][e]); w.w = pack2(y[6][e], y[7][e]);
                    *(uint4*)(BT + ((size_t)(((b * 16 + c) * 2 + g) * 128 + n0 + e)) * 128 + tl) = w; }
            }
        }
    }
}
DI void ssd_prompt_item(const Params& P, unsigned char* L, int item) {
    const int b = item >> 4, h = item & 15, g = h >> 3;
    const int tid0 = otid(), wid = tid0 >> 6;
    bf16_t* Cs = (bf16_t*)L;
    bf16_t* Bs = Cs + 128 * 136;
    bf16_t* BsT = Bs + 128 * 136;
    bf16_t* XsT = BsT + 128 * 136;
    bf16_t* St = XsT + 64 * 136;
    float* dtvB = (float*)(St + 64 * 136); float* acsB = dtvB + 256; float* wvB = acsB + 256;
    const bf16_t* U = WSP(bf16_t, OFF_U); const float* DT = WSP(float, OFF_DT); bf16_t* MIX = WSP(bf16_t, OFF_MIX); float* SSB = WSP(float, OFF_SSB);
    const float a_neg = -__expf(P.in[22][h]), dtb = P.in[21][h], Dh = P.in[23][h];
    f32x16 accS;
#pragma unroll
    for (int i = 0; i < 16; ++i) accS[i] = 0.f;
    lds_barrier();
    for (int i = tid0; i < 64 * 136; i += 512) St[i] = 0;
    float dtr0 = 0.f, dtr1 = 0.f;
#define SSD_DTLOAD(cc) do { if (wid == 0) { const float* dp_ = DT + (size_t)(b * 2048 + (cc) * 128 + (tid0 & 63)) * 16 + h; dtr0 = dp_[0]; dtr1 = dp_[64 * 16]; } } while (0)
#define SSD_SCAN(buf) do { if (wid == 0) { const int ln_ = tid0 & 63; const float d0_ = softplus(dtr0 + dtb), d1_ = softplus(dtr1 + dtb); float v0_ = d0_ * a_neg, v1_ = d1_ * a_neg; \
        _Pragma("unroll") for (int o_ = 1; o_ < 64; o_ <<= 1) { const float n0_ = __shfl_up(v0_, o_), n1_ = __shfl_up(v1_, o_); if (ln_ >= o_) { v0_ += n0_; v1_ += n1_; } } \
        v1_ += __shfl(v0_, 63); const float al_ = __shfl(v1_, 63); \
        dtvB[(buf) * 128 + ln_] = d0_; dtvB[(buf) * 128 + 64 + ln_] = d1_; acsB[(buf) * 128 + ln_] = v0_; acsB[(buf) * 128 + 64 + ln_] = v1_; \
        wvB[(buf) * 128 + ln_] = __expf(al_ - v0_) * d0_; wvB[(buf) * 128 + 64 + ln_] = __expf(al_ - v1_) * d1_; } } while (0)
    SSD_DTLOAD(0); SSD_SCAN(0); SSD_DTLOAD(1);
    u32x4 tC[4], tB[4], tT[4], tX[2];
    for (int c = 0; c < 16; ++c) {
        const int row0 = b * 2048 + c * 128;
        lds_barrier();
        int zv = 0; asm volatile("" : "+v"(zv));
        const int tid = tid0 + zv, lane = tid & 63, hh = lane >> 5, l31 = lane & 31;
        const int prow = tid >> 4, pcol = (tid & 15) * 8;
        const float* dtv = dtvB + (c & 1) * 128; const float* acs = acsB + (c & 1) * 128; const float* wv = wvB + (c & 1) * 128;
        if (c + 1 < 16) { SSD_SCAN((c + 1) & 1); if (c + 2 < 16) SSD_DTLOAD(c + 2); }
        if (c == 0) {
            const size_t tb_ = ((size_t)((b * 16 + c) * 2 + g)) * 128 * 128 + (size_t)prow * 128 + pcol;
            const u32x4* pc = (const u32x4*)(WSP(bf16_t, OFF_CN) + tb_); const u32x4* pb = (const u32x4*)(WSP(bf16_t, OFF_BN) + tb_); const u32x4* pt = (const u32x4*)(WSP(bf16_t, OFF_BT) + tb_);
            const u32x4* px = (const u32x4*)(WSP(bf16_t, OFF_XT) + ((size_t)((b * 16 + c) * 1024 + h * 64 + prow)) * 128 + pcol);
#pragma unroll
            for (int i = 0; i < 4; ++i) { tC[i] = pc[i * 512]; tB[i] = pb[i * 512]; tT[i] = pt[i * 512]; }
            tX[0] = px[0]; tX[1] = px[512];
        }
        const float a_last = acs[127];
#pragma unroll
        for (int i = 0; i < 4; ++i) {
            *(u32x4*)(Cs + (prow + 32 * i) * 136 + pcol) = tC[i]; *(u32x4*)(Bs + (prow + 32 * i) * 136 + pcol) = tB[i]; *(u32x4*)(BsT + (prow + 32 * i) * 136 + pcol) = tT[i];
        }
        *(u32x4*)(XsT + prow * 136 + pcol) = tX[0]; *(u32x4*)(XsT + (prow + 32) * 136 + pcol) = tX[1];
        if (c + 1 < 16) {
            const size_t tb_ = ((size_t)((b * 16 + c + 1) * 2 + g)) * 128 * 128 + (size_t)prow * 128 + pcol;
            const u32x4* pc = (const u32x4*)(WSP(bf16_t, OFF_CN) + tb_); const u32x4* pb = (const u32x4*)(WSP(bf16_t, OFF_BN) + tb_); const u32x4* pt = (const u32x4*)(WSP(bf16_t, OFF_BT) + tb_);
            const u32x4* px = (const u32x4*)(WSP(bf16_t, OFF_XT) + ((size_t)((b * 16 + c + 1) * 1024 + h * 64 + prow)) * 128 + pcol);
#pragma unroll
            for (int i = 0; i < 4; ++i) { tC[i] = pc[i * 512]; tB[i] = pb[i * 512]; tT[i] = pt[i * 512]; }
            tX[0] = px[0]; tX[1] = px[512];
        }
        bf16_t zr[16];
        {
            const unsigned zoff = (unsigned)((row0 + (wid >> 1) * 32 + 4 * hh) * N0 + 2048 + h * 64 + (wid & 1) * 32 + l31);
#pragma unroll
            for (int reg = 0; reg < 16; ++reg) zr[reg] = (U + ((reg & 3) + 8 * (reg >> 2)) * N0)[zoff];
        }
        lds_barrier();
        {
            const int rb = (wid >> 1) * 32, cb0 = (wid & 1) * 64;
            f32x16 cbA[2];
#pragma unroll
            for (int i = 0; i < 16; ++i) { cbA[0][i] = 0.f; cbA[1][i] = 0.f; }
#pragma unroll
            for (int ks = 0; ks < 8; ++ks) {
                const bf16x8 a = ldfrag(Cs, 136, rb, ks * 16, lane);
                cbA[0] = MFMA32(a, ldfrag(Bs, 136, cb0, ks * 16, lane), cbA[0]);
                cbA[1] = MFMA32(a, ldfrag(Bs, 136, cb0 + 32, ks * 16, lane), cbA[1]);
            }
            lds_barrier();
            bf16_t* Ws = Bs;
#pragma unroll
            for (int j = 0; j < 2; ++j) {
                const int s = cb0 + j * 32 + l31; const float as = acs[s], ds = dtv[s];
#pragma unroll
                for (int reg = 0; reg < 16; ++reg) {
                    const int t = rb + crow(reg, hh);
                    const float v = (s <= t) ? cbA[j][reg] * __expf(acs[t] - as) * ds : 0.f;
                    Ws[t * 136 + s] = f2bf(v);
                }
            }
        }
        lds_barrier();
        {
            const bf16_t* Ws = Bs;
            const int tb = (wid >> 1) * 32, pb = (wid & 1) * 32;
            f32x16 y;
#pragma unroll
            for (int i = 0; i < 16; ++i) y[i] = 0.f;
#pragma unroll
            for (int ks = 0; ks < 8; ++ks) y = MFMA32(ldfrag(Cs, 136, tb, ks * 16, lane), ldfrag(St, 136, pb, ks * 16, lane), y);
#pragma unroll
            for (int reg = 0; reg < 16; ++reg) y[reg] *= __expf(acs[tb + crow(reg, hh)]);
#pragma unroll
            for (int ks = 0; ks < 8; ++ks) y = MFMA32(ldfrag(Ws, 136, tb, ks * 16, lane), ldfrag(XsT, 136, pb, ks * 16, lane), y);
            lds_barrier();
            {
                bf16_t* XwT = Cs;
                const uint4 xa = *(const uint4*)(XsT + prow * 136 + pcol), xb_ = *(const uint4*)(XsT + (prow + 32) * 136 + pcol);
                const f32x4 w0 = *(const f32x4*)(wv + pcol), w1 = *(const f32x4*)(wv + pcol + 4);
                uint4 oa, ob;
                oa.x = pack2(bflo(xa.x) * w0[0], bfhi(xa.x) * w0[1]); oa.y = pack2(bflo(xa.y) * w0[2], bfhi(xa.y) * w0[3]); oa.z = pack2(bflo(xa.z) * w1[0], bfhi(xa.z) * w1[1]); oa.w = pack2(bflo(xa.w) * w1[2], bfhi(xa.w) * w1[3]);
                ob.x = pack2(bflo(xb_.x) * w0[0], bfhi(xb_.x) * w0[1]); ob.y = pack2(bflo(xb_.y) * w0[2], bfhi(xb_.y) * w0[3]); ob.z = pack2(bflo(xb_.z) * w1[0], bfhi(xb_.z) * w1[1]); ob.w = pack2(bflo(xb_.w) * w1[2], bfhi(xb_.w) * w1[3]);
                *(uint4*)(XwT + prow * 136 + pcol) = oa; *(uint4*)(XwT + (prow + 32) * 136 + pcol) = ob;
            }
            const int p = pb + l31, ch = h * 64 + p; const float nwv = P.in[24][ch];
#pragma unroll
            for (int reg = 0; reg < 16; ++reg) {
                const int t = tb + crow(reg, hh); const size_t row = (size_t)(row0 + t);
                const float xv = bf2f(XsT[p * 136 + t]); const float z = bf2f(zr[reg]);
                const float yy = (y[reg] + Dh * xv) * silu(z);
                float ss = yy * yy;
                ss += __shfl_xor(ss, 1); ss += __shfl_xor(ss, 2); ss += __shfl_xor(ss, 4); ss += __shfl_xor(ss, 8); ss += __shfl_xor(ss, 16);
                if (l31 == 0) atomicAdd(SSB + row * 2 + g, ss);
                MIX[row * 2048 + 1024 + ch] = f2bf(yy * nwv);
            }
            lds_barrier();
            const int pb2 = (wid >> 2) * 32, nb = (wid & 3) * 32;
            const float ea = __expf(a_last);
#pragma unroll
            for (int reg = 0; reg < 16; ++reg) accS[reg] *= ea;
#pragma unroll
            for (int ks = 0; ks < 8; ++ks) accS = MFMA32(ldfrag(Cs, 136, pb2, ks * 16, lane), ldfrag(BsT, 136, nb, ks * 16, lane), accS);
#pragma unroll
            for (int reg = 0; reg < 16; ++reg) St[(pb2 + crow(reg, hh)) * 136 + nb + l31] = f2bf(accS[reg]);
        }
    }
    {
        const int lane = tid0 & 63, hh = lane >> 5, l31 = lane & 31;
        const int pb2 = (wid >> 2) * 32, nb = (wid & 3) * 32;
        float* o = P.out + O_BSP + (size_t)(b * 16 + h) * 64 * 128;
#pragma unroll
        for (int reg = 0; reg < 16; ++reg) o[(pb2 + crow(reg, hh)) * 128 + nb + l31] = accS[reg];
    }
}
#undef SSD_DTLOAD
#undef SSD_SCAN
DI void ssd_sample_item(const Params& P, unsigned char* L, int item) {
    const int b = item >> 4, h = item & 15, g = h >> 3, tid = otid(), lane = tid & 63;
    float* xs = (float*)L; float* Bv = xs + 64; float* Cv = Bv + 128; float* yv = Cv + 128;
    const bf16_t* U = WSP(bf16_t, OFF_U); bf16_t* MIX = WSP(bf16_t, OFF_MIX); float* SSB = WSP(float, OFF_SSB);
    const size_t row = (size_t)(MP + b);
    __syncthreads();
    if (tid < 320) {
        int cc; if (tid < 64) cc = h * 64 + tid; else if (tid < 192) cc = 1024 + g * 128 + (tid - 64); else cc = 1280 + g * 128 + (tid - 192);
        const float* buf = P.in[7] + (size_t)b * 3 * 1536 + cc;
        const float v = P.in[20][cc] + P.in[19][cc] * buf[0] + P.in[19][1536 + cc] * buf[1536] + P.in[19][2 * 1536 + cc] * buf[2 * 1536] + P.in[19][3 * 1536 + cc] * bf2f(U[row * N0 + 3072 + cc]);
        xs[tid] = silu(v);
    }
    const float dt = softplus(WSP(float, OFF_DT)[row * 16 + h] + P.in[21][h]);
    const float dA = __expf(-dt * __expf(P.in[22][h]));
    __syncthreads();
    const float* s0 = P.in[6] + (size_t)(b * 16 + h) * 64 * 128; float* s1 = P.out + O_BSS + (size_t)(b * 16 + h) * 64 * 128;
    const int n4 = (tid & 31) * 4;
    const f32x4 Bq = *(const f32x4*)(Bv + n4), Cq = *(const f32x4*)(Cv + n4);
#pragma unroll
    for (int j = 0; j < 4; ++j) {
        const int p = (tid >> 5) + 16 * j;
        const f32x4 s = *(const f32x4*)(s0 + p * 128 + n4);
        const float dx = dt * xs[p];
        const f32x4 sn = s * dA + Bq * dx;
        *(f32x4*)(s1 + p * 128 + n4) = sn;
        float yp = sn[0] * Cq[0] + sn[1] * Cq[1] + sn[2] * Cq[2] + sn[3] * Cq[3];
        yp += __shfl_xor(yp, 1); yp += __shfl_xor(yp, 2); yp += __shfl_xor(yp, 4); yp += __shfl_xor(yp, 8); yp += __shfl_xor(yp, 16);
        if ((tid & 31) == 0) yv[p] = yp;
    }
    __syncthreads();
    if (tid < 64) {
        const int ch = h * 64 + tid;
        const float yy = (yv[tid] + P.in[23][h] * xs[tid]) * silu(bf2f(U[row * N0 + 2048 + ch]));
        const float ss = wave_sum(yy * yy);
        if (lane == 0) atomicAdd(SSB + row * 2 + g, ss);
        MIX[row * 2048 + 1024 + ch] = f2bf(yy * P.in[24][ch]);
    }
}
template <bool SAMPLE>
DI void rglru_item(const Params& P, unsigned char* L, int item) {
    const int tid0 = otid(), wid = tid0 >> 6;
    const int b = SAMPLE ? 0 : (item >> 4), k = (item >> 1) & 7, dh = item & 1;
    bf16_t* Xs = (bf16_t*)L;
    bf16_t* Wg = Xs + 128 * 136;
    float* Aa = (float*)(Wg + 128 * 136);
    float* Uu = Aa + 128 * 64; float* segA = Uu + 128 * 64; float* segH = segA + 512; float* hc = segH + 512;
    const bf16_t* U = WSP(bf16_t, OFF_U); bf16_t* MIX = WSP(bf16_t, OFF_MIX);
    lds_barrier();
    {
        const bf16_t* WRT = WSP(bf16_t, OFF_WRT); const bf16_t* WIT = WSP(bf16_t, OFF_WIT);
#pragma unroll
        for (int i = 0; i < 4; ++i) {
            const int chk = tid0 + i * 512, r = chk >> 4, c8 = (chk & 15) * 8;
            const bf16_t* src = (r < 64 ? WRT + (size_t)(dh * 64 + r) * 1024 : WIT + (size_t)(dh * 64 + r - 64) * 1024) + k * 128 + c8;
            *(u32x4*)(Wg + r * 136 + c8) = *(const u32x4*)src;
        }
        if (tid0 < 64) hc[tid0] = 0.f;
    }
    float sp[4], br[4], bi[4];
#pragma unroll
    for (int ct = 0; ct < 4; ++ct) { const int chd = k * 128 + dh * 64 + ct * 16 + (tid0 & 15); sp[ct] = softplus(-P.in[18][chd]); br[ct] = P.in[15][chd]; bi[ct] = P.in[17][chd]; }
    const int ch0 = k * 128 + (tid0 & 31) * 4;
    float cw[4][4], cbias[4];
#pragma unroll
    for (int kk = 0; kk < 4; ++kk)
#pragma unroll
        for (int e = 0; e < 4; ++e) cw[kk][e] = P.in[12][kk * 1024 + ch0 + e];
#pragma unroll
    for (int e = 0; e < 4; ++e) cbias[e] = P.in[13][ch0 + e];
    u32x2 raw[11];
#define RG_LOAD(tl_) do { const int tg_ = (tl_) * 128 + (tid0 >> 5) * 8; const unsigned vo_ = (unsigned)((b * 2048 + tg_) * N0 + ch0); \
        _Pragma("unroll") for (int j = 0; j < 11; ++j) raw[j] = (tg_ + j - 3 >= 0) ? *(const u32x2*)((U + (j - 3) * N0) + vo_) : (u32x2){0u, 0u}; } while (0)
    if (!SAMPLE) RG_LOAD(0);
    const int ntiles = SAMPLE ? 1 : 16;
    for (int tile = 0; tile < ntiles; ++tile) {
        const int row0 = SAMPLE ? MP : b * 2048 + tile * 128;
        lds_barrier();
        int zv = 0; asm volatile("" : "+v"(zv));
        const int tid = tid0 + zv, lane = tid & 63, quad = tid & 31, seg = tid >> 5;
        const int sd = tid & 63, sseg = wid, sch = k * 128 + dh * 64 + sd;
        bf16_t gt[16];
        if (!SAMPLE) {
            const unsigned goff = (unsigned)((row0 + sseg * 16) * N0 + 1024 + sch);
#pragma unroll
            for (int t = 0; t < 16; ++t) gt[t] = (U + t * N0)[goff];
        }
        if (SAMPLE) {
#pragma unroll
            for (int t = 0; t < 8; ++t) {
                const int bb = seg * 8 + t;
                const float* buf = P.in[5] + (size_t)bb * 3 * 1024 + ch0;
                const f32x4 p0 = *(const f32x4*)buf, p1 = *(const f32x4*)(buf + 1024), p2 = *(const f32x4*)(buf + 2048);
                float cur[4]; ld4bf(U + (size_t)(MP + bb) * N0 + ch0, cur);
                float y[4];
#pragma unroll
                for (int e = 0; e < 4; ++e) y[e] = cbias[e] + cw[0][e] * p0[e] + cw[1][e] * p1[e] + cw[2][e] * p2[e] + cw[3][e] * cur[e];
                *(u32x2*)(Xs + bb * 136 + quad * 4) = pack4v(y[0], y[1], y[2], y[3]);
            }
        } else {
#pragma unroll
            for (int j = 0; j < 8; ++j) {
                const float x0[4] = {bflo(raw[j].x), bfhi(raw[j].x), bflo(raw[j].y), bfhi(raw[j].y)};
                const float x1[4] = {bflo(raw[j + 1].x), bfhi(raw[j + 1].x), bflo(raw[j + 1].y), bfhi(raw[j + 1].y)};
                const float x2[4] = {bflo(raw[j + 2].x), bfhi(raw[j + 2].x), bflo(raw[j + 2].y), bfhi(raw[j + 2].y)};
                const float x3[4] = {bflo(raw[j + 3].x), bfhi(raw[j + 3].x), bflo(raw[j + 3].y), bfhi(raw[j + 3].y)};
                float y[4];
#pragma unroll
                for (int e = 0; e < 4; ++e) y[e] = cbias[e] + cw[0][e] * x0[e] + cw[1][e] * x1[e] + cw[2][e] * x2[e] + cw[3][e] * x3[e];
                *(u32x2*)(Xs + (seg * 8 + j) * 136 + quad * 4) = pack4v(y[0], y[1], y[2], y[3]);
            }
            if (tile + 1 < 16) RG_LOAD(tile + 1);
        }
        lds_barrier();
        {
            f32x4 acc[8];
#pragma unroll
            for (int i = 0; i < 8; ++i) acc[i] = (f32x4){0.f, 0.f, 0.f, 0.f};
#pragma unroll
            for (int ks = 0; ks < 4; ++ks) {
                const bf16x8 a = ldfrag16(Xs, 136, wid * 16, ks * 32, lane);
#pragma unroll
                for (int tl = 0; tl < 8; ++tl) acc[tl] = MFMA16(a, ldfrag16(Wg, 136, tl * 16, ks * 32, lane), acc[tl]);
            }
#pragma unroll
            for (int ct = 0; ct < 4; ++ct)
#pragma unroll
                for (int reg = 0; reg < 4; ++reg) {
                    const int t = wid * 16 + (lane >> 4) * 4 + reg, d = ct * 16 + (lane & 15);
                    const float r = sigm(acc[ct][reg] + br[ct]), gi = sigm(acc[4 + ct][reg] + bi[ct]);
                    const float a = __expf(-8.f * r * sp[ct]);
                    const float uu = __builtin_amdgcn_sqrtf(fmaxf(1.f - a * a, 0.f)) * gi * bf2f(Xs[t * 136 + dh * 64 + d]);
                    if (SAMPLE) {
                        const int chd = k * 128 + dh * 64 + d;
                        const float hn = a * P.in[4][(size_t)t * 1024 + chd] + uu;
                        P.out[O_AHS + (size_t)t * 1024 + chd] = hn;
                        const float gv = bf2f(U[(size_t)(MP + t) * N0 + 1024 + chd]);
                        MIX[(size_t)(MP + t) * 2048 + chd] = f2bf(hn * silu(gv));
                    } else { Aa[t * 64 + d] = a; Uu[t * 64 + d] = uu; }
                }
        }
        if (!SAMPLE) {
            lds_barrier();
            float av[16], uv[16], Ap = 1.f, Hp = 0.f;
#pragma unroll
            for (int t = 0; t < 16; ++t) { av[t] = Aa[(sseg * 16 + t) * 64 + sd]; uv[t] = Uu[(sseg * 16 + t) * 64 + sd]; Hp = av[t] * Hp + uv[t]; Ap *= av[t]; }
            segA[sseg * 64 + sd] = Ap; segH[sseg * 64 + sd] = Hp;
            lds_barrier();
            float hin = hc[sd];
            for (int s2 = 0; s2 < sseg; ++s2) hin = segA[s2 * 64 + sd] * hin + segH[s2 * 64 + sd];
            const unsigned moff = (unsigned)((row0 + sseg * 16) * 2048 + sch);
#pragma unroll
            for (int t = 0; t < 16; ++t) {
                hin = av[t] * hin + uv[t];
                (MIX + t * 2048)[moff] = f2bf(hin * silu(bf2f(gt[t])));
            }
            lds_barrier();
            if (sseg == 7) hc[sd] = hin;
        }
    }
#undef RG_LOAD
    if (!SAMPLE) { lds_barrier(); if (tid0 < 64) P.out[O_AHP + (size_t)b * 1024 + k * 128 + dh * 64 + tid0] = hc[tid0]; }
}
DI void phase_mix0(const Params& P, unsigned char* L) {
    const int tid = otid(), bid = blockIdx.x, G = gridDim.x;
    { const bf16_t* U = WSP(bf16_t, OFF_U);
      for (int i = bid * 512 + tid; i < 8 * 3 * 1024; i += G * 512) { const int c = i & 1023, j = (i >> 10) % 3, b = i / 3072; P.out[O_ACP + i] = bf2f(U[(size_t)(b * 2048 + 2045 + j) * N0 + c]); }
      for (int i = bid * 512 + tid; i < 8 * 3 * 1536; i += G * 512) { const int c = i % 1536, j = (i / 1536) % 3, b = i / 4608; P.out[O_BCP + i] = bf2f(U[(size_t)(b * 2048 + 2045 + j) * N0 + 3072 + c]); }
      for (int i = bid * 512 + tid; i < 128 * 3 * 1024; i += G * 512) { const int c = i & 1023, j = (i >> 10) % 3, b = i / 3072; P.out[O_ACS + i] = j < 2 ? P.in[5][(size_t)(b * 3 + j + 1) * 1024 + c] : bf2f(U[(size_t)(MP + b) * N0 + c]); }
      for (int i = bid * 512 + tid; i < 128 * 3 * 1536; i += G * 512) { const int c = i % 1536, j = (i / 1536) % 3, b = i / 4608; P.out[O_BCS + i] = j < 2 ? P.in[7][(size_t)(b * 3 + j + 1) * 1536 + c] : bf2f(U[(size_t)(MP + b) * N0 + 3072 + c]); } }
    if (bid < 128) rglru_item<false>(P, L, bid); else if (bid < 256) ssd_prompt_item(P, L, bid - 128);
    unsigned* ctr = WSP(unsigned, OFF_CTL);
    unsigned* bc = (unsigned*)(L + LDS_BYTES - 16);
    for (;;) {
        __syncthreads();
        if (tid == 0) bc[0] = atomicAdd(ctr, 1u);
        __syncthreads();
        const unsigned it = bc[0];
        if (it >= 16u + 2048u) break;
        if (it < 16u) rglru_item<true>(P, L, (int)it); else ssd_sample_item(P, L, (int)(it - 16u));
    }
}
DI void phase_norm0(const Params& P) {
    bf16_t* MIX = WSP(bf16_t, OFF_MIX); const float* SSB = WSP(float, OFF_SSB);
    for (int i = blockIdx.x * 512 + threadIdx.x; i < MV * 128; i += gridDim.x * 512) {
        const int row = i >> 7, c8 = (i & 127) * 8, g = c8 >> 9;
        const float sc = rsqrtf(SSB[(size_t)row * 2 + g] * (1.f / 512.f) + EPSF);
        uint4* p = (uint4*)(MIX + (size_t)row * 2048 + 1024 + c8); uint4 w = *p;
        w.x = pack2(bflo(w.x) * sc, bfhi(w.x) * sc); w.y = pack2(bflo(w.y) * sc, bfhi(w.y) * sc); w.z = pack2(bflo(w.z) * sc, bfhi(w.z) * sc); w.w = pack2(bflo(w.w) * sc, bfhi(w.w) * sc);
        *p = w;
    }
}

DI void hgrn_prompt_item(const Params& P, unsigned char* L, int item) {
    const int b = item >> 4, h = item & 15;
    const int tid = otid(), lane = tid & 63, wid = tid >> 6, hh = lane >> 5, l31 = lane & 31;
    bf16_t* Qs = (bf16_t*)L;
    bf16_t* Ks = Qs + 64 * 136;
    float* Of = (float*)L;
    bf16_t* KsT = Ks + 64 * 136;
    bf16_t* VsT = KsT + 128 * 72;
    bf16_t* SsT = VsT + 128 * 72;
    bf16_t* As = SsT + 128 * 136;
    float* Gseg = (float*)(As + 64 * 72);
    float* E1 = Gseg + 16 * 128; float* E2 = E1 + 128;
    const bf16_t* U = WSP(bf16_t, OFF_U); bf16_t* MIX = WSP(bf16_t, OFF_MIX);
    const int kq = tid & 31, ts = tid >> 5;
    float lb[4];
#pragma unroll
    for (int e = 0; e < 4; ++e) { const int ch = h * 128 + kq * 4 + e; lb[e] = sigm(P.in[27][2048 + ch] - P.in[27][ch]); }
    const int kb = (wid >> 1) * 32, vb0 = (wid & 1) * 64;
    f32x16 accS[2];
#pragma unroll
    for (int i = 0; i < 16; ++i) { accS[0][i] = 0.f; accS[1][i] = 0.f; }
    uint2 rq[4], rf[4], rv[4];
#define HG_LOAD(cc) do { _Pragma("unroll") for (int i = 0; i < 4; ++i) { const bf16_t* bp = U + (size_t)(b * 2048 + (cc) * 64 + ts * 4 + i) * INC + h * 128 + kq * 4; \
        rq[i] = *(const uint2*)bp; rf[i] = *(const uint2*)(bp + 2048); rv[i] = *(const uint2*)(bp + 4096); } } while (0)
    HG_LOAD(0);
    lds_barrier();
    for (int c = 0; c < 32; ++c) {
        u32x4 gpre0, gpre1;
        { const bf16_t* gp = U + (size_t)(b * 2048 + c * 64 + (tid >> 3)) * INC + 6144 + h * 128 + (tid & 7) * 16; gpre0 = *(const u32x4*)gp; gpre1 = *(const u32x4*)(gp + 8); }
        float kk[4][4], cs[4][4];
#pragma unroll
        for (int i = 0; i < 4; ++i) {
            const float fx[4] = {bflo(rf[i].x), bfhi(rf[i].x), bflo(rf[i].y), bfhi(rf[i].y)};
#pragma unroll
            for (int e = 0; e < 4; ++e) {
                const float sg = sigm(fx[e]); const float kv = (1.f - lb[e]) * (1.f - sg);
                kk[i][e] = kv; const float gl = __logf(1.f - kv);
                cs[i][e] = (i == 0 ? 0.f : cs[i - 1][e]) + gl;
            }
        }
        *(f32x4*)(Gseg + ts * 128 + kq * 4) = (f32x4){cs[3][0], cs[3][1], cs[3][2], cs[3][3]};
        lds_barrier();
        f32x4 off = {0.f, 0.f, 0.f, 0.f}, gmid = off, glast = off;
        {
            const int swid = __builtin_amdgcn_readfirstlane(tid >> 6);
            f32x4 pre = {0.f, 0.f, 0.f, 0.f};
#pragma unroll
            for (int s = 0; s < 16; ++s) {
                const f32x4 v = *(const f32x4*)(Gseg + s * 128 + kq * 4);
                if (s == 2 * swid) off = pre;
                if (s == 8) gmid = pre;
                pre += v;
            }
            glast = pre;
            if (ts & 1) off += *(const f32x4*)(Gseg + (ts - 1) * 128 + kq * 4);
        }
        {
            float qt[4][4], kt[4][4], vt[4][4];
#pragma unroll
            for (int i = 0; i < 4; ++i) {
                const float q[4] = {bflo(rq[i].x), bfhi(rq[i].x), bflo(rq[i].y), bfhi(rq[i].y)};
                vt[i][0] = bflo(rv[i].x); vt[i][1] = bfhi(rv[i].x); vt[i][2] = bflo(rv[i].y); vt[i][3] = bfhi(rv[i].y);
#pragma unroll
                for (int e = 0; e < 4; ++e) { const float Gv = off[e] + cs[i][e]; const float ex = __expf(Gv - gmid[e]); qt[i][e] = q[e] * 0.08838834764831845f * ex; kt[i][e] = kk[i][e] * frcp(ex); }
                *(uint2*)(Qs + (ts * 4 + i) * 136 + kq * 4) = pack4(qt[i][0], qt[i][1], qt[i][2], qt[i][3]);
                *(uint2*)(Ks + (ts * 4 + i) * 136 + kq * 4) = pack4(kt[i][0], kt[i][1], kt[i][2], kt[i][3]);
            }
#pragma unroll
            for (int e = 0; e < 4; ++e) {
                *(uint2*)(KsT + (kq * 4 + e) * 72 + ts * 4) = pack4(kt[0][e], kt[1][e], kt[2][e], kt[3][e]);
                *(uint2*)(VsT + (kq * 4 + e) * 72 + ts * 4) = pack4(vt[0][e], vt[1][e], vt[2][e], vt[3][e]);
            }
            if (ts == 0) {
#pragma unroll
                for (int e = 0; e < 4; ++e) { E1[kq * 4 + e] = __expf(gmid[e]); E2[kq * 4 + e] = __expf(glast[e] - gmid[e]); }
            }
        }
        if (c + 1 < 32) HG_LOAD(c + 1);
        lds_barrier();
#pragma unroll
        for (int j = 0; j < 2; ++j) {
#pragma unroll
            for (int reg = 0; reg < 16; ++reg) accS[j][reg] *= E1[kb + crow(reg, hh)];
            const int v = vb0 + j * 32 + l31;
#pragma unroll
            for (int rg = 0; rg < 4; ++rg) *(uint2*)(SsT + v * 136 + kb + 8 * rg + 4 * hh) = pack4(accS[j][4 * rg], accS[j][4 * rg + 1], accS[j][4 * rg + 2], accS[j][4 * rg + 3]);
        }
        if (wid < 4) {
            const int tb = (wid >> 1) * 32, sb = (wid & 1) * 32;
            f32x16 aa;
#pragma unroll
            for (int i = 0; i < 16; ++i) aa[i] = 0.f;
#pragma unroll
            for (int ks = 0; ks < 8; ++ks) aa = MFMA32(ldfrag(Qs, 136, tb, ks * 16, lane), ldfrag(Ks, 136, sb, ks * 16, lane), aa);
            const int s = sb + l31;
#pragma unroll
            for (int reg = 0; reg < 16; ++reg) { const int t = tb + crow(reg, hh); As[t * 72 + s] = f2bf(s <= t ? aa[reg] : 0.f); }
        }
        lds_barrier();
        const int tb2 = (wid >> 2) * 32, vb2 = (wid & 3) * 32;
        f32x16 o;
#pragma unroll
        for (int i = 0; i < 16; ++i) o[i] = 0.f;
#pragma unroll
        for (int ks = 0; ks < 8; ++ks) o = MFMA32(ldfrag(Qs, 136, tb2, ks * 16, lane), ldfrag(SsT, 136, vb2, ks * 16, lane), o);
#pragma unroll
        for (int ks = 0; ks < 4; ++ks) o = MFMA32(ldfrag(As, 72, tb2, ks * 16, lane), ldfrag(VsT, 72, vb2, ks * 16, lane), o);
#pragma unroll
        for (int j = 0; j < 2; ++j) {
#pragma unroll
            for (int ks = 0; ks < 4; ++ks) accS[j] = MFMA32(ldfrag(KsT, 72, kb, ks * 16, lane), ldfrag(VsT, 72, vb0 + j * 32, ks * 16, lane), accS[j]);
#pragma unroll
            for (int reg = 0; reg < 16; ++reg) accS[j][reg] *= E2[kb + crow(reg, hh)];
        }
        lds_barrier();
#pragma unroll
        for (int reg = 0; reg < 16; ++reg) Of[(tb2 + crow(reg, hh)) * 132 + vb2 + l31] = o[reg];
        lds_barrier();
        {
            const int t = tid >> 3, vs = tid & 7;
            const size_t row = (size_t)(b * 2048 + c * 64 + t);
            f32x4 ov[4]; float ss = 0.f;
#pragma unroll
            for (int i = 0; i < 4; ++i) { ov[i] = *(const f32x4*)(Of + t * 132 + vs * 16 + i * 4); ss += ov[i][0] * ov[i][0] + ov[i][1] * ov[i][1] + ov[i][2] * ov[i][2] + ov[i][3] * ov[i][3]; }
            ss += __shfl_xor(ss, 1); ss += __shfl_xor(ss, 2); ss += __shfl_xor(ss, 4);
            const float rstd = rsqrtf(ss * (1.f / 128.f) + EPSF);
            const float* nwp = P.in[28] + h * 128 + vs * 16;
            const unsigned gw[8] = {gpre0.x, gpre0.y, gpre0.z, gpre0.w, gpre1.x, gpre1.y, gpre1.z, gpre1.w};
            unsigned ow[8];
#pragma unroll
            for (int i = 0; i < 4; ++i) {
                const f32x4 w = *(const f32x4*)(nwp + i * 4);
                ow[2 * i] = pack2(ov[i][0] * rstd * w[0] * silu(bflo(gw[2 * i])), ov[i][1] * rstd * w[1] * silu(bfhi(gw[2 * i])));
                ow[2 * i + 1] = pack2(ov[i][2] * rstd * w[2] * silu(bflo(gw[2 * i + 1])), ov[i][3] * rstd * w[3] * silu(bfhi(gw[2 * i + 1])));
            }
            bf16_t* op = MIX + row * 2048 + h * 128 + vs * 16;
            *(uint4*)op = make_uint4(ow[0], ow[1], ow[2], ow[3]); *(uint4*)(op + 8) = make_uint4(ow[4], ow[5], ow[6], ow[7]);
        }
        lds_barrier();
    }
#undef HG_LOAD
    float* so = P.out + O_CP + (size_t)(b * 16 + h) * 128 * 128;
#pragma unroll
    for (int j = 0; j < 2; ++j)
#pragma unroll
        for (int reg = 0; reg < 16; ++reg) so[(kb + crow(reg, hh)) * 128 + vb0 + j * 32 + l31] = accS[j][reg];
}
DI void hgrn_sample_item(const Params& P, unsigned char* L, int item) {
    const int b = item >> 4, h = item & 15, tid = otid(), lane = tid & 63;
    float* qv = (float*)L; float* egv = qv + 128; float* kkv = egv + 128; float* vv = kkv + 128; float* part = vv + 128; float* red = part + 16 * 128;
    const bf16_t* U = WSP(bf16_t, OFF_U); bf16_t* MIX = WSP(bf16_t, OFF_MIX);
    const size_t row = (size_t)(MP + b); const bf16_t* ub = U + row * INC + h * 128;
    __syncthreads();
    if (tid < 128) {
        const int ch = h * 128 + tid;
        const float lbv = sigm(P.in[27][2048 + ch] - P.in[27][ch]);
        const float sg = sigm(bf2f(ub[2048 + tid])); const float kv = (1.f - lbv) * (1.f - sg);
        qv[tid] = bf2f(ub[tid]) * 0.08838834764831845f; egv[tid] = 1.f - kv; kkv[tid] = kv;
    } else if (tid < 256) vv[tid - 128] = bf2f(ub[4096 + tid - 128]);
    __syncthreads();
    const float* s0 = P.in[8] + (size_t)(b * 16 + h) * 128 * 128; float* s1 = P.out + O_CS + (size_t)(b * 16 + h) * 128 * 128;
    const int v4 = (tid & 31) * 4; const f32x4 vq = *(const f32x4*)(vv + v4);
    f32x4 op = {0.f, 0.f, 0.f, 0.f};
#pragma unroll
    for (int j = 0; j < 8; ++j) {
        const int k = (tid >> 5) + 16 * j;
        const f32x4 s = *(const f32x4*)(s0 + k * 128 + v4);
        const f32x4 sn = s * egv[k] + vq * kkv[k];
        *(f32x4*)(s1 + k * 128 + v4) = sn;
        op += sn * qv[k];
    }
    *(f32x4*)(part + (tid >> 5) * 128 + v4) = op;
    __syncthreads();
    float o = 0.f;
    if (tid < 128) {
#pragma unroll
        for (int i = 0; i < 16; ++i) o += part[i * 128 + tid];
        const float ss = wave_sum(o * o);
        if (lane == 0) red[tid >> 6] = ss;
    }
    __syncthreads();
    if (tid < 128) {
        const float rstd = rsqrtf((red[0] + red[1]) * (1.f / 128.f) + EPSF);
        const int ch = h * 128 + tid;
        MIX[row * 2048 + ch] = f2bf(o * rstd * P.in[28][ch] * silu(bf2f(ub[6144 + tid])));
    }
}
DI void phase_mix1(const Params& P, unsigned char* L) {
    const int tid = otid(), bid = blockIdx.x;
    if (bid < 128) hgrn_prompt_item(P, L, bid);
    else { const int nb = gridDim.x - 128; for (int it = bid - 128; it < 2048; it += nb) hgrn_sample_item(P, L, it); }
}
DI void phase_final(const Params& P) {
    const int lane = threadIdx.x & 63, gw = blockIdx.x * 8 + (threadIdx.x >> 6), nwv = gridDim.x * 8;
    const float* H = WSP(float, OFF_H); const float* SS = WSP(float, OFF_SS2); const float* nf = P.in[10];
    f32x4 w4[4];
#pragma unroll
    for (int i = 0; i < 4; ++i) w4[i] = *(const f32x4*)(nf + lane * 4 + 256 * i);
    for (int r = gw; r < MV; r += nwv) {
        const float rstd = rsqrtf(SS[r] * (1.f / 1024.f) + EPSF);
#pragma unroll
        for (int i = 0; i < 4; ++i) { const f32x4 v = *(const f32x4*)(H + (size_t)r * 1024 + lane * 4 + 256 * i); *(f32x4*)(P.out + O_Y + (size_t)r * 1024 + lane * 4 + 256 * i) = v * rstd * w4[i]; }
    }
}

#define XB_TMO      128
#define XB_XCNT(j)  (256  + 64 * (j))
#define XB_XSUB(j)  (1280 + 64 * (j))
#define XB_XGEN(j)  (2304 + 64 * (j))
#define XB_TOP      3328
#define XB_TOPGEN   3392
#define XCD_BAR_WORDS 3456
#define XB_SPIN_CAP (1u << 18)

__device__ __forceinline__ unsigned xb_ld(unsigned* p)              { return __hip_atomic_load(p, __ATOMIC_RELAXED, __HIP_MEMORY_SCOPE_AGENT); }
__device__ __forceinline__ unsigned xb_add(unsigned* p, unsigned v) { return __hip_atomic_fetch_add(p, v, __ATOMIC_RELAXED, __HIP_MEMORY_SCOPE_AGENT); }
__device__ __forceinline__ unsigned xb_xcc_id() { return (unsigned)__builtin_amdgcn_s_getreg((3 << 11) | 20) & 0xFu; }
#define XB_SPIN(cond, bar) do { unsigned _sp = 0; while (cond) { __builtin_amdgcn_s_sleep(1); \
    if ((++_sp & 255u) == 0u) { if (xb_ld(&(bar)[XB_TMO])) break; if (_sp > XB_SPIN_CAP) { atomicAdd(&(bar)[XB_TMO], 1u); break; } } } } while (0)

struct XcdBarrier {
    unsigned* bar; unsigned x;
    volatile LAS unsigned* st;
};

__device__ __forceinline__ XcdBarrier xcd_barrier_post(unsigned* bar, volatile LAS unsigned* st) {
    XcdBarrier b; b.bar = bar; b.x = xb_xcc_id(); b.st = st;
    if (threadIdx.x == 0) (void)xb_add(&bar[XB_XCNT(b.x)], 1u);
    return b;
}
__device__ __forceinline__ void xcd_barrier_complete(unsigned* bar, unsigned x, unsigned& nloc, unsigned& nx) {
    const unsigned G = gridDim.x * gridDim.y * gridDim.z;
    unsigned sum, cnt, mine, sp = 0u;
    for (;;) {
        sum = 0u; cnt = 0u; mine = 0u;
#pragma unroll
        for (unsigned j = 0; j < 16; ++j) { const unsigned c = xb_ld(&bar[XB_XCNT(j)]); sum += c; cnt += (c > 0u) ? 1u : 0u; mine = (j == x) ? c : mine; }
        if (sum == G) break;
        __builtin_amdgcn_s_sleep(1);
        if ((++sp & 255u) == 0u) { if (xb_ld(&bar[XB_TMO])) break; if (sp > XB_SPIN_CAP) { atomicAdd(&bar[XB_TMO], 1u); break; } }
    }
    nloc = mine > 0u ? mine : 1u; nx = cnt > 0u ? cnt : 1u;
}

__device__ __forceinline__ void xcd_barrier(const XcdBarrier& b) {
    asm volatile("s_waitcnt vmcnt(0)" ::: "memory");
    __syncthreads();
    if (threadIdx.x == 0) {
        unsigned* bar = b.bar;
        __builtin_amdgcn_s_waitcnt(0);
        unsigned nloc = b.st[0], nx = b.st[1];
        if (nloc == 0u) { xcd_barrier_complete(bar, b.x, nloc, nx); b.st[0] = nloc; b.st[1] = nx; }
        const unsigned old = xb_add(&bar[XB_XSUB(b.x)], 1u);
        const unsigned gen = old / nloc;
        if (old + 1u == (gen + 1u) * nloc) {
            __builtin_amdgcn_fence(__ATOMIC_RELEASE, "agent");
            asm volatile("s_waitcnt vmcnt(0)" ::: "memory");
            const unsigned og = xb_add(&bar[XB_TOP], 1u);
            const unsigned tg = og / nx;
            if (og + 1u == (tg + 1u) * nx) xb_add(&bar[XB_TOPGEN], 1u);
            else XB_SPIN(xb_ld(&bar[XB_TOPGEN]) == tg, bar);
            __builtin_amdgcn_fence(__ATOMIC_ACQUIRE, "agent");
            xb_add(&bar[XB_XGEN(b.x)], 1u);
            asm volatile("s_waitcnt vmcnt(0)" ::: "memory");
        } else {
            XB_SPIN(xb_ld(&bar[XB_XGEN(b.x)]) == gen, bar);
            __builtin_amdgcn_fence(__ATOMIC_ACQUIRE, "agent");
            asm volatile("s_waitcnt vmcnt(0)" ::: "memory");
        }
    }
    __syncthreads();
}


#ifndef PHM
#define PHM 0xFFFF
#endif
typedef const __attribute__((address_space(4))) Params* ParamsK;
DI Params getp() {
    ParamsK pp = (ParamsK)__builtin_amdgcn_kernarg_segment_ptr(); asm volatile("" : "+s"(pp));
    Params P;
#pragma unroll
    for (int i = 0; i < 32; ++i) P.in[i] = pp->in[i];
    P.out = pp->out; P.ws = pp->ws; return P;
}
#define GETP() const Params P = getp()
__global__ void __launch_bounds__(512, 2) fwd_kernel(Params Parg) {
    extern __shared__ __attribute__((aligned(16))) unsigned char lds[];
    cg::grid_group grid = cg::this_grid();
    unsigned char* L = (unsigned char*)lds;
    LAS unsigned char* LL = (LAS unsigned char*)lds;
    volatile LAS unsigned* xst = (volatile LAS unsigned*)(LL + LDS_BYTES - 32);
    if (threadIdx.x < 2) xst[threadIdx.x] = 0u;
    __syncthreads();
    XcdBarrier xb;
    { GETP(); xb = xcd_barrier_post(WSP(unsigned, OFF_BAR), xst); }
    if (PHM & 1) { GETP(); phase_prep(P, L); }
    if (gridDim.y == 0xFFFFu) grid.sync();
    xcd_barrier(xb);
    if (PHM & 2) { GETP(); pg8::StaticOrder S; S.init(MP, N0 + 256, gridDim.x, blockIdx.x); pg8::Gemm g{WSP(bf16_t, OFF_XN), WSP(bf16_t, OFF_W0T), MP, N0 + 256, 1024};
      EpiStoreBf16 E{WSP(bf16_t, OFF_U), N0, nullptr, WSP(float, OFF_DT)}; pg8::gemm_phase(LL, g, S, E); }
    { GETP(); SfU f{WSP(bf16_t, OFF_U), N0, nullptr, WSP(float, OFF_DT)}; sgemm(WSP(bf16_t, OFF_XN), WSP(bf16_t, OFF_W0T), 1024, 145, 64 * 19, f); }
    xcd_barrier(xb);
    { GETP(); phase_convbc(P); }
    xcd_barrier(xb);
    if (PHM & 4) { GETP(); phase_mix0(P, L); }
    xcd_barrier(xb);
    { GETP(); phase_norm0(P); }
    xcd_barrier(xb);
    { GETP(); convert_p(P, 0); }
    __syncthreads();
    if (PHM & 8) { GETP(); pg8::StaticOrder S; S.init(MP, 1024, gridDim.x, blockIdx.x); pg8::Gemm g{WSP(bf16_t, OFF_MIX), WSP(bf16_t, OFF_WO0T), MP, 1024, 2048};
      EpiResid E{P.in[0], P.in[1], WSP(float, OFF_H), WSP(bf16_t, OFF_HB)}; pg8::gemm_phase(LL, g, S, E); }
    { GETP(); SfResid f{P.in[1], WSP(float, OFF_H), WSP(bf16_t, OFF_HB)}; sgemm(WSP(bf16_t, OFF_MIX), WSP(bf16_t, OFF_WO0T), 2048, 32, 256, f); }
    xcd_barrier(xb);
    if (PHM & 16) { GETP(); pg8::StaticOrder S; S.init(MP, 1024, gridDim.x, blockIdx.x);
      pg8::Gemm g1{WSP(bf16_t, OFF_HB), WSP(bf16_t, OFF_WG0T), MP, 1024, 1024}; EpiGate E1{WSP(float, OFF_MIX)}; pg8::gemm_phase(LL, g1, S, E1); }
    { GETP(); SfGate f{WSP(float, OFF_MIX)}; sgemm(WSP(bf16_t, OFF_HB), WSP(bf16_t, OFF_WG0T), 1024, 32, 256, f); }
    if (PHM & 16) { GETP(); pg8::StaticOrder S; S.init(MP, 1024, gridDim.x, blockIdx.x);
      pg8::Gemm g2{WSP(bf16_t, OFF_PB), WSP(bf16_t, OFF_WP0T), MP, 1024, 256};
      EpiPle E2{WSP(float, OFF_H), WSP(float, OFF_MIX), WSP(bf16_t, OFF_XN), P.in[9] + 1024, WSP(float, OFF_SS1)}; pg8::gemm_phase(LL, g2, S, E2); }
    { GETP(); SfPle f{WSP(float, OFF_H), WSP(float, OFF_MIX), WSP(bf16_t, OFF_XN), P.in[9] + 1024, WSP(float, OFF_SS1)}; sgemm(WSP(bf16_t, OFF_PB), WSP(bf16_t, OFF_WP0T), 256, 32, 256, f); }
    xcd_barrier(xb);
    if (PHM & 32) { GETP(); pg8::StaticOrder S; S.init(MP, INC, gridDim.x, blockIdx.x); pg8::Gemm g{WSP(bf16_t, OFF_XN), WSP(bf16_t, OFF_W1T), MP, INC, 1024};
      EpiStoreBf16 E{WSP(bf16_t, OFF_U), INC, WSP(float, OFF_SS1), nullptr}; pg8::gemm_phase(LL, g, S, E); }
    { GETP(); SfU f{WSP(bf16_t, OFF_U), INC, WSP(float, OFF_SS1), nullptr}; sgemm(WSP(bf16_t, OFF_XN), WSP(bf16_t, OFF_W1T), 1024, 256, 64 * 32, f); }
    xcd_barrier(xb);
    if (PHM & 64) { GETP(); phase_mix1(P, L); }
    xcd_barrier(xb);
    { GETP(); convert_p(P, 1); }
    __syncthreads();
    if (PHM & 128) { GETP(); pg8::StaticOrder S; S.init(MP, 1024, gridDim.x, blockIdx.x); pg8::Gemm g{WSP(bf16_t, OFF_MIX), WSP(bf16_t, OFF_WO1T), MP, 1024, 2048};
      EpiResid E{WSP(float, OFF_H), WSP(float, OFF_H) + (size_t)MP * 1024, WSP(float, OFF_H), WSP(bf16_t, OFF_HB)}; pg8::gemm_phase(LL, g, S, E); }
    { GETP(); SfResid f{WSP(float, OFF_H) + (size_t)MP * 1024, WSP(float, OFF_H), WSP(bf16_t, OFF_HB)}; sgemm(WSP(bf16_t, OFF_MIX), WSP(bf16_t, OFF_WO1T), 2048, 32, 256, f); }
    xcd_barrier(xb);
    if (PHM & 256) { GETP(); pg8::StaticOrder S; S.init(MP, 1024, gridDim.x, blockIdx.x);
      pg8::Gemm g1{WSP(bf16_t, OFF_HB), WSP(bf16_t, OFF_WG1T), MP, 1024, 1024}; EpiGate E1{WSP(float, OFF_MIX)}; pg8::gemm_phase(LL, g1, S, E1); }
    { GETP(); SfGate f{WSP(float, OFF_MIX)}; sgemm(WSP(bf16_t, OFF_HB), WSP(bf16_t, OFF_WG1T), 1024, 32, 256, f); }
    if (PHM & 256) { GETP(); pg8::StaticOrder S; S.init(MP, 1024, gridDim.x, blockIdx.x);
      pg8::Gemm g2{WSP(bf16_t, OFF_PB), WSP(bf16_t, OFF_WP1T), MP, 1024, 256};
      EpiPle E2{WSP(float, OFF_H), WSP(float, OFF_MIX), nullptr, nullptr, WSP(float, OFF_SS2)}; pg8::gemm_phase(LL, g2, S, E2); }
    { GETP(); SfPle f{WSP(float, OFF_H), WSP(float, OFF_MIX), nullptr, nullptr, WSP(float, OFF_SS2)}; sgemm(WSP(bf16_t, OFF_PB), WSP(bf16_t, OFF_WP1T), 256, 32, 256, f); }
    xcd_barrier(xb);
    { GETP(); phase_final(P); }
}

extern "C" void kernel_launch(void* const* d_in, const int* in_sizes, int n_in, void* d_out, int out_size, void* d_ws, size_t ws_size, hipStream_t stream) {
    static int grid = 0;
    if (grid == 0) {
        if (n_in != 32 || ws_size < WS_END) { fprintf(stderr, "kernel_launch: need 32 inputs and %zu bytes of workspace (got %d, %zu)\n", (size_t)WS_END, n_in, ws_size); grid = -1; return; }
        int dev = 0, cus = 0, per_cu = 0;
        (void)hipGetDevice(&dev); (void)hipDeviceGetAttribute(&cus, hipDeviceAttributeMultiprocessorCount, dev);
        if (hipFuncSetAttribute((const void*)fwd_kernel, hipFuncAttributeMaxDynamicSharedMemorySize, LDS_BYTES) != hipSuccess) { fprintf(stderr, "kernel_launch: hipFuncSetAttribute failed\n"); grid = -1; return; }
        if (hipOccupancyMaxActiveBlocksPerMultiprocessor(&per_cu, (const void*)fwd_kernel, 512, LDS_BYTES) != hipSuccess || per_cu < 1) { fprintf(stderr, "kernel_launch: occupancy query says %d\n", per_cu); per_cu = 1; }
        (void)hipGetLastError();
        grid = cus;
    }
    if (grid < 0) return;
    Params p{};
    for (int i = 0; i < 32; ++i) p.in[i] = (const float*)d_in[i];
    p.out = (float*)d_out; p.ws = (unsigned char*)d_ws;
    if (hipMemsetAsync((char*)d_ws + OFF_BAR, 0, 16384, stream) != hipSuccess) { fprintf(stderr, "kernel_launch: memset of barrier words failed\n"); return; }
    void* args[] = {&p};
    hipError_t e = hipLaunchCooperativeKernel((const void*)fwd_kernel, dim3(grid), dim3(512), args, LDS_BYTES, stream);
    if (e != hipSuccess) fprintf(stderr, "cooperative launch failed: %s (grid %d)\n", hipGetErrorString(e), grid);
}
```

```cpp
#include <hip/hip_runtime.h>
#include <hip/hip_cooperative_groups.h>
#include <cstdio>
namespace cg = cooperative_groups;

#define LAS __attribute__((address_space(3)))
#define DI __device__ __forceinline__
typedef unsigned short bf16_t;
typedef short bf16x8 __attribute__((ext_vector_type(8)));
typedef float f32x4 __attribute__((ext_vector_type(4)));
typedef float f32x16 __attribute__((ext_vector_type(16)));

constexpr int MP = 16384, MS = 128, MV = MP + MS, MPAD = 16640;
constexpr int DM = 1024, INAB = 4624, N0 = 4608, INC = 8192;
constexpr float EPSF = 1e-6f;
constexpr size_t O_Y = 0, O_AHP = 16908288, O_ACP = 16916480, O_BSP = 16941056, O_BCP = 17989632, O_CP = 18026496,
                 O_AHS = 20123648, O_ACS = 20254720, O_BSS = 20647936, O_BCS = 37425152, O_CS = 38014976;
constexpr size_t al256(size_t x) { return (x + 255) & ~size_t(255); }
constexpr size_t OFF_CTL = 0;
constexpr size_t OFF_BAR = 256;
constexpr size_t OFF_SS1 = 256 + 16384;
constexpr size_t OFF_SS2 = OFF_SS1 + al256((size_t)MPAD * 4);
constexpr size_t OFF_SSB = OFF_SS2 + al256((size_t)MPAD * 4);
constexpr size_t OFF_DT  = OFF_SSB + al256((size_t)MPAD * 8);
constexpr size_t OFF_W0T = OFF_DT + al256((size_t)MV * 16 * 4);
constexpr size_t OFF_WO0T = OFF_W0T + (size_t)(N0 + 256) * 1024 * 2;
constexpr size_t OFF_WG0T = OFF_WO0T + (size_t)1024 * 2048 * 2;
constexpr size_t OFF_WP0T = OFF_WG0T + (size_t)1024 * 1024 * 2;
constexpr size_t OFF_W1T  = OFF_WP0T + (size_t)1024 * 256 * 2;
constexpr size_t OFF_WO1T = OFF_W1T + (size_t)INC * 1024 * 2;
constexpr size_t OFF_WG1T = OFF_WO1T + (size_t)1024 * 2048 * 2;
constexpr size_t OFF_WP1T = OFF_WG1T + (size_t)1024 * 1024 * 2;
constexpr size_t OFF_WRT  = OFF_WP1T + (size_t)1024 * 256 * 2;
constexpr size_t OFF_WIT  = OFF_WRT + (size_t)128 * 1024 * 2;
constexpr size_t OFF_XN   = OFF_WIT + (size_t)128 * 1024 * 2;
constexpr size_t OFF_MIX  = OFF_XN + (size_t)MPAD * 1024 * 2;
constexpr size_t OFF_H    = OFF_MIX + (size_t)MPAD * 2048 * 2;
constexpr size_t OFF_U    = OFF_H + al256((size_t)MV * 1024 * 4);
constexpr size_t OFF_HB   = OFF_U;
constexpr size_t OFF_PB   = OFF_U + (size_t)MPAD * 1024 * 2;
constexpr size_t WS_END   = OFF_U + al256((size_t)MV * INC * 2);
constexpr int LDS_BYTES = 144 * 1024;

struct Params { const float* in[32]; float* out; unsigned char* ws; };
#define WSP(T, off) ((T*)(P.ws + (off)))

typedef __bf16 bf16v2_t __attribute__((ext_vector_type(2)));
typedef float f32v2_t __attribute__((ext_vector_type(2)));
DI unsigned pack2(float lo, float hi) { f32v2_t v = {lo, hi}; bf16v2_t b = __builtin_convertvector(v, bf16v2_t); return __builtin_bit_cast(unsigned, b); }
DI bf16_t f2bf(float f) { return __builtin_bit_cast(bf16_t, (__bf16)f); }
DI float bf2f(bf16_t b) { return __uint_as_float(((unsigned)b) << 16); }
DI float bflo(unsigned w) { return __uint_as_float(w << 16); }
DI float bfhi(unsigned w) { return __uint_as_float(w & 0xFFFF0000u); }
DI float frcp(float x) { return __builtin_amdgcn_rcpf(x); }
DI float sigm(float x) { return frcp(1.f + __expf(-x)); }
DI float silu(float x) { return x * frcp(1.f + __expf(-x)); }
DI float softplus(float x) { return x > 20.f ? x : log1pf(__expf(x)); }
DI float wave_sum(float v) { for (int o = 32; o > 0; o >>= 1) v += __shfl_xor(v, o); return v; }
DI int otid() { int t = threadIdx.x; asm volatile("" : "+v"(t)); return t; }
DI void lds_barrier() { asm volatile("s_waitcnt lgkmcnt(0)" ::: "memory"); __builtin_amdgcn_s_barrier(); asm volatile("" ::: "memory"); }
DI int crow(int reg, int hh) { return (reg & 3) + 8 * (reg >> 2) + 4 * hh; }
DI void ld4bf(const bf16_t* p, float (&o)[4]) { uint2 w = *(const uint2*)p; o[0] = bflo(w.x); o[1] = bfhi(w.x); o[2] = bflo(w.y); o[3] = bfhi(w.y); }
typedef unsigned u32x2 __attribute__((ext_vector_type(2)));
typedef unsigned u32x4 __attribute__((ext_vector_type(4)));
DI u32x2 pack4v(float a, float b, float c, float d) { u32x2 r; r.x = pack2(a, b); r.y = pack2(c, d); return r; }
DI uint2 pack4(float a, float b, float c, float d) { uint2 r; r.x = pack2(a, b); r.y = pack2(c, d); return r; }
#define MFMA32(a, b, c) __builtin_amdgcn_mfma_f32_32x32x16_bf16((a), (b), (c), 0, 0, 0)
#define MFMA16(a, b, c) __builtin_amdgcn_mfma_f32_16x16x32_bf16((a), (b), (c), 0, 0, 0)
DI bf16x8 ldfrag(const bf16_t* base, int ld, int row0, int k0, int lane) { return *(const bf16x8*)(base + (row0 + (lane & 31)) * ld + k0 + 8 * (lane >> 5)); }
DI bf16x8 ldfrag16(const bf16_t* base, int ld, int row0, int k0, int lane) { return *(const bf16x8*)(base + (row0 + (lane & 15)) * ld + k0 + 8 * (lane >> 4)); }

namespace pg8 {
constexpr int BM = 256, BK = 64, HALF = 128, HTB = HALF * BK * 2, STAGE_BYTES = 8 * HTB, NXCD = 8, WGM = 8;
DI int lds_byte(int r, int c) { const int st = (r >> 4) * 2 + (c >> 5), rr = r & 15, cc = c & 31, ob = rr * 64 + cc * 2; return st * 1024 + (ob ^ (((ob >> 9) & 1) << 5)); }
DI void stage_rc(int b, int& R, int& C) { const int st = b / 1024, sb = b % 1024, swz = sb ^ (((sb >> 9) & 1) << 5); R = (st >> 1) * 16 + swz / 64; C = (st & 1) * 32 + (swz % 64) / 2; }
DI int perm32(int rho) { const int n = rho >> 4, i = rho & 15; return 8 * (i >> 2) + 4 * n + (i & 3); }
struct Unit { int pm, pn; };
struct Gemm { const bf16_t* A; const bf16_t* Bt; int M, N, K; };
struct StaticOrder {
    int nM, nN, nwg, G, c;
    DI void init(int M, int N, int G_, int c_) { nM = M / BM; nN = N / BM; nwg = nM * nN; G = G_; c = c_; }
    DI bool next(int i, Unit& u) const {
        const long L = (long)i * G + c; if (L >= nwg) return false;
        int wgid = (int)L; { const int q = nwg / NXCD, r = nwg % NXCD, xcd = wgid % NXCD, off = wgid / NXCD; wgid = (xcd < r ? xcd * (q + 1) : r * (q + 1) + (xcd - r) * q) + off; }
        const int nig = WGM * nN, gid = wgid / nig, fm = gid * WGM, gsz = (nM - fm) < WGM ? (nM - fm) : WGM;
        u.pm = fm + ((wgid % nig) % gsz); u.pn = (wgid % nig) / gsz; return true;
    }
};

template <class Epi>
DI void gemm_phase(LAS unsigned char* lds, const Gemm g, const StaticOrder& S, const Epi& E) {
    const int tid = otid(), wid = __builtin_amdgcn_readfirstlane(tid >> 6), lane = tid & 63, wr = wid >> 2, wc = wid & 3, fr = lane & 15, fq = lane >> 4;
    const int K = g.K, nt = K / BK;
    unsigned voffA[2], voffB[2];
#pragma unroll
    for (int i = 0; i < 2; ++i) { int R, C; stage_rc(tid * 16 + i * 8192, R, C); const int Rb = Epi::PERM ? ((R & ~31) + perm32(R & 31)) : R;
        voffA[i] = (unsigned)(R * K + C) * 2u; voffB[i] = (unsigned)(Rb * K + C) * 2u; }
    const size_t kstep = (size_t)(BK * 2);
    const size_t hstep = (size_t)HALF * K * 2;
    const size_t tstep = 2 * hstep;
    const unsigned ldsw = (unsigned)wid * 1024u;
    const int aoff = lds_byte(wr * 64 + fr, fq * 8), boff = lds_byte(wc * 32 + fr, fq * 8);
#define PG8_SA(b, h) (((b) * 2 + (h)) * HTB)
#define PG8_SB(b, h) ((4 + (b) * 2 + (h)) * HTB)
#define PG8_STAGE(bufoff, gbase, voff) do { _Pragma("unroll") for (int _i = 0; _i < 2; ++_i) \
        __builtin_amdgcn_global_load_lds((const unsigned*)((const char*)(gbase) + (voff)[_i]), (LAS unsigned*)(lds + (bufoff) + ldsw + _i * 8192), 16, 0, 0); } while (0)
#define PG8_LDA(dst, b, h) do { _Pragma("unroll") for (int m = 0; m < 4; ++m) _Pragma("unroll") for (int k = 0; k < 2; ++k) dst[m][k] = *(const LAS bf16x8*)(lds + PG8_SA(b, h) + aoff + m * 2048 + k * 1024); } while (0)
#define PG8_LDB(dst, b, h) do { _Pragma("unroll") for (int n = 0; n < 2; ++n) _Pragma("unroll") for (int k = 0; k < 2; ++k) dst[n][k] = *(const LAS bf16x8*)(lds + PG8_SB(b, h) + boff + n * 2048 + k * 1024); } while (0)
#define PG8_MMA(ai, bj, At, Bt) do { __builtin_amdgcn_s_setprio(1); _Pragma("unroll") for (int m = 0; m < 4; ++m) _Pragma("unroll") for (int n = 0; n < 2; ++n) _Pragma("unroll") for (int k = 0; k < 2; ++k) \
        acc[ai][bj][m][n] = __builtin_amdgcn_mfma_f32_16x16x32_bf16(Bt[n][k], At[m][k], acc[ai][bj][m][n], 0, 0, 0); __builtin_amdgcn_s_setprio(0); } while (0)
#define PG8_WAIT_V(n) asm volatile("s_waitcnt vmcnt(" #n ")" ::: "memory")
#define PG8_WAIT_L(n) asm volatile("s_waitcnt lgkmcnt(" #n ")" ::: "memory")
#define PG8_BAR __builtin_amdgcn_s_barrier()
#define PG8_SCHED __builtin_amdgcn_sched_barrier(0)
    Unit cur, nxt; int ui = 0;
    if (!S.next(0, cur)) return;
    f32x4 acc[2][2][4][2];
#pragma unroll
    for (int a = 0; a < 2; ++a)
#pragma unroll
        for (int b = 0; b < 2; ++b)
#pragma unroll
            for (int m = 0; m < 4; ++m)
#pragma unroll
                for (int n = 0; n < 2; ++n) acc[a][b][m][n] = (f32x4){0.f, 0.f, 0.f, 0.f};
    bf16x8 At[4][2], B0[2][2], B1[2][2];
    const char* cA = (const char*)g.A + (size_t)cur.pm * tstep; const char* cB = (const char*)g.Bt + (size_t)cur.pn * tstep;
    PG8_STAGE(PG8_SB(0, 0), cB, voffB); PG8_STAGE(PG8_SA(0, 0), cA, voffA); PG8_STAGE(PG8_SB(0, 1), cB + hstep, voffB); PG8_STAGE(PG8_SA(0, 1), cA + hstep, voffA);
    if (wr == 1) PG8_BAR;
    PG8_WAIT_V(4); PG8_BAR;
    PG8_STAGE(PG8_SB(1, 0), cB + kstep, voffB); PG8_STAGE(PG8_SA(1, 0), cA + kstep, voffA); PG8_STAGE(PG8_SB(1, 1), cB + hstep + kstep, voffB);
    PG8_WAIT_V(6); PG8_BAR;
    for (;;) {
        const bool has_next = S.next(ui + 1, nxt);
        const char* nA = has_next ? (const char*)g.A + (size_t)nxt.pm * tstep : cA; const char* nB = has_next ? (const char*)g.Bt + (size_t)nxt.pn * tstep : cB;
        for (int t = 0; t < nt; t += 2) {
            const bool last = (t == nt - 2);
            const char* a1 = cA + (size_t)(t + 1) * kstep;
            const char* a2 = last ? nA : cA + (size_t)(t + 2) * kstep; const char* b2 = last ? nB : cB + (size_t)(t + 2) * kstep;
            const char* a3 = a2 + kstep; const char* b3 = b2 + kstep;
            PG8_LDB(B0, 0, 0); PG8_SCHED; PG8_LDA(At, 0, 0); PG8_STAGE(PG8_SA(1, 1), a1 + hstep, voffA);
            PG8_WAIT_L(8); PG8_BAR; PG8_WAIT_L(0); PG8_MMA(0, 0, At, B0); PG8_BAR; PG8_SCHED;
            PG8_LDB(B1, 0, 1); PG8_STAGE(PG8_SB(0, 0), b2, voffB);
            PG8_BAR; PG8_WAIT_L(0); PG8_MMA(0, 1, At, B1); PG8_BAR;
            PG8_LDA(At, 0, 1); PG8_STAGE(PG8_SA(0, 0), a2, voffA);
            PG8_BAR; PG8_WAIT_L(0); PG8_MMA(1, 0, At, B0); PG8_BAR; PG8_SCHED;
            PG8_STAGE(PG8_SB(0, 1), b2 + hstep, voffB);
            PG8_WAIT_V(6); PG8_BAR; PG8_MMA(1, 1, At, B1); PG8_BAR;
            PG8_LDB(B0, 1, 0); PG8_SCHED; PG8_LDA(At, 1, 0); PG8_STAGE(PG8_SA(0, 1), a2 + hstep, voffA);
            PG8_WAIT_L(8); PG8_BAR; PG8_WAIT_L(0); PG8_MMA(0, 0, At, B0); PG8_BAR; PG8_SCHED;
            PG8_LDB(B1, 1, 1); PG8_STAGE(PG8_SB(1, 0), b3, voffB);
            PG8_BAR; PG8_WAIT_L(0); PG8_MMA(0, 1, At, B1); PG8_BAR;
            PG8_LDA(At, 1, 1); PG8_STAGE(PG8_SA(1, 0), a3, voffA);
            PG8_BAR; PG8_WAIT_L(0); PG8_MMA(1, 0, At, B0); PG8_BAR; PG8_SCHED;
            PG8_STAGE(PG8_SB(1, 1), b3 + hstep, voffB);
            PG8_WAIT_V(6); PG8_BAR; PG8_MMA(1, 1, At, B1); PG8_BAR;
        }
        E(acc, cur, wr, wc, fr, fq);
        if (!has_next) break;
#pragma unroll
        for (int a = 0; a < 2; ++a)
#pragma unroll
            for (int b = 0; b < 2; ++b)
#pragma unroll
                for (int m = 0; m < 4; ++m)
#pragma unroll
                    for (int n = 0; n < 2; ++n) acc[a][b][m][n] = (f32x4){0.f, 0.f, 0.f, 0.f};
        cur = nxt; cA = nA; cB = nB; ++ui;
    }
    PG8_WAIT_V(0);
    if (wr == 0) PG8_BAR;
    PG8_BAR;
#undef PG8_SA
#undef PG8_SB
#undef PG8_STAGE
#undef PG8_LDA
#undef PG8_LDB
#undef PG8_MMA
#undef PG8_WAIT_V
#undef PG8_WAIT_L
#undef PG8_BAR
#undef PG8_SCHED
}
}

struct EpiStoreBf16 {
    static constexpr bool PERM = true;
    bf16_t* O; int ldc; const float* ss; float* DT;
    DI void operator()(const f32x4 (&acc)[2][2][4][2], const pg8::Unit& u, int wr, int wc, int fr, int fq) const {
        const int row0 = u.pm * 256 + wr * 64 + fr, col0 = u.pn * 256 + wc * 32 + 8 * fq;
        if (u.pn * 256 >= ldc) {
            if (wc == 0 && fq < 2) {
#pragma unroll
                for (int ai = 0; ai < 2; ++ai)
#pragma unroll
                    for (int m = 0; m < 4; ++m) { const int row = row0 + ai * 128 + m * 16;
                        if (row < MV) { *(f32x4*)(DT + (size_t)row * 16 + 8 * fq) = acc[ai][0][m][0]; *(f32x4*)(DT + (size_t)row * 16 + 8 * fq + 4) = acc[ai][0][m][1]; } }
            }
            return;
        }
#pragma unroll
        for (int ai = 0; ai < 2; ++ai)
#pragma unroll
            for (int m = 0; m < 4; ++m) {
                const int row = row0 + ai * 128 + m * 16;
                if (row < MV) {
                    const float sc = ss ? rsqrtf(ss[row] * (1.f / 1024.f) + EPSF) : 1.f;
                    bf16_t* rp = O + (size_t)row * ldc + col0;
#pragma unroll
                    for (int bj = 0; bj < 2; ++bj) {
                        const f32x4 v0 = acc[ai][bj][m][0] * sc, v1 = acc[ai][bj][m][1] * sc;
                        uint4 w; w.x = pack2(v0[0], v0[1]); w.y = pack2(v0[2], v0[3]); w.z = pack2(v1[0], v1[1]); w.w = pack2(v1[2], v1[3]);
                        *(uint4*)(rp + bj * 128) = w;
                    }
                }
            }
    }
};
struct EpiResid {
    static constexpr bool PERM = false;
    const float* rp_prompt; const float* rp_sample;
    float* H; bf16_t* HB;
    DI void operator()(const f32x4 (&acc)[2][2][4][2], const pg8::Unit& u, int wr, int wc, int fr, int fq) const {
        const int row0 = u.pm * 256 + wr * 64 + fr, col0 = u.pn * 256 + wc * 32 + 4 * fq;
#pragma unroll
        for (int ai = 0; ai < 2; ++ai)
#pragma unroll
            for (int m = 0; m < 4; ++m) {
                const int row = row0 + ai * 128 + m * 16;
                if (row < MV) {
                    const float* rs = (row < MP ? rp_prompt + (size_t)row * 1024 : rp_sample + (size_t)(row - MP) * 1024) + col0;
                    float* hp = H + (size_t)row * 1024 + col0; bf16_t* bp = HB + (size_t)row * 1024 + col0;
#pragma unroll
                    for (int bj = 0; bj < 2; ++bj)
#pragma unroll
                        for (int n = 0; n < 2; ++n) {
                            const int co = bj * 128 + n * 16;
                            const f32x4 v = acc[ai][bj][m][n] + *(const f32x4*)(rs + co);
                            *(f32x4*)(hp + co) = v; *(uint2*)(bp + co) = pack4(v[0], v[1], v[2], v[3]);
                        }
                }
            }
    }
};
struct EpiGate {
    static constexpr bool PERM = false;
    float* Gt;
    DI void operator()(const f32x4 (&acc)[2][2][4][2], const pg8::Unit& u, int wr, int wc, int fr, int fq) const {
        const int row0 = u.pm * 256 + wr * 64 + fr, col0 = u.pn * 256 + wc * 32 + 4 * fq;
#pragma unroll
        for (int ai = 0; ai < 2; ++ai)
#pragma unroll
            for (int m = 0; m < 4; ++m) {
                const int row = row0 + ai * 128 + m * 16;
                if (row < MV) {
                    float* gp = Gt + (size_t)row * 1024 + col0;
#pragma unroll
                    for (int bj = 0; bj < 2; ++bj)
#pragma unroll
                        for (int n = 0; n < 2; ++n) {
                            const f32x4 a = acc[ai][bj][m][n];
                            *(f32x4*)(gp + bj * 128 + n * 16) = (f32x4){sigm(a[0]), sigm(a[1]), sigm(a[2]), sigm(a[3])};
                        }
                }
            }
    }
};
struct EpiPle {
    static constexpr bool PERM = false;
    float* H; const float* Gt; bf16_t* XN; const float* nw; float* SS;
    DI void operator()(const f32x4 (&acc)[2][2][4][2], const pg8::Unit& u, int wr, int wc, int fr, int fq) const {
        const int row0 = u.pm * 256 + wr * 64 + fr, col0 = u.pn * 256 + wc * 32 + 4 * fq;
#pragma unroll
        for (int ai = 0; ai < 2; ++ai)
#pragma unroll
            for (int m = 0; m < 4; ++m) {
                const int row = row0 + ai * 128 + m * 16;
                float ssum = 0.f;
                if (row < MV) {
                    float* hp = H + (size_t)row * 1024 + col0; const float* gp = Gt + (size_t)row * 1024 + col0;
#pragma unroll
                    for (int bj = 0; bj < 2; ++bj)
#pragma unroll
                        for (int n = 0; n < 2; ++n) {
                            const int co = bj * 128 + n * 16;
                            const f32x4 v = *(const f32x4*)(hp + co) + *(const f32x4*)(gp + co) * acc[ai][bj][m][n];
                            *(f32x4*)(hp + co) = v;
                            ssum += v[0] * v[0] + v[1] * v[1] + v[2] * v[2] + v[3] * v[3];
                            if (XN) { const f32x4 w = *(const f32x4*)(nw + col0 + co); *(uint2*)(XN + (size_t)row * 1024 + col0 + co) = pack4(v[0] * w[0], v[1] * w[1], v[2] * w[2], v[3] * w[3]); }
                        }
                }
                ssum += __shfl_xor(ssum, 16); ssum += __shfl_xor(ssum, 32);
                if (fq == 0 && row < MV) atomicAdd(SS + row, ssum);
            }
    }
};

template <class F>
DI void sgemm(const bf16_t* A, const bf16_t* Bt, int K, int ntask, int nwg_main, const F& f) {
    const int tid = otid(), lane = tid & 63, wid = tid >> 6;
    const int G = gridDim.x, off = nwg_main % G;
    int li = blockIdx.x, nl = G;
    if (off != 0) { if ((int)blockIdx.x < off) return; li = blockIdx.x - off; nl = G - off; }
    for (int t = li; t < ntask; t += nl) {
        const bf16_t* ap = A + (size_t)(MP + wid * 16 + (lane & 15)) * K + 8 * (lane >> 4);
        const bf16_t* bp0 = Bt + (size_t)(t * 32 + (lane & 15)) * K + 8 * (lane >> 4);
        const bf16_t* bp1 = bp0 + (size_t)16 * K;
        f32x4 acc0 = {0.f, 0.f, 0.f, 0.f}, acc1 = {0.f, 0.f, 0.f, 0.f};
        for (int k0 = 0; k0 < K; k0 += 256) {
            bf16x8 a[8], b0[8], b1[8];
#pragma unroll
            for (int q = 0; q < 8; ++q) { a[q] = *(const bf16x8*)(ap + k0 + q * 32); b0[q] = *(const bf16x8*)(bp0 + k0 + q * 32); b1[q] = *(const bf16x8*)(bp1 + k0 + q * 32); }
#pragma unroll
            for (int q = 0; q < 8; ++q) { acc0 = MFMA16(a[q], b0[q], acc0); acc1 = MFMA16(a[q], b1[q], acc1); }
        }
#pragma unroll
        for (int reg = 0; reg < 4; ++reg) {
            const int row = MP + wid * 16 + (lane >> 4) * 4 + reg, col = t * 32 + (lane & 15);
            f(row, col, acc0[reg], lane); f(row, col + 16, acc1[reg], lane);
        }
    }
}
struct SfU { bf16_t* O; int ldc; const float* ss; float* DT;
    DI void operator()(int row, int col, float v, int) const {
        if (col >= ldc) { if (col < ldc + 16) DT[(size_t)row * 16 + col - ldc] = v; return; }
        const float sc = ss ? rsqrtf(ss[row] * (1.f / 1024.f) + EPSF) : 1.f; O[(size_t)row * ldc + col] = f2bf(v * sc); } };
struct SfResid { const float* rs; float* H; bf16_t* HB;
    DI void operator()(int row, int col, float v, int) const { const float h = rs[(size_t)(row - MP) * 1024 + col] + v; H[(size_t)row * 1024 + col] = h; HB[(size_t)row * 1024 + col] = f2bf(h); } };
struct SfGate { float* Gt; DI void operator()(int row, int col, float v, int) const { Gt[(size_t)row * 1024 + col] = sigm(v); } };
struct SfPle { float* H; const float* Gt; bf16_t* XN; const float* nw; float* SS;
    DI void operator()(int row, int col, float v, int lane) const {
        const size_t o = (size_t)row * 1024 + col; const float h = H[o] + Gt[o] * v; H[o] = h;
        if (XN) XN[o] = f2bf(h * nw[col]);
        float ss = h * h; ss += __shfl_xor(ss, 1); ss += __shfl_xor(ss, 2); ss += __shfl_xor(ss, 4); ss += __shfl_xor(ss, 8);
        if ((lane & 15) == 0) atomicAdd(SS + row, ss); } };

DI void transpose_tile_w(const float* src, int lds_, bf16_t* dst, int ldd, int k0, int n0, int nvalid, float* tile, int lane) {
    const float* sp = src + (size_t)k0 * lds_ + n0 + lane;
#pragma unroll
    for (int bt = 0; bt < 4; ++bt) {
        float v[16];
#pragma unroll
        for (int r = 0; r < 16; ++r) v[r] = (lane < nvalid) ? sp[(size_t)(bt * 16 + r) * lds_] : 0.f;
#pragma unroll
        for (int r = 0; r < 16; ++r) tile[(bt * 16 + r) * 65 + lane] = v[r];
    }
    const int koct = lane & 7;
#pragma unroll
    for (int p = 0; p < 8; ++p) {
        const int nn = (lane >> 3) + 8 * p;
        const float* tp = tile + (koct * 8) * 65 + nn;
        uint4 w;
        w.x = pack2(tp[0], tp[65]); w.y = pack2(tp[2 * 65], tp[3 * 65]); w.z = pack2(tp[4 * 65], tp[5 * 65]); w.w = pack2(tp[6 * 65], tp[7 * 65]);
        *(uint4*)(dst + (size_t)(n0 + nn) * ldd + k0 + koct * 8) = w;
    }
}
DI void transpose_job(const float* src, int lds_, bf16_t* dst, int ldd, int K, int N, int nvalid_last, int& base, float* tile, int gw, int nwv, int lane) {
    const int ntn = (N + 63) / 64, nt = (K / 64) * ntn;
    const int first = (gw - (base % nwv) + nwv) % nwv;
    for (int t = first; t < nt; t += nwv) { const int tn = t % ntn; transpose_tile_w(src, lds_, dst, ldd, (t / ntn) * 64, tn * 64, (tn == ntn - 1) ? nvalid_last : 64, tile, lane); }
    base += nt;
}
DI void phase_prep(const Params& P, unsigned char* L) {
    const int tid = otid(), lane = tid & 63, wid = tid >> 6;
    const int gw = blockIdx.x * 8 + wid, nwv = gridDim.x * 8;
    { float* z = WSP(float, OFF_SS1); const int n = (int)((OFF_DT - OFF_SS1) / 4);
      for (int i = blockIdx.x * 512 + tid; i < n; i += gridDim.x * 512) z[i] = 0.f;
      if (blockIdx.x == 0 && tid < 64) WSP(unsigned, OFF_CTL)[tid] = 0u; }
    { float* tile = (float*)L + wid * (64 * 65); int base = 0;
      transpose_job(P.in[26], INC, WSP(bf16_t, OFF_W1T), 1024, 1024, INC, 64, base, tile, gw, nwv, lane);
      transpose_job(P.in[11], INAB, WSP(bf16_t, OFF_W0T), 1024, 1024, N0, 64, base, tile, gw, nwv, lane);
      transpose_job(P.in[11] + N0, INAB, WSP(bf16_t, OFF_W0T) + (size_t)N0 * 1024, 1024, 1024, 16, 16, base, tile, gw, nwv, lane);
      transpose_job(P.in[25], 1024, WSP(bf16_t, OFF_WO0T), 2048, 2048, 1024, 64, base, tile, gw, nwv, lane);
      transpose_job(P.in[31], 1024, WSP(bf16_t, OFF_WG0T), 1024, 1024, 1024, 64, base, tile, gw, nwv, lane);
      transpose_job(P.in[30], 1024, WSP(bf16_t, OFF_WP0T), 256, 256, 1024, 64, base, tile, gw, nwv, lane);
      transpose_job(P.in[29], 1024, WSP(bf16_t, OFF_WO1T), 2048, 2048, 1024, 64, base, tile, gw, nwv, lane);
      transpose_job(P.in[31] + 1024 * 1024, 1024, WSP(bf16_t, OFF_WG1T), 1024, 1024, 1024, 64, base, tile, gw, nwv, lane);
      transpose_job(P.in[30] + 256 * 1024, 1024, WSP(bf16_t, OFF_WP1T), 256, 256, 1024, 64, base, tile, gw, nwv, lane);
      transpose_job(P.in[14], 128, WSP(bf16_t, OFF_WRT), 1024, 1024, 128, 64, base, tile, gw, nwv, lane);
      transpose_job(P.in[16], 128, WSP(bf16_t, OFF_WIT), 1024, 1024, 128, 64, base, tile, gw, nwv, lane); }
    { const float* nwp = P.in[9]; bf16_t* XN = WSP(bf16_t, OFF_XN);
      f32x4 w4[4];
#pragma unroll
      for (int i = 0; i < 4; ++i) w4[i] = *(const f32x4*)(nwp + lane * 4 + 256 * i);
      for (int r0 = gw * 2; r0 < MV; r0 += nwv * 2) {
          f32x4 x[2][4];
#pragma unroll
          for (int q = 0; q < 2; ++q) { const int r = r0 + q; const float* src = r < MP ? P.in[0] + (size_t)r * 1024 : P.in[1] + (size_t)(r - MP) * 1024;
#pragma unroll
              for (int i = 0; i < 4; ++i) x[q][i] = *(const f32x4*)(src + lane * 4 + 256 * i); }
#pragma unroll
          for (int q = 0; q < 2; ++q) {
              float ss = 0.f;
#pragma unroll
              for (int i = 0; i < 4; ++i) ss += x[q][i][0] * x[q][i][0] + x[q][i][1] * x[q][i][1] + x[q][i][2] * x[q][i][2] + x[q][i][3] * x[q][i][3];
              ss = wave_sum(ss); const float rstd = rsqrtf(ss * (1.f / 1024.f) + EPSF);
#pragma unroll
              for (int i = 0; i < 4; ++i) { const f32x4 v = x[q][i] * rstd * w4[i]; *(uint2*)(XN + (size_t)(r0 + q) * 1024 + lane * 4 + 256 * i) = pack4(v[0], v[1], v[2], v[3]); }
          }
      } }
}
DI void convert_p(const Params& P, int layer) {
    bf16_t* PB = WSP(bf16_t, OFF_PB);
    const float* pp = P.in[2] + (size_t)layer * MP * 256; const float* ps = P.in[3] + (size_t)layer * MS * 256;
    for (int i = blockIdx.x * 512 + threadIdx.x; i < MV * 64; i += gridDim.x * 512) {
        const int row = i >> 6, c4 = (i & 63) * 4;
        const f32x4 v = *(const f32x4*)((row < MP ? pp + (size_t)row * 256 : ps + (size_t)(row - MP) * 256) + c4);
        *(uint2*)(PB + (size_t)row * 256 + c4) = pack4(v[0], v[1], v[2], v[3]);
    }
}

constexpr size_t OFF_XT = OFF_XN;
constexpr size_t OFF_CN = OFF_H;
constexpr size_t OFF_BN = OFF_CN + (size_t)MP * 256 * 2;
constexpr size_t OFF_BT = OFF_BN + (size_t)MP * 256 * 2;
DI void phase_convbc(const Params& P) {
    const bf16_t* U = WSP(bf16_t, OFF_U);
    bf16_t* XT = WSP(bf16_t, OFF_XT); bf16_t* CN = WSP(bf16_t, OFF_CN); bf16_t* BN = WSP(bf16_t, OFF_BN); bf16_t* BT = WSP(bf16_t, OFF_BT);
    for (int idx = blockIdx.x * 512 + otid(); idx < 2048 * 384; idx += gridDim.x * 512) {
        const int quad = idx % 384, tgp = idx / 384, b = tgp >> 8, t0 = (tgp & 255) * 8, cch = quad * 4;
        float cw[4][4], cbias[4];
#pragma unroll
        for (int kk = 0; kk < 4; ++kk) { const f32x4 w = *(const f32x4*)(P.in[19] + kk * 1536 + cch); cw[kk][0] = w[0]; cw[kk][1] = w[1]; cw[kk][2] = w[2]; cw[kk][3] = w[3]; }
        { const f32x4 w = *(const f32x4*)(P.in[20] + cch); cbias[0] = w[0]; cbias[1] = w[1]; cbias[2] = w[2]; cbias[3] = w[3]; }
        const unsigned voff = (unsigned)((b * 2048 + t0) * N0 + 3072 + cch);
        uint2 raw[11];
#pragma unroll
        for (int j = 0; j < 11; ++j) raw[j] = (t0 + j - 3 >= 0) ? *(const uint2*)((U + (j - 3) * N0) + voff) : make_uint2(0u, 0u);
        float y[8][4];
#pragma unroll
        for (int j = 0; j < 8; ++j) {
            const float x0[4] = {bflo(raw[j].x), bfhi(raw[j].x), bflo(raw[j].y), bfhi(raw[j].y)};
            const float x1[4] = {bflo(raw[j + 1].x), bfhi(raw[j + 1].x), bflo(raw[j + 1].y), bfhi(raw[j + 1].y)};
            const float x2[4] = {bflo(raw[j + 2].x), bfhi(raw[j + 2].x), bflo(raw[j + 2].y), bfhi(raw[j + 2].y)};
            const float x3[4] = {bflo(raw[j + 3].x), bfhi(raw[j + 3].x), bflo(raw[j + 3].y), bfhi(raw[j + 3].y)};
#pragma unroll
            for (int e = 0; e < 4; ++e) y[j][e] = silu(cbias[e] + cw[0][e] * x0[e] + cw[1][e] * x1[e] + cw[2][e] * x2[e] + cw[3][e] * x3[e]);
        }
        const int c = t0 >> 7, tl = t0 & 127;
        if (cch < 1024) {
#pragma unroll
            for (int e = 0; e < 4; ++e) { uint4 w; w.x = pack2(y[0][e], y[1][e]); w.y = pack2(y[2][e], y[3][e]); w.z = pack2(y[4][e], y[5][e]); w.w = pack2(y[6][e], y[7][e]);
                *(uint4*)(XT + ((size_t)((b * 16 + c) * 1024 + cch + e)) * 128 + tl) = w; }
        } else {
            const int cc = cch - 1024, isC = cc >= 256, g = (cc & 255) >> 7, n0 = cc & 127;
            bf16_t* nat = (isC ? CN : BN) + ((size_t)(((b * 16 + c) * 2 + g) * 128 + tl)) * 128 + n0;
#pragma unroll
            for (int j = 0; j < 8; ++j) *(uint2*)(nat + j * 128) = pack4(y[j][0], y[j][1], y[j][2], y[j][3]);
            if (!isC) {
#pragma unroll
                for (int e = 0; e < 4; ++e) { uint4 w; w.x = pack2(y[0][e], y[1][e]); w.y = pack2(y[2][e], y[3][e]); w.z = pack2(y[4][e], y[5][e]); w.w = pack2(y[6][e], y[7][e]);
                    *(uint4*)(BT + ((size_t)(((b * 16 + c) * 2 + g) * 128 + n0 + e)) * 128 + tl) = w; }
            }
        }
    }
}
DI void ssd_prompt_item(const Params& P, unsigned char* L, int item) {
    const int b = item >> 4, h = item & 15, g = h >> 3;
    const int tid0 = otid(), wid = tid0 >> 6;
    bf16_t* Cs = (bf16_t*)L;
    bf16_t* Bs = Cs + 128 * 136;
    bf16_t* BsT = Bs + 128 * 136;
    bf16_t* XsT = BsT + 128 * 136;
    bf16_t* St = XsT + 64 * 136;
    float* dtvB = (float*)(St + 64 * 136); float* acsB = dtvB + 256; float* wvB = acsB + 256;
    const bf16_t* U = WSP(bf16_t, OFF_U); const float* DT = WSP(float, OFF_DT); bf16_t* MIX = WSP(bf16_t, OFF_MIX); float* SSB = WSP(float, OFF_SSB);
    const float a_neg = -__expf(P.in[22][h]), dtb = P.in[21][h], Dh = P.in[23][h];
    f32x16 accS;
#pragma unroll
    for (int i = 0; i < 16; ++i) accS[i] = 0.f;
    lds_barrier();
    for (int i = tid0; i < 64 * 136; i += 512) St[i] = 0;
    float dtr0 = 0.f, dtr1 = 0.f;
#define SSD_DTLOAD(cc) do { if (wid == 0) { const float* dp_ = DT + (size_t)(b * 2048 + (cc) * 128 + (tid0 & 63)) * 16 + h; dtr0 = dp_[0]; dtr1 = dp_[64 * 16]; } } while (0)
#define SSD_SCAN(buf) do { if (wid == 0) { const int ln_ = tid0 & 63; const float d0_ = softplus(dtr0 + dtb), d1_ = softplus(dtr1 + dtb); float v0_ = d0_ * a_neg, v1_ = d1_ * a_neg; \
        _Pragma("unroll") for (int o_ = 1; o_ < 64; o_ <<= 1) { const float n0_ = __shfl_up(v0_, o_), n1_ = __shfl_up(v1_, o_); if (ln_ >= o_) { v0_ += n0_; v1_ += n1_; } } \
        v1_ += __shfl(v0_, 63); const float al_ = __shfl(v1_, 63); \
        dtvB[(buf) * 128 + ln_] = d0_; dtvB[(buf) * 128 + 64 + ln_] = d1_; acsB[(buf) * 128 + ln_] = v0_; acsB[(buf) * 128 + 64 + ln_] = v1_; \
        wvB[(buf) * 128 + ln_] = __expf(al_ - v0_) * d0_; wvB[(buf) * 128 + 64 + ln_] = __expf(al_ - v1_) * d1_; } } while (0)
    SSD_DTLOAD(0); SSD_SCAN(0); SSD_DTLOAD(1);
    u32x4 tC[4], tB[4], tT[4], tX[2];
    for (int c = 0; c < 16; ++c) {
        const int row0 = b * 2048 + c * 128;
        lds_barrier();
        int zv = 0; asm volatile("" : "+v"(zv));
        const int tid = tid0 + zv, lane = tid & 63, hh = lane >> 5, l31 = lane & 31;
        const int prow = tid >> 4, pcol = (tid & 15) * 8;
        const float* dtv = dtvB + (c & 1) * 128; const float* acs = acsB + (c & 1) * 128; const float* wv = wvB + (c & 1) * 128;
        if (c + 1 < 16) { SSD_SCAN((c + 1) & 1); if (c + 2 < 16) SSD_DTLOAD(c + 2); }
        if (c == 0) {
            const size_t tb_ = ((size_t)((b * 16 + c) * 2 + g)) * 128 * 128 + (size_t)prow * 128 + pcol;
            const u32x4* pc = (const u32x4*)(WSP(bf16_t, OFF_CN) + tb_); const u32x4* pb = (const u32x4*)(WSP(bf16_t, OFF_BN) + tb_); const u32x4* pt = (const u32x4*)(WSP(bf16_t, OFF_BT) + tb_);
            const u32x4* px = (const u32x4*)(WSP(bf16_t, OFF_XT) + ((size_t)((b * 16 + c) * 1024 + h * 64 + prow)) * 128 + pcol);
#pragma unroll
            for (int i = 0; i < 4; ++i) { tC[i] = pc[i * 512]; tB[i] = pb[i * 512]; tT[i] = pt[i * 512]; }
            tX[0] = px[0]; tX[1] = px[512];
        }
        const float a_last = acs[127];
#pragma unroll
        for (int i = 0; i < 4; ++i) {
            *(u32x4*)(Cs + (prow + 32 * i) * 136 + pcol) = tC[i]; *(u32x4*)(Bs + (prow + 32 * i) * 136 + pcol) = tB[i]; *(u32x4*)(BsT + (prow + 32 * i) * 136 + pcol) = tT[i];
        }
        *(u32x4*)(XsT + prow * 136 + pcol) = tX[0]; *(u32x4*)(XsT + (prow + 32) * 136 + pcol) = tX[1];
        if (c + 1 < 16) {
            const size_t tb_ = ((size_t)((b * 16 + c + 1) * 2 + g)) * 128 * 128 + (size_t)prow * 128 + pcol;
            const u32x4* pc = (const u32x4*)(WSP(bf16_t, OFF_CN) + tb_); const u32x4* pb = (const u32x4*)(WSP(bf16_t, OFF_BN) + tb_); const u32x4* pt = (const u32x4*)(WSP(bf16_t, OFF_BT) + tb_);
            const u32x4* px = (const u32x4*)(WSP(bf16_t, OFF_XT) + ((size_t)((b * 16 + c + 1) * 1024 + h * 64 + prow)) * 128 + pcol);
#pragma unroll
            for (int i = 0; i < 4; ++i) { tC[i] = pc[i * 512]; tB[i] = pb[i * 512]; tT[i] = pt[i * 512]; }
            tX[0] = px[0]; tX[1] = px[512];
        }
        bf16_t zr[16];
        {
            const unsigned zoff = (unsigned)((row0 + (wid >> 1) * 32 + 4 * hh) * N0 + 2048 + h * 64 + (wid & 1) * 32 + l31);
#pragma unroll
            for (int reg = 0; reg < 16; ++reg) zr[reg] = (U + ((reg & 3) + 8 * (reg >> 2)) * N0)[zoff];
        }
        lds_barrier();
        {
            const int rb = (wid >> 1) * 32, cb0 = (wid & 1) * 64;
            f32x16 cbA[2];
#pragma unroll
            for (int i = 0; i < 16; ++i) { cbA[0][i] = 0.f; cbA[1][i] = 0.f; }
#pragma unroll
            for (int ks = 0; ks < 8; ++ks) {
                const bf16x8 a = ldfrag(Cs, 136, rb, ks * 16, lane);
                cbA[0] = MFMA32(a, ldfrag(Bs, 136, cb0, ks * 16, lane), cbA[0]);
                cbA[1] = MFMA32(a, ldfrag(Bs, 136, cb0 + 32, ks * 16, lane), cbA[1]);
            }
            lds_barrier();
            bf16_t* Ws = Bs;
#pragma unroll
            for (int j = 0; j < 2; ++j) {
                const int s = cb0 + j * 32 + l31; const float as = acs[s], ds = dtv[s];
#pragma unroll
                for (int reg = 0; reg < 16; ++reg) {
                    const int t = rb + crow(reg, hh);
                    const float v = (s <= t) ? cbA[j][reg] * __expf(acs[t] - as) * ds : 0.f;
                    Ws[t * 136 + s] = f2bf(v);
                }
            }
        }
        lds_barrier();
        {
            const bf16_t* Ws = Bs;
            const int tb = (wid >> 1) * 32, pb = (wid & 1) * 32;
            f32x16 y;
#pragma unroll
            for (int i = 0; i < 16; ++i) y[i] = 0.f;
#pragma unroll
            for (int ks = 0; ks < 8; ++ks) y = MFMA32(ldfrag(Cs, 136, tb, ks * 16, lane), ldfrag(St, 136, pb, ks * 16, lane), y);
#pragma unroll
            for (int reg = 0; reg < 16; ++reg) y[reg] *= __expf(acs[tb + crow(reg, hh)]);
#pragma unroll
            for (int ks = 0; ks < 8; ++ks) y = MFMA32(ldfrag(Ws, 136, tb, ks * 16, lane), ldfrag(XsT, 136, pb, ks * 16, lane), y);
            lds_barrier();
            {
                bf16_t* XwT = Cs;
                const uint4 xa = *(const uint4*)(XsT + prow * 136 + pcol), xb_ = *(const uint4*)(XsT + (prow + 32) * 136 + pcol);
                const f32x4 w0 = *(const f32x4*)(wv + pcol), w1 = *(const f32x4*)(wv + pcol + 4);
                uint4 oa, ob;
                oa.x = pack2(bflo(xa.x) * w0[0], bfhi(xa.x) * w0[1]); oa.y = pack2(bflo(xa.y) * w0[2], bfhi(xa.y) * w0[3]); oa.z = pack2(bflo(xa.z) * w1[0], bfhi(xa.z) * w1[1]); oa.w = pack2(bflo(xa.w) * w1[2], bfhi(xa.w) * w1[3]);
                ob.x = pack2(bflo(xb_.x) * w0[0], bfhi(xb_.x) * w0[1]); ob.y = pack2(bflo(xb_.y) * w0[2], bfhi(xb_.y) * w0[3]); ob.z = pack2(bflo(xb_.z) * w1[0], bfhi(xb_.z) * w1[1]); ob.w = pack2(bflo(xb_.w) * w1[2], bfhi(xb_.w) * w1[3]);
                *(uint4*)(XwT + prow * 136 + pcol) = oa; *(uint4*)(XwT + (prow + 32) * 136 + pcol) = ob;
            }
            const int p = pb + l31, ch = h * 64 + p; const float nwv = P.in[24][ch];
#pragma unroll
            for (int reg = 0; reg < 16; ++reg) {
                const int t = tb + crow(reg, hh); const size_t row = (size_t)(row0 + t);
                const float xv = bf2f(XsT[p * 136 + t]); const float z = bf2f(zr[reg]);
                const float yy = (y[reg] + Dh * xv) * silu(z);
                float ss = yy * yy;
                ss += __shfl_xor(ss, 1); ss += __shfl_xor(ss, 2); ss += __shfl_xor(ss, 4); ss += __shfl_xor(ss, 8); ss += __shfl_xor(ss, 16);
                if (l31 == 0) atomicAdd(SSB + row * 2 + g, ss);
                MIX[row * 2048 + 1024 + ch] = f2bf(yy * nwv);
            }
            lds_barrier();
            const int pb2 = (wid >> 2) * 32, nb = (wid & 3) * 32;
            const float ea = __expf(a_last);
#pragma unroll
            for (int reg = 0; reg < 16; ++reg) accS[reg] *= ea;
#pragma unroll
            for (int ks = 0; ks < 8; ++ks) accS = MFMA32(ldfrag(Cs, 136, pb2, ks * 16, lane), ldfrag(BsT, 136, nb, ks * 16, lane), accS);
#pragma unroll
            for (int reg = 0; reg < 16; ++reg) St[(pb2 + crow(reg, hh)) * 136 + nb + l31] = f2bf(accS[reg]);
        }
    }
    {
        const int lane = tid0 & 63, hh = lane >> 5, l31 = lane & 31;
        const int pb2 = (wid >> 2) * 32, nb = (wid & 3) * 32;
        float* o = P.out + O_BSP + (size_t)(b * 16 + h) * 64 * 128;
#pragma unroll
        for (int reg = 0; reg < 16; ++reg) o[(pb2 + crow(reg, hh)) * 128 + nb + l31] = accS[reg];
    }
}
#undef SSD_DTLOAD
#undef SSD_SCAN
DI void ssd_sample_item(const Params& P, unsigned char* L, int item) {
    const int b = item >> 4, h = item & 15, g = h >> 3, tid = otid(), lane = tid & 63;
    float* xs = (float*)L; float* Bv = xs + 64; float* Cv = Bv + 128; float* yv = Cv + 128;
    const bf16_t* U = WSP(bf16_t, OFF_U); bf16_t* MIX = WSP(bf16_t, OFF_MIX); float* SSB = WSP(float, OFF_SSB);
    const size_t row = (size_t)(MP + b);
    __syncthreads();
    if (tid < 320) {
        int cc; if (tid < 64) cc = h * 64 + tid; else if (tid < 192) cc = 1024 + g * 128 + (tid - 64); else cc = 1280 + g * 128 + (tid - 192);
        const float* buf = P.in[7] + (size_t)b * 3 * 1536 + cc;
        const float v = P.in[20][cc] + P.in[19][cc] * buf[0] + P.in[19][1536 + cc] * buf[1536] + P.in[19][2 * 1536 + cc] * buf[2 * 1536] + P.in[19][3 * 1536 + cc] * bf2f(U[row * N0 + 3072 + cc]);
        xs[tid] = silu(v);
    }
    const float dt = softplus(WSP(float, OFF_DT)[row * 16 + h] + P.in[21][h]);
    const float dA = __expf(-dt * __expf(P.in[22][h]));
    __syncthreads();
    const float* s0 = P.in[6] + (size_t)(b * 16 + h) * 64 * 128; float* s1 = P.out + O_BSS + (size_t)(b * 16 + h) * 64 * 128;
    const int n4 = (tid & 31) * 4;
    const f32x4 Bq = *(const f32x4*)(Bv + n4), Cq = *(const f32x4*)(Cv + n4);
#pragma unroll
    for (int j = 0; j < 4; ++j) {
        const int p = (tid >> 5) + 16 * j;
        const f32x4 s = *(const f32x4*)(s0 + p * 128 + n4);
        const float dx = dt * xs[p];
        const f32x4 sn = s * dA + Bq * dx;
        *(f32x4*)(s1 + p * 128 + n4) = sn;
        float yp = sn[0] * Cq[0] + sn[1] * Cq[1] + sn[2] * Cq[2] + sn[3] * Cq[3];
        yp += __shfl_xor(yp, 1); yp += __shfl_xor(yp, 2); yp += __shfl_xor(yp, 4); yp += __shfl_xor(yp, 8); yp += __shfl_xor(yp, 16);
        if ((tid & 31) == 0) yv[p] = yp;
    }
    __syncthreads();
    if (tid < 64) {
        const int ch = h * 64 + tid;
        const float yy = (yv[tid] + P.in[23][h] * xs[tid]) * silu(bf2f(U[row * N0 + 2048 + ch]));
        const float ss = wave_sum(yy * yy);
        if (lane == 0) atomicAdd(SSB + row * 2 + g, ss);
        MIX[row * 2048 + 1024 + ch] = f2bf(yy * P.in[24][ch]);
    }
}
DI void ssd_sample_item4(const Params& P, unsigned char* L, int item) {
    const int b = item >> 2, tid = otid(), gi = tid >> 7, lt = tid & 127, h = (item & 3) * 4 + gi, g = h >> 3;
    float* xs = (float*)L + gi * 512; float* Bv = xs + 64; float* Cv = Bv + 128; float* yv = Cv + 128;
    const bf16_t* U = WSP(bf16_t, OFF_U); bf16_t* MIX = WSP(bf16_t, OFF_MIX); float* SSB = WSP(float, OFF_SSB);
    const size_t row = (size_t)(MP + b);
    __syncthreads();
#pragma unroll
    for (int ps = 0; ps < 3; ++ps) {
        const int idx = lt + 128 * ps;
        if (idx < 320) {
            int cc; if (idx < 64) cc = h * 64 + idx; else if (idx < 192) cc = 1024 + g * 128 + (idx - 64); else cc = 1280 + g * 128 + (idx - 192);
            const float* buf = P.in[7] + (size_t)b * 3 * 1536 + cc;
            const float v = P.in[20][cc] + P.in[19][cc] * buf[0] + P.in[19][1536 + cc] * buf[1536] + P.in[19][2 * 1536 + cc] * buf[2 * 1536] + P.in[19][3 * 1536 + cc] * bf2f(U[row * N0 + 3072 + cc]);
            xs[idx] = silu(v);
        }
    }
    const float dt = softplus(WSP(float, OFF_DT)[row * 16 + h] + P.in[21][h]);
    const float dA = __expf(-dt * __expf(P.in[22][h]));
    __syncthreads();
    const float* s0 = P.in[6] + (size_t)(b * 16 + h) * 64 * 128; float* s1 = P.out + O_BSS + (size_t)(b * 16 + h) * 64 * 128;
    const int n4 = (lt & 31) * 4;
    const f32x4 Bq = *(const f32x4*)(Bv + n4), Cq = *(const f32x4*)(Cv + n4);
    f32x4 sv[16];
#pragma unroll
    for (int j = 0; j < 16; ++j) sv[j] = *(const f32x4*)(s0 + ((lt >> 5) + 4 * j) * 128 + n4);
#pragma unroll
    for (int j = 0; j < 16; ++j) {
        const int p = (lt >> 5) + 4 * j;
        const f32x4 sn = sv[j] * dA + Bq * (dt * xs[p]);
        *(f32x4*)(s1 + p * 128 + n4) = sn;
        float yp = sn[0] * Cq[0] + sn[1] * Cq[1] + sn[2] * Cq[2] + sn[3] * Cq[3];
        yp += __shfl_xor(yp, 1); yp += __shfl_xor(yp, 2); yp += __shfl_xor(yp, 4); yp += __shfl_xor(yp, 8); yp += __shfl_xor(yp, 16);
        if ((lt & 31) == 0) yv[p] = yp;
    }
    __syncthreads();
    if (lt < 64) {
        const int ch = h * 64 + lt;
        const float yy = (yv[lt] + P.in[23][h] * xs[lt]) * silu(bf2f(U[row * N0 + 2048 + ch]));
        const float ss = wave_sum(yy * yy);
        if (lt == 0) atomicAdd(SSB + row * 2 + g, ss);
        MIX[row * 2048 + 1024 + ch] = f2bf(yy * P.in[24][ch]);
    }
}
template <bool SAMPLE>
DI void rglru_item(const Params& P, unsigned char* L, int item) {
    const int tid0 = otid(), wid = tid0 >> 6;
    const int b = SAMPLE ? 0 : (item >> 4), k = (item >> 1) & 7, dh = item & 1;
    bf16_t* Xs = (bf16_t*)L;
    bf16_t* Wg = Xs + 128 * 136;
    float* Aa = (float*)(Wg + 128 * 136);
    float* Uu = Aa + 128 * 64; float* segA = Uu + 128 * 64; float* segH = segA + 512; float* hc = segH + 512;
    const bf16_t* U = WSP(bf16_t, OFF_U); bf16_t* MIX = WSP(bf16_t, OFF_MIX);
    lds_barrier();
    {
        const bf16_t* WRT = WSP(bf16_t, OFF_WRT); const bf16_t* WIT = WSP(bf16_t, OFF_WIT);
#pragma unroll
        for (int i = 0; i < 4; ++i) {
            const int chk = tid0 + i * 512, r = chk >> 4, c8 = (chk & 15) * 8;
            const bf16_t* src = (r < 64 ? WRT + (size_t)(dh * 64 + r) * 1024 : WIT + (size_t)(dh * 64 + r - 64) * 1024) + k * 128 + c8;
            *(u32x4*)(Wg + r * 136 + c8) = *(const u32x4*)src;
        }
        if (tid0 < 64) hc[tid0] = 0.f;
    }
    float sp[4], br[4], bi[4];
#pragma unroll
    for (int ct = 0; ct < 4; ++ct) { const int chd = k * 128 + dh * 64 + ct * 16 + (tid0 & 15); sp[ct] = softplus(-P.in[18][chd]); br[ct] = P.in[15][chd]; bi[ct] = P.in[17][chd]; }
    const int ch0 = k * 128 + (tid0 & 31) * 4;
    float cw[4][4], cbias[4];
#pragma unroll
    for (int kk = 0; kk < 4; ++kk)
#pragma unroll
        for (int e = 0; e < 4; ++e) cw[kk][e] = P.in[12][kk * 1024 + ch0 + e];
#pragma unroll
    for (int e = 0; e < 4; ++e) cbias[e] = P.in[13][ch0 + e];
    u32x2 raw[11];
#define RG_LOAD(tl_) do { const int tg_ = (tl_) * 128 + (tid0 >> 5) * 8; const unsigned vo_ = (unsigned)((b * 2048 + tg_) * N0 + ch0); \
        _Pragma("unroll") for (int j = 0; j < 11; ++j) raw[j] = (tg_ + j - 3 >= 0) ? *(const u32x2*)((U + (j - 3) * N0) + vo_) : (u32x2){0u, 0u}; } while (0)
    if (!SAMPLE) RG_LOAD(0);
    const int ntiles = SAMPLE ? 1 : 16;
    for (int tile = 0; tile < ntiles; ++tile) {
        const int row0 = SAMPLE ? MP : b * 2048 + tile * 128;
        lds_barrier();
        int zv = 0; asm volatile("" : "+v"(zv));
        const int tid = tid0 + zv, lane = tid & 63, quad = tid & 31, seg = tid >> 5;
        const int sd = tid & 63, sseg = wid, sch = k * 128 + dh * 64 + sd;
        bf16_t gt[16];
        if (!SAMPLE) {
            const unsigned goff = (unsigned)((row0 + sseg * 16) * N0 + 1024 + sch);
#pragma unroll
            for (int t = 0; t < 16; ++t) gt[t] = (U + t * N0)[goff];
        }
        if (SAMPLE) {
#pragma unroll
            for (int t = 0; t < 8; ++t) {
                const int bb = seg * 8 + t;
                const float* buf = P.in[5] + (size_t)bb * 3 * 1024 + ch0;
                const f32x4 p0 = *(const f32x4*)buf, p1 = *(const f32x4*)(buf + 1024), p2 = *(const f32x4*)(buf + 2048);
                float cur[4]; ld4bf(U + (size_t)(MP + bb) * N0 + ch0, cur);
                float y[4];
#pragma unroll
                for (int e = 0; e < 4; ++e) y[e] = cbias[e] + cw[0][e] * p0[e] + cw[1][e] * p1[e] + cw[2][e] * p2[e] + cw[3][e] * cur[e];
                *(u32x2*)(Xs + bb * 136 + quad * 4) = pack4v(y[0], y[1], y[2], y[3]);
            }
        } else {
#pragma unroll
            for (int j = 0; j < 8; ++j) {
                const float x0[4] = {bflo(raw[j].x), bfhi(raw[j].x), bflo(raw[j].y), bfhi(raw[j].y)};
                const float x1[4] = {bflo(raw[j + 1].x), bfhi(raw[j + 1].x), bflo(raw[j + 1].y), bfhi(raw[j + 1].y)};
                const float x2[4] = {bflo(raw[j + 2].x), bfhi(raw[j + 2].x), bflo(raw[j + 2].y), bfhi(raw[j + 2].y)};
                const float x3[4] = {bflo(raw[j + 3].x), bfhi(raw[j + 3].x), bflo(raw[j + 3].y), bfhi(raw[j + 3].y)};
                float y[4];
#pragma unroll
                for (int e = 0; e < 4; ++e) y[e] = cbias[e] + cw[0][e] * x0[e] + cw[1][e] * x1[e] + cw[2][e] * x2[e] + cw[3][e] * x3[e];
                *(u32x2*)(Xs + (seg * 8 + j) * 136 + quad * 4) = pack4v(y[0], y[1], y[2], y[3]);
            }
            if (tile + 1 < 16) RG_LOAD(tile + 1);
        }
        lds_barrier();
        {
            f32x4 acc[8];
#pragma unroll
            for (int i = 0; i < 8; ++i) acc[i] = (f32x4){0.f, 0.f, 0.f, 0.f};
#pragma unroll
            for (int ks = 0; ks < 4; ++ks) {
                const bf16x8 a = ldfrag16(Xs, 136, wid * 16, ks * 32, lane);
#pragma unroll
                for (int tl = 0; tl < 8; ++tl) acc[tl] = MFMA16(a, ldfrag16(Wg, 136, tl * 16, ks * 32, lane), acc[tl]);
            }
#pragma unroll
            for (int ct = 0; ct < 4; ++ct)
#pragma unroll
                for (int reg = 0; reg < 4; ++reg) {
                    const int t = wid * 16 + (lane >> 4) * 4 + reg, d = ct * 16 + (lane & 15);
                    const float r = sigm(acc[ct][reg] + br[ct]), gi = sigm(acc[4 + ct][reg] + bi[ct]);
                    const float a = __expf(-8.f * r * sp[ct]);
                    const float uu = __builtin_amdgcn_sqrtf(fmaxf(1.f - a * a, 0.f)) * gi * bf2f(Xs[t * 136 + dh * 64 + d]);
                    if (SAMPLE) {
                        const int chd = k * 128 + dh * 64 + d;
                        const float hn = a * P.in[4][(size_t)t * 1024 + chd] + uu;
                        P.out[O_AHS + (size_t)t * 1024 + chd] = hn;
                        const float gv = bf2f(U[(size_t)(MP + t) * N0 + 1024 + chd]);
                        MIX[(size_t)(MP + t) * 2048 + chd] = f2bf(hn * silu(gv));
                    } else { Aa[t * 64 + d] = a; Uu[t * 64 + d] = uu; }
                }
        }
        if (!SAMPLE) {
            lds_barrier();
            float av[16], uv[16], Ap = 1.f, Hp = 0.f;
#pragma unroll
            for (int t = 0; t < 16; ++t) { av[t] = Aa[(sseg * 16 + t) * 64 + sd]; uv[t] = Uu[(sseg * 16 + t) * 64 + sd]; Hp = av[t] * Hp + uv[t]; Ap *= av[t]; }
            segA[sseg * 64 + sd] = Ap; segH[sseg * 64 + sd] = Hp;
            lds_barrier();
            float hin = hc[sd];
            for (int s2 = 0; s2 < sseg; ++s2) hin = segA[s2 * 64 + sd] * hin + segH[s2 * 64 + sd];
            const unsigned moff = (unsigned)((row0 + sseg * 16) * 2048 + sch);
#pragma unroll
            for (int t = 0; t < 16; ++t) {
                hin = av[t] * hin + uv[t];
                (MIX + t * 2048)[moff] = f2bf(hin * silu(bf2f(gt[t])));
            }
            lds_barrier();
            if (sseg == 7) hc[sd] = hin;
        }
    }
#undef RG_LOAD
    if (!SAMPLE) { lds_barrier(); if (tid0 < 64) P.out[O_AHP + (size_t)b * 1024 + k * 128 + dh * 64 + tid0] = hc[tid0]; }
}
DI void phase_mix0(const Params& P, unsigned char* L) {
    const int tid = otid(), bid = blockIdx.x, G = gridDim.x;
    { const bf16_t* U = WSP(bf16_t, OFF_U);
      for (int i = bid * 512 + tid; i < 8 * 3 * 1024; i += G * 512) { const int c = i & 1023, j = (i >> 10) % 3, b = i / 3072; P.out[O_ACP + i] = bf2f(U[(size_t)(b * 2048 + 2045 + j) * N0 + c]); }
      for (int i = bid * 512 + tid; i < 8 * 3 * 1536; i += G * 512) { const int c = i % 1536, j = (i / 1536) % 3, b = i / 4608; P.out[O_BCP + i] = bf2f(U[(size_t)(b * 2048 + 2045 + j) * N0 + 3072 + c]); }
      for (int i = bid * 512 + tid; i < 128 * 3 * 1024; i += G * 512) { const int c = i & 1023, j = (i >> 10) % 3, b = i / 3072; P.out[O_ACS + i] = j < 2 ? P.in[5][(size_t)(b * 3 + j + 1) * 1024 + c] : bf2f(U[(size_t)(MP + b) * N0 + c]); }
      for (int i = bid * 512 + tid; i < 128 * 3 * 1536; i += G * 512) { const int c = i % 1536, j = (i / 1536) % 3, b = i / 4608; P.out[O_BCS + i] = j < 2 ? P.in[7][(size_t)(b * 3 + j + 1) * 1536 + c] : bf2f(U[(size_t)(MP + b) * N0 + 3072 + c]); } }
    if (bid < 128) rglru_item<false>(P, L, bid); else if (bid < 256) ssd_prompt_item(P, L, bid - 128);
    unsigned* ctr = WSP(unsigned, OFF_CTL);
    unsigned* bc = (unsigned*)(L + LDS_BYTES - 16);
    for (;;) {
        __syncthreads();
        if (tid == 0) bc[0] = atomicAdd(ctr, 1u);
        __syncthreads();
        const unsigned it = bc[0];
        if (it >= 16u + 512u) break;
        if (it < 16u) rglru_item<true>(P, L, (int)it); else ssd_sample_item4(P, L, (int)(it - 16u));
    }
}
DI void phase_norm0(const Params& P) {
    bf16_t* MIX = WSP(bf16_t, OFF_MIX); const float* SSB = WSP(float, OFF_SSB);
    for (int i = blockIdx.x * 512 + threadIdx.x; i < MV * 128; i += gridDim.x * 512) {
        const int row = i >> 7, c8 = (i & 127) * 8, g = c8 >> 9;
        const float sc = rsqrtf(SSB[(size_t)row * 2 + g] * (1.f / 512.f) + EPSF);
        uint4* p = (uint4*)(MIX + (size_t)row * 2048 + 1024 + c8); uint4 w = *p;
        w.x = pack2(bflo(w.x) * sc, bfhi(w.x) * sc); w.y = pack2(bflo(w.y) * sc, bfhi(w.y) * sc); w.z = pack2(bflo(w.z) * sc, bfhi(w.z) * sc); w.w = pack2(bflo(w.w) * sc, bfhi(w.w) * sc);
        *p = w;
    }
}

DI void hgrn_prompt_item(const Params& P, unsigned char* L, int item) {
    const int b = item >> 4, h = item & 15;
    const int tid = otid(), lane = tid & 63, wid = tid >> 6, hh = lane >> 5, l31 = lane & 31;
    bf16_t* Qs = (bf16_t*)L;
    bf16_t* Ks = Qs + 64 * 136;
    float* Of = (float*)L;
    bf16_t* KsT = Ks + 64 * 136;
    bf16_t* VsT = KsT + 128 * 72;
    bf16_t* SsT = VsT + 128 * 72;
    bf16_t* As = SsT + 128 * 136;
    float* Gseg = (float*)(As + 64 * 72);
    float* E1 = Gseg + 16 * 128; float* E2 = E1 + 128;
    const bf16_t* U = WSP(bf16_t, OFF_U); bf16_t* MIX = WSP(bf16_t, OFF_MIX);
    const int kq = tid & 31, ts = tid >> 5;
    float lb[4];
#pragma unroll
    for (int e = 0; e < 4; ++e) { const int ch = h * 128 + kq * 4 + e; lb[e] = sigm(P.in[27][2048 + ch] - P.in[27][ch]); }
    const int kb = (wid >> 1) * 32, vb0 = (wid & 1) * 64;
    f32x16 accS[2];
#pragma unroll
    for (int i = 0; i < 16; ++i) { accS[0][i] = 0.f; accS[1][i] = 0.f; }
    uint2 rq[4], rf[4], rv[4];
#define HG_LOAD(cc) do { _Pragma("unroll") for (int i = 0; i < 4; ++i) { const bf16_t* bp = U + (size_t)(b * 2048 + (cc) * 64 + ts * 4 + i) * INC + h * 128 + kq * 4; \
        rq[i] = *(const uint2*)bp; rf[i] = *(const uint2*)(bp + 2048); rv[i] = *(const uint2*)(bp + 4096); } } while (0)
    HG_LOAD(0);
    lds_barrier();
    for (int c = 0; c < 32; ++c) {
        u32x4 gpre0, gpre1;
        { const bf16_t* gp = U + (size_t)(b * 2048 + c * 64 + (tid >> 3)) * INC + 6144 + h * 128 + (tid & 7) * 16; gpre0 = *(const u32x4*)gp; gpre1 = *(const u32x4*)(gp + 8); }
        float kk[4][4], cs[4][4];
#pragma unroll
        for (int i = 0; i < 4; ++i) {
            const float fx[4] = {bflo(rf[i].x), bfhi(rf[i].x), bflo(rf[i].y), bfhi(rf[i].y)};
#pragma unroll
            for (int e = 0; e < 4; ++e) {
                const float sg = sigm(fx[e]); const float kv = (1.f - lb[e]) * (1.f - sg);
                kk[i][e] = kv; const float gl = __logf(1.f - kv);
                cs[i][e] = (i == 0 ? 0.f : cs[i - 1][e]) + gl;
            }
        }
        *(f32x4*)(Gseg + ts * 128 + kq * 4) = (f32x4){cs[3][0], cs[3][1], cs[3][2], cs[3][3]};
        lds_barrier();
        f32x4 off = {0.f, 0.f, 0.f, 0.f}, gmid = off, glast = off;
        {
            const int swid = __builtin_amdgcn_readfirstlane(tid >> 6);
            f32x4 pre = {0.f, 0.f, 0.f, 0.f};
#pragma unroll
            for (int s = 0; s < 16; ++s) {
                const f32x4 v = *(const f32x4*)(Gseg + s * 128 + kq * 4);
                if (s == 2 * swid) off = pre;
                if (s == 8) gmid = pre;
                pre += v;
            }
            glast = pre;
            if (ts & 1) off += *(const f32x4*)(Gseg + (ts - 1) * 128 + kq * 4);
        }
        {
            float qt[4][4], kt[4][4], vt[4][4];
#pragma unroll
            for (int i = 0; i < 4; ++i) {
                const float q[4] = {bflo(rq[i].x), bfhi(rq[i].x), bflo(rq[i].y), bfhi(rq[i].y)};
                vt[i][0] = bflo(rv[i].x); vt[i][1] = bfhi(rv[i].x); vt[i][2] = bflo(rv[i].y); vt[i][3] = bfhi(rv[i].y);
#pragma unroll
                for (int e = 0; e < 4; ++e) { const float Gv = off[e] + cs[i][e]; const float ex = __expf(Gv - gmid[e]); qt[i][e] = q[e] * 0.08838834764831845f * ex; kt[i][e] = kk[i][e] * frcp(ex); }
                *(uint2*)(Qs + (ts * 4 + i) * 136 + kq * 4) = pack4(qt[i][0], qt[i][1], qt[i][2], qt[i][3]);
                *(uint2*)(Ks + (ts * 4 + i) * 136 + kq * 4) = pack4(kt[i][0], kt[i][1], kt[i][2], kt[i][3]);
            }
#pragma unroll
            for (int e = 0; e < 4; ++e) {
                *(uint2*)(KsT + (kq * 4 + e) * 72 + ts * 4) = pack4(kt[0][e], kt[1][e], kt[2][e], kt[3][e]);
                *(uint2*)(VsT + (kq * 4 + e) * 72 + ts * 4) = pack4(vt[0][e], vt[1][e], vt[2][e], vt[3][e]);
            }
            if (ts == 0) {
#pragma unroll
                for (int e = 0; e < 4; ++e) { E1[kq * 4 + e] = __expf(gmid[e]); E2[kq * 4 + e] = __expf(glast[e] - gmid[e]); }
            }
        }
        if (c + 1 < 32) HG_LOAD(c + 1);
        lds_barrier();
#pragma unroll
        for (int j = 0; j < 2; ++j) {
#pragma unroll
            for (int reg = 0; reg < 16; ++reg) accS[j][reg] *= E1[kb + crow(reg, hh)];
            const int v = vb0 + j * 32 + l31;
#pragma unroll
            for (int rg = 0; rg < 4; ++rg) *(uint2*)(SsT + v * 136 + kb + 8 * rg + 4 * hh) = pack4(accS[j][4 * rg], accS[j][4 * rg + 1], accS[j][4 * rg + 2], accS[j][4 * rg + 3]);
        }
        if (wid < 4) {
            const int tb = (wid >> 1) * 32, sb = (wid & 1) * 32;
            f32x16 aa;
#pragma unroll
            for (int i = 0; i < 16; ++i) aa[i] = 0.f;
#pragma unroll
            for (int ks = 0; ks < 8; ++ks) aa = MFMA32(ldfrag(Qs, 136, tb, ks * 16, lane), ldfrag(Ks, 136, sb, ks * 16, lane), aa);
            const int s = sb + l31;
#pragma unroll
            for (int reg = 0; reg < 16; ++reg) { const int t = tb + crow(reg, hh); As[t * 72 + s] = f2bf(s <= t ? aa[reg] : 0.f); }
        }
        lds_barrier();
        const int tb2 = (wid >> 2) * 32, vb2 = (wid & 3) * 32;
        f32x16 o;
#pragma unroll
        for (int i = 0; i < 16; ++i) o[i] = 0.f;
#pragma unroll
        for (int ks = 0; ks < 8; ++ks) o = MFMA32(ldfrag(Qs, 136, tb2, ks * 16, lane), ldfrag(SsT, 136, vb2, ks * 16, lane), o);
#pragma unroll
        for (int ks = 0; ks < 4; ++ks) o = MFMA32(ldfrag(As, 72, tb2, ks * 16, lane), ldfrag(VsT, 72, vb2, ks * 16, lane), o);
#pragma unroll
        for (int j = 0; j < 2; ++j) {
#pragma unroll
            for (int ks = 0; ks < 4; ++ks) accS[j] = MFMA32(ldfrag(KsT, 72, kb, ks * 16, lane), ldfrag(VsT, 72, vb0 + j * 32, ks * 16, lane), accS[j]);
#pragma unroll
            for (int reg = 0; reg < 16; ++reg) accS[j][reg] *= E2[kb + crow(reg, hh)];
        }
        lds_barrier();
#pragma unroll
        for (int reg = 0; reg < 16; ++reg) Of[(tb2 + crow(reg, hh)) * 132 + vb2 + l31] = o[reg];
        lds_barrier();
        {
            const int t = tid >> 3, vs = tid & 7;
            const size_t row = (size_t)(b * 2048 + c * 64 + t);
            f32x4 ov[4]; float ss = 0.f;
#pragma unroll
            for (int i = 0; i < 4; ++i) { ov[i] = *(const f32x4*)(Of + t * 132 + vs * 16 + i * 4); ss += ov[i][0] * ov[i][0] + ov[i][1] * ov[i][1] + ov[i][2] * ov[i][2] + ov[i][3] * ov[i][3]; }
            ss += __shfl_xor(ss, 1); ss += __shfl_xor(ss, 2); ss += __shfl_xor(ss, 4);
            const float rstd = rsqrtf(ss * (1.f / 128.f) + EPSF);
            const float* nwp = P.in[28] + h * 128 + vs * 16;
            const unsigned gw[8] = {gpre0.x, gpre0.y, gpre0.z, gpre0.w, gpre1.x, gpre1.y, gpre1.z, gpre1.w};
            unsigned ow[8];
#pragma unroll
            for (int i = 0; i < 4; ++i) {
                const f32x4 w = *(const f32x4*)(nwp + i * 4);
                ow[2 * i] = pack2(ov[i][0] * rstd * w[0] * silu(bflo(gw[2 * i])), ov[i][1] * rstd * w[1] * silu(bfhi(gw[2 * i])));
                ow[2 * i + 1] = pack2(ov[i][2] * rstd * w[2] * silu(bflo(gw[2 * i + 1])), ov[i][3] * rstd * w[3] * silu(bfhi(gw[2 * i + 1])));
            }
            bf16_t* op = MIX + row * 2048 + h * 128 + vs * 16;
            *(uint4*)op = make_uint4(ow[0], ow[1], ow[2], ow[3]); *(uint4*)(op + 8) = make_uint4(ow[4], ow[5], ow[6], ow[7]);
        }
        lds_barrier();
    }
#undef HG_LOAD
    float* so = P.out + O_CP + (size_t)(b * 16 + h) * 128 * 128;
#pragma unroll
    for (int j = 0; j < 2; ++j)
#pragma unroll
        for (int reg = 0; reg < 16; ++reg) so[(kb + crow(reg, hh)) * 128 + vb0 + j * 32 + l31] = accS[j][reg];
}
DI void hgrn_sample_item(const Params& P, unsigned char* L, int item) {
    const int b = item >> 4, h = item & 15, tid = otid(), lane = tid & 63;
    float* qv = (float*)L; float* egv = qv + 128; float* kkv = egv + 128; float* vv = kkv + 128; float* part = vv + 128; float* red = part + 16 * 128;
    const bf16_t* U = WSP(bf16_t, OFF_U); bf16_t* MIX = WSP(bf16_t, OFF_MIX);
    const size_t row = (size_t)(MP + b); const bf16_t* ub = U + row * INC + h * 128;
    __syncthreads();
    if (tid < 128) {
        const int ch = h * 128 + tid;
        const float lbv = sigm(P.in[27][2048 + ch] - P.in[27][ch]);
        const float sg = sigm(bf2f(ub[2048 + tid])); const float kv = (1.f - lbv) * (1.f - sg);
        qv[tid] = bf2f(ub[tid]) * 0.08838834764831845f; egv[tid] = 1.f - kv; kkv[tid] = kv;
    } else if (tid < 256) vv[tid - 128] = bf2f(ub[4096 + tid - 128]);
    __syncthreads();
    const float* s0 = P.in[8] + (size_t)(b * 16 + h) * 128 * 128; float* s1 = P.out + O_CS + (size_t)(b * 16 + h) * 128 * 128;
    const int v4 = (tid & 31) * 4; const f32x4 vq = *(const f32x4*)(vv + v4);
    f32x4 op = {0.f, 0.f, 0.f, 0.f};
#pragma unroll
    for (int j = 0; j < 8; ++j) {
        const int k = (tid >> 5) + 16 * j;
        const f32x4 s = *(const f32x4*)(s0 + k * 128 + v4);
        const f32x4 sn = s * egv[k] + vq * kkv[k];
        *(f32x4*)(s1 + k * 128 + v4) = sn;
        op += sn * qv[k];
    }
    *(f32x4*)(part + (tid >> 5) * 128 + v4) = op;
    __syncthreads();
    float o = 0.f;
    if (tid < 128) {
#pragma unroll
        for (int i = 0; i < 16; ++i) o += part[i * 128 + tid];
        const float ss = wave_sum(o * o);
        if (lane == 0) red[tid >> 6] = ss;
    }
    __syncthreads();
    if (tid < 128) {
        const float rstd = rsqrtf((red[0] + red[1]) * (1.f / 128.f) + EPSF);
        const int ch = h * 128 + tid;
        MIX[row * 2048 + ch] = f2bf(o * rstd * P.in[28][ch] * silu(bf2f(ub[6144 + tid])));
    }
}
DI void phase_mix1(const Params& P, unsigned char* L) {
    const int tid = otid(), bid = blockIdx.x;
    if (bid < 128) hgrn_prompt_item(P, L, bid);
    else { const int nb = gridDim.x - 128; for (int it = bid - 128; it < 2048; it += nb) hgrn_sample_item(P, L, it); }
}
DI void phase_final(const Params& P) {
    const int lane = threadIdx.x & 63, gw = blockIdx.x * 8 + (threadIdx.x >> 6), nwv = gridDim.x * 8;
    const float* H = WSP(float, OFF_H); const float* SS = WSP(float, OFF_SS2); const float* nf = P.in[10];
    f32x4 w4[4];
#pragma unroll
    for (int i = 0; i < 4; ++i) w4[i] = *(const f32x4*)(nf + lane * 4 + 256 * i);
    for (int r = gw; r < MV; r += nwv) {
        const float rstd = rsqrtf(SS[r] * (1.f / 1024.f) + EPSF);
#pragma unroll
        for (int i = 0; i < 4; ++i) { const f32x4 v = *(const f32x4*)(H + (size_t)r * 1024 + lane * 4 + 256 * i); *(f32x4*)(P.out + O_Y + (size_t)r * 1024 + lane * 4 + 256 * i) = v * rstd * w4[i]; }
    }
}

#define XB_TMO      128
#define XB_XCNT(j)  (256  + 64 * (j))
#define XB_XSUB(j)  (1280 + 64 * (j))
#define XB_XGEN(j)  (2304 + 64 * (j))
#define XB_TOP      3328
#define XB_TOPGEN   3392
#define XCD_BAR_WORDS 3456
#define XB_SPIN_CAP (1u << 18)

__device__ __forceinline__ unsigned xb_ld(unsigned* p)              { return __hip_atomic_load(p, __ATOMIC_RELAXED, __HIP_MEMORY_SCOPE_AGENT); }
__device__ __forceinline__ unsigned xb_add(unsigned* p, unsigned v) { return __hip_atomic_fetch_add(p, v, __ATOMIC_RELAXED, __HIP_MEMORY_SCOPE_AGENT); }
__device__ __forceinline__ unsigned xb_xcc_id() { return (unsigned)__builtin_amdgcn_s_getreg((3 << 11) | 20) & 0xFu; }
#define XB_SPIN(cond, bar) do { unsigned _sp = 0; while (cond) { __builtin_amdgcn_s_sleep(1); \
    if ((++_sp & 255u) == 0u) { if (xb_ld(&(bar)[XB_TMO])) break; if (_sp > XB_SPIN_CAP) { atomicAdd(&(bar)[XB_TMO], 1u); break; } } } } while (0)

struct XcdBarrier {
    unsigned* bar; unsigned x;
    volatile LAS unsigned* st;
};

__device__ __forceinline__ XcdBarrier xcd_barrier_post(unsigned* bar, volatile LAS unsigned* st) {
    XcdBarrier b; b.bar = bar; b.x = xb_xcc_id(); b.st = st;
    if (threadIdx.x == 0) (void)xb_add(&bar[XB_XCNT(b.x)], 1u);
    return b;
}
__device__ __forceinline__ void xcd_barrier_complete(unsigned* bar, unsigned x, unsigned& nloc, unsigned& nx) {
    const unsigned G = gridDim.x * gridDim.y * gridDim.z;
    unsigned sum, cnt, mine, sp = 0u;
    for (;;) {
        sum = 0u; cnt = 0u; mine = 0u;
#pragma unroll
        for (unsigned j = 0; j < 16; ++j) { const unsigned c = xb_ld(&bar[XB_XCNT(j)]); sum += c; cnt += (c > 0u) ? 1u : 0u; mine = (j == x) ? c : mine; }
        if (sum == G) break;
        __builtin_amdgcn_s_sleep(1);
        if ((++sp & 255u) == 0u) { if (xb_ld(&bar[XB_TMO])) break; if (sp > XB_SPIN_CAP) { atomicAdd(&bar[XB_TMO], 1u); break; } }
    }
    nloc = mine > 0u ? mine : 1u; nx = cnt > 0u ? cnt : 1u;
}

__device__ __forceinline__ void xcd_barrier(const XcdBarrier& b) {
    asm volatile("s_waitcnt vmcnt(0)" ::: "memory");
    __syncthreads();
    if (threadIdx.x == 0) {
        unsigned* bar = b.bar;
        __builtin_amdgcn_s_waitcnt(0);
        unsigned nloc = b.st[0], nx = b.st[1];
        if (nloc == 0u) { xcd_barrier_complete(bar, b.x, nloc, nx); b.st[0] = nloc; b.st[1] = nx; }
        const unsigned old = xb_add(&bar[XB_XSUB(b.x)], 1u);
        const unsigned gen = old / nloc;
        if (old + 1u == (gen + 1u) * nloc) {
            __builtin_amdgcn_fence(__ATOMIC_RELEASE, "agent");
            asm volatile("s_waitcnt vmcnt(0)" ::: "memory");
            const unsigned og = xb_add(&bar[XB_TOP], 1u);
            const unsigned tg = og / nx;
            if (og + 1u == (tg + 1u) * nx) xb_add(&bar[XB_TOPGEN], 1u);
            else XB_SPIN(xb_ld(&bar[XB_TOPGEN]) == tg, bar);
            __builtin_amdgcn_fence(__ATOMIC_ACQUIRE, "agent");
            xb_add(&bar[XB_XGEN(b.x)], 1u);
            asm volatile("s_waitcnt vmcnt(0)" ::: "memory");
        } else {
            XB_SPIN(xb_ld(&bar[XB_XGEN(b.x)]) == gen, bar);
            __builtin_amdgcn_fence(__ATOMIC_ACQUIRE, "agent");
            asm volatile("s_waitcnt vmcnt(0)" ::: "memory");
        }
    }
    __syncthreads();
}


#ifndef PHM
#define PHM 0xFFFF
#endif
typedef const __attribute__((address_space(4))) Params* ParamsK;
DI Params getp() {
    ParamsK pp = (ParamsK)__builtin_amdgcn_kernarg_segment_ptr(); asm volatile("" : "+s"(pp));
    Params P;
#pragma unroll
    for (int i = 0; i < 32; ++i) P.in[i] = pp->in[i];
    P.out = pp->out; P.ws = pp->ws; return P;
}
#define GETP() const Params P = getp()
__global__ void __launch_bounds__(512, 2) fwd_kernel(Params Parg) {
    extern __shared__ __attribute__((aligned(16))) unsigned char lds[];
    cg::grid_group grid = cg::this_grid();
    unsigned char* L = (unsigned char*)lds;
    LAS unsigned char* LL = (LAS unsigned char*)lds;
    volatile LAS unsigned* xst = (volatile LAS unsigned*)(LL + LDS_BYTES - 32);
    if (threadIdx.x < 2) xst[threadIdx.x] = 0u;
    __syncthreads();
    XcdBarrier xb;
    { GETP(); xb = xcd_barrier_post(WSP(unsigned, OFF_BAR), xst); }
    if (PHM & 1) { GETP(); phase_prep(P, L); }
    if (gridDim.y == 0xFFFFu) grid.sync();
    xcd_barrier(xb);
    if (PHM & 2) { GETP(); pg8::StaticOrder S; S.init(MP, N0 + 256, gridDim.x, blockIdx.x); pg8::Gemm g{WSP(bf16_t, OFF_XN), WSP(bf16_t, OFF_W0T), MP, N0 + 256, 1024};
      EpiStoreBf16 E{WSP(bf16_t, OFF_U), N0, nullptr, WSP(float, OFF_DT)}; pg8::gemm_phase(LL, g, S, E); }
    { GETP(); SfU f{WSP(bf16_t, OFF_U), N0, nullptr, WSP(float, OFF_DT)}; sgemm(WSP(bf16_t, OFF_XN), WSP(bf16_t, OFF_W0T), 1024, 145, 64 * 19, f); }
    xcd_barrier(xb);
    { GETP(); phase_convbc(P); }
    xcd_barrier(xb);
    if (PHM & 4) { GETP(); phase_mix0(P, L); }
    xcd_barrier(xb);
    { GETP(); phase_norm0(P); }
    xcd_barrier(xb);
    { GETP(); convert_p(P, 0); }
    __syncthreads();
    if (PHM & 8) { GETP(); pg8::StaticOrder S; S.init(MP, 1024, gridDim.x, blockIdx.x); pg8::Gemm g{WSP(bf16_t, OFF_MIX), WSP(bf16_t, OFF_WO0T), MP, 1024, 2048};
      EpiResid E{P.in[0], P.in[1], WSP(float, OFF_H), WSP(bf16_t, OFF_HB)}; pg8::gemm_phase(LL, g, S, E); }
    { GETP(); SfResid f{P.in[1], WSP(float, OFF_H), WSP(bf16_t, OFF_HB)}; sgemm(WSP(bf16_t, OFF_MIX), WSP(bf16_t, OFF_WO0T), 2048, 32, 256, f); }
    xcd_barrier(xb);
    if (PHM & 16) { GETP(); pg8::StaticOrder S; S.init(MP, 1024, gridDim.x, blockIdx.x);
      pg8::Gemm g1{WSP(bf16_t, OFF_HB), WSP(bf16_t, OFF_WG0T), MP, 1024, 1024}; EpiGate E1{WSP(float, OFF_MIX)}; pg8::gemm_phase(LL, g1, S, E1); }
    { GETP(); SfGate f{WSP(float, OFF_MIX)}; sgemm(WSP(bf16_t, OFF_HB), WSP(bf16_t, OFF_WG0T), 1024, 32, 256, f); }
    if (PHM & 16) { GETP(); pg8::StaticOrder S; S.init(MP, 1024, gridDim.x, blockIdx.x);
      pg8::Gemm g2{WSP(bf16_t, OFF_PB), WSP(bf16_t, OFF_WP0T), MP, 1024, 256};
      EpiPle E2{WSP(float, OFF_H), WSP(float, OFF_MIX), WSP(bf16_t, OFF_XN), P.in[9] + 1024, WSP(float, OFF_SS1)}; pg8::gemm_phase(LL, g2, S, E2); }
    { GETP(); SfPle f{WSP(float, OFF_H), WSP(float, OFF_MIX), WSP(bf16_t, OFF_XN), P.in[9] + 1024, WSP(float, OFF_SS1)}; sgemm(WSP(bf16_t, OFF_PB), WSP(bf16_t, OFF_WP0T), 256, 32, 256, f); }
    xcd_barrier(xb);
    if (PHM & 32) { GETP(); pg8::StaticOrder S; S.init(MP, INC, gridDim.x, blockIdx.x); pg8::Gemm g{WSP(bf16_t, OFF_XN), WSP(bf16_t, OFF_W1T), MP, INC, 1024};
      EpiStoreBf16 E{WSP(bf16_t, OFF_U), INC, WSP(float, OFF_SS1), nullptr}; pg8::gemm_phase(LL, g, S, E); }
    { GETP(); SfU f{WSP(bf16_t, OFF_U), INC, WSP(float, OFF_SS1), nullptr}; sgemm(WSP(bf16_t, OFF_XN), WSP(bf16_t, OFF_W1T), 1024, 256, 64 * 32, f); }
    xcd_barrier(xb);
    if (PHM & 64) { GETP(); phase_mix1(P, L); }
    xcd_barrier(xb);
    { GETP(); convert_p(P, 1); }
    __syncthreads();
    if (PHM & 128) { GETP(); pg8::StaticOrder S; S.init(MP, 1024, gridDim.x, blockIdx.x); pg8::Gemm g{WSP(bf16_t, OFF_MIX), WSP(bf16_t, OFF_WO1T), MP, 1024, 2048};
      EpiResid E{WSP(float, OFF_H), WSP(float, OFF_H) + (size_t)MP * 1024, WSP(float, OFF_H), WSP(bf16_t, OFF_HB)}; pg8::gemm_phase(LL, g, S, E); }
    { GETP(); SfResid f{WSP(float, OFF_H) + (size_t)MP * 1024, WSP(float, OFF_H), WSP(bf16_t, OFF_HB)}; sgemm(WSP(bf16_t, OFF_MIX), WSP(bf16_t, OFF_WO1T), 2048, 32, 256, f); }
    xcd_barrier(xb);
    if (PHM & 256) { GETP(); pg8::StaticOrder S; S.init(MP, 1024, gridDim.x, blockIdx.x);
      pg8::Gemm g1{WSP(bf16_t, OFF_HB), WSP(bf16_t, OFF_WG1T), MP, 1024, 1024}; EpiGate E1{WSP(float, OFF_MIX)}; pg8::gemm_phase(LL, g1, S, E1); }
    { GETP(); SfGate f{WSP(float, OFF_MIX)}; sgemm(WSP(bf16_t, OFF_HB), WSP(bf16_t, OFF_WG1T), 1024, 32, 256, f); }
    if (PHM & 256) { GETP(); pg8::StaticOrder S; S.init(MP, 1024, gridDim.x, blockIdx.x);
      pg8::Gemm g2{WSP(bf16_t, OFF_PB), WSP(bf16_t, OFF_WP1T), MP, 1024, 256};
      EpiPle E2{WSP(float, OFF_H), WSP(float, OFF_MIX), nullptr, nullptr, WSP(float, OFF_SS2)}; pg8::gemm_phase(LL, g2, S, E2); }
    { GETP(); SfPle f{WSP(float, OFF_H), WSP(float, OFF_MIX), nullptr, nullptr, WSP(float, OFF_SS2)}; sgemm(WSP(bf16_t, OFF_PB), WSP(bf16_t, OFF_WP1T), 256, 32, 256, f); }
    xcd_barrier(xb);
    { GETP(); phase_final(P); }
}

extern "C" void kernel_launch(void* const* d_in, const int* in_sizes, int n_in, void* d_out, int out_size, void* d_ws, size_t ws_size, hipStream_t stream) {
    static int grid = 0;
    if (grid == 0) {
        if (n_in != 32 || ws_size < WS_END) { fprintf(stderr, "kernel_launch: need 32 inputs and %zu bytes of workspace (got %d, %zu)\n", (size_t)WS_END, n_in, ws_size); grid = -1; return; }
        int dev = 0, cus = 0, per_cu = 0;
        (void)hipGetDevice(&dev); (void)hipDeviceGetAttribute(&cus, hipDeviceAttributeMultiprocessorCount, dev);
        if (hipFuncSetAttribute((const void*)fwd_kernel, hipFuncAttributeMaxDynamicSharedMemorySize, LDS_BYTES) != hipSuccess) { fprintf(stderr, "kernel_launch: hipFuncSetAttribute failed\n"); grid = -1; return; }
        if (hipOccupancyMaxActiveBlocksPerMultiprocessor(&per_cu, (const void*)fwd_kernel, 512, LDS_BYTES) != hipSuccess || per_cu < 1) { fprintf(stderr, "kernel_launch: occupancy query says %d\n", per_cu); per_cu = 1; }
        (void)hipGetLastError();
        grid = cus;
    }
    if (grid < 0) return;
    Params p{};
    for (int i = 0; i < 32; ++i) p.in[i] = (const float*)d_in[i];
    p.out = (float*)d_out; p.ws = (unsigned char*)d_ws;
    if (hipMemsetAsync((char*)d_ws + OFF_BAR, 0, 16384, stream) != hipSuccess) { fprintf(stderr, "kernel_launch: memset of barrier words failed\n"); return; }
    void* args[] = {&p};
    hipError_t e = hipLaunchCooperativeKernel((const void*)fwd_kernel, dim3(grid), dim3(512), args, LDS_BYTES, stream);
    if (e != hipSuccess) fprintf(stderr, "cooperative launch failed: %s (grid %d)\n", hipGetErrorString(e), grid);
}
```

```cpp
#include <hip/hip_runtime.h>
#include <hip/hip_cooperative_groups.h>
#include <cstdio>
namespace cg = cooperative_groups;

#define LAS __attribute__((address_space(3)))
#define DI __device__ __forceinline__
typedef unsigned short bf16_t;
typedef short bf16x8 __attribute__((ext_vector_type(8)));
typedef float f32x4 __attribute__((ext_vector_type(4)));
typedef float f32x16 __attribute__((ext_vector_type(16)));

constexpr int MP = 16384, MS = 128, MV = MP + MS, MPAD = 16640;
constexpr int DM = 1024, INAB = 4624, N0 = 4608, INC = 8192;
constexpr float EPSF = 1e-6f;
constexpr size_t O_Y = 0, O_AHP = 16908288, O_ACP = 16916480, O_BSP = 16941056, O_BCP = 17989632, O_CP = 18026496,
                 O_AHS = 20123648, O_ACS = 20254720, O_BSS = 20647936, O_BCS = 37425152, O_CS = 38014976;
constexpr size_t al256(size_t x) { return (x + 255) & ~size_t(255); }
constexpr size_t OFF_CTL = 0;
constexpr size_t OFF_BAR = 256;
constexpr size_t OFF_SS1 = 256 + 16384;
constexpr size_t OFF_SS2 = OFF_SS1 + al256((size_t)MPAD * 4);
constexpr size_t OFF_SSB = OFF_SS2 + al256((size_t)MPAD * 4);
constexpr size_t OFF_DT  = OFF_SSB + al256((size_t)MPAD * 8);
constexpr size_t OFF_W0T = OFF_DT + al256((size_t)MV * 16 * 4);
constexpr size_t OFF_WO0T = OFF_W0T + (size_t)(N0 + 256) * 1024 * 2;
constexpr size_t OFF_WG0T = OFF_WO0T + (size_t)1024 * 2048 * 2;
constexpr size_t OFF_WP0T = OFF_WG0T + (size_t)1024 * 1024 * 2;
constexpr size_t OFF_W1T  = OFF_WP0T + (size_t)1024 * 256 * 2;
constexpr size_t OFF_WO1T = OFF_W1T + (size_t)INC * 1024 * 2;
constexpr size_t OFF_WG1T = OFF_WO1T + (size_t)1024 * 2048 * 2;
constexpr size_t OFF_WP1T = OFF_WG1T + (size_t)1024 * 1024 * 2;
constexpr size_t OFF_WRT  = OFF_WP1T + (size_t)1024 * 256 * 2;
constexpr size_t OFF_WIT  = OFF_WRT + (size_t)128 * 1024 * 2;
constexpr size_t OFF_XN   = OFF_WIT + (size_t)128 * 1024 * 2;
constexpr size_t OFF_MIX  = OFF_XN + (size_t)MPAD * 1024 * 2;
constexpr size_t OFF_H    = OFF_MIX + (size_t)MPAD * 2048 * 2;
constexpr size_t OFF_U    = OFF_H + al256((size_t)MV * 1024 * 4);
constexpr size_t OFF_HB   = OFF_U;
constexpr size_t OFF_PB   = OFF_U + (size_t)MPAD * 1024 * 2;
constexpr size_t WS_END   = OFF_U + al256((size_t)MV * INC * 2);
constexpr int LDS_BYTES = 144 * 1024;

struct Params { const float* in[32]; float* out; unsigned char* ws; };
#define WSP(T, off) ((T*)(P.ws + (off)))

typedef __bf16 bf16v2_t __attribute__((ext_vector_type(2)));
typedef float f32v2_t __attribute__((ext_vector_type(2)));
DI unsigned pack2(float lo, float hi) { f32v2_t v = {lo, hi}; bf16v2_t b = __builtin_convertvector(v, bf16v2_t); return __builtin_bit_cast(unsigned, b); }
DI bf16_t f2bf(float f) { return __builtin_bit_cast(bf16_t, (__bf16)f); }
DI float bf2f(bf16_t b) { return __uint_as_float(((unsigned)b) << 16); }
DI float bflo(unsigned w) { return __uint_as_float(w << 16); }
DI float bfhi(unsigned w) { return __uint_as_float(w & 0xFFFF0000u); }
DI float frcp(float x) { return __builtin_amdgcn_rcpf(x); }
DI float sigm(float x) { return frcp(1.f + __expf(-x)); }
DI float silu(float x) { return x * frcp(1.f + __expf(-x)); }
DI float softplus(float x) { return x > 20.f ? x : log1pf(__expf(x)); }
DI float wave_sum(float v) { for (int o = 32; o > 0; o >>= 1) v += __shfl_xor(v, o); return v; }
DI int otid() { int t = threadIdx.x; asm volatile("" : "+v"(t)); return t; }
DI void lds_barrier() { asm volatile("s_waitcnt lgkmcnt(0)" ::: "memory"); __builtin_amdgcn_s_barrier(); asm volatile("" ::: "memory"); }
DI int crow(int reg, int hh) { return (reg & 3) + 8 * (reg >> 2) + 4 * hh; }
DI void ld4bf(const bf16_t* p, float (&o)[4]) { uint2 w = *(const uint2*)p; o[0] = bflo(w.x); o[1] = bfhi(w.x); o[2] = bflo(w.y); o[3] = bfhi(w.y); }
typedef unsigned u32x2 __attribute__((ext_vector_type(2)));
typedef unsigned u32x4 __attribute__((ext_vector_type(4)));
DI u32x2 pack4v(float a, float b, float c, float d) { u32x2 r; r.x = pack2(a, b); r.y = pack2(c, d); return r; }
DI uint2 pack4(float a, float b, float c, float d) { uint2 r; r.x = pack2(a, b); r.y = pack2(c, d); return r; }
#define MFMA32(a, b, c) __builtin_amdgcn_mfma_f32_32x32x16_bf16((a), (b), (c), 0, 0, 0)
#define MFMA16(a, b, c) __builtin_amdgcn_mfma_f32_16x16x32_bf16((a), (b), (c), 0, 0, 0)
DI bf16x8 ldfrag(const bf16_t* base, int ld, int row0, int k0, int lane) { return *(const bf16x8*)(base + (row0 + (lane & 31)) * ld + k0 + 8 * (lane >> 5)); }
DI bf16x8 ldfrag16(const bf16_t* base, int ld, int row0, int k0, int lane) { return *(const bf16x8*)(base + (row0 + (lane & 15)) * ld + k0 + 8 * (lane >> 4)); }

namespace pg8 {
constexpr int BM = 256, BK = 64, HALF = 128, HTB = HALF * BK * 2, STAGE_BYTES = 8 * HTB, NXCD = 8, WGM = 8;
DI int lds_byte(int r, int c) { const int st = (r >> 4) * 2 + (c >> 5), rr = r & 15, cc = c & 31, ob = rr * 64 + cc * 2; return st * 1024 + (ob ^ (((ob >> 9) & 1) << 5)); }
DI void stage_rc(int b, int& R, int& C) { const int st = b / 1024, sb = b % 1024, swz = sb ^ (((sb >> 9) & 1) << 5); R = (st >> 1) * 16 + swz / 64; C = (st & 1) * 32 + (swz % 64) / 2; }
DI int perm32(int rho) { const int n = rho >> 4, i = rho & 15; return 8 * (i >> 2) + 4 * n + (i & 3); }
struct Unit { int pm, pn; };
struct Gemm { const bf16_t* A; const bf16_t* Bt; int M, N, K; };
struct StaticOrder {
    int nM, nN, nwg, G, c;
    DI void init(int M, int N, int G_, int c_) { nM = M / BM; nN = N / BM; nwg = nM * nN; G = G_; c = c_; }
    DI bool next(int i, Unit& u) const {
        const long L = (long)i * G + c; if (L >= nwg) return false;
        int wgid = (int)L; { const int q = nwg / NXCD, r = nwg % NXCD, xcd = wgid % NXCD, off = wgid / NXCD; wgid = (xcd < r ? xcd * (q + 1) : r * (q + 1) + (xcd - r) * q) + off; }
        const int nig = WGM * nN, gid = wgid / nig, fm = gid * WGM, gsz = (nM - fm) < WGM ? (nM - fm) : WGM;
        u.pm = fm + ((wgid % nig) % gsz); u.pn = (wgid % nig) / gsz; return true;
    }
};

template <class Epi>
DI void gemm_phase(LAS unsigned char* lds, const Gemm g, const StaticOrder& S, const Epi& E) {
    const int tid = otid(), wid = __builtin_amdgcn_readfirstlane(tid >> 6), lane = tid & 63, wr = wid >> 2, wc = wid & 3, fr = lane & 15, fq = lane >> 4;
    const int K = g.K, nt = K / BK;
    unsigned voffA[2], voffB[2];
#pragma unroll
    for (int i = 0; i < 2; ++i) { int R, C; stage_rc(tid * 16 + i * 8192, R, C); const int Rb = Epi::PERM ? ((R & ~31) + perm32(R & 31)) : R;
        voffA[i] = (unsigned)(R * K + C) * 2u; voffB[i] = (unsigned)(Rb * K + C) * 2u; }
    const size_t kstep = (size_t)(BK * 2);
    const size_t hstep = (size_t)HALF * K * 2;
    const size_t tstep = 2 * hstep;
    const unsigned ldsw = (unsigned)wid * 1024u;
    const int aoff = lds_byte(wr * 64 + fr, fq * 8), boff = lds_byte(wc * 32 + fr, fq * 8);
#define PG8_SA(b, h) (((b) * 2 + (h)) * HTB)
#define PG8_SB(b, h) ((4 + (b) * 2 + (h)) * HTB)
#define PG8_STAGE(bufoff, gbase, voff) do { _Pragma("unroll") for (int _i = 0; _i < 2; ++_i) \
        __builtin_amdgcn_global_load_lds((const unsigned*)((const char*)(gbase) + (voff)[_i]), (LAS unsigned*)(lds + (bufoff) + ldsw + _i * 8192), 16, 0, 0); } while (0)
#define PG8_LDA(dst, b, h) do { _Pragma("unroll") for (int m = 0; m < 4; ++m) _Pragma("unroll") for (int k = 0; k < 2; ++k) dst[m][k] = *(const LAS bf16x8*)(lds + PG8_SA(b, h) + aoff + m * 2048 + k * 1024); } while (0)
#define PG8_LDB(dst, b, h) do { _Pragma("unroll") for (int n = 0; n < 2; ++n) _Pragma("unroll") for (int k = 0; k < 2; ++k) dst[n][k] = *(const LAS bf16x8*)(lds + PG8_SB(b, h) + boff + n * 2048 + k * 1024); } while (0)
#define PG8_MMA(ai, bj, At, Bt) do { __builtin_amdgcn_s_setprio(1); _Pragma("unroll") for (int m = 0; m < 4; ++m) _Pragma("unroll") for (int n = 0; n < 2; ++n) _Pragma("unroll") for (int k = 0; k < 2; ++k) \
        acc[ai][bj][m][n] = __builtin_amdgcn_mfma_f32_16x16x32_bf16(Bt[n][k], At[m][k], acc[ai][bj][m][n], 0, 0, 0); __builtin_amdgcn_s_setprio(0); } while (0)
#define PG8_WAIT_V(n) asm volatile("s_waitcnt vmcnt(" #n ")" ::: "memory")
#define PG8_WAIT_L(n) asm volatile("s_waitcnt lgkmcnt(" #n ")" ::: "memory")
#define PG8_BAR __builtin_amdgcn_s_barrier()
#define PG8_SCHED __builtin_amdgcn_sched_barrier(0)
    Unit cur, nxt; int ui = 0;
    if (!S.next(0, cur)) return;
    f32x4 acc[2][2][4][2];
#pragma unroll
    for (int a = 0; a < 2; ++a)
#pragma unroll
        for (int b = 0; b < 2; ++b)
#pragma unroll
            for (int m = 0; m < 4; ++m)
#pragma unroll
                for (int n = 0; n < 2; ++n) acc[a][b][m][n] = (f32x4){0.f, 0.f, 0.f, 0.f};
    bf16x8 At[4][2], B0[2][2], B1[2][2];
    const char* cA = (const char*)g.A + (size_t)cur.pm * tstep; const char* cB = (const char*)g.Bt + (size_t)cur.pn * tstep;
    PG8_STAGE(PG8_SB(0, 0), cB, voffB); PG8_STAGE(PG8_SA(0, 0), cA, voffA); PG8_STAGE(PG8_SB(0, 1), cB + hstep, voffB); PG8_STAGE(PG8_SA(0, 1), cA + hstep, voffA);
    if (wr == 1) PG8_BAR;
    PG8_WAIT_V(4); PG8_BAR;
    PG8_STAGE(PG8_SB(1, 0), cB + kstep, voffB); PG8_STAGE(PG8_SA(1, 0), cA + kstep, voffA); PG8_STAGE(PG8_SB(1, 1), cB + hstep + kstep, voffB);
    PG8_WAIT_V(6); PG8_BAR;
    for (;;) {
        const bool has_next = S.next(ui + 1, nxt);
        const char* nA = has_next ? (const char*)g.A + (size_t)nxt.pm * tstep : cA; const char* nB = has_next ? (const char*)g.Bt + (size_t)nxt.pn * tstep : cB;
        for (int t = 0; t < nt; t += 2) {
            const bool last = (t == nt - 2);
            const char* a1 = cA + (size_t)(t + 1) * kstep;
            const char* a2 = last ? nA : cA + (size_t)(t + 2) * kstep; const char* b2 = last ? nB : cB + (size_t)(t + 2) * kstep;
            const char* a3 = a2 + kstep; const char* b3 = b2 + kstep;
            PG8_LDB(B0, 0, 0); PG8_SCHED; PG8_LDA(At, 0, 0); PG8_STAGE(PG8_SA(1, 1), a1 + hstep, voffA);
            PG8_WAIT_L(8); PG8_BAR; PG8_WAIT_L(0); PG8_MMA(0, 0, At, B0); PG8_BAR; PG8_SCHED;
            PG8_LDB(B1, 0, 1); PG8_STAGE(PG8_SB(0, 0), b2, voffB);
            PG8_BAR; PG8_WAIT_L(0); PG8_MMA(0, 1, At, B1); PG8_BAR;
            PG8_LDA(At, 0, 1); PG8_STAGE(PG8_SA(0, 0), a2, voffA);
            PG8_BAR; PG8_WAIT_L(0); PG8_MMA(1, 0, At, B0); PG8_BAR; PG8_SCHED;
            PG8_STAGE(PG8_SB(0, 1), b2 + hstep, voffB);
            PG8_WAIT_V(6); PG8_BAR; PG8_MMA(1, 1, At, B1); PG8_BAR;
            PG8_LDB(B0, 1, 0); PG8_SCHED; PG8_LDA(At, 1, 0); PG8_STAGE(PG8_SA(0, 1), a2 + hstep, voffA);
            PG8_WAIT_L(8); PG8_BAR; PG8_WAIT_L(0); PG8_MMA(0, 0, At, B0); PG8_BAR; PG8_SCHED;
            PG8_LDB(B1, 1, 1); PG8_STAGE(PG8_SB(1, 0), b3, voffB);
            PG8_BAR; PG8_WAIT_L(0); PG8_MMA(0, 1, At, B1); PG8_BAR;
            PG8_LDA(At, 1, 1); PG8_STAGE(PG8_SA(1, 0), a3, voffA);
            PG8_BAR; PG8_WAIT_L(0); PG8_MMA(1, 0, At, B0); PG8_BAR; PG8_SCHED;
            PG8_STAGE(PG8_SB(1, 1), b3 + hstep, voffB);
            PG8_WAIT_V(6); PG8_BAR; PG8_MMA(1, 1, At, B1); PG8_BAR;
        }
        E(acc, cur, wr, wc, fr, fq);
        if (!has_next) break;
#pragma unroll
        for (int a = 0; a < 2; ++a)
#pragma unroll
            for (int b = 0; b < 2; ++b)
#pragma unroll
                for (int m = 0; m < 4; ++m)
#pragma unroll
                    for (int n = 0; n < 2; ++n) acc[a][b][m][n] = (f32x4){0.f, 0.f, 0.f, 0.f};
        cur = nxt; cA = nA; cB = nB; ++ui;
    }
    PG8_WAIT_V(0);
    if (wr == 0) PG8_BAR;
    PG8_BAR;
#undef PG8_SA
#undef PG8_SB
#undef PG8_STAGE
#undef PG8_LDA
#undef PG8_LDB
#undef PG8_MMA
#undef PG8_WAIT_V
#undef PG8_WAIT_L
#undef PG8_BAR
#undef PG8_SCHED
}
}

struct EpiStoreBf16 {
    static constexpr bool PERM = true;
    bf16_t* O; int ldc; const float* ss; float* DT;
    DI void operator()(const f32x4 (&acc)[2][2][4][2], const pg8::Unit& u, int wr, int wc, int fr, int fq) const {
        const int row0 = u.pm * 256 + wr * 64 + fr, col0 = u.pn * 256 + wc * 32 + 8 * fq;
        if (u.pn * 256 >= ldc) {
            if (wc == 0 && fq < 2) {
#pragma unroll
                for (int ai = 0; ai < 2; ++ai)
#pragma unroll
                    for (int m = 0; m < 4; ++m) { const int row = row0 + ai * 128 + m * 16;
                        if (row < MV) { *(f32x4*)(DT + (size_t)row * 16 + 8 * fq) = acc[ai][0][m][0]; *(f32x4*)(DT + (size_t)row * 16 + 8 * fq + 4) = acc[ai][0][m][1]; } }
            }
            return;
        }
#pragma unroll
        for (int ai = 0; ai < 2; ++ai)
#pragma unroll
            for (int m = 0; m < 4; ++m) {
                const int row = row0 + ai * 128 + m * 16;
                if (row < MV) {
                    const float sc = ss ? rsqrtf(ss[row] * (1.f / 1024.f) + EPSF) : 1.f;
                    bf16_t* rp = O + (size_t)row * ldc + col0;
#pragma unroll
                    for (int bj = 0; bj < 2; ++bj) {
                        const f32x4 v0 = acc[ai][bj][m][0] * sc, v1 = acc[ai][bj][m][1] * sc;
                        uint4 w; w.x = pack2(v0[0], v0[1]); w.y = pack2(v0[2], v0[3]); w.z = pack2(v1[0], v1[1]); w.w = pack2(v1[2], v1[3]);
                        *(uint4*)(rp + bj * 128) = w;
                    }
                }
            }
    }
};
struct EpiResid {
    static constexpr bool PERM = false;
    const float* rp_prompt; const float* rp_sample;
    float* H; bf16_t* HB;
    DI void operator()(const f32x4 (&acc)[2][2][4][2], const pg8::Unit& u, int wr, int wc, int fr, int fq) const {
        const int row0 = u.pm * 256 + wr * 64 + fr, col0 = u.pn * 256 + wc * 32 + 4 * fq;
#pragma unroll
        for (int ai = 0; ai < 2; ++ai)
#pragma unroll
            for (int m = 0; m < 4; ++m) {
                const int row = row0 + ai * 128 + m * 16;
                if (row < MV) {
                    const float* rs = (row < MP ? rp_prompt + (size_t)row * 1024 : rp_sample + (size_t)(row - MP) * 1024) + col0;
                    float* hp = H + (size_t)row * 1024 + col0; bf16_t* bp = HB + (size_t)row * 1024 + col0;
#pragma unroll
                    for (int bj = 0; bj < 2; ++bj)
#pragma unroll
                        for (int n = 0; n < 2; ++n) {
                            const int co = bj * 128 + n * 16;
                            const f32x4 v = acc[ai][bj][m][n] + *(const f32x4*)(rs + co);
                            *(f32x4*)(hp + co) = v; *(uint2*)(bp + co) = pack4(v[0], v[1], v[2], v[3]);
                        }
                }
            }
    }
};
struct EpiGate {
    static constexpr bool PERM = false;
    float* Gt;
    DI void operator()(const f32x4 (&acc)[2][2][4][2], const pg8::Unit& u, int wr, int wc, int fr, int fq) const {
        const int row0 = u.pm * 256 + wr * 64 + fr, col0 = u.pn * 256 + wc * 32 + 4 * fq;
#pragma unroll
        for (int ai = 0; ai < 2; ++ai)
#pragma unroll
            for (int m = 0; m < 4; ++m) {
                const int row = row0 + ai * 128 + m * 16;
                if (row < MV) {
                    float* gp = Gt + (size_t)row * 1024 + col0;
#pragma unroll
                    for (int bj = 0; bj < 2; ++bj)
#pragma unroll
                        for (int n = 0; n < 2; ++n) {
                            const f32x4 a = acc[ai][bj][m][n];
                            *(f32x4*)(gp + bj * 128 + n * 16) = (f32x4){sigm(a[0]), sigm(a[1]), sigm(a[2]), sigm(a[3])};
                        }
                }
            }
    }
};
struct EpiPle {
    static constexpr bool PERM = false;
    float* H; const float* Gt; bf16_t* XN; const float* nw; float* SS;
    DI void operator()(const f32x4 (&acc)[2][2][4][2], const pg8::Unit& u, int wr, int wc, int fr, int fq) const {
        const int row0 = u.pm * 256 + wr * 64 + fr, col0 = u.pn * 256 + wc * 32 + 4 * fq;
#pragma unroll
        for (int ai = 0; ai < 2; ++ai)
#pragma unroll
            for (int m = 0; m < 4; ++m) {
                const int row = row0 + ai * 128 + m * 16;
                float ssum = 0.f;
                if (row < MV) {
                    float* hp = H + (size_t)row * 1024 + col0; const float* gp = Gt + (size_t)row * 1024 + col0;
#pragma unroll
                    for (int bj = 0; bj < 2; ++bj)
#pragma unroll
                        for (int n = 0; n < 2; ++n) {
                            const int co = bj * 128 + n * 16;
                            const f32x4 v = *(const f32x4*)(hp + co) + *(const f32x4*)(gp + co) * acc[ai][bj][m][n];
                            *(f32x4*)(hp + co) = v;
                            ssum += v[0] * v[0] + v[1] * v[1] + v[2] * v[2] + v[3] * v[3];
                            if (XN) { const f32x4 w = *(const f32x4*)(nw + col0 + co); *(uint2*)(XN + (size_t)row * 1024 + col0 + co) = pack4(v[0] * w[0], v[1] * w[1], v[2] * w[2], v[3] * w[3]); }
                        }
                }
                ssum += __shfl_xor(ssum, 16); ssum += __shfl_xor(ssum, 32);
                if (fq == 0 && row < MV) atomicAdd(SS + row, ssum);
            }
    }
};

template <int KS, class F>
DI void sgemm(const bf16_t* A, const bf16_t* Bt, int K, int ncolt, int nwg_main, const F& f, unsigned char* L) {
    constexpr int RT = 8 / KS, NRS = 128 / (16 * RT);
    const int tid = otid(), lane = tid & 63, wid = __builtin_amdgcn_readfirstlane(tid >> 6), rt = wid % RT, ks = wid / RT;
    const int G = gridDim.x, off = nwg_main % G, Kh = K / KS;
    int li = blockIdx.x, nl = G;
    if (off != 0) { if ((int)blockIdx.x < off) return; li = blockIdx.x - off; nl = G - off; }
    float* red = (float*)L;
    for (int t = li; t < ncolt * NRS; t += nl) {
        const int ct = t / NRS, rs = t % NRS;
        const bf16_t* ap = A + (size_t)(MP + rs * 16 * RT + rt * 16 + (lane & 15)) * K + ks * Kh + 8 * (lane >> 4);
        const bf16_t* bp0 = Bt + (size_t)(ct * 32 + (lane & 15)) * K + ks * Kh + 8 * (lane >> 4);
        const bf16_t* bp1 = bp0 + (size_t)16 * K;
        f32x4 acc0 = {0.f, 0.f, 0.f, 0.f}, acc1 = {0.f, 0.f, 0.f, 0.f};
        bf16x8 a0[4], a1[4], p0[4], p1[4], q0[4], q1[4];
#define SG_LOAD(av, pv, qv, kk) do { _Pragma("unroll") for (int q_ = 0; q_ < 4; ++q_) { av[q_] = *(const bf16x8*)(ap + (kk) + q_ * 32); pv[q_] = *(const bf16x8*)(bp0 + (kk) + q_ * 32); qv[q_] = *(const bf16x8*)(bp1 + (kk) + q_ * 32); } } while (0)
#define SG_MMA(av, pv, qv) do { _Pragma("unroll") for (int q_ = 0; q_ < 4; ++q_) { acc0 = MFMA16(av[q_], pv[q_], acc0); acc1 = MFMA16(av[q_], qv[q_], acc1); } } while (0)
        SG_LOAD(a0, p0, q0, 0);
        for (int k0 = 0; k0 < Kh; k0 += 256) {
            if (k0 + 128 < Kh) SG_LOAD(a1, p1, q1, k0 + 128);
            SG_MMA(a0, p0, q0);
            if (k0 + 256 < Kh) SG_LOAD(a0, p0, q0, k0 + 256);
            if (k0 + 128 < Kh) SG_MMA(a1, p1, q1);
        }
#undef SG_LOAD
#undef SG_MMA
        if (ks > 0) { float* rp = red + (((ks - 1) * RT + rt) * 64 + lane) * 8; *(f32x4*)rp = acc0; *(f32x4*)(rp + 4) = acc1; }
        lds_barrier();
        if (ks == 0) {
#pragma unroll
            for (int j = 0; j < KS - 1; ++j) { const float* rp = red + ((j * RT + rt) * 64 + lane) * 8; acc0 += *(const f32x4*)rp; acc1 += *(const f32x4*)(rp + 4); }
#pragma unroll
            for (int reg = 0; reg < 4; ++reg) {
                const int row = MP + rs * 16 * RT + rt * 16 + (lane >> 4) * 4 + reg, col = ct * 32 + (lane & 15);
                f(row, col, acc0[reg], lane); f(row, col + 16, acc1[reg], lane);
            }
        }
        lds_barrier();
    }
}
struct SfU { bf16_t* O; int ldc; const float* ss; float* DT;
    DI void operator()(int row, int col, float v, int) const {
        if (col >= ldc) { if (col < ldc + 16) DT[(size_t)row * 16 + col - ldc] = v; return; }
        const float sc = ss ? rsqrtf(ss[row] * (1.f / 1024.f) + EPSF) : 1.f; O[(size_t)row * ldc + col] = f2bf(v * sc); } };
struct SfResid { const float* rs; float* H; bf16_t* HB;
    DI void operator()(int row, int col, float v, int) const { const float h = rs[(size_t)(row - MP) * 1024 + col] + v; H[(size_t)row * 1024 + col] = h; HB[(size_t)row * 1024 + col] = f2bf(h); } };
struct SfGate { float* Gt; DI void operator()(int row, int col, float v, int) const { Gt[(size_t)row * 1024 + col] = sigm(v); } };
struct SfPle { float* H; const float* Gt; bf16_t* XN; const float* nw; float* SS;
    DI void operator()(int row, int col, float v, int lane) const {
        const size_t o = (size_t)row * 1024 + col; const float h = H[o] + Gt[o] * v; H[o] = h;
        if (XN) XN[o] = f2bf(h * nw[col]);
        float ss = h * h; ss += __shfl_xor(ss, 1); ss += __shfl_xor(ss, 2); ss += __shfl_xor(ss, 4); ss += __shfl_xor(ss, 8);
        if ((lane & 15) == 0) atomicAdd(SS + row, ss); } };

DI void transpose_tile_w(const float* src, int lds_, bf16_t* dst, int ldd, int k0, int n0, int nvalid, float* tile, int lane) {
    const float* sp = src + (size_t)k0 * lds_ + n0 + lane;
#pragma unroll
    for (int bt = 0; bt < 4; ++bt) {
        float v[16];
#pragma unroll
        for (int r = 0; r < 16; ++r) v[r] = (lane < nvalid) ? sp[(size_t)(bt * 16 + r) * lds_] : 0.f;
#pragma unroll
        for (int r = 0; r < 16; ++r) tile[(bt * 16 + r) * 65 + lane] = v[r];
    }
    const int koct = lane & 7;
#pragma unroll
    for (int p = 0; p < 8; ++p) {
        const int nn = (lane >> 3) + 8 * p;
        const float* tp = tile + (koct * 8) * 65 + nn;
        uint4 w;
        w.x = pack2(tp[0], tp[65]); w.y = pack2(tp[2 * 65], tp[3 * 65]); w.z = pack2(tp[4 * 65], tp[5 * 65]); w.w = pack2(tp[6 * 65], tp[7 * 65]);
        *(uint4*)(dst + (size_t)(n0 + nn) * ldd + k0 + koct * 8) = w;
    }
}
DI void transpose_job(const float* src, int lds_, bf16_t* dst, int ldd, int K, int N, int nvalid_last, int& base, float* tile, int gw, int nwv, int lane) {
    const int ntn = (N + 63) / 64, nt = (K / 64) * ntn;
    const int first = (gw - (base % nwv) + nwv) % nwv;
    for (int t = first; t < nt; t += nwv) { const int tn = t % ntn; transpose_tile_w(src, lds_, dst, ldd, (t / ntn) * 64, tn * 64, (tn == ntn - 1) ? nvalid_last : 64, tile, lane); }
    base += nt;
}
DI void phase_prep(const Params& P, unsigned char* L) {
    const int tid = otid(), lane = tid & 63, wid = tid >> 6;
    const int gw = blockIdx.x * 8 + wid, nwv = gridDim.x * 8;
    { float* z = WSP(float, OFF_SS1); const int n = (int)((OFF_DT - OFF_SS1) / 4);
      for (int i = blockIdx.x * 512 + tid; i < n; i += gridDim.x * 512) z[i] = 0.f;
      if (blockIdx.x == 0 && tid < 64) WSP(unsigned, OFF_CTL)[tid] = 0u; }
    { float* tile = (float*)L + wid * (64 * 65); int base = 0;
      transpose_job(P.in[26], INC, WSP(bf16_t, OFF_W1T), 1024, 1024, INC, 64, base, tile, gw, nwv, lane);
      transpose_job(P.in[11], INAB, WSP(bf16_t, OFF_W0T), 1024, 1024, N0, 64, base, tile, gw, nwv, lane);
      transpose_job(P.in[11] + N0, INAB, WSP(bf16_t, OFF_W0T) + (size_t)N0 * 1024, 1024, 1024, 16, 16, base, tile, gw, nwv, lane);
      transpose_job(P.in[25], 1024, WSP(bf16_t, OFF_WO0T), 2048, 2048, 1024, 64, base, tile, gw, nwv, lane);
      transpose_job(P.in[31], 1024, WSP(bf16_t, OFF_WG0T), 1024, 1024, 1024, 64, base, tile, gw, nwv, lane);
      transpose_job(P.in[30], 1024, WSP(bf16_t, OFF_WP0T), 256, 256, 1024, 64, base, tile, gw, nwv, lane);
      transpose_job(P.in[29], 1024, WSP(bf16_t, OFF_WO1T), 2048, 2048, 1024, 64, base, tile, gw, nwv, lane);
      transpose_job(P.in[31] + 1024 * 1024, 1024, WSP(bf16_t, OFF_WG1T), 1024, 1024, 1024, 64, base, tile, gw, nwv, lane);
      transpose_job(P.in[30] + 256 * 1024, 1024, WSP(bf16_t, OFF_WP1T), 256, 256, 1024, 64, base, tile, gw, nwv, lane);
      transpose_job(P.in[14], 128, WSP(bf16_t, OFF_WRT), 1024, 1024, 128, 64, base, tile, gw, nwv, lane);
      transpose_job(P.in[16], 128, WSP(bf16_t, OFF_WIT), 1024, 1024, 128, 64, base, tile, gw, nwv, lane); }
    { const float* nwp = P.in[9]; bf16_t* XN = WSP(bf16_t, OFF_XN);
      f32x4 w4[4];
#pragma unroll
      for (int i = 0; i < 4; ++i) w4[i] = *(const f32x4*)(nwp + lane * 4 + 256 * i);
      for (int r0 = gw * 2; r0 < MV; r0 += nwv * 2) {
          f32x4 x[2][4];
#pragma unroll
          for (int q = 0; q < 2; ++q) { const int r = r0 + q; const float* src = r < MP ? P.in[0] + (size_t)r * 1024 : P.in[1] + (size_t)(r - MP) * 1024;
#pragma unroll
              for (int i = 0; i < 4; ++i) x[q][i] = *(const f32x4*)(src + lane * 4 + 256 * i); }
#pragma unroll
          for (int q = 0; q < 2; ++q) {
              float ss = 0.f;
#pragma unroll
              for (int i = 0; i < 4; ++i) ss += x[q][i][0] * x[q][i][0] + x[q][i][1] * x[q][i][1] + x[q][i][2] * x[q][i][2] + x[q][i][3] * x[q][i][3];
              ss = wave_sum(ss); const float rstd = rsqrtf(ss * (1.f / 1024.f) + EPSF);
#pragma unroll
              for (int i = 0; i < 4; ++i) { const f32x4 v = x[q][i] * rstd * w4[i]; *(uint2*)(XN + (size_t)(r0 + q) * 1024 + lane * 4 + 256 * i) = pack4(v[0], v[1], v[2], v[3]); }
          }
      } }
}
DI void convert_p(const Params& P, int layer) {
    bf16_t* PB = WSP(bf16_t, OFF_PB);
    const float* pp = P.in[2] + (size_t)layer * MP * 256; const float* ps = P.in[3] + (size_t)layer * MS * 256;
    for (int i = blockIdx.x * 512 + threadIdx.x; i < MV * 64; i += gridDim.x * 512) {
        const int row = i >> 6, c4 = (i & 63) * 4;
        const f32x4 v = *(const f32x4*)((row < MP ? pp + (size_t)row * 256 : ps + (size_t)(row - MP) * 256) + c4);
        *(uint2*)(PB + (size_t)row * 256 + c4) = pack4(v[0], v[1], v[2], v[3]);
    }
}

constexpr size_t OFF_XT = OFF_XN;
constexpr size_t OFF_CN = OFF_H;
constexpr size_t OFF_BN = OFF_CN + (size_t)MP * 256 * 2;
constexpr size_t OFF_BT = OFF_BN + (size_t)MP * 256 * 2;
DI void phase_convbc(const Params& P) {
    const bf16_t* U = WSP(bf16_t, OFF_U);
    bf16_t* XT = WSP(bf16_t, OFF_XT); bf16_t* CN = WSP(bf16_t, OFF_CN); bf16_t* BN = WSP(bf16_t, OFF_BN); bf16_t* BT = WSP(bf16_t, OFF_BT);
    for (int idx = blockIdx.x * 512 + otid(); idx < 2048 * 384; idx += gridDim.x * 512) {
        const int quad = idx % 384, tgp = idx / 384, b = tgp >> 8, t0 = (tgp & 255) * 8, cch = quad * 4;
        float cw[4][4], cbias[4];
#pragma unroll
        for (int kk = 0; kk < 4; ++kk) { const f32x4 w = *(const f32x4*)(P.in[19] + kk * 1536 + cch); cw[kk][0] = w[0]; cw[kk][1] = w[1]; cw[kk][2] = w[2]; cw[kk][3] = w[3]; }
        { const f32x4 w = *(const f32x4*)(P.in[20] + cch); cbias[0] = w[0]; cbias[1] = w[1]; cbias[2] = w[2]; cbias[3] = w[3]; }
        const unsigned voff = (unsigned)((b * 2048 + t0) * N0 + 3072 + cch);
        uint2 raw[11];
#pragma unroll
        for (int j = 0; j < 11; ++j) raw[j] = (t0 + j - 3 >= 0) ? *(const uint2*)((U + (j - 3) * N0) + voff) : make_uint2(0u, 0u);
        float y[8][4];
#pragma unroll
        for (int j = 0; j < 8; ++j) {
            const float x0[4] = {bflo(raw[j].x), bfhi(raw[j].x), bflo(raw[j].y), bfhi(raw[j].y)};
            const float x1[4] = {bflo(raw[j + 1].x), bfhi(raw[j + 1].x), bflo(raw[j + 1].y), bfhi(raw[j + 1].y)};
            const float x2[4] = {bflo(raw[j + 2].x), bfhi(raw[j + 2].x), bflo(raw[j + 2].y), bfhi(raw[j + 2].y)};
            const float x3[4] = {bflo(raw[j + 3].x), bfhi(raw[j + 3].x), bflo(raw[j + 3].y), bfhi(raw[j + 3].y)};
#pragma unroll
            for (int e = 0; e < 4; ++e) y[j][e] = silu(cbias[e] + cw[0][e] * x0[e] + cw[1][e] * x1[e] + cw[2][e] * x2[e] + cw[3][e] * x3[e]);
        }
        const int c = t0 >> 7, tl = t0 & 127;
        if (cch < 1024) {
#pragma unroll
            for (int e = 0; e < 4; ++e) { uint4 w; w.x = pack2(y[0][e], y[1][e]); w.y = pack2(y[2][e], y[3][e]); w.z = pack2(y[4][e], y[5][e]); w.w = pack2(y[6][e], y[7][e]);
                *(uint4*)(XT + ((size_t)((b * 16 + c) * 1024 + cch + e)) * 128 + tl) = w; }
        } else {
            const int cc = cch - 1024, isC = cc >= 256, g = (cc & 255) >> 7, n0 = cc & 127;
            bf16_t* nat = (isC ? CN : BN) + ((size_t)(((b * 16 + c) * 2 + g) * 128 + tl)) * 128 + n0;
#pragma unroll
            for (int j = 0; j < 8; ++j) *(uint2*)(nat + j * 128) = pack4(y[j][0], y[j][1], y[j][2], y[j][3]);
            if (!isC) {
#pragma unroll
                for (int e = 0; e < 4; ++e) { uint4 w; w.x = pack2(y[0][e], y[1][e]); w.y = pack2(y[2][e], y[3][e]); w.z = pack2(y[4][e], y[5][e]); w.w = pack2(y[6][e], y[7][e]);
                    *(uint4*)(BT + ((size_t)(((b * 16 + c) * 2 + g) * 128 + n0 + e)) * 128 + tl) = w; }
            }
        }
    }
}
DI void ssd_prompt_item(const Params& P, unsigned char* L, int item) {
    const int b = item >> 4, h = item & 15, g = h >> 3;
    const int tid0 = otid(), wid = tid0 >> 6;
    bf16_t* Cs = (bf16_t*)L;
    bf16_t* Bs = Cs + 128 * 136;
    bf16_t* BsT = Bs + 128 * 136;
    bf16_t* XsT = BsT + 128 * 136;
    bf16_t* St = XsT + 64 * 136;
    float* dtvB = (float*)(St + 64 * 136); float* acsB = dtvB + 256; float* wvB = acsB + 256;
    const bf16_t* U = WSP(bf16_t, OFF_U); const float* DT = WSP(float, OFF_DT); bf16_t* MIX = WSP(bf16_t, OFF_MIX); float* SSB = WSP(float, OFF_SSB);
    const float a_neg = -__expf(P.in[22][h]), dtb = P.in[21][h], Dh = P.in[23][h];
    f32x16 accS;
#pragma unroll
    for (int i = 0; i < 16; ++i) accS[i] = 0.f;
    lds_barrier();
    for (int i = tid0; i < 64 * 136; i += 512) St[i] = 0;
    float dtr0 = 0.f, dtr1 = 0.f;
#define SSD_DTLOAD(cc) do { if (wid == 0) { const float* dp_ = DT + (size_t)(b * 2048 + (cc) * 128 + (tid0 & 63)) * 16 + h; dtr0 = dp_[0]; dtr1 = dp_[64 * 16]; } } while (0)
#define SSD_SCAN(buf) do { if (wid == 0) { const int ln_ = tid0 & 63; const float d0_ = softplus(dtr0 + dtb), d1_ = softplus(dtr1 + dtb); float v0_ = d0_ * a_neg, v1_ = d1_ * a_neg; \
        _Pragma("unroll") for (int o_ = 1; o_ < 64; o_ <<= 1) { const float n0_ = __shfl_up(v0_, o_), n1_ = __shfl_up(v1_, o_); if (ln_ >= o_) { v0_ += n0_; v1_ += n1_; } } \
        v1_ += __shfl(v0_, 63); const float al_ = __shfl(v1_, 63); \
        dtvB[(buf) * 128 + ln_] = d0_; dtvB[(buf) * 128 + 64 + ln_] = d1_; acsB[(buf) * 128 + ln_] = v0_; acsB[(buf) * 128 + 64 + ln_] = v1_; \
        wvB[(buf) * 128 + ln_] = __expf(al_ - v0_) * d0_; wvB[(buf) * 128 + 64 + ln_] = __expf(al_ - v1_) * d1_; } } while (0)
    SSD_DTLOAD(0); SSD_SCAN(0); SSD_DTLOAD(1);
    u32x4 tC[4], tB[4], tT[4], tX[2];
    for (int c = 0; c < 16; ++c) {
        const int row0 = b * 2048 + c * 128;
        lds_barrier();
        int zv = 0; asm volatile("" : "+v"(zv));
        const int tid = tid0 + zv, lane = tid & 63, hh = lane >> 5, l31 = lane & 31;
        const int prow = tid >> 4, pcol = (tid & 15) * 8;
        const float* dtv = dtvB + (c & 1) * 128; const float* acs = acsB + (c & 1) * 128; const float* wv = wvB + (c & 1) * 128;
        if (c + 1 < 16) { SSD_SCAN((c + 1) & 1); if (c + 2 < 16) SSD_DTLOAD(c + 2); }
        if (c == 0) {
            const size_t tb_ = ((size_t)((b * 16 + c) * 2 + g)) * 128 * 128 + (size_t)prow * 128 + pcol;
            const u32x4* pc = (const u32x4*)(WSP(bf16_t, OFF_CN) + tb_); const u32x4* pb = (const u32x4*)(WSP(bf16_t, OFF_BN) + tb_); const u32x4* pt = (const u32x4*)(WSP(bf16_t, OFF_BT) + tb_);
            const u32x4* px = (const u32x4*)(WSP(bf16_t, OFF_XT) + ((size_t)((b * 16 + c) * 1024 + h * 64 + prow)) * 128 + pcol);
#pragma unroll
            for (int i = 0; i < 4; ++i) { tC[i] = pc[i * 512]; tB[i] = pb[i * 512]; tT[i] = pt[i * 512]; }
            tX[0] = px[0]; tX[1] = px[512];
        }
        const float a_last = acs[127];
#pragma unroll
        for (int i = 0; i < 4; ++i) {
            *(u32x4*)(Cs + (prow + 32 * i) * 136 + pcol) = tC[i]; *(u32x4*)(Bs + (prow + 32 * i) * 136 + pcol) = tB[i]; *(u32x4*)(BsT + (prow + 32 * i) * 136 + pcol) = tT[i];
        }
        *(u32x4*)(XsT + prow * 136 + pcol) = tX[0]; *(u32x4*)(XsT + (prow + 32) * 136 + pcol) = tX[1];
        if (c + 1 < 16) {
            const size_t tb_ = ((size_t)((b * 16 + c + 1) * 2 + g)) * 128 * 128 + (size_t)prow * 128 + pcol;
            const u32x4* pc = (const u32x4*)(WSP(bf16_t, OFF_CN) + tb_); const u32x4* pb = (const u32x4*)(WSP(bf16_t, OFF_BN) + tb_); const u32x4* pt = (const u32x4*)(WSP(bf16_t, OFF_BT) + tb_);
            const u32x4* px = (const u32x4*)(WSP(bf16_t, OFF_XT) + ((size_t)((b * 16 + c + 1) * 1024 + h * 64 + prow)) * 128 + pcol);
#pragma unroll
            for (int i = 0; i < 4; ++i) { tC[i] = pc[i * 512]; tB[i] = pb[i * 512]; tT[i] = pt[i * 512]; }
            tX[0] = px[0]; tX[1] = px[512];
        }
        bf16_t zr[16];
        {
            const unsigned zoff = (unsigned)((row0 + (wid >> 1) * 32 + 4 * hh) * N0 + 2048 + h * 64 + (wid & 1) * 32 + l31);
#pragma unroll
            for (int reg = 0; reg < 16; ++reg) zr[reg] = (U + ((reg & 3) + 8 * (reg >> 2)) * N0)[zoff];
        }
        lds_barrier();
        {
            const int rb = (wid >> 1) * 32, cb0 = (wid & 1) * 64;
            f32x16 cbA[2];
#pragma unroll
            for (int i = 0; i < 16; ++i) { cbA[0][i] = 0.f; cbA[1][i] = 0.f; }
#pragma unroll
            for (int ks = 0; ks < 8; ++ks) {
                const bf16x8 a = ldfrag(Cs, 136, rb, ks * 16, lane);
                cbA[0] = MFMA32(a, ldfrag(Bs, 136, cb0, ks * 16, lane), cbA[0]);
                cbA[1] = MFMA32(a, ldfrag(Bs, 136, cb0 + 32, ks * 16, lane), cbA[1]);
            }
            lds_barrier();
            bf16_t* Ws = Bs;
#pragma unroll
            for (int j = 0; j < 2; ++j) {
                const int s = cb0 + j * 32 + l31; const float as = acs[s], ds = dtv[s];
#pragma unroll
                for (int reg = 0; reg < 16; ++reg) {
                    const int t = rb + crow(reg, hh);
                    const float v = (s <= t) ? cbA[j][reg] * __expf(acs[t] - as) * ds : 0.f;
                    Ws[t * 136 + s] = f2bf(v);
                }
            }
        }
        lds_barrier();
        {
            const bf16_t* Ws = Bs;
            const int tb = (wid >> 1) * 32, pb = (wid & 1) * 32;
            f32x16 y;
#pragma unroll
            for (int i = 0; i < 16; ++i) y[i] = 0.f;
#pragma unroll
            for (int ks = 0; ks < 8; ++ks) y = MFMA32(ldfrag(Cs, 136, tb, ks * 16, lane), ldfrag(St, 136, pb, ks * 16, lane), y);
#pragma unroll
            for (int reg = 0; reg < 16; ++reg) y[reg] *= __expf(acs[tb + crow(reg, hh)]);
#pragma unroll
            for (int ks = 0; ks < 8; ++ks) y = MFMA32(ldfrag(Ws, 136, tb, ks * 16, lane), ldfrag(XsT, 136, pb, ks * 16, lane), y);
            lds_barrier();
            {
                bf16_t* XwT = Cs;
                const uint4 xa = *(const uint4*)(XsT + prow * 136 + pcol), xb_ = *(const uint4*)(XsT + (prow + 32) * 136 + pcol);
                const f32x4 w0 = *(const f32x4*)(wv + pcol), w1 = *(const f32x4*)(wv + pcol + 4);
                uint4 oa, ob;
                oa.x = pack2(bflo(xa.x) * w0[0], bfhi(xa.x) * w0[1]); oa.y = pack2(bflo(xa.y) * w0[2], bfhi(xa.y) * w0[3]); oa.z = pack2(bflo(xa.z) * w1[0], bfhi(xa.z) * w1[1]); oa.w = pack2(bflo(xa.w) * w1[2], bfhi(xa.w) * w1[3]);
                ob.x = pack2(bflo(xb_.x) * w0[0], bfhi(xb_.x) * w0[1]); ob.y = pack2(bflo(xb_.y) * w0[2], bfhi(xb_.y) * w0[3]); ob.z = pack2(bflo(xb_.z) * w1[0], bfhi(xb_.z) * w1[1]); ob.w = pack2(bflo(xb_.w) * w1[2], bfhi(xb_.w) * w1[3]);
                *(uint4*)(XwT + prow * 136 + pcol) = oa; *(uint4*)(XwT + (prow + 32) * 136 + pcol) = ob;
            }
            const int p = pb + l31, ch = h * 64 + p; const float nwv = P.in[24][ch];
#pragma unroll
            for (int reg = 0; reg < 16; ++reg) {
                const int t = tb + crow(reg, hh); const size_t row = (size_t)(row0 + t);
                const float xv = bf2f(XsT[p * 136 + t]); const float z = bf2f(zr[reg]);
                const float yy = (y[reg] + Dh * xv) * silu(z);
                float ss = yy * yy;
                ss += __shfl_xor(ss, 1); ss += __shfl_xor(ss, 2); ss += __shfl_xor(ss, 4); ss += __shfl_xor(ss, 8); ss += __shfl_xor(ss, 16);
                if (l31 == 0) atomicAdd(SSB + row * 2 + g, ss);
                MIX[row * 2048 + 1024 + ch] = f2bf(yy * nwv);
            }
            lds_barrier();
            const int pb2 = (wid >> 2) * 32, nb = (wid & 3) * 32;
            const float ea = __expf(a_last);
#pragma unroll
            for (int reg = 0; reg < 16; ++reg) accS[reg] *= ea;
#pragma unroll
            for (int ks = 0; ks < 8; ++ks) accS = MFMA32(ldfrag(Cs, 136, pb2, ks * 16, lane), ldfrag(BsT, 136, nb, ks * 16, lane), accS);
#pragma unroll
            for (int reg = 0; reg < 16; ++reg) St[(pb2 + crow(reg, hh)) * 136 + nb + l31] = f2bf(accS[reg]);
        }
    }
    {
        const int lane = tid0 & 63, hh = lane >> 5, l31 = lane & 31;
        const int pb2 = (wid >> 2) * 32, nb = (wid & 3) * 32;
        float* o = P.out + O_BSP + (size_t)(b * 16 + h) * 64 * 128;
#pragma unroll
        for (int reg = 0; reg < 16; ++reg) o[(pb2 + crow(reg, hh)) * 128 + nb + l31] = accS[reg];
    }
}
#undef SSD_DTLOAD
#undef SSD_SCAN
DI void ssd_sample_item(const Params& P, unsigned char* L, int item) {
    const int b = item >> 4, h = item & 15, g = h >> 3, tid = otid(), lane = tid & 63;
    float* xs = (float*)L; float* Bv = xs + 64; float* Cv = Bv + 128; float* yv = Cv + 128;
    const bf16_t* U = WSP(bf16_t, OFF_U); bf16_t* MIX = WSP(bf16_t, OFF_MIX); float* SSB = WSP(float, OFF_SSB);
    const size_t row = (size_t)(MP + b);
    __syncthreads();
    if (tid < 320) {
        int cc; if (tid < 64) cc = h * 64 + tid; else if (tid < 192) cc = 1024 + g * 128 + (tid - 64); else cc = 1280 + g * 128 + (tid - 192);
        const float* buf = P.in[7] + (size_t)b * 3 * 1536 + cc;
        const float v = P.in[20][cc] + P.in[19][cc] * buf[0] + P.in[19][1536 + cc] * buf[1536] + P.in[19][2 * 1536 + cc] * buf[2 * 1536] + P.in[19][3 * 1536 + cc] * bf2f(U[row * N0 + 3072 + cc]);
        xs[tid] = silu(v);
    }
    const float dt = softplus(WSP(float, OFF_DT)[row * 16 + h] + P.in[21][h]);
    const float dA = __expf(-dt * __expf(P.in[22][h]));
    __syncthreads();
    const float* s0 = P.in[6] + (size_t)(b * 16 + h) * 64 * 128; float* s1 = P.out + O_BSS + (size_t)(b * 16 + h) * 64 * 128;
    const int n4 = (tid & 31) * 4;
    const f32x4 Bq = *(const f32x4*)(Bv + n4), Cq = *(const f32x4*)(Cv + n4);
#pragma unroll
    for (int j = 0; j < 4; ++j) {
        const int p = (tid >> 5) + 16 * j;
        const f32x4 s = *(const f32x4*)(s0 + p * 128 + n4);
        const float dx = dt * xs[p];
        const f32x4 sn = s * dA + Bq * dx;
        *(f32x4*)(s1 + p * 128 + n4) = sn;
        float yp = sn[0] * Cq[0] + sn[1] * Cq[1] + sn[2] * Cq[2] + sn[3] * Cq[3];
        yp += __shfl_xor(yp, 1); yp += __shfl_xor(yp, 2); yp += __shfl_xor(yp, 4); yp += __shfl_xor(yp, 8); yp += __shfl_xor(yp, 16);
        if ((tid & 31) == 0) yv[p] = yp;
    }
    __syncthreads();
    if (tid < 64) {
        const int ch = h * 64 + tid;
        const float yy = (yv[tid] + P.in[23][h] * xs[tid]) * silu(bf2f(U[row * N0 + 2048 + ch]));
        const float ss = wave_sum(yy * yy);
        if (lane == 0) atomicAdd(SSB + row * 2 + g, ss);
        MIX[row * 2048 + 1024 + ch] = f2bf(yy * P.in[24][ch]);
    }
}
DI void ssd_sample_item4(const Params& P, unsigned char* L, int item) {
    const int b = item >> 2, tid = otid(), gi = tid >> 7, lt = tid & 127, h = (item & 3) * 4 + gi, g = h >> 3;
    float* xs = (float*)L + gi * 512; float* Bv = xs + 64; float* Cv = Bv + 128; float* yv = Cv + 128;
    const bf16_t* U = WSP(bf16_t, OFF_U); bf16_t* MIX = WSP(bf16_t, OFF_MIX); float* SSB = WSP(float, OFF_SSB);
    const size_t row = (size_t)(MP + b);
    __syncthreads();
#pragma unroll
    for (int ps = 0; ps < 3; ++ps) {
        const int idx = lt + 128 * ps;
        if (idx < 320) {
            int cc; if (idx < 64) cc = h * 64 + idx; else if (idx < 192) cc = 1024 + g * 128 + (idx - 64); else cc = 1280 + g * 128 + (idx - 192);
            const float* buf = P.in[7] + (size_t)b * 3 * 1536 + cc;
            const float v = P.in[20][cc] + P.in[19][cc] * buf[0] + P.in[19][1536 + cc] * buf[1536] + P.in[19][2 * 1536 + cc] * buf[2 * 1536] + P.in[19][3 * 1536 + cc] * bf2f(U[row * N0 + 3072 + cc]);
            xs[idx] = silu(v);
        }
    }
    const float dt = softplus(WSP(float, OFF_DT)[row * 16 + h] + P.in[21][h]);
    const float dA = __expf(-dt * __expf(P.in[22][h]));
    __syncthreads();
    const float* s0 = P.in[6] + (size_t)(b * 16 + h) * 64 * 128; float* s1 = P.out + O_BSS + (size_t)(b * 16 + h) * 64 * 128;
    const int n4 = (lt & 31) * 4;
    const f32x4 Bq = *(const f32x4*)(Bv + n4), Cq = *(const f32x4*)(Cv + n4);
    f32x4 sv[16];
#pragma unroll
    for (int j = 0; j < 16; ++j) sv[j] = *(const f32x4*)(s0 + ((lt >> 5) + 4 * j) * 128 + n4);
#pragma unroll
    for (int j = 0; j < 16; ++j) {
        const int p = (lt >> 5) + 4 * j;
        const f32x4 sn = sv[j] * dA + Bq * (dt * xs[p]);
        *(f32x4*)(s1 + p * 128 + n4) = sn;
        float yp = sn[0] * Cq[0] + sn[1] * Cq[1] + sn[2] * Cq[2] + sn[3] * Cq[3];
        yp += __shfl_xor(yp, 1); yp += __shfl_xor(yp, 2); yp += __shfl_xor(yp, 4); yp += __shfl_xor(yp, 8); yp += __shfl_xor(yp, 16);
        if ((lt & 31) == 0) yv[p] = yp;
    }
    __syncthreads();
    if (lt < 64) {
        const int ch = h * 64 + lt;
        const float yy = (yv[lt] + P.in[23][h] * xs[lt]) * silu(bf2f(U[row * N0 + 2048 + ch]));
        const float ss = wave_sum(yy * yy);
        if (lt == 0) atomicAdd(SSB + row * 2 + g, ss);
        MIX[row * 2048 + 1024 + ch] = f2bf(yy * P.in[24][ch]);
    }
}
template <bool SAMPLE>
DI void rglru_item(const Params& P, unsigned char* L, int item) {
    const int tid0 = otid(), wid = tid0 >> 6;
    const int b = SAMPLE ? 0 : (item >> 4), k = (item >> 1) & 7, dh = item & 1;
    bf16_t* Xs = (bf16_t*)L;
    bf16_t* Wg = Xs + 128 * 136;
    float* Aa = (float*)(Wg + 128 * 136);
    float* Uu = Aa + 128 * 64; float* segA = Uu + 128 * 64; float* segH = segA + 512; float* hc = segH + 512;
    const bf16_t* U = WSP(bf16_t, OFF_U); bf16_t* MIX = WSP(bf16_t, OFF_MIX);
    lds_barrier();
    {
        const bf16_t* WRT = WSP(bf16_t, OFF_WRT); const bf16_t* WIT = WSP(bf16_t, OFF_WIT);
#pragma unroll
        for (int i = 0; i < 4; ++i) {
            const int chk = tid0 + i * 512, r = chk >> 4, c8 = (chk & 15) * 8;
            const bf16_t* src = (r < 64 ? WRT + (size_t)(dh * 64 + r) * 1024 : WIT + (size_t)(dh * 64 + r - 64) * 1024) + k * 128 + c8;
            *(u32x4*)(Wg + r * 136 + c8) = *(const u32x4*)src;
        }
        if (tid0 < 64) hc[tid0] = 0.f;
    }
    float sp[4], br[4], bi[4];
#pragma unroll
    for (int ct = 0; ct < 4; ++ct) { const int chd = k * 128 + dh * 64 + ct * 16 + (tid0 & 15); sp[ct] = softplus(-P.in[18][chd]); br[ct] = P.in[15][chd]; bi[ct] = P.in[17][chd]; }
    const int ch0 = k * 128 + (tid0 & 31) * 4;
    float cw[4][4], cbias[4];
#pragma unroll
    for (int kk = 0; kk < 4; ++kk)
#pragma unroll
        for (int e = 0; e < 4; ++e) cw[kk][e] = P.in[12][kk * 1024 + ch0 + e];
#pragma unroll
    for (int e = 0; e < 4; ++e) cbias[e] = P.in[13][ch0 + e];
    u32x2 raw[11];
#define RG_LOAD(tl_) do { const int tg_ = (tl_) * 128 + (tid0 >> 5) * 8; const unsigned vo_ = (unsigned)((b * 2048 + tg_) * N0 + ch0); \
        _Pragma("unroll") for (int j = 0; j < 11; ++j) raw[j] = (tg_ + j - 3 >= 0) ? *(const u32x2*)((U + (j - 3) * N0) + vo_) : (u32x2){0u, 0u}; } while (0)
    if (!SAMPLE) RG_LOAD(0);
    const int ntiles = SAMPLE ? 1 : 16;
    for (int tile = 0; tile < ntiles; ++tile) {
        const int row0 = SAMPLE ? MP : b * 2048 + tile * 128;
        lds_barrier();
        int zv = 0; asm volatile("" : "+v"(zv));
        const int tid = tid0 + zv, lane = tid & 63, quad = tid & 31, seg = tid >> 5;
        const int sd = tid & 63, sseg = wid, sch = k * 128 + dh * 64 + sd;
        bf16_t gt[16];
        if (!SAMPLE) {
            const unsigned goff = (unsigned)((row0 + sseg * 16) * N0 + 1024 + sch);
#pragma unroll
            for (int t = 0; t < 16; ++t) gt[t] = (U + t * N0)[goff];
        }
        if (SAMPLE) {
#pragma unroll
            for (int t = 0; t < 8; ++t) {
                const int bb = seg * 8 + t;
                const float* buf = P.in[5] + (size_t)bb * 3 * 1024 + ch0;
                const f32x4 p0 = *(const f32x4*)buf, p1 = *(const f32x4*)(buf + 1024), p2 = *(const f32x4*)(buf + 2048);
                float cur[4]; ld4bf(U + (size_t)(MP + bb) * N0 + ch0, cur);
                float y[4];
#pragma unroll
                for (int e = 0; e < 4; ++e) y[e] = cbias[e] + cw[0][e] * p0[e] + cw[1][e] * p1[e] + cw[2][e] * p2[e] + cw[3][e] * cur[e];
                *(u32x2*)(Xs + bb * 136 + quad * 4) = pack4v(y[0], y[1], y[2], y[3]);
            }
        } else {
#pragma unroll
            for (int j = 0; j < 8; ++j) {
                const float x0[4] = {bflo(raw[j].x), bfhi(raw[j].x), bflo(raw[j].y), bfhi(raw[j].y)};
                const float x1[4] = {bflo(raw[j + 1].x), bfhi(raw[j + 1].x), bflo(raw[j + 1].y), bfhi(raw[j + 1].y)};
                const float x2[4] = {bflo(raw[j + 2].x), bfhi(raw[j + 2].x), bflo(raw[j + 2].y), bfhi(raw[j + 2].y)};
                const float x3[4] = {bflo(raw[j + 3].x), bfhi(raw[j + 3].x), bflo(raw[j + 3].y), bfhi(raw[j + 3].y)};
                float y[4];
#pragma unroll
                for (int e = 0; e < 4; ++e) y[e] = cbias[e] + cw[0][e] * x0[e] + cw[1][e] * x1[e] + cw[2][e] * x2[e] + cw[3][e] * x3[e];
                *(u32x2*)(Xs + (seg * 8 + j) * 136 + quad * 4) = pack4v(y[0], y[1], y[2], y[3]);
            }
            if (tile + 1 < 16) RG_LOAD(tile + 1);
        }
        lds_barrier();
        {
            f32x4 acc[8];
#pragma unroll
            for (int i = 0; i < 8; ++i) acc[i] = (f32x4){0.f, 0.f, 0.f, 0.f};
#pragma unroll
            for (int ks = 0; ks < 4; ++ks) {
                const bf16x8 a = ldfrag16(Xs, 136, wid * 16, ks * 32, lane);
#pragma unroll
                for (int tl = 0; tl < 8; ++tl) acc[tl] = MFMA16(a, ldfrag16(Wg, 136, tl * 16, ks * 32, lane), acc[tl]);
            }
#pragma unroll
            for (int ct = 0; ct < 4; ++ct)
#pragma unroll
                for (int reg = 0; reg < 4; ++reg) {
                    const int t = wid * 16 + (lane >> 4) * 4 + reg, d = ct * 16 + (lane & 15);
                    const float r = sigm(acc[ct][reg] + br[ct]), gi = sigm(acc[4 + ct][reg] + bi[ct]);
                    const float a = __expf(-8.f * r * sp[ct]);
                    const float uu = __builtin_amdgcn_sqrtf(fmaxf(1.f - a * a, 0.f)) * gi * bf2f(Xs[t * 136 + dh * 64 + d]);
                    if (SAMPLE) {
                        const int chd = k * 128 + dh * 64 + d;
                        const float hn = a * P.in[4][(size_t)t * 1024 + chd] + uu;
                        P.out[O_AHS + (size_t)t * 1024 + chd] = hn;
                        const float gv = bf2f(U[(size_t)(MP + t) * N0 + 1024 + chd]);
                        MIX[(size_t)(MP + t) * 2048 + chd] = f2bf(hn * silu(gv));
                    } else { Aa[t * 64 + d] = a; Uu[t * 64 + d] = uu; }
                }
        }
        if (!SAMPLE) {
            lds_barrier();
            float av[16], uv[16], Ap = 1.f, Hp = 0.f;
#pragma unroll
            for (int t = 0; t < 16; ++t) { av[t] = Aa[(sseg * 16 + t) * 64 + sd]; uv[t] = Uu[(sseg * 16 + t) * 64 + sd]; Hp = av[t] * Hp + uv[t]; Ap *= av[t]; }
            segA[sseg * 64 + sd] = Ap; segH[sseg * 64 + sd] = Hp;
            lds_barrier();
            float hin = hc[sd];
            for (int s2 = 0; s2 < sseg; ++s2) hin = segA[s2 * 64 + sd] * hin + segH[s2 * 64 + sd];
            const unsigned moff = (unsigned)((row0 + sseg * 16) * 2048 + sch);
#pragma unroll
            for (int t = 0; t < 16; ++t) {
                hin = av[t] * hin + uv[t];
                (MIX + t * 2048)[moff] = f2bf(hin * silu(bf2f(gt[t])));
            }
            lds_barrier();
            if (sseg == 7) hc[sd] = hin;
        }
    }
#undef RG_LOAD
    if (!SAMPLE) { lds_barrier(); if (tid0 < 64) P.out[O_AHP + (size_t)b * 1024 + k * 128 + dh * 64 + tid0] = hc[tid0]; }
}
DI void phase_mix0(const Params& P, unsigned char* L) {
    const int tid = otid(), bid = blockIdx.x, G = gridDim.x;
    { const bf16_t* U = WSP(bf16_t, OFF_U);
      for (int i = bid * 512 + tid; i < 8 * 3 * 1024; i += G * 512) { const int c = i & 1023, j = (i >> 10) % 3, b = i / 3072; P.out[O_ACP + i] = bf2f(U[(size_t)(b * 2048 + 2045 + j) * N0 + c]); }
      for (int i = bid * 512 + tid; i < 8 * 3 * 1536; i += G * 512) { const int c = i % 1536, j = (i / 1536) % 3, b = i / 4608; P.out[O_BCP + i] = bf2f(U[(size_t)(b * 2048 + 2045 + j) * N0 + 3072 + c]); }
      for (int i = bid * 512 + tid; i < 128 * 3 * 1024; i += G * 512) { const int c = i & 1023, j = (i >> 10) % 3, b = i / 3072; P.out[O_ACS + i] = j < 2 ? P.in[5][(size_t)(b * 3 + j + 1) * 1024 + c] : bf2f(U[(size_t)(MP + b) * N0 + c]); }
      for (int i = bid * 512 + tid; i < 128 * 3 * 1536; i += G * 512) { const int c = i % 1536, j = (i / 1536) % 3, b = i / 4608; P.out[O_BCS + i] = j < 2 ? P.in[7][(size_t)(b * 3 + j + 1) * 1536 + c] : bf2f(U[(size_t)(MP + b) * N0 + 3072 + c]); } }
    if (bid < 128) rglru_item<false>(P, L, bid); else if (bid < 256) ssd_prompt_item(P, L, bid - 128);
    unsigned* ctr = WSP(unsigned, OFF_CTL);
    unsigned* bc = (unsigned*)(L + LDS_BYTES - 16);
    for (;;) {
        __syncthreads();
        if (tid == 0) bc[0] = atomicAdd(ctr, 1u);
        __syncthreads();
        const unsigned it = bc[0];
        if (it >= 16u + 512u) break;
        if (it < 16u) rglru_item<true>(P, L, (int)it); else ssd_sample_item4(P, L, (int)(it - 16u));
    }
}
DI void phase_norm0(const Params& P) {
    bf16_t* MIX = WSP(bf16_t, OFF_MIX); const float* SSB = WSP(float, OFF_SSB);
    for (int i = blockIdx.x * 512 + threadIdx.x; i < MV * 128; i += gridDim.x * 512) {
        const int row = i >> 7, c8 = (i & 127) * 8, g = c8 >> 9;
        const float sc = rsqrtf(SSB[(size_t)row * 2 + g] * (1.f / 512.f) + EPSF);
        uint4* p = (uint4*)(MIX + (size_t)row * 2048 + 1024 + c8); uint4 w = *p;
        w.x = pack2(bflo(w.x) * sc, bfhi(w.x) * sc); w.y = pack2(bflo(w.y) * sc, bfhi(w.y) * sc); w.z = pack2(bflo(w.z) * sc, bfhi(w.z) * sc); w.w = pack2(bflo(w.w) * sc, bfhi(w.w) * sc);
        *p = w;
    }
}

DI void hgrn_prompt_item(const Params& P, unsigned char* L, int item) {
    const int b = item >> 4, h = item & 15;
    const int tid = otid(), lane = tid & 63, wid = tid >> 6, hh = lane >> 5, l31 = lane & 31;
    bf16_t* Qs = (bf16_t*)L;
    bf16_t* Ks = Qs + 64 * 136;
    float* Of = (float*)L;
    bf16_t* KsT = Ks + 64 * 136;
    bf16_t* VsT = KsT + 128 * 72;
    bf16_t* SsT = VsT + 128 * 72;
    bf16_t* As = SsT + 128 * 136;
    float* Gseg = (float*)(As + 64 * 72);
    float* E1 = Gseg + 16 * 128; float* E2 = E1 + 128;
    const bf16_t* U = WSP(bf16_t, OFF_U); bf16_t* MIX = WSP(bf16_t, OFF_MIX);
    const int kq = tid & 31, ts = tid >> 5;
    float lb[4];
#pragma unroll
    for (int e = 0; e < 4; ++e) { const int ch = h * 128 + kq * 4 + e; lb[e] = sigm(P.in[27][2048 + ch] - P.in[27][ch]); }
    const int kb = (wid >> 1) * 32, vb0 = (wid & 1) * 64;
    f32x16 accS[2];
#pragma unroll
    for (int i = 0; i < 16; ++i) { accS[0][i] = 0.f; accS[1][i] = 0.f; }
    uint2 rq[4], rf[4], rv[4];
#define HG_LOAD(cc) do { _Pragma("unroll") for (int i = 0; i < 4; ++i) { const bf16_t* bp = U + (size_t)(b * 2048 + (cc) * 64 + ts * 4 + i) * INC + h * 128 + kq * 4; \
        rq[i] = *(const uint2*)bp; rf[i] = *(const uint2*)(bp + 2048); rv[i] = *(const uint2*)(bp + 4096); } } while (0)
    HG_LOAD(0);
    lds_barrier();
    for (int c = 0; c < 32; ++c) {
        u32x4 gpre0, gpre1;
        { const bf16_t* gp = U + (size_t)(b * 2048 + c * 64 + (tid >> 3)) * INC + 6144 + h * 128 + (tid & 7) * 16; gpre0 = *(const u32x4*)gp; gpre1 = *(const u32x4*)(gp + 8); }
        float kk[4][4], cs[4][4];
#pragma unroll
        for (int i = 0; i < 4; ++i) {
            const float fx[4] = {bflo(rf[i].x), bfhi(rf[i].x), bflo(rf[i].y), bfhi(rf[i].y)};
#pragma unroll
            for (int e = 0; e < 4; ++e) {
                const float sg = sigm(fx[e]); const float kv = (1.f - lb[e]) * (1.f - sg);
                kk[i][e] = kv; const float gl = __logf(1.f - kv);
                cs[i][e] = (i == 0 ? 0.f : cs[i - 1][e]) + gl;
            }
        }
        *(f32x4*)(Gseg + ts * 128 + kq * 4) = (f32x4){cs[3][0], cs[3][1], cs[3][2], cs[3][3]};
        lds_barrier();
        f32x4 off = {0.f, 0.f, 0.f, 0.f}, gmid = off, glast = off;
        {
            const int swid = __builtin_amdgcn_readfirstlane(tid >> 6);
            f32x4 pre = {0.f, 0.f, 0.f, 0.f};
#pragma unroll
            for (int s = 0; s < 16; ++s) {
                const f32x4 v = *(const f32x4*)(Gseg + s * 128 + kq * 4);
                if (s == 2 * swid) off = pre;
                if (s == 8) gmid = pre;
                pre += v;
            }
            glast = pre;
            if (ts & 1) off += *(const f32x4*)(Gseg + (ts - 1) * 128 + kq * 4);
        }
        {
            float qt[4][4], kt[4][4], vt[4][4];
#pragma unroll
            for (int i = 0; i < 4; ++i) {
                const float q[4] = {bflo(rq[i].x), bfhi(rq[i].x), bflo(rq[i].y), bfhi(rq[i].y)};
                vt[i][0] = bflo(rv[i].x); vt[i][1] = bfhi(rv[i].x); vt[i][2] = bflo(rv[i].y); vt[i][3] = bfhi(rv[i].y);
#pragma unroll
                for (int e = 0; e < 4; ++e) { const float Gv = off[e] + cs[i][e]; const float ex = __expf(Gv - gmid[e]); qt[i][e] = q[e] * 0.08838834764831845f * ex; kt[i][e] = kk[i][e] * frcp(ex); }
                *(uint2*)(Qs + (ts * 4 + i) * 136 + kq * 4) = pack4(qt[i][0], qt[i][1], qt[i][2], qt[i][3]);
                *(uint2*)(Ks + (ts * 4 + i) * 136 + kq * 4) = pack4(kt[i][0], kt[i][1], kt[i][2], kt[i][3]);
            }
#pragma unroll
            for (int e = 0; e < 4; ++e) {
                *(uint2*)(KsT + (kq * 4 + e) * 72 + ts * 4) = pack4(kt[0][e], kt[1][e], kt[2][e], kt[3][e]);
                *(uint2*)(VsT + (kq * 4 + e) * 72 + ts * 4) = pack4(vt[0][e], vt[1][e], vt[2][e], vt[3][e]);
            }
            if (ts == 0) {
#pragma unroll
                for (int e = 0; e < 4; ++e) { E1[kq * 4 + e] = __expf(gmid[e]); E2[kq * 4 + e] = __expf(glast[e] - gmid[e]); }
            }
        }
        if (c + 1 < 32) HG_LOAD(c + 1);
        lds_barrier();
#pragma unroll
        for (int j = 0; j < 2; ++j) {
#pragma unroll
            for (int reg = 0; reg < 16; ++reg) accS[j][reg] *= E1[kb + crow(reg, hh)];
            const int v = vb0 + j * 32 + l31;
#pragma unroll
            for (int rg = 0; rg < 4; ++rg) *(uint2*)(SsT + v * 136 + kb + 8 * rg + 4 * hh) = pack4(accS[j][4 * rg], accS[j][4 * rg + 1], accS[j][4 * rg + 2], accS[j][4 * rg + 3]);
        }
        if (wid < 4) {
            const int tb = (wid >> 1) * 32, sb = (wid & 1) * 32;
            f32x16 aa;
#pragma unroll
            for (int i = 0; i < 16; ++i) aa[i] = 0.f;
#pragma unroll
            for (int ks = 0; ks < 8; ++ks) aa = MFMA32(ldfrag(Qs, 136, tb, ks * 16, lane), ldfrag(Ks, 136, sb, ks * 16, lane), aa);
            const int s = sb + l31;
#pragma unroll
            for (int reg = 0; reg < 16; ++reg) { const int t = tb + crow(reg, hh); As[t * 72 + s] = f2bf(s <= t ? aa[reg] : 0.f); }
        }
        lds_barrier();
        const int tb2 = (wid >> 2) * 32, vb2 = (wid & 3) * 32;
        f32x16 o;
#pragma unroll
        for (int i = 0; i < 16; ++i) o[i] = 0.f;
#pragma unroll
        for (int ks = 0; ks < 8; ++ks) o = MFMA32(ldfrag(Qs, 136, tb2, ks * 16, lane), ldfrag(SsT, 136, vb2, ks * 16, lane), o);
#pragma unroll
        for (int ks = 0; ks < 4; ++ks) o = MFMA32(ldfrag(As, 72, tb2, ks * 16, lane), ldfrag(VsT, 72, vb2, ks * 16, lane), o);
#pragma unroll
        for (int j = 0; j < 2; ++j) {
#pragma unroll
            for (int ks = 0; ks < 4; ++ks) accS[j] = MFMA32(ldfrag(KsT, 72, kb, ks * 16, lane), ldfrag(VsT, 72, vb0 + j * 32, ks * 16, lane), accS[j]);
#pragma unroll
            for (int reg = 0; reg < 16; ++reg) accS[j][reg] *= E2[kb + crow(reg, hh)];
        }
        lds_barrier();
#pragma unroll
        for (int reg = 0; reg < 16; ++reg) Of[(tb2 + crow(reg, hh)) * 132 + vb2 + l31] = o[reg];
        lds_barrier();
        {
            const int t = tid >> 3, vs = tid & 7;
            const size_t row = (size_t)(b * 2048 + c * 64 + t);
            f32x4 ov[4]; float ss = 0.f;
#pragma unroll
            for (int i = 0; i < 4; ++i) { ov[i] = *(const f32x4*)(Of + t * 132 + vs * 16 + i * 4); ss += ov[i][0] * ov[i][0] + ov[i][1] * ov[i][1] + ov[i][2] * ov[i][2] + ov[i][3] * ov[i][3]; }
            ss += __shfl_xor(ss, 1); ss += __shfl_xor(ss, 2); ss += __shfl_xor(ss, 4);
            const float rstd = rsqrtf(ss * (1.f / 128.f) + EPSF);
            const float* nwp = P.in[28] + h * 128 + vs * 16;
            const unsigned gw[8] = {gpre0.x, gpre0.y, gpre0.z, gpre0.w, gpre1.x, gpre1.y, gpre1.z, gpre1.w};
            unsigned ow[8];
#pragma unroll
            for (int i = 0; i < 4; ++i) {
                const f32x4 w = *(const f32x4*)(nwp + i * 4);
                ow[2 * i] = pack2(ov[i][0] * rstd * w[0] * silu(bflo(gw[2 * i])), ov[i][1] * rstd * w[1] * silu(bfhi(gw[2 * i])));
                ow[2 * i + 1] = pack2(ov[i][2] * rstd * w[2] * silu(bflo(gw[2 * i + 1])), ov[i][3] * rstd * w[3] * silu(bfhi(gw[2 * i + 1])));
            }
            bf16_t* op = MIX + row * 2048 + h * 128 + vs * 16;
            *(uint4*)op = make_uint4(ow[0], ow[1], ow[2], ow[3]); *(uint4*)(op + 8) = make_uint4(ow[4], ow[5], ow[6], ow[7]);
        }
        lds_barrier();
    }
#undef HG_LOAD
    float* so = P.out + O_CP + (size_t)(b * 16 + h) * 128 * 128;
#pragma unroll
    for (int j = 0; j < 2; ++j)
#pragma unroll
        for (int reg = 0; reg < 16; ++reg) so[(kb + crow(reg, hh)) * 128 + vb0 + j * 32 + l31] = accS[j][reg];
}
DI void hgrn_sample_item(const Params& P, unsigned char* L, int item) {
    const int b = item >> 4, h = item & 15, tid = otid(), lane = tid & 63;
    float* qv = (float*)L; float* egv = qv + 128; float* kkv = egv + 128; float* vv = kkv + 128; float* part = vv + 128; float* red = part + 16 * 128;
    const bf16_t* U = WSP(bf16_t, OFF_U); bf16_t* MIX = WSP(bf16_t, OFF_MIX);
    const size_t row = (size_t)(MP + b); const bf16_t* ub = U + row * INC + h * 128;
    __syncthreads();
    if (tid < 128) {
        const int ch = h * 128 + tid;
        const float lbv = sigm(P.in[27][2048 + ch] - P.in[27][ch]);
        const float sg = sigm(bf2f(ub[2048 + tid])); const float kv = (1.f - lbv) * (1.f - sg);
        qv[tid] = bf2f(ub[tid]) * 0.08838834764831845f; egv[tid] = 1.f - kv; kkv[tid] = kv;
    } else if (tid < 256) vv[tid - 128] = bf2f(ub[4096 + tid - 128]);
    __syncthreads();
    const float* s0 = P.in[8] + (size_t)(b * 16 + h) * 128 * 128; float* s1 = P.out + O_CS + (size_t)(b * 16 + h) * 128 * 128;
    const int v4 = (tid & 31) * 4; const f32x4 vq = *(const f32x4*)(vv + v4);
    f32x4 op = {0.f, 0.f, 0.f, 0.f};
#pragma unroll
    for (int j = 0; j < 8; ++j) {
        const int k = (tid >> 5) + 16 * j;
        const f32x4 s = *(const f32x4*)(s0 + k * 128 + v4);
        const f32x4 sn = s * egv[k] + vq * kkv[k];
        *(f32x4*)(s1 + k * 128 + v4) = sn;
        op += sn * qv[k];
    }
    *(f32x4*)(part + (tid >> 5) * 128 + v4) = op;
    __syncthreads();
    float o = 0.f;
    if (tid < 128) {
#pragma unroll
        for (int i = 0; i < 16; ++i) o += part[i * 128 + tid];
        const float ss = wave_sum(o * o);
        if (lane == 0) red[tid >> 6] = ss;
    }
    __syncthreads();
    if (tid < 128) {
        const float rstd = rsqrtf((red[0] + red[1]) * (1.f / 128.f) + EPSF);
        const int ch = h * 128 + tid;
        MIX[row * 2048 + ch] = f2bf(o * rstd * P.in[28][ch] * silu(bf2f(ub[6144 + tid])));
    }
}
DI void phase_mix1(const Params& P, unsigned char* L) {
    const int tid = otid(), bid = blockIdx.x;
    if (bid < 128) hgrn_prompt_item(P, L, bid);
    else { const int nb = gridDim.x - 128; for (int it = bid - 128; it < 2048; it += nb) hgrn_sample_item(P, L, it); }
}
DI void phase_final(const Params& P) {
    const int lane = threadIdx.x & 63, gw = blockIdx.x * 8 + (threadIdx.x >> 6), nwv = gridDim.x * 8;
    const float* H = WSP(float, OFF_H); const float* SS = WSP(float, OFF_SS2); const float* nf = P.in[10];
    f32x4 w4[4];
#pragma unroll
    for (int i = 0; i < 4; ++i) w4[i] = *(const f32x4*)(nf + lane * 4 + 256 * i);
    for (int r = gw; r < MV; r += nwv) {
        const float rstd = rsqrtf(SS[r] * (1.f / 1024.f) + EPSF);
#pragma unroll
        for (int i = 0; i < 4; ++i) { const f32x4 v = *(const f32x4*)(H + (size_t)r * 1024 + lane * 4 + 256 * i); *(f32x4*)(P.out + O_Y + (size_t)r * 1024 + lane * 4 + 256 * i) = v * rstd * w4[i]; }
    }
}

#define XB_TMO      128
#define XB_XCNT(j)  (256  + 64 * (j))
#define XB_XSUB(j)  (1280 + 64 * (j))
#define XB_XGEN(j)  (2304 + 64 * (j))
#define XB_TOP      3328
#define XB_TOPGEN   3392
#define XCD_BAR_WORDS 3456
#define XB_SPIN_CAP (1u << 18)

__device__ __forceinline__ unsigned xb_ld(unsigned* p)              { return __hip_atomic_load(p, __ATOMIC_RELAXED, __HIP_MEMORY_SCOPE_AGENT); }
__device__ __forceinline__ unsigned xb_add(unsigned* p, unsigned v) { return __hip_atomic_fetch_add(p, v, __ATOMIC_RELAXED, __HIP_MEMORY_SCOPE_AGENT); }
__device__ __forceinline__ unsigned xb_xcc_id() { return (unsigned)__builtin_amdgcn_s_getreg((3 << 11) | 20) & 0xFu; }
#define XB_SPIN(cond, bar) do { unsigned _sp = 0; while (cond) { __builtin_amdgcn_s_sleep(1); \
    if ((++_sp & 255u) == 0u) { if (xb_ld(&(bar)[XB_TMO])) break; if (_sp > XB_SPIN_CAP) { atomicAdd(&(bar)[XB_TMO], 1u); break; } } } } while (0)

struct XcdBarrier {
    unsigned* bar; unsigned x;
    volatile LAS unsigned* st;
};

__device__ __forceinline__ XcdBarrier xcd_barrier_post(unsigned* bar, volatile LAS unsigned* st) {
    XcdBarrier b; b.bar = bar; b.x = xb_xcc_id(); b.st = st;
    if (threadIdx.x == 0) (void)xb_add(&bar[XB_XCNT(b.x)], 1u);
    return b;
}
__device__ __forceinline__ void xcd_barrier_complete(unsigned* bar, unsigned x, unsigned& nloc, unsigned& nx) {
    const unsigned G = gridDim.x * gridDim.y * gridDim.z;
    unsigned sum, cnt, mine, sp = 0u;
    for (;;) {
        sum = 0u; cnt = 0u; mine = 0u;
#pragma unroll
        for (unsigned j = 0; j < 16; ++j) { const unsigned c = xb_ld(&bar[XB_XCNT(j)]); sum += c; cnt += (c > 0u) ? 1u : 0u; mine = (j == x) ? c : mine; }
        if (sum == G) break;
        __builtin_amdgcn_s_sleep(1);
        if ((++sp & 255u) == 0u) { if (xb_ld(&bar[XB_TMO])) break; if (sp > XB_SPIN_CAP) { atomicAdd(&bar[XB_TMO], 1u); break; } }
    }
    nloc = mine > 0u ? mine : 1u; nx = cnt > 0u ? cnt : 1u;
}

__device__ __forceinline__ void xcd_barrier(const XcdBarrier& b) {
    asm volatile("s_waitcnt vmcnt(0)" ::: "memory");
    __syncthreads();
    if (threadIdx.x == 0) {
        unsigned* bar = b.bar;
        __builtin_amdgcn_s_waitcnt(0);
        unsigned nloc = b.st[0], nx = b.st[1];
        if (nloc == 0u) { xcd_barrier_complete(bar, b.x, nloc, nx); b.st[0] = nloc; b.st[1] = nx; }
        const unsigned old = xb_add(&bar[XB_XSUB(b.x)], 1u);
        const unsigned gen = old / nloc;
        if (old + 1u == (gen + 1u) * nloc) {
            __builtin_amdgcn_fence(__ATOMIC_RELEASE, "agent");
            asm volatile("s_waitcnt vmcnt(0)" ::: "memory");
            const unsigned og = xb_add(&bar[XB_TOP], 1u);
            const unsigned tg = og / nx;
            if (og + 1u == (tg + 1u) * nx) xb_add(&bar[XB_TOPGEN], 1u);
            else XB_SPIN(xb_ld(&bar[XB_TOPGEN]) == tg, bar);
            __builtin_amdgcn_fence(__ATOMIC_ACQUIRE, "agent");
            xb_add(&bar[XB_XGEN(b.x)], 1u);
            asm volatile("s_waitcnt vmcnt(0)" ::: "memory");
        } else {
            XB_SPIN(xb_ld(&bar[XB_XGEN(b.x)]) == gen, bar);
            __builtin_amdgcn_fence(__ATOMIC_ACQUIRE, "agent");
            asm volatile("s_waitcnt vmcnt(0)" ::: "memory");
        }
    }
    __syncthreads();
}


#ifndef PHM
#define PHM 0xFFFF
#endif
typedef const __attribute__((address_space(4))) Params* ParamsK;
DI Params getp() {
    ParamsK pp = (ParamsK)__builtin_amdgcn_kernarg_segment_ptr(); asm volatile("" : "+s"(pp));
    Params P;
#pragma unroll
    for (int i = 0; i < 32; ++i) P.in[i] = pp->in[i];
    P.out = pp->out; P.ws = pp->ws; return P;
}
#define GETP() const Params P = getp()
__global__ void __launch_bounds__(512, 2) fwd_kernel(Params Parg) {
    extern __shared__ __attribute__((aligned(16))) unsigned char lds[];
    cg::grid_group grid = cg::this_grid();
    unsigned char* L = (unsigned char*)lds;
    LAS unsigned char* LL = (LAS unsigned char*)lds;
    volatile LAS unsigned* xst = (volatile LAS unsigned*)(LL + LDS_BYTES - 32);
    if (threadIdx.x < 2) xst[threadIdx.x] = 0u;
    __syncthreads();
    XcdBarrier xb;
    { GETP(); xb = xcd_barrier_post(WSP(unsigned, OFF_BAR), xst); }
    if (PHM & 1) { GETP(); phase_prep(P, L); }
    if (gridDim.y == 0xFFFFu) grid.sync();
    xcd_barrier(xb);
    if (PHM & 2) { GETP(); pg8::StaticOrder S; S.init(MP, N0 + 256, gridDim.x, blockIdx.x); pg8::Gemm g{WSP(bf16_t, OFF_XN), WSP(bf16_t, OFF_W0T), MP, N0 + 256, 1024};
      EpiStoreBf16 E{WSP(bf16_t, OFF_U), N0, nullptr, WSP(float, OFF_DT)}; pg8::gemm_phase(LL, g, S, E); }
    { GETP(); SfU f{WSP(bf16_t, OFF_U), N0, nullptr, WSP(float, OFF_DT)}; sgemm<4>(WSP(bf16_t, OFF_XN), WSP(bf16_t, OFF_W0T), 1024, 145, 64 * 19, f, L); }
    xcd_barrier(xb);
    { GETP(); phase_convbc(P); }
    xcd_barrier(xb);
    if (PHM & 4) { GETP(); phase_mix0(P, L); }
    xcd_barrier(xb);
    { GETP(); phase_norm0(P); }
    xcd_barrier(xb);
    { GETP(); convert_p(P, 0); }
    __syncthreads();
    if (PHM & 8) { GETP(); pg8::StaticOrder S; S.init(MP, 1024, gridDim.x, blockIdx.x); pg8::Gemm g{WSP(bf16_t, OFF_MIX), WSP(bf16_t, OFF_WO0T), MP, 1024, 2048};
      EpiResid E{P.in[0], P.in[1], WSP(float, OFF_H), WSP(bf16_t, OFF_HB)}; pg8::gemm_phase(LL, g, S, E); }
    { GETP(); SfResid f{P.in[1], WSP(float, OFF_H), WSP(bf16_t, OFF_HB)}; sgemm<4>(WSP(bf16_t, OFF_MIX), WSP(bf16_t, OFF_WO0T), 2048, 32, 256, f, L); }
    xcd_barrier(xb);
    if (PHM & 16) { GETP(); pg8::StaticOrder S; S.init(MP, 1024, gridDim.x, blockIdx.x);
      pg8::Gemm g1{WSP(bf16_t, OFF_HB), WSP(bf16_t, OFF_WG0T), MP, 1024, 1024}; EpiGate E1{WSP(float, OFF_MIX)}; pg8::gemm_phase(LL, g1, S, E1); }
    { GETP(); SfGate f{WSP(float, OFF_MIX)};   sgemm<2>(WSP(bf16_t, OFF_HB), WSP(bf16_t, OFF_WG0T), 1024, 32, 256, f, L); }
    if (PHM & 16) { GETP(); pg8::StaticOrder S; S.init(MP, 1024, gridDim.x, blockIdx.x);
      pg8::Gemm g2{WSP(bf16_t, OFF_PB), WSP(bf16_t, OFF_WP0T), MP, 1024, 256};
      EpiPle E2{WSP(float, OFF_H), WSP(float, OFF_MIX), WSP(bf16_t, OFF_XN), P.in[9] + 1024, WSP(float, OFF_SS1)}; pg8::gemm_phase(LL, g2, S, E2); }
    { GETP(); SfPle f{WSP(float, OFF_H), WSP(float, OFF_MIX), WSP(bf16_t, OFF_XN), P.in[9] + 1024, WSP(float, OFF_SS1)}; sgemm<2>(WSP(bf16_t, OFF_PB), WSP(bf16_t, OFF_WP0T), 256, 32, 256, f, L); }
    xcd_barrier(xb);
    if (PHM & 32) { GETP(); pg8::StaticOrder S; S.init(MP, INC, gridDim.x, blockIdx.x); pg8::Gemm g{WSP(bf16_t, OFF_XN), WSP(bf16_t, OFF_W1T), MP, INC, 1024};
      EpiStoreBf16 E{WSP(bf16_t, OFF_U), INC, WSP(float, OFF_SS1), nullptr}; pg8::gemm_phase(LL, g, S, E); }
    { GETP(); SfU f{WSP(bf16_t, OFF_U), INC, WSP(float, OFF_SS1), nullptr}; sgemm<4>(WSP(bf16_t, OFF_XN), WSP(bf16_t, OFF_W1T), 1024, 256, 64 * 32, f, L); }
    xcd_barrier(xb);
    if (PHM & 64) { GETP(); phase_mix1(P, L); }
    xcd_barrier(xb);
    { GETP(); convert_p(P, 1); }
    __syncthreads();
    if (PHM & 128) { GETP(); pg8::StaticOrder S; S.init(MP, 1024, gridDim.x, blockIdx.x); pg8::Gemm g{WSP(bf16_t, OFF_MIX), WSP(bf16_t, OFF_WO1T), MP, 1024, 2048};
      EpiResid E{WSP(float, OFF_H), WSP(float, OFF_H) + (size_t)MP * 1024, WSP(float, OFF_H), WSP(bf16_t, OFF_HB)}; pg8::gemm_phase(LL, g, S, E); }
    { GETP(); SfResid f{WSP(float, OFF_H) + (size_t)MP * 1024, WSP(float, OFF_H), WSP(bf16_t, OFF_HB)}; sgemm<4>(WSP(bf16_t, OFF_MIX), WSP(bf16_t, OFF_WO1T), 2048, 32, 256, f, L); }
    xcd_barrier(xb);
    if (PHM & 256) { GETP(); pg8::StaticOrder S; S.init(MP, 1024, gridDim.x, blockIdx.x);
      pg8::Gemm g1{WSP(bf16_t, OFF_HB), WSP(bf16_t, OFF_WG1T), MP, 1024, 1024}; EpiGate E1{WSP(float, OFF_MIX)}; pg8::gemm_phase(LL, g1, S, E1); }
    { GETP(); SfGate f{WSP(float, OFF_MIX)};   sgemm<2>(WSP(bf16_t, OFF_HB), WSP(bf16_t, OFF_WG1T), 1024, 32, 256, f, L); }
    if (PHM & 256) { GETP(); pg8::StaticOrder S; S.init(MP, 1024, gridDim.x, blockIdx.x);
      pg8::Gemm g2{WSP(bf16_t, OFF_PB), WSP(bf16_t, OFF_WP1T), MP, 1024, 256};
      EpiPle E2{WSP(float, OFF_H), WSP(float, OFF_MIX), nullptr, nullptr, WSP(float, OFF_SS2)}; pg8::gemm_phase(LL, g2, S, E2); }
    { GETP(); SfPle f{WSP(float, OFF_H), WSP(float, OFF_MIX), nullptr, nullptr, WSP(float, OFF_SS2)}; sgemm<2>(WSP(bf16_t, OFF_PB), WSP(bf16_t, OFF_WP1T), 256, 32, 256, f, L); }
    xcd_barrier(xb);
    { GETP(); phase_final(P); }
}

extern "C" void kernel_launch(void* const* d_in, const int* in_sizes, int n_in, void* d_out, int out_size, void* d_ws, size_t ws_size, hipStream_t stream) {
    static int grid = 0;
    if (grid == 0) {
        if (n_in != 32 || ws_size < WS_END) { fprintf(stderr, "kernel_launch: need 32 inputs and %zu bytes of workspace (got %d, %zu)\n", (size_t)WS_END, n_in, ws_size); grid = -1; return; }
        int dev = 0, cus = 0, per_cu = 0;
        (void)hipGetDevice(&dev); (void)hipDeviceGetAttribute(&cus, hipDeviceAttributeMultiprocessorCount, dev);
        if (hipFuncSetAttribute((const void*)fwd_kernel, hipFuncAttributeMaxDynamicSharedMemorySize, LDS_BYTES) != hipSuccess) { fprintf(stderr, "kernel_launch: hipFuncSetAttribute failed\n"); grid = -1; return; }
        if (hipOccupancyMaxActiveBlocksPerMultiprocessor(&per_cu, (const void*)fwd_kernel, 512, LDS_BYTES) != hipSuccess || per_cu < 1) { fprintf(stderr, "kernel_launch: occupancy query says %d\n", per_cu); per_cu = 1; }
        (void)hipGetLastError();
        grid = cus;
    }
    if (grid < 0) return;
    Params p{};
    for (int i = 0; i < 32; ++i) p.in[i] = (const float*)d_in[i];
    p.out = (float*)d_out; p.ws = (unsigned char*)d_ws;
    if (hipMemsetAsync((char*)d_ws + OFF_BAR, 0, 16384, stream) != hipSuccess) { fprintf(stderr, "kernel_launch: memset of barrier words failed\n"); return; }
    void* args[] = {&p};
    hipError_t e = hipLaunchCooperativeKernel((const void*)fwd_kernel, dim3(grid), dim3(512), args, LDS_BYTES, stream);
    if (e != hipSuccess) fprintf(stderr, "cooperative launch failed: %s (grid %d)\n", hipGetErrorString(e), grid);
}
```

```cpp
#include <hip/hip_runtime.h>
#include <hip/hip_cooperative_groups.h>
#include <cstdio>
namespace cg = cooperative_groups;

#define LAS __attribute__((address_space(3)))
#define DI __device__ __forceinline__
typedef unsigned short bf16_t;
typedef short bf16x8 __attribute__((ext_vector_type(8)));
typedef float f32x4 __attribute__((ext_vector_type(4)));
typedef float f32x16 __attribute__((ext_vector_type(16)));

constexpr int MP = 16384, MS = 128, MV = MP + MS, MPAD = 16640;
constexpr int DM = 1024, INAB = 4624, N0 = 4608, INC = 8192;
constexpr float EPSF = 1e-6f;
constexpr size_t O_Y = 0, O_AHP = 16908288, O_ACP = 16916480, O_BSP = 16941056, O_BCP = 17989632, O_CP = 18026496,
                 O_AHS = 20123648, O_ACS = 20254720, O_BSS = 20647936, O_BCS = 37425152, O_CS = 38014976;
constexpr size_t al256(size_t x) { return (x + 255) & ~size_t(255); }
constexpr size_t OFF_CTL = 0;
constexpr size_t OFF_BAR = 256;
constexpr size_t OFF_SS1 = 256 + 16384;
constexpr size_t OFF_SS2 = OFF_SS1 + al256((size_t)MPAD * 4);
constexpr size_t OFF_SSB = OFF_SS2 + al256((size_t)MPAD * 4);
constexpr size_t OFF_DT  = OFF_SSB + al256((size_t)MPAD * 8);
constexpr size_t OFF_W0T = OFF_DT + al256((size_t)MV * 16 * 4);
constexpr size_t OFF_WO0T = OFF_W0T + (size_t)(N0 + 256) * 1024 * 2;
constexpr size_t OFF_WG0T = OFF_WO0T + (size_t)1024 * 2048 * 2;
constexpr size_t OFF_WP0T = OFF_WG0T + (size_t)1024 * 1024 * 2;
constexpr size_t OFF_W1T  = OFF_WP0T + (size_t)1024 * 256 * 2;
constexpr size_t OFF_WO1T = OFF_W1T + (size_t)INC * 1024 * 2;
constexpr size_t OFF_WG1T = OFF_WO1T + (size_t)1024 * 2048 * 2;
constexpr size_t OFF_WP1T = OFF_WG1T + (size_t)1024 * 1024 * 2;
constexpr size_t OFF_WRT  = OFF_WP1T + (size_t)1024 * 256 * 2;
constexpr size_t OFF_WIT  = OFF_WRT + (size_t)128 * 1024 * 2;
constexpr size_t OFF_XN   = OFF_WIT + (size_t)128 * 1024 * 2;
constexpr size_t OFF_MIX  = OFF_XN + (size_t)MPAD * 1024 * 2;
constexpr size_t OFF_H    = OFF_MIX + (size_t)MPAD * 2048 * 2;
constexpr size_t OFF_U    = OFF_H + al256((size_t)MV * 1024 * 4);
constexpr size_t OFF_HB   = OFF_U;
constexpr size_t OFF_PB   = OFF_U + al256((size_t)MV * INC * 2);
constexpr size_t PB_STRIDE = (size_t)MPAD * 256 * 2;
constexpr size_t WS_END   = OFF_PB + 2 * PB_STRIDE;
constexpr int LDS_BYTES = 144 * 1024;

struct Params { const float* in[32]; float* out; unsigned char* ws; };
#define WSP(T, off) ((T*)(P.ws + (off)))

typedef __bf16 bf16v2_t __attribute__((ext_vector_type(2)));
typedef float f32v2_t __attribute__((ext_vector_type(2)));
DI unsigned pack2(float lo, float hi) { f32v2_t v = {lo, hi}; bf16v2_t b = __builtin_convertvector(v, bf16v2_t); return __builtin_bit_cast(unsigned, b); }
DI bf16_t f2bf(float f) { return __builtin_bit_cast(bf16_t, (__bf16)f); }
DI float bf2f(bf16_t b) { return __uint_as_float(((unsigned)b) << 16); }
DI float bflo(unsigned w) { return __uint_as_float(w << 16); }
DI float bfhi(unsigned w) { return __uint_as_float(w & 0xFFFF0000u); }
DI float frcp(float x) { return __builtin_amdgcn_rcpf(x); }
DI float sigm(float x) { return frcp(1.f + __expf(-x)); }
DI float silu(float x) { return x * frcp(1.f + __expf(-x)); }
DI float softplus(float x) { return x > 20.f ? x : log1pf(__expf(x)); }
DI float wave_sum(float v) { for (int o = 32; o > 0; o >>= 1) v += __shfl_xor(v, o); return v; }
DI int otid() { int t = threadIdx.x; asm volatile("" : "+v"(t)); return t; }
DI void lds_barrier() { asm volatile("s_waitcnt lgkmcnt(0)" ::: "memory"); __builtin_amdgcn_s_barrier(); asm volatile("" ::: "memory"); }
DI int crow(int reg, int hh) { return (reg & 3) + 8 * (reg >> 2) + 4 * hh; }
DI void ld4bf(const bf16_t* p, float (&o)[4]) { uint2 w = *(const uint2*)p; o[0] = bflo(w.x); o[1] = bfhi(w.x); o[2] = bflo(w.y); o[3] = bfhi(w.y); }
typedef unsigned u32x2 __attribute__((ext_vector_type(2)));
typedef unsigned u32x4 __attribute__((ext_vector_type(4)));
DI u32x2 pack4v(float a, float b, float c, float d) { u32x2 r; r.x = pack2(a, b); r.y = pack2(c, d); return r; }
DI uint2 pack4(float a, float b, float c, float d) { uint2 r; r.x = pack2(a, b); r.y = pack2(c, d); return r; }
#define MFMA32(a, b, c) __builtin_amdgcn_mfma_f32_32x32x16_bf16((a), (b), (c), 0, 0, 0)
#define MFMA16(a, b, c) __builtin_amdgcn_mfma_f32_16x16x32_bf16((a), (b), (c), 0, 0, 0)
DI bf16x8 ldfrag(const bf16_t* base, int ld, int row0, int k0, int lane) { return *(const bf16x8*)(base + (row0 + (lane & 31)) * ld + k0 + 8 * (lane >> 5)); }
DI bf16x8 ldfrag16(const bf16_t* base, int ld, int row0, int k0, int lane) { return *(const bf16x8*)(base + (row0 + (lane & 15)) * ld + k0 + 8 * (lane >> 4)); }

namespace pg8 {
constexpr int BM = 256, BK = 64, HALF = 128, HTB = HALF * BK * 2, STAGE_BYTES = 8 * HTB, NXCD = 8, WGM = 8;
DI int lds_byte(int r, int c) { const int st = (r >> 4) * 2 + (c >> 5), rr = r & 15, cc = c & 31, ob = rr * 64 + cc * 2; return st * 1024 + (ob ^ (((ob >> 9) & 1) << 5)); }
DI void stage_rc(int b, int& R, int& C) { const int st = b / 1024, sb = b % 1024, swz = sb ^ (((sb >> 9) & 1) << 5); R = (st >> 1) * 16 + swz / 64; C = (st & 1) * 32 + (swz % 64) / 2; }
DI int perm32(int rho) { const int n = rho >> 4, i = rho & 15; return 8 * (i >> 2) + 4 * n + (i & 3); }
struct Unit { int pm, pn; };
struct Gemm { const bf16_t* A; const bf16_t* Bt; int M, N, K; };
struct StaticOrder {
    int nM, nN, nwg, G, c;
    DI void init(int M, int N, int G_, int c_) { nM = M / BM; nN = N / BM; nwg = nM * nN; G = G_; c = c_; }
    DI bool next(int i, Unit& u) const {
        const long L = (long)i * G + c; if (L >= nwg) return false;
        int wgid = (int)L; { const int q = nwg / NXCD, r = nwg % NXCD, xcd = wgid % NXCD, off = wgid / NXCD; wgid = (xcd < r ? xcd * (q + 1) : r * (q + 1) + (xcd - r) * q) + off; }
        const int nig = WGM * nN, gid = wgid / nig, fm = gid * WGM, gsz = (nM - fm) < WGM ? (nM - fm) : WGM;
        u.pm = fm + ((wgid % nig) % gsz); u.pn = (wgid % nig) / gsz; return true;
    }
};

template <class Epi>
DI void gemm_phase(LAS unsigned char* lds, const Gemm g, const StaticOrder& S, const Epi& E) {
    const int tid = otid(), wid = __builtin_amdgcn_readfirstlane(tid >> 6), lane = tid & 63, wr = wid >> 2, wc = wid & 3, fr = lane & 15, fq = lane >> 4;
    const int K = g.K, nt = K / BK;
    unsigned voffA[2], voffB[2];
#pragma unroll
    for (int i = 0; i < 2; ++i) { int R, C; stage_rc(tid * 16 + i * 8192, R, C); const int Rb = Epi::PERM ? ((R & ~31) + perm32(R & 31)) : R;
        voffA[i] = (unsigned)(R * K + C) * 2u; voffB[i] = (unsigned)(Rb * K + C) * 2u; }
    const size_t kstep = (size_t)(BK * 2);
    const size_t hstep = (size_t)HALF * K * 2;
    const size_t tstep = 2 * hstep;
    const unsigned ldsw = (unsigned)wid * 1024u;
    const int aoff = lds_byte(wr * 64 + fr, fq * 8), boff = lds_byte(wc * 32 + fr, fq * 8);
#define PG8_SA(b, h) (((b) * 2 + (h)) * HTB)
#define PG8_SB(b, h) ((4 + (b) * 2 + (h)) * HTB)
#define PG8_STAGE(bufoff, gbase, voff) do { _Pragma("unroll") for (int _i = 0; _i < 2; ++_i) \
        __builtin_amdgcn_global_load_lds((const unsigned*)((const char*)(gbase) + (voff)[_i]), (LAS unsigned*)(lds + (bufoff) + ldsw + _i * 8192), 16, 0, 0); } while (0)
#define PG8_LDA(dst, b, h) do { _Pragma("unroll") for (int m = 0; m < 4; ++m) _Pragma("unroll") for (int k = 0; k < 2; ++k) dst[m][k] = *(const LAS bf16x8*)(lds + PG8_SA(b, h) + aoff + m * 2048 + k * 1024); } while (0)
#define PG8_LDB(dst, b, h) do { _Pragma("unroll") for (int n = 0; n < 2; ++n) _Pragma("unroll") for (int k = 0; k < 2; ++k) dst[n][k] = *(const LAS bf16x8*)(lds + PG8_SB(b, h) + boff + n * 2048 + k * 1024); } while (0)
#define PG8_MMA(ai, bj, At, Bt) do { __builtin_amdgcn_s_setprio(1); _Pragma("unroll") for (int m = 0; m < 4; ++m) _Pragma("unroll") for (int n = 0; n < 2; ++n) _Pragma("unroll") for (int k = 0; k < 2; ++k) \
        acc[ai][bj][m][n] = __builtin_amdgcn_mfma_f32_16x16x32_bf16(Bt[n][k], At[m][k], acc[ai][bj][m][n], 0, 0, 0); __builtin_amdgcn_s_setprio(0); } while (0)
#define PG8_WAIT_V(n) asm volatile("s_waitcnt vmcnt(" #n ")" ::: "memory")
#define PG8_WAIT_L(n) asm volatile("s_waitcnt lgkmcnt(" #n ")" ::: "memory")
#define PG8_BAR __builtin_amdgcn_s_barrier()
#define PG8_SCHED __builtin_amdgcn_sched_barrier(0)
    Unit cur, nxt; int ui = 0;
    if (!S.next(0, cur)) return;
    f32x4 acc[2][2][4][2];
#pragma unroll
    for (int a = 0; a < 2; ++a)
#pragma unroll
        for (int b = 0; b < 2; ++b)
#pragma unroll
            for (int m = 0; m < 4; ++m)
#pragma unroll
                for (int n = 0; n < 2; ++n) acc[a][b][m][n] = (f32x4){0.f, 0.f, 0.f, 0.f};
    bf16x8 At[4][2], B0[2][2], B1[2][2];
    const char* cA = (const char*)g.A + (size_t)cur.pm * tstep; const char* cB = (const char*)g.Bt + (size_t)cur.pn * tstep;
    PG8_STAGE(PG8_SB(0, 0), cB, voffB); PG8_STAGE(PG8_SA(0, 0), cA, voffA); PG8_STAGE(PG8_SB(0, 1), cB + hstep, voffB); PG8_STAGE(PG8_SA(0, 1), cA + hstep, voffA);
    if (wr == 1) PG8_BAR;
    PG8_WAIT_V(4); PG8_BAR;
    PG8_STAGE(PG8_SB(1, 0), cB + kstep, voffB); PG8_STAGE(PG8_SA(1, 0), cA + kstep, voffA); PG8_STAGE(PG8_SB(1, 1), cB + hstep + kstep, voffB);
    PG8_WAIT_V(6); PG8_BAR;
    for (;;) {
        const bool has_next = S.next(ui + 1, nxt);
        const char* nA = has_next ? (const char*)g.A + (size_t)nxt.pm * tstep : cA; const char* nB = has_next ? (const char*)g.Bt + (size_t)nxt.pn * tstep : cB;
        for (int t = 0; t < nt; t += 2) {
            const bool last = (t == nt - 2);
            const char* a1 = cA + (size_t)(t + 1) * kstep;
            const char* a2 = last ? nA : cA + (size_t)(t + 2) * kstep; const char* b2 = last ? nB : cB + (size_t)(t + 2) * kstep;
            const char* a3 = a2 + kstep; const char* b3 = b2 + kstep;
            PG8_LDB(B0, 0, 0); PG8_SCHED; PG8_LDA(At, 0, 0); PG8_STAGE(PG8_SA(1, 1), a1 + hstep, voffA);
            PG8_WAIT_L(8); PG8_BAR; PG8_WAIT_L(0); PG8_MMA(0, 0, At, B0); PG8_BAR; PG8_SCHED;
            PG8_LDB(B1, 0, 1); PG8_STAGE(PG8_SB(0, 0), b2, voffB);
            PG8_BAR; PG8_WAIT_L(0); PG8_MMA(0, 1, At, B1); PG8_BAR;
            PG8_LDA(At, 0, 1); PG8_STAGE(PG8_SA(0, 0), a2, voffA);
            PG8_BAR; PG8_WAIT_L(0); PG8_MMA(1, 0, At, B0); PG8_BAR; PG8_SCHED;
            PG8_STAGE(PG8_SB(0, 1), b2 + hstep, voffB);
            PG8_WAIT_V(6); PG8_BAR; PG8_MMA(1, 1, At, B1); PG8_BAR;
            PG8_LDB(B0, 1, 0); PG8_SCHED; PG8_LDA(At, 1, 0); PG8_STAGE(PG8_SA(0, 1), a2 + hstep, voffA);
            PG8_WAIT_L(8); PG8_BAR; PG8_WAIT_L(0); PG8_MMA(0, 0, At, B0); PG8_BAR; PG8_SCHED;
            PG8_LDB(B1, 1, 1); PG8_STAGE(PG8_SB(1, 0), b3, voffB);
            PG8_BAR; PG8_WAIT_L(0); PG8_MMA(0, 1, At, B1); PG8_BAR;
            PG8_LDA(At, 1, 1); PG8_STAGE(PG8_SA(1, 0), a3, voffA);
            PG8_BAR; PG8_WAIT_L(0); PG8_MMA(1, 0, At, B0); PG8_BAR; PG8_SCHED;
            PG8_STAGE(PG8_SB(1, 1), b3 + hstep, voffB);
            PG8_WAIT_V(6); PG8_BAR; PG8_MMA(1, 1, At, B1); PG8_BAR;
        }
        E(acc, cur, wr, wc, fr, fq);
        if (!has_next) break;
#pragma unroll
        for (int a = 0; a < 2; ++a)
#pragma unroll
            for (int b = 0; b < 2; ++b)
#pragma unroll
                for (int m = 0; m < 4; ++m)
#pragma unroll
                    for (int n = 0; n < 2; ++n) acc[a][b][m][n] = (f32x4){0.f, 0.f, 0.f, 0.f};
        cur = nxt; cA = nA; cB = nB; ++ui;
    }
    PG8_WAIT_V(0);
    if (wr == 0) PG8_BAR;
    PG8_BAR;
#undef PG8_SA
#undef PG8_SB
#undef PG8_STAGE
#undef PG8_LDA
#undef PG8_LDB
#undef PG8_MMA
#undef PG8_WAIT_V
#undef PG8_WAIT_L
#undef PG8_BAR
#undef PG8_SCHED
}
}

struct EpiStoreBf16 {
    static constexpr bool PERM = true;
    bf16_t* O; int ldc; const float* ss; float* DT;
    DI void operator()(const f32x4 (&acc)[2][2][4][2], const pg8::Unit& u, int wr, int wc, int fr, int fq) const {
        const int row0 = u.pm * 256 + wr * 64 + fr, col0 = u.pn * 256 + wc * 32 + 8 * fq;
        if (u.pn * 256 >= ldc) {
            if (wc == 0 && fq < 2) {
#pragma unroll
                for (int ai = 0; ai < 2; ++ai)
#pragma unroll
                    for (int m = 0; m < 4; ++m) { const int row = row0 + ai * 128 + m * 16;
                        if (row < MV) { *(f32x4*)(DT + (size_t)row * 16 + 8 * fq) = acc[ai][0][m][0]; *(f32x4*)(DT + (size_t)row * 16 + 8 * fq + 4) = acc[ai][0][m][1]; } }
            }
            return;
        }
#pragma unroll
        for (int ai = 0; ai < 2; ++ai)
#pragma unroll
            for (int m = 0; m < 4; ++m) {
                const int row = row0 + ai * 128 + m * 16;
                if (row < MV) {
                    const float sc = ss ? rsqrtf(ss[row] * (1.f / 1024.f) + EPSF) : 1.f;
                    bf16_t* rp = O + (size_t)row * ldc + col0;
#pragma unroll
                    for (int bj = 0; bj < 2; ++bj) {
                        const f32x4 v0 = acc[ai][bj][m][0] * sc, v1 = acc[ai][bj][m][1] * sc;
                        uint4 w; w.x = pack2(v0[0], v0[1]); w.y = pack2(v0[2], v0[3]); w.z = pack2(v1[0], v1[1]); w.w = pack2(v1[2], v1[3]);
                        *(uint4*)(rp + bj * 128) = w;
                    }
                }
            }
    }
};
struct EpiResid {
    static constexpr bool PERM = false;
    const float* rp_prompt; const float* rp_sample;
    float* H; bf16_t* HB;
    DI void operator()(const f32x4 (&acc)[2][2][4][2], const pg8::Unit& u, int wr, int wc, int fr, int fq) const {
        const int row0 = u.pm * 256 + wr * 64 + fr, col0 = u.pn * 256 + wc * 32 + 4 * fq;
#pragma unroll
        for (int ai = 0; ai < 2; ++ai)
#pragma unroll
            for (int m = 0; m < 4; ++m) {
                const int row = row0 + ai * 128 + m * 16;
                if (row < MV) {
                    const float* rs = (row < MP ? rp_prompt + (size_t)row * 1024 : rp_sample + (size_t)(row - MP) * 1024) + col0;
                    float* hp = H + (size_t)row * 1024 + col0; bf16_t* bp = HB + (size_t)row * 1024 + col0;
#pragma unroll
                    for (int bj = 0; bj < 2; ++bj)
#pragma unroll
                        for (int n = 0; n < 2; ++n) {
                            const int co = bj * 128 + n * 16;
                            const f32x4 v = acc[ai][bj][m][n] + *(const f32x4*)(rs + co);
                            *(f32x4*)(hp + co) = v; *(uint2*)(bp + co) = pack4(v[0], v[1], v[2], v[3]);
                        }
                }
            }
    }
};
struct EpiGate {
    static constexpr bool PERM = false;
    float* Gt;
    DI void operator()(const f32x4 (&acc)[2][2][4][2], const pg8::Unit& u, int wr, int wc, int fr, int fq) const {
        const int row0 = u.pm * 256 + wr * 64 + fr, col0 = u.pn * 256 + wc * 32 + 4 * fq;
#pragma unroll
        for (int ai = 0; ai < 2; ++ai)
#pragma unroll
            for (int m = 0; m < 4; ++m) {
                const int row = row0 + ai * 128 + m * 16;
                if (row < MV) {
                    float* gp = Gt + (size_t)row * 1024 + col0;
#pragma unroll
                    for (int bj = 0; bj < 2; ++bj)
#pragma unroll
                        for (int n = 0; n < 2; ++n) {
                            const f32x4 a = acc[ai][bj][m][n];
                            *(f32x4*)(gp + bj * 128 + n * 16) = (f32x4){sigm(a[0]), sigm(a[1]), sigm(a[2]), sigm(a[3])};
                        }
                }
            }
    }
};
struct EpiPle {
    static constexpr bool PERM = false;
    float* H; const float* Gt; bf16_t* XN; const float* nw; float* SS;
    DI void operator()(const f32x4 (&acc)[2][2][4][2], const pg8::Unit& u, int wr, int wc, int fr, int fq) const {
        const int row0 = u.pm * 256 + wr * 64 + fr, col0 = u.pn * 256 + wc * 32 + 4 * fq;
#pragma unroll
        for (int ai = 0; ai < 2; ++ai)
#pragma unroll
            for (int m = 0; m < 4; ++m) {
                const int row = row0 + ai * 128 + m * 16;
                float ssum = 0.f;
                if (row < MV) {
                    float* hp = H + (size_t)row * 1024 + col0; const float* gp = Gt + (size_t)row * 1024 + col0;
#pragma unroll
                    for (int bj = 0; bj < 2; ++bj)
#pragma unroll
                        for (int n = 0; n < 2; ++n) {
                            const int co = bj * 128 + n * 16;
                            const f32x4 v = *(const f32x4*)(hp + co) + *(const f32x4*)(gp + co) * acc[ai][bj][m][n];
                            *(f32x4*)(hp + co) = v;
                            ssum += v[0] * v[0] + v[1] * v[1] + v[2] * v[2] + v[3] * v[3];
                            if (XN) { const f32x4 w = *(const f32x4*)(nw + col0 + co); *(uint2*)(XN + (size_t)row * 1024 + col0 + co) = pack4(v[0] * w[0], v[1] * w[1], v[2] * w[2], v[3] * w[3]); }
                        }
                }
                ssum += __shfl_xor(ssum, 16); ssum += __shfl_xor(ssum, 32);
                if (fq == 0 && row < MV) atomicAdd(SS + row, ssum);
            }
    }
};

template <int KS, class F>
DI void sgemm(const bf16_t* A, const bf16_t* Bt, int K, int ncolt, int nwg_main, const F& f, unsigned char* L) {
    constexpr int RT = 8 / KS, NRS = 128 / (16 * RT);
    const int tid = otid(), lane = tid & 63, wid = __builtin_amdgcn_readfirstlane(tid >> 6), rt = wid % RT, ks = wid / RT;
    const int G = gridDim.x, off = nwg_main % G, Kh = K / KS;
    int li = blockIdx.x, nl = G;
    if (off != 0) { if ((int)blockIdx.x < off) return; li = blockIdx.x - off; nl = G - off; }
    float* red = (float*)L;
    for (int t = li; t < ncolt * NRS; t += nl) {
        const int ct = t / NRS, rs = t % NRS;
        const bf16_t* ap = A + (size_t)(MP + rs * 16 * RT + rt * 16 + (lane & 15)) * K + ks * Kh + 8 * (lane >> 4);
        const bf16_t* bp0 = Bt + (size_t)(ct * 32 + (lane & 15)) * K + ks * Kh + 8 * (lane >> 4);
        const bf16_t* bp1 = bp0 + (size_t)16 * K;
        f32x4 acc0 = {0.f, 0.f, 0.f, 0.f}, acc1 = {0.f, 0.f, 0.f, 0.f};
        bf16x8 a0[4], a1[4], p0[4], p1[4], q0[4], q1[4];
#define SG_LOAD(av, pv, qv, kk) do { _Pragma("unroll") for (int q_ = 0; q_ < 4; ++q_) { av[q_] = *(const bf16x8*)(ap + (kk) + q_ * 32); pv[q_] = *(const bf16x8*)(bp0 + (kk) + q_ * 32); qv[q_] = *(const bf16x8*)(bp1 + (kk) + q_ * 32); } } while (0)
#define SG_MMA(av, pv, qv) do { _Pragma("unroll") for (int q_ = 0; q_ < 4; ++q_) { acc0 = MFMA16(av[q_], pv[q_], acc0); acc1 = MFMA16(av[q_], qv[q_], acc1); } } while (0)
        SG_LOAD(a0, p0, q0, 0);
        for (int k0 = 0; k0 < Kh; k0 += 256) {
            if (k0 + 128 < Kh) SG_LOAD(a1, p1, q1, k0 + 128);
            SG_MMA(a0, p0, q0);
            if (k0 + 256 < Kh) SG_LOAD(a0, p0, q0, k0 + 256);
            if (k0 + 128 < Kh) SG_MMA(a1, p1, q1);
        }
#undef SG_LOAD
#undef SG_MMA
        if (ks > 0) { float* rp = red + (((ks - 1) * RT + rt) * 64 + lane) * 8; *(f32x4*)rp = acc0; *(f32x4*)(rp + 4) = acc1; }
        lds_barrier();
        if (ks == 0) {
#pragma unroll
            for (int j = 0; j < KS - 1; ++j) { const float* rp = red + ((j * RT + rt) * 64 + lane) * 8; acc0 += *(const f32x4*)rp; acc1 += *(const f32x4*)(rp + 4); }
#pragma unroll
            for (int reg = 0; reg < 4; ++reg) {
                const int row = MP + rs * 16 * RT + rt * 16 + (lane >> 4) * 4 + reg, col = ct * 32 + (lane & 15);
                f(row, col, acc0[reg], lane); f(row, col + 16, acc1[reg], lane);
            }
        }
        lds_barrier();
    }
}
struct SfU { bf16_t* O; int ldc; const float* ss; float* DT;
    DI void operator()(int row, int col, float v, int) const {
        if (col >= ldc) { if (col < ldc + 16) DT[(size_t)row * 16 + col - ldc] = v; return; }
        const float sc = ss ? rsqrtf(ss[row] * (1.f / 1024.f) + EPSF) : 1.f; O[(size_t)row * ldc + col] = f2bf(v * sc); } };
struct SfResid { const float* rs; float* H; bf16_t* HB;
    DI void operator()(int row, int col, float v, int) const { const float h = rs[(size_t)(row - MP) * 1024 + col] + v; H[(size_t)row * 1024 + col] = h; HB[(size_t)row * 1024 + col] = f2bf(h); } };
struct SfGate { float* Gt; DI void operator()(int row, int col, float v, int) const { Gt[(size_t)row * 1024 + col] = sigm(v); } };
struct SfPle { float* H; const float* Gt; bf16_t* XN; const float* nw; float* SS;
    DI void operator()(int row, int col, float v, int lane) const {
        const size_t o = (size_t)row * 1024 + col; const float h = H[o] + Gt[o] * v; H[o] = h;
        if (XN) XN[o] = f2bf(h * nw[col]);
        float ss = h * h; ss += __shfl_xor(ss, 1); ss += __shfl_xor(ss, 2); ss += __shfl_xor(ss, 4); ss += __shfl_xor(ss, 8);
        if ((lane & 15) == 0) atomicAdd(SS + row, ss); } };

DI void transpose_tile_w(const float* src, int lds_, bf16_t* dst, int ldd, int k0, int n0, int nvalid, float* tile, int lane) {
    const float* sp = src + (size_t)k0 * lds_ + n0 + lane;
#pragma unroll
    for (int bt = 0; bt < 4; ++bt) {
        float v[16];
#pragma unroll
        for (int r = 0; r < 16; ++r) v[r] = (lane < nvalid) ? sp[(size_t)(bt * 16 + r) * lds_] : 0.f;
#pragma unroll
        for (int r = 0; r < 16; ++r) tile[(bt * 16 + r) * 65 + lane] = v[r];
    }
    const int koct = lane & 7;
#pragma unroll
    for (int p = 0; p < 8; ++p) {
        const int nn = (lane >> 3) + 8 * p;
        const float* tp = tile + (koct * 8) * 65 + nn;
        uint4 w;
        w.x = pack2(tp[0], tp[65]); w.y = pack2(tp[2 * 65], tp[3 * 65]); w.z = pack2(tp[4 * 65], tp[5 * 65]); w.w = pack2(tp[6 * 65], tp[7 * 65]);
        *(uint4*)(dst + (size_t)(n0 + nn) * ldd + k0 + koct * 8) = w;
    }
}
DI void transpose_job(const float* src, int lds_, bf16_t* dst, int ldd, int K, int N, int nvalid_last, int& base, float* tile, int gw, int nwv, int lane) {
    const int ntn = (N + 63) / 64, nt = (K / 64) * ntn;
    const int first = (gw - (base % nwv) + nwv) % nwv;
    for (int t = first; t < nt; t += nwv) { const int tn = t % ntn; transpose_tile_w(src, lds_, dst, ldd, (t / ntn) * 64, tn * 64, (tn == ntn - 1) ? nvalid_last : 64, tile, lane); }
    base += nt;
}
DI void l1_weight_tile(const Params& P, int t, float* tile, int lane) {
    if (t < 2048) transpose_tile_w(P.in[26], INC, WSP(bf16_t, OFF_W1T), 1024, (t >> 7) * 64, (t & 127) * 64, 64, tile, lane);
    else if (t < 2560) { t -= 2048; transpose_tile_w(P.in[29], 1024, WSP(bf16_t, OFF_WO1T), 2048, (t >> 4) * 64, (t & 15) * 64, 64, tile, lane); }
    else if (t < 2816) { t -= 2560; transpose_tile_w(P.in[31] + 1024 * 1024, 1024, WSP(bf16_t, OFF_WG1T), 1024, (t >> 4) * 64, (t & 15) * 64, 64, tile, lane); }
    else if (t < 2880) { t -= 2816; transpose_tile_w(P.in[30] + 256 * 1024, 1024, WSP(bf16_t, OFF_WP1T), 256, (t >> 4) * 64, (t & 15) * 64, 64, tile, lane); }
    else if (t < 3392) { t -= 2880; transpose_tile_w(P.in[25], 1024, WSP(bf16_t, OFF_WO0T), 2048, (t >> 4) * 64, (t & 15) * 64, 64, tile, lane); }
    else if (t < 3648) { t -= 3392; transpose_tile_w(P.in[31], 1024, WSP(bf16_t, OFF_WG0T), 1024, (t >> 4) * 64, (t & 15) * 64, 64, tile, lane); }
    else { t -= 3648; transpose_tile_w(P.in[30], 1024, WSP(bf16_t, OFF_WP0T), 256, (t >> 4) * 64, (t & 15) * 64, 64, tile, lane); }
}
DI void phase_prep(const Params& P, unsigned char* L) {
    const int tid = otid(), lane = tid & 63, wid = tid >> 6;
    const int gw = blockIdx.x * 8 + wid, nwv = gridDim.x * 8;
    { float* z = WSP(float, OFF_SS1); const int n = (int)((OFF_DT - OFF_SS1) / 4);
      for (int i = blockIdx.x * 512 + tid; i < n; i += gridDim.x * 512) z[i] = 0.f;
      if (blockIdx.x == 0 && tid < 64) WSP(unsigned, OFF_CTL)[tid] = 0u; }
    { float* tile = (float*)L + wid * (64 * 65); int base = 0;
      transpose_job(P.in[11], INAB, WSP(bf16_t, OFF_W0T), 1024, 1024, N0, 64, base, tile, gw, nwv, lane);
      transpose_job(P.in[11] + N0, INAB, WSP(bf16_t, OFF_W0T) + (size_t)N0 * 1024, 1024, 1024, 16, 16, base, tile, gw, nwv, lane);
      transpose_job(P.in[14], 128, WSP(bf16_t, OFF_WRT), 1024, 1024, 128, 64, base, tile, gw, nwv, lane);
      transpose_job(P.in[16], 128, WSP(bf16_t, OFF_WIT), 1024, 1024, 128, 64, base, tile, gw, nwv, lane); }
    { const float* nwp = P.in[9]; bf16_t* XN = WSP(bf16_t, OFF_XN);
      f32x4 w4[4];
#pragma unroll
      for (int i = 0; i < 4; ++i) w4[i] = *(const f32x4*)(nwp + lane * 4 + 256 * i);
      for (int r0 = gw * 2; r0 < MV; r0 += nwv * 2) {
          f32x4 x[2][4];
#pragma unroll
          for (int q = 0; q < 2; ++q) { const int r = r0 + q; const float* src = r < MP ? P.in[0] + (size_t)r * 1024 : P.in[1] + (size_t)(r - MP) * 1024;
#pragma unroll
              for (int i = 0; i < 4; ++i) x[q][i] = *(const f32x4*)(src + lane * 4 + 256 * i); }
#pragma unroll
          for (int q = 0; q < 2; ++q) {
              float ss = 0.f;
#pragma unroll
              for (int i = 0; i < 4; ++i) ss += x[q][i][0] * x[q][i][0] + x[q][i][1] * x[q][i][1] + x[q][i][2] * x[q][i][2] + x[q][i][3] * x[q][i][3];
              ss = wave_sum(ss); const float rstd = rsqrtf(ss * (1.f / 1024.f) + EPSF);
#pragma unroll
              for (int i = 0; i < 4; ++i) { const f32x4 v = x[q][i] * rstd * w4[i]; *(uint2*)(XN + (size_t)(r0 + q) * 1024 + lane * 4 + 256 * i) = pack4(v[0], v[1], v[2], v[3]); }
          }
      } }
}
DI void convert_p_chunk(const Params& P, int layer, int chunk, int tid) {
    bf16_t* PB = WSP(bf16_t, OFF_PB + (size_t)layer * PB_STRIDE);
    const float* pp = P.in[2] + (size_t)layer * MP * 256; const float* ps = P.in[3] + (size_t)layer * MS * 256;
#pragma unroll 4
    for (int j = 0; j < 16; ++j) {
        const int i = chunk * 8192 + j * 512 + tid;
        if (i < MV * 64) {
            const int row = i >> 6, c4 = (i & 63) * 4;
            const f32x4 v = *(const f32x4*)((row < MP ? pp + (size_t)row * 256 : ps + (size_t)(row - MP) * 256) + c4);
            *(uint2*)(PB + (size_t)row * 256 + c4) = pack4(v[0], v[1], v[2], v[3]);
        }
    }
}

constexpr size_t OFF_XT = OFF_XN;
constexpr size_t OFF_CN = OFF_H;
constexpr size_t OFF_BN = OFF_CN + (size_t)MP * 256 * 2;
constexpr size_t OFF_BT = OFF_BN + (size_t)MP * 256 * 2;
DI void phase_convbc(const Params& P) {
    const bf16_t* U = WSP(bf16_t, OFF_U);
    bf16_t* XT = WSP(bf16_t, OFF_XT); bf16_t* CN = WSP(bf16_t, OFF_CN); bf16_t* BN = WSP(bf16_t, OFF_BN); bf16_t* BT = WSP(bf16_t, OFF_BT);
    for (int idx = blockIdx.x * 512 + otid(); idx < 2048 * 384; idx += gridDim.x * 512) {
        const int quad = idx % 384, tgp = idx / 384, b = tgp >> 8, t0 = (tgp & 255) * 8, cch = quad * 4;
        float cw[4][4], cbias[4];
#pragma unroll
        for (int kk = 0; kk < 4; ++kk) { const f32x4 w = *(const f32x4*)(P.in[19] + kk * 1536 + cch); cw[kk][0] = w[0]; cw[kk][1] = w[1]; cw[kk][2] = w[2]; cw[kk][3] = w[3]; }
        { const f32x4 w = *(const f32x4*)(P.in[20] + cch); cbias[0] = w[0]; cbias[1] = w[1]; cbias[2] = w[2]; cbias[3] = w[3]; }
        const unsigned voff = (unsigned)((b * 2048 + t0) * N0 + 3072 + cch);
        uint2 raw[11];
#pragma unroll
        for (int j = 0; j < 11; ++j) raw[j] = (t0 + j - 3 >= 0) ? *(const uint2*)((U + (j - 3) * N0) + voff) : make_uint2(0u, 0u);
        float y[8][4];
#pragma unroll
        for (int j = 0; j < 8; ++j) {
            const float x0[4] = {bflo(raw[j].x), bfhi(raw[j].x), bflo(raw[j].y), bfhi(raw[j].y)};
            const float x1[4] = {bflo(raw[j + 1].x), bfhi(raw[j + 1].x), bflo(raw[j + 1].y), bfhi(raw[j + 1].y)};
            const float x2[4] = {bflo(raw[j + 2].x), bfhi(raw[j + 2].x), bflo(raw[j + 2].y), bfhi(raw[j + 2].y)};
            const float x3[4] = {bflo(raw[j + 3].x), bfhi(raw[j + 3].x), bflo(raw[j + 3].y), bfhi(raw[j + 3].y)};
#pragma unroll
            for (int e = 0; e < 4; ++e) y[j][e] = silu(cbias[e] + cw[0][e] * x0[e] + cw[1][e] * x1[e] + cw[2][e] * x2[e] + cw[3][e] * x3[e]);
        }
        const int c = t0 >> 7, tl = t0 & 127;
        if (cch < 1024) {
#pragma unroll
            for (int e = 0; e < 4; ++e) { uint4 w; w.x = pack2(y[0][e], y[1][e]); w.y = pack2(y[2][e], y[3][e]); w.z = pack2(y[4][e], y[5][e]); w.w = pack2(y[6][e], y[7][e]);
                *(uint4*)(XT + ((size_t)((b * 16 + c) * 1024 + cch + e)) * 128 + tl) = w; }
        } else {
            const int cc = cch - 1024, isC = cc >= 256, g = (cc & 255) >> 7, n0 = cc & 127;
            bf16_t* nat = (isC ? CN : BN) + ((size_t)(((b * 16 + c) * 2 + g) * 128 + tl)) * 128 + n0;
#pragma unroll
            for (int j = 0; j < 8; ++j) *(uint2*)(nat + j * 128) = pack4(y[j][0], y[j][1], y[j][2], y[j][3]);
            if (!isC) {
#pragma unroll
                for (int e = 0; e < 4; ++e) { uint4 w; w.x = pack2(y[0][e], y[1][e]); w.y = pack2(y[2][e], y[3][e]); w.z = pack2(y[4][e], y[5][e]); w.w = pack2(y[6][e], y[7][e]);
                    *(uint4*)(BT + ((size_t)(((b * 16 + c) * 2 + g) * 128 + n0 + e)) * 128 + tl) = w; }
            }
        }
    }
}
DI void ssd_prompt_item(const Params& P, unsigned char* L, int item) {
    const int b = item >> 4, h = item & 15, g = h >> 3;
    const int tid0 = otid(), wid = tid0 >> 6;
    bf16_t* Cs = (bf16_t*)L;
    bf16_t* Bs = Cs + 128 * 136;
    bf16_t* BsT = Bs + 128 * 136;
    bf16_t* XsT = BsT + 128 * 136;
    bf16_t* St = XsT + 64 * 136;
    float* dtvB = (float*)(St + 64 * 136); float* acsB = dtvB + 256; float* wvB = acsB + 256;
    const bf16_t* U = WSP(bf16_t, OFF_U); const float* DT = WSP(float, OFF_DT); bf16_t* MIX = WSP(bf16_t, OFF_MIX); float* SSB = WSP(float, OFF_SSB);
    const float a_neg = -__expf(P.in[22][h]), dtb = P.in[21][h], Dh = P.in[23][h];
    f32x16 accS;
#pragma unroll
    for (int i = 0; i < 16; ++i) accS[i] = 0.f;
    lds_barrier();
    for (int i = tid0; i < 64 * 136; i += 512) St[i] = 0;
    float dtr0 = 0.f, dtr1 = 0.f;
#define SSD_DTLOAD(cc) do { if (wid == 0) { const float* dp_ = DT + (size_t)(b * 2048 + (cc) * 128 + (tid0 & 63)) * 16 + h; dtr0 = dp_[0]; dtr1 = dp_[64 * 16]; } } while (0)
#define SSD_SCAN(buf) do { if (wid == 0) { const int ln_ = tid0 & 63; const float d0_ = softplus(dtr0 + dtb), d1_ = softplus(dtr1 + dtb); float v0_ = d0_ * a_neg, v1_ = d1_ * a_neg; \
        _Pragma("unroll") for (int o_ = 1; o_ < 64; o_ <<= 1) { const float n0_ = __shfl_up(v0_, o_), n1_ = __shfl_up(v1_, o_); if (ln_ >= o_) { v0_ += n0_; v1_ += n1_; } } \
        v1_ += __shfl(v0_, 63); const float al_ = __shfl(v1_, 63); \
        dtvB[(buf) * 128 + ln_] = d0_; dtvB[(buf) * 128 + 64 + ln_] = d1_; acsB[(buf) * 128 + ln_] = v0_; acsB[(buf) * 128 + 64 + ln_] = v1_; \
        wvB[(buf) * 128 + ln_] = __expf(al_ - v0_) * d0_; wvB[(buf) * 128 + 64 + ln_] = __expf(al_ - v1_) * d1_; } } while (0)
    SSD_DTLOAD(0); SSD_SCAN(0); SSD_DTLOAD(1);
    u32x4 tC[4], tB[4], tT[4], tX[2];
    for (int c = 0; c < 16; ++c) {
        const int row0 = b * 2048 + c * 128;
        lds_barrier();
        int zv = 0; asm volatile("" : "+v"(zv));
        const int tid = tid0 + zv, lane = tid & 63, hh = lane >> 5, l31 = lane & 31;
        const int prow = tid >> 4, pcol = (tid & 15) * 8;
        const float* dtv = dtvB + (c & 1) * 128; const float* acs = acsB + (c & 1) * 128; const float* wv = wvB + (c & 1) * 128;
        if (c + 1 < 16) { SSD_SCAN((c + 1) & 1); if (c + 2 < 16) SSD_DTLOAD(c + 2); }
        if (c == 0) {
            const size_t tb_ = ((size_t)((b * 16 + c) * 2 + g)) * 128 * 128 + (size_t)prow * 128 + pcol;
            const u32x4* pc = (const u32x4*)(WSP(bf16_t, OFF_CN) + tb_); const u32x4* pb = (const u32x4*)(WSP(bf16_t, OFF_BN) + tb_); const u32x4* pt = (const u32x4*)(WSP(bf16_t, OFF_BT) + tb_);
            const u32x4* px = (const u32x4*)(WSP(bf16_t, OFF_XT) + ((size_t)((b * 16 + c) * 1024 + h * 64 + prow)) * 128 + pcol);
#pragma unroll
            for (int i = 0; i < 4; ++i) { tC[i] = pc[i * 512]; tB[i] = pb[i * 512]; tT[i] = pt[i * 512]; }
            tX[0] = px[0]; tX[1] = px[512];
        }
        const float a_last = acs[127];
#pragma unroll
        for (int i = 0; i < 4; ++i) {
            *(u32x4*)(Cs + (prow + 32 * i) * 136 + pcol) = tC[i]; *(u32x4*)(Bs + (prow + 32 * i) * 136 + pcol) = tB[i]; *(u32x4*)(BsT + (prow + 32 * i) * 136 + pcol) = tT[i];
        }
        *(u32x4*)(XsT + prow * 136 + pcol) = tX[0]; *(u32x4*)(XsT + (prow + 32) * 136 + pcol) = tX[1];
        if (c + 1 < 16) {
            const size_t tb_ = ((size_t)((b * 16 + c + 1) * 2 + g)) * 128 * 128 + (size_t)prow * 128 + pcol;
            const u32x4* pc = (const u32x4*)(WSP(bf16_t, OFF_CN) + tb_); const u32x4* pb = (const u32x4*)(WSP(bf16_t, OFF_BN) + tb_); const u32x4* pt = (const u32x4*)(WSP(bf16_t, OFF_BT) + tb_);
            const u32x4* px = (const u32x4*)(WSP(bf16_t, OFF_XT) + ((size_t)((b * 16 + c + 1) * 1024 + h * 64 + prow)) * 128 + pcol);
#pragma unroll
            for (int i = 0; i < 4; ++i) { tC[i] = pc[i * 512]; tB[i] = pb[i * 512]; tT[i] = pt[i * 512]; }
            tX[0] = px[0]; tX[1] = px[512];
        }
        bf16_t zr[16];
        {
            const unsigned zoff = (unsigned)((row0 + (wid >> 1) * 32 + 4 * hh) * N0 + 2048 + h * 64 + (wid & 1) * 32 + l31);
#pragma unroll
            for (int reg = 0; reg < 16; ++reg) zr[reg] = (U + ((reg & 3) + 8 * (reg >> 2)) * N0)[zoff];
        }
        lds_barrier();
        {
            const int rb = (wid >> 1) * 32, cb0 = (wid & 1) * 64;
            f32x16 cbA[2];
#pragma unroll
            for (int i = 0; i < 16; ++i) { cbA[0][i] = 0.f; cbA[1][i] = 0.f; }
#pragma unroll
            for (int ks = 0; ks < 8; ++ks) {
                const bf16x8 a = ldfrag(Cs, 136, rb, ks * 16, lane);
                cbA[0] = MFMA32(a, ldfrag(Bs, 136, cb0, ks * 16, lane), cbA[0]);
                cbA[1] = MFMA32(a, ldfrag(Bs, 136, cb0 + 32, ks * 16, lane), cbA[1]);
            }
            lds_barrier();
            bf16_t* Ws = Bs;
#pragma unroll
            for (int j = 0; j < 2; ++j) {
                const int s = cb0 + j * 32 + l31; const float as = acs[s], ds = dtv[s];
#pragma unroll
                for (int reg = 0; reg < 16; ++reg) {
                    const int t = rb + crow(reg, hh);
                    const float v = (s <= t) ? cbA[j][reg] * __expf(acs[t] - as) * ds : 0.f;
                    Ws[t * 136 + s] = f2bf(v);
                }
            }
        }
        lds_barrier();
        {
            const bf16_t* Ws = Bs;
            const int tb = (wid >> 1) * 32, pb = (wid & 1) * 32;
            f32x16 y;
#pragma unroll
            for (int i = 0; i < 16; ++i) y[i] = 0.f;
#pragma unroll
            for (int ks = 0; ks < 8; ++ks) y = MFMA32(ldfrag(Cs, 136, tb, ks * 16, lane), ldfrag(St, 136, pb, ks * 16, lane), y);
#pragma unroll
            for (int reg = 0; reg < 16; ++reg) y[reg] *= __expf(acs[tb + crow(reg, hh)]);
#pragma unroll
            for (int ks = 0; ks < 8; ++ks) y = MFMA32(ldfrag(Ws, 136, tb, ks * 16, lane), ldfrag(XsT, 136, pb, ks * 16, lane), y);
            lds_barrier();
            {
                bf16_t* XwT = Cs;
                const uint4 xa = *(const uint4*)(XsT + prow * 136 + pcol), xb_ = *(const uint4*)(XsT + (prow + 32) * 136 + pcol);
                const f32x4 w0 = *(const f32x4*)(wv + pcol), w1 = *(const f32x4*)(wv + pcol + 4);
                uint4 oa, ob;
                oa.x = pack2(bflo(xa.x) * w0[0], bfhi(xa.x) * w0[1]); oa.y = pack2(bflo(xa.y) * w0[2], bfhi(xa.y) * w0[3]); oa.z = pack2(bflo(xa.z) * w1[0], bfhi(xa.z) * w1[1]); oa.w = pack2(bflo(xa.w) * w1[2], bfhi(xa.w) * w1[3]);
                ob.x = pack2(bflo(xb_.x) * w0[0], bfhi(xb_.x) * w0[1]); ob.y = pack2(bflo(xb_.y) * w0[2], bfhi(xb_.y) * w0[3]); ob.z = pack2(bflo(xb_.z) * w1[0], bfhi(xb_.z) * w1[1]); ob.w = pack2(bflo(xb_.w) * w1[2], bfhi(xb_.w) * w1[3]);
                *(uint4*)(XwT + prow * 136 + pcol) = oa; *(uint4*)(XwT + (prow + 32) * 136 + pcol) = ob;
            }
            const int p = pb + l31, ch = h * 64 + p; const float nwv = P.in[24][ch];
#pragma unroll
            for (int reg = 0; reg < 16; ++reg) {
                const int t = tb + crow(reg, hh); const size_t row = (size_t)(row0 + t);
                const float xv = bf2f(XsT[p * 136 + t]); const float z = bf2f(zr[reg]);
                const float yy = (y[reg] + Dh * xv) * silu(z);
                float ss = yy * yy;
                ss += __shfl_xor(ss, 1); ss += __shfl_xor(ss, 2); ss += __shfl_xor(ss, 4); ss += __shfl_xor(ss, 8); ss += __shfl_xor(ss, 16);
                if (l31 == 0) atomicAdd(SSB + row * 2 + g, ss);
                MIX[row * 2048 + 1024 + ch] = f2bf(yy * nwv);
            }
            lds_barrier();
            const int pb2 = (wid >> 2) * 32, nb = (wid & 3) * 32;
            const float ea = __expf(a_last);
#pragma unroll
            for (int reg = 0; reg < 16; ++reg) accS[reg] *= ea;
#pragma unroll
            for (int ks = 0; ks < 8; ++ks) accS = MFMA32(ldfrag(Cs, 136, pb2, ks * 16, lane), ldfrag(BsT, 136, nb, ks * 16, lane), accS);
#pragma unroll
            for (int reg = 0; reg < 16; ++reg) St[(pb2 + crow(reg, hh)) * 136 + nb + l31] = f2bf(accS[reg]);
        }
    }
    {
        const int lane = tid0 & 63, hh = lane >> 5, l31 = lane & 31;
        const int pb2 = (wid >> 2) * 32, nb = (wid & 3) * 32;
        float* o = P.out + O_BSP + (size_t)(b * 16 + h) * 64 * 128;
#pragma unroll
        for (int reg = 0; reg < 16; ++reg) o[(pb2 + crow(reg, hh)) * 128 + nb + l31] = accS[reg];
    }
}
#undef SSD_DTLOAD
#undef SSD_SCAN
DI void ssd_sample_item(const Params& P, unsigned char* L, int item) {
    const int b = item >> 4, h = item & 15, g = h >> 3, tid = otid(), lane = tid & 63;
    float* xs = (float*)L; float* Bv = xs + 64; float* Cv = Bv + 128; float* yv = Cv + 128;
    const bf16_t* U = WSP(bf16_t, OFF_U); bf16_t* MIX = WSP(bf16_t, OFF_MIX); float* SSB = WSP(float, OFF_SSB);
    const size_t row = (size_t)(MP + b);
    __syncthreads();
    if (tid < 320) {
        int cc; if (tid < 64) cc = h * 64 + tid; else if (tid < 192) cc = 1024 + g * 128 + (tid - 64); else cc = 1280 + g * 128 + (tid - 192);
        const float* buf = P.in[7] + (size_t)b * 3 * 1536 + cc;
        const float v = P.in[20][cc] + P.in[19][cc] * buf[0] + P.in[19][1536 + cc] * buf[1536] + P.in[19][2 * 1536 + cc] * buf[2 * 1536] + P.in[19][3 * 1536 + cc] * bf2f(U[row * N0 + 3072 + cc]);
        xs[tid] = silu(v);
    }
    const float dt = softplus(WSP(float, OFF_DT)[row * 16 + h] + P.in[21][h]);
    const float dA = __expf(-dt * __expf(P.in[22][h]));
    __syncthreads();
    const float* s0 = P.in[6] + (size_t)(b * 16 + h) * 64 * 128; float* s1 = P.out + O_BSS + (size_t)(b * 16 + h) * 64 * 128;
    const int n4 = (tid & 31) * 4;
    const f32x4 Bq = *(const f32x4*)(Bv + n4), Cq = *(const f32x4*)(Cv + n4);
#pragma unroll
    for (int j = 0; j < 4; ++j) {
        const int p = (tid >> 5) + 16 * j;
        const f32x4 s = *(const f32x4*)(s0 + p * 128 + n4);
        const float dx = dt * xs[p];
        const f32x4 sn = s * dA + Bq * dx;
        *(f32x4*)(s1 + p * 128 + n4) = sn;
        float yp = sn[0] * Cq[0] + sn[1] * Cq[1] + sn[2] * Cq[2] + sn[3] * Cq[3];
        yp += __shfl_xor(yp, 1); yp += __shfl_xor(yp, 2); yp += __shfl_xor(yp, 4); yp += __shfl_xor(yp, 8); yp += __shfl_xor(yp, 16);
        if ((tid & 31) == 0) yv[p] = yp;
    }
    __syncthreads();
    if (tid < 64) {
        const int ch = h * 64 + tid;
        const float yy = (yv[tid] + P.in[23][h] * xs[tid]) * silu(bf2f(U[row * N0 + 2048 + ch]));
        const float ss = wave_sum(yy * yy);
        if (lane == 0) atomicAdd(SSB + row * 2 + g, ss);
        MIX[row * 2048 + 1024 + ch] = f2bf(yy * P.in[24][ch]);
    }
}
DI void ssd_sample_item4(const Params& P, unsigned char* L, int item) {
    const int b = item >> 2, tid = otid(), gi = tid >> 7, lt = tid & 127, h = (item & 3) * 4 + gi, g = h >> 3;
    float* xs = (float*)L + gi * 512; float* Bv = xs + 64; float* Cv = Bv + 128; float* yv = Cv + 128;
    const bf16_t* U = WSP(bf16_t, OFF_U); bf16_t* MIX = WSP(bf16_t, OFF_MIX); float* SSB = WSP(float, OFF_SSB);
    const size_t row = (size_t)(MP + b);
    __syncthreads();
#pragma unroll
    for (int ps = 0; ps < 3; ++ps) {
        const int idx = lt + 128 * ps;
        if (idx < 320) {
            int cc; if (idx < 64) cc = h * 64 + idx; else if (idx < 192) cc = 1024 + g * 128 + (idx - 64); else cc = 1280 + g * 128 + (idx - 192);
            const float* buf = P.in[7] + (size_t)b * 3 * 1536 + cc;
            const float v = P.in[20][cc] + P.in[19][cc] * buf[0] + P.in[19][1536 + cc] * buf[1536] + P.in[19][2 * 1536 + cc] * buf[2 * 1536] + P.in[19][3 * 1536 + cc] * bf2f(U[row * N0 + 3072 + cc]);
            xs[idx] = silu(v);
        }
    }
    const float dt = softplus(WSP(float, OFF_DT)[row * 16 + h] + P.in[21][h]);
    const float dA = __expf(-dt * __expf(P.in[22][h]));
    __syncthreads();
    const float* s0 = P.in[6] + (size_t)(b * 16 + h) * 64 * 128; float* s1 = P.out + O_BSS + (size_t)(b * 16 + h) * 64 * 128;
    const int n4 = (lt & 31) * 4;
    const f32x4 Bq = *(const f32x4*)(Bv + n4), Cq = *(const f32x4*)(Cv + n4);
    f32x4 sv[16];
#pragma unroll
    for (int j = 0; j < 16; ++j) sv[j] = *(const f32x4*)(s0 + ((lt >> 5) + 4 * j) * 128 + n4);
#pragma unroll
    for (int j = 0; j < 16; ++j) {
        const int p = (lt >> 5) + 4 * j;
        const f32x4 sn = sv[j] * dA + Bq * (dt * xs[p]);
        *(f32x4*)(s1 + p * 128 + n4) = sn;
        float yp = sn[0] * Cq[0] + sn[1] * Cq[1] + sn[2] * Cq[2] + sn[3] * Cq[3];
        yp += __shfl_xor(yp, 1); yp += __shfl_xor(yp, 2); yp += __shfl_xor(yp, 4); yp += __shfl_xor(yp, 8); yp += __shfl_xor(yp, 16);
        if ((lt & 31) == 0) yv[p] = yp;
    }
    __syncthreads();
    if (lt < 64) {
        const int ch = h * 64 + lt;
        const float yy = (yv[lt] + P.in[23][h] * xs[lt]) * silu(bf2f(U[row * N0 + 2048 + ch]));
        const float ss = wave_sum(yy * yy);
        if (lt == 0) atomicAdd(SSB + row * 2 + g, ss);
        MIX[row * 2048 + 1024 + ch] = f2bf(yy * P.in[24][ch]);
    }
}
template <bool SAMPLE>
DI void rglru_item(const Params& P, unsigned char* L, int item) {
    const int tid0 = otid(), wid = tid0 >> 6;
    const int b = SAMPLE ? 0 : (item >> 4), k = (item >> 1) & 7, dh = item & 1;
    bf16_t* Xs = (bf16_t*)L;
    bf16_t* Wg = Xs + 128 * 136;
    float* Aa = (float*)(Wg + 128 * 136);
    float* Uu = Aa + 128 * 64; float* segA = Uu + 128 * 64; float* segH = segA + 512; float* hc = segH + 512;
    const bf16_t* U = WSP(bf16_t, OFF_U); bf16_t* MIX = WSP(bf16_t, OFF_MIX);
    lds_barrier();
    {
        const bf16_t* WRT = WSP(bf16_t, OFF_WRT); const bf16_t* WIT = WSP(bf16_t, OFF_WIT);
#pragma unroll
        for (int i = 0; i < 4; ++i) {
            const int chk = tid0 + i * 512, r = chk >> 4, c8 = (chk & 15) * 8;
            const bf16_t* src = (r < 64 ? WRT + (size_t)(dh * 64 + r) * 1024 : WIT + (size_t)(dh * 64 + r - 64) * 1024) + k * 128 + c8;
            *(u32x4*)(Wg + r * 136 + c8) = *(const u32x4*)src;
        }
        if (tid0 < 64) hc[tid0] = 0.f;
    }
    float sp[4], br[4], bi[4];
#pragma unroll
    for (int ct = 0; ct < 4; ++ct) { const int chd = k * 128 + dh * 64 + ct * 16 + (tid0 & 15); sp[ct] = softplus(-P.in[18][chd]); br[ct] = P.in[15][chd]; bi[ct] = P.in[17][chd]; }
    const int ch0 = k * 128 + (tid0 & 31) * 4;
    float cw[4][4], cbias[4];
#pragma unroll
    for (int kk = 0; kk < 4; ++kk)
#pragma unroll
        for (int e = 0; e < 4; ++e) cw[kk][e] = P.in[12][kk * 1024 + ch0 + e];
#pragma unroll
    for (int e = 0; e < 4; ++e) cbias[e] = P.in[13][ch0 + e];
    u32x2 raw[11];
#define RG_LOAD(tl_) do { const int tg_ = (tl_) * 128 + (tid0 >> 5) * 8; const unsigned vo_ = (unsigned)((b * 2048 + tg_) * N0 + ch0); \
        _Pragma("unroll") for (int j = 0; j < 11; ++j) raw[j] = (tg_ + j - 3 >= 0) ? *(const u32x2*)((U + (j - 3) * N0) + vo_) : (u32x2){0u, 0u}; } while (0)
    if (!SAMPLE) RG_LOAD(0);
    const int ntiles = SAMPLE ? 1 : 16;
    for (int tile = 0; tile < ntiles; ++tile) {
        const int row0 = SAMPLE ? MP : b * 2048 + tile * 128;
        lds_barrier();
        int zv = 0; asm volatile("" : "+v"(zv));
        const int tid = tid0 + zv, lane = tid & 63, quad = tid & 31, seg = tid >> 5;
        const int sd = tid & 63, sseg = wid, sch = k * 128 + dh * 64 + sd;
        bf16_t gt[16];
        if (!SAMPLE) {
            const unsigned goff = (unsigned)((row0 + sseg * 16) * N0 + 1024 + sch);
#pragma unroll
            for (int t = 0; t < 16; ++t) gt[t] = (U + t * N0)[goff];
        }
        if (SAMPLE) {
#pragma unroll
            for (int t = 0; t < 8; ++t) {
                const int bb = seg * 8 + t;
                const float* buf = P.in[5] + (size_t)bb * 3 * 1024 + ch0;
                const f32x4 p0 = *(const f32x4*)buf, p1 = *(const f32x4*)(buf + 1024), p2 = *(const f32x4*)(buf + 2048);
                float cur[4]; ld4bf(U + (size_t)(MP + bb) * N0 + ch0, cur);
                float y[4];
#pragma unroll
                for (int e = 0; e < 4; ++e) y[e] = cbias[e] + cw[0][e] * p0[e] + cw[1][e] * p1[e] + cw[2][e] * p2[e] + cw[3][e] * cur[e];
                *(u32x2*)(Xs + bb * 136 + quad * 4) = pack4v(y[0], y[1], y[2], y[3]);
            }
        } else {
#pragma unroll
            for (int j = 0; j < 8; ++j) {
                const float x0[4] = {bflo(raw[j].x), bfhi(raw[j].x), bflo(raw[j].y), bfhi(raw[j].y)};
                const float x1[4] = {bflo(raw[j + 1].x), bfhi(raw[j + 1].x), bflo(raw[j + 1].y), bfhi(raw[j + 1].y)};
                const float x2[4] = {bflo(raw[j + 2].x), bfhi(raw[j + 2].x), bflo(raw[j + 2].y), bfhi(raw[j + 2].y)};
                const float x3[4] = {bflo(raw[j + 3].x), bfhi(raw[j + 3].x), bflo(raw[j + 3].y), bfhi(raw[j + 3].y)};
                float y[4];
#pragma unroll
                for (int e = 0; e < 4; ++e) y[e] = cbias[e] + cw[0][e] * x0[e] + cw[1][e] * x1[e] + cw[2][e] * x2[e] + cw[3][e] * x3[e];
                *(u32x2*)(Xs + (seg * 8 + j) * 136 + quad * 4) = pack4v(y[0], y[1], y[2], y[3]);
            }
            if (tile + 1 < 16) RG_LOAD(tile + 1);
        }
        lds_barrier();
        {
            f32x4 acc[8];
#pragma unroll
            for (int i = 0; i < 8; ++i) acc[i] = (f32x4){0.f, 0.f, 0.f, 0.f};
#pragma unroll
            for (int ks = 0; ks < 4; ++ks) {
                const bf16x8 a = ldfrag16(Xs, 136, wid * 16, ks * 32, lane);
#pragma unroll
                for (int tl = 0; tl < 8; ++tl) acc[tl] = MFMA16(a, ldfrag16(Wg, 136, tl * 16, ks * 32, lane), acc[tl]);
            }
#pragma unroll
            for (int ct = 0; ct < 4; ++ct)
#pragma unroll
                for (int reg = 0; reg < 4; ++reg) {
                    const int t = wid * 16 + (lane >> 4) * 4 + reg, d = ct * 16 + (lane & 15);
                    const float r = sigm(acc[ct][reg] + br[ct]), gi = sigm(acc[4 + ct][reg] + bi[ct]);
                    const float a = __expf(-8.f * r * sp[ct]);
                    const float uu = __builtin_amdgcn_sqrtf(fmaxf(1.f - a * a, 0.f)) * gi * bf2f(Xs[t * 136 + dh * 64 + d]);
                    if (SAMPLE) {
                        const int chd = k * 128 + dh * 64 + d;
                        const float hn = a * P.in[4][(size_t)t * 1024 + chd] + uu;
                        P.out[O_AHS + (size_t)t * 1024 + chd] = hn;
                        const float gv = bf2f(U[(size_t)(MP + t) * N0 + 1024 + chd]);
                        MIX[(size_t)(MP + t) * 2048 + chd] = f2bf(hn * silu(gv));
                    } else { Aa[t * 64 + d] = a; Uu[t * 64 + d] = uu; }
                }
        }
        if (!SAMPLE) {
            lds_barrier();
            float av[16], uv[16], Ap = 1.f, Hp = 0.f;
#pragma unroll
            for (int t = 0; t < 16; ++t) { av[t] = Aa[(sseg * 16 + t) * 64 + sd]; uv[t] = Uu[(sseg * 16 + t) * 64 + sd]; Hp = av[t] * Hp + uv[t]; Ap *= av[t]; }
            segA[sseg * 64 + sd] = Ap; segH[sseg * 64 + sd] = Hp;
            lds_barrier();
            float hin = hc[sd];
            for (int s2 = 0; s2 < sseg; ++s2) hin = segA[s2 * 64 + sd] * hin + segH[s2 * 64 + sd];
            const unsigned moff = (unsigned)((row0 + sseg * 16) * 2048 + sch);
#pragma unroll
            for (int t = 0; t < 16; ++t) {
                hin = av[t] * hin + uv[t];
                (MIX + t * 2048)[moff] = f2bf(hin * silu(bf2f(gt[t])));
            }
            lds_barrier();
            if (sseg == 7) hc[sd] = hin;
        }
    }
#undef RG_LOAD
    if (!SAMPLE) { lds_barrier(); if (tid0 < 64) P.out[O_AHP + (size_t)b * 1024 + k * 128 + dh * 64 + tid0] = hc[tid0]; }
}
DI void phase_mix0(const Params& P, unsigned char* L) {
    const int tid = otid(), bid = blockIdx.x, G = gridDim.x;
    { const bf16_t* U = WSP(bf16_t, OFF_U);
      for (int i = bid * 512 + tid; i < 8 * 3 * 1024; i += G * 512) { const int c = i & 1023, j = (i >> 10) % 3, b = i / 3072; P.out[O_ACP + i] = bf2f(U[(size_t)(b * 2048 + 2045 + j) * N0 + c]); }
      for (int i = bid * 512 + tid; i < 8 * 3 * 1536; i += G * 512) { const int c = i % 1536, j = (i / 1536) % 3, b = i / 4608; P.out[O_BCP + i] = bf2f(U[(size_t)(b * 2048 + 2045 + j) * N0 + 3072 + c]); }
      for (int i = bid * 512 + tid; i < 128 * 3 * 1024; i += G * 512) { const int c = i & 1023, j = (i >> 10) % 3, b = i / 3072; P.out[O_ACS + i] = j < 2 ? P.in[5][(size_t)(b * 3 + j + 1) * 1024 + c] : bf2f(U[(size_t)(MP + b) * N0 + c]); }
      for (int i = bid * 512 + tid; i < 128 * 3 * 1536; i += G * 512) { const int c = i % 1536, j = (i / 1536) % 3, b = i / 4608; P.out[O_BCS + i] = j < 2 ? P.in[7][(size_t)(b * 3 + j + 1) * 1536 + c] : bf2f(U[(size_t)(MP + b) * N0 + 3072 + c]); } }
    if (bid < 128) rglru_item<false>(P, L, bid); else if (bid < 256) ssd_prompt_item(P, L, bid - 128);
    unsigned* ctr = WSP(unsigned, OFF_CTL);
    unsigned* bc = (unsigned*)(L + LDS_BYTES - 16);
    for (;;) {
        __syncthreads();
        if (tid == 0) bc[0] = atomicAdd(ctr, 1u);
        __syncthreads();
        const unsigned it = bc[0];
        if (it >= 16u + 512u) break;
        if (it < 16u) rglru_item<true>(P, L, (int)it); else ssd_sample_item4(P, L, (int)(it - 16u));
    }
    for (;;) {
        __syncthreads();
        if (tid == 0) bc[0] = atomicAdd(ctr + 32, 1u);
        __syncthreads();
        const unsigned q = bc[0];
        if (q >= 464u + 260u) break;
        if (q < 464u) l1_weight_tile(P, (int)q * 8 + (tid >> 6), (float*)L + (tid >> 6) * (64 * 65), tid & 63);
        else { const int c = (int)q - 464; convert_p_chunk(P, c >= 130, c >= 130 ? c - 130 : c, tid); }
    }
}
DI void phase_norm0(const Params& P) {
    bf16_t* MIX = WSP(bf16_t, OFF_MIX); const float* SSB = WSP(float, OFF_SSB);
    for (int i = blockIdx.x * 512 + threadIdx.x; i < MV * 128; i += gridDim.x * 512) {
        const int row = i >> 7, c8 = (i & 127) * 8, g = c8 >> 9;
        const float sc = rsqrtf(SSB[(size_t)row * 2 + g] * (1.f / 512.f) + EPSF);
        uint4* p = (uint4*)(MIX + (size_t)row * 2048 + 1024 + c8); uint4 w = *p;
        w.x = pack2(bflo(w.x) * sc, bfhi(w.x) * sc); w.y = pack2(bflo(w.y) * sc, bfhi(w.y) * sc); w.z = pack2(bflo(w.z) * sc, bfhi(w.z) * sc); w.w = pack2(bflo(w.w) * sc, bfhi(w.w) * sc);
        *p = w;
    }
}

DI void hgrn_prompt_item(const Params& P, unsigned char* L, int item) {
    const int b = item >> 4, h = item & 15;
    const int tid = otid(), lane = tid & 63, wid = tid >> 6, hh = lane >> 5, l31 = lane & 31;
    bf16_t* Qs = (bf16_t*)L;
    bf16_t* Ks = Qs + 64 * 136;
    float* Of = (float*)L;
    bf16_t* KsT = Ks + 64 * 136;
    bf16_t* VsT = KsT + 128 * 72;
    bf16_t* SsT = VsT + 128 * 72;
    bf16_t* As = SsT + 128 * 136;
    float* Gseg = (float*)(As + 64 * 72);
    float* E1 = Gseg + 16 * 128; float* E2 = E1 + 128;
    const bf16_t* U = WSP(bf16_t, OFF_U); bf16_t* MIX = WSP(bf16_t, OFF_MIX);
    const int kq = tid & 31, ts = tid >> 5;
    float lb[4];
#pragma unroll
    for (int e = 0; e < 4; ++e) { const int ch = h * 128 + kq * 4 + e; lb[e] = sigm(P.in[27][2048 + ch] - P.in[27][ch]); }
    const int kb = (wid >> 1) * 32, vb0 = (wid & 1) * 64;
    f32x16 accS[2];
#pragma unroll
    for (int i = 0; i < 16; ++i) { accS[0][i] = 0.f; accS[1][i] = 0.f; }
    uint2 rq[4], rf[4], rv[4];
#define HG_LOAD(cc) do { _Pragma("unroll") for (int i = 0; i < 4; ++i) { const bf16_t* bp = U + (size_t)(b * 2048 + (cc) * 64 + ts * 4 + i) * INC + h * 128 + kq * 4; \
        rq[i] = *(const uint2*)bp; rf[i] = *(const uint2*)(bp + 2048); rv[i] = *(const uint2*)(bp + 4096); } } while (0)
    HG_LOAD(0);
    lds_barrier();
    for (int c = 0; c < 32; ++c) {
        u32x4 gpre0, gpre1;
        { const bf16_t* gp = U + (size_t)(b * 2048 + c * 64 + (tid >> 3)) * INC + 6144 + h * 128 + (tid & 7) * 16; gpre0 = *(const u32x4*)gp; gpre1 = *(const u32x4*)(gp + 8); }
        float kk[4][4], cs[4][4];
#pragma unroll
        for (int i = 0; i < 4; ++i) {
            const float fx[4] = {bflo(rf[i].x), bfhi(rf[i].x), bflo(rf[i].y), bfhi(rf[i].y)};
#pragma unroll
            for (int e = 0; e < 4; ++e) {
                const float sg = sigm(fx[e]); const float kv = (1.f - lb[e]) * (1.f - sg);
                kk[i][e] = kv; const float gl = __logf(1.f - kv);
                cs[i][e] = (i == 0 ? 0.f : cs[i - 1][e]) + gl;
            }
        }
        *(f32x4*)(Gseg + ts * 128 + kq * 4) = (f32x4){cs[3][0], cs[3][1], cs[3][2], cs[3][3]};
        lds_barrier();
        f32x4 off = {0.f, 0.f, 0.f, 0.f}, gmid = off, glast = off;
        {
            const int swid = __builtin_amdgcn_readfirstlane(tid >> 6);
            f32x4 pre = {0.f, 0.f, 0.f, 0.f};
#pragma unroll
            for (int s = 0; s < 16; ++s) {
                const f32x4 v = *(const f32x4*)(Gseg + s * 128 + kq * 4);
                if (s == 2 * swid) off = pre;
                if (s == 8) gmid = pre;
                pre += v;
            }
            glast = pre;
            if (ts & 1) off += *(const f32x4*)(Gseg + (ts - 1) * 128 + kq * 4);
        }
        {
            float qt[4][4], kt[4][4], vt[4][4];
#pragma unroll
            for (int i = 0; i < 4; ++i) {
                const float q[4] = {bflo(rq[i].x), bfhi(rq[i].x), bflo(rq[i].y), bfhi(rq[i].y)};
                vt[i][0] = bflo(rv[i].x); vt[i][1] = bfhi(rv[i].x); vt[i][2] = bflo(rv[i].y); vt[i][3] = bfhi(rv[i].y);
#pragma unroll
                for (int e = 0; e < 4; ++e) { const float Gv = off[e] + cs[i][e]; const float ex = __expf(Gv - gmid[e]); qt[i][e] = q[e] * 0.08838834764831845f * ex; kt[i][e] = kk[i][e] * frcp(ex); }
                *(uint2*)(Qs + (ts * 4 + i) * 136 + kq * 4) = pack4(qt[i][0], qt[i][1], qt[i][2], qt[i][3]);
                *(uint2*)(Ks + (ts * 4 + i) * 136 + kq * 4) = pack4(kt[i][0], kt[i][1], kt[i][2], kt[i][3]);
            }
#pragma unroll
            for (int e = 0; e < 4; ++e) {
                *(uint2*)(KsT + (kq * 4 + e) * 72 + ts * 4) = pack4(kt[0][e], kt[1][e], kt[2][e], kt[3][e]);
                *(uint2*)(VsT + (kq * 4 + e) * 72 + ts * 4) = pack4(vt[0][e], vt[1][e], vt[2][e], vt[3][e]);
            }
            if (ts == 0) {
#pragma unroll
                for (int e = 0; e < 4; ++e) { E1[kq * 4 + e] = __expf(gmid[e]); E2[kq * 4 + e] = __expf(glast[e] - gmid[e]); }
            }
        }
        if (c + 1 < 32) HG_LOAD(c + 1);
        lds_barrier();
#pragma unroll
        for (int j = 0; j < 2; ++j) {
#pragma unroll
            for (int reg = 0; reg < 16; ++reg) accS[j][reg] *= E1[kb + crow(reg, hh)];
            const int v = vb0 + j * 32 + l31;
#pragma unroll
            for (int rg = 0; rg < 4; ++rg) *(uint2*)(SsT + v * 136 + kb + 8 * rg + 4 * hh) = pack4(accS[j][4 * rg], accS[j][4 * rg + 1], accS[j][4 * rg + 2], accS[j][4 * rg + 3]);
        }
        if (wid < 4) {
            const int tb = (wid >> 1) * 32, sb = (wid & 1) * 32;
            f32x16 aa;
#pragma unroll
            for (int i = 0; i < 16; ++i) aa[i] = 0.f;
#pragma unroll
            for (int ks = 0; ks < 8; ++ks) aa = MFMA32(ldfrag(Qs, 136, tb, ks * 16, lane), ldfrag(Ks, 136, sb, ks * 16, lane), aa);
            const int s = sb + l31;
#pragma unroll
            for (int reg = 0; reg < 16; ++reg) { const int t = tb + crow(reg, hh); As[t * 72 + s] = f2bf(s <= t ? aa[reg] : 0.f); }
        }
        lds_barrier();
        const int tb2 = (wid >> 2) * 32, vb2 = (wid & 3) * 32;
        f32x16 o;
#pragma unroll
        for (int i = 0; i < 16; ++i) o[i] = 0.f;
#pragma unroll
        for (int ks = 0; ks < 8; ++ks) o = MFMA32(ldfrag(Qs, 136, tb2, ks * 16, lane), ldfrag(SsT, 136, vb2, ks * 16, lane), o);
#pragma unroll
        for (int ks = 0; ks < 4; ++ks) o = MFMA32(ldfrag(As, 72, tb2, ks * 16, lane), ldfrag(VsT, 72, vb2, ks * 16, lane), o);
#pragma unroll
        for (int j = 0; j < 2; ++j) {
#pragma unroll
            for (int ks = 0; ks < 4; ++ks) accS[j] = MFMA32(ldfrag(KsT, 72, kb, ks * 16, lane), ldfrag(VsT, 72, vb0 + j * 32, ks * 16, lane), accS[j]);
#pragma unroll
            for (int reg = 0; reg < 16; ++reg) accS[j][reg] *= E2[kb + crow(reg, hh)];
        }
        lds_barrier();
#pragma unroll
        for (int reg = 0; reg < 16; ++reg) Of[(tb2 + crow(reg, hh)) * 132 + vb2 + l31] = o[reg];
        lds_barrier();
        {
            const int t = tid >> 3, vs = tid & 7;
            const size_t row = (size_t)(b * 2048 + c * 64 + t);
            f32x4 ov[4]; float ss = 0.f;
#pragma unroll
            for (int i = 0; i < 4; ++i) { ov[i] = *(const f32x4*)(Of + t * 132 + vs * 16 + i * 4); ss += ov[i][0] * ov[i][0] + ov[i][1] * ov[i][1] + ov[i][2] * ov[i][2] + ov[i][3] * ov[i][3]; }
            ss += __shfl_xor(ss, 1); ss += __shfl_xor(ss, 2); ss += __shfl_xor(ss, 4);
            const float rstd = rsqrtf(ss * (1.f / 128.f) + EPSF);
            const float* nwp = P.in[28] + h * 128 + vs * 16;
            const unsigned gw[8] = {gpre0.x, gpre0.y, gpre0.z, gpre0.w, gpre1.x, gpre1.y, gpre1.z, gpre1.w};
            unsigned ow[8];
#pragma unroll
            for (int i = 0; i < 4; ++i) {
                const f32x4 w = *(const f32x4*)(nwp + i * 4);
                ow[2 * i] = pack2(ov[i][0] * rstd * w[0] * silu(bflo(gw[2 * i])), ov[i][1] * rstd * w[1] * silu(bfhi(gw[2 * i])));
                ow[2 * i + 1] = pack2(ov[i][2] * rstd * w[2] * silu(bflo(gw[2 * i + 1])), ov[i][3] * rstd * w[3] * silu(bfhi(gw[2 * i + 1])));
            }
            bf16_t* op = MIX + row * 2048 + h * 128 + vs * 16;
            *(uint4*)op = make_uint4(ow[0], ow[1], ow[2], ow[3]); *(uint4*)(op + 8) = make_uint4(ow[4], ow[5], ow[6], ow[7]);
        }
        lds_barrier();
    }
#undef HG_LOAD
    float* so = P.out + O_CP + (size_t)(b * 16 + h) * 128 * 128;
#pragma unroll
    for (int j = 0; j < 2; ++j)
#pragma unroll
        for (int reg = 0; reg < 16; ++reg) so[(kb + crow(reg, hh)) * 128 + vb0 + j * 32 + l31] = accS[j][reg];
}
DI void hgrn_sample_item(const Params& P, unsigned char* L, int item) {
    const int b = item >> 4, h = item & 15, tid = otid(), lane = tid & 63;
    float* qv = (float*)L; float* egv = qv + 128; float* kkv = egv + 128; float* vv = kkv + 128; float* part = vv + 128; float* red = part + 16 * 128;
    const bf16_t* U = WSP(bf16_t, OFF_U); bf16_t* MIX = WSP(bf16_t, OFF_MIX);
    const size_t row = (size_t)(MP + b); const bf16_t* ub = U + row * INC + h * 128;
    __syncthreads();
    if (tid < 128) {
        const int ch = h * 128 + tid;
        const float lbv = sigm(P.in[27][2048 + ch] - P.in[27][ch]);
        const float sg = sigm(bf2f(ub[2048 + tid])); const float kv = (1.f - lbv) * (1.f - sg);
        qv[tid] = bf2f(ub[tid]) * 0.08838834764831845f; egv[tid] = 1.f - kv; kkv[tid] = kv;
    } else if (tid < 256) vv[tid - 128] = bf2f(ub[4096 + tid - 128]);
    __syncthreads();
    const float* s0 = P.in[8] + (size_t)(b * 16 + h) * 128 * 128; float* s1 = P.out + O_CS + (size_t)(b * 16 + h) * 128 * 128;
    const int v4 = (tid & 31) * 4; const f32x4 vq = *(const f32x4*)(vv + v4);
    f32x4 op = {0.f, 0.f, 0.f, 0.f};
#pragma unroll
    for (int j = 0; j < 8; ++j) {
        const int k = (tid >> 5) + 16 * j;
        const f32x4 s = *(const f32x4*)(s0 + k * 128 + v4);
        const f32x4 sn = s * egv[k] + vq * kkv[k];
        *(f32x4*)(s1 + k * 128 + v4) = sn;
        op += sn * qv[k];
    }
    *(f32x4*)(part + (tid >> 5) * 128 + v4) = op;
    __syncthreads();
    float o = 0.f;
    if (tid < 128) {
#pragma unroll
        for (int i = 0; i < 16; ++i) o += part[i * 128 + tid];
        const float ss = wave_sum(o * o);
        if (lane == 0) red[tid >> 6] = ss;
    }
    __syncthreads();
    if (tid < 128) {
        const float rstd = rsqrtf((red[0] + red[1]) * (1.f / 128.f) + EPSF);
        const int ch = h * 128 + tid;
        MIX[row * 2048 + ch] = f2bf(o * rstd * P.in[28][ch] * silu(bf2f(ub[6144 + tid])));
    }
}
DI void phase_mix1(const Params& P, unsigned char* L) {
    const int tid = otid(), bid = blockIdx.x;
    if (bid < 128) hgrn_prompt_item(P, L, bid);
    else { const int nb = gridDim.x - 128; for (int it = bid - 128; it < 2048; it += nb) hgrn_sample_item(P, L, it); }
}
DI void phase_final(const Params& P) {
    const int lane = threadIdx.x & 63, gw = blockIdx.x * 8 + (threadIdx.x >> 6), nwv = gridDim.x * 8;
    const float* H = WSP(float, OFF_H); const float* SS = WSP(float, OFF_SS2); const float* nf = P.in[10];
    f32x4 w4[4];
#pragma unroll
    for (int i = 0; i < 4; ++i) w4[i] = *(const f32x4*)(nf + lane * 4 + 256 * i);
    for (int r = gw; r < MV; r += nwv) {
        const float rstd = rsqrtf(SS[r] * (1.f / 1024.f) + EPSF);
#pragma unroll
        for (int i = 0; i < 4; ++i) { const f32x4 v = *(const f32x4*)(H + (size_t)r * 1024 + lane * 4 + 256 * i); *(f32x4*)(P.out + O_Y + (size_t)r * 1024 + lane * 4 + 256 * i) = v * rstd * w4[i]; }
    }
}

#define XB_TMO      128
#define XB_XCNT(j)  (256  + 64 * (j))
#define XB_XSUB(j)  (1280 + 64 * (j))
#define XB_XGEN(j)  (2304 + 64 * (j))
#define XB_TOP      3328
#define XB_TOPGEN   3392
#define XCD_BAR_WORDS 3456
#define XB_SPIN_CAP (1u << 18)

__device__ __forceinline__ unsigned xb_ld(unsigned* p)              { return __hip_atomic_load(p, __ATOMIC_RELAXED, __HIP_MEMORY_SCOPE_AGENT); }
__device__ __forceinline__ unsigned xb_add(unsigned* p, unsigned v) { return __hip_atomic_fetch_add(p, v, __ATOMIC_RELAXED, __HIP_MEMORY_SCOPE_AGENT); }
__device__ __forceinline__ unsigned xb_xcc_id() { return (unsigned)__builtin_amdgcn_s_getreg((3 << 11) | 20) & 0xFu; }
#define XB_SPIN(cond, bar) do { unsigned _sp = 0; while (cond) { __builtin_amdgcn_s_sleep(1); \
    if ((++_sp & 255u) == 0u) { if (xb_ld(&(bar)[XB_TMO])) break; if (_sp > XB_SPIN_CAP) { atomicAdd(&(bar)[XB_TMO], 1u); break; } } } } while (0)

struct XcdBarrier {
    unsigned* bar; unsigned x;
    volatile LAS unsigned* st;
};

__device__ __forceinline__ XcdBarrier xcd_barrier_post(unsigned* bar, volatile LAS unsigned* st) {
    XcdBarrier b; b.bar = bar; b.x = xb_xcc_id(); b.st = st;
    if (threadIdx.x == 0) (void)xb_add(&bar[XB_XCNT(b.x)], 1u);
    return b;
}
__device__ __forceinline__ void xcd_barrier_complete(unsigned* bar, unsigned x, unsigned& nloc, unsigned& nx) {
    const unsigned G = gridDim.x * gridDim.y * gridDim.z;
    unsigned sum, cnt, mine, sp = 0u;
    for (;;) {
        sum = 0u; cnt = 0u; mine = 0u;
#pragma unroll
        for (unsigned j = 0; j < 16; ++j) { const unsigned c = xb_ld(&bar[XB_XCNT(j)]); sum += c; cnt += (c > 0u) ? 1u : 0u; mine = (j == x) ? c : mine; }
        if (sum == G) break;
        __builtin_amdgcn_s_sleep(1);
        if ((++sp & 255u) == 0u) { if (xb_ld(&bar[XB_TMO])) break; if (sp > XB_SPIN_CAP) { atomicAdd(&bar[XB_TMO], 1u); break; } }
    }
    nloc = mine > 0u ? mine : 1u; nx = cnt > 0u ? cnt : 1u;
}

__device__ __forceinline__ void xcd_barrier(const XcdBarrier& b) {
    asm volatile("s_waitcnt vmcnt(0)" ::: "memory");
    __syncthreads();
    if (threadIdx.x == 0) {
        unsigned* bar = b.bar;
        __builtin_amdgcn_s_waitcnt(0);
        unsigned nloc = b.st[0], nx = b.st[1];
        if (nloc == 0u) { xcd_barrier_complete(bar, b.x, nloc, nx); b.st[0] = nloc; b.st[1] = nx; }
        const unsigned old = xb_add(&bar[XB_XSUB(b.x)], 1u);
        const unsigned gen = old / nloc;
        if (old + 1u == (gen + 1u) * nloc) {
            __builtin_amdgcn_fence(__ATOMIC_RELEASE, "agent");
            asm volatile("s_waitcnt vmcnt(0)" ::: "memory");
            const unsigned og = xb_add(&bar[XB_TOP], 1u);
            const unsigned tg = og / nx;
            if (og + 1u == (tg + 1u) * nx) xb_add(&bar[XB_TOPGEN], 1u);
            else XB_SPIN(xb_ld(&bar[XB_TOPGEN]) == tg, bar);
            __builtin_amdgcn_fence(__ATOMIC_ACQUIRE, "agent");
            xb_add(&bar[XB_XGEN(b.x)], 1u);
            asm volatile("s_waitcnt vmcnt(0)" ::: "memory");
        } else {
            XB_SPIN(xb_ld(&bar[XB_XGEN(b.x)]) == gen, bar);
            __builtin_amdgcn_fence(__ATOMIC_ACQUIRE, "agent");
            asm volatile("s_waitcnt vmcnt(0)" ::: "memory");
        }
    }
    __syncthreads();
}


#ifndef PHM
#define PHM 0xFFFF
#endif
typedef const __attribute__((address_space(4))) Params* ParamsK;
DI Params getp() {
    ParamsK pp = (ParamsK)__builtin_amdgcn_kernarg_segment_ptr(); asm volatile("" : "+s"(pp));
    Params P;
#pragma unroll
    for (int i = 0; i < 32; ++i) P.in[i] = pp->in[i];
    P.out = pp->out; P.ws = pp->ws; return P;
}
#define GETP() const Params P = getp()
__global__ void __launch_bounds__(512, 2) fwd_kernel(Params Parg) {
    extern __shared__ __attribute__((aligned(16))) unsigned char lds[];
    cg::grid_group grid = cg::this_grid();
    unsigned char* L = (unsigned char*)lds;
    LAS unsigned char* LL = (LAS unsigned char*)lds;
    volatile LAS unsigned* xst = (volatile LAS unsigned*)(LL + LDS_BYTES - 32);
    if (threadIdx.x < 2) xst[threadIdx.x] = 0u;
    __syncthreads();
    XcdBarrier xb;
    { GETP(); xb = xcd_barrier_post(WSP(unsigned, OFF_BAR), xst); }
    if (PHM & 1) { GETP(); phase_prep(P, L); }
    if (gridDim.y == 0xFFFFu) grid.sync();
    xcd_barrier(xb);
    if (PHM & 2) { GETP(); pg8::StaticOrder S; S.init(MP, N0 + 256, gridDim.x, blockIdx.x); pg8::Gemm g{WSP(bf16_t, OFF_XN), WSP(bf16_t, OFF_W0T), MP, N0 + 256, 1024};
      EpiStoreBf16 E{WSP(bf16_t, OFF_U), N0, nullptr, WSP(float, OFF_DT)}; pg8::gemm_phase(LL, g, S, E); }
    { GETP(); SfU f{WSP(bf16_t, OFF_U), N0, nullptr, WSP(float, OFF_DT)}; sgemm<4>(WSP(bf16_t, OFF_XN), WSP(bf16_t, OFF_W0T), 1024, 145, 64 * 19, f, L); }
    xcd_barrier(xb);
    { GETP(); phase_convbc(P); }
    xcd_barrier(xb);
    if (PHM & 4) { GETP(); phase_mix0(P, L); }
    xcd_barrier(xb);
    { GETP(); phase_norm0(P); }
    xcd_barrier(xb);
    if (PHM & 8) { GETP(); pg8::StaticOrder S; S.init(MP, 1024, gridDim.x, blockIdx.x); pg8::Gemm g{WSP(bf16_t, OFF_MIX), WSP(bf16_t, OFF_WO0T), MP, 1024, 2048};
      EpiResid E{P.in[0], P.in[1], WSP(float, OFF_H), WSP(bf16_t, OFF_HB)}; pg8::gemm_phase(LL, g, S, E); }
    { GETP(); SfResid f{P.in[1], WSP(float, OFF_H), WSP(bf16_t, OFF_HB)}; sgemm<4>(WSP(bf16_t, OFF_MIX), WSP(bf16_t, OFF_WO0T), 2048, 32, 256, f, L); }
    xcd_barrier(xb);
    if (PHM & 16) { GETP(); pg8::StaticOrder S; S.init(MP, 1024, gridDim.x, blockIdx.x);
      pg8::Gemm g1{WSP(bf16_t, OFF_HB), WSP(bf16_t, OFF_WG0T), MP, 1024, 1024}; EpiGate E1{WSP(float, OFF_MIX)}; pg8::gemm_phase(LL, g1, S, E1); }
    { GETP(); SfGate f{WSP(float, OFF_MIX)};   sgemm<2>(WSP(bf16_t, OFF_HB), WSP(bf16_t, OFF_WG0T), 1024, 32, 256, f, L); }
    if (PHM & 16) { GETP(); pg8::StaticOrder S; S.init(MP, 1024, gridDim.x, blockIdx.x);
      pg8::Gemm g2{WSP(bf16_t, OFF_PB), WSP(bf16_t, OFF_WP0T), MP, 1024, 256};
      EpiPle E2{WSP(float, OFF_H), WSP(float, OFF_MIX), WSP(bf16_t, OFF_XN), P.in[9] + 1024, WSP(float, OFF_SS1)}; pg8::gemm_phase(LL, g2, S, E2); }
    { GETP(); SfPle f{WSP(float, OFF_H), WSP(float, OFF_MIX), WSP(bf16_t, OFF_XN), P.in[9] + 1024, WSP(float, OFF_SS1)}; sgemm<2>(WSP(bf16_t, OFF_PB), WSP(bf16_t, OFF_WP0T), 256, 32, 256, f, L); }
    xcd_barrier(xb);
    if (PHM & 32) { GETP(); pg8::StaticOrder S; S.init(MP, INC, gridDim.x, blockIdx.x); pg8::Gemm g{WSP(bf16_t, OFF_XN), WSP(bf16_t, OFF_W1T), MP, INC, 1024};
      EpiStoreBf16 E{WSP(bf16_t, OFF_U), INC, WSP(float, OFF_SS1), nullptr}; pg8::gemm_phase(LL, g, S, E); }
    { GETP(); SfU f{WSP(bf16_t, OFF_U), INC, WSP(float, OFF_SS1), nullptr}; sgemm<4>(WSP(bf16_t, OFF_XN), WSP(bf16_t, OFF_W1T), 1024, 256, 64 * 32, f, L); }
    xcd_barrier(xb);
    if (PHM & 64) { GETP(); phase_mix1(P, L); }
    xcd_barrier(xb);
    if (PHM & 128) { GETP(); pg8::StaticOrder S; S.init(MP, 1024, gridDim.x, blockIdx.x); pg8::Gemm g{WSP(bf16_t, OFF_MIX), WSP(bf16_t, OFF_WO1T), MP, 1024, 2048};
      EpiResid E{WSP(float, OFF_H), WSP(float, OFF_H) + (size_t)MP * 1024, WSP(float, OFF_H), WSP(bf16_t, OFF_HB)}; pg8::gemm_phase(LL, g, S, E); }
    { GETP(); SfResid f{WSP(float, OFF_H) + (size_t)MP * 1024, WSP(float, OFF_H), WSP(bf16_t, OFF_HB)}; sgemm<4>(WSP(bf16_t, OFF_MIX), WSP(bf16_t, OFF_WO1T), 2048, 32, 256, f, L); }
    xcd_barrier(xb);
    if (PHM & 256) { GETP(); pg8::StaticOrder S; S.init(MP, 1024, gridDim.x, blockIdx.x);
      pg8::Gemm g1{WSP(bf16_t, OFF_HB), WSP(bf16_t, OFF_WG1T), MP, 1024, 1024}; EpiGate E1{WSP(float, OFF_MIX)}; pg8::gemm_phase(LL, g1, S, E1); }
    { GETP(); SfGate f{WSP(float, OFF_MIX)};   sgemm<2>(WSP(bf16_t, OFF_HB), WSP(bf16_t, OFF_WG1T), 1024, 32, 256, f, L); }
    if (PHM & 256) { GETP(); pg8::StaticOrder S; S.init(MP, 1024, gridDim.x, blockIdx.x);
      pg8::Gemm g2{WSP(bf16_t, OFF_PB + PB_STRIDE), WSP(bf16_t, OFF_WP1T), MP, 1024, 256};
      EpiPle E2{WSP(float, OFF_H), WSP(float, OFF_MIX), nullptr, nullptr, WSP(float, OFF_SS2)}; pg8::gemm_phase(LL, g2, S, E2); }
    { GETP(); SfPle f{WSP(float, OFF_H), WSP(float, OFF_MIX), nullptr, nullptr, WSP(float, OFF_SS2)}; sgemm<2>(WSP(bf16_t, OFF_PB + PB_STRIDE), WSP(bf16_t, OFF_WP1T), 256, 32, 256, f, L); }
    xcd_barrier(xb);
    { GETP(); phase_final(P); }
}

extern "C" void kernel_launch(void* const* d_in, const int* in_sizes, int n_in, void* d_out, int out_size, void* d_ws, size_t ws_size, hipStream_t stream) {
    static int grid = 0;
    if (grid == 0) {
        if (n_in != 32 || ws_size < WS_END) { fprintf(stderr, "kernel_launch: need 32 inputs and %zu bytes of workspace (got %d, %zu)\n", (size_t)WS_END, n_in, ws_size); grid = -1; return; }
        int dev = 0, cus = 0, per_cu = 0;
        (void)hipGetDevice(&dev); (void)hipDeviceGetAttribute(&cus, hipDeviceAttributeMultiprocessorCount, dev);
        if (hipFuncSetAttribute((const void*)fwd_kernel, hipFuncAttributeMaxDynamicSharedMemorySize, LDS_BYTES) != hipSuccess) { fprintf(stderr, "kernel_launch: hipFuncSetAttribute failed\n"); grid = -1; return; }
        if (hipOccupancyMaxActiveBlocksPerMultiprocessor(&per_cu, (const void*)fwd_kernel, 512, LDS_BYTES) != hipSuccess || per_cu < 1) { fprintf(stderr, "kernel_launch: occupancy query says %d\n", per_cu); per_cu = 1; }
        (void)hipGetLastError();
        grid = cus;
    }
    if (grid < 0) return;
    Params p{};
    for (int i = 0; i < 32; ++i) p.in[i] = (const float*)d_in[i];
    p.out = (float*)d_out; p.ws = (unsigned char*)d_ws;
    if (hipMemsetAsync((char*)d_ws + OFF_BAR, 0, 16384, stream) != hipSuccess) { fprintf(stderr, "kernel_launch: memset of barrier words failed\n"); return; }
    void* args[] = {&p};
    hipError_t e = hipLaunchCooperativeKernel((const void*)fwd_kernel, dim3(grid), dim3(512), args, LDS_BYTES, stream);
    if (e != hipSuccess) fprintf(stderr, "cooperative launch failed: %s (grid %d)\n", hipGetErrorString(e), grid);
}
```

```cpp
#include <hip/hip_runtime.h>
#include <hip/hip_cooperative_groups.h>
#include <cstdio>
namespace cg = cooperative_groups;

#define LAS __attribute__((address_space(3)))
#define DI __device__ __forceinline__
typedef unsigned short bf16_t;
typedef short bf16x8 __attribute__((ext_vector_type(8)));
typedef float f32x4 __attribute__((ext_vector_type(4)));
typedef float f32x16 __attribute__((ext_vector_type(16)));

constexpr int MP = 16384, MS = 128, MV = MP + MS, MPAD = 16640;
constexpr int DM = 1024, INAB = 4624, N0 = 4608, INC = 8192;
constexpr float EPSF = 1e-6f;
constexpr size_t O_Y = 0, O_AHP = 16908288, O_ACP = 16916480, O_BSP = 16941056, O_BCP = 17989632, O_CP = 18026496,
                 O_AHS = 20123648, O_ACS = 20254720, O_BSS = 20647936, O_BCS = 37425152, O_CS = 38014976;
constexpr size_t al256(size_t x) { return (x + 255) & ~size_t(255); }
constexpr size_t OFF_CTL = 0;
constexpr size_t OFF_BAR = 256;
constexpr size_t OFF_SS1 = 256 + 16384;
constexpr size_t OFF_SS2 = OFF_SS1 + al256((size_t)MPAD * 4);
constexpr size_t OFF_SSB = OFF_SS2 + al256((size_t)MPAD * 4);
constexpr size_t OFF_DT  = OFF_SSB + al256((size_t)MPAD * 8);
constexpr size_t OFF_W0T = OFF_DT + al256((size_t)MV * 16 * 4);
constexpr size_t OFF_WO0T = OFF_W0T + (size_t)(N0 + 256) * 1024 * 2;
constexpr size_t OFF_WG0T = OFF_WO0T + (size_t)1024 * 2048 * 2;
constexpr size_t OFF_WP0T = OFF_WG0T + (size_t)1024 * 1024 * 2;
constexpr size_t OFF_W1T  = OFF_WP0T + (size_t)1024 * 256 * 2;
constexpr size_t OFF_WO1T = OFF_W1T + (size_t)INC * 1024 * 2;
constexpr size_t OFF_WG1T = OFF_WO1T + (size_t)1024 * 2048 * 2;
constexpr size_t OFF_WP1T = OFF_WG1T + (size_t)1024 * 1024 * 2;
constexpr size_t OFF_WRT  = OFF_WP1T + (size_t)1024 * 256 * 2;
constexpr size_t OFF_WIT  = OFF_WRT + (size_t)128 * 1024 * 2;
constexpr size_t OFF_XN   = OFF_WIT + (size_t)128 * 1024 * 2;
constexpr size_t OFF_MIX  = OFF_XN + (size_t)MPAD * 1024 * 2;
constexpr size_t OFF_H    = OFF_MIX + (size_t)MPAD * 2048 * 2;
constexpr size_t OFF_U    = OFF_H + al256((size_t)MV * 1024 * 4);
constexpr size_t OFF_HB   = OFF_U;
constexpr size_t OFF_PB   = OFF_U + al256((size_t)MV * INC * 2);
constexpr size_t PB_STRIDE = (size_t)MPAD * 256 * 2;
constexpr size_t WS_END   = OFF_PB + 2 * PB_STRIDE;
constexpr int LDS_BYTES = 160 * 1024;

struct Params { const float* in[32]; float* out; unsigned char* ws; };
#define WSP(T, off) ((T*)(P.ws + (off)))

typedef __bf16 bf16v2_t __attribute__((ext_vector_type(2)));
typedef float f32v2_t __attribute__((ext_vector_type(2)));
DI unsigned pack2(float lo, float hi) { f32v2_t v = {lo, hi}; bf16v2_t b = __builtin_convertvector(v, bf16v2_t); return __builtin_bit_cast(unsigned, b); }
DI bf16_t f2bf(float f) { return __builtin_bit_cast(bf16_t, (__bf16)f); }
DI float bf2f(bf16_t b) { return __uint_as_float(((unsigned)b) << 16); }
DI float bflo(unsigned w) { return __uint_as_float(w << 16); }
DI float bfhi(unsigned w) { return __uint_as_float(w & 0xFFFF0000u); }
DI float frcp(float x) { return __builtin_amdgcn_rcpf(x); }
DI float sigm(float x) { return frcp(1.f + __expf(-x)); }
DI float silu(float x) { return x * frcp(1.f + __expf(-x)); }
DI float softplus(float x) { return x > 20.f ? x : log1pf(__expf(x)); }
DI float wave_sum(float v) { for (int o = 32; o > 0; o >>= 1) v += __shfl_xor(v, o); return v; }
DI int otid() { int t = threadIdx.x; asm volatile("" : "+v"(t)); return t; }
DI void lds_barrier() { asm volatile("s_waitcnt lgkmcnt(0)" ::: "memory"); __builtin_amdgcn_s_barrier(); asm volatile("" ::: "memory"); }
DI int crow(int reg, int hh) { return (reg & 3) + 8 * (reg >> 2) + 4 * hh; }
DI void ld4bf(const bf16_t* p, float (&o)[4]) { uint2 w = *(const uint2*)p; o[0] = bflo(w.x); o[1] = bfhi(w.x); o[2] = bflo(w.y); o[3] = bfhi(w.y); }
typedef unsigned u32x2 __attribute__((ext_vector_type(2)));
typedef unsigned u32x4 __attribute__((ext_vector_type(4)));
DI u32x2 pack4v(float a, float b, float c, float d) { u32x2 r; r.x = pack2(a, b); r.y = pack2(c, d); return r; }
DI uint2 pack4(float a, float b, float c, float d) { uint2 r; r.x = pack2(a, b); r.y = pack2(c, d); return r; }
#define MFMA32(a, b, c) __builtin_amdgcn_mfma_f32_32x32x16_bf16((a), (b), (c), 0, 0, 0)
#define MFMA16(a, b, c) __builtin_amdgcn_mfma_f32_16x16x32_bf16((a), (b), (c), 0, 0, 0)
DI bf16x8 ldfrag(const bf16_t* base, int ld, int row0, int k0, int lane) { return *(const bf16x8*)(base + (row0 + (lane & 31)) * ld + k0 + 8 * (lane >> 5)); }
DI bf16x8 ldfrag16(const bf16_t* base, int ld, int row0, int k0, int lane) { return *(const bf16x8*)(base + (row0 + (lane & 15)) * ld + k0 + 8 * (lane >> 4)); }

namespace pg8 {
constexpr int BM = 256, BK = 64, HALF = 128, HTB = HALF * BK * 2, STAGE_BYTES = 8 * HTB, NXCD = 8, WGM = 8;
DI int lds_byte(int r, int c) { const int st = (r >> 4) * 2 + (c >> 5), rr = r & 15, cc = c & 31, ob = rr * 64 + cc * 2; return st * 1024 + (ob ^ (((ob >> 9) & 1) << 5)); }
DI void stage_rc(int b, int& R, int& C) { const int st = b / 1024, sb = b % 1024, swz = sb ^ (((sb >> 9) & 1) << 5); R = (st >> 1) * 16 + swz / 64; C = (st & 1) * 32 + (swz % 64) / 2; }
DI int perm32(int rho) { const int n = rho >> 4, i = rho & 15; return 8 * (i >> 2) + 4 * n + (i & 3); }
struct Unit { int pm, pn; };
struct Gemm { const bf16_t* A; const bf16_t* Bt; int M, N, K; };
struct StaticOrder {
    int nM, nN, nwg, G, c;
    DI void init(int M, int N, int G_, int c_) { nM = M / BM; nN = N / BM; nwg = nM * nN; G = G_; c = c_; }
    DI bool next(int i, Unit& u) const {
        const long L = (long)i * G + c; if (L >= nwg) return false;
        int wgid = (int)L; { const int q = nwg / NXCD, r = nwg % NXCD, xcd = wgid % NXCD, off = wgid / NXCD; wgid = (xcd < r ? xcd * (q + 1) : r * (q + 1) + (xcd - r) * q) + off; }
        const int nig = WGM * nN, gid = wgid / nig, fm = gid * WGM, gsz = (nM - fm) < WGM ? (nM - fm) : WGM;
        u.pm = fm + ((wgid % nig) % gsz); u.pn = (wgid % nig) / gsz; return true;
    }
};

template <class Epi>
DI void gemm_phase(LAS unsigned char* lds, const Gemm g, const StaticOrder& S, const Epi& E) {
    const int tid = otid(), wid = __builtin_amdgcn_readfirstlane(tid >> 6), lane = tid & 63, wr = wid >> 2, wc = wid & 3, fr = lane & 15, fq = lane >> 4;
    const int K = g.K, nt = K / BK;
    unsigned voffA[2], voffB[2];
#pragma unroll
    for (int i = 0; i < 2; ++i) { int R, C; stage_rc(tid * 16 + i * 8192, R, C); const int Rb = Epi::PERM ? ((R & ~31) + perm32(R & 31)) : R;
        voffA[i] = (unsigned)(R * K + C) * 2u; voffB[i] = (unsigned)(Rb * K + C) * 2u; }
    const size_t kstep = (size_t)(BK * 2);
    const size_t hstep = (size_t)HALF * K * 2;
    const size_t tstep = 2 * hstep;
    const unsigned ldsw = (unsigned)wid * 1024u;
    const int aoff = lds_byte(wr * 64 + fr, fq * 8), boff = lds_byte(wc * 32 + fr, fq * 8);
#define PG8_SA(b, h) (((b) * 2 + (h)) * HTB)
#define PG8_SB(b, h) ((4 + (b) * 2 + (h)) * HTB)
#define PG8_STAGE(bufoff, gbase, voff) do { _Pragma("unroll") for (int _i = 0; _i < 2; ++_i) \
        __builtin_amdgcn_global_load_lds((const unsigned*)((const char*)(gbase) + (voff)[_i]), (LAS unsigned*)(lds + (bufoff) + ldsw + _i * 8192), 16, 0, 0); } while (0)
#define PG8_LDA(dst, b, h) do { _Pragma("unroll") for (int m = 0; m < 4; ++m) _Pragma("unroll") for (int k = 0; k < 2; ++k) dst[m][k] = *(const LAS bf16x8*)(lds + PG8_SA(b, h) + aoff + m * 2048 + k * 1024); } while (0)
#define PG8_LDB(dst, b, h) do { _Pragma("unroll") for (int n = 0; n < 2; ++n) _Pragma("unroll") for (int k = 0; k < 2; ++k) dst[n][k] = *(const LAS bf16x8*)(lds + PG8_SB(b, h) + boff + n * 2048 + k * 1024); } while (0)
#define PG8_MMA(ai, bj, At, Bt) do { __builtin_amdgcn_s_setprio(1); _Pragma("unroll") for (int m = 0; m < 4; ++m) _Pragma("unroll") for (int n = 0; n < 2; ++n) _Pragma("unroll") for (int k = 0; k < 2; ++k) \
        acc[ai][bj][m][n] = __builtin_amdgcn_mfma_f32_16x16x32_bf16(Bt[n][k], At[m][k], acc[ai][bj][m][n], 0, 0, 0); __builtin_amdgcn_s_setprio(0); } while (0)
#define PG8_WAIT_V(n) asm volatile("s_waitcnt vmcnt(" #n ")" ::: "memory")
#define PG8_WAIT_L(n) asm volatile("s_waitcnt lgkmcnt(" #n ")" ::: "memory")
#define PG8_BAR __builtin_amdgcn_s_barrier()
#define PG8_SCHED __builtin_amdgcn_sched_barrier(0)
    Unit cur, nxt; int ui = 0;
    if (!S.next(0, cur)) return;
    f32x4 acc[2][2][4][2];
#pragma unroll
    for (int a = 0; a < 2; ++a)
#pragma unroll
        for (int b = 0; b < 2; ++b)
#pragma unroll
            for (int m = 0; m < 4; ++m)
#pragma unroll
                for (int n = 0; n < 2; ++n) acc[a][b][m][n] = (f32x4){0.f, 0.f, 0.f, 0.f};
    bf16x8 At[4][2], B0[2][2], B1[2][2];
    const char* cA = (const char*)g.A + (size_t)cur.pm * tstep; const char* cB = (const char*)g.Bt + (size_t)cur.pn * tstep;
    PG8_STAGE(PG8_SB(0, 0), cB, voffB); PG8_STAGE(PG8_SA(0, 0), cA, voffA); PG8_STAGE(PG8_SB(0, 1), cB + hstep, voffB); PG8_STAGE(PG8_SA(0, 1), cA + hstep, voffA);
    if (wr == 1) PG8_BAR;
    PG8_WAIT_V(4); PG8_BAR;
    PG8_STAGE(PG8_SB(1, 0), cB + kstep, voffB); PG8_STAGE(PG8_SA(1, 0), cA + kstep, voffA); PG8_STAGE(PG8_SB(1, 1), cB + hstep + kstep, voffB);
    PG8_WAIT_V(6); PG8_BAR;
    for (;;) {
        const bool has_next = S.next(ui + 1, nxt);
        const char* nA = has_next ? (const char*)g.A + (size_t)nxt.pm * tstep : cA; const char* nB = has_next ? (const char*)g.Bt + (size_t)nxt.pn * tstep : cB;
        for (int t = 0; t < nt; t += 2) {
            const bool last = (t == nt - 2);
            const char* a1 = cA + (size_t)(t + 1) * kstep;
            const char* a2 = last ? nA : cA + (size_t)(t + 2) * kstep; const char* b2 = last ? nB : cB + (size_t)(t + 2) * kstep;
            const char* a3 = a2 + kstep; const char* b3 = b2 + kstep;
            PG8_LDB(B0, 0, 0); PG8_SCHED; PG8_LDA(At, 0, 0); PG8_STAGE(PG8_SA(1, 1), a1 + hstep, voffA);
            PG8_WAIT_L(8); PG8_BAR; PG8_WAIT_L(0); PG8_MMA(0, 0, At, B0); PG8_BAR; PG8_SCHED;
            PG8_LDB(B1, 0, 1); PG8_STAGE(PG8_SB(0, 0), b2, voffB);
            PG8_BAR; PG8_WAIT_L(0); PG8_MMA(0, 1, At, B1); PG8_BAR;
            PG8_LDA(At, 0, 1); PG8_STAGE(PG8_SA(0, 0), a2, voffA);
            PG8_BAR; PG8_WAIT_L(0); PG8_MMA(1, 0, At, B0); PG8_BAR; PG8_SCHED;
            PG8_STAGE(PG8_SB(0, 1), b2 + hstep, voffB);
            PG8_WAIT_V(6); PG8_BAR; PG8_MMA(1, 1, At, B1); PG8_BAR;
            PG8_LDB(B0, 1, 0); PG8_SCHED; PG8_LDA(At, 1, 0); PG8_STAGE(PG8_SA(0, 1), a2 + hstep, voffA);
            PG8_WAIT_L(8); PG8_BAR; PG8_WAIT_L(0); PG8_MMA(0, 0, At, B0); PG8_BAR; PG8_SCHED;
            PG8_LDB(B1, 1, 1); PG8_STAGE(PG8_SB(1, 0), b3, voffB);
            PG8_BAR; PG8_WAIT_L(0); PG8_MMA(0, 1, At, B1); PG8_BAR;
            PG8_LDA(At, 1, 1); PG8_STAGE(PG8_SA(1, 0), a3, voffA);
            PG8_BAR; PG8_WAIT_L(0); PG8_MMA(1, 0, At, B0); PG8_BAR; PG8_SCHED;
            PG8_STAGE(PG8_SB(1, 1), b3 + hstep, voffB);
            PG8_WAIT_V(6); PG8_BAR; PG8_MMA(1, 1, At, B1); PG8_BAR;
        }
        E(acc, cur, wr, wc, fr, fq);
        if (!has_next) break;
#pragma unroll
        for (int a = 0; a < 2; ++a)
#pragma unroll
            for (int b = 0; b < 2; ++b)
#pragma unroll
                for (int m = 0; m < 4; ++m)
#pragma unroll
                    for (int n = 0; n < 2; ++n) acc[a][b][m][n] = (f32x4){0.f, 0.f, 0.f, 0.f};
        cur = nxt; cA = nA; cB = nB; ++ui;
    }
    PG8_WAIT_V(0);
    if (wr == 0) PG8_BAR;
    PG8_BAR;
#undef PG8_SA
#undef PG8_SB
#undef PG8_STAGE
#undef PG8_LDA
#undef PG8_LDB
#undef PG8_MMA
#undef PG8_WAIT_V
#undef PG8_WAIT_L
#undef PG8_BAR
#undef PG8_SCHED
}
}

struct EpiStoreBf16 {
    static constexpr bool PERM = true;
    bf16_t* O; int ldc; const float* ss; float* DT;
    DI void operator()(const f32x4 (&acc)[2][2][4][2], const pg8::Unit& u, int wr, int wc, int fr, int fq) const {
        const int row0 = u.pm * 256 + wr * 64 + fr, col0 = u.pn * 256 + wc * 32 + 8 * fq;
        if (u.pn * 256 >= ldc) {
            if (wc == 0 && fq < 2) {
#pragma unroll
                for (int ai = 0; ai < 2; ++ai)
#pragma unroll
                    for (int m = 0; m < 4; ++m) { const int row = row0 + ai * 128 + m * 16;
                        if (row < MV) { *(f32x4*)(DT + (size_t)row * 16 + 8 * fq) = acc[ai][0][m][0]; *(f32x4*)(DT + (size_t)row * 16 + 8 * fq + 4) = acc[ai][0][m][1]; } }
            }
            return;
        }
#pragma unroll
        for (int ai = 0; ai < 2; ++ai)
#pragma unroll
            for (int m = 0; m < 4; ++m) {
                const int row = row0 + ai * 128 + m * 16;
                if (row < MV) {
                    const float sc = ss ? rsqrtf(ss[row] * (1.f / 1024.f) + EPSF) : 1.f;
                    bf16_t* rp = O + (size_t)row * ldc + col0;
#pragma unroll
                    for (int bj = 0; bj < 2; ++bj) {
                        const f32x4 v0 = acc[ai][bj][m][0] * sc, v1 = acc[ai][bj][m][1] * sc;
                        uint4 w; w.x = pack2(v0[0], v0[1]); w.y = pack2(v0[2], v0[3]); w.z = pack2(v1[0], v1[1]); w.w = pack2(v1[2], v1[3]);
                        *(uint4*)(rp + bj * 128) = w;
                    }
                }
            }
    }
};
struct EpiResid {
    static constexpr bool PERM = false;
    const float* rp_prompt; const float* rp_sample;
    float* H; bf16_t* HB;
    DI void operator()(const f32x4 (&acc)[2][2][4][2], const pg8::Unit& u, int wr, int wc, int fr, int fq) const {
        const int row0 = u.pm * 256 + wr * 64 + fr, col0 = u.pn * 256 + wc * 32 + 4 * fq;
#pragma unroll
        for (int ai = 0; ai < 2; ++ai)
#pragma unroll
            for (int m = 0; m < 4; ++m) {
                const int row = row0 + ai * 128 + m * 16;
                if (row < MV) {
                    const float* rs = (row < MP ? rp_prompt + (size_t)row * 1024 : rp_sample + (size_t)(row - MP) * 1024) + col0;
                    float* hp = H + (size_t)row * 1024 + col0; bf16_t* bp = HB + (size_t)row * 1024 + col0;
#pragma unroll
                    for (int bj = 0; bj < 2; ++bj)
#pragma unroll
                        for (int n = 0; n < 2; ++n) {
                            const int co = bj * 128 + n * 16;
                            const f32x4 v = acc[ai][bj][m][n] + *(const f32x4*)(rs + co);
                            *(f32x4*)(hp + co) = v; *(uint2*)(bp + co) = pack4(v[0], v[1], v[2], v[3]);
                        }
                }
            }
    }
};
struct EpiGate {
    static constexpr bool PERM = false;
    float* Gt;
    DI void operator()(const f32x4 (&acc)[2][2][4][2], const pg8::Unit& u, int wr, int wc, int fr, int fq) const {
        const int row0 = u.pm * 256 + wr * 64 + fr, col0 = u.pn * 256 + wc * 32 + 4 * fq;
#pragma unroll
        for (int ai = 0; ai < 2; ++ai)
#pragma unroll
            for (int m = 0; m < 4; ++m) {
                const int row = row0 + ai * 128 + m * 16;
                if (row < MV) {
                    float* gp = Gt + (size_t)row * 1024 + col0;
#pragma unroll
                    for (int bj = 0; bj < 2; ++bj)
#pragma unroll
                        for (int n = 0; n < 2; ++n) {
                            const f32x4 a = acc[ai][bj][m][n];
                            *(f32x4*)(gp + bj * 128 + n * 16) = (f32x4){sigm(a[0]), sigm(a[1]), sigm(a[2]), sigm(a[3])};
                        }
                }
            }
    }
};
struct EpiPle {
    static constexpr bool PERM = false;
    float* H; const float* Gt; bf16_t* XN; const float* nw; float* SS;
    DI void operator()(const f32x4 (&acc)[2][2][4][2], const pg8::Unit& u, int wr, int wc, int fr, int fq) const {
        const int row0 = u.pm * 256 + wr * 64 + fr, col0 = u.pn * 256 + wc * 32 + 4 * fq;
#pragma unroll
        for (int ai = 0; ai < 2; ++ai)
#pragma unroll
            for (int m = 0; m < 4; ++m) {
                const int row = row0 + ai * 128 + m * 16;
                float ssum = 0.f;
                if (row < MV) {
                    float* hp = H + (size_t)row * 1024 + col0; const float* gp = Gt + (size_t)row * 1024 + col0;
#pragma unroll
                    for (int bj = 0; bj < 2; ++bj)
#pragma unroll
                        for (int n = 0; n < 2; ++n) {
                            const int co = bj * 128 + n * 16;
                            const f32x4 v = *(const f32x4*)(hp + co) + *(const f32x4*)(gp + co) * acc[ai][bj][m][n];
                            *(f32x4*)(hp + co) = v;
                            ssum += v[0] * v[0] + v[1] * v[1] + v[2] * v[2] + v[3] * v[3];
                            if (XN) { const f32x4 w = *(const f32x4*)(nw + col0 + co); *(uint2*)(XN + (size_t)row * 1024 + col0 + co) = pack4(v[0] * w[0], v[1] * w[1], v[2] * w[2], v[3] * w[3]); }
                        }
                }
                ssum += __shfl_xor(ssum, 16); ssum += __shfl_xor(ssum, 32);
                if (fq == 0 && row < MV) atomicAdd(SS + row, ssum);
            }
    }
};

template <int KS, class F>
DI void sgemm(const bf16_t* A, const bf16_t* Bt, int K, int ncolt, int nwg_main, const F& f, unsigned char* L) {
    constexpr int RT = 8 / KS, NRS = 128 / (16 * RT);
    const int tid = otid(), lane = tid & 63, wid = __builtin_amdgcn_readfirstlane(tid >> 6), rt = wid % RT, ks = wid / RT;
    const int G = gridDim.x, off = nwg_main % G, Kh = K / KS;
    int li = blockIdx.x, nl = G;
    if (off != 0) { if ((int)blockIdx.x < off) return; li = blockIdx.x - off; nl = G - off; }
    float* red = (float*)L;
    for (int t = li; t < ncolt * NRS; t += nl) {
        const int ct = t / NRS, rs = t % NRS;
        const bf16_t* ap = A + (size_t)(MP + rs * 16 * RT + rt * 16 + (lane & 15)) * K + ks * Kh + 8 * (lane >> 4);
        const bf16_t* bp0 = Bt + (size_t)(ct * 32 + (lane & 15)) * K + ks * Kh + 8 * (lane >> 4);
        const bf16_t* bp1 = bp0 + (size_t)16 * K;
        f32x4 acc0 = {0.f, 0.f, 0.f, 0.f}, acc1 = {0.f, 0.f, 0.f, 0.f};
        bf16x8 a0[4], a1[4], p0[4], p1[4], q0[4], q1[4];
#define SG_LOAD(av, pv, qv, kk) do { _Pragma("unroll") for (int q_ = 0; q_ < 4; ++q_) { av[q_] = *(const bf16x8*)(ap + (kk) + q_ * 32); pv[q_] = *(const bf16x8*)(bp0 + (kk) + q_ * 32); qv[q_] = *(const bf16x8*)(bp1 + (kk) + q_ * 32); } } while (0)
#define SG_MMA(av, pv, qv) do { _Pragma("unroll") for (int q_ = 0; q_ < 4; ++q_) { acc0 = MFMA16(av[q_], pv[q_], acc0); acc1 = MFMA16(av[q_], qv[q_], acc1); } } while (0)
        SG_LOAD(a0, p0, q0, 0);
        for (int k0 = 0; k0 < Kh; k0 += 256) {
            if (k0 + 128 < Kh) SG_LOAD(a1, p1, q1, k0 + 128);
            SG_MMA(a0, p0, q0);
            if (k0 + 256 < Kh) SG_LOAD(a0, p0, q0, k0 + 256);
            if (k0 + 128 < Kh) SG_MMA(a1, p1, q1);
        }
#undef SG_LOAD
#undef SG_MMA
        if (ks > 0) { float* rp = red + (((ks - 1) * RT + rt) * 64 + lane) * 8; *(f32x4*)rp = acc0; *(f32x4*)(rp + 4) = acc1; }
        lds_barrier();
        if (ks == 0) {
#pragma unroll
            for (int j = 0; j < KS - 1; ++j) { const float* rp = red + ((j * RT + rt) * 64 + lane) * 8; acc0 += *(const f32x4*)rp; acc1 += *(const f32x4*)(rp + 4); }
#pragma unroll
            for (int reg = 0; reg < 4; ++reg) {
                const int row = MP + rs * 16 * RT + rt * 16 + (lane >> 4) * 4 + reg, col = ct * 32 + (lane & 15);
                f(row, col, acc0[reg], lane); f(row, col + 16, acc1[reg], lane);
            }
        }
        lds_barrier();
    }
}
struct SfU { bf16_t* O; int ldc; const float* ss; float* DT;
    DI void operator()(int row, int col, float v, int) const {
        if (col >= ldc) { if (col < ldc + 16) DT[(size_t)row * 16 + col - ldc] = v; return; }
        const float sc = ss ? rsqrtf(ss[row] * (1.f / 1024.f) + EPSF) : 1.f; O[(size_t)row * ldc + col] = f2bf(v * sc); } };
struct SfResid { const float* rs; float* H; bf16_t* HB;
    DI void operator()(int row, int col, float v, int) const { const float h = rs[(size_t)(row - MP) * 1024 + col] + v; H[(size_t)row * 1024 + col] = h; HB[(size_t)row * 1024 + col] = f2bf(h); } };
struct SfGate { float* Gt; DI void operator()(int row, int col, float v, int) const { Gt[(size_t)row * 1024 + col] = sigm(v); } };
struct SfPle { float* H; const float* Gt; bf16_t* XN; const float* nw; float* SS;
    DI void operator()(int row, int col, float v, int lane) const {
        const size_t o = (size_t)row * 1024 + col; const float h = H[o] + Gt[o] * v; H[o] = h;
        if (XN) XN[o] = f2bf(h * nw[col]);
        float ss = h * h; ss += __shfl_xor(ss, 1); ss += __shfl_xor(ss, 2); ss += __shfl_xor(ss, 4); ss += __shfl_xor(ss, 8);
        if ((lane & 15) == 0) atomicAdd(SS + row, ss); } };

DI void transpose_tile_w(const float* src, int lds_, bf16_t* dst, int ldd, int k0, int n0, int nvalid, float* tile, int lane) {
    const float* sp = src + (size_t)k0 * lds_ + n0 + lane;
#pragma unroll
    for (int bt = 0; bt < 4; ++bt) {
        float v[16];
#pragma unroll
        for (int r = 0; r < 16; ++r) v[r] = (lane < nvalid) ? sp[(size_t)(bt * 16 + r) * lds_] : 0.f;
#pragma unroll
        for (int r = 0; r < 16; ++r) tile[(bt * 16 + r) * 65 + lane] = v[r];
    }
    const int koct = lane & 7;
#pragma unroll
    for (int p = 0; p < 8; ++p) {
        const int nn = (lane >> 3) + 8 * p;
        const float* tp = tile + (koct * 8) * 65 + nn;
        uint4 w;
        w.x = pack2(tp[0], tp[65]); w.y = pack2(tp[2 * 65], tp[3 * 65]); w.z = pack2(tp[4 * 65], tp[5 * 65]); w.w = pack2(tp[6 * 65], tp[7 * 65]);
        *(uint4*)(dst + (size_t)(n0 + nn) * ldd + k0 + koct * 8) = w;
    }
}
DI void transpose_job(const float* src, int lds_, bf16_t* dst, int ldd, int K, int N, int nvalid_last, int& base, float* tile, int gw, int nwv, int lane) {
    const int ntn = (N + 63) / 64, nt = (K / 64) * ntn;
    const int first = (gw - (base % nwv) + nwv) % nwv;
    for (int t = first; t < nt; t += nwv) { const int tn = t % ntn; transpose_tile_w(src, lds_, dst, ldd, (t / ntn) * 64, tn * 64, (tn == ntn - 1) ? nvalid_last : 64, tile, lane); }
    base += nt;
}
DI void l1_weight_tile(const Params& P, int t, float* tile, int lane) {
    if (t < 2048) transpose_tile_w(P.in[26], INC, WSP(bf16_t, OFF_W1T), 1024, (t >> 7) * 64, (t & 127) * 64, 64, tile, lane);
    else if (t < 2560) { t -= 2048; transpose_tile_w(P.in[29], 1024, WSP(bf16_t, OFF_WO1T), 2048, (t >> 4) * 64, (t & 15) * 64, 64, tile, lane); }
    else if (t < 2816) { t -= 2560; transpose_tile_w(P.in[31] + 1024 * 1024, 1024, WSP(bf16_t, OFF_WG1T), 1024, (t >> 4) * 64, (t & 15) * 64, 64, tile, lane); }
    else if (t < 2880) { t -= 2816; transpose_tile_w(P.in[30] + 256 * 1024, 1024, WSP(bf16_t, OFF_WP1T), 256, (t >> 4) * 64, (t & 15) * 64, 64, tile, lane); }
    else if (t < 3392) { t -= 2880; transpose_tile_w(P.in[25], 1024, WSP(bf16_t, OFF_WO0T), 2048, (t >> 4) * 64, (t & 15) * 64, 64, tile, lane); }
    else if (t < 3648) { t -= 3392; transpose_tile_w(P.in[31], 1024, WSP(bf16_t, OFF_WG0T), 1024, (t >> 4) * 64, (t & 15) * 64, 64, tile, lane); }
    else { t -= 3648; transpose_tile_w(P.in[30], 1024, WSP(bf16_t, OFF_WP0T), 256, (t >> 4) * 64, (t & 15) * 64, 64, tile, lane); }
}
DI void phase_prep(const Params& P, unsigned char* L) {
    const int tid = otid(), lane = tid & 63, wid = tid >> 6;
    const int gw = blockIdx.x * 8 + wid, nwv = gridDim.x * 8;
    { float* z = WSP(float, OFF_SS1); const int n = (int)((OFF_DT - OFF_SS1) / 4);
      for (int i = blockIdx.x * 512 + tid; i < n; i += gridDim.x * 512) z[i] = 0.f;
      if (blockIdx.x == 0 && tid < 64) WSP(unsigned, OFF_CTL)[tid] = 0u; }
    { float* tile = (float*)L + wid * (64 * 65); int base = 0;
      transpose_job(P.in[11], INAB, WSP(bf16_t, OFF_W0T), 1024, 1024, N0, 64, base, tile, gw, nwv, lane);
      transpose_job(P.in[11] + N0, INAB, WSP(bf16_t, OFF_W0T) + (size_t)N0 * 1024, 1024, 1024, 16, 16, base, tile, gw, nwv, lane);
      transpose_job(P.in[14], 128, WSP(bf16_t, OFF_WRT), 1024, 1024, 128, 64, base, tile, gw, nwv, lane);
      transpose_job(P.in[16], 128, WSP(bf16_t, OFF_WIT), 1024, 1024, 128, 64, base, tile, gw, nwv, lane); }
    { const float* nwp = P.in[9]; bf16_t* XN = WSP(bf16_t, OFF_XN);
      f32x4 w4[4];
#pragma unroll
      for (int i = 0; i < 4; ++i) w4[i] = *(const f32x4*)(nwp + lane * 4 + 256 * i);
      for (int r0 = gw * 2; r0 < MV; r0 += nwv * 2) {
          f32x4 x[2][4];
#pragma unroll
          for (int q = 0; q < 2; ++q) { const int r = r0 + q; const float* src = r < MP ? P.in[0] + (size_t)r * 1024 : P.in[1] + (size_t)(r - MP) * 1024;
#pragma unroll
              for (int i = 0; i < 4; ++i) x[q][i] = *(const f32x4*)(src + lane * 4 + 256 * i); }
#pragma unroll
          for (int q = 0; q < 2; ++q) {
              float ss = 0.f;
#pragma unroll
              for (int i = 0; i < 4; ++i) ss += x[q][i][0] * x[q][i][0] + x[q][i][1] * x[q][i][1] + x[q][i][2] * x[q][i][2] + x[q][i][3] * x[q][i][3];
              ss = wave_sum(ss); const float rstd = rsqrtf(ss * (1.f / 1024.f) + EPSF);
#pragma unroll
              for (int i = 0; i < 4; ++i) { const f32x4 v = x[q][i] * rstd * w4[i]; *(uint2*)(XN + (size_t)(r0 + q) * 1024 + lane * 4 + 256 * i) = pack4(v[0], v[1], v[2], v[3]); }
          }
      } }
}
DI void convert_p_chunk(const Params& P, int layer, int chunk, int tid) {
    bf16_t* PB = WSP(bf16_t, OFF_PB + (size_t)layer * PB_STRIDE);
    const float* pp = P.in[2] + (size_t)layer * MP * 256; const float* ps = P.in[3] + (size_t)layer * MS * 256;
#pragma unroll 4
    for (int j = 0; j < 16; ++j) {
        const int i = chunk * 8192 + j * 512 + tid;
        if (i < MV * 64) {
            const int row = i >> 6, c4 = (i & 63) * 4;
            const f32x4 v = *(const f32x4*)((row < MP ? pp + (size_t)row * 256 : ps + (size_t)(row - MP) * 256) + c4);
            *(uint2*)(PB + (size_t)row * 256 + c4) = pack4(v[0], v[1], v[2], v[3]);
        }
    }
}

constexpr size_t OFF_XT = OFF_XN;
constexpr size_t OFF_CN = OFF_H;
constexpr size_t OFF_BN = OFF_CN + (size_t)MP * 256 * 2;
constexpr size_t OFF_BT = OFF_BN + (size_t)MP * 256 * 2;
DI void phase_convbc(const Params& P) {
    const bf16_t* U = WSP(bf16_t, OFF_U);
    bf16_t* XT = WSP(bf16_t, OFF_XT); bf16_t* CN = WSP(bf16_t, OFF_CN); bf16_t* BN = WSP(bf16_t, OFF_BN); bf16_t* BT = WSP(bf16_t, OFF_BT);
    for (int idx = blockIdx.x * 512 + otid(); idx < 2048 * 384; idx += gridDim.x * 512) {
        const int quad = idx % 384, tgp = idx / 384, b = tgp >> 8, t0 = (tgp & 255) * 8, cch = quad * 4;
        float cw[4][4], cbias[4];
#pragma unroll
        for (int kk = 0; kk < 4; ++kk) { const f32x4 w = *(const f32x4*)(P.in[19] + kk * 1536 + cch); cw[kk][0] = w[0]; cw[kk][1] = w[1]; cw[kk][2] = w[2]; cw[kk][3] = w[3]; }
        { const f32x4 w = *(const f32x4*)(P.in[20] + cch); cbias[0] = w[0]; cbias[1] = w[1]; cbias[2] = w[2]; cbias[3] = w[3]; }
        const unsigned voff = (unsigned)((b * 2048 + t0) * N0 + 3072 + cch);
        uint2 raw[11];
#pragma unroll
        for (int j = 0; j < 11; ++j) raw[j] = (t0 + j - 3 >= 0) ? *(const uint2*)((U + (j - 3) * N0) + voff) : make_uint2(0u, 0u);
        float y[8][4];
#pragma unroll
        for (int j = 0; j < 8; ++j) {
            const float x0[4] = {bflo(raw[j].x), bfhi(raw[j].x), bflo(raw[j].y), bfhi(raw[j].y)};
            const float x1[4] = {bflo(raw[j + 1].x), bfhi(raw[j + 1].x), bflo(raw[j + 1].y), bfhi(raw[j + 1].y)};
            const float x2[4] = {bflo(raw[j + 2].x), bfhi(raw[j + 2].x), bflo(raw[j + 2].y), bfhi(raw[j + 2].y)};
            const float x3[4] = {bflo(raw[j + 3].x), bfhi(raw[j + 3].x), bflo(raw[j + 3].y), bfhi(raw[j + 3].y)};
#pragma unroll
            for (int e = 0; e < 4; ++e) y[j][e] = silu(cbias[e] + cw[0][e] * x0[e] + cw[1][e] * x1[e] + cw[2][e] * x2[e] + cw[3][e] * x3[e]);
        }
        const int c = t0 >> 7, tl = t0 & 127;
        if (cch < 1024) {
#pragma unroll
            for (int e = 0; e < 4; ++e) { uint4 w; w.x = pack2(y[0][e], y[1][e]); w.y = pack2(y[2][e], y[3][e]); w.z = pack2(y[4][e], y[5][e]); w.w = pack2(y[6][e], y[7][e]);
                *(uint4*)(XT + ((size_t)((b * 16 + c) * 1024 + cch + e)) * 128 + tl) = w; }
        } else {
            const int cc = cch - 1024, isC = cc >= 256, g = (cc & 255) >> 7, n0 = cc & 127;
            bf16_t* nat = (isC ? CN : BN) + ((size_t)(((b * 16 + c) * 2 + g) * 128 + tl)) * 128 + n0;
#pragma unroll
            for (int j = 0; j < 8; ++j) *(uint2*)(nat + j * 128) = pack4(y[j][0], y[j][1], y[j][2], y[j][3]);
            if (!isC) {
#pragma unroll
                for (int e = 0; e < 4; ++e) { uint4 w; w.x = pack2(y[0][e], y[1][e]); w.y = pack2(y[2][e], y[3][e]); w.z = pack2(y[4][e], y[5][e]); w.w = pack2(y[6][e], y[7][e]);
                    *(uint4*)(BT + ((size_t)(((b * 16 + c) * 2 + g) * 128 + n0 + e)) * 128 + tl) = w; }
            }
        }
    }
}
DI void ssd_prompt_item(const Params& P, unsigned char* L, int item) {
    const int b = item >> 4, h = item & 15, g = h >> 3;
    const int tid0 = otid(), wid = tid0 >> 6;
    bf16_t* Cs = (bf16_t*)L;
    bf16_t* Bs = Cs + 128 * 136;
    bf16_t* BsT = Bs + 128 * 136;
    bf16_t* XsT = BsT + 128 * 136;
    bf16_t* St = XsT + 64 * 136;
    bf16_t* XwT = St + 64 * 136;
    float* dtvB = (float*)(XwT + 64 * 136); float* acsB = dtvB + 256; float* wvB = acsB + 256;
    const bf16_t* U = WSP(bf16_t, OFF_U); const float* DT = WSP(float, OFF_DT); bf16_t* MIX = WSP(bf16_t, OFF_MIX); float* SSB = WSP(float, OFF_SSB);
    const float a_neg = -__expf(P.in[22][h]), dtb = P.in[21][h], Dh = P.in[23][h];
    f32x16 accS;
#pragma unroll
    for (int i = 0; i < 16; ++i) accS[i] = 0.f;
    lds_barrier();
    for (int i = tid0; i < 64 * 136; i += 512) St[i] = 0;
    float dtr0 = 0.f, dtr1 = 0.f;
#define SSD_DTLOAD(cc) do { if (wid == 0) { const float* dp_ = DT + (size_t)(b * 2048 + (cc) * 128 + (tid0 & 63)) * 16 + h; dtr0 = dp_[0]; dtr1 = dp_[64 * 16]; } } while (0)
#define SSD_SCAN(buf) do { if (wid == 0) { const int ln_ = tid0 & 63; const float d0_ = softplus(dtr0 + dtb), d1_ = softplus(dtr1 + dtb); float v0_ = d0_ * a_neg, v1_ = d1_ * a_neg; \
        _Pragma("unroll") for (int o_ = 1; o_ < 64; o_ <<= 1) { const float n0_ = __shfl_up(v0_, o_), n1_ = __shfl_up(v1_, o_); if (ln_ >= o_) { v0_ += n0_; v1_ += n1_; } } \
        v1_ += __shfl(v0_, 63); const float al_ = __shfl(v1_, 63); \
        dtvB[(buf) * 128 + ln_] = d0_; dtvB[(buf) * 128 + 64 + ln_] = d1_; acsB[(buf) * 128 + ln_] = v0_; acsB[(buf) * 128 + 64 + ln_] = v1_; \
        wvB[(buf) * 128 + ln_] = __expf(al_ - v0_) * d0_; wvB[(buf) * 128 + 64 + ln_] = __expf(al_ - v1_) * d1_; } } while (0)
    SSD_DTLOAD(0); SSD_SCAN(0); SSD_DTLOAD(1);
    u32x4 tC[4], tB[4], tT[4], tX[2];
    for (int c = 0; c < 16; ++c) {
        const int row0 = b * 2048 + c * 128;
        lds_barrier();
        int zv = 0; asm volatile("" : "+v"(zv));
        const int tid = tid0 + zv, lane = tid & 63, hh = lane >> 5, l31 = lane & 31;
        const int prow = tid >> 4, pcol = (tid & 15) * 8;
        const float* dtv = dtvB + (c & 1) * 128; const float* acs = acsB + (c & 1) * 128; const float* wv = wvB + (c & 1) * 128;
        if (c + 1 < 16) { SSD_SCAN((c + 1) & 1); if (c + 2 < 16) SSD_DTLOAD(c + 2); }
        if (c == 0) {
            const size_t tb_ = ((size_t)((b * 16 + c) * 2 + g)) * 128 * 128 + (size_t)prow * 128 + pcol;
            const u32x4* pc = (const u32x4*)(WSP(bf16_t, OFF_CN) + tb_); const u32x4* pb = (const u32x4*)(WSP(bf16_t, OFF_BN) + tb_); const u32x4* pt = (const u32x4*)(WSP(bf16_t, OFF_BT) + tb_);
            const u32x4* px = (const u32x4*)(WSP(bf16_t, OFF_XT) + ((size_t)((b * 16 + c) * 1024 + h * 64 + prow)) * 128 + pcol);
#pragma unroll
            for (int i = 0; i < 4; ++i) { tC[i] = pc[i * 512]; tB[i] = pb[i * 512]; tT[i] = pt[i * 512]; }
            tX[0] = px[0]; tX[1] = px[512];
        }
        const float a_last = acs[127];
#pragma unroll
        for (int i = 0; i < 4; ++i) {
            *(u32x4*)(Cs + (prow + 32 * i) * 136 + pcol) = tC[i]; *(u32x4*)(Bs + (prow + 32 * i) * 136 + pcol) = tB[i]; *(u32x4*)(BsT + (prow + 32 * i) * 136 + pcol) = tT[i];
        }
        *(u32x4*)(XsT + prow * 136 + pcol) = tX[0]; *(u32x4*)(XsT + (prow + 32) * 136 + pcol) = tX[1];
        {
            const f32x4 w0 = *(const f32x4*)(wv + pcol), w1 = *(const f32x4*)(wv + pcol + 4);
            u32x4 oa, ob; const u32x4 xa = tX[0], xb_ = tX[1];
            oa.x = pack2(bflo(xa.x) * w0[0], bfhi(xa.x) * w0[1]); oa.y = pack2(bflo(xa.y) * w0[2], bfhi(xa.y) * w0[3]); oa.z = pack2(bflo(xa.z) * w1[0], bfhi(xa.z) * w1[1]); oa.w = pack2(bflo(xa.w) * w1[2], bfhi(xa.w) * w1[3]);
            ob.x = pack2(bflo(xb_.x) * w0[0], bfhi(xb_.x) * w0[1]); ob.y = pack2(bflo(xb_.y) * w0[2], bfhi(xb_.y) * w0[3]); ob.z = pack2(bflo(xb_.z) * w1[0], bfhi(xb_.z) * w1[1]); ob.w = pack2(bflo(xb_.w) * w1[2], bfhi(xb_.w) * w1[3]);
            *(u32x4*)(XwT + prow * 136 + pcol) = oa; *(u32x4*)(XwT + (prow + 32) * 136 + pcol) = ob;
        }
        if (c + 1 < 16) {
            const size_t tb_ = ((size_t)((b * 16 + c + 1) * 2 + g)) * 128 * 128 + (size_t)prow * 128 + pcol;
            const u32x4* pc = (const u32x4*)(WSP(bf16_t, OFF_CN) + tb_); const u32x4* pb = (const u32x4*)(WSP(bf16_t, OFF_BN) + tb_); const u32x4* pt = (const u32x4*)(WSP(bf16_t, OFF_BT) + tb_);
            const u32x4* px = (const u32x4*)(WSP(bf16_t, OFF_XT) + ((size_t)((b * 16 + c + 1) * 1024 + h * 64 + prow)) * 128 + pcol);
#pragma unroll
            for (int i = 0; i < 4; ++i) { tC[i] = pc[i * 512]; tB[i] = pb[i * 512]; tT[i] = pt[i * 512]; }
            tX[0] = px[0]; tX[1] = px[512];
        }
        bf16_t zr[16];
        {
            const unsigned zoff = (unsigned)((row0 + (wid >> 1) * 32 + 4 * hh) * N0 + 2048 + h * 64 + (wid & 1) * 32 + l31);
#pragma unroll
            for (int reg = 0; reg < 16; ++reg) zr[reg] = (U + ((reg & 3) + 8 * (reg >> 2)) * N0)[zoff];
        }
        lds_barrier();
        {
            const int rb = (wid >> 1) * 32, cb0 = (wid & 1) * 64;
            f32x16 cbA[2];
#pragma unroll
            for (int i = 0; i < 16; ++i) { cbA[0][i] = 0.f; cbA[1][i] = 0.f; }
#pragma unroll
            for (int ks = 0; ks < 8; ++ks) {
                const bf16x8 a = ldfrag(Cs, 136, rb, ks * 16, lane);
                cbA[0] = MFMA32(a, ldfrag(Bs, 136, cb0, ks * 16, lane), cbA[0]);
                cbA[1] = MFMA32(a, ldfrag(Bs, 136, cb0 + 32, ks * 16, lane), cbA[1]);
            }
            lds_barrier();
            bf16_t* Ws = Bs;
#pragma unroll
            for (int j = 0; j < 2; ++j) {
                const int s = cb0 + j * 32 + l31; const float as = acs[s], ds = dtv[s];
#pragma unroll
                for (int reg = 0; reg < 16; ++reg) {
                    const int t = rb + crow(reg, hh);
                    const float v = (s <= t) ? cbA[j][reg] * __expf(acs[t] - as) * ds : 0.f;
                    Ws[t * 136 + s] = f2bf(v);
                }
            }
        }
        lds_barrier();
        {
            const bf16_t* Ws = Bs;
            const int tb = (wid >> 1) * 32, pb = (wid & 1) * 32;
            f32x16 y;
#pragma unroll
            for (int i = 0; i < 16; ++i) y[i] = 0.f;
#pragma unroll
            for (int ks = 0; ks < 8; ++ks) y = MFMA32(ldfrag(Cs, 136, tb, ks * 16, lane), ldfrag(St, 136, pb, ks * 16, lane), y);
            f32x16 y2;
#pragma unroll
            for (int i = 0; i < 16; ++i) y2[i] = 0.f;
#pragma unroll
            for (int ks = 0; ks < 8; ++ks) y2 = MFMA32(ldfrag(Ws, 136, tb, ks * 16, lane), ldfrag(XsT, 136, pb, ks * 16, lane), y2);
#pragma unroll
            for (int reg = 0; reg < 16; ++reg) y[reg] = y[reg] * __expf(acs[tb + crow(reg, hh)]) + y2[reg];
            const int p = pb + l31, ch = h * 64 + p; const float nwv = P.in[24][ch];
#pragma unroll
            for (int reg = 0; reg < 16; ++reg) {
                const int t = tb + crow(reg, hh); const size_t row = (size_t)(row0 + t);
                const float xv = bf2f(XsT[p * 136 + t]); const float z = bf2f(zr[reg]);
                const float yy = (y[reg] + Dh * xv) * silu(z);
                float ss = yy * yy;
                ss += __shfl_xor(ss, 1); ss += __shfl_xor(ss, 2); ss += __shfl_xor(ss, 4); ss += __shfl_xor(ss, 8); ss += __shfl_xor(ss, 16);
                if (l31 == 0) atomicAdd(SSB + row * 2 + g, ss);
                MIX[row * 2048 + 1024 + ch] = f2bf(yy * nwv);
            }
            lds_barrier();
            const int pb2 = (wid >> 2) * 32, nb = (wid & 3) * 32;
            const float ea = __expf(a_last);
#pragma unroll
            for (int reg = 0; reg < 16; ++reg) accS[reg] *= ea;
#pragma unroll
            for (int ks = 0; ks < 8; ++ks) accS = MFMA32(ldfrag(XwT, 136, pb2, ks * 16, lane), ldfrag(BsT, 136, nb, ks * 16, lane), accS);
#pragma unroll
            for (int reg = 0; reg < 16; ++reg) St[(pb2 + crow(reg, hh)) * 136 + nb + l31] = f2bf(accS[reg]);
        }
    }
    {
        const int lane = tid0 & 63, hh = lane >> 5, l31 = lane & 31;
        const int pb2 = (wid >> 2) * 32, nb = (wid & 3) * 32;
        float* o = P.out + O_BSP + (size_t)(b * 16 + h) * 64 * 128;
#pragma unroll
        for (int reg = 0; reg < 16; ++reg) o[(pb2 + crow(reg, hh)) * 128 + nb + l31] = accS[reg];
    }
}
#undef SSD_DTLOAD
#undef SSD_SCAN
DI void ssd_sample_item(const Params& P, unsigned char* L, int item) {
    const int b = item >> 4, h = item & 15, g = h >> 3, tid = otid(), lane = tid & 63;
    float* xs = (float*)L; float* Bv = xs + 64; float* Cv = Bv + 128; float* yv = Cv + 128;
    const bf16_t* U = WSP(bf16_t, OFF_U); bf16_t* MIX = WSP(bf16_t, OFF_MIX); float* SSB = WSP(float, OFF_SSB);
    const size_t row = (size_t)(MP + b);
    __syncthreads();
    if (tid < 320) {
        int cc; if (tid < 64) cc = h * 64 + tid; else if (tid < 192) cc = 1024 + g * 128 + (tid - 64); else cc = 1280 + g * 128 + (tid - 192);
        const float* buf = P.in[7] + (size_t)b * 3 * 1536 + cc;
        const float v = P.in[20][cc] + P.in[19][cc] * buf[0] + P.in[19][1536 + cc] * buf[1536] + P.in[19][2 * 1536 + cc] * buf[2 * 1536] + P.in[19][3 * 1536 + cc] * bf2f(U[row * N0 + 3072 + cc]);
        xs[tid] = silu(v);
    }
    const float dt = softplus(WSP(float, OFF_DT)[row * 16 + h] + P.in[21][h]);
    const float dA = __expf(-dt * __expf(P.in[22][h]));
    __syncthreads();
    const float* s0 = P.in[6] + (size_t)(b * 16 + h) * 64 * 128; float* s1 = P.out + O_BSS + (size_t)(b * 16 + h) * 64 * 128;
    const int n4 = (tid & 31) * 4;
    const f32x4 Bq = *(const f32x4*)(Bv + n4), Cq = *(const f32x4*)(Cv + n4);
#pragma unroll
    for (int j = 0; j < 4; ++j) {
        const int p = (tid >> 5) + 16 * j;
        const f32x4 s = *(const f32x4*)(s0 + p * 128 + n4);
        const float dx = dt * xs[p];
        const f32x4 sn = s * dA + Bq * dx;
        *(f32x4*)(s1 + p * 128 + n4) = sn;
        float yp = sn[0] * Cq[0] + sn[1] * Cq[1] + sn[2] * Cq[2] + sn[3] * Cq[3];
        yp += __shfl_xor(yp, 1); yp += __shfl_xor(yp, 2); yp += __shfl_xor(yp, 4); yp += __shfl_xor(yp, 8); yp += __shfl_xor(yp, 16);
        if ((tid & 31) == 0) yv[p] = yp;
    }
    __syncthreads();
    if (tid < 64) {
        const int ch = h * 64 + tid;
        const float yy = (yv[tid] + P.in[23][h] * xs[tid]) * silu(bf2f(U[row * N0 + 2048 + ch]));
        const float ss = wave_sum(yy * yy);
        if (lane == 0) atomicAdd(SSB + row * 2 + g, ss);
        MIX[row * 2048 + 1024 + ch] = f2bf(yy * P.in[24][ch]);
    }
}
DI void ssd_sample_item4(const Params& P, unsigned char* L, int item) {
    const int b = item >> 2, tid = otid(), gi = tid >> 7, lt = tid & 127, h = (item & 3) * 4 + gi, g = h >> 3;
    float* xs = (float*)L + gi * 512; float* Bv = xs + 64; float* Cv = Bv + 128; float* yv = Cv + 128;
    const bf16_t* U = WSP(bf16_t, OFF_U); bf16_t* MIX = WSP(bf16_t, OFF_MIX); float* SSB = WSP(float, OFF_SSB);
    const size_t row = (size_t)(MP + b);
    __syncthreads();
#pragma unroll
    for (int ps = 0; ps < 3; ++ps) {
        const int idx = lt + 128 * ps;
        if (idx < 320) {
            int cc; if (idx < 64) cc = h * 64 + idx; else if (idx < 192) cc = 1024 + g * 128 + (idx - 64); else cc = 1280 + g * 128 + (idx - 192);
            const float* buf = P.in[7] + (size_t)b * 3 * 1536 + cc;
            const float v = P.in[20][cc] + P.in[19][cc] * buf[0] + P.in[19][1536 + cc] * buf[1536] + P.in[19][2 * 1536 + cc] * buf[2 * 1536] + P.in[19][3 * 1536 + cc] * bf2f(U[row * N0 + 3072 + cc]);
            xs[idx] = silu(v);
        }
    }
    const float dt = softplus(WSP(float, OFF_DT)[row * 16 + h] + P.in[21][h]);
    const float dA = __expf(-dt * __expf(P.in[22][h]));
    __syncthreads();
    const float* s0 = P.in[6] + (size_t)(b * 16 + h) * 64 * 128; float* s1 = P.out + O_BSS + (size_t)(b * 16 + h) * 64 * 128;
    const int n4 = (lt & 31) * 4;
    const f32x4 Bq = *(const f32x4*)(Bv + n4), Cq = *(const f32x4*)(Cv + n4);
    f32x4 sv[16];
#pragma unroll
    for (int j = 0; j < 16; ++j) sv[j] = *(const f32x4*)(s0 + ((lt >> 5) + 4 * j) * 128 + n4);
#pragma unroll
    for (int j = 0; j < 16; ++j) {
        const int p = (lt >> 5) + 4 * j;
        const f32x4 sn = sv[j] * dA + Bq * (dt * xs[p]);
        *(f32x4*)(s1 + p * 128 + n4) = sn;
        float yp = sn[0] * Cq[0] + sn[1] * Cq[1] + sn[2] * Cq[2] + sn[3] * Cq[3];
        yp += __shfl_xor(yp, 1); yp += __shfl_xor(yp, 2); yp += __shfl_xor(yp, 4); yp += __shfl_xor(yp, 8); yp += __shfl_xor(yp, 16);
        if ((lt & 31) == 0) yv[p] = yp;
    }
    __syncthreads();
    if (lt < 64) {
        const int ch = h * 64 + lt;
        const float yy = (yv[lt] + P.in[23][h] * xs[lt]) * silu(bf2f(U[row * N0 + 2048 + ch]));
        const float ss = wave_sum(yy * yy);
        if (lt == 0) atomicAdd(SSB + row * 2 + g, ss);
        MIX[row * 2048 + 1024 + ch] = f2bf(yy * P.in[24][ch]);
    }
}
template <bool SAMPLE>
DI void rglru_item(const Params& P, unsigned char* L, int item) {
    const int tid0 = otid(), wid = tid0 >> 6;
    const int b = SAMPLE ? 0 : (item >> 4), k = (item >> 1) & 7, dh = item & 1;
    bf16_t* Xs = (bf16_t*)L;
    bf16_t* Wg = Xs + 128 * 136;
    float* Aa = (float*)(Wg + 128 * 136);
    float* Uu = Aa + 128 * 64; float* segA = Uu + 128 * 64; float* segH = segA + 512; float* hc = segH + 512;
    const bf16_t* U = WSP(bf16_t, OFF_U); bf16_t* MIX = WSP(bf16_t, OFF_MIX);
    lds_barrier();
    {
        const bf16_t* WRT = WSP(bf16_t, OFF_WRT); const bf16_t* WIT = WSP(bf16_t, OFF_WIT);
#pragma unroll
        for (int i = 0; i < 4; ++i) {
            const int chk = tid0 + i * 512, r = chk >> 4, c8 = (chk & 15) * 8;
            const bf16_t* src = (r < 64 ? WRT + (size_t)(dh * 64 + r) * 1024 : WIT + (size_t)(dh * 64 + r - 64) * 1024) + k * 128 + c8;
            *(u32x4*)(Wg + r * 136 + c8) = *(const u32x4*)src;
        }
        if (tid0 < 64) hc[tid0] = 0.f;
    }
    float sp[4], br[4], bi[4];
#pragma unroll
    for (int ct = 0; ct < 4; ++ct) { const int chd = k * 128 + dh * 64 + ct * 16 + (tid0 & 15); sp[ct] = softplus(-P.in[18][chd]); br[ct] = P.in[15][chd]; bi[ct] = P.in[17][chd]; }
    const int ch0 = k * 128 + (tid0 & 31) * 4;
    float cw[4][4], cbias[4];
#pragma unroll
    for (int kk = 0; kk < 4; ++kk)
#pragma unroll
        for (int e = 0; e < 4; ++e) cw[kk][e] = P.in[12][kk * 1024 + ch0 + e];
#pragma unroll
    for (int e = 0; e < 4; ++e) cbias[e] = P.in[13][ch0 + e];
    u32x2 raw[11];
#define RG_LOAD(tl_) do { const int tg_ = (tl_) * 128 + (tid0 >> 5) * 8; const unsigned vo_ = (unsigned)((b * 2048 + tg_) * N0 + ch0); \
        _Pragma("unroll") for (int j = 0; j < 11; ++j) raw[j] = (tg_ + j - 3 >= 0) ? *(const u32x2*)((U + (j - 3) * N0) + vo_) : (u32x2){0u, 0u}; } while (0)
    if (!SAMPLE) RG_LOAD(0);
    const int ntiles = SAMPLE ? 1 : 16;
    for (int tile = 0; tile < ntiles; ++tile) {
        const int row0 = SAMPLE ? MP : b * 2048 + tile * 128;
        lds_barrier();
        int zv = 0; asm volatile("" : "+v"(zv));
        const int tid = tid0 + zv, lane = tid & 63, quad = tid & 31, seg = tid >> 5;
        const int sd = tid & 63, sseg = wid, sch = k * 128 + dh * 64 + sd;
        bf16_t gt[16];
        if (!SAMPLE) {
            const unsigned goff = (unsigned)((row0 + sseg * 16) * N0 + 1024 + sch);
#pragma unroll
            for (int t = 0; t < 16; ++t) gt[t] = (U + t * N0)[goff];
        }
        if (SAMPLE) {
#pragma unroll
            for (int t = 0; t < 8; ++t) {
                const int bb = seg * 8 + t;
                const float* buf = P.in[5] + (size_t)bb * 3 * 1024 + ch0;
                const f32x4 p0 = *(const f32x4*)buf, p1 = *(const f32x4*)(buf + 1024), p2 = *(const f32x4*)(buf + 2048);
                float cur[4]; ld4bf(U + (size_t)(MP + bb) * N0 + ch0, cur);
                float y[4];
#pragma unroll
                for (int e = 0; e < 4; ++e) y[e] = cbias[e] + cw[0][e] * p0[e] + cw[1][e] * p1[e] + cw[2][e] * p2[e] + cw[3][e] * cur[e];
                *(u32x2*)(Xs + bb * 136 + quad * 4) = pack4v(y[0], y[1], y[2], y[3]);
            }
        } else {
#pragma unroll
            for (int j = 0; j < 8; ++j) {
                const float x0[4] = {bflo(raw[j].x), bfhi(raw[j].x), bflo(raw[j].y), bfhi(raw[j].y)};
                const float x1[4] = {bflo(raw[j + 1].x), bfhi(raw[j + 1].x), bflo(raw[j + 1].y), bfhi(raw[j + 1].y)};
                const float x2[4] = {bflo(raw[j + 2].x), bfhi(raw[j + 2].x), bflo(raw[j + 2].y), bfhi(raw[j + 2].y)};
                const float x3[4] = {bflo(raw[j + 3].x), bfhi(raw[j + 3].x), bflo(raw[j + 3].y), bfhi(raw[j + 3].y)};
                float y[4];
#pragma unroll
                for (int e = 0; e < 4; ++e) y[e] = cbias[e] + cw[0][e] * x0[e] + cw[1][e] * x1[e] + cw[2][e] * x2[e] + cw[3][e] * x3[e];
                *(u32x2*)(Xs + (seg * 8 + j) * 136 + quad * 4) = pack4v(y[0], y[1], y[2], y[3]);
            }
            if (tile + 1 < 16) RG_LOAD(tile + 1);
        }
        lds_barrier();
        {
            f32x4 acc[8];
#pragma unroll
            for (int i = 0; i < 8; ++i) acc[i] = (f32x4){0.f, 0.f, 0.f, 0.f};
#pragma unroll
            for (int ks = 0; ks < 4; ++ks) {
                const bf16x8 a = ldfrag16(Xs, 136, wid * 16, ks * 32, lane);
#pragma unroll
                for (int tl = 0; tl < 8; ++tl) acc[tl] = MFMA16(a, ldfrag16(Wg, 136, tl * 16, ks * 32, lane), acc[tl]);
            }
#pragma unroll
            for (int ct = 0; ct < 4; ++ct)
#pragma unroll
                for (int reg = 0; reg < 4; ++reg) {
                    const int t = wid * 16 + (lane >> 4) * 4 + reg, d = ct * 16 + (lane & 15);
                    const float r = sigm(acc[ct][reg] + br[ct]), gi = sigm(acc[4 + ct][reg] + bi[ct]);
                    const float a = __expf(-8.f * r * sp[ct]);
                    const float uu = __builtin_amdgcn_sqrtf(fmaxf(1.f - a * a, 0.f)) * gi * bf2f(Xs[t * 136 + dh * 64 + d]);
                    if (SAMPLE) {
                        const int chd = k * 128 + dh * 64 + d;
                        const float hn = a * P.in[4][(size_t)t * 1024 + chd] + uu;
                        P.out[O_AHS + (size_t)t * 1024 + chd] = hn;
                        const float gv = bf2f(U[(size_t)(MP + t) * N0 + 1024 + chd]);
                        MIX[(size_t)(MP + t) * 2048 + chd] = f2bf(hn * silu(gv));
                    } else { Aa[t * 64 + d] = a; Uu[t * 64 + d] = uu; }
                }
        }
        if (!SAMPLE) {
            lds_barrier();
            float av[16], uv[16], Ap = 1.f, Hp = 0.f;
#pragma unroll
            for (int t = 0; t < 16; ++t) { av[t] = Aa[(sseg * 16 + t) * 64 + sd]; uv[t] = Uu[(sseg * 16 + t) * 64 + sd]; Hp = av[t] * Hp + uv[t]; Ap *= av[t]; }
            segA[sseg * 64 + sd] = Ap; segH[sseg * 64 + sd] = Hp;
            lds_barrier();
            float hin = hc[sd];
            for (int s2 = 0; s2 < sseg; ++s2) hin = segA[s2 * 64 + sd] * hin + segH[s2 * 64 + sd];
            const unsigned moff = (unsigned)((row0 + sseg * 16) * 2048 + sch);
#pragma unroll
            for (int t = 0; t < 16; ++t) {
                hin = av[t] * hin + uv[t];
                (MIX + t * 2048)[moff] = f2bf(hin * silu(bf2f(gt[t])));
            }
            lds_barrier();
            if (sseg == 7) hc[sd] = hin;
        }
    }
#undef RG_LOAD
    if (!SAMPLE) { lds_barrier(); if (tid0 < 64) P.out[O_AHP + (size_t)b * 1024 + k * 128 + dh * 64 + tid0] = hc[tid0]; }
}
DI void phase_mix0(const Params& P, unsigned char* L) {
    const int tid = otid(), bid = blockIdx.x, G = gridDim.x;
    { const bf16_t* U = WSP(bf16_t, OFF_U);
      for (int i = bid * 512 + tid; i < 8 * 3 * 1024; i += G * 512) { const int c = i & 1023, j = (i >> 10) % 3, b = i / 3072; P.out[O_ACP + i] = bf2f(U[(size_t)(b * 2048 + 2045 + j) * N0 + c]); }
      for (int i = bid * 512 + tid; i < 8 * 3 * 1536; i += G * 512) { const int c = i % 1536, j = (i / 1536) % 3, b = i / 4608; P.out[O_BCP + i] = bf2f(U[(size_t)(b * 2048 + 2045 + j) * N0 + 3072 + c]); }
      for (int i = bid * 512 + tid; i < 128 * 3 * 1024; i += G * 512) { const int c = i & 1023, j = (i >> 10) % 3, b = i / 3072; P.out[O_ACS + i] = j < 2 ? P.in[5][(size_t)(b * 3 + j + 1) * 1024 + c] : bf2f(U[(size_t)(MP + b) * N0 + c]); }
      for (int i = bid * 512 + tid; i < 128 * 3 * 1536; i += G * 512) { const int c = i % 1536, j = (i / 1536) % 3, b = i / 4608; P.out[O_BCS + i] = j < 2 ? P.in[7][(size_t)(b * 3 + j + 1) * 1536 + c] : bf2f(U[(size_t)(MP + b) * N0 + 3072 + c]); } }
    if (bid < 128) rglru_item<false>(P, L, bid); else if (bid < 256) ssd_prompt_item(P, L, bid - 128);
    unsigned* ctr = WSP(unsigned, OFF_CTL);
    unsigned* bc = (unsigned*)(L + LDS_BYTES - 16);
    for (;;) {
        __syncthreads();
        if (tid == 0) bc[0] = atomicAdd(ctr, 1u);
        __syncthreads();
        const unsigned it = bc[0];
        if (it >= 16u + 512u) break;
        if (it < 16u) rglru_item<true>(P, L, (int)it); else ssd_sample_item4(P, L, (int)(it - 16u));
    }
    for (;;) {
        __syncthreads();
        if (tid == 0) bc[0] = atomicAdd(ctr + 32, 1u);
        __syncthreads();
        const unsigned q = bc[0];
        if (q >= 464u + 260u) break;
        if (q < 464u) l1_weight_tile(P, (int)q * 8 + (tid >> 6), (float*)L + (tid >> 6) * (64 * 65), tid & 63);
        else { const int c = (int)q - 464; convert_p_chunk(P, c >= 130, c >= 130 ? c - 130 : c, tid); }
    }
}
DI void phase_norm0(const Params& P) {
    bf16_t* MIX = WSP(bf16_t, OFF_MIX); const float* SSB = WSP(float, OFF_SSB);
    for (int i = blockIdx.x * 512 + threadIdx.x; i < MV * 128; i += gridDim.x * 512) {
        const int row = i >> 7, c8 = (i & 127) * 8, g = c8 >> 9;
        const float sc = rsqrtf(SSB[(size_t)row * 2 + g] * (1.f / 512.f) + EPSF);
        uint4* p = (uint4*)(MIX + (size_t)row * 2048 + 1024 + c8); uint4 w = *p;
        w.x = pack2(bflo(w.x) * sc, bfhi(w.x) * sc); w.y = pack2(bflo(w.y) * sc, bfhi(w.y) * sc); w.z = pack2(bflo(w.z) * sc, bfhi(w.z) * sc); w.w = pack2(bflo(w.w) * sc, bfhi(w.w) * sc);
        *p = w;
    }
}

DI void hgrn_prompt_item(const Params& P, unsigned char* L, int item) {
    const int b = item >> 4, h = item & 15;
    const int tid = otid(), lane = tid & 63, wid = tid >> 6, hh = lane >> 5, l31 = lane & 31;
    bf16_t* Qs = (bf16_t*)L;
    bf16_t* Ks = Qs + 64 * 136;
    bf16_t* KsT = Ks + 64 * 136;
    bf16_t* VsT = KsT + 128 * 72;
    bf16_t* SsT = VsT + 128 * 72;
    bf16_t* As = SsT + 128 * 136;
    float* Gseg = (float*)(As + 64 * 72);
    float* E1 = Gseg + 16 * 128; float* E2 = E1 + 128;
    float* Of = E2 + 128;
    const bf16_t* U = WSP(bf16_t, OFF_U); bf16_t* MIX = WSP(bf16_t, OFF_MIX);
    const int kq = tid & 31, ts = tid >> 5;
    float lb[4];
#pragma unroll
    for (int e = 0; e < 4; ++e) { const int ch = h * 128 + kq * 4 + e; lb[e] = sigm(P.in[27][2048 + ch] - P.in[27][ch]); }
    const int kb = (wid >> 1) * 32, vb0 = (wid & 1) * 64;
    f32x16 accS[2];
#pragma unroll
    for (int i = 0; i < 16; ++i) { accS[0][i] = 0.f; accS[1][i] = 0.f; }
    uint2 rq[4], rf[4], rv[4];
#define HG_LOAD(cc) do { _Pragma("unroll") for (int i = 0; i < 4; ++i) { const bf16_t* bp = U + (size_t)(b * 2048 + (cc) * 64 + ts * 4 + i) * INC + h * 128 + kq * 4; \
        rq[i] = *(const uint2*)bp; rf[i] = *(const uint2*)(bp + 2048); rv[i] = *(const uint2*)(bp + 4096); } } while (0)
    HG_LOAD(0);
    lds_barrier();
    for (int c = 0; c < 32; ++c) {
        u32x4 gpre0, gpre1;
        { const bf16_t* gp = U + (size_t)(b * 2048 + c * 64 + (tid >> 3)) * INC + 6144 + h * 128 + (tid & 7) * 16; gpre0 = *(const u32x4*)gp; gpre1 = *(const u32x4*)(gp + 8); }
        float kk[4][4], cs[4][4];
#pragma unroll
        for (int i = 0; i < 4; ++i) {
            const float fx[4] = {bflo(rf[i].x), bfhi(rf[i].x), bflo(rf[i].y), bfhi(rf[i].y)};
#pragma unroll
            for (int e = 0; e < 4; ++e) {
                const float sg = sigm(fx[e]); const float kv = (1.f - lb[e]) * (1.f - sg);
                kk[i][e] = kv; const float gl = __logf(1.f - kv);
                cs[i][e] = (i == 0 ? 0.f : cs[i - 1][e]) + gl;
            }
        }
        *(f32x4*)(Gseg + ts * 128 + kq * 4) = (f32x4){cs[3][0], cs[3][1], cs[3][2], cs[3][3]};
        lds_barrier();
        f32x4 off = {0.f, 0.f, 0.f, 0.f}, gmid = off, glast = off;
        {
            const int swid = __builtin_amdgcn_readfirstlane(tid >> 6);
            f32x4 pre = {0.f, 0.f, 0.f, 0.f};
#pragma unroll
            for (int s = 0; s < 16; ++s) {
                const f32x4 v = *(const f32x4*)(Gseg + s * 128 + kq * 4);
                if (s == 2 * swid) off = pre;
                if (s == 8) gmid = pre;
                pre += v;
            }
            glast = pre;
            if (ts & 1) off += *(const f32x4*)(Gseg + (ts - 1) * 128 + kq * 4);
        }
        {
            float qt[4][4], kt[4][4], vt[4][4];
#pragma unroll
            for (int i = 0; i < 4; ++i) {
                const float q[4] = {bflo(rq[i].x), bfhi(rq[i].x), bflo(rq[i].y), bfhi(rq[i].y)};
                vt[i][0] = bflo(rv[i].x); vt[i][1] = bfhi(rv[i].x); vt[i][2] = bflo(rv[i].y); vt[i][3] = bfhi(rv[i].y);
#pragma unroll
                for (int e = 0; e < 4; ++e) { const float Gv = off[e] + cs[i][e]; const float ex = __expf(Gv - gmid[e]); qt[i][e] = q[e] * 0.08838834764831845f * ex; kt[i][e] = kk[i][e] * frcp(ex); }
                *(uint2*)(Qs + (ts * 4 + i) * 136 + kq * 4) = pack4(qt[i][0], qt[i][1], qt[i][2], qt[i][3]);
                *(uint2*)(Ks + (ts * 4 + i) * 136 + kq * 4) = pack4(kt[i][0], kt[i][1], kt[i][2], kt[i][3]);
            }
#pragma unroll
            for (int e = 0; e < 4; ++e) {
                *(uint2*)(KsT + (kq * 4 + e) * 72 + ts * 4) = pack4(kt[0][e], kt[1][e], kt[2][e], kt[3][e]);
                *(uint2*)(VsT + (kq * 4 + e) * 72 + ts * 4) = pack4(vt[0][e], vt[1][e], vt[2][e], vt[3][e]);
            }
            if (ts == 0) {
#pragma unroll
                for (int e = 0; e < 4; ++e) { E1[kq * 4 + e] = __expf(gmid[e]); E2[kq * 4 + e] = __expf(glast[e] - gmid[e]); }
            }
        }
        if (c + 1 < 32) HG_LOAD(c + 1);
        lds_barrier();
#pragma unroll
        for (int j = 0; j < 2; ++j) {
#pragma unroll
            for (int reg = 0; reg < 16; ++reg) accS[j][reg] *= E1[kb + crow(reg, hh)];
            const int v = vb0 + j * 32 + l31;
#pragma unroll
            for (int rg = 0; rg < 4; ++rg) *(uint2*)(SsT + v * 136 + kb + 8 * rg + 4 * hh) = pack4(accS[j][4 * rg], accS[j][4 * rg + 1], accS[j][4 * rg + 2], accS[j][4 * rg + 3]);
        }
        if (wid < 4) {
            const int tb = (wid >> 1) * 32, sb = (wid & 1) * 32;
            f32x16 aa;
#pragma unroll
            for (int i = 0; i < 16; ++i) aa[i] = 0.f;
#pragma unroll
            for (int ks = 0; ks < 8; ++ks) aa = MFMA32(ldfrag(Qs, 136, tb, ks * 16, lane), ldfrag(Ks, 136, sb, ks * 16, lane), aa);
            const int s = sb + l31;
#pragma unroll
            for (int reg = 0; reg < 16; ++reg) { const int t = tb + crow(reg, hh); As[t * 72 + s] = f2bf(s <= t ? aa[reg] : 0.f); }
        }
        lds_barrier();
        const int tb2 = (wid >> 2) * 32, vb2 = (wid & 3) * 32;
        f32x16 o, o2;
#pragma unroll
        for (int i = 0; i < 16; ++i) { o[i] = 0.f; o2[i] = 0.f; }
#pragma unroll
        for (int ks = 0; ks < 8; ++ks) o = MFMA32(ldfrag(Qs, 136, tb2, ks * 16, lane), ldfrag(SsT, 136, vb2, ks * 16, lane), o);
#pragma unroll
        for (int ks = 0; ks < 4; ++ks) o2 = MFMA32(ldfrag(As, 72, tb2, ks * 16, lane), ldfrag(VsT, 72, vb2, ks * 16, lane), o2);
#pragma unroll
        for (int i = 0; i < 16; ++i) o[i] += o2[i];
#pragma unroll
        for (int j = 0; j < 2; ++j) {
#pragma unroll
            for (int ks = 0; ks < 4; ++ks) accS[j] = MFMA32(ldfrag(KsT, 72, kb, ks * 16, lane), ldfrag(VsT, 72, vb0 + j * 32, ks * 16, lane), accS[j]);
#pragma unroll
            for (int reg = 0; reg < 16; ++reg) accS[j][reg] *= E2[kb + crow(reg, hh)];
        }
#pragma unroll
        for (int reg = 0; reg < 16; ++reg) Of[(tb2 + crow(reg, hh)) * 132 + vb2 + l31] = o[reg];
        lds_barrier();
        {
            const int t = tid >> 3, vs = tid & 7;
            const size_t row = (size_t)(b * 2048 + c * 64 + t);
            f32x4 ov[4]; float ss = 0.f;
#pragma unroll
            for (int i = 0; i < 4; ++i) { ov[i] = *(const f32x4*)(Of + t * 132 + vs * 16 + i * 4); ss += ov[i][0] * ov[i][0] + ov[i][1] * ov[i][1] + ov[i][2] * ov[i][2] + ov[i][3] * ov[i][3]; }
            ss += __shfl_xor(ss, 1); ss += __shfl_xor(ss, 2); ss += __shfl_xor(ss, 4);
            const float rstd = rsqrtf(ss * (1.f / 128.f) + EPSF);
            const float* nwp = P.in[28] + h * 128 + vs * 16;
            const unsigned gw[8] = {gpre0.x, gpre0.y, gpre0.z, gpre0.w, gpre1.x, gpre1.y, gpre1.z, gpre1.w};
            unsigned ow[8];
#pragma unroll
            for (int i = 0; i < 4; ++i) {
                const f32x4 w = *(const f32x4*)(nwp + i * 4);
                ow[2 * i] = pack2(ov[i][0] * rstd * w[0] * silu(bflo(gw[2 * i])), ov[i][1] * rstd * w[1] * silu(bfhi(gw[2 * i])));
                ow[2 * i + 1] = pack2(ov[i][2] * rstd * w[2] * silu(bflo(gw[2 * i + 1])), ov[i][3] * rstd * w[3] * silu(bfhi(gw[2 * i + 1])));
            }
            bf16_t* op = MIX + row * 2048 + h * 128 + vs * 16;
            *(uint4*)op = make_uint4(ow[0], ow[1], ow[2], ow[3]); *(uint4*)(op + 8) = make_uint4(ow[4], ow[5], ow[6], ow[7]);
        }
    }
#undef HG_LOAD
    float* so = P.out + O_CP + (size_t)(b * 16 + h) * 128 * 128;
#pragma unroll
    for (int j = 0; j < 2; ++j)
#pragma unroll
        for (int reg = 0; reg < 16; ++reg) so[(kb + crow(reg, hh)) * 128 + vb0 + j * 32 + l31] = accS[j][reg];
}
DI void hgrn_sample_item(const Params& P, unsigned char* L, int item) {
    const int b = item >> 4, h = item & 15, tid = otid(), lane = tid & 63;
    float* qv = (float*)L; float* egv = qv + 128; float* kkv = egv + 128; float* vv = kkv + 128; float* part = vv + 128; float* red = part + 16 * 128;
    const bf16_t* U = WSP(bf16_t, OFF_U); bf16_t* MIX = WSP(bf16_t, OFF_MIX);
    const size_t row = (size_t)(MP + b); const bf16_t* ub = U + row * INC + h * 128;
    __syncthreads();
    if (tid < 128) {
        const int ch = h * 128 + tid;
        const float lbv = sigm(P.in[27][2048 + ch] - P.in[27][ch]);
        const float sg = sigm(bf2f(ub[2048 + tid])); const float kv = (1.f - lbv) * (1.f - sg);
        qv[tid] = bf2f(ub[tid]) * 0.08838834764831845f; egv[tid] = 1.f - kv; kkv[tid] = kv;
    } else if (tid < 256) vv[tid - 128] = bf2f(ub[4096 + tid - 128]);
    __syncthreads();
    const float* s0 = P.in[8] + (size_t)(b * 16 + h) * 128 * 128; float* s1 = P.out + O_CS + (size_t)(b * 16 + h) * 128 * 128;
    const int v4 = (tid & 31) * 4; const f32x4 vq = *(const f32x4*)(vv + v4);
    f32x4 op = {0.f, 0.f, 0.f, 0.f};
#pragma unroll
    for (int j = 0; j < 8; ++j) {
        const int k = (tid >> 5) + 16 * j;
        const f32x4 s = *(const f32x4*)(s0 + k * 128 + v4);
        const f32x4 sn = s * egv[k] + vq * kkv[k];
        *(f32x4*)(s1 + k * 128 + v4) = sn;
        op += sn * qv[k];
    }
    *(f32x4*)(part + (tid >> 5) * 128 + v4) = op;
    __syncthreads();
    float o = 0.f;
    if (tid < 128) {
#pragma unroll
        for (int i = 0; i < 16; ++i) o += part[i * 128 + tid];
        const float ss = wave_sum(o * o);
        if (lane == 0) red[tid >> 6] = ss;
    }
    __syncthreads();
    if (tid < 128) {
        const float rstd = rsqrtf((red[0] + red[1]) * (1.f / 128.f) + EPSF);
        const int ch = h * 128 + tid;
        MIX[row * 2048 + ch] = f2bf(o * rstd * P.in[28][ch] * silu(bf2f(ub[6144 + tid])));
    }
}
DI void phase_mix1(const Params& P, unsigned char* L) {
    const int tid = otid(), bid = blockIdx.x;
    if (bid < 128) hgrn_prompt_item(P, L, bid);
    else { const int nb = gridDim.x - 128; for (int it = bid - 128; it < 2048; it += nb) hgrn_sample_item(P, L, it); }
}
DI void phase_final(const Params& P) {
    const int lane = threadIdx.x & 63, gw = blockIdx.x * 8 + (threadIdx.x >> 6), nwv = gridDim.x * 8;
    const float* H = WSP(float, OFF_H); const float* SS = WSP(float, OFF_SS2); const float* nf = P.in[10];
    f32x4 w4[4];
#pragma unroll
    for (int i = 0; i < 4; ++i) w4[i] = *(const f32x4*)(nf + lane * 4 + 256 * i);
    for (int r = gw; r < MV; r += nwv) {
        const float rstd = rsqrtf(SS[r] * (1.f / 1024.f) + EPSF);
#pragma unroll
        for (int i = 0; i < 4; ++i) { const f32x4 v = *(const f32x4*)(H + (size_t)r * 1024 + lane * 4 + 256 * i); *(f32x4*)(P.out + O_Y + (size_t)r * 1024 + lane * 4 + 256 * i) = v * rstd * w4[i]; }
    }
}

#define XB_TMO      128
#define XB_XCNT(j)  (256  + 64 * (j))
#define XB_XSUB(j)  (1280 + 64 * (j))
#define XB_XGEN(j)  (2304 + 64 * (j))
#define XB_TOP      3328
#define XB_TOPGEN   3392
#define XCD_BAR_WORDS 3456
#define XB_SPIN_CAP (1u << 18)

__device__ __forceinline__ unsigned xb_ld(unsigned* p)              { return __hip_atomic_load(p, __ATOMIC_RELAXED, __HIP_MEMORY_SCOPE_AGENT); }
__device__ __forceinline__ unsigned xb_add(unsigned* p, unsigned v) { return __hip_atomic_fetch_add(p, v, __ATOMIC_RELAXED, __HIP_MEMORY_SCOPE_AGENT); }
__device__ __forceinline__ unsigned xb_xcc_id() { return (unsigned)__builtin_amdgcn_s_getreg((3 << 11) | 20) & 0xFu; }
#define XB_SPIN(cond, bar) do { unsigned _sp = 0; while (cond) { __builtin_amdgcn_s_sleep(1); \
    if ((++_sp & 255u) == 0u) { if (xb_ld(&(bar)[XB_TMO])) break; if (_sp > XB_SPIN_CAP) { atomicAdd(&(bar)[XB_TMO], 1u); break; } } } } while (0)

struct XcdBarrier {
    unsigned* bar; unsigned x;
    volatile LAS unsigned* st;
};

__device__ __forceinline__ XcdBarrier xcd_barrier_post(unsigned* bar, volatile LAS unsigned* st) {
    XcdBarrier b; b.bar = bar; b.x = xb_xcc_id(); b.st = st;
    if (threadIdx.x == 0) (void)xb_add(&bar[XB_XCNT(b.x)], 1u);
    return b;
}
__device__ __forceinline__ void xcd_barrier_complete(unsigned* bar, unsigned x, unsigned& nloc, unsigned& nx) {
    const unsigned G = gridDim.x * gridDim.y * gridDim.z;
    unsigned sum, cnt, mine, sp = 0u;
    for (;;) {
        sum = 0u; cnt = 0u; mine = 0u;
#pragma unroll
        for (unsigned j = 0; j < 16; ++j) { const unsigned c = xb_ld(&bar[XB_XCNT(j)]); sum += c; cnt += (c > 0u) ? 1u : 0u; mine = (j == x) ? c : mine; }
        if (sum == G) break;
        __builtin_amdgcn_s_sleep(1);
        if ((++sp & 255u) == 0u) { if (xb_ld(&bar[XB_TMO])) break; if (sp > XB_SPIN_CAP) { atomicAdd(&bar[XB_TMO], 1u); break; } }
    }
    nloc = mine > 0u ? mine : 1u; nx = cnt > 0u ? cnt : 1u;
}

__device__ __forceinline__ void xcd_barrier(const XcdBarrier& b) {
    asm volatile("s_waitcnt vmcnt(0)" ::: "memory");
    __syncthreads();
    if (threadIdx.x == 0) {
        unsigned* bar = b.bar;
        __builtin_amdgcn_s_waitcnt(0);
        unsigned nloc = b.st[0], nx = b.st[1];
        if (nloc == 0u) { xcd_barrier_complete(bar, b.x, nloc, nx); b.st[0] = nloc; b.st[1] = nx; }
        const unsigned old = xb_add(&bar[XB_XSUB(b.x)], 1u);
        const unsigned gen = old / nloc;
        if (old + 1u == (gen + 1u) * nloc) {
            __builtin_amdgcn_fence(__ATOMIC_RELEASE, "agent");
            asm volatile("s_waitcnt vmcnt(0)" ::: "memory");
            const unsigned og = xb_add(&bar[XB_TOP], 1u);
            const unsigned tg = og / nx;
            if (og + 1u == (tg + 1u) * nx) xb_add(&bar[XB_TOPGEN], 1u);
            else XB_SPIN(xb_ld(&bar[XB_TOPGEN]) == tg, bar);
            __builtin_amdgcn_fence(__ATOMIC_ACQUIRE, "agent");
            xb_add(&bar[XB_XGEN(b.x)], 1u);
            asm volatile("s_waitcnt vmcnt(0)" ::: "memory");
        } else {
            XB_SPIN(xb_ld(&bar[XB_XGEN(b.x)]) == gen, bar);
            __builtin_amdgcn_fence(__ATOMIC_ACQUIRE, "agent");
            asm volatile("s_waitcnt vmcnt(0)" ::: "memory");
        }
    }
    __syncthreads();
}


#ifndef PHM
#define PHM 0xFFFF
#endif
typedef const __attribute__((address_space(4))) Params* ParamsK;
DI Params getp() {
    ParamsK pp = (ParamsK)__builtin_amdgcn_kernarg_segment_ptr(); asm volatile("" : "+s"(pp));
    Params P;
#pragma unroll
    for (int i = 0; i < 32; ++i) P.in[i] = pp->in[i];
    P.out = pp->out; P.ws = pp->ws; return P;
}
#define GETP() const Params P = getp()
__global__ void __launch_bounds__(512, 2) fwd_kernel(Params Parg) {
    extern __shared__ __attribute__((aligned(16))) unsigned char lds[];
    cg::grid_group grid = cg::this_grid();
    unsigned char* L = (unsigned char*)lds;
    LAS unsigned char* LL = (LAS unsigned char*)lds;
    volatile LAS unsigned* xst = (volatile LAS unsigned*)(LL + LDS_BYTES - 32);
    if (threadIdx.x < 2) xst[threadIdx.x] = 0u;
    __syncthreads();
    XcdBarrier xb;
    { GETP(); xb = xcd_barrier_post(WSP(unsigned, OFF_BAR), xst); }
    if (PHM & 1) { GETP(); phase_prep(P, L); }
    if (gridDim.y == 0xFFFFu) grid.sync();
    xcd_barrier(xb);
    if (PHM & 2) { GETP(); pg8::StaticOrder S; S.init(MP, N0 + 256, gridDim.x, blockIdx.x); pg8::Gemm g{WSP(bf16_t, OFF_XN), WSP(bf16_t, OFF_W0T), MP, N0 + 256, 1024};
      EpiStoreBf16 E{WSP(bf16_t, OFF_U), N0, nullptr, WSP(float, OFF_DT)}; pg8::gemm_phase(LL, g, S, E); }
    { GETP(); SfU f{WSP(bf16_t, OFF_U), N0, nullptr, WSP(float, OFF_DT)}; sgemm<4>(WSP(bf16_t, OFF_XN), WSP(bf16_t, OFF_W0T), 1024, 145, 64 * 19, f, L); }
    xcd_barrier(xb);
    { GETP(); phase_convbc(P); }
    xcd_barrier(xb);
    if (PHM & 4) { GETP(); phase_mix0(P, L); }
    xcd_barrier(xb);
    { GETP(); phase_norm0(P); }
    xcd_barrier(xb);
    if (PHM & 8) { GETP(); pg8::StaticOrder S; S.init(MP, 1024, gridDim.x, blockIdx.x); pg8::Gemm g{WSP(bf16_t, OFF_MIX), WSP(bf16_t, OFF_WO0T), MP, 1024, 2048};
      EpiResid E{P.in[0], P.in[1], WSP(float, OFF_H), WSP(bf16_t, OFF_HB)}; pg8::gemm_phase(LL, g, S, E); }
    { GETP(); SfResid f{P.in[1], WSP(float, OFF_H), WSP(bf16_t, OFF_HB)}; sgemm<4>(WSP(bf16_t, OFF_MIX), WSP(bf16_t, OFF_WO0T), 2048, 32, 256, f, L); }
    xcd_barrier(xb);
    if (PHM & 16) { GETP(); pg8::StaticOrder S; S.init(MP, 1024, gridDim.x, blockIdx.x);
      pg8::Gemm g1{WSP(bf16_t, OFF_HB), WSP(bf16_t, OFF_WG0T), MP, 1024, 1024}; EpiGate E1{WSP(float, OFF_MIX)}; pg8::gemm_phase(LL, g1, S, E1); }
    { GETP(); SfGate f{WSP(float, OFF_MIX)};   sgemm<2>(WSP(bf16_t, OFF_HB), WSP(bf16_t, OFF_WG0T), 1024, 32, 256, f, L); }
    if (PHM & 16) { GETP(); pg8::StaticOrder S; S.init(MP, 1024, gridDim.x, blockIdx.x);
      pg8::Gemm g2{WSP(bf16_t, OFF_PB), WSP(bf16_t, OFF_WP0T), MP, 1024, 256};
      EpiPle E2{WSP(float, OFF_H), WSP(float, OFF_MIX), WSP(bf16_t, OFF_XN), P.in[9] + 1024, WSP(float, OFF_SS1)}; pg8::gemm_phase(LL, g2, S, E2); }
    { GETP(); SfPle f{WSP(float, OFF_H), WSP(float, OFF_MIX), WSP(bf16_t, OFF_XN), P.in[9] + 1024, WSP(float, OFF_SS1)}; sgemm<2>(WSP(bf16_t, OFF_PB), WSP(bf16_t, OFF_WP0T), 256, 32, 256, f, L); }
    xcd_barrier(xb);
    if (PHM & 32) { GETP(); pg8::StaticOrder S; S.init(MP, INC, gridDim.x, blockIdx.x); pg8::Gemm g{WSP(bf16_t, OFF_XN), WSP(bf16_t, OFF_W1T), MP, INC, 1024};
      EpiStoreBf16 E{WSP(bf16_t, OFF_U), INC, WSP(float, OFF_SS1), nullptr}; pg8::gemm_phase(LL, g, S, E); }
    { GETP(); SfU f{WSP(bf16_t, OFF_U), INC, WSP(float, OFF_SS1), nullptr}; sgemm<4>(WSP(bf16_t, OFF_XN), WSP(bf16_t, OFF_W1T), 1024, 256, 64 * 32, f, L); }
    xcd_barrier(xb);
    if (PHM & 64) { GETP(); phase_mix1(P, L); }
    xcd_barrier(xb);
    if (PHM & 128) { GETP(); pg8::StaticOrder S; S.init(MP, 1024, gridDim.x, blockIdx.x); pg8::Gemm g{WSP(bf16_t, OFF_MIX), WSP(bf16_t, OFF_WO1T), MP, 1024, 2048};
      EpiResid E{WSP(float, OFF_H), WSP(float, OFF_H) + (size_t)MP * 1024, WSP(float, OFF_H), WSP(bf16_t, OFF_HB)}; pg8::gemm_phase(LL, g, S, E); }
    { GETP(); SfResid f{WSP(float, OFF_H) + (size_t)MP * 1024, WSP(float, OFF_H), WSP(bf16_t, OFF_HB)}; sgemm<4>(WSP(bf16_t, OFF_MIX), WSP(bf16_t, OFF_WO1T), 2048, 32, 256, f, L); }
    xcd_barrier(xb);
    if (PHM & 256) { GETP(); pg8::StaticOrder S; S.init(MP, 1024, gridDim.x, blockIdx.x);
      pg8::Gemm g1{WSP(bf16_t, OFF_HB), WSP(bf16_t, OFF_WG1T), MP, 1024, 1024}; EpiGate E1{WSP(float, OFF_MIX)}; pg8::gemm_phase(LL, g1, S, E1); }
    { GETP(); SfGate f{WSP(float, OFF_MIX)};   sgemm<2>(WSP(bf16_t, OFF_HB), WSP(bf16_t, OFF_WG1T), 1024, 32, 256, f, L); }
    if (PHM & 256) { GETP(); pg8::StaticOrder S; S.init(MP, 1024, gridDim.x, blockIdx.x);
      pg8::Gemm g2{WSP(bf16_t, OFF_PB + PB_STRIDE), WSP(bf16_t, OFF_WP1T), MP, 1024, 256};
      EpiPle E2{WSP(float, OFF_H), WSP(float, OFF_MIX), nullptr, nullptr, WSP(float, OFF_SS2)}; pg8::gemm_phase(LL, g2, S, E2); }
    { GETP(); SfPle f{WSP(float, OFF_H), WSP(float, OFF_MIX), nullptr, nullptr, WSP(float, OFF_SS2)}; sgemm<2>(WSP(bf16_t, OFF_PB + PB_STRIDE), WSP(bf16_t, OFF_WP1T), 256, 32, 256, f, L); }
    xcd_barrier(xb);
    { GETP(); phase_final(P); }
}

extern "C" void kernel_launch(void* const* d_in, const int* in_sizes, int n_in, void* d_out, int out_size, void* d_ws, size_t ws_size, hipStream_t stream) {
    static int grid = 0;
    if (grid == 0) {
        if (n_in != 32 || ws_size < WS_END) { fprintf(stderr, "kernel_launch: need 32 inputs and %zu bytes of workspace (got %d, %zu)\n", (size_t)WS_END, n_in, ws_size); grid = -1; return; }
        int dev = 0, cus = 0, per_cu = 0;
        (void)hipGetDevice(&dev); (void)hipDeviceGetAttribute(&cus, hipDeviceAttributeMultiprocessorCount, dev);
        if (hipFuncSetAttribute((const void*)fwd_kernel, hipFuncAttributeMaxDynamicSharedMemorySize, LDS_BYTES) != hipSuccess) { fprintf(stderr, "kernel_launch: hipFuncSetAttribute failed\n"); grid = -1; return; }
        if (hipOccupancyMaxActiveBlocksPerMultiprocessor(&per_cu, (const void*)fwd_kernel, 512, LDS_BYTES) != hipSuccess || per_cu < 1) { fprintf(stderr, "kernel_launch: occupancy query says %d\n", per_cu); per_cu = 1; }
        (void)hipGetLastError();
        grid = cus;
    }
    if (grid < 0) return;
    Params p{};
    for (int i = 0; i < 32; ++i) p.in[i] = (const float*)d_in[i];
    p.out = (float*)d_out; p.ws = (unsigned char*)d_ws;
    if (hipMemsetAsync((char*)d_ws + OFF_BAR, 0, 16384, stream) != hipSuccess) { fprintf(stderr, "kernel_launch: memset of barrier words failed\n"); return; }
    void* args[] = {&p};
    hipError_t e = hipLaunchCooperativeKernel((const void*)fwd_kernel, dim3(grid), dim3(512), args, LDS_BYTES, stream);
    if (e != hipSuccess) fprintf(stderr, "cooperative launch failed: %s (grid %d)\n", hipGetErrorString(e), grid);
}
```

```cpp
#include <hip/hip_runtime.h>
#include <hip/hip_cooperative_groups.h>
#include <cstdio>
namespace cg = cooperative_groups;

#define LAS __attribute__((address_space(3)))
#define DI __device__ __forceinline__
typedef unsigned short bf16_t;
typedef short bf16x8 __attribute__((ext_vector_type(8)));
typedef float f32x4 __attribute__((ext_vector_type(4)));
typedef float f32x16 __attribute__((ext_vector_type(16)));

constexpr int MP = 16384, MS = 128, MV = MP + MS, MPAD = 16640;
constexpr int DM = 1024, INAB = 4624, N0 = 4608, INC = 8192;
constexpr float EPSF = 1e-6f;
constexpr size_t O_Y = 0, O_AHP = 16908288, O_ACP = 16916480, O_BSP = 16941056, O_BCP = 17989632, O_CP = 18026496,
                 O_AHS = 20123648, O_ACS = 20254720, O_BSS = 20647936, O_BCS = 37425152, O_CS = 38014976;
constexpr size_t al256(size_t x) { return (x + 255) & ~size_t(255); }
constexpr size_t OFF_CTL = 0;
constexpr size_t OFF_BAR = 256;
constexpr size_t OFF_SS1 = 256 + 16384;
constexpr size_t OFF_SS2 = OFF_SS1 + al256((size_t)MPAD * 4);
constexpr size_t OFF_SSB = OFF_SS2 + al256((size_t)MPAD * 4);
constexpr size_t OFF_DT  = OFF_SSB + al256((size_t)MPAD * 8);
constexpr size_t OFF_W0T = OFF_DT + al256((size_t)MV * 16 * 4);
constexpr size_t OFF_WO0T = OFF_W0T + (size_t)(N0 + 256) * 1024 * 2;
constexpr size_t OFF_WG0T = OFF_WO0T + (size_t)1024 * 2048 * 2;
constexpr size_t OFF_WP0T = OFF_WG0T + (size_t)1024 * 1024 * 2;
constexpr size_t OFF_W1T  = OFF_WP0T + (size_t)1024 * 256 * 2;
constexpr size_t OFF_WO1T = OFF_W1T + (size_t)INC * 1024 * 2;
constexpr size_t OFF_WG1T = OFF_WO1T + (size_t)1024 * 2048 * 2;
constexpr size_t OFF_WP1T = OFF_WG1T + (size_t)1024 * 1024 * 2;
constexpr size_t OFF_WRT  = OFF_WP1T + (size_t)1024 * 256 * 2;
constexpr size_t OFF_WIT  = OFF_WRT + (size_t)128 * 1024 * 2;
constexpr size_t OFF_XN   = OFF_WIT + (size_t)128 * 1024 * 2;
constexpr size_t OFF_MIX  = OFF_XN + (size_t)MPAD * 1024 * 2;
constexpr size_t OFF_H    = OFF_MIX + (size_t)MPAD * 2048 * 2;
constexpr size_t OFF_U    = OFF_H + al256((size_t)MV * 1024 * 4);
constexpr size_t OFF_HB   = OFF_U;
constexpr size_t OFF_PB   = OFF_U + al256((size_t)MV * INC * 2);
constexpr size_t PB_STRIDE = (size_t)MPAD * 256 * 2;
constexpr size_t WS_END   = OFF_PB + 2 * PB_STRIDE;
constexpr int LDS_BYTES = 160 * 1024;

struct Params { const float* in[32]; float* out; unsigned char* ws; };
#define WSP(T, off) ((T*)(P.ws + (off)))

typedef __bf16 bf16v2_t __attribute__((ext_vector_type(2)));
typedef float f32v2_t __attribute__((ext_vector_type(2)));
DI unsigned pack2(float lo, float hi) { f32v2_t v = {lo, hi}; bf16v2_t b = __builtin_convertvector(v, bf16v2_t); return __builtin_bit_cast(unsigned, b); }
DI bf16_t f2bf(float f) { return __builtin_bit_cast(bf16_t, (__bf16)f); }
DI float bf2f(bf16_t b) { return __uint_as_float(((unsigned)b) << 16); }
DI float bflo(unsigned w) { return __uint_as_float(w << 16); }
DI float bfhi(unsigned w) { return __uint_as_float(w & 0xFFFF0000u); }
DI float frcp(float x) { return __builtin_amdgcn_rcpf(x); }
DI float sigm(float x) { return frcp(1.f + __expf(-x)); }
DI float silu(float x) { return x * frcp(1.f + __expf(-x)); }
DI float softplus(float x) { return x > 20.f ? x : log1pf(__expf(x)); }
DI float wave_sum(float v) { for (int o = 32; o > 0; o >>= 1) v += __shfl_xor(v, o); return v; }
DI int otid() { int t = threadIdx.x; asm volatile("" : "+v"(t)); return t; }
DI void lds_barrier() { asm volatile("s_waitcnt lgkmcnt(0)" ::: "memory"); __builtin_amdgcn_s_barrier(); asm volatile("" ::: "memory"); }
DI int crow(int reg, int hh) { return (reg & 3) + 8 * (reg >> 2) + 4 * hh; }
DI void ld4bf(const bf16_t* p, float (&o)[4]) { uint2 w = *(const uint2*)p; o[0] = bflo(w.x); o[1] = bfhi(w.x); o[2] = bflo(w.y); o[3] = bfhi(w.y); }
typedef unsigned u32x2 __attribute__((ext_vector_type(2)));
typedef unsigned u32x4 __attribute__((ext_vector_type(4)));
DI u32x2 pack4v(float a, float b, float c, float d) { u32x2 r; r.x = pack2(a, b); r.y = pack2(c, d); return r; }
DI uint2 pack4(float a, float b, float c, float d) { uint2 r; r.x = pack2(a, b); r.y = pack2(c, d); return r; }
#define MFMA32(a, b, c) __builtin_amdgcn_mfma_f32_32x32x16_bf16((a), (b), (c), 0, 0, 0)
#define MFMA16(a, b, c) __builtin_amdgcn_mfma_f32_16x16x32_bf16((a), (b), (c), 0, 0, 0)
DI bf16x8 ldfrag(const bf16_t* base, int ld, int row0, int k0, int lane) { return *(const bf16x8*)(base + (row0 + (lane & 31)) * ld + k0 + 8 * (lane >> 5)); }
DI bf16x8 ldfrag16(const bf16_t* base, int ld, int row0, int k0, int lane) { return *(const bf16x8*)(base + (row0 + (lane & 15)) * ld + k0 + 8 * (lane >> 4)); }

namespace pg8 {
constexpr int BM = 256, BK = 64, HALF = 128, HTB = HALF * BK * 2, STAGE_BYTES = 8 * HTB, NXCD = 8, WGM = 8;
DI int lds_byte(int r, int c) { const int st = (r >> 4) * 2 + (c >> 5), rr = r & 15, cc = c & 31, ob = rr * 64 + cc * 2; return st * 1024 + (ob ^ (((ob >> 9) & 1) << 5)); }
DI void stage_rc(int b, int& R, int& C) { const int st = b / 1024, sb = b % 1024, swz = sb ^ (((sb >> 9) & 1) << 5); R = (st >> 1) * 16 + swz / 64; C = (st & 1) * 32 + (swz % 64) / 2; }
DI int perm32(int rho) { const int n = rho >> 4, i = rho & 15; return 8 * (i >> 2) + 4 * n + (i & 3); }
struct Unit { int pm, pn; };
struct Gemm { const bf16_t* A; const bf16_t* Bt; int M, N, K; };
struct StaticOrder {
    int nM, nN, nwg, G, c;
    DI void init(int M, int N, int G_, int c_) { nM = M / BM; nN = N / BM; nwg = nM * nN; G = G_; c = c_; }
    DI bool next(int i, Unit& u) const {
        const long L = (long)i * G + c; if (L >= nwg) return false;
        int wgid = (int)L; { const int q = nwg / NXCD, r = nwg % NXCD, xcd = wgid % NXCD, off = wgid / NXCD; wgid = (xcd < r ? xcd * (q + 1) : r * (q + 1) + (xcd - r) * q) + off; }
        const int nig = WGM * nN, gid = wgid / nig, fm = gid * WGM, gsz = (nM - fm) < WGM ? (nM - fm) : WGM;
        u.pm = fm + ((wgid % nig) % gsz); u.pn = (wgid % nig) / gsz; return true;
    }
};

template <class Epi>
DI void gemm_phase(LAS unsigned char* lds, const Gemm g, const StaticOrder& S, const Epi& E) {
    const int tid = otid(), wid = __builtin_amdgcn_readfirstlane(tid >> 6), lane = tid & 63, wr = wid >> 2, wc = wid & 3, fr = lane & 15, fq = lane >> 4;
    const int K = g.K, nt = K / BK;
    unsigned voffA[2], voffB[2];
#pragma unroll
    for (int i = 0; i < 2; ++i) { int R, C; stage_rc(tid * 16 + i * 8192, R, C); const int Rb = Epi::PERM ? ((R & ~31) + perm32(R & 31)) : R;
        voffA[i] = (unsigned)(R * K + C) * 2u; voffB[i] = (unsigned)(Rb * K + C) * 2u; }
    const size_t kstep = (size_t)(BK * 2);
    const size_t hstep = (size_t)HALF * K * 2;
    const size_t tstep = 2 * hstep;
    const unsigned ldsw = (unsigned)wid * 1024u;
    const int aoff = lds_byte(wr * 64 + fr, fq * 8), boff = lds_byte(wc * 32 + fr, fq * 8);
#define PG8_SA(b, h) (((b) * 2 + (h)) * HTB)
#define PG8_SB(b, h) ((4 + (b) * 2 + (h)) * HTB)
#define PG8_STAGE(bufoff, gbase, voff) do { _Pragma("unroll") for (int _i = 0; _i < 2; ++_i) \
        __builtin_amdgcn_global_load_lds((const unsigned*)((const char*)(gbase) + (voff)[_i]), (LAS unsigned*)(lds + (bufoff) + ldsw + _i * 8192), 16, 0, 0); } while (0)
#define PG8_LDA(dst, b, h) do { _Pragma("unroll") for (int m = 0; m < 4; ++m) _Pragma("unroll") for (int k = 0; k < 2; ++k) dst[m][k] = *(const LAS bf16x8*)(lds + PG8_SA(b, h) + aoff + m * 2048 + k * 1024); } while (0)
#define PG8_LDB(dst, b, h) do { _Pragma("unroll") for (int n = 0; n < 2; ++n) _Pragma("unroll") for (int k = 0; k < 2; ++k) dst[n][k] = *(const LAS bf16x8*)(lds + PG8_SB(b, h) + boff + n * 2048 + k * 1024); } while (0)
#define PG8_MMA(ai, bj, At, Bt) do { __builtin_amdgcn_s_setprio(1); _Pragma("unroll") for (int m = 0; m < 4; ++m) _Pragma("unroll") for (int n = 0; n < 2; ++n) _Pragma("unroll") for (int k = 0; k < 2; ++k) \
        acc[ai][bj][m][n] = __builtin_amdgcn_mfma_f32_16x16x32_bf16(Bt[n][k], At[m][k], acc[ai][bj][m][n], 0, 0, 0); __builtin_amdgcn_s_setprio(0); } while (0)
#define PG8_WAIT_V(n) asm volatile("s_waitcnt vmcnt(" #n ")" ::: "memory")
#define PG8_WAIT_L(n) asm volatile("s_waitcnt lgkmcnt(" #n ")" ::: "memory")
#define PG8_BAR __builtin_amdgcn_s_barrier()
#define PG8_SCHED __builtin_amdgcn_sched_barrier(0)
    Unit cur, nxt; int ui = 0;
    if (!S.next(0, cur)) return;
    f32x4 acc[2][2][4][2];
#pragma unroll
    for (int a = 0; a < 2; ++a)
#pragma unroll
        for (int b = 0; b < 2; ++b)
#pragma unroll
            for (int m = 0; m < 4; ++m)
#pragma unroll
                for (int n = 0; n < 2; ++n) acc[a][b][m][n] = (f32x4){0.f, 0.f, 0.f, 0.f};
    bf16x8 At[4][2], B0[2][2], B1[2][2];
    const char* cA = (const char*)g.A + (size_t)cur.pm * tstep; const char* cB = (const char*)g.Bt + (size_t)cur.pn * tstep;
    PG8_STAGE(PG8_SB(0, 0), cB, voffB); PG8_STAGE(PG8_SA(0, 0), cA, voffA); PG8_STAGE(PG8_SB(0, 1), cB + hstep, voffB); PG8_STAGE(PG8_SA(0, 1), cA + hstep, voffA);
    if (wr == 1) PG8_BAR;
    PG8_WAIT_V(4); PG8_BAR;
    PG8_STAGE(PG8_SB(1, 0), cB + kstep, voffB); PG8_STAGE(PG8_SA(1, 0), cA + kstep, voffA); PG8_STAGE(PG8_SB(1, 1), cB + hstep + kstep, voffB);
    PG8_WAIT_V(6); PG8_BAR;
    for (;;) {
        const bool has_next = S.next(ui + 1, nxt);
        const char* nA = has_next ? (const char*)g.A + (size_t)nxt.pm * tstep : cA; const char* nB = has_next ? (const char*)g.Bt + (size_t)nxt.pn * tstep : cB;
        for (int t = 0; t < nt; t += 2) {
            const bool last = (t == nt - 2);
            const char* a1 = cA + (size_t)(t + 1) * kstep;
            const char* a2 = last ? nA : cA + (size_t)(t + 2) * kstep; const char* b2 = last ? nB : cB + (size_t)(t + 2) * kstep;
            const char* a3 = a2 + kstep; const char* b3 = b2 + kstep;
            PG8_LDB(B0, 0, 0); PG8_SCHED; PG8_LDA(At, 0, 0); PG8_STAGE(PG8_SA(1, 1), a1 + hstep, voffA);
            PG8_WAIT_L(8); PG8_BAR; PG8_WAIT_L(0); PG8_MMA(0, 0, At, B0); PG8_BAR; PG8_SCHED;
            PG8_LDB(B1, 0, 1); PG8_STAGE(PG8_SB(0, 0), b2, voffB);
            PG8_BAR; PG8_WAIT_L(0); PG8_MMA(0, 1, At, B1); PG8_BAR;
            PG8_LDA(At, 0, 1); PG8_STAGE(PG8_SA(0, 0), a2, voffA);
            PG8_BAR; PG8_WAIT_L(0); PG8_MMA(1, 0, At, B0); PG8_BAR; PG8_SCHED;
            PG8_STAGE(PG8_SB(0, 1), b2 + hstep, voffB);
            PG8_WAIT_V(6); PG8_BAR; PG8_MMA(1, 1, At, B1); PG8_BAR;
            PG8_LDB(B0, 1, 0); PG8_SCHED; PG8_LDA(At, 1, 0); PG8_STAGE(PG8_SA(0, 1), a2 + hstep, voffA);
            PG8_WAIT_L(8); PG8_BAR; PG8_WAIT_L(0); PG8_MMA(0, 0, At, B0); PG8_BAR; PG8_SCHED;
            PG8_LDB(B1, 1, 1); PG8_STAGE(PG8_SB(1, 0), b3, voffB);
            PG8_BAR; PG8_WAIT_L(0); PG8_MMA(0, 1, At, B1); PG8_BAR;
            PG8_LDA(At, 1, 1); PG8_STAGE(PG8_SA(1, 0), a3, voffA);
            PG8_BAR; PG8_WAIT_L(0); PG8_MMA(1, 0, At, B0); PG8_BAR; PG8_SCHED;
            PG8_STAGE(PG8_SB(1, 1), b3 + hstep, voffB);
            PG8_WAIT_V(6); PG8_BAR; PG8_MMA(1, 1, At, B1); PG8_BAR;
        }
        E(acc, cur, wr, wc, fr, fq);
        if (!has_next) break;
#pragma unroll
        for (int a = 0; a < 2; ++a)
#pragma unroll
            for (int b = 0; b < 2; ++b)
#pragma unroll
                for (int m = 0; m < 4; ++m)
#pragma unroll
                    for (int n = 0; n < 2; ++n) acc[a][b][m][n] = (f32x4){0.f, 0.f, 0.f, 0.f};
        cur = nxt; cA = nA; cB = nB; ++ui;
    }
    PG8_WAIT_V(0);
    if (wr == 0) PG8_BAR;
    PG8_BAR;
#undef PG8_SA
#undef PG8_SB
#undef PG8_STAGE
#undef PG8_LDA
#undef PG8_LDB
#undef PG8_MMA
#undef PG8_WAIT_V
#undef PG8_WAIT_L
#undef PG8_BAR
#undef PG8_SCHED
}
}

struct EpiStoreBf16 {
    static constexpr bool PERM = true;
    bf16_t* O; int ldc; const float* ss; float* DT;
    DI void operator()(const f32x4 (&acc)[2][2][4][2], const pg8::Unit& u, int wr, int wc, int fr, int fq) const {
        const int row0 = u.pm * 256 + wr * 64 + fr, col0 = u.pn * 256 + wc * 32 + 8 * fq;
        if (u.pn * 256 >= ldc) {
            if (wc == 0 && fq < 2) {
#pragma unroll
                for (int ai = 0; ai < 2; ++ai)
#pragma unroll
                    for (int m = 0; m < 4; ++m) { const int row = row0 + ai * 128 + m * 16;
                        if (row < MV) { *(f32x4*)(DT + (size_t)row * 16 + 8 * fq) = acc[ai][0][m][0]; *(f32x4*)(DT + (size_t)row * 16 + 8 * fq + 4) = acc[ai][0][m][1]; } }
            }
            return;
        }
#pragma unroll
        for (int ai = 0; ai < 2; ++ai)
#pragma unroll
            for (int m = 0; m < 4; ++m) {
                const int row = row0 + ai * 128 + m * 16;
                if (row < MV) {
                    const float sc = ss ? rsqrtf(ss[row] * (1.f / 1024.f) + EPSF) : 1.f;
                    bf16_t* rp = O + (size_t)row * ldc + col0;
#pragma unroll
                    for (int bj = 0; bj < 2; ++bj) {
                        const f32x4 v0 = acc[ai][bj][m][0] * sc, v1 = acc[ai][bj][m][1] * sc;
                        uint4 w; w.x = pack2(v0[0], v0[1]); w.y = pack2(v0[2], v0[3]); w.z = pack2(v1[0], v1[1]); w.w = pack2(v1[2], v1[3]);
                        *(uint4*)(rp + bj * 128) = w;
                    }
                }
            }
    }
};
struct EpiResid {
    static constexpr bool PERM = false;
    const float* rp_prompt; const float* rp_sample;
    float* H; bf16_t* HB;
    DI void operator()(const f32x4 (&acc)[2][2][4][2], const pg8::Unit& u, int wr, int wc, int fr, int fq) const {
        const int row0 = u.pm * 256 + wr * 64 + fr, col0 = u.pn * 256 + wc * 32 + 4 * fq;
#pragma unroll
        for (int ai = 0; ai < 2; ++ai)
#pragma unroll
            for (int m = 0; m < 4; ++m) {
                const int row = row0 + ai * 128 + m * 16;
                if (row < MV) {
                    const float* rs = (row < MP ? rp_prompt + (size_t)row * 1024 : rp_sample + (size_t)(row - MP) * 1024) + col0;
                    float* hp = H + (size_t)row * 1024 + col0; bf16_t* bp = HB + (size_t)row * 1024 + col0;
#pragma unroll
                    for (int bj = 0; bj < 2; ++bj)
#pragma unroll
                        for (int n = 0; n < 2; ++n) {
                            const int co = bj * 128 + n * 16;
                            const f32x4 v = acc[ai][bj][m][n] + *(const f32x4*)(rs + co);
                            *(f32x4*)(hp + co) = v; *(uint2*)(bp + co) = pack4(v[0], v[1], v[2], v[3]);
                        }
                }
            }
    }
};
struct EpiGate {
    static constexpr bool PERM = false;
    float* Gt;
    DI void operator()(const f32x4 (&acc)[2][2][4][2], const pg8::Unit& u, int wr, int wc, int fr, int fq) const {
        const int row0 = u.pm * 256 + wr * 64 + fr, col0 = u.pn * 256 + wc * 32 + 4 * fq;
#pragma unroll
        for (int ai = 0; ai < 2; ++ai)
#pragma unroll
            for (int m = 0; m < 4; ++m) {
                const int row = row0 + ai * 128 + m * 16;
                if (row < MV) {
                    float* gp = Gt + (size_t)row * 1024 + col0;
#pragma unroll
                    for (int bj = 0; bj < 2; ++bj)
#pragma unroll
                        for (int n = 0; n < 2; ++n) {
                            const f32x4 a = acc[ai][bj][m][n];
                            *(f32x4*)(gp + bj * 128 + n * 16) = (f32x4){sigm(a[0]), sigm(a[1]), sigm(a[2]), sigm(a[3])};
                        }
                }
            }
    }
};
struct EpiPle {
    static constexpr bool PERM = false;
    float* H; const float* Gt; bf16_t* XN; const float* nw; float* SS;
    DI void operator()(const f32x4 (&acc)[2][2][4][2], const pg8::Unit& u, int wr, int wc, int fr, int fq) const {
        const int row0 = u.pm * 256 + wr * 64 + fr, col0 = u.pn * 256 + wc * 32 + 4 * fq;
#pragma unroll
        for (int ai = 0; ai < 2; ++ai)
#pragma unroll
            for (int m = 0; m < 4; ++m) {
                const int row = row0 + ai * 128 + m * 16;
                float ssum = 0.f;
                if (row < MV) {
                    float* hp = H + (size_t)row * 1024 + col0; const float* gp = Gt + (size_t)row * 1024 + col0;
#pragma unroll
                    for (int bj = 0; bj < 2; ++bj)
#pragma unroll
                        for (int n = 0; n < 2; ++n) {
                            const int co = bj * 128 + n * 16;
                            const f32x4 v = *(const f32x4*)(hp + co) + *(const f32x4*)(gp + co) * acc[ai][bj][m][n];
                            *(f32x4*)(hp + co) = v;
                            ssum += v[0] * v[0] + v[1] * v[1] + v[2] * v[2] + v[3] * v[3];
                            if (XN) { const f32x4 w = *(const f32x4*)(nw + col0 + co); *(uint2*)(XN + (size_t)row * 1024 + col0 + co) = pack4(v[0] * w[0], v[1] * w[1], v[2] * w[2], v[3] * w[3]); }
                        }
                }
                ssum += __shfl_xor(ssum, 16); ssum += __shfl_xor(ssum, 32);
                if (fq == 0 && row < MV) atomicAdd(SS + row, ssum);
            }
    }
};

template <int KS, class F>
DI void sgemm(const bf16_t* A, const bf16_t* Bt, int K, int ncolt, int nwg_main, const F& f, unsigned char* L) {
    constexpr int RT = 8 / KS, NRS = 128 / (16 * RT);
    const int tid = otid(), lane = tid & 63, wid = __builtin_amdgcn_readfirstlane(tid >> 6), rt = wid % RT, ks = wid / RT;
    const int G = gridDim.x, off = nwg_main % G, Kh = K / KS;
    int li = blockIdx.x, nl = G;
    if (off != 0) { if ((int)blockIdx.x < off) return; li = blockIdx.x - off; nl = G - off; }
    float* red = (float*)L;
    for (int t = li; t < ncolt * NRS; t += nl) {
        const int ct = t / NRS, rs = t % NRS;
        const bf16_t* ap = A + (size_t)(MP + rs * 16 * RT + rt * 16 + (lane & 15)) * K + ks * Kh + 8 * (lane >> 4);
        const bf16_t* bp0 = Bt + (size_t)(ct * 32 + (lane & 15)) * K + ks * Kh + 8 * (lane >> 4);
        const bf16_t* bp1 = bp0 + (size_t)16 * K;
        f32x4 acc0 = {0.f, 0.f, 0.f, 0.f}, acc1 = {0.f, 0.f, 0.f, 0.f};
        bf16x8 a0[4], a1[4], p0[4], p1[4], q0[4], q1[4];
#define SG_LOAD(av, pv, qv, kk) do { _Pragma("unroll") for (int q_ = 0; q_ < 4; ++q_) { av[q_] = *(const bf16x8*)(ap + (kk) + q_ * 32); pv[q_] = *(const bf16x8*)(bp0 + (kk) + q_ * 32); qv[q_] = *(const bf16x8*)(bp1 + (kk) + q_ * 32); } } while (0)
#define SG_MMA(av, pv, qv) do { _Pragma("unroll") for (int q_ = 0; q_ < 4; ++q_) { acc0 = MFMA16(av[q_], pv[q_], acc0); acc1 = MFMA16(av[q_], qv[q_], acc1); } } while (0)
        SG_LOAD(a0, p0, q0, 0);
        for (int k0 = 0; k0 < Kh; k0 += 256) {
            if (k0 + 128 < Kh) SG_LOAD(a1, p1, q1, k0 + 128);
            SG_MMA(a0, p0, q0);
            if (k0 + 256 < Kh) SG_LOAD(a0, p0, q0, k0 + 256);
            if (k0 + 128 < Kh) SG_MMA(a1, p1, q1);
        }
#undef SG_LOAD
#undef SG_MMA
        if (ks > 0) { float* rp = red + (((ks - 1) * RT + rt) * 64 + lane) * 8; *(f32x4*)rp = acc0; *(f32x4*)(rp + 4) = acc1; }
        lds_barrier();
        if (ks == 0) {
#pragma unroll
            for (int j = 0; j < KS - 1; ++j) { const float* rp = red + ((j * RT + rt) * 64 + lane) * 8; acc0 += *(const f32x4*)rp; acc1 += *(const f32x4*)(rp + 4); }
#pragma unroll
            for (int reg = 0; reg < 4; ++reg) {
                const int row = MP + rs * 16 * RT + rt * 16 + (lane >> 4) * 4 + reg, col = ct * 32 + (lane & 15);
                f(row, col, acc0[reg], lane); f(row, col + 16, acc1[reg], lane);
            }
        }
        lds_barrier();
    }
}
struct SfU { bf16_t* O; int ldc; const float* ss; float* DT;
    DI void operator()(int row, int col, float v, int) const {
        if (col >= ldc) { if (col < ldc + 16) DT[(size_t)row * 16 + col - ldc] = v; return; }
        const float sc = ss ? rsqrtf(ss[row] * (1.f / 1024.f) + EPSF) : 1.f; O[(size_t)row * ldc + col] = f2bf(v * sc); } };
struct SfResid { const float* rs; float* H; bf16_t* HB;
    DI void operator()(int row, int col, float v, int) const { const float h = rs[(size_t)(row - MP) * 1024 + col] + v; H[(size_t)row * 1024 + col] = h; HB[(size_t)row * 1024 + col] = f2bf(h); } };
struct SfGate { float* Gt; DI void operator()(int row, int col, float v, int) const { Gt[(size_t)row * 1024 + col] = sigm(v); } };
struct SfPle { float* H; const float* Gt; bf16_t* XN; const float* nw; float* SS;
    DI void operator()(int row, int col, float v, int lane) const {
        const size_t o = (size_t)row * 1024 + col; const float h = H[o] + Gt[o] * v; H[o] = h;
        if (XN) XN[o] = f2bf(h * nw[col]);
        float ss = h * h; ss += __shfl_xor(ss, 1); ss += __shfl_xor(ss, 2); ss += __shfl_xor(ss, 4); ss += __shfl_xor(ss, 8);
        if ((lane & 15) == 0) atomicAdd(SS + row, ss); } };

DI void transpose_tile_w(const float* src, int lds_, bf16_t* dst, int ldd, int k0, int n0, int nvalid, float* tile, int lane) {
    const float* sp = src + (size_t)k0 * lds_ + n0 + lane;
#pragma unroll
    for (int bt = 0; bt < 4; ++bt) {
        float v[16];
#pragma unroll
        for (int r = 0; r < 16; ++r) v[r] = (lane < nvalid) ? sp[(size_t)(bt * 16 + r) * lds_] : 0.f;
#pragma unroll
        for (int r = 0; r < 16; ++r) tile[(bt * 16 + r) * 65 + lane] = v[r];
    }
    const int koct = lane & 7;
#pragma unroll
    for (int p = 0; p < 8; ++p) {
        const int nn = (lane >> 3) + 8 * p;
        const float* tp = tile + (koct * 8) * 65 + nn;
        uint4 w;
        w.x = pack2(tp[0], tp[65]); w.y = pack2(tp[2 * 65], tp[3 * 65]); w.z = pack2(tp[4 * 65], tp[5 * 65]); w.w = pack2(tp[6 * 65], tp[7 * 65]);
        *(uint4*)(dst + (size_t)(n0 + nn) * ldd + k0 + koct * 8) = w;
    }
}
DI void transpose_job(const float* src, int lds_, bf16_t* dst, int ldd, int K, int N, int nvalid_last, int& base, float* tile, int gw, int nwv, int lane) {
    const int ntn = (N + 63) / 64, nt = (K / 64) * ntn;
    const int first = (gw - (base % nwv) + nwv) % nwv;
    for (int t = first; t < nt; t += nwv) { const int tn = t % ntn; transpose_tile_w(src, lds_, dst, ldd, (t / ntn) * 64, tn * 64, (tn == ntn - 1) ? nvalid_last : 64, tile, lane); }
    base += nt;
}
DI void l1_weight_tile(const Params& P, int t, float* tile, int lane) {
    if (t < 2048) transpose_tile_w(P.in[26], INC, WSP(bf16_t, OFF_W1T), 1024, (t >> 7) * 64, (t & 127) * 64, 64, tile, lane);
    else if (t < 2560) { t -= 2048; transpose_tile_w(P.in[29], 1024, WSP(bf16_t, OFF_WO1T), 2048, (t >> 4) * 64, (t & 15) * 64, 64, tile, lane); }
    else if (t < 2816) { t -= 2560; transpose_tile_w(P.in[31] + 1024 * 1024, 1024, WSP(bf16_t, OFF_WG1T), 1024, (t >> 4) * 64, (t & 15) * 64, 64, tile, lane); }
    else if (t < 2880) { t -= 2816; transpose_tile_w(P.in[30] + 256 * 1024, 1024, WSP(bf16_t, OFF_WP1T), 256, (t >> 4) * 64, (t & 15) * 64, 64, tile, lane); }
    else if (t < 3392) { t -= 2880; transpose_tile_w(P.in[25], 1024, WSP(bf16_t, OFF_WO0T), 2048, (t >> 4) * 64, (t & 15) * 64, 64, tile, lane); }
    else if (t < 3648) { t -= 3392; transpose_tile_w(P.in[31], 1024, WSP(bf16_t, OFF_WG0T), 1024, (t >> 4) * 64, (t & 15) * 64, 64, tile, lane); }
    else { t -= 3648; transpose_tile_w(P.in[30], 1024, WSP(bf16_t, OFF_WP0T), 256, (t >> 4) * 64, (t & 15) * 64, 64, tile, lane); }
}
DI void phase_prep(const Params& P, unsigned char* L) {
    const int tid = otid(), lane = tid & 63, wid = tid >> 6;
    const int gw = blockIdx.x * 8 + wid, nwv = gridDim.x * 8;
    { float* z = WSP(float, OFF_SS1); const int n = (int)((OFF_DT - OFF_SS1) / 4);
      for (int i = blockIdx.x * 512 + tid; i < n; i += gridDim.x * 512) z[i] = 0.f;
      if (blockIdx.x == 0 && tid < 64) WSP(unsigned, OFF_CTL)[tid] = 0u; }
    { float* tile = (float*)L + wid * (64 * 65); int base = 0;
      transpose_job(P.in[11], INAB, WSP(bf16_t, OFF_W0T), 1024, 1024, N0, 64, base, tile, gw, nwv, lane);
      transpose_job(P.in[11] + N0, INAB, WSP(bf16_t, OFF_W0T) + (size_t)N0 * 1024, 1024, 1024, 16, 16, base, tile, gw, nwv, lane);
      transpose_job(P.in[14], 128, WSP(bf16_t, OFF_WRT), 1024, 1024, 128, 64, base, tile, gw, nwv, lane);
      transpose_job(P.in[16], 128, WSP(bf16_t, OFF_WIT), 1024, 1024, 128, 64, base, tile, gw, nwv, lane); }
    { const float* nwp = P.in[9]; bf16_t* XN = WSP(bf16_t, OFF_XN);
      f32x4 w4[4];
#pragma unroll
      for (int i = 0; i < 4; ++i) w4[i] = *(const f32x4*)(nwp + lane * 4 + 256 * i);
      for (int r0 = gw * 2; r0 < MV; r0 += nwv * 2) {
          f32x4 x[2][4];
#pragma unroll
          for (int q = 0; q < 2; ++q) { const int r = r0 + q; const float* src = r < MP ? P.in[0] + (size_t)r * 1024 : P.in[1] + (size_t)(r - MP) * 1024;
#pragma unroll
              for (int i = 0; i < 4; ++i) x[q][i] = *(const f32x4*)(src + lane * 4 + 256 * i); }
#pragma unroll
          for (int q = 0; q < 2; ++q) {
              float ss = 0.f;
#pragma unroll
              for (int i = 0; i < 4; ++i) ss += x[q][i][0] * x[q][i][0] + x[q][i][1] * x[q][i][1] + x[q][i][2] * x[q][i][2] + x[q][i][3] * x[q][i][3];
              ss = wave_sum(ss); const float rstd = rsqrtf(ss * (1.f / 1024.f) + EPSF);
#pragma unroll
              for (int i = 0; i < 4; ++i) { const f32x4 v = x[q][i] * rstd * w4[i]; *(uint2*)(XN + (size_t)(r0 + q) * 1024 + lane * 4 + 256 * i) = pack4(v[0], v[1], v[2], v[3]); }
          }
      } }
}
DI void convert_p_chunk(const Params& P, int layer, int chunk, int tid) {
    bf16_t* PB = WSP(bf16_t, OFF_PB + (size_t)layer * PB_STRIDE);
    const float* pp = P.in[2] + (size_t)layer * MP * 256; const float* ps = P.in[3] + (size_t)layer * MS * 256;
#pragma unroll 4
    for (int j = 0; j < 16; ++j) {
        const int i = chunk * 8192 + j * 512 + tid;
        if (i < MV * 64) {
            const int row = i >> 6, c4 = (i & 63) * 4;
            const f32x4 v = *(const f32x4*)((row < MP ? pp + (size_t)row * 256 : ps + (size_t)(row - MP) * 256) + c4);
            *(uint2*)(PB + (size_t)row * 256 + c4) = pack4(v[0], v[1], v[2], v[3]);
        }
    }
}

constexpr size_t OFF_XT = OFF_XN;
constexpr size_t OFF_CN = OFF_H;
constexpr size_t OFF_BN = OFF_CN + (size_t)MP * 256 * 2;
constexpr size_t OFF_BT = OFF_BN + (size_t)MP * 256 * 2;
DI void phase_convbc(const Params& P) {
    const bf16_t* U = WSP(bf16_t, OFF_U);
    bf16_t* XT = WSP(bf16_t, OFF_XT); bf16_t* CN = WSP(bf16_t, OFF_CN); bf16_t* BN = WSP(bf16_t, OFF_BN); bf16_t* BT = WSP(bf16_t, OFF_BT);
    for (int idx = blockIdx.x * 512 + otid(); idx < 2048 * 384; idx += gridDim.x * 512) {
        const int quad = idx % 384, tgp = idx / 384, b = tgp >> 8, t0 = (tgp & 255) * 8, cch = quad * 4;
        float cw[4][4], cbias[4];
#pragma unroll
        for (int kk = 0; kk < 4; ++kk) { const f32x4 w = *(const f32x4*)(P.in[19] + kk * 1536 + cch); cw[kk][0] = w[0]; cw[kk][1] = w[1]; cw[kk][2] = w[2]; cw[kk][3] = w[3]; }
        { const f32x4 w = *(const f32x4*)(P.in[20] + cch); cbias[0] = w[0]; cbias[1] = w[1]; cbias[2] = w[2]; cbias[3] = w[3]; }
        const unsigned voff = (unsigned)((b * 2048 + t0) * N0 + 3072 + cch);
        uint2 raw[11];
#pragma unroll
        for (int j = 0; j < 11; ++j) raw[j] = (t0 + j - 3 >= 0) ? *(const uint2*)((U + (j - 3) * N0) + voff) : make_uint2(0u, 0u);
        float y[8][4];
#pragma unroll
        for (int j = 0; j < 8; ++j) {
            const float x0[4] = {bflo(raw[j].x), bfhi(raw[j].x), bflo(raw[j].y), bfhi(raw[j].y)};
            const float x1[4] = {bflo(raw[j + 1].x), bfhi(raw[j + 1].x), bflo(raw[j + 1].y), bfhi(raw[j + 1].y)};
            const float x2[4] = {bflo(raw[j + 2].x), bfhi(raw[j + 2].x), bflo(raw[j + 2].y), bfhi(raw[j + 2].y)};
            const float x3[4] = {bflo(raw[j + 3].x), bfhi(raw[j + 3].x), bflo(raw[j + 3].y), bfhi(raw[j + 3].y)};
#pragma unroll
            for (int e = 0; e < 4; ++e) y[j][e] = silu(cbias[e] + cw[0][e] * x0[e] + cw[1][e] * x1[e] + cw[2][e] * x2[e] + cw[3][e] * x3[e]);
        }
        const int c = t0 >> 7, tl = t0 & 127;
        if (cch < 1024) {
#pragma unroll
            for (int e = 0; e < 4; ++e) { uint4 w; w.x = pack2(y[0][e], y[1][e]); w.y = pack2(y[2][e], y[3][e]); w.z = pack2(y[4][e], y[5][e]); w.w = pack2(y[6][e], y[7][e]);
                *(uint4*)(XT + ((size_t)((b * 16 + c) * 1024 + cch + e)) * 128 + tl) = w; }
        } else {
            const int cc = cch - 1024, isC = cc >= 256, g = (cc & 255) >> 7, n0 = cc & 127;
            bf16_t* nat = (isC ? CN : BN) + ((size_t)(((b * 16 + c) * 2 + g) * 128 + tl)) * 128 + n0;
#pragma unroll
            for (int j = 0; j < 8; ++j) *(uint2*)(nat + j * 128) = pack4(y[j][0], y[j][1], y[j][2], y[j][3]);
            if (!isC) {
#pragma unroll
                for (int e = 0; e < 4; ++e) { uint4 w; w.x = pack2(y[0][e], y[1][e]); w.y = pack2(y[2][e], y[3][e]); w.z = pack2(y[4][e], y[5][e]); w.w = pack2(y[6][e], y[7][e]);
                    *(uint4*)(BT + ((size_t)(((b * 16 + c) * 2 + g) * 128 + n0 + e)) * 128 + tl) = w; }
            }
        }
    }
}
DI void ssd_prompt_item(const Params& P, unsigned char* L, int item) {
    const int b = item >> 4, h = item & 15, g = h >> 3;
    const int tid0 = otid(), wid = tid0 >> 6;
    bf16_t* Cs = (bf16_t*)L;
    bf16_t* Bs = Cs + 128 * 136;
    bf16_t* BsT = Bs + 128 * 136;
    bf16_t* XsT = BsT + 128 * 136;
    bf16_t* St = XsT + 64 * 136;
    bf16_t* XwT = St + 64 * 136;
    float* dtvB = (float*)(XwT + 64 * 136); float* acsB = dtvB + 256; float* wvB = acsB + 256;
    const bf16_t* U = WSP(bf16_t, OFF_U); const float* DT = WSP(float, OFF_DT); bf16_t* MIX = WSP(bf16_t, OFF_MIX); float* SSB = WSP(float, OFF_SSB);
    const float a_neg = -__expf(P.in[22][h]), dtb = P.in[21][h], Dh = P.in[23][h];
    f32x16 accS;
#pragma unroll
    for (int i = 0; i < 16; ++i) accS[i] = 0.f;
    lds_barrier();
    for (int i = tid0; i < 64 * 136; i += 512) St[i] = 0;
    float dtr0 = 0.f, dtr1 = 0.f;
#define SSD_DTLOAD(cc) do { if (wid == 0) { const float* dp_ = DT + (size_t)(b * 2048 + (cc) * 128 + (tid0 & 63)) * 16 + h; dtr0 = dp_[0]; dtr1 = dp_[64 * 16]; } } while (0)
#define SSD_SCAN(buf) do { if (wid == 0) { const int ln_ = tid0 & 63; const float d0_ = softplus(dtr0 + dtb), d1_ = softplus(dtr1 + dtb); float v0_ = d0_ * a_neg, v1_ = d1_ * a_neg; \
        _Pragma("unroll") for (int o_ = 1; o_ < 64; o_ <<= 1) { const float n0_ = __shfl_up(v0_, o_), n1_ = __shfl_up(v1_, o_); if (ln_ >= o_) { v0_ += n0_; v1_ += n1_; } } \
        v1_ += __shfl(v0_, 63); const float al_ = __shfl(v1_, 63); \
        dtvB[(buf) * 128 + ln_] = d0_; dtvB[(buf) * 128 + 64 + ln_] = d1_; acsB[(buf) * 128 + ln_] = v0_; acsB[(buf) * 128 + 64 + ln_] = v1_; \
        wvB[(buf) * 128 + ln_] = __expf(al_ - v0_) * d0_; wvB[(buf) * 128 + 64 + ln_] = __expf(al_ - v1_) * d1_; } } while (0)
    SSD_DTLOAD(0); SSD_SCAN(0); SSD_DTLOAD(1);
    u32x4 tC[4], tB[4], tT[4], tX[2];
    for (int c = 0; c < 16; ++c) {
        const int row0 = b * 2048 + c * 128;
        lds_barrier();
        int zv = 0; asm volatile("" : "+v"(zv));
        const int tid = tid0 + zv, lane = tid & 63, hh = lane >> 5, l31 = lane & 31;
        const int prow = tid >> 4, pcol = (tid & 15) * 8;
        const float* dtv = dtvB + (c & 1) * 128; const float* acs = acsB + (c & 1) * 128; const float* wv = wvB + (c & 1) * 128;
        if (c + 1 < 16) { SSD_SCAN((c + 1) & 1); if (c + 2 < 16) SSD_DTLOAD(c + 2); }
        if (c == 0) {
            const size_t tb_ = ((size_t)((b * 16 + c) * 2 + g)) * 128 * 128 + (size_t)prow * 128 + pcol;
            const u32x4* pc = (const u32x4*)(WSP(bf16_t, OFF_CN) + tb_); const u32x4* pb = (const u32x4*)(WSP(bf16_t, OFF_BN) + tb_); const u32x4* pt = (const u32x4*)(WSP(bf16_t, OFF_BT) + tb_);
            const u32x4* px = (const u32x4*)(WSP(bf16_t, OFF_XT) + ((size_t)((b * 16 + c) * 1024 + h * 64 + prow)) * 128 + pcol);
#pragma unroll
            for (int i = 0; i < 4; ++i) { tC[i] = pc[i * 512]; tB[i] = pb[i * 512]; tT[i] = pt[i * 512]; }
            tX[0] = px[0]; tX[1] = px[512];
        }
        const float a_last = acs[127];
#pragma unroll
        for (int i = 0; i < 4; ++i) {
            *(u32x4*)(Cs + (prow + 32 * i) * 136 + pcol) = tC[i]; *(u32x4*)(Bs + (prow + 32 * i) * 136 + pcol) = tB[i]; *(u32x4*)(BsT + (prow + 32 * i) * 136 + pcol) = tT[i];
        }
        *(u32x4*)(XsT + prow * 136 + pcol) = tX[0]; *(u32x4*)(XsT + (prow + 32) * 136 + pcol) = tX[1];
        {
            const f32x4 w0 = *(const f32x4*)(wv + pcol), w1 = *(const f32x4*)(wv + pcol + 4);
            u32x4 oa, ob; const u32x4 xa = tX[0], xb_ = tX[1];
            oa.x = pack2(bflo(xa.x) * w0[0], bfhi(xa.x) * w0[1]); oa.y = pack2(bflo(xa.y) * w0[2], bfhi(xa.y) * w0[3]); oa.z = pack2(bflo(xa.z) * w1[0], bfhi(xa.z) * w1[1]); oa.w = pack2(bflo(xa.w) * w1[2], bfhi(xa.w) * w1[3]);
            ob.x = pack2(bflo(xb_.x) * w0[0], bfhi(xb_.x) * w0[1]); ob.y = pack2(bflo(xb_.y) * w0[2], bfhi(xb_.y) * w0[3]); ob.z = pack2(bflo(xb_.z) * w1[0], bfhi(xb_.z) * w1[1]); ob.w = pack2(bflo(xb_.w) * w1[2], bfhi(xb_.w) * w1[3]);
            *(u32x4*)(XwT + prow * 136 + pcol) = oa; *(u32x4*)(XwT + (prow + 32) * 136 + pcol) = ob;
        }
        if (c + 1 < 16) {
            const size_t tb_ = ((size_t)((b * 16 + c + 1) * 2 + g)) * 128 * 128 + (size_t)prow * 128 + pcol;
            const u32x4* pc = (const u32x4*)(WSP(bf16_t, OFF_CN) + tb_); const u32x4* pb = (const u32x4*)(WSP(bf16_t, OFF_BN) + tb_); const u32x4* pt = (const u32x4*)(WSP(bf16_t, OFF_BT) + tb_);
            const u32x4* px = (const u32x4*)(WSP(bf16_t, OFF_XT) + ((size_t)((b * 16 + c + 1) * 1024 + h * 64 + prow)) * 128 + pcol);
#pragma unroll
            for (int i = 0; i < 4; ++i) { tC[i] = pc[i * 512]; tB[i] = pb[i * 512]; tT[i] = pt[i * 512]; }
            tX[0] = px[0]; tX[1] = px[512];
        }
        bf16_t zr[16];
        {
            const unsigned zoff = (unsigned)((row0 + (wid >> 1) * 32 + 4 * hh) * N0 + 2048 + h * 64 + (wid & 1) * 32 + l31);
#pragma unroll
            for (int reg = 0; reg < 16; ++reg) zr[reg] = (U + ((reg & 3) + 8 * (reg >> 2)) * N0)[zoff];
        }
        lds_barrier();
        {
            const int rb = (wid >> 1) * 32, cb0 = (wid & 1) * 64;
            f32x16 cbA[2];
#pragma unroll
            for (int i = 0; i < 16; ++i) { cbA[0][i] = 0.f; cbA[1][i] = 0.f; }
#pragma unroll
            for (int ks = 0; ks < 8; ++ks) {
                const bf16x8 a = ldfrag(Cs, 136, rb, ks * 16, lane);
                cbA[0] = MFMA32(a, ldfrag(Bs, 136, cb0, ks * 16, lane), cbA[0]);
                cbA[1] = MFMA32(a, ldfrag(Bs, 136, cb0 + 32, ks * 16, lane), cbA[1]);
            }
            lds_barrier();
            bf16_t* Ws = Bs;
#pragma unroll
            for (int j = 0; j < 2; ++j) {
                const int s = cb0 + j * 32 + l31; const float as = acs[s], ds = dtv[s];
#pragma unroll
                for (int reg = 0; reg < 16; ++reg) {
                    const int t = rb + crow(reg, hh);
                    const float v = (s <= t) ? cbA[j][reg] * __expf(acs[t] - as) * ds : 0.f;
                    Ws[t * 136 + s] = f2bf(v);
                }
            }
        }
        lds_barrier();
        {
            const bf16_t* Ws = Bs;
            const int tb = (wid >> 1) * 32, pb = (wid & 1) * 32;
            f32x16 y;
#pragma unroll
            for (int i = 0; i < 16; ++i) y[i] = 0.f;
#pragma unroll
            for (int ks = 0; ks < 8; ++ks) y = MFMA32(ldfrag(Cs, 136, tb, ks * 16, lane), ldfrag(St, 136, pb, ks * 16, lane), y);
            f32x16 y2;
#pragma unroll
            for (int i = 0; i < 16; ++i) y2[i] = 0.f;
#pragma unroll
            for (int ks = 0; ks < 8; ++ks) y2 = MFMA32(ldfrag(Ws, 136, tb, ks * 16, lane), ldfrag(XsT, 136, pb, ks * 16, lane), y2);
#pragma unroll
            for (int reg = 0; reg < 16; ++reg) y[reg] = y[reg] * __expf(acs[tb + crow(reg, hh)]) + y2[reg];
            const int p = pb + l31, ch = h * 64 + p; const float nwv = P.in[24][ch];
#pragma unroll
            for (int reg = 0; reg < 16; ++reg) {
                const int t = tb + crow(reg, hh); const size_t row = (size_t)(row0 + t);
                const float xv = bf2f(XsT[p * 136 + t]); const float z = bf2f(zr[reg]);
                const float yy = (y[reg] + Dh * xv) * silu(z);
                float ss = yy * yy;
                ss += __shfl_xor(ss, 1); ss += __shfl_xor(ss, 2); ss += __shfl_xor(ss, 4); ss += __shfl_xor(ss, 8); ss += __shfl_xor(ss, 16);
                if (l31 == 0) atomicAdd(SSB + row * 2 + g, ss);
                MIX[row * 2048 + 1024 + ch] = f2bf(yy * nwv);
            }
            lds_barrier();
            const int pb2 = (wid >> 2) * 32, nb = (wid & 3) * 32;
            const float ea = __expf(a_last);
#pragma unroll
            for (int reg = 0; reg < 16; ++reg) accS[reg] *= ea;
#pragma unroll
            for (int ks = 0; ks < 8; ++ks) accS = MFMA32(ldfrag(XwT, 136, pb2, ks * 16, lane), ldfrag(BsT, 136, nb, ks * 16, lane), accS);
#pragma unroll
            for (int reg = 0; reg < 16; ++reg) St[(pb2 + crow(reg, hh)) * 136 + nb + l31] = f2bf(accS[reg]);
        }
    }
    {
        const int lane = tid0 & 63, hh = lane >> 5, l31 = lane & 31;
        const int pb2 = (wid >> 2) * 32, nb = (wid & 3) * 32;
        float* o = P.out + O_BSP + (size_t)(b * 16 + h) * 64 * 128;
#pragma unroll
        for (int reg = 0; reg < 16; ++reg) o[(pb2 + crow(reg, hh)) * 128 + nb + l31] = accS[reg];
    }
}
#undef SSD_DTLOAD
#undef SSD_SCAN
DI void ssd_sample_item(const Params& P, unsigned char* L, int item) {
    const int b = item >> 4, h = item & 15, g = h >> 3, tid = otid(), lane = tid & 63;
    float* xs = (float*)L; float* Bv = xs + 64; float* Cv = Bv + 128; float* yv = Cv + 128;
    const bf16_t* U = WSP(bf16_t, OFF_U); bf16_t* MIX = WSP(bf16_t, OFF_MIX); float* SSB = WSP(float, OFF_SSB);
    const size_t row = (size_t)(MP + b);
    __syncthreads();
    if (tid < 320) {
        int cc; if (tid < 64) cc = h * 64 + tid; else if (tid < 192) cc = 1024 + g * 128 + (tid - 64); else cc = 1280 + g * 128 + (tid - 192);
        const float* buf = P.in[7] + (size_t)b * 3 * 1536 + cc;
        const float v = P.in[20][cc] + P.in[19][cc] * buf[0] + P.in[19][1536 + cc] * buf[1536] + P.in[19][2 * 1536 + cc] * buf[2 * 1536] + P.in[19][3 * 1536 + cc] * bf2f(U[row * N0 + 3072 + cc]);
        xs[tid] = silu(v);
    }
    const float dt = softplus(WSP(float, OFF_DT)[row * 16 + h] + P.in[21][h]);
    const float dA = __expf(-dt * __expf(P.in[22][h]));
    __syncthreads();
    const float* s0 = P.in[6] + (size_t)(b * 16 + h) * 64 * 128; float* s1 = P.out + O_BSS + (size_t)(b * 16 + h) * 64 * 128;
    const int n4 = (tid & 31) * 4;
    const f32x4 Bq = *(const f32x4*)(Bv + n4), Cq = *(const f32x4*)(Cv + n4);
#pragma unroll
    for (int j = 0; j < 4; ++j) {
        const int p = (tid >> 5) + 16 * j;
        const f32x4 s = *(const f32x4*)(s0 + p * 128 + n4);
        const float dx = dt * xs[p];
        const f32x4 sn = s * dA + Bq * dx;
        *(f32x4*)(s1 + p * 128 + n4) = sn;
        float yp = sn[0] * Cq[0] + sn[1] * Cq[1] + sn[2] * Cq[2] + sn[3] * Cq[3];
        yp += __shfl_xor(yp, 1); yp += __shfl_xor(yp, 2); yp += __shfl_xor(yp, 4); yp += __shfl_xor(yp, 8); yp += __shfl_xor(yp, 16);
        if ((tid & 31) == 0) yv[p] = yp;
    }
    __syncthreads();
    if (tid < 64) {
        const int ch = h * 64 + tid;
        const float yy = (yv[tid] + P.in[23][h] * xs[tid]) * silu(bf2f(U[row * N0 + 2048 + ch]));
        const float ss = wave_sum(yy * yy);
        if (lane == 0) atomicAdd(SSB + row * 2 + g, ss);
        MIX[row * 2048 + 1024 + ch] = f2bf(yy * P.in[24][ch]);
    }
}
DI void ssd_sample_item4(const Params& P, unsigned char* L, int item) {
    const int b = item >> 2, tid = otid(), gi = tid >> 7, lt = tid & 127, h = (item & 3) * 4 + gi, g = h >> 3;
    float* xs = (float*)L + gi * 512; float* Bv = xs + 64; float* Cv = Bv + 128; float* yv = Cv + 128;
    const bf16_t* U = WSP(bf16_t, OFF_U); bf16_t* MIX = WSP(bf16_t, OFF_MIX); float* SSB = WSP(float, OFF_SSB);
    const size_t row = (size_t)(MP + b);
    __syncthreads();
#pragma unroll
    for (int ps = 0; ps < 3; ++ps) {
        const int idx = lt + 128 * ps;
        if (idx < 320) {
            int cc; if (idx < 64) cc = h * 64 + idx; else if (idx < 192) cc = 1024 + g * 128 + (idx - 64); else cc = 1280 + g * 128 + (idx - 192);
            const float* buf = P.in[7] + (size_t)b * 3 * 1536 + cc;
            const float v = P.in[20][cc] + P.in[19][cc] * buf[0] + P.in[19][1536 + cc] * buf[1536] + P.in[19][2 * 1536 + cc] * buf[2 * 1536] + P.in[19][3 * 1536 + cc] * bf2f(U[row * N0 + 3072 + cc]);
            xs[idx] = silu(v);
        }
    }
    const float dt = softplus(WSP(float, OFF_DT)[row * 16 + h] + P.in[21][h]);
    const float dA = __expf(-dt * __expf(P.in[22][h]));
    __syncthreads();
    const float* s0 = P.in[6] + (size_t)(b * 16 + h) * 64 * 128; float* s1 = P.out + O_BSS + (size_t)(b * 16 + h) * 64 * 128;
    const int n4 = (lt & 31) * 4;
    const f32x4 Bq = *(const f32x4*)(Bv + n4), Cq = *(const f32x4*)(Cv + n4);
    f32x4 sv[16];
#pragma unroll
    for (int j = 0; j < 16; ++j) sv[j] = *(const f32x4*)(s0 + ((lt >> 5) + 4 * j) * 128 + n4);
#pragma unroll
    for (int j = 0; j < 16; ++j) {
        const int p = (lt >> 5) + 4 * j;
        const f32x4 sn = sv[j] * dA + Bq * (dt * xs[p]);
        *(f32x4*)(s1 + p * 128 + n4) = sn;
        float yp = sn[0] * Cq[0] + sn[1] * Cq[1] + sn[2] * Cq[2] + sn[3] * Cq[3];
        yp += __shfl_xor(yp, 1); yp += __shfl_xor(yp, 2); yp += __shfl_xor(yp, 4); yp += __shfl_xor(yp, 8); yp += __shfl_xor(yp, 16);
        if ((lt & 31) == 0) yv[p] = yp;
    }
    __syncthreads();
    if (lt < 64) {
        const int ch = h * 64 + lt;
        const float yy = (yv[lt] + P.in[23][h] * xs[lt]) * silu(bf2f(U[row * N0 + 2048 + ch]));
        const float ss = wave_sum(yy * yy);
        if (lt == 0) atomicAdd(SSB + row * 2 + g, ss);
        MIX[row * 2048 + 1024 + ch] = f2bf(yy * P.in[24][ch]);
    }
}
template <bool SAMPLE>
DI void rglru_item(const Params& P, unsigned char* L, int item) {
    const int tid0 = otid(), wid = tid0 >> 6;
    const int b = SAMPLE ? 0 : (item >> 4), k = (item >> 1) & 7, dh = item & 1;
    bf16_t* Xs = (bf16_t*)L;
    bf16_t* Wg = Xs + 128 * 136;
    float* Aa = (float*)(Wg + 128 * 136);
    float* Uu = Aa + 128 * 64; float* segA = Uu + 128 * 64; float* segH = segA + 512; float* hc = segH + 512;
    const bf16_t* U = WSP(bf16_t, OFF_U); bf16_t* MIX = WSP(bf16_t, OFF_MIX);
    lds_barrier();
    {
        const bf16_t* WRT = WSP(bf16_t, OFF_WRT); const bf16_t* WIT = WSP(bf16_t, OFF_WIT);
#pragma unroll
        for (int i = 0; i < 4; ++i) {
            const int chk = tid0 + i * 512, r = chk >> 4, c8 = (chk & 15) * 8;
            const bf16_t* src = (r < 64 ? WRT + (size_t)(dh * 64 + r) * 1024 : WIT + (size_t)(dh * 64 + r - 64) * 1024) + k * 128 + c8;
            *(u32x4*)(Wg + r * 136 + c8) = *(const u32x4*)src;
        }
        if (tid0 < 64) hc[tid0] = 0.f;
    }
    float sp[4], br[4], bi[4];
#pragma unroll
    for (int ct = 0; ct < 4; ++ct) { const int chd = k * 128 + dh * 64 + ct * 16 + (tid0 & 15); sp[ct] = softplus(-P.in[18][chd]); br[ct] = P.in[15][chd]; bi[ct] = P.in[17][chd]; }
    const int ch0 = k * 128 + (tid0 & 31) * 4;
    float cw[4][4], cbias[4];
#pragma unroll
    for (int kk = 0; kk < 4; ++kk)
#pragma unroll
        for (int e = 0; e < 4; ++e) cw[kk][e] = P.in[12][kk * 1024 + ch0 + e];
#pragma unroll
    for (int e = 0; e < 4; ++e) cbias[e] = P.in[13][ch0 + e];
    u32x2 raw[11];
#define RG_LOAD(tl_) do { const int tg_ = (tl_) * 128 + (tid0 >> 5) * 8; const unsigned vo_ = (unsigned)((b * 2048 + tg_) * N0 + ch0); \
        _Pragma("unroll") for (int j = 0; j < 11; ++j) raw[j] = (tg_ + j - 3 >= 0) ? *(const u32x2*)((U + (j - 3) * N0) + vo_) : (u32x2){0u, 0u}; } while (0)
    if (!SAMPLE) RG_LOAD(0);
    const int ntiles = SAMPLE ? 1 : 16;
    for (int tile = 0; tile < ntiles; ++tile) {
        const int row0 = SAMPLE ? MP : b * 2048 + tile * 128;
        lds_barrier();
        int zv = 0; asm volatile("" : "+v"(zv));
        const int tid = tid0 + zv, lane = tid & 63, quad = tid & 31, seg = tid >> 5;
        const int sd = tid & 63, sseg = wid, sch = k * 128 + dh * 64 + sd;
        bf16_t gt[16];
        if (!SAMPLE) {
            const unsigned goff = (unsigned)((row0 + sseg * 16) * N0 + 1024 + sch);
#pragma unroll
            for (int t = 0; t < 16; ++t) gt[t] = (U + t * N0)[goff];
        }
        if (SAMPLE) {
#pragma unroll
            for (int t = 0; t < 8; ++t) {
                const int bb = seg * 8 + t;
                const float* buf = P.in[5] + (size_t)bb * 3 * 1024 + ch0;
                const f32x4 p0 = *(const f32x4*)buf, p1 = *(const f32x4*)(buf + 1024), p2 = *(const f32x4*)(buf + 2048);
                float cur[4]; ld4bf(U + (size_t)(MP + bb) * N0 + ch0, cur);
                float y[4];
#pragma unroll
                for (int e = 0; e < 4; ++e) y[e] = cbias[e] + cw[0][e] * p0[e] + cw[1][e] * p1[e] + cw[2][e] * p2[e] + cw[3][e] * cur[e];
                *(u32x2*)(Xs + bb * 136 + quad * 4) = pack4v(y[0], y[1], y[2], y[3]);
            }
        } else {
#pragma unroll
            for (int j = 0; j < 8; ++j) {
                const float x0[4] = {bflo(raw[j].x), bfhi(raw[j].x), bflo(raw[j].y), bfhi(raw[j].y)};
                const float x1[4] = {bflo(raw[j + 1].x), bfhi(raw[j + 1].x), bflo(raw[j + 1].y), bfhi(raw[j + 1].y)};
                const float x2[4] = {bflo(raw[j + 2].x), bfhi(raw[j + 2].x), bflo(raw[j + 2].y), bfhi(raw[j + 2].y)};
                const float x3[4] = {bflo(raw[j + 3].x), bfhi(raw[j + 3].x), bflo(raw[j + 3].y), bfhi(raw[j + 3].y)};
                float y[4];
#pragma unroll
                for (int e = 0; e < 4; ++e) y[e] = cbias[e] + cw[0][e] * x0[e] + cw[1][e] * x1[e] + cw[2][e] * x2[e] + cw[3][e] * x3[e];
                *(u32x2*)(Xs + (seg * 8 + j) * 136 + quad * 4) = pack4v(y[0], y[1], y[2], y[3]);
            }
            if (tile + 1 < 16) RG_LOAD(tile + 1);
        }
        lds_barrier();
        {
            f32x4 acc[8];
#pragma unroll
            for (int i = 0; i < 8; ++i) acc[i] = (f32x4){0.f, 0.f, 0.f, 0.f};
#pragma unroll
            for (int ks = 0; ks < 4; ++ks) {
                const bf16x8 a = ldfrag16(Xs, 136, wid * 16, ks * 32, lane);
#pragma unroll
                for (int tl = 0; tl < 8; ++tl) acc[tl] = MFMA16(a, ldfrag16(Wg, 136, tl * 16, ks * 32, lane), acc[tl]);
            }
#pragma unroll
            for (int ct = 0; ct < 4; ++ct)
#pragma unroll
                for (int reg = 0; reg < 4; ++reg) {
                    const int t = wid * 16 + (lane >> 4) * 4 + reg, d = ct * 16 + (lane & 15);
                    const float r = sigm(acc[ct][reg] + br[ct]), gi = sigm(acc[4 + ct][reg] + bi[ct]);
                    const float a = __expf(-8.f * r * sp[ct]);
                    const float uu = __builtin_amdgcn_sqrtf(fmaxf(1.f - a * a, 0.f)) * gi * bf2f(Xs[t * 136 + dh * 64 + d]);
                    if (SAMPLE) {
                        const int chd = k * 128 + dh * 64 + d;
                        const float hn = a * P.in[4][(size_t)t * 1024 + chd] + uu;
                        P.out[O_AHS + (size_t)t * 1024 + chd] = hn;
                        const float gv = bf2f(U[(size_t)(MP + t) * N0 + 1024 + chd]);
                        MIX[(size_t)(MP + t) * 2048 + chd] = f2bf(hn * silu(gv));
                    } else { Aa[t * 64 + d] = a; Uu[t * 64 + d] = uu; }
                }
        }
        if (!SAMPLE) {
            lds_barrier();
            float av[16], uv[16], Ap = 1.f, Hp = 0.f;
#pragma unroll
            for (int t = 0; t < 16; ++t) { av[t] = Aa[(sseg * 16 + t) * 64 + sd]; uv[t] = Uu[(sseg * 16 + t) * 64 + sd]; Hp = av[t] * Hp + uv[t]; Ap *= av[t]; }
            segA[sseg * 64 + sd] = Ap; segH[sseg * 64 + sd] = Hp;
            lds_barrier();
            float hin = hc[sd];
            for (int s2 = 0; s2 < sseg; ++s2) hin = segA[s2 * 64 + sd] * hin + segH[s2 * 64 + sd];
            const unsigned moff = (unsigned)((row0 + sseg * 16) * 2048 + sch);
#pragma unroll
            for (int t = 0; t < 16; ++t) {
                hin = av[t] * hin + uv[t];
                (MIX + t * 2048)[moff] = f2bf(hin * silu(bf2f(gt[t])));
            }
            lds_barrier();
            if (sseg == 7) hc[sd] = hin;
        }
    }
#undef RG_LOAD
    if (!SAMPLE) { lds_barrier(); if (tid0 < 64) P.out[O_AHP + (size_t)b * 1024 + k * 128 + dh * 64 + tid0] = hc[tid0]; }
}
DI void phase_mix0(const Params& P, unsigned char* L) {
    const int tid = otid(), bid = blockIdx.x, G = gridDim.x;
    { const bf16_t* U = WSP(bf16_t, OFF_U);
      for (int i = bid * 512 + tid; i < 8 * 3 * 1024; i += G * 512) { const int c = i & 1023, j = (i >> 10) % 3, b = i / 3072; P.out[O_ACP + i] = bf2f(U[(size_t)(b * 2048 + 2045 + j) * N0 + c]); }
      for (int i = bid * 512 + tid; i < 8 * 3 * 1536; i += G * 512) { const int c = i % 1536, j = (i / 1536) % 3, b = i / 4608; P.out[O_BCP + i] = bf2f(U[(size_t)(b * 2048 + 2045 + j) * N0 + 3072 + c]); }
      for (int i = bid * 512 + tid; i < 128 * 3 * 1024; i += G * 512) { const int c = i & 1023, j = (i >> 10) % 3, b = i / 3072; P.out[O_ACS + i] = j < 2 ? P.in[5][(size_t)(b * 3 + j + 1) * 1024 + c] : bf2f(U[(size_t)(MP + b) * N0 + c]); }
      for (int i = bid * 512 + tid; i < 128 * 3 * 1536; i += G * 512) { const int c = i % 1536, j = (i / 1536) % 3, b = i / 4608; P.out[O_BCS + i] = j < 2 ? P.in[7][(size_t)(b * 3 + j + 1) * 1536 + c] : bf2f(U[(size_t)(MP + b) * N0 + 3072 + c]); } }
    if (bid < 128) { const int x = bid & 7, j = bid >> 3; rglru_item<false>(P, L, (x + 8 * (j >> 1)) * 2 + (j & 1)); }
    else if (bid < 256) { const int x = bid & 7, j = (bid - 128) >> 3, grp = x + 8 * (j >> 3); ssd_prompt_item(P, L, (grp >> 1) * 16 + (grp & 1) * 8 + (j & 7)); }
    unsigned* ctr = WSP(unsigned, OFF_CTL);
    unsigned* bc = (unsigned*)(L + LDS_BYTES - 16);
    for (;;) {
        __syncthreads();
        if (tid == 0) bc[0] = atomicAdd(ctr, 1u);
        __syncthreads();
        const unsigned it = bc[0];
        if (it >= 16u + 512u) break;
        if (it < 16u) rglru_item<true>(P, L, (int)it); else ssd_sample_item4(P, L, (int)(it - 16u));
    }
    for (;;) {
        __syncthreads();
        if (tid == 0) bc[0] = atomicAdd(ctr + 32, 1u);
        __syncthreads();
        const unsigned q = bc[0];
        if (q >= 256u + 104u + 130u) break;
        if (q < 256u) l1_weight_tile(P, (int)q * 8 + (tid >> 6), (float*)L + (tid >> 6) * (64 * 65), tid & 63);
        else if (q < 360u) l1_weight_tile(P, 2880 + ((int)q - 256) * 8 + (tid >> 6), (float*)L + (tid >> 6) * (64 * 65), tid & 63);
        else convert_p_chunk(P, 0, (int)q - 360, tid);
    }
}
DI void phase_norm0(const Params& P) {
    bf16_t* MIX = WSP(bf16_t, OFF_MIX); const float* SSB = WSP(float, OFF_SSB);
    for (int i = blockIdx.x * 512 + threadIdx.x; i < MV * 128; i += gridDim.x * 512) {
        const int row = i >> 7, c8 = (i & 127) * 8, g = c8 >> 9;
        const float sc = rsqrtf(SSB[(size_t)row * 2 + g] * (1.f / 512.f) + EPSF);
        uint4* p = (uint4*)(MIX + (size_t)row * 2048 + 1024 + c8); uint4 w = *p;
        w.x = pack2(bflo(w.x) * sc, bfhi(w.x) * sc); w.y = pack2(bflo(w.y) * sc, bfhi(w.y) * sc); w.z = pack2(bflo(w.z) * sc, bfhi(w.z) * sc); w.w = pack2(bflo(w.w) * sc, bfhi(w.w) * sc);
        *p = w;
    }
}

DI void hgrn_prompt_item(const Params& P, unsigned char* L, int item) {
    const int b = item >> 4, h = item & 15;
    const int tid = otid(), lane = tid & 63, wid = tid >> 6, hh = lane >> 5, l31 = lane & 31;
    bf16_t* Qs = (bf16_t*)L;
    bf16_t* Ks = Qs + 64 * 136;
    bf16_t* KsT = Ks + 64 * 136;
    bf16_t* VsT = KsT + 128 * 72;
    bf16_t* SsT = VsT + 128 * 72;
    bf16_t* As = SsT + 128 * 136;
    float* Gseg = (float*)(As + 64 * 72);
    float* E1 = Gseg + 16 * 128; float* E2 = E1 + 128;
    float* Of = E2 + 128;
    const bf16_t* U = WSP(bf16_t, OFF_U); bf16_t* MIX = WSP(bf16_t, OFF_MIX);
    const int kq = tid & 31, ts = tid >> 5;
    float lb[4];
#pragma unroll
    for (int e = 0; e < 4; ++e) { const int ch = h * 128 + kq * 4 + e; lb[e] = sigm(P.in[27][2048 + ch] - P.in[27][ch]); }
    const int kb = (wid >> 1) * 32, vb0 = (wid & 1) * 64;
    f32x16 accS[2];
#pragma unroll
    for (int i = 0; i < 16; ++i) { accS[0][i] = 0.f; accS[1][i] = 0.f; }
    uint2 rq[4], rf[4], rv[4];
#define HG_LOAD(cc) do { _Pragma("unroll") for (int i = 0; i < 4; ++i) { const bf16_t* bp = U + (size_t)(b * 2048 + (cc) * 64 + ts * 4 + i) * INC + h * 128 + kq * 4; \
        rq[i] = *(const uint2*)bp; rf[i] = *(const uint2*)(bp + 2048); rv[i] = *(const uint2*)(bp + 4096); } } while (0)
    HG_LOAD(0);
    lds_barrier();
    for (int c = 0; c < 32; ++c) {
        u32x4 gpre0, gpre1;
        { const bf16_t* gp = U + (size_t)(b * 2048 + c * 64 + (tid >> 3)) * INC + 6144 + h * 128 + (tid & 7) * 16; gpre0 = *(const u32x4*)gp; gpre1 = *(const u32x4*)(gp + 8); }
        float kk[4][4], cs[4][4];
#pragma unroll
        for (int i = 0; i < 4; ++i) {
            const float fx[4] = {bflo(rf[i].x), bfhi(rf[i].x), bflo(rf[i].y), bfhi(rf[i].y)};
#pragma unroll
            for (int e = 0; e < 4; ++e) {
                const float sg = sigm(fx[e]); const float kv = (1.f - lb[e]) * (1.f - sg);
                kk[i][e] = kv; const float gl = __logf(1.f - kv);
                cs[i][e] = (i == 0 ? 0.f : cs[i - 1][e]) + gl;
            }
        }
        *(f32x4*)(Gseg + ts * 128 + kq * 4) = (f32x4){cs[3][0], cs[3][1], cs[3][2], cs[3][3]};
        lds_barrier();
        f32x4 off = {0.f, 0.f, 0.f, 0.f}, gmid = off, glast = off;
        {
            const int swid = __builtin_amdgcn_readfirstlane(tid >> 6);
            f32x4 pre = {0.f, 0.f, 0.f, 0.f};
#pragma unroll
            for (int s = 0; s < 16; ++s) {
                const f32x4 v = *(const f32x4*)(Gseg + s * 128 + kq * 4);
                if (s == 2 * swid) off = pre;
                if (s == 8) gmid = pre;
                pre += v;
            }
            glast = pre;
            if (ts & 1) off += *(const f32x4*)(Gseg + (ts - 1) * 128 + kq * 4);
        }
        {
            float qt[4][4], kt[4][4], vt[4][4];
#pragma unroll
            for (int i = 0; i < 4; ++i) {
                const float q[4] = {bflo(rq[i].x), bfhi(rq[i].x), bflo(rq[i].y), bfhi(rq[i].y)};
                vt[i][0] = bflo(rv[i].x); vt[i][1] = bfhi(rv[i].x); vt[i][2] = bflo(rv[i].y); vt[i][3] = bfhi(rv[i].y);
#pragma unroll
                for (int e = 0; e < 4; ++e) { const float Gv = off[e] + cs[i][e]; const float ex = __expf(Gv - gmid[e]); qt[i][e] = q[e] * 0.08838834764831845f * ex; kt[i][e] = kk[i][e] * frcp(ex); }
                *(uint2*)(Qs + (ts * 4 + i) * 136 + kq * 4) = pack4(qt[i][0], qt[i][1], qt[i][2], qt[i][3]);
                *(uint2*)(Ks + (ts * 4 + i) * 136 + kq * 4) = pack4(kt[i][0], kt[i][1], kt[i][2], kt[i][3]);
            }
#pragma unroll
            for (int e = 0; e < 4; ++e) {
                *(uint2*)(KsT + (kq * 4 + e) * 72 + ts * 4) = pack4(kt[0][e], kt[1][e], kt[2][e], kt[3][e]);
                *(uint2*)(VsT + (kq * 4 + e) * 72 + ts * 4) = pack4(vt[0][e], vt[1][e], vt[2][e], vt[3][e]);
            }
            if (ts == 0) {
#pragma unroll
                for (int e = 0; e < 4; ++e) { E1[kq * 4 + e] = __expf(gmid[e]); E2[kq * 4 + e] = __expf(glast[e] - gmid[e]); }
            }
        }
        if (c + 1 < 32) HG_LOAD(c + 1);
        lds_barrier();
#pragma unroll
        for (int j = 0; j < 2; ++j) {
#pragma unroll
            for (int reg = 0; reg < 16; ++reg) accS[j][reg] *= E1[kb + crow(reg, hh)];
            const int v = vb0 + j * 32 + l31;
#pragma unroll
            for (int rg = 0; rg < 4; ++rg) *(uint2*)(SsT + v * 136 + kb + 8 * rg + 4 * hh) = pack4(accS[j][4 * rg], accS[j][4 * rg + 1], accS[j][4 * rg + 2], accS[j][4 * rg + 3]);
        }
        if (wid < 4) {
            const int tb = (wid >> 1) * 32, sb = (wid & 1) * 32;
            f32x16 aa;
#pragma unroll
            for (int i = 0; i < 16; ++i) aa[i] = 0.f;
#pragma unroll
            for (int ks = 0; ks < 8; ++ks) aa = MFMA32(ldfrag(Qs, 136, tb, ks * 16, lane), ldfrag(Ks, 136, sb, ks * 16, lane), aa);
            const int s = sb + l31;
#pragma unroll
            for (int reg = 0; reg < 16; ++reg) { const int t = tb + crow(reg, hh); As[t * 72 + s] = f2bf(s <= t ? aa[reg] : 0.f); }
        }
        lds_barrier();
        const int tb2 = (wid >> 2) * 32, vb2 = (wid & 3) * 32;
        f32x16 o, o2;
#pragma unroll
        for (int i = 0; i < 16; ++i) { o[i] = 0.f; o2[i] = 0.f; }
#pragma unroll
        for (int ks = 0; ks < 8; ++ks) o = MFMA32(ldfrag(Qs, 136, tb2, ks * 16, lane), ldfrag(SsT, 136, vb2, ks * 16, lane), o);
#pragma unroll
        for (int ks = 0; ks < 4; ++ks) o2 = MFMA32(ldfrag(As, 72, tb2, ks * 16, lane), ldfrag(VsT, 72, vb2, ks * 16, lane), o2);
#pragma unroll
        for (int i = 0; i < 16; ++i) o[i] += o2[i];
#pragma unroll
        for (int j = 0; j < 2; ++j) {
#pragma unroll
            for (int ks = 0; ks < 4; ++ks) accS[j] = MFMA32(ldfrag(KsT, 72, kb, ks * 16, lane), ldfrag(VsT, 72, vb0 + j * 32, ks * 16, lane), accS[j]);
#pragma unroll
            for (int reg = 0; reg < 16; ++reg) accS[j][reg] *= E2[kb + crow(reg, hh)];
        }
#pragma unroll
        for (int reg = 0; reg < 16; ++reg) Of[(tb2 + crow(reg, hh)) * 132 + vb2 + l31] = o[reg];
        lds_barrier();
        {
            const int t = tid >> 3, vs = tid & 7;
            const size_t row = (size_t)(b * 2048 + c * 64 + t);
            f32x4 ov[4]; float ss = 0.f;
#pragma unroll
            for (int i = 0; i < 4; ++i) { ov[i] = *(const f32x4*)(Of + t * 132 + vs * 16 + i * 4); ss += ov[i][0] * ov[i][0] + ov[i][1] * ov[i][1] + ov[i][2] * ov[i][2] + ov[i][3] * ov[i][3]; }
            ss += __shfl_xor(ss, 1); ss += __shfl_xor(ss, 2); ss += __shfl_xor(ss, 4);
            const float rstd = rsqrtf(ss * (1.f / 128.f) + EPSF);
            const float* nwp = P.in[28] + h * 128 + vs * 16;
            const unsigned gw[8] = {gpre0.x, gpre0.y, gpre0.z, gpre0.w, gpre1.x, gpre1.y, gpre1.z, gpre1.w};
            unsigned ow[8];
#pragma unroll
            for (int i = 0; i < 4; ++i) {
                const f32x4 w = *(const f32x4*)(nwp + i * 4);
                ow[2 * i] = pack2(ov[i][0] * rstd * w[0] * silu(bflo(gw[2 * i])), ov[i][1] * rstd * w[1] * silu(bfhi(gw[2 * i])));
                ow[2 * i + 1] = pack2(ov[i][2] * rstd * w[2] * silu(bflo(gw[2 * i + 1])), ov[i][3] * rstd * w[3] * silu(bfhi(gw[2 * i + 1])));
            }
            bf16_t* op = MIX + row * 2048 + h * 128 + vs * 16;
            *(uint4*)op = make_uint4(ow[0], ow[1], ow[2], ow[3]); *(uint4*)(op + 8) = make_uint4(ow[4], ow[5], ow[6], ow[7]);
        }
    }
#undef HG_LOAD
    float* so = P.out + O_CP + (size_t)(b * 16 + h) * 128 * 128;
#pragma unroll
    for (int j = 0; j < 2; ++j)
#pragma unroll
        for (int reg = 0; reg < 16; ++reg) so[(kb + crow(reg, hh)) * 128 + vb0 + j * 32 + l31] = accS[j][reg];
}
DI void hgrn_sample_item(const Params& P, unsigned char* L, int item) {
    const int b = item >> 4, h = item & 15, tid = otid(), lane = tid & 63;
    float* qv = (float*)L; float* egv = qv + 128; float* kkv = egv + 128; float* vv = kkv + 128; float* part = vv + 128; float* red = part + 16 * 128;
    const bf16_t* U = WSP(bf16_t, OFF_U); bf16_t* MIX = WSP(bf16_t, OFF_MIX);
    const size_t row = (size_t)(MP + b); const bf16_t* ub = U + row * INC + h * 128;
    __syncthreads();
    if (tid < 128) {
        const int ch = h * 128 + tid;
        const float lbv = sigm(P.in[27][2048 + ch] - P.in[27][ch]);
        const float sg = sigm(bf2f(ub[2048 + tid])); const float kv = (1.f - lbv) * (1.f - sg);
        qv[tid] = bf2f(ub[tid]) * 0.08838834764831845f; egv[tid] = 1.f - kv; kkv[tid] = kv;
    } else if (tid < 256) vv[tid - 128] = bf2f(ub[4096 + tid - 128]);
    __syncthreads();
    const float* s0 = P.in[8] + (size_t)(b * 16 + h) * 128 * 128; float* s1 = P.out + O_CS + (size_t)(b * 16 + h) * 128 * 128;
    const int v4 = (tid & 31) * 4; const f32x4 vq = *(const f32x4*)(vv + v4);
    f32x4 op = {0.f, 0.f, 0.f, 0.f};
#pragma unroll
    for (int j = 0; j < 8; ++j) {
        const int k = (tid >> 5) + 16 * j;
        const f32x4 s = *(const f32x4*)(s0 + k * 128 + v4);
        const f32x4 sn = s * egv[k] + vq * kkv[k];
        *(f32x4*)(s1 + k * 128 + v4) = sn;
        op += sn * qv[k];
    }
    *(f32x4*)(part + (tid >> 5) * 128 + v4) = op;
    __syncthreads();
    float o = 0.f;
    if (tid < 128) {
#pragma unroll
        for (int i = 0; i < 16; ++i) o += part[i * 128 + tid];
        const float ss = wave_sum(o * o);
        if (lane == 0) red[tid >> 6] = ss;
    }
    __syncthreads();
    if (tid < 128) {
        const float rstd = rsqrtf((red[0] + red[1]) * (1.f / 128.f) + EPSF);
        const int ch = h * 128 + tid;
        MIX[row * 2048 + ch] = f2bf(o * rstd * P.in[28][ch] * silu(bf2f(ub[6144 + tid])));
    }
}
DI void phase_mix1(const Params& P, unsigned char* L) {
    const int tid = otid(), bid = blockIdx.x;
    if (bid < 128) hgrn_prompt_item(P, L, bid);
    else { const int nb = gridDim.x - 128; for (int it = bid - 128; it < 2048; it += nb) hgrn_sample_item(P, L, it); }
    unsigned* ctr = WSP(unsigned, OFF_CTL) + 48;
    unsigned* bc = (unsigned*)(L + LDS_BYTES - 16);
    for (;;) {
        __syncthreads();
        if (tid == 0) bc[0] = atomicAdd(ctr, 1u);
        __syncthreads();
        const unsigned q = bc[0];
        if (q >= 104u + 130u) break;
        if (q < 104u) l1_weight_tile(P, 2048 + (int)q * 8 + (tid >> 6), (float*)L + (tid >> 6) * (64 * 65), tid & 63);
        else convert_p_chunk(P, 1, (int)q - 104, tid);
    }
}
DI void phase_final(const Params& P) {
    const int lane = threadIdx.x & 63, gw = blockIdx.x * 8 + (threadIdx.x >> 6), nwv = gridDim.x * 8;
    const float* H = WSP(float, OFF_H); const float* SS = WSP(float, OFF_SS2); const float* nf = P.in[10];
    f32x4 w4[4];
#pragma unroll
    for (int i = 0; i < 4; ++i) w4[i] = *(const f32x4*)(nf + lane * 4 + 256 * i);
    for (int r = gw; r < MV; r += nwv) {
        const float rstd = rsqrtf(SS[r] * (1.f / 1024.f) + EPSF);
#pragma unroll
        for (int i = 0; i < 4; ++i) { const f32x4 v = *(const f32x4*)(H + (size_t)r * 1024 + lane * 4 + 256 * i); *(f32x4*)(P.out + O_Y + (size_t)r * 1024 + lane * 4 + 256 * i) = v * rstd * w4[i]; }
    }
}

#define XB_TMO      128
#define XB_XCNT(j)  (256  + 64 * (j))
#define XB_XSUB(j)  (1280 + 64 * (j))
#define XB_XGEN(j)  (2304 + 64 * (j))
#define XB_TOP      3328
#define XB_TOPGEN   3392
#define XCD_BAR_WORDS 3456
#define XB_SPIN_CAP (1u << 18)

__device__ __forceinline__ unsigned xb_ld(unsigned* p)              { return __hip_atomic_load(p, __ATOMIC_RELAXED, __HIP_MEMORY_SCOPE_AGENT); }
__device__ __forceinline__ unsigned xb_add(unsigned* p, unsigned v) { return __hip_atomic_fetch_add(p, v, __ATOMIC_RELAXED, __HIP_MEMORY_SCOPE_AGENT); }
__device__ __forceinline__ unsigned xb_xcc_id() { return (unsigned)__builtin_amdgcn_s_getreg((3 << 11) | 20) & 0xFu; }
#define XB_SPIN(cond, bar) do { unsigned _sp = 0; while (cond) { __builtin_amdgcn_s_sleep(1); \
    if ((++_sp & 255u) == 0u) { if (xb_ld(&(bar)[XB_TMO])) break; if (_sp > XB_SPIN_CAP) { atomicAdd(&(bar)[XB_TMO], 1u); break; } } } } while (0)

struct XcdBarrier {
    unsigned* bar; unsigned x;
    volatile LAS unsigned* st;
};

__device__ __forceinline__ XcdBarrier xcd_barrier_post(unsigned* bar, volatile LAS unsigned* st) {
    XcdBarrier b; b.bar = bar; b.x = xb_xcc_id(); b.st = st;
    if (threadIdx.x == 0) (void)xb_add(&bar[XB_XCNT(b.x)], 1u);
    return b;
}
__device__ __forceinline__ void xcd_barrier_complete(unsigned* bar, unsigned x, unsigned& nloc, unsigned& nx) {
    const unsigned G = gridDim.x * gridDim.y * gridDim.z;
    unsigned sum, cnt, mine, sp = 0u;
    for (;;) {
        sum = 0u; cnt = 0u; mine = 0u;
#pragma unroll
        for (unsigned j = 0; j < 16; ++j) { const unsigned c = xb_ld(&bar[XB_XCNT(j)]); sum += c; cnt += (c > 0u) ? 1u : 0u; mine = (j == x) ? c : mine; }
        if (sum == G) break;
        __builtin_amdgcn_s_sleep(1);
        if ((++sp & 255u) == 0u) { if (xb_ld(&bar[XB_TMO])) break; if (sp > XB_SPIN_CAP) { atomicAdd(&bar[XB_TMO], 1u); break; } }
    }
    nloc = mine > 0u ? mine : 1u; nx = cnt > 0u ? cnt : 1u;
}

__device__ __forceinline__ void xcd_barrier(const XcdBarrier& b) {
    asm volatile("s_waitcnt vmcnt(0)" ::: "memory");
    __syncthreads();
    if (threadIdx.x == 0) {
        unsigned* bar = b.bar;
        __builtin_amdgcn_s_waitcnt(0);
        unsigned nloc = b.st[0], nx = b.st[1];
        if (nloc == 0u) { xcd_barrier_complete(bar, b.x, nloc, nx); b.st[0] = nloc; b.st[1] = nx; }
        const unsigned old = xb_add(&bar[XB_XSUB(b.x)], 1u);
        const unsigned gen = old / nloc;
        if (old + 1u == (gen + 1u) * nloc) {
            __builtin_amdgcn_fence(__ATOMIC_RELEASE, "agent");
            asm volatile("s_waitcnt vmcnt(0)" ::: "memory");
            const unsigned og = xb_add(&bar[XB_TOP], 1u);
            const unsigned tg = og / nx;
            if (og + 1u == (tg + 1u) * nx) xb_add(&bar[XB_TOPGEN], 1u);
            else XB_SPIN(xb_ld(&bar[XB_TOPGEN]) == tg, bar);
            __builtin_amdgcn_fence(__ATOMIC_ACQUIRE, "agent");
            xb_add(&bar[XB_XGEN(b.x)], 1u);
            asm volatile("s_waitcnt vmcnt(0)" ::: "memory");
        } else {
            XB_SPIN(xb_ld(&bar[XB_XGEN(b.x)]) == gen, bar);
            __builtin_amdgcn_fence(__ATOMIC_ACQUIRE, "agent");
            asm volatile("s_waitcnt vmcnt(0)" ::: "memory");
        }
    }
    __syncthreads();
}


#ifndef PHM
#define PHM 0xFFFF
#endif
typedef const __attribute__((address_space(4))) Params* ParamsK;
DI Params getp() {
    ParamsK pp = (ParamsK)__builtin_amdgcn_kernarg_segment_ptr(); asm volatile("" : "+s"(pp));
    Params P;
#pragma unroll
    for (int i = 0; i < 32; ++i) P.in[i] = pp->in[i];
    P.out = pp->out; P.ws = pp->ws; return P;
}
#define GETP() const Params P = getp()
__global__ void __launch_bounds__(512, 2) fwd_kernel(Params Parg) {
    extern __shared__ __attribute__((aligned(16))) unsigned char lds[];
    cg::grid_group grid = cg::this_grid();
    unsigned char* L = (unsigned char*)lds;
    LAS unsigned char* LL = (LAS unsigned char*)lds;
    volatile LAS unsigned* xst = (volatile LAS unsigned*)(LL + LDS_BYTES - 32);
    if (threadIdx.x < 2) xst[threadIdx.x] = 0u;
    __syncthreads();
    XcdBarrier xb;
    { GETP(); xb = xcd_barrier_post(WSP(unsigned, OFF_BAR), xst); }
    if (PHM & 1) { GETP(); phase_prep(P, L); }
    if (gridDim.y == 0xFFFFu) grid.sync();
    xcd_barrier(xb);
    if (PHM & 2) { GETP(); pg8::StaticOrder S; S.init(MP, N0 + 256, gridDim.x, blockIdx.x); pg8::Gemm g{WSP(bf16_t, OFF_XN), WSP(bf16_t, OFF_W0T), MP, N0 + 256, 1024};
      EpiStoreBf16 E{WSP(bf16_t, OFF_U), N0, nullptr, WSP(float, OFF_DT)}; pg8::gemm_phase(LL, g, S, E); }
    { GETP(); SfU f{WSP(bf16_t, OFF_U), N0, nullptr, WSP(float, OFF_DT)}; sgemm<4>(WSP(bf16_t, OFF_XN), WSP(bf16_t, OFF_W0T), 1024, 145, 64 * 19, f, L); }
    xcd_barrier(xb);
    { GETP(); phase_convbc(P); }
    xcd_barrier(xb);
    if (PHM & 4) { GETP(); phase_mix0(P, L); }
    xcd_barrier(xb);
    { GETP(); phase_norm0(P); }
    xcd_barrier(xb);
    if (PHM & 8) { GETP(); pg8::StaticOrder S; S.init(MP, 1024, gridDim.x, blockIdx.x); pg8::Gemm g{WSP(bf16_t, OFF_MIX), WSP(bf16_t, OFF_WO0T), MP, 1024, 2048};
      EpiResid E{P.in[0], P.in[1], WSP(float, OFF_H), WSP(bf16_t, OFF_HB)}; pg8::gemm_phase(LL, g, S, E); }
    { GETP(); SfResid f{P.in[1], WSP(float, OFF_H), WSP(bf16_t, OFF_HB)}; sgemm<4>(WSP(bf16_t, OFF_MIX), WSP(bf16_t, OFF_WO0T), 2048, 32, 256, f, L); }
    xcd_barrier(xb);
    if (PHM & 16) { GETP(); pg8::StaticOrder S; S.init(MP, 1024, gridDim.x, blockIdx.x);
      pg8::Gemm g1{WSP(bf16_t, OFF_HB), WSP(bf16_t, OFF_WG0T), MP, 1024, 1024}; EpiGate E1{WSP(float, OFF_MIX)}; pg8::gemm_phase(LL, g1, S, E1); }
    { GETP(); SfGate f{WSP(float, OFF_MIX)};   sgemm<2>(WSP(bf16_t, OFF_HB), WSP(bf16_t, OFF_WG0T), 1024, 32, 256, f, L); }
    if (PHM & 16) { GETP(); pg8::StaticOrder S; S.init(MP, 1024, gridDim.x, blockIdx.x);
      pg8::Gemm g2{WSP(bf16_t, OFF_PB), WSP(bf16_t, OFF_WP0T), MP, 1024, 256};
      EpiPle E2{WSP(float, OFF_H), WSP(float, OFF_MIX), WSP(bf16_t, OFF_XN), P.in[9] + 1024, WSP(float, OFF_SS1)}; pg8::gemm_phase(LL, g2, S, E2); }
    { GETP(); SfPle f{WSP(float, OFF_H), WSP(float, OFF_MIX), WSP(bf16_t, OFF_XN), P.in[9] + 1024, WSP(float, OFF_SS1)}; sgemm<2>(WSP(bf16_t, OFF_PB), WSP(bf16_t, OFF_WP0T), 256, 32, 256, f, L); }
    xcd_barrier(xb);
    if (PHM & 32) { GETP(); pg8::StaticOrder S; S.init(MP, INC, gridDim.x, blockIdx.x); pg8::Gemm g{WSP(bf16_t, OFF_XN), WSP(bf16_t, OFF_W1T), MP, INC, 1024};
      EpiStoreBf16 E{WSP(bf16_t, OFF_U), INC, WSP(float, OFF_SS1), nullptr}; pg8::gemm_phase(LL, g, S, E); }
    { GETP(); SfU f{WSP(bf16_t, OFF_U), INC, WSP(float, OFF_SS1), nullptr}; sgemm<4>(WSP(bf16_t, OFF_XN), WSP(bf16_t, OFF_W1T), 1024, 256, 64 * 32, f, L); }
    xcd_barrier(xb);
    if (PHM & 64) { GETP(); phase_mix1(P, L); }
    xcd_barrier(xb);
    if (PHM & 128) { GETP(); pg8::StaticOrder S; S.init(MP, 1024, gridDim.x, blockIdx.x); pg8::Gemm g{WSP(bf16_t, OFF_MIX), WSP(bf16_t, OFF_WO1T), MP, 1024, 2048};
      EpiResid E{WSP(float, OFF_H), WSP(float, OFF_H) + (size_t)MP * 1024, WSP(float, OFF_H), WSP(bf16_t, OFF_HB)}; pg8::gemm_phase(LL, g, S, E); }
    { GETP(); SfResid f{WSP(float, OFF_H) + (size_t)MP * 1024, WSP(float, OFF_H), WSP(bf16_t, OFF_HB)}; sgemm<4>(WSP(bf16_t, OFF_MIX), WSP(bf16_t, OFF_WO1T), 2048, 32, 256, f, L); }
    xcd_barrier(xb);
    if (PHM & 256) { GETP(); pg8::StaticOrder S; S.init(MP, 1024, gridDim.x, blockIdx.x);
      pg8::Gemm g1{WSP(bf16_t, OFF_HB), WSP(bf16_t, OFF_WG1T), MP, 1024, 1024}; EpiGate E1{WSP(float, OFF_MIX)}; pg8::gemm_phase(LL, g1, S, E1); }
    { GETP(); SfGate f{WSP(float, OFF_MIX)};   sgemm<2>(WSP(bf16_t, OFF_HB), WSP(bf16_t, OFF_WG1T), 1024, 32, 256, f, L); }
    if (PHM & 256) { GETP(); pg8::StaticOrder S; S.init(MP, 1024, gridDim.x, blockIdx.x);
      pg8::Gemm g2{WSP(bf16_t, OFF_PB + PB_STRIDE), WSP(bf16_t, OFF_WP1T), MP, 1024, 256};
      EpiPle E2{WSP(float, OFF_H), WSP(float, OFF_MIX), nullptr, nullptr, WSP(float, OFF_SS2)}; pg8::gemm_phase(LL, g2, S, E2); }
    { GETP(); SfPle f{WSP(float, OFF_H), WSP(float, OFF_MIX), nullptr, nullptr, WSP(float, OFF_SS2)}; sgemm<2>(WSP(bf16_t, OFF_PB + PB_STRIDE), WSP(bf16_t, OFF_WP1T), 256, 32, 256, f, L); }
    xcd_barrier(xb);
    { GETP(); phase_final(P); }
}

extern "C" void kernel_launch(void* const* d_in, const int* in_sizes, int n_in, void* d_out, int out_size, void* d_ws, size_t ws_size, hipStream_t stream) {
    static int grid = 0;
    if (grid == 0) {
        if (n_in != 32 || ws_size < WS_END) { fprintf(stderr, "kernel_launch: need 32 inputs and %zu bytes of workspace (got %d, %zu)\n", (size_t)WS_END, n_in, ws_size); grid = -1; return; }
        int dev = 0, cus = 0, per_cu = 0;
        (void)hipGetDevice(&dev); (void)hipDeviceGetAttribute(&cus, hipDeviceAttributeMultiprocessorCount, dev);
        if (hipFuncSetAttribute((const void*)fwd_kernel, hipFuncAttributeMaxDynamicSharedMemorySize, LDS_BYTES) != hipSuccess) { fprintf(stderr, "kernel_launch: hipFuncSetAttribute failed\n"); grid = -1; return; }
        if (hipOccupancyMaxActiveBlocksPerMultiprocessor(&per_cu, (const void*)fwd_kernel, 512, LDS_BYTES) != hipSuccess || per_cu < 1) { fprintf(stderr, "kernel_launch: occupancy query says %d\n", per_cu); per_cu = 1; }
        (void)hipGetLastError();
        grid = cus;
    }
    if (grid < 0) return;
    Params p{};
    for (int i = 0; i < 32; ++i) p.in[i] = (const float*)d_in[i];
    p.out = (float*)d_out; p.ws = (unsigned char*)d_ws;
    if (hipMemsetAsync((char*)d_ws + OFF_BAR, 0, 16384, stream) != hipSuccess) { fprintf(stderr, "kernel_launch: memset of barrier words failed\n"); return; }
    void* args[] = {&p};
    hipError_t e = hipLaunchCooperativeKernel((const void*)fwd_kernel, dim3(grid), dim3(512), args, LDS_BYTES, stream);
    if (e != hipSuccess) fprintf(stderr, "cooperative launch failed: %s (grid %d)\n", hipGetErrorString(e), grid);
}
```

```cpp
#include <hip/hip_runtime.h>
#include <hip/hip_cooperative_groups.h>
#include <cstdio>
namespace cg = cooperative_groups;

#define LAS __attribute__((address_space(3)))
#define DI __device__ __forceinline__
typedef unsigned short bf16_t;
typedef short bf16x8 __attribute__((ext_vector_type(8)));
typedef float f32x4 __attribute__((ext_vector_type(4)));
typedef float f32x16 __attribute__((ext_vector_type(16)));

constexpr int MP = 16384, MS = 128, MV = MP + MS, MPAD = 16640;
constexpr int DM = 1024, INAB = 4624, N0 = 4608, INC = 8192;
constexpr float EPSF = 1e-6f;
constexpr size_t O_Y = 0, O_AHP = 16908288, O_ACP = 16916480, O_BSP = 16941056, O_BCP = 17989632, O_CP = 18026496,
                 O_AHS = 20123648, O_ACS = 20254720, O_BSS = 20647936, O_BCS = 37425152, O_CS = 38014976;
constexpr size_t al256(size_t x) { return (x + 255) & ~size_t(255); }
constexpr size_t OFF_CTL = 0;
constexpr size_t OFF_BAR = 256;
constexpr size_t OFF_SS1 = 256 + 16384;
constexpr size_t OFF_SS2 = OFF_SS1 + al256((size_t)MPAD * 4);
constexpr size_t OFF_SSB = OFF_SS2 + al256((size_t)MPAD * 4);
constexpr size_t OFF_DT  = OFF_SSB + al256((size_t)MPAD * 8);
constexpr size_t OFF_W0T = OFF_DT + al256((size_t)MV * 16 * 4);
constexpr size_t OFF_WO0T = OFF_W0T + (size_t)(N0 + 256) * 1024 * 2;
constexpr size_t OFF_WG0T = OFF_WO0T + (size_t)1024 * 2048 * 2;
constexpr size_t OFF_WP0T = OFF_WG0T + (size_t)1024 * 1024 * 2;
constexpr size_t OFF_W1T  = OFF_WP0T + (size_t)1024 * 256 * 2;
constexpr size_t OFF_WO1T = OFF_W1T + (size_t)INC * 1024 * 2;
constexpr size_t OFF_WG1T = OFF_WO1T + (size_t)1024 * 2048 * 2;
constexpr size_t OFF_WP1T = OFF_WG1T + (size_t)1024 * 1024 * 2;
constexpr size_t OFF_WRT  = OFF_WP1T + (size_t)1024 * 256 * 2;
constexpr size_t OFF_WIT  = OFF_WRT + (size_t)128 * 1024 * 2;
constexpr size_t OFF_XN   = OFF_WIT + (size_t)128 * 1024 * 2;
constexpr size_t OFF_MIX  = OFF_XN + (size_t)MPAD * 1024 * 2;
constexpr size_t OFF_H    = OFF_MIX + (size_t)MPAD * 2048 * 2;
constexpr size_t OFF_U    = OFF_H + al256((size_t)MV * 1024 * 4);
constexpr size_t OFF_HB   = OFF_U;
constexpr size_t OFF_PB   = OFF_U + al256((size_t)MV * INC * 2);
constexpr size_t PB_STRIDE = (size_t)MPAD * 256 * 2;
constexpr size_t WS_END   = OFF_PB + 2 * PB_STRIDE;
constexpr int LDS_BYTES = 160 * 1024;

struct Params { const float* in[32]; float* out; unsigned char* ws; };
#define WSP(T, off) ((T*)(P.ws + (off)))

typedef __bf16 bf16v2_t __attribute__((ext_vector_type(2)));
typedef float f32v2_t __attribute__((ext_vector_type(2)));
DI unsigned pack2(float lo, float hi) { f32v2_t v = {lo, hi}; bf16v2_t b = __builtin_convertvector(v, bf16v2_t); return __builtin_bit_cast(unsigned, b); }
DI bf16_t f2bf(float f) { return __builtin_bit_cast(bf16_t, (__bf16)f); }
DI float bf2f(bf16_t b) { return __uint_as_float(((unsigned)b) << 16); }
DI float bflo(unsigned w) { return __uint_as_float(w << 16); }
DI float bfhi(unsigned w) { return __uint_as_float(w & 0xFFFF0000u); }
DI float frcp(float x) { return __builtin_amdgcn_rcpf(x); }
DI float sigm(float x) { return frcp(1.f + __expf(-x)); }
DI float silu(float x) { return x * frcp(1.f + __expf(-x)); }
DI float softplus(float x) { return x > 20.f ? x : log1pf(__expf(x)); }
DI float wave_sum(float v) { for (int o = 32; o > 0; o >>= 1) v += __shfl_xor(v, o); return v; }
DI int otid() { int t = threadIdx.x; asm volatile("" : "+v"(t)); return t; }
DI void lds_barrier() { asm volatile("s_waitcnt lgkmcnt(0)" ::: "memory"); __builtin_amdgcn_s_barrier(); asm volatile("" ::: "memory"); }
DI int crow(int reg, int hh) { return (reg & 3) + 8 * (reg >> 2) + 4 * hh; }
DI void ld4bf(const bf16_t* p, float (&o)[4]) { uint2 w = *(const uint2*)p; o[0] = bflo(w.x); o[1] = bfhi(w.x); o[2] = bflo(w.y); o[3] = bfhi(w.y); }
typedef unsigned u32x2 __attribute__((ext_vector_type(2)));
typedef unsigned u32x4 __attribute__((ext_vector_type(4)));
DI u32x2 pack4v(float a, float b, float c, float d) { u32x2 r; r.x = pack2(a, b); r.y = pack2(c, d); return r; }
DI uint2 pack4(float a, float b, float c, float d) { uint2 r; r.x = pack2(a, b); r.y = pack2(c, d); return r; }
#define MFMA32(a, b, c) __builtin_amdgcn_mfma_f32_32x32x16_bf16((a), (b), (c), 0, 0, 0)
#define MFMA16(a, b, c) __builtin_amdgcn_mfma_f32_16x16x32_bf16((a), (b), (c), 0, 0, 0)
DI bf16x8 ldfrag(const bf16_t* base, int ld, int row0, int k0, int lane) { return *(const bf16x8*)(base + (row0 + (lane & 31)) * ld + k0 + 8 * (lane >> 5)); }
DI bf16x8 ldfrag16(const bf16_t* base, int ld, int row0, int k0, int lane) { return *(const bf16x8*)(base + (row0 + (lane & 15)) * ld + k0 + 8 * (lane >> 4)); }

namespace pg8 {
constexpr int BM = 256, BK = 64, HALF = 128, HTB = HALF * BK * 2, STAGE_BYTES = 8 * HTB, NXCD = 8, WGM = 8;
DI int lds_byte(int r, int c) { const int st = (r >> 4) * 2 + (c >> 5), rr = r & 15, cc = c & 31, ob = rr * 64 + cc * 2; return st * 1024 + (ob ^ (((ob >> 9) & 1) << 5)); }
DI void stage_rc(int b, int& R, int& C) { const int st = b / 1024, sb = b % 1024, swz = sb ^ (((sb >> 9) & 1) << 5); R = (st >> 1) * 16 + swz / 64; C = (st & 1) * 32 + (swz % 64) / 2; }
DI int perm32(int rho) { const int n = rho >> 4, i = rho & 15; return 8 * (i >> 2) + 4 * n + (i & 3); }
struct Unit { int pm, pn; };
struct Gemm { const bf16_t* A; const bf16_t* Bt; int M, N, K; };
struct StaticOrder {
    int nM, nN, nwg, G, c;
    DI void init(int M, int N, int G_, int c_) { nM = M / BM; nN = N / BM; nwg = nM * nN; G = G_; c = c_; }
    DI bool next(int i, Unit& u) const {
        const long L = (long)i * G + c; if (L >= nwg) return false;
        int wgid = (int)L; { const int q = nwg / NXCD, r = nwg % NXCD, xcd = wgid % NXCD, off = wgid / NXCD; wgid = (xcd < r ? xcd * (q + 1) : r * (q + 1) + (xcd - r) * q) + off; }
        const int nig = WGM * nN, gid = wgid / nig, fm = gid * WGM, gsz = (nM - fm) < WGM ? (nM - fm) : WGM;
        u.pm = fm + ((wgid % nig) % gsz); u.pn = (wgid % nig) / gsz; return true;
    }
};

template <class Epi>
DI void gemm_phase(LAS unsigned char* lds, const Gemm g, const StaticOrder& S, const Epi& E) {
    const int tid = otid(), wid = __builtin_amdgcn_readfirstlane(tid >> 6), lane = tid & 63, wr = wid >> 2, wc = wid & 3, fr = lane & 15, fq = lane >> 4;
    const int K = g.K, nt = K / BK;
    unsigned voffA[2], voffB[2];
#pragma unroll
    for (int i = 0; i < 2; ++i) { int R, C; stage_rc(tid * 16 + i * 8192, R, C); const int Rb = Epi::PERM ? ((R & ~31) + perm32(R & 31)) : R;
        voffA[i] = (unsigned)(R * K + C) * 2u; voffB[i] = (unsigned)(Rb * K + C) * 2u; }
    const size_t kstep = (size_t)(BK * 2);
    const size_t hstep = (size_t)HALF * K * 2;
    const size_t tstep = 2 * hstep;
    const unsigned ldsw = (unsigned)wid * 1024u;
    const int aoff = lds_byte(wr * 64 + fr, fq * 8), boff = lds_byte(wc * 32 + fr, fq * 8);
#define PG8_SA(b, h) (((b) * 2 + (h)) * HTB)
#define PG8_SB(b, h) ((4 + (b) * 2 + (h)) * HTB)
#define PG8_STAGE(bufoff, gbase, voff) do { _Pragma("unroll") for (int _i = 0; _i < 2; ++_i) \
        __builtin_amdgcn_global_load_lds((const unsigned*)((const char*)(gbase) + (voff)[_i]), (LAS unsigned*)(lds + (bufoff) + ldsw + _i * 8192), 16, 0, 0); } while (0)
#define PG8_LDA(dst, b, h) do { _Pragma("unroll") for (int m = 0; m < 4; ++m) _Pragma("unroll") for (int k = 0; k < 2; ++k) dst[m][k] = *(const LAS bf16x8*)(lds + PG8_SA(b, h) + aoff + m * 2048 + k * 1024); } while (0)
#define PG8_LDB(dst, b, h) do { _Pragma("unroll") for (int n = 0; n < 2; ++n) _Pragma("unroll") for (int k = 0; k < 2; ++k) dst[n][k] = *(const LAS bf16x8*)(lds + PG8_SB(b, h) + boff + n * 2048 + k * 1024); } while (0)
#define PG8_MMA(ai, bj, At, Bt) do { __builtin_amdgcn_s_setprio(1); _Pragma("unroll") for (int m = 0; m < 4; ++m) _Pragma("unroll") for (int n = 0; n < 2; ++n) _Pragma("unroll") for (int k = 0; k < 2; ++k) \
        acc[ai][bj][m][n] = __builtin_amdgcn_mfma_f32_16x16x32_bf16(Bt[n][k], At[m][k], acc[ai][bj][m][n], 0, 0, 0); __builtin_amdgcn_s_setprio(0); } while (0)
#define PG8_WAIT_V(n) asm volatile("s_waitcnt vmcnt(" #n ")" ::: "memory")
#define PG8_WAIT_L(n) asm volatile("s_waitcnt lgkmcnt(" #n ")" ::: "memory")
#define PG8_BAR __builtin_amdgcn_s_barrier()
#define PG8_SCHED __builtin_amdgcn_sched_barrier(0)
    Unit cur, nxt; int ui = 0;
    if (!S.next(0, cur)) return;
    f32x4 acc[2][2][4][2];
#pragma unroll
    for (int a = 0; a < 2; ++a)
#pragma unroll
        for (int b = 0; b < 2; ++b)
#pragma unroll
            for (int m = 0; m < 4; ++m)
#pragma unroll
                for (int n = 0; n < 2; ++n) acc[a][b][m][n] = (f32x4){0.f, 0.f, 0.f, 0.f};
    bf16x8 At[4][2], B0[2][2], B1[2][2];
    const char* cA = (const char*)g.A + (size_t)cur.pm * tstep; const char* cB = (const char*)g.Bt + (size_t)cur.pn * tstep;
    PG8_STAGE(PG8_SB(0, 0), cB, voffB); PG8_STAGE(PG8_SA(0, 0), cA, voffA); PG8_STAGE(PG8_SB(0, 1), cB + hstep, voffB); PG8_STAGE(PG8_SA(0, 1), cA + hstep, voffA);
    if (wr == 1) PG8_BAR;
    PG8_WAIT_V(4); PG8_BAR;
    PG8_STAGE(PG8_SB(1, 0), cB + kstep, voffB); PG8_STAGE(PG8_SA(1, 0), cA + kstep, voffA); PG8_STAGE(PG8_SB(1, 1), cB + hstep + kstep, voffB);
    PG8_WAIT_V(6); PG8_BAR;
    for (;;) {
        const bool has_next = S.next(ui + 1, nxt);
        const char* nA = has_next ? (const char*)g.A + (size_t)nxt.pm * tstep : cA; const char* nB = has_next ? (const char*)g.Bt + (size_t)nxt.pn * tstep : cB;
        for (int t = 0; t < nt; t += 2) {
            const bool last = (t == nt - 2);
            const char* a1 = cA + (size_t)(t + 1) * kstep;
            const char* a2 = last ? nA : cA + (size_t)(t + 2) * kstep; const char* b2 = last ? nB : cB + (size_t)(t + 2) * kstep;
            const char* a3 = a2 + kstep; const char* b3 = b2 + kstep;
            PG8_LDB(B0, 0, 0); PG8_SCHED; PG8_LDA(At, 0, 0); PG8_STAGE(PG8_SA(1, 1), a1 + hstep, voffA);
            PG8_WAIT_L(8); PG8_BAR; PG8_WAIT_L(0); PG8_MMA(0, 0, At, B0); PG8_BAR; PG8_SCHED;
            PG8_LDB(B1, 0, 1); PG8_STAGE(PG8_SB(0, 0), b2, voffB);
            PG8_BAR; PG8_WAIT_L(0); PG8_MMA(0, 1, At, B1); PG8_BAR;
            PG8_LDA(At, 0, 1); PG8_STAGE(PG8_SA(0, 0), a2, voffA);
            PG8_BAR; PG8_WAIT_L(0); PG8_MMA(1, 0, At, B0); PG8_BAR; PG8_SCHED;
            PG8_STAGE(PG8_SB(0, 1), b2 + hstep, voffB);
            PG8_WAIT_V(6); PG8_BAR; PG8_MMA(1, 1, At, B1); PG8_BAR;
            PG8_LDB(B0, 1, 0); PG8_SCHED; PG8_LDA(At, 1, 0); PG8_STAGE(PG8_SA(0, 1), a2 + hstep, voffA);
            PG8_WAIT_L(8); PG8_BAR; PG8_WAIT_L(0); PG8_MMA(0, 0, At, B0); PG8_BAR; PG8_SCHED;
            PG8_LDB(B1, 1, 1); PG8_STAGE(PG8_SB(1, 0), b3, voffB);
            PG8_BAR; PG8_WAIT_L(0); PG8_MMA(0, 1, At, B1); PG8_BAR;
            PG8_LDA(At, 1, 1); PG8_STAGE(PG8_SA(1, 0), a3, voffA);
            PG8_BAR; PG8_WAIT_L(0); PG8_MMA(1, 0, At, B0); PG8_BAR; PG8_SCHED;
            PG8_STAGE(PG8_SB(1, 1), b3 + hstep, voffB);
            PG8_WAIT_V(6); PG8_BAR; PG8_MMA(1, 1, At, B1); PG8_BAR;
        }
        E(acc, cur, wr, wc, fr, fq);
        if (!has_next) break;
#pragma unroll
        for (int a = 0; a < 2; ++a)
#pragma unroll
            for (int b = 0; b < 2; ++b)
#pragma unroll
                for (int m = 0; m < 4; ++m)
#pragma unroll
                    for (int n = 0; n < 2; ++n) acc[a][b][m][n] = (f32x4){0.f, 0.f, 0.f, 0.f};
        cur = nxt; cA = nA; cB = nB; ++ui;
    }
    PG8_WAIT_V(0);
    if (wr == 0) PG8_BAR;
    PG8_BAR;
#undef PG8_SA
#undef PG8_SB
#undef PG8_STAGE
#undef PG8_LDA
#undef PG8_LDB
#undef PG8_MMA
#undef PG8_WAIT_V
#undef PG8_WAIT_L
#undef PG8_BAR
#undef PG8_SCHED
}
}

struct EpiStoreBf16 {
    static constexpr bool PERM = true;
    bf16_t* O; int ldc; const float* ss; float* DT;
    DI void operator()(const f32x4 (&acc)[2][2][4][2], const pg8::Unit& u, int wr, int wc, int fr, int fq) const {
        const int row0 = u.pm * 256 + wr * 64 + fr, col0 = u.pn * 256 + wc * 32 + 8 * fq;
        if (u.pn * 256 >= ldc) {
            if (wc == 0 && fq < 2) {
#pragma unroll
                for (int ai = 0; ai < 2; ++ai)
#pragma unroll
                    for (int m = 0; m < 4; ++m) { const int row = row0 + ai * 128 + m * 16;
                        if (row < MV) { *(f32x4*)(DT + (size_t)row * 16 + 8 * fq) = acc[ai][0][m][0]; *(f32x4*)(DT + (size_t)row * 16 + 8 * fq + 4) = acc[ai][0][m][1]; } }
            }
            return;
        }
#pragma unroll
        for (int ai = 0; ai < 2; ++ai)
#pragma unroll
            for (int m = 0; m < 4; ++m) {
                const int row = row0 + ai * 128 + m * 16;
                if (row < MV) {
                    const float sc = ss ? rsqrtf(ss[row] * (1.f / 1024.f) + EPSF) : 1.f;
                    bf16_t* rp = O + (size_t)row * ldc + col0;
#pragma unroll
                    for (int bj = 0; bj < 2; ++bj) {
                        const f32x4 v0 = acc[ai][bj][m][0] * sc, v1 = acc[ai][bj][m][1] * sc;
                        uint4 w; w.x = pack2(v0[0], v0[1]); w.y = pack2(v0[2], v0[3]); w.z = pack2(v1[0], v1[1]); w.w = pack2(v1[2], v1[3]);
                        *(uint4*)(rp + bj * 128) = w;
                    }
                }
            }
    }
};
struct EpiResid {
    static constexpr bool PERM = false;
    const float* rp_prompt; const float* rp_sample;
    float* H; bf16_t* HB;
    DI void operator()(const f32x4 (&acc)[2][2][4][2], const pg8::Unit& u, int wr, int wc, int fr, int fq) const {
        const int row0 = u.pm * 256 + wr * 64 + fr, col0 = u.pn * 256 + wc * 32 + 4 * fq;
#pragma unroll
        for (int ai = 0; ai < 2; ++ai)
#pragma unroll
            for (int m = 0; m < 4; ++m) {
                const int row = row0 + ai * 128 + m * 16;
                if (row < MV) {
                    const float* rs = (row < MP ? rp_prompt + (size_t)row * 1024 : rp_sample + (size_t)(row - MP) * 1024) + col0;
                    float* hp = H + (size_t)row * 1024 + col0; bf16_t* bp = HB + (size_t)row * 1024 + col0;
#pragma unroll
                    for (int bj = 0; bj < 2; ++bj)
#pragma unroll
                        for (int n = 0; n < 2; ++n) {
                            const int co = bj * 128 + n * 16;
                            const f32x4 v = acc[ai][bj][m][n] + *(const f32x4*)(rs + co);
                            *(f32x4*)(hp + co) = v; *(uint2*)(bp + co) = pack4(v[0], v[1], v[2], v[3]);
                        }
                }
            }
    }
};
struct EpiGate {
    static constexpr bool PERM = false;
    bf16_t* Gt;
    DI void operator()(const f32x4 (&acc)[2][2][4][2], const pg8::Unit& u, int wr, int wc, int fr, int fq) const {
        const int row0 = u.pm * 256 + wr * 64 + fr, col0 = u.pn * 256 + wc * 32 + 4 * fq;
#pragma unroll
        for (int ai = 0; ai < 2; ++ai)
#pragma unroll
            for (int m = 0; m < 4; ++m) {
                const int row = row0 + ai * 128 + m * 16;
                if (row < MV) {
                    bf16_t* gp = Gt + (size_t)row * 1024 + col0;
#pragma unroll
                    for (int bj = 0; bj < 2; ++bj)
#pragma unroll
                        for (int n = 0; n < 2; ++n) {
                            const f32x4 a = acc[ai][bj][m][n];
                            *(uint2*)(gp + bj * 128 + n * 16) = pack4(sigm(a[0]), sigm(a[1]), sigm(a[2]), sigm(a[3]));
                        }
                }
            }
    }
};
struct EpiPle {
    static constexpr bool PERM = false;
    float* H; const bf16_t* Gt; bf16_t* XN; const float* nw; float* SS;
    DI void operator()(const f32x4 (&acc)[2][2][4][2], const pg8::Unit& u, int wr, int wc, int fr, int fq) const {
        const int row0 = u.pm * 256 + wr * 64 + fr, col0 = u.pn * 256 + wc * 32 + 4 * fq;
#pragma unroll
        for (int ai = 0; ai < 2; ++ai)
#pragma unroll
            for (int m = 0; m < 4; ++m) {
                const int row = row0 + ai * 128 + m * 16;
                float ssum = 0.f;
                if (row < MV) {
                    float* hp = H + (size_t)row * 1024 + col0; const bf16_t* gp = Gt + (size_t)row * 1024 + col0;
#pragma unroll
                    for (int bj = 0; bj < 2; ++bj)
#pragma unroll
                        for (int n = 0; n < 2; ++n) {
                            const int co = bj * 128 + n * 16;
                            float gq[4]; ld4bf(gp + co, gq); const f32x4 v = *(const f32x4*)(hp + co) + (f32x4){gq[0], gq[1], gq[2], gq[3]} * acc[ai][bj][m][n];
                            *(f32x4*)(hp + co) = v;
                            ssum += v[0] * v[0] + v[1] * v[1] + v[2] * v[2] + v[3] * v[3];
                            if (XN) { const f32x4 w = *(const f32x4*)(nw + col0 + co); *(uint2*)(XN + (size_t)row * 1024 + col0 + co) = pack4(v[0] * w[0], v[1] * w[1], v[2] * w[2], v[3] * w[3]); }
                        }
                }
                ssum += __shfl_xor(ssum, 16); ssum += __shfl_xor(ssum, 32);
                if (fq == 0 && row < MV) atomicAdd(SS + row, ssum);
            }
    }
};

template <int KS, class F>
DI void sgemm(const bf16_t* A, const bf16_t* Bt, int K, int ncolt, int nwg_main, const F& f, unsigned char* L) {
    constexpr int RT = 8 / KS, NRS = 128 / (16 * RT);
    const int tid = otid(), lane = tid & 63, wid = __builtin_amdgcn_readfirstlane(tid >> 6), rt = wid % RT, ks = wid / RT;
    const int G = gridDim.x, off = nwg_main % G, Kh = K / KS;
    int li = blockIdx.x, nl = G;
    if (off != 0) { if ((int)blockIdx.x < off) return; li = blockIdx.x - off; nl = G - off; }
    float* red = (float*)L;
    for (int t = li; t < ncolt * NRS; t += nl) {
        const int ct = t / NRS, rs = t % NRS;
        const bf16_t* ap = A + (size_t)(MP + rs * 16 * RT + rt * 16 + (lane & 15)) * K + ks * Kh + 8 * (lane >> 4);
        const bf16_t* bp0 = Bt + (size_t)(ct * 32 + (lane & 15)) * K + ks * Kh + 8 * (lane >> 4);
        const bf16_t* bp1 = bp0 + (size_t)16 * K;
        f32x4 acc0 = {0.f, 0.f, 0.f, 0.f}, acc1 = {0.f, 0.f, 0.f, 0.f};
        bf16x8 a0[4], a1[4], p0[4], p1[4], q0[4], q1[4];
#define SG_LOAD(av, pv, qv, kk) do { _Pragma("unroll") for (int q_ = 0; q_ < 4; ++q_) { av[q_] = *(const bf16x8*)(ap + (kk) + q_ * 32); pv[q_] = *(const bf16x8*)(bp0 + (kk) + q_ * 32); qv[q_] = *(const bf16x8*)(bp1 + (kk) + q_ * 32); } } while (0)
#define SG_MMA(av, pv, qv) do { _Pragma("unroll") for (int q_ = 0; q_ < 4; ++q_) { acc0 = MFMA16(av[q_], pv[q_], acc0); acc1 = MFMA16(av[q_], qv[q_], acc1); } } while (0)
        SG_LOAD(a0, p0, q0, 0);
        for (int k0 = 0; k0 < Kh; k0 += 256) {
            if (k0 + 128 < Kh) SG_LOAD(a1, p1, q1, k0 + 128);
            SG_MMA(a0, p0, q0);
            if (k0 + 256 < Kh) SG_LOAD(a0, p0, q0, k0 + 256);
            if (k0 + 128 < Kh) SG_MMA(a1, p1, q1);
        }
#undef SG_LOAD
#undef SG_MMA
        if (ks > 0) { float* rp = red + (((ks - 1) * RT + rt) * 64 + lane) * 8; *(f32x4*)rp = acc0; *(f32x4*)(rp + 4) = acc1; }
        lds_barrier();
        if (ks == 0) {
#pragma unroll
            for (int j = 0; j < KS - 1; ++j) { const float* rp = red + ((j * RT + rt) * 64 + lane) * 8; acc0 += *(const f32x4*)rp; acc1 += *(const f32x4*)(rp + 4); }
#pragma unroll
            for (int reg = 0; reg < 4; ++reg) {
                const int row = MP + rs * 16 * RT + rt * 16 + (lane >> 4) * 4 + reg, col = ct * 32 + (lane & 15);
                f(row, col, acc0[reg], lane); f(row, col + 16, acc1[reg], lane);
            }
        }
        lds_barrier();
    }
}
struct SfU { bf16_t* O; int ldc; const float* ss; float* DT;
    DI void operator()(int row, int col, float v, int) const {
        if (col >= ldc) { if (col < ldc + 16) DT[(size_t)row * 16 + col - ldc] = v; return; }
        const float sc = ss ? rsqrtf(ss[row] * (1.f / 1024.f) + EPSF) : 1.f; O[(size_t)row * ldc + col] = f2bf(v * sc); } };
struct SfResid { const float* rs; float* H; bf16_t* HB;
    DI void operator()(int row, int col, float v, int) const { const float h = rs[(size_t)(row - MP) * 1024 + col] + v; H[(size_t)row * 1024 + col] = h; HB[(size_t)row * 1024 + col] = f2bf(h); } };
struct SfGate { bf16_t* Gt; DI void operator()(int row, int col, float v, int) const { Gt[(size_t)row * 1024 + col] = f2bf(sigm(v)); } };
struct SfPle { float* H; const bf16_t* Gt; bf16_t* XN; const float* nw; float* SS;
    DI void operator()(int row, int col, float v, int lane) const {
        const size_t o = (size_t)row * 1024 + col; const float h = H[o] + bf2f(Gt[o]) * v; H[o] = h;
        if (XN) XN[o] = f2bf(h * nw[col]);
        float ss = h * h; ss += __shfl_xor(ss, 1); ss += __shfl_xor(ss, 2); ss += __shfl_xor(ss, 4); ss += __shfl_xor(ss, 8);
        if ((lane & 15) == 0) atomicAdd(SS + row, ss); } };

DI void transpose_tile_w(const float* src, int lds_, bf16_t* dst, int ldd, int k0, int n0, int nvalid, float* tile, int lane) {
    const float* sp = src + (size_t)k0 * lds_ + n0 + lane;
#pragma unroll
    for (int bt = 0; bt < 4; ++bt) {
        float v[16];
#pragma unroll
        for (int r = 0; r < 16; ++r) v[r] = (lane < nvalid) ? sp[(size_t)(bt * 16 + r) * lds_] : 0.f;
#pragma unroll
        for (int r = 0; r < 16; ++r) tile[(bt * 16 + r) * 65 + lane] = v[r];
    }
    const int koct = lane & 7;
#pragma unroll
    for (int p = 0; p < 8; ++p) {
        const int nn = (lane >> 3) + 8 * p;
        const float* tp = tile + (koct * 8) * 65 + nn;
        uint4 w;
        w.x = pack2(tp[0], tp[65]); w.y = pack2(tp[2 * 65], tp[3 * 65]); w.z = pack2(tp[4 * 65], tp[5 * 65]); w.w = pack2(tp[6 * 65], tp[7 * 65]);
        *(uint4*)(dst + (size_t)(n0 + nn) * ldd + k0 + koct * 8) = w;
    }
}
DI void transpose_job(const float* src, int lds_, bf16_t* dst, int ldd, int K, int N, int nvalid_last, int& base, float* tile, int gw, int nwv, int lane) {
    const int ntn = (N + 63) / 64, nt = (K / 64) * ntn;
    const int first = (gw - (base % nwv) + nwv) % nwv;
    for (int t = first; t < nt; t += nwv) { const int tn = t % ntn; transpose_tile_w(src, lds_, dst, ldd, (t / ntn) * 64, tn * 64, (tn == ntn - 1) ? nvalid_last : 64, tile, lane); }
    base += nt;
}
DI void l1_weight_tile(const Params& P, int t, float* tile, int lane) {
    if (t < 2048) transpose_tile_w(P.in[26], INC, WSP(bf16_t, OFF_W1T), 1024, (t >> 7) * 64, (t & 127) * 64, 64, tile, lane);
    else if (t < 2560) { t -= 2048; transpose_tile_w(P.in[29], 1024, WSP(bf16_t, OFF_WO1T), 2048, (t >> 4) * 64, (t & 15) * 64, 64, tile, lane); }
    else if (t < 2816) { t -= 2560; transpose_tile_w(P.in[31] + 1024 * 1024, 1024, WSP(bf16_t, OFF_WG1T), 1024, (t >> 4) * 64, (t & 15) * 64, 64, tile, lane); }
    else if (t < 2880) { t -= 2816; transpose_tile_w(P.in[30] + 256 * 1024, 1024, WSP(bf16_t, OFF_WP1T), 256, (t >> 4) * 64, (t & 15) * 64, 64, tile, lane); }
    else if (t < 3392) { t -= 2880; transpose_tile_w(P.in[25], 1024, WSP(bf16_t, OFF_WO0T), 2048, (t >> 4) * 64, (t & 15) * 64, 64, tile, lane); }
    else if (t < 3648) { t -= 3392; transpose_tile_w(P.in[31], 1024, WSP(bf16_t, OFF_WG0T), 1024, (t >> 4) * 64, (t & 15) * 64, 64, tile, lane); }
    else { t -= 3648; transpose_tile_w(P.in[30], 1024, WSP(bf16_t, OFF_WP0T), 256, (t >> 4) * 64, (t & 15) * 64, 64, tile, lane); }
}
DI void phase_prep(const Params& P, unsigned char* L) {
    const int tid = otid(), lane = tid & 63, wid = tid >> 6;
    const int gw = blockIdx.x * 8 + wid, nwv = gridDim.x * 8;
    { float* z = WSP(float, OFF_SS1); const int n = (int)((OFF_DT - OFF_SS1) / 4);
      for (int i = blockIdx.x * 512 + tid; i < n; i += gridDim.x * 512) z[i] = 0.f;
      if (blockIdx.x == 0 && tid < 64) WSP(unsigned, OFF_CTL)[tid] = 0u; }
    { float* tile = (float*)L + wid * (64 * 65); int base = 0;
      transpose_job(P.in[11], INAB, WSP(bf16_t, OFF_W0T), 1024, 1024, N0, 64, base, tile, gw, nwv, lane);
      transpose_job(P.in[11] + N0, INAB, WSP(bf16_t, OFF_W0T) + (size_t)N0 * 1024, 1024, 1024, 16, 16, base, tile, gw, nwv, lane);
      transpose_job(P.in[14], 128, WSP(bf16_t, OFF_WRT), 1024, 1024, 128, 64, base, tile, gw, nwv, lane);
      transpose_job(P.in[16], 128, WSP(bf16_t, OFF_WIT), 1024, 1024, 128, 64, base, tile, gw, nwv, lane); }
    { const float* nwp = P.in[9]; bf16_t* XN = WSP(bf16_t, OFF_XN);
      f32x4 w4[4];
#pragma unroll
      for (int i = 0; i < 4; ++i) w4[i] = *(const f32x4*)(nwp + lane * 4 + 256 * i);
      for (int r0 = gw * 2; r0 < MV; r0 += nwv * 2) {
          f32x4 x[2][4];
#pragma unroll
          for (int q = 0; q < 2; ++q) { const int r = r0 + q; const float* src = r < MP ? P.in[0] + (size_t)r * 1024 : P.in[1] + (size_t)(r - MP) * 1024;
#pragma unroll
              for (int i = 0; i < 4; ++i) x[q][i] = *(const f32x4*)(src + lane * 4 + 256 * i); }
#pragma unroll
          for (int q = 0; q < 2; ++q) {
              float ss = 0.f;
#pragma unroll
              for (int i = 0; i < 4; ++i) ss += x[q][i][0] * x[q][i][0] + x[q][i][1] * x[q][i][1] + x[q][i][2] * x[q][i][2] + x[q][i][3] * x[q][i][3];
              ss = wave_sum(ss); const float rstd = rsqrtf(ss * (1.f / 1024.f) + EPSF);
#pragma unroll
              for (int i = 0; i < 4; ++i) { const f32x4 v = x[q][i] * rstd * w4[i]; *(uint2*)(XN + (size_t)(r0 + q) * 1024 + lane * 4 + 256 * i) = pack4(v[0], v[1], v[2], v[3]); }
          }
      } }
}
DI void convert_p_chunk(const Params& P, int layer, int chunk, int tid) {
    bf16_t* PB = WSP(bf16_t, OFF_PB + (size_t)layer * PB_STRIDE);
    const float* pp = P.in[2] + (size_t)layer * MP * 256; const float* ps = P.in[3] + (size_t)layer * MS * 256;
#pragma unroll 4
    for (int j = 0; j < 16; ++j) {
        const int i = chunk * 8192 + j * 512 + tid;
        if (i < MV * 64) {
            const int row = i >> 6, c4 = (i & 63) * 4;
            const f32x4 v = *(const f32x4*)((row < MP ? pp + (size_t)row * 256 : ps + (size_t)(row - MP) * 256) + c4);
            *(uint2*)(PB + (size_t)row * 256 + c4) = pack4(v[0], v[1], v[2], v[3]);
        }
    }
}

constexpr size_t OFF_XT = OFF_XN;
constexpr size_t OFF_CN = OFF_H;
constexpr size_t OFF_BN = OFF_CN + (size_t)MP * 256 * 2;
constexpr size_t OFF_BT = OFF_BN + (size_t)MP * 256 * 2;
DI void phase_convbc(const Params& P) {
    const bf16_t* U = WSP(bf16_t, OFF_U);
    bf16_t* XT = WSP(bf16_t, OFF_XT); bf16_t* CN = WSP(bf16_t, OFF_CN); bf16_t* BN = WSP(bf16_t, OFF_BN); bf16_t* BT = WSP(bf16_t, OFF_BT);
    for (int idx = blockIdx.x * 512 + otid(); idx < 2048 * 384; idx += gridDim.x * 512) {
        const int quad = idx % 384, tgp = idx / 384, b = tgp >> 8, t0 = (tgp & 255) * 8, cch = quad * 4;
        float cw[4][4], cbias[4];
#pragma unroll
        for (int kk = 0; kk < 4; ++kk) { const f32x4 w = *(const f32x4*)(P.in[19] + kk * 1536 + cch); cw[kk][0] = w[0]; cw[kk][1] = w[1]; cw[kk][2] = w[2]; cw[kk][3] = w[3]; }
        { const f32x4 w = *(const f32x4*)(P.in[20] + cch); cbias[0] = w[0]; cbias[1] = w[1]; cbias[2] = w[2]; cbias[3] = w[3]; }
        const unsigned voff = (unsigned)((b * 2048 + t0) * N0 + 3072 + cch);
        uint2 raw[11];
#pragma unroll
        for (int j = 0; j < 11; ++j) raw[j] = (t0 + j - 3 >= 0) ? *(const uint2*)((U + (j - 3) * N0) + voff) : make_uint2(0u, 0u);
        float y[8][4];
#pragma unroll
        for (int j = 0; j < 8; ++j) {
            const float x0[4] = {bflo(raw[j].x), bfhi(raw[j].x), bflo(raw[j].y), bfhi(raw[j].y)};
            const float x1[4] = {bflo(raw[j + 1].x), bfhi(raw[j + 1].x), bflo(raw[j + 1].y), bfhi(raw[j + 1].y)};
            const float x2[4] = {bflo(raw[j + 2].x), bfhi(raw[j + 2].x), bflo(raw[j + 2].y), bfhi(raw[j + 2].y)};
            const float x3[4] = {bflo(raw[j + 3].x), bfhi(raw[j + 3].x), bflo(raw[j + 3].y), bfhi(raw[j + 3].y)};
#pragma unroll
            for (int e = 0; e < 4; ++e) y[j][e] = silu(cbias[e] + cw[0][e] * x0[e] + cw[1][e] * x1[e] + cw[2][e] * x2[e] + cw[3][e] * x3[e]);
        }
        const int c = t0 >> 7, tl = t0 & 127;
        if (cch < 1024) {
#pragma unroll
            for (int e = 0; e < 4; ++e) { uint4 w; w.x = pack2(y[0][e], y[1][e]); w.y = pack2(y[2][e], y[3][e]); w.z = pack2(y[4][e], y[5][e]); w.w = pack2(y[6][e], y[7][e]);
                *(uint4*)(XT + ((size_t)((b * 16 + c) * 1024 + cch + e)) * 128 + tl) = w; }
        } else {
            const int cc = cch - 1024, isC = cc >= 256, g = (cc & 255) >> 7, n0 = cc & 127;
            bf16_t* nat = (isC ? CN : BN) + ((size_t)(((b * 16 + c) * 2 + g) * 128 + tl)) * 128 + n0;
#pragma unroll
            for (int j = 0; j < 8; ++j) *(uint2*)(nat + j * 128) = pack4(y[j][0], y[j][1], y[j][2], y[j][3]);
            if (!isC) {
#pragma unroll
                for (int e = 0; e < 4; ++e) { uint4 w; w.x = pack2(y[0][e], y[1][e]); w.y = pack2(y[2][e], y[3][e]); w.z = pack2(y[4][e], y[5][e]); w.w = pack2(y[6][e], y[7][e]);
                    *(uint4*)(BT + ((size_t)(((b * 16 + c) * 2 + g) * 128 + n0 + e)) * 128 + tl) = w; }
            }
        }
    }
}
DI void ssd_prompt_item(const Params& P, unsigned char* L, int item) {
    const int b = item >> 4, h = item & 15, g = h >> 3;
    const int tid0 = otid(), wid = tid0 >> 6;
    bf16_t* Cs = (bf16_t*)L;
    bf16_t* Bs = Cs + 128 * 136;
    bf16_t* BsT = Bs + 128 * 136;
    bf16_t* XsT = BsT + 128 * 136;
    bf16_t* St = XsT + 64 * 136;
    bf16_t* XwT = St + 64 * 136;
    float* dtvB = (float*)(XwT + 64 * 136); float* acsB = dtvB + 256; float* wvB = acsB + 256;
    const bf16_t* U = WSP(bf16_t, OFF_U); const float* DT = WSP(float, OFF_DT); bf16_t* MIX = WSP(bf16_t, OFF_MIX); float* SSB = WSP(float, OFF_SSB);
    const float a_neg = -__expf(P.in[22][h]), dtb = P.in[21][h], Dh = P.in[23][h];
    f32x16 accS;
#pragma unroll
    for (int i = 0; i < 16; ++i) accS[i] = 0.f;
    lds_barrier();
    for (int i = tid0; i < 64 * 136; i += 512) St[i] = 0;
    float dtr0 = 0.f, dtr1 = 0.f;
#define SSD_DTLOAD(cc) do { if (wid == 0) { const float* dp_ = DT + (size_t)(b * 2048 + (cc) * 128 + (tid0 & 63)) * 16 + h; dtr0 = dp_[0]; dtr1 = dp_[64 * 16]; } } while (0)
#define SSD_SCAN(buf) do { if (wid == 0) { const int ln_ = tid0 & 63; const float d0_ = softplus(dtr0 + dtb), d1_ = softplus(dtr1 + dtb); float v0_ = d0_ * a_neg, v1_ = d1_ * a_neg; \
        _Pragma("unroll") for (int o_ = 1; o_ < 64; o_ <<= 1) { const float n0_ = __shfl_up(v0_, o_), n1_ = __shfl_up(v1_, o_); if (ln_ >= o_) { v0_ += n0_; v1_ += n1_; } } \
        v1_ += __shfl(v0_, 63); const float al_ = __shfl(v1_, 63); \
        dtvB[(buf) * 128 + ln_] = d0_; dtvB[(buf) * 128 + 64 + ln_] = d1_; acsB[(buf) * 128 + ln_] = v0_; acsB[(buf) * 128 + 64 + ln_] = v1_; \
        wvB[(buf) * 128 + ln_] = __expf(al_ - v0_) * d0_; wvB[(buf) * 128 + 64 + ln_] = __expf(al_ - v1_) * d1_; } } while (0)
    SSD_DTLOAD(0); SSD_SCAN(0); SSD_DTLOAD(1);
    u32x4 tC[4], tB[4], tT[4], tX[2];
    for (int c = 0; c < 16; ++c) {
        const int row0 = b * 2048 + c * 128;
        lds_barrier();
        int zv = 0; asm volatile("" : "+v"(zv));
        const int tid = tid0 + zv, lane = tid & 63, hh = lane >> 5, l31 = lane & 31;
        const int prow = tid >> 4, pcol = (tid & 15) * 8;
        const float* dtv = dtvB + (c & 1) * 128; const float* acs = acsB + (c & 1) * 128; const float* wv = wvB + (c & 1) * 128;
        if (c + 1 < 16) { SSD_SCAN((c + 1) & 1); if (c + 2 < 16) SSD_DTLOAD(c + 2); }
        if (c == 0) {
            const size_t tb_ = ((size_t)((b * 16 + c) * 2 + g)) * 128 * 128 + (size_t)prow * 128 + pcol;
            const u32x4* pc = (const u32x4*)(WSP(bf16_t, OFF_CN) + tb_); const u32x4* pb = (const u32x4*)(WSP(bf16_t, OFF_BN) + tb_); const u32x4* pt = (const u32x4*)(WSP(bf16_t, OFF_BT) + tb_);
            const u32x4* px = (const u32x4*)(WSP(bf16_t, OFF_XT) + ((size_t)((b * 16 + c) * 1024 + h * 64 + prow)) * 128 + pcol);
#pragma unroll
            for (int i = 0; i < 4; ++i) { tC[i] = pc[i * 512]; tB[i] = pb[i * 512]; tT[i] = pt[i * 512]; }
            tX[0] = px[0]; tX[1] = px[512];
        }
        const float a_last = acs[127];
#pragma unroll
        for (int i = 0; i < 4; ++i) {
            *(u32x4*)(Cs + (prow + 32 * i) * 136 + pcol) = tC[i]; *(u32x4*)(Bs + (prow + 32 * i) * 136 + pcol) = tB[i]; *(u32x4*)(BsT + (prow + 32 * i) * 136 + pcol) = tT[i];
        }
        *(u32x4*)(XsT + prow * 136 + pcol) = tX[0]; *(u32x4*)(XsT + (prow + 32) * 136 + pcol) = tX[1];
        {
            const f32x4 w0 = *(const f32x4*)(wv + pcol), w1 = *(const f32x4*)(wv + pcol + 4);
            u32x4 oa, ob; const u32x4 xa = tX[0], xb_ = tX[1];
            oa.x = pack2(bflo(xa.x) * w0[0], bfhi(xa.x) * w0[1]); oa.y = pack2(bflo(xa.y) * w0[2], bfhi(xa.y) * w0[3]); oa.z = pack2(bflo(xa.z) * w1[0], bfhi(xa.z) * w1[1]); oa.w = pack2(bflo(xa.w) * w1[2], bfhi(xa.w) * w1[3]);
            ob.x = pack2(bflo(xb_.x) * w0[0], bfhi(xb_.x) * w0[1]); ob.y = pack2(bflo(xb_.y) * w0[2], bfhi(xb_.y) * w0[3]); ob.z = pack2(bflo(xb_.z) * w1[0], bfhi(xb_.z) * w1[1]); ob.w = pack2(bflo(xb_.w) * w1[2], bfhi(xb_.w) * w1[3]);
            *(u32x4*)(XwT + prow * 136 + pcol) = oa; *(u32x4*)(XwT + (prow + 32) * 136 + pcol) = ob;
        }
        if (c + 1 < 16) {
            const size_t tb_ = ((size_t)((b * 16 + c + 1) * 2 + g)) * 128 * 128 + (size_t)prow * 128 + pcol;
            const u32x4* pc = (const u32x4*)(WSP(bf16_t, OFF_CN) + tb_); const u32x4* pb = (const u32x4*)(WSP(bf16_t, OFF_BN) + tb_); const u32x4* pt = (const u32x4*)(WSP(bf16_t, OFF_BT) + tb_);
            const u32x4* px = (const u32x4*)(WSP(bf16_t, OFF_XT) + ((size_t)((b * 16 + c + 1) * 1024 + h * 64 + prow)) * 128 + pcol);
#pragma unroll
            for (int i = 0; i < 4; ++i) { tC[i] = pc[i * 512]; tB[i] = pb[i * 512]; tT[i] = pt[i * 512]; }
            tX[0] = px[0]; tX[1] = px[512];
        }
        bf16_t zr[16];
        {
            const unsigned zoff = (unsigned)((row0 + (wid >> 1) * 32 + 4 * hh) * N0 + 2048 + h * 64 + (wid & 1) * 32 + l31);
#pragma unroll
            for (int reg = 0; reg < 16; ++reg) zr[reg] = (U + ((reg & 3) + 8 * (reg >> 2)) * N0)[zoff];
        }
        lds_barrier();
        {
            const int rb = (wid >> 1) * 32, cb0 = (wid & 1) * 64;
            f32x16 cbA[2];
#pragma unroll
            for (int i = 0; i < 16; ++i) { cbA[0][i] = 0.f; cbA[1][i] = 0.f; }
#pragma unroll
            for (int ks = 0; ks < 8; ++ks) {
                const bf16x8 a = ldfrag(Cs, 136, rb, ks * 16, lane);
                cbA[0] = MFMA32(a, ldfrag(Bs, 136, cb0, ks * 16, lane), cbA[0]);
                cbA[1] = MFMA32(a, ldfrag(Bs, 136, cb0 + 32, ks * 16, lane), cbA[1]);
            }
            lds_barrier();
            bf16_t* Ws = Bs;
#pragma unroll
            for (int j = 0; j < 2; ++j) {
                const int s = cb0 + j * 32 + l31; const float as = acs[s], ds = dtv[s];
#pragma unroll
                for (int reg = 0; reg < 16; ++reg) {
                    const int t = rb + crow(reg, hh);
                    const float v = (s <= t) ? cbA[j][reg] * __expf(acs[t] - as) * ds : 0.f;
                    Ws[t * 136 + s] = f2bf(v);
                }
            }
        }
        lds_barrier();
        {
            const bf16_t* Ws = Bs;
            const int tb = (wid >> 1) * 32, pb = (wid & 1) * 32;
            f32x16 y;
#pragma unroll
            for (int i = 0; i < 16; ++i) y[i] = 0.f;
#pragma unroll
            for (int ks = 0; ks < 8; ++ks) y = MFMA32(ldfrag(Cs, 136, tb, ks * 16, lane), ldfrag(St, 136, pb, ks * 16, lane), y);
            f32x16 y2;
#pragma unroll
            for (int i = 0; i < 16; ++i) y2[i] = 0.f;
#pragma unroll
            for (int ks = 0; ks < 8; ++ks) y2 = MFMA32(ldfrag(Ws, 136, tb, ks * 16, lane), ldfrag(XsT, 136, pb, ks * 16, lane), y2);
#pragma unroll
            for (int reg = 0; reg < 16; ++reg) y[reg] = y[reg] * __expf(acs[tb + crow(reg, hh)]) + y2[reg];
            const int p = pb + l31, ch = h * 64 + p; const float nwv = P.in[24][ch];
#pragma unroll
            for (int reg = 0; reg < 16; ++reg) {
                const int t = tb + crow(reg, hh); const size_t row = (size_t)(row0 + t);
                const float xv = bf2f(XsT[p * 136 + t]); const float z = bf2f(zr[reg]);
                const float yy = (y[reg] + Dh * xv) * silu(z);
                float ss = yy * yy;
                ss += __shfl_xor(ss, 1); ss += __shfl_xor(ss, 2); ss += __shfl_xor(ss, 4); ss += __shfl_xor(ss, 8); ss += __shfl_xor(ss, 16);
                if (l31 == 0) atomicAdd(SSB + row * 2 + g, ss);
                MIX[row * 2048 + 1024 + ch] = f2bf(yy * nwv);
            }
            lds_barrier();
            const int pb2 = (wid >> 2) * 32, nb = (wid & 3) * 32;
            const float ea = __expf(a_last);
#pragma unroll
            for (int reg = 0; reg < 16; ++reg) accS[reg] *= ea;
#pragma unroll
            for (int ks = 0; ks < 8; ++ks) accS = MFMA32(ldfrag(XwT, 136, pb2, ks * 16, lane), ldfrag(BsT, 136, nb, ks * 16, lane), accS);
#pragma unroll
            for (int reg = 0; reg < 16; ++reg) St[(pb2 + crow(reg, hh)) * 136 + nb + l31] = f2bf(accS[reg]);
        }
    }
    {
        const int lane = tid0 & 63, hh = lane >> 5, l31 = lane & 31;
        const int pb2 = (wid >> 2) * 32, nb = (wid & 3) * 32;
        float* o = P.out + O_BSP + (size_t)(b * 16 + h) * 64 * 128;
#pragma unroll
        for (int reg = 0; reg < 16; ++reg) o[(pb2 + crow(reg, hh)) * 128 + nb + l31] = accS[reg];
    }
}
#undef SSD_DTLOAD
#undef SSD_SCAN
DI void ssd_sample_item(const Params& P, unsigned char* L, int item) {
    const int b = item >> 4, h = item & 15, g = h >> 3, tid = otid(), lane = tid & 63;
    float* xs = (float*)L; float* Bv = xs + 64; float* Cv = Bv + 128; float* yv = Cv + 128;
    const bf16_t* U = WSP(bf16_t, OFF_U); bf16_t* MIX = WSP(bf16_t, OFF_MIX); float* SSB = WSP(float, OFF_SSB);
    const size_t row = (size_t)(MP + b);
    __syncthreads();
    if (tid < 320) {
        int cc; if (tid < 64) cc = h * 64 + tid; else if (tid < 192) cc = 1024 + g * 128 + (tid - 64); else cc = 1280 + g * 128 + (tid - 192);
        const float* buf = P.in[7] + (size_t)b * 3 * 1536 + cc;
        const float v = P.in[20][cc] + P.in[19][cc] * buf[0] + P.in[19][1536 + cc] * buf[1536] + P.in[19][2 * 1536 + cc] * buf[2 * 1536] + P.in[19][3 * 1536 + cc] * bf2f(U[row * N0 + 3072 + cc]);
        xs[tid] = silu(v);
    }
    const float dt = softplus(WSP(float, OFF_DT)[row * 16 + h] + P.in[21][h]);
    const float dA = __expf(-dt * __expf(P.in[22][h]));
    __syncthreads();
    const float* s0 = P.in[6] + (size_t)(b * 16 + h) * 64 * 128; float* s1 = P.out + O_BSS + (size_t)(b * 16 + h) * 64 * 128;
    const int n4 = (tid & 31) * 4;
    const f32x4 Bq = *(const f32x4*)(Bv + n4), Cq = *(const f32x4*)(Cv + n4);
#pragma unroll
    for (int j = 0; j < 4; ++j) {
        const int p = (tid >> 5) + 16 * j;
        const f32x4 s = *(const f32x4*)(s0 + p * 128 + n4);
        const float dx = dt * xs[p];
        const f32x4 sn = s * dA + Bq * dx;
        *(f32x4*)(s1 + p * 128 + n4) = sn;
        float yp = sn[0] * Cq[0] + sn[1] * Cq[1] + sn[2] * Cq[2] + sn[3] * Cq[3];
        yp += __shfl_xor(yp, 1); yp += __shfl_xor(yp, 2); yp += __shfl_xor(yp, 4); yp += __shfl_xor(yp, 8); yp += __shfl_xor(yp, 16);
        if ((tid & 31) == 0) yv[p] = yp;
    }
    __syncthreads();
    if (tid < 64) {
        const int ch = h * 64 + tid;
        const float yy = (yv[tid] + P.in[23][h] * xs[tid]) * silu(bf2f(U[row * N0 + 2048 + ch]));
        const float ss = wave_sum(yy * yy);
        if (lane == 0) atomicAdd(SSB + row * 2 + g, ss);
        MIX[row * 2048 + 1024 + ch] = f2bf(yy * P.in[24][ch]);
    }
}
DI void ssd_sample_item4(const Params& P, unsigned char* L, int item) {
    const int b = item >> 2, tid = otid(), gi = tid >> 7, lt = tid & 127, h = (item & 3) * 4 + gi, g = h >> 3;
    float* xs = (float*)L + gi * 512; float* Bv = xs + 64; float* Cv = Bv + 128; float* yv = Cv + 128;
    const bf16_t* U = WSP(bf16_t, OFF_U); bf16_t* MIX = WSP(bf16_t, OFF_MIX); float* SSB = WSP(float, OFF_SSB);
    const size_t row = (size_t)(MP + b);
    __syncthreads();
#pragma unroll
    for (int ps = 0; ps < 3; ++ps) {
        const int idx = lt + 128 * ps;
        if (idx < 320) {
            int cc; if (idx < 64) cc = h * 64 + idx; else if (idx < 192) cc = 1024 + g * 128 + (idx - 64); else cc = 1280 + g * 128 + (idx - 192);
            const float* buf = P.in[7] + (size_t)b * 3 * 1536 + cc;
            const float v = P.in[20][cc] + P.in[19][cc] * buf[0] + P.in[19][1536 + cc] * buf[1536] + P.in[19][2 * 1536 + cc] * buf[2 * 1536] + P.in[19][3 * 1536 + cc] * bf2f(U[row * N0 + 3072 + cc]);
            xs[idx] = silu(v);
        }
    }
    const float dt = softplus(WSP(float, OFF_DT)[row * 16 + h] + P.in[21][h]);
    const float dA = __expf(-dt * __expf(P.in[22][h]));
    __syncthreads();
    const float* s0 = P.in[6] + (size_t)(b * 16 + h) * 64 * 128; float* s1 = P.out + O_BSS + (size_t)(b * 16 + h) * 64 * 128;
    const int n4 = (lt & 31) * 4;
    const f32x4 Bq = *(const f32x4*)(Bv + n4), Cq = *(const f32x4*)(Cv + n4);
    f32x4 sv[16];
#pragma unroll
    for (int j = 0; j < 16; ++j) sv[j] = *(const f32x4*)(s0 + ((lt >> 5) + 4 * j) * 128 + n4);
#pragma unroll
    for (int j = 0; j < 16; ++j) {
        const int p = (lt >> 5) + 4 * j;
        const f32x4 sn = sv[j] * dA + Bq * (dt * xs[p]);
        *(f32x4*)(s1 + p * 128 + n4) = sn;
        float yp = sn[0] * Cq[0] + sn[1] * Cq[1] + sn[2] * Cq[2] + sn[3] * Cq[3];
        yp += __shfl_xor(yp, 1); yp += __shfl_xor(yp, 2); yp += __shfl_xor(yp, 4); yp += __shfl_xor(yp, 8); yp += __shfl_xor(yp, 16);
        if ((lt & 31) == 0) yv[p] = yp;
    }
    __syncthreads();
    if (lt < 64) {
        const int ch = h * 64 + lt;
        const float yy = (yv[lt] + P.in[23][h] * xs[lt]) * silu(bf2f(U[row * N0 + 2048 + ch]));
        const float ss = wave_sum(yy * yy);
        if (lt == 0) atomicAdd(SSB + row * 2 + g, ss);
        MIX[row * 2048 + 1024 + ch] = f2bf(yy * P.in[24][ch]);
    }
}
template <bool SAMPLE>
DI void rglru_item(const Params& P, unsigned char* L, int item) {
    const int tid0 = otid(), wid = tid0 >> 6;
    const int b = SAMPLE ? 0 : (item >> 4), k = (item >> 1) & 7, dh = item & 1;
    bf16_t* Xs = (bf16_t*)L;
    bf16_t* Wg = Xs + 128 * 136;
    float* Aa = (float*)(Wg + 128 * 136);
    float* Uu = Aa + 128 * 64; float* segA = Uu + 128 * 64; float* segH = segA + 512; float* hc = segH + 512;
    const bf16_t* U = WSP(bf16_t, OFF_U); bf16_t* MIX = WSP(bf16_t, OFF_MIX);
    lds_barrier();
    {
        const bf16_t* WRT = WSP(bf16_t, OFF_WRT); const bf16_t* WIT = WSP(bf16_t, OFF_WIT);
#pragma unroll
        for (int i = 0; i < 4; ++i) {
            const int chk = tid0 + i * 512, r = chk >> 4, c8 = (chk & 15) * 8;
            const bf16_t* src = (r < 64 ? WRT + (size_t)(dh * 64 + r) * 1024 : WIT + (size_t)(dh * 64 + r - 64) * 1024) + k * 128 + c8;
            *(u32x4*)(Wg + r * 136 + c8) = *(const u32x4*)src;
        }
        if (tid0 < 64) hc[tid0] = 0.f;
    }
    float sp[4], br[4], bi[4];
#pragma unroll
    for (int ct = 0; ct < 4; ++ct) { const int chd = k * 128 + dh * 64 + ct * 16 + (tid0 & 15); sp[ct] = softplus(-P.in[18][chd]); br[ct] = P.in[15][chd]; bi[ct] = P.in[17][chd]; }
    const int ch0 = k * 128 + (tid0 & 31) * 4;
    float cw[4][4], cbias[4];
#pragma unroll
    for (int kk = 0; kk < 4; ++kk)
#pragma unroll
        for (int e = 0; e < 4; ++e) cw[kk][e] = P.in[12][kk * 1024 + ch0 + e];
#pragma unroll
    for (int e = 0; e < 4; ++e) cbias[e] = P.in[13][ch0 + e];
    u32x2 raw[11];
#define RG_LOAD(tl_) do { const int tg_ = (tl_) * 128 + (tid0 >> 5) * 8; const unsigned vo_ = (unsigned)((b * 2048 + tg_) * N0 + ch0); \
        _Pragma("unroll") for (int j = 0; j < 11; ++j) raw[j] = (tg_ + j - 3 >= 0) ? *(const u32x2*)((U + (j - 3) * N0) + vo_) : (u32x2){0u, 0u}; } while (0)
    if (!SAMPLE) RG_LOAD(0);
    const int ntiles = SAMPLE ? 1 : 16;
    for (int tile = 0; tile < ntiles; ++tile) {
        const int row0 = SAMPLE ? MP : b * 2048 + tile * 128;
        lds_barrier();
        int zv = 0; asm volatile("" : "+v"(zv));
        const int tid = tid0 + zv, lane = tid & 63, quad = tid & 31, seg = tid >> 5;
        const int sd = tid & 63, sseg = wid, sch = k * 128 + dh * 64 + sd;
        bf16_t gt[16];
        if (!SAMPLE) {
            const unsigned goff = (unsigned)((row0 + sseg * 16) * N0 + 1024 + sch);
#pragma unroll
            for (int t = 0; t < 16; ++t) gt[t] = (U + t * N0)[goff];
        }
        if (SAMPLE) {
#pragma unroll
            for (int t = 0; t < 8; ++t) {
                const int bb = seg * 8 + t;
                const float* buf = P.in[5] + (size_t)bb * 3 * 1024 + ch0;
                const f32x4 p0 = *(const f32x4*)buf, p1 = *(const f32x4*)(buf + 1024), p2 = *(const f32x4*)(buf + 2048);
                float cur[4]; ld4bf(U + (size_t)(MP + bb) * N0 + ch0, cur);
                float y[4];
#pragma unroll
                for (int e = 0; e < 4; ++e) y[e] = cbias[e] + cw[0][e] * p0[e] + cw[1][e] * p1[e] + cw[2][e] * p2[e] + cw[3][e] * cur[e];
                *(u32x2*)(Xs + bb * 136 + quad * 4) = pack4v(y[0], y[1], y[2], y[3]);
            }
        } else {
#pragma unroll
            for (int j = 0; j < 8; ++j) {
                const float x0[4] = {bflo(raw[j].x), bfhi(raw[j].x), bflo(raw[j].y), bfhi(raw[j].y)};
                const float x1[4] = {bflo(raw[j + 1].x), bfhi(raw[j + 1].x), bflo(raw[j + 1].y), bfhi(raw[j + 1].y)};
                const float x2[4] = {bflo(raw[j + 2].x), bfhi(raw[j + 2].x), bflo(raw[j + 2].y), bfhi(raw[j + 2].y)};
                const float x3[4] = {bflo(raw[j + 3].x), bfhi(raw[j + 3].x), bflo(raw[j + 3].y), bfhi(raw[j + 3].y)};
                float y[4];
#pragma unroll
                for (int e = 0; e < 4; ++e) y[e] = cbias[e] + cw[0][e] * x0[e] + cw[1][e] * x1[e] + cw[2][e] * x2[e] + cw[3][e] * x3[e];
                *(u32x2*)(Xs + (seg * 8 + j) * 136 + quad * 4) = pack4v(y[0], y[1], y[2], y[3]);
            }
            if (tile + 1 < 16) RG_LOAD(tile + 1);
        }
        lds_barrier();
        {
            f32x4 acc[8];
#pragma unroll
            for (int i = 0; i < 8; ++i) acc[i] = (f32x4){0.f, 0.f, 0.f, 0.f};
#pragma unroll
            for (int ks = 0; ks < 4; ++ks) {
                const bf16x8 a = ldfrag16(Xs, 136, wid * 16, ks * 32, lane);
#pragma unroll
                for (int tl = 0; tl < 8; ++tl) acc[tl] = MFMA16(a, ldfrag16(Wg, 136, tl * 16, ks * 32, lane), acc[tl]);
            }
#pragma unroll
            for (int ct = 0; ct < 4; ++ct)
#pragma unroll
                for (int reg = 0; reg < 4; ++reg) {
                    const int t = wid * 16 + (lane >> 4) * 4 + reg, d = ct * 16 + (lane & 15);
                    const float r = sigm(acc[ct][reg] + br[ct]), gi = sigm(acc[4 + ct][reg] + bi[ct]);
                    const float a = __expf(-8.f * r * sp[ct]);
                    const float uu = __builtin_amdgcn_sqrtf(fmaxf(1.f - a * a, 0.f)) * gi * bf2f(Xs[t * 136 + dh * 64 + d]);
                    if (SAMPLE) {
                        const int chd = k * 128 + dh * 64 + d;
                        const float hn = a * P.in[4][(size_t)t * 1024 + chd] + uu;
                        P.out[O_AHS + (size_t)t * 1024 + chd] = hn;
                        const float gv = bf2f(U[(size_t)(MP + t) * N0 + 1024 + chd]);
                        MIX[(size_t)(MP + t) * 2048 + chd] = f2bf(hn * silu(gv));
                    } else { Aa[t * 64 + d] = a; Uu[t * 64 + d] = uu; }
                }
        }
        if (!SAMPLE) {
            lds_barrier();
            float av[16], uv[16], Ap = 1.f, Hp = 0.f;
#pragma unroll
            for (int t = 0; t < 16; ++t) { av[t] = Aa[(sseg * 16 + t) * 64 + sd]; uv[t] = Uu[(sseg * 16 + t) * 64 + sd]; Hp = av[t] * Hp + uv[t]; Ap *= av[t]; }
            segA[sseg * 64 + sd] = Ap; segH[sseg * 64 + sd] = Hp;
            lds_barrier();
            float hin = hc[sd];
            for (int s2 = 0; s2 < sseg; ++s2) hin = segA[s2 * 64 + sd] * hin + segH[s2 * 64 + sd];
            const unsigned moff = (unsigned)((row0 + sseg * 16) * 2048 + sch);
#pragma unroll
            for (int t = 0; t < 16; ++t) {
                hin = av[t] * hin + uv[t];
                (MIX + t * 2048)[moff] = f2bf(hin * silu(bf2f(gt[t])));
            }
            lds_barrier();
            if (sseg == 7) hc[sd] = hin;
        }
    }
#undef RG_LOAD
    if (!SAMPLE) { lds_barrier(); if (tid0 < 64) P.out[O_AHP + (size_t)b * 1024 + k * 128 + dh * 64 + tid0] = hc[tid0]; }
}
DI void phase_mix0(const Params& P, unsigned char* L) {
    const int tid = otid(), bid = blockIdx.x, G = gridDim.x;
    { const bf16_t* U = WSP(bf16_t, OFF_U);
      for (int i = bid * 512 + tid; i < 8 * 3 * 1024; i += G * 512) { const int c = i & 1023, j = (i >> 10) % 3, b = i / 3072; P.out[O_ACP + i] = bf2f(U[(size_t)(b * 2048 + 2045 + j) * N0 + c]); }
      for (int i = bid * 512 + tid; i < 8 * 3 * 1536; i += G * 512) { const int c = i % 1536, j = (i / 1536) % 3, b = i / 4608; P.out[O_BCP + i] = bf2f(U[(size_t)(b * 2048 + 2045 + j) * N0 + 3072 + c]); }
      for (int i = bid * 512 + tid; i < 128 * 3 * 1024; i += G * 512) { const int c = i & 1023, j = (i >> 10) % 3, b = i / 3072; P.out[O_ACS + i] = j < 2 ? P.in[5][(size_t)(b * 3 + j + 1) * 1024 + c] : bf2f(U[(size_t)(MP + b) * N0 + c]); }
      for (int i = bid * 512 + tid; i < 128 * 3 * 1536; i += G * 512) { const int c = i % 1536, j = (i / 1536) % 3, b = i / 4608; P.out[O_BCS + i] = j < 2 ? P.in[7][(size_t)(b * 3 + j + 1) * 1536 + c] : bf2f(U[(size_t)(MP + b) * N0 + 3072 + c]); } }
    if (bid < 128) { const int x = bid & 7, j = bid >> 3; rglru_item<false>(P, L, (x + 8 * (j >> 1)) * 2 + (j & 1)); }
    else if (bid < 256) { const int x = bid & 7, j = (bid - 128) >> 3, grp = x + 8 * (j >> 3); ssd_prompt_item(P, L, (grp >> 1) * 16 + (grp & 1) * 8 + (j & 7)); }
    unsigned* ctr = WSP(unsigned, OFF_CTL);
    unsigned* bc = (unsigned*)(L + LDS_BYTES - 16);
    for (;;) {
        __syncthreads();
        if (tid == 0) bc[0] = atomicAdd(ctr, 1u);
        __syncthreads();
        const unsigned it = bc[0];
        if (it >= 16u + 512u) break;
        if (it < 16u) rglru_item<true>(P, L, (int)it); else ssd_sample_item4(P, L, (int)(it - 16u));
    }
    for (;;) {
        __syncthreads();
        if (tid == 0) bc[0] = atomicAdd(ctr + 32, 1u);
        __syncthreads();
        const unsigned q = bc[0];
        if (q >= 256u + 104u + 130u) break;
        if (q < 256u) l1_weight_tile(P, (int)q * 8 + (tid >> 6), (float*)L + (tid >> 6) * (64 * 65), tid & 63);
        else if (q < 360u) l1_weight_tile(P, 2880 + ((int)q - 256) * 8 + (tid >> 6), (float*)L + (tid >> 6) * (64 * 65), tid & 63);
        else convert_p_chunk(P, 0, (int)q - 360, tid);
    }
}
DI void phase_norm0(const Params& P) {
    bf16_t* MIX = WSP(bf16_t, OFF_MIX); const float* SSB = WSP(float, OFF_SSB);
    for (int i = blockIdx.x * 512 + threadIdx.x; i < MV * 128; i += gridDim.x * 512) {
        const int row = i >> 7, c8 = (i & 127) * 8, g = c8 >> 9;
        const float sc = rsqrtf(SSB[(size_t)row * 2 + g] * (1.f / 512.f) + EPSF);
        uint4* p = (uint4*)(MIX + (size_t)row * 2048 + 1024 + c8); uint4 w = *p;
        w.x = pack2(bflo(w.x) * sc, bfhi(w.x) * sc); w.y = pack2(bflo(w.y) * sc, bfhi(w.y) * sc); w.z = pack2(bflo(w.z) * sc, bfhi(w.z) * sc); w.w = pack2(bflo(w.w) * sc, bfhi(w.w) * sc);
        *p = w;
    }
}

DI void hgrn_prompt_item(const Params& P, unsigned char* L, int item) {
    const int b = item >> 4, h = item & 15;
    const int tid = otid(), lane = tid & 63, wid = tid >> 6, hh = lane >> 5, l31 = lane & 31;
    bf16_t* Qs = (bf16_t*)L;
    bf16_t* Ks = Qs + 64 * 136;
    bf16_t* KsT = Ks + 64 * 136;
    bf16_t* VsT = KsT + 128 * 72;
    bf16_t* SsT = VsT + 128 * 72;
    bf16_t* As = SsT + 128 * 136;
    float* Gseg = (float*)(As + 64 * 72);
    float* E1 = Gseg + 16 * 128; float* E2 = E1 + 128;
    float* Of = E2 + 128;
    const bf16_t* U = WSP(bf16_t, OFF_U); bf16_t* MIX = WSP(bf16_t, OFF_MIX);
    const int kq = tid & 31, ts = tid >> 5;
    float lb[4];
#pragma unroll
    for (int e = 0; e < 4; ++e) { const int ch = h * 128 + kq * 4 + e; lb[e] = sigm(P.in[27][2048 + ch] - P.in[27][ch]); }
    const int kb = (wid >> 1) * 32, vb0 = (wid & 1) * 64;
    f32x16 accS[2];
#pragma unroll
    for (int i = 0; i < 16; ++i) { accS[0][i] = 0.f; accS[1][i] = 0.f; }
    uint2 rq[4], rf[4], rv[4];
#define HG_LOAD(cc) do { _Pragma("unroll") for (int i = 0; i < 4; ++i) { const bf16_t* bp = U + (size_t)(b * 2048 + (cc) * 64 + ts * 4 + i) * INC + h * 128 + kq * 4; \
        rq[i] = *(const uint2*)bp; rf[i] = *(const uint2*)(bp + 2048); rv[i] = *(const uint2*)(bp + 4096); } } while (0)
    HG_LOAD(0);
    lds_barrier();
    for (int c = 0; c < 32; ++c) {
        u32x4 gpre0, gpre1;
        { const bf16_t* gp = U + (size_t)(b * 2048 + c * 64 + (tid >> 3)) * INC + 6144 + h * 128 + (tid & 7) * 16; gpre0 = *(const u32x4*)gp; gpre1 = *(const u32x4*)(gp + 8); }
        float kk[4][4], cs[4][4];
#pragma unroll
        for (int i = 0; i < 4; ++i) {
            const float fx[4] = {bflo(rf[i].x), bfhi(rf[i].x), bflo(rf[i].y), bfhi(rf[i].y)};
#pragma unroll
            for (int e = 0; e < 4; ++e) {
                const float sg = sigm(fx[e]); const float kv = (1.f - lb[e]) * (1.f - sg);
                kk[i][e] = kv; const float gl = __logf(1.f - kv);
                cs[i][e] = (i == 0 ? 0.f : cs[i - 1][e]) + gl;
            }
        }
        *(f32x4*)(Gseg + ts * 128 + kq * 4) = (f32x4){cs[3][0], cs[3][1], cs[3][2], cs[3][3]};
        lds_barrier();
        f32x4 off = {0.f, 0.f, 0.f, 0.f}, gmid = off, glast = off;
        {
            const int swid = __builtin_amdgcn_readfirstlane(tid >> 6);
            f32x4 pre = {0.f, 0.f, 0.f, 0.f};
#pragma unroll
            for (int s = 0; s < 16; ++s) {
                const f32x4 v = *(const f32x4*)(Gseg + s * 128 + kq * 4);
                if (s == 2 * swid) off = pre;
                if (s == 8) gmid = pre;
                pre += v;
            }
            glast = pre;
            if (ts & 1) off += *(const f32x4*)(Gseg + (ts - 1) * 128 + kq * 4);
        }
        {
            float qt[4][4], kt[4][4], vt[4][4];
#pragma unroll
            for (int i = 0; i < 4; ++i) {
                const float q[4] = {bflo(rq[i].x), bfhi(rq[i].x), bflo(rq[i].y), bfhi(rq[i].y)};
                vt[i][0] = bflo(rv[i].x); vt[i][1] = bfhi(rv[i].x); vt[i][2] = bflo(rv[i].y); vt[i][3] = bfhi(rv[i].y);
#pragma unroll
                for (int e = 0; e < 4; ++e) { const float Gv = off[e] + cs[i][e]; const float ex = __expf(Gv - gmid[e]); qt[i][e] = q[e] * 0.08838834764831845f * ex; kt[i][e] = kk[i][e] * frcp(ex); }
                *(uint2*)(Qs + (ts * 4 + i) * 136 + kq * 4) = pack4(qt[i][0], qt[i][1], qt[i][2], qt[i][3]);
                *(uint2*)(Ks + (ts * 4 + i) * 136 + kq * 4) = pack4(kt[i][0], kt[i][1], kt[i][2], kt[i][3]);
            }
#pragma unroll
            for (int e = 0; e < 4; ++e) {
                *(uint2*)(KsT + (kq * 4 + e) * 72 + ts * 4) = pack4(kt[0][e], kt[1][e], kt[2][e], kt[3][e]);
                *(uint2*)(VsT + (kq * 4 + e) * 72 + ts * 4) = pack4(vt[0][e], vt[1][e], vt[2][e], vt[3][e]);
            }
            if (ts == 0) {
#pragma unroll
                for (int e = 0; e < 4; ++e) { E1[kq * 4 + e] = __expf(gmid[e]); E2[kq * 4 + e] = __expf(glast[e] - gmid[e]); }
            }
        }
        if (c + 1 < 32) HG_LOAD(c + 1);
        lds_barrier();
#pragma unroll
        for (int j = 0; j < 2; ++j) {
#pragma unroll
            for (int reg = 0; reg < 16; ++reg) accS[j][reg] *= E1[kb + crow(reg, hh)];
            const int v = vb0 + j * 32 + l31;
#pragma unroll
            for (int rg = 0; rg < 4; ++rg) *(uint2*)(SsT + v * 136 + kb + 8 * rg + 4 * hh) = pack4(accS[j][4 * rg], accS[j][4 * rg + 1], accS[j][4 * rg + 2], accS[j][4 * rg + 3]);
        }
        if (wid < 4) {
            const int tb = (wid >> 1) * 32, sb = (wid & 1) * 32;
            f32x16 aa;
#pragma unroll
            for (int i = 0; i < 16; ++i) aa[i] = 0.f;
#pragma unroll
            for (int ks = 0; ks < 8; ++ks) aa = MFMA32(ldfrag(Qs, 136, tb, ks * 16, lane), ldfrag(Ks, 136, sb, ks * 16, lane), aa);
            const int s = sb + l31;
#pragma unroll
            for (int reg = 0; reg < 16; ++reg) { const int t = tb + crow(reg, hh); As[t * 72 + s] = f2bf(s <= t ? aa[reg] : 0.f); }
        }
        lds_barrier();
        const int tb2 = (wid >> 2) * 32, vb2 = (wid & 3) * 32;
        f32x16 o, o2;
#pragma unroll
        for (int i = 0; i < 16; ++i) { o[i] = 0.f; o2[i] = 0.f; }
#pragma unroll
        for (int ks = 0; ks < 8; ++ks) o = MFMA32(ldfrag(Qs, 136, tb2, ks * 16, lane), ldfrag(SsT, 136, vb2, ks * 16, lane), o);
#pragma unroll
        for (int ks = 0; ks < 4; ++ks) o2 = MFMA32(ldfrag(As, 72, tb2, ks * 16, lane), ldfrag(VsT, 72, vb2, ks * 16, lane), o2);
#pragma unroll
        for (int i = 0; i < 16; ++i) o[i] += o2[i];
#pragma unroll
        for (int j = 0; j < 2; ++j) {
#pragma unroll
            for (int ks = 0; ks < 4; ++ks) accS[j] = MFMA32(ldfrag(KsT, 72, kb, ks * 16, lane), ldfrag(VsT, 72, vb0 + j * 32, ks * 16, lane), accS[j]);
#pragma unroll
            for (int reg = 0; reg < 16; ++reg) accS[j][reg] *= E2[kb + crow(reg, hh)];
        }
#pragma unroll
        for (int reg = 0; reg < 16; ++reg) Of[(tb2 + crow(reg, hh)) * 132 + vb2 + l31] = o[reg];
        lds_barrier();
        {
            const int t = tid >> 3, vs = tid & 7;
            const size_t row = (size_t)(b * 2048 + c * 64 + t);
            f32x4 ov[4]; float ss = 0.f;
#pragma unroll
            for (int i = 0; i < 4; ++i) { ov[i] = *(const f32x4*)(Of + t * 132 + vs * 16 + i * 4); ss += ov[i][0] * ov[i][0] + ov[i][1] * ov[i][1] + ov[i][2] * ov[i][2] + ov[i][3] * ov[i][3]; }
            ss += __shfl_xor(ss, 1); ss += __shfl_xor(ss, 2); ss += __shfl_xor(ss, 4);
            const float rstd = rsqrtf(ss * (1.f / 128.f) + EPSF);
            const float* nwp = P.in[28] + h * 128 + vs * 16;
            const unsigned gw[8] = {gpre0.x, gpre0.y, gpre0.z, gpre0.w, gpre1.x, gpre1.y, gpre1.z, gpre1.w};
            unsigned ow[8];
#pragma unroll
            for (int i = 0; i < 4; ++i) {
                const f32x4 w = *(const f32x4*)(nwp + i * 4);
                ow[2 * i] = pack2(ov[i][0] * rstd * w[0] * silu(bflo(gw[2 * i])), ov[i][1] * rstd * w[1] * silu(bfhi(gw[2 * i])));
                ow[2 * i + 1] = pack2(ov[i][2] * rstd * w[2] * silu(bflo(gw[2 * i + 1])), ov[i][3] * rstd * w[3] * silu(bfhi(gw[2 * i + 1])));
            }
            bf16_t* op = MIX + row * 2048 + h * 128 + vs * 16;
            *(uint4*)op = make_uint4(ow[0], ow[1], ow[2], ow[3]); *(uint4*)(op + 8) = make_uint4(ow[4], ow[5], ow[6], ow[7]);
        }
    }
#undef HG_LOAD
    float* so = P.out + O_CP + (size_t)(b * 16 + h) * 128 * 128;
#pragma unroll
    for (int j = 0; j < 2; ++j)
#pragma unroll
        for (int reg = 0; reg < 16; ++reg) so[(kb + crow(reg, hh)) * 128 + vb0 + j * 32 + l31] = accS[j][reg];
}
DI void hgrn_sample_item(const Params& P, unsigned char* L, int item) {
    const int b = item >> 4, h = item & 15, tid = otid(), lane = tid & 63;
    float* qv = (float*)L; float* egv = qv + 128; float* kkv = egv + 128; float* vv = kkv + 128; float* part = vv + 128; float* red = part + 16 * 128;
    const bf16_t* U = WSP(bf16_t, OFF_U); bf16_t* MIX = WSP(bf16_t, OFF_MIX);
    const size_t row = (size_t)(MP + b); const bf16_t* ub = U + row * INC + h * 128;
    __syncthreads();
    if (tid < 128) {
        const int ch = h * 128 + tid;
        const float lbv = sigm(P.in[27][2048 + ch] - P.in[27][ch]);
        const float sg = sigm(bf2f(ub[2048 + tid])); const float kv = (1.f - lbv) * (1.f - sg);
        qv[tid] = bf2f(ub[tid]) * 0.08838834764831845f; egv[tid] = 1.f - kv; kkv[tid] = kv;
    } else if (tid < 256) vv[tid - 128] = bf2f(ub[4096 + tid - 128]);
    __syncthreads();
    const float* s0 = P.in[8] + (size_t)(b * 16 + h) * 128 * 128; float* s1 = P.out + O_CS + (size_t)(b * 16 + h) * 128 * 128;
    const int v4 = (tid & 31) * 4; const f32x4 vq = *(const f32x4*)(vv + v4);
    f32x4 op = {0.f, 0.f, 0.f, 0.f};
#pragma unroll
    for (int j = 0; j < 8; ++j) {
        const int k = (tid >> 5) + 16 * j;
        const f32x4 s = *(const f32x4*)(s0 + k * 128 + v4);
        const f32x4 sn = s * egv[k] + vq * kkv[k];
        *(f32x4*)(s1 + k * 128 + v4) = sn;
        op += sn * qv[k];
    }
    *(f32x4*)(part + (tid >> 5) * 128 + v4) = op;
    __syncthreads();
    float o = 0.f;
    if (tid < 128) {
#pragma unroll
        for (int i = 0; i < 16; ++i) o += part[i * 128 + tid];
        const float ss = wave_sum(o * o);
        if (lane == 0) red[tid >> 6] = ss;
    }
    __syncthreads();
    if (tid < 128) {
        const float rstd = rsqrtf((red[0] + red[1]) * (1.f / 128.f) + EPSF);
        const int ch = h * 128 + tid;
        MIX[row * 2048 + ch] = f2bf(o * rstd * P.in[28][ch] * silu(bf2f(ub[6144 + tid])));
    }
}
DI void phase_mix1(const Params& P, unsigned char* L) {
    const int tid = otid(), bid = blockIdx.x;
    if (bid < 128) hgrn_prompt_item(P, L, bid);
    else { const int nb = gridDim.x - 128; for (int it = bid - 128; it < 2048; it += nb) hgrn_sample_item(P, L, it); }
    unsigned* ctr = WSP(unsigned, OFF_CTL) + 48;
    unsigned* bc = (unsigned*)(L + LDS_BYTES - 16);
    for (;;) {
        __syncthreads();
        if (tid == 0) bc[0] = atomicAdd(ctr, 1u);
        __syncthreads();
        const unsigned q = bc[0];
        if (q >= 104u + 130u) break;
        if (q < 104u) l1_weight_tile(P, 2048 + (int)q * 8 + (tid >> 6), (float*)L + (tid >> 6) * (64 * 65), tid & 63);
        else convert_p_chunk(P, 1, (int)q - 104, tid);
    }
}
DI void phase_final(const Params& P) {
    const int lane = threadIdx.x & 63, gw = blockIdx.x * 8 + (threadIdx.x >> 6), nwv = gridDim.x * 8;
    const float* H = WSP(float, OFF_H); const float* SS = WSP(float, OFF_SS2); const float* nf = P.in[10];
    f32x4 w4[4];
#pragma unroll
    for (int i = 0; i < 4; ++i) w4[i] = *(const f32x4*)(nf + lane * 4 + 256 * i);
    for (int r0 = gw * 4; r0 < MV; r0 += nwv * 4) {
        f32x4 v[4][4]; float rs[4];
#pragma unroll
        for (int q = 0; q < 4; ++q) { rs[q] = SS[r0 + q];
#pragma unroll
            for (int i = 0; i < 4; ++i) v[q][i] = *(const f32x4*)(H + (size_t)(r0 + q) * 1024 + lane * 4 + 256 * i); }
#pragma unroll
        for (int q = 0; q < 4; ++q) { const float rstd = rsqrtf(rs[q] * (1.f / 1024.f) + EPSF);
#pragma unroll
            for (int i = 0; i < 4; ++i) __builtin_nontemporal_store(v[q][i] * rstd * w4[i], (f32x4*)(P.out + O_Y + (size_t)(r0 + q) * 1024 + lane * 4 + 256 * i)); }
    }
}

#define XB_TMO      128
#define XB_XCNT(j)  (256  + 64 * (j))
#define XB_XSUB(j)  (1280 + 64 * (j))
#define XB_XGEN(j)  (2304 + 64 * (j))
#define XB_TOP      3328
#define XB_TOPGEN   3392
#define XCD_BAR_WORDS 3456
#define XB_SPIN_CAP (1u << 18)

__device__ __forceinline__ unsigned xb_ld(unsigned* p)              { return __hip_atomic_load(p, __ATOMIC_RELAXED, __HIP_MEMORY_SCOPE_AGENT); }
__device__ __forceinline__ unsigned xb_add(unsigned* p, unsigned v) { return __hip_atomic_fetch_add(p, v, __ATOMIC_RELAXED, __HIP_MEMORY_SCOPE_AGENT); }
__device__ __forceinline__ unsigned xb_xcc_id() { return (unsigned)__builtin_amdgcn_s_getreg((3 << 11) | 20) & 0xFu; }
#define XB_SPIN(cond, bar) do { unsigned _sp = 0; while (cond) { __builtin_amdgcn_s_sleep(1); \
    if ((++_sp & 255u) == 0u) { if (xb_ld(&(bar)[XB_TMO])) break; if (_sp > XB_SPIN_CAP) { atomicAdd(&(bar)[XB_TMO], 1u); break; } } } } while (0)

struct XcdBarrier {
    unsigned* bar; unsigned x;
    volatile LAS unsigned* st;
};

__device__ __forceinline__ XcdBarrier xcd_barrier_post(unsigned* bar, volatile LAS unsigned* st) {
    XcdBarrier b; b.bar = bar; b.x = xb_xcc_id(); b.st = st;
    if (threadIdx.x == 0) (void)xb_add(&bar[XB_XCNT(b.x)], 1u);
    return b;
}
__device__ __forceinline__ void xcd_barrier_complete(unsigned* bar, unsigned x, unsigned& nloc, unsigned& nx) {
    const unsigned G = gridDim.x * gridDim.y * gridDim.z;
    unsigned sum, cnt, mine, sp = 0u;
    for (;;) {
        sum = 0u; cnt = 0u; mine = 0u;
#pragma unroll
        for (unsigned j = 0; j < 16; ++j) { const unsigned c = xb_ld(&bar[XB_XCNT(j)]); sum += c; cnt += (c > 0u) ? 1u : 0u; mine = (j == x) ? c : mine; }
        if (sum == G) break;
        __builtin_amdgcn_s_sleep(1);
        if ((++sp & 255u) == 0u) { if (xb_ld(&bar[XB_TMO])) break; if (sp > XB_SPIN_CAP) { atomicAdd(&bar[XB_TMO], 1u); break; } }
    }
    nloc = mine > 0u ? mine : 1u; nx = cnt > 0u ? cnt : 1u;
}

__device__ __forceinline__ void xcd_barrier(const XcdBarrier& b) {
    asm volatile("s_waitcnt vmcnt(0)" ::: "memory");
    __syncthreads();
    if (threadIdx.x == 0) {
        unsigned* bar = b.bar;
        __builtin_amdgcn_s_waitcnt(0);
        unsigned nloc = b.st[0], nx = b.st[1];
        if (nloc == 0u) { xcd_barrier_complete(bar, b.x, nloc, nx); b.st[0] = nloc; b.st[1] = nx; }
        const unsigned old = xb_add(&bar[XB_XSUB(b.x)], 1u);
        const unsigned gen = old / nloc;
        if (old + 1u == (gen + 1u) * nloc) {
            __builtin_amdgcn_fence(__ATOMIC_RELEASE, "agent");
            asm volatile("s_waitcnt vmcnt(0)" ::: "memory");
            const unsigned og = xb_add(&bar[XB_TOP], 1u);
            const unsigned tg = og / nx;
            if (og + 1u == (tg + 1u) * nx) xb_add(&bar[XB_TOPGEN], 1u);
            else XB_SPIN(xb_ld(&bar[XB_TOPGEN]) == tg, bar);
            __builtin_amdgcn_fence(__ATOMIC_ACQUIRE, "agent");
            xb_add(&bar[XB_XGEN(b.x)], 1u);
            asm volatile("s_waitcnt vmcnt(0)" ::: "memory");
        } else {
            XB_SPIN(xb_ld(&bar[XB_XGEN(b.x)]) == gen, bar);
            __builtin_amdgcn_fence(__ATOMIC_ACQUIRE, "agent");
            asm volatile("s_waitcnt vmcnt(0)" ::: "memory");
        }
    }
    __syncthreads();
}


#ifndef PHM
#define PHM 0xFFFF
#endif
typedef const __attribute__((address_space(4))) Params* ParamsK;
DI Params getp() {
    ParamsK pp = (ParamsK)__builtin_amdgcn_kernarg_segment_ptr(); asm volatile("" : "+s"(pp));
    Params P;
#pragma unroll
    for (int i = 0; i < 32; ++i) P.in[i] = pp->in[i];
    P.out = pp->out; P.ws = pp->ws; return P;
}
#define GETP() const Params P = getp()
__global__ void __launch_bounds__(512, 2) fwd_kernel(Params Parg) {
    extern __shared__ __attribute__((aligned(16))) unsigned char lds[];
    cg::grid_group grid = cg::this_grid();
    unsigned char* L = (unsigned char*)lds;
    LAS unsigned char* LL = (LAS unsigned char*)lds;
    volatile LAS unsigned* xst = (volatile LAS unsigned*)(LL + LDS_BYTES - 32);
    if (threadIdx.x < 2) xst[threadIdx.x] = 0u;
    __syncthreads();
    XcdBarrier xb;
    { GETP(); xb = xcd_barrier_post(WSP(unsigned, OFF_BAR), xst); }
    if (PHM & 1) { GETP(); phase_prep(P, L); }
    if (gridDim.y == 0xFFFFu) grid.sync();
    xcd_barrier(xb);
    if (PHM & 2) { GETP(); pg8::StaticOrder S; S.init(MP, N0 + 256, gridDim.x, blockIdx.x); pg8::Gemm g{WSP(bf16_t, OFF_XN), WSP(bf16_t, OFF_W0T), MP, N0 + 256, 1024};
      EpiStoreBf16 E{WSP(bf16_t, OFF_U), N0, nullptr, WSP(float, OFF_DT)}; pg8::gemm_phase(LL, g, S, E); }
    { GETP(); SfU f{WSP(bf16_t, OFF_U), N0, nullptr, WSP(float, OFF_DT)}; sgemm<4>(WSP(bf16_t, OFF_XN), WSP(bf16_t, OFF_W0T), 1024, 145, 64 * 19, f, L); }
    xcd_barrier(xb);
    { GETP(); phase_convbc(P); }
    xcd_barrier(xb);
    if (PHM & 4) { GETP(); phase_mix0(P, L); }
    xcd_barrier(xb);
    { GETP(); phase_norm0(P); }
    xcd_barrier(xb);
    if (PHM & 8) { GETP(); pg8::StaticOrder S; S.init(MP, 1024, gridDim.x, blockIdx.x); pg8::Gemm g{WSP(bf16_t, OFF_MIX), WSP(bf16_t, OFF_WO0T), MP, 1024, 2048};
      EpiResid E{P.in[0], P.in[1], WSP(float, OFF_H), WSP(bf16_t, OFF_HB)}; pg8::gemm_phase(LL, g, S, E); }
    { GETP(); SfResid f{P.in[1], WSP(float, OFF_H), WSP(bf16_t, OFF_HB)}; sgemm<4>(WSP(bf16_t, OFF_MIX), WSP(bf16_t, OFF_WO0T), 2048, 32, 256, f, L); }
    xcd_barrier(xb);
    if (PHM & 16) { GETP(); pg8::StaticOrder S; S.init(MP, 1024, gridDim.x, blockIdx.x);
      pg8::Gemm g1{WSP(bf16_t, OFF_HB), WSP(bf16_t, OFF_WG0T), MP, 1024, 1024}; EpiGate E1{WSP(bf16_t, OFF_MIX)}; pg8::gemm_phase(LL, g1, S, E1); }
    { GETP(); SfGate f{WSP(bf16_t, OFF_MIX)};   sgemm<2>(WSP(bf16_t, OFF_HB), WSP(bf16_t, OFF_WG0T), 1024, 32, 256, f, L); }
    if (PHM & 16) { GETP(); pg8::StaticOrder S; S.init(MP, 1024, gridDim.x, blockIdx.x);
      pg8::Gemm g2{WSP(bf16_t, OFF_PB), WSP(bf16_t, OFF_WP0T), MP, 1024, 256};
      EpiPle E2{WSP(float, OFF_H), WSP(bf16_t, OFF_MIX), WSP(bf16_t, OFF_XN), P.in[9] + 1024, WSP(float, OFF_SS1)}; pg8::gemm_phase(LL, g2, S, E2); }
    { GETP(); SfPle f{WSP(float, OFF_H), WSP(bf16_t, OFF_MIX), WSP(bf16_t, OFF_XN), P.in[9] + 1024, WSP(float, OFF_SS1)}; sgemm<2>(WSP(bf16_t, OFF_PB), WSP(bf16_t, OFF_WP0T), 256, 32, 256, f, L); }
    xcd_barrier(xb);
    if (PHM & 32) { GETP(); pg8::StaticOrder S; S.init(MP, INC, gridDim.x, blockIdx.x); pg8::Gemm g{WSP(bf16_t, OFF_XN), WSP(bf16_t, OFF_W1T), MP, INC, 1024};
      EpiStoreBf16 E{WSP(bf16_t, OFF_U), INC, WSP(float, OFF_SS1), nullptr}; pg8::gemm_phase(LL, g, S, E); }
    { GETP(); SfU f{WSP(bf16_t, OFF_U), INC, WSP(float, OFF_SS1), nullptr}; sgemm<4>(WSP(bf16_t, OFF_XN), WSP(bf16_t, OFF_W1T), 1024, 256, 64 * 32, f, L); }
    xcd_barrier(xb);
    if (PHM & 64) { GETP(); phase_mix1(P, L); }
    xcd_barrier(xb);
    if (PHM & 128) { GETP(); pg8::StaticOrder S; S.init(MP, 1024, gridDim.x, blockIdx.x); pg8::Gemm g{WSP(bf16_t, OFF_MIX), WSP(bf16_t, OFF_WO1T), MP, 1024, 2048};
      EpiResid E{WSP(float, OFF_H), WSP(float, OFF_H) + (size_t)MP * 1024, WSP(float, OFF_H), WSP(bf16_t, OFF_HB)}; pg8::gemm_phase(LL, g, S, E); }
    { GETP(); SfResid f{WSP(float, OFF_H) + (size_t)MP * 1024, WSP(float, OFF_H), WSP(bf16_t, OFF_HB)}; sgemm<4>(WSP(bf16_t, OFF_MIX), WSP(bf16_t, OFF_WO1T), 2048, 32, 256, f, L); }
    xcd_barrier(xb);
    if (PHM & 256) { GETP(); pg8::StaticOrder S; S.init(MP, 1024, gridDim.x, blockIdx.x);
      pg8::Gemm g1{WSP(bf16_t, OFF_HB), WSP(bf16_t, OFF_WG1T), MP, 1024, 1024}; EpiGate E1{WSP(bf16_t, OFF_MIX)}; pg8::gemm_phase(LL, g1, S, E1); }
    { GETP(); SfGate f{WSP(bf16_t, OFF_MIX)};   sgemm<2>(WSP(bf16_t, OFF_HB), WSP(bf16_t, OFF_WG1T), 1024, 32, 256, f, L); }
    if (PHM & 256) { GETP(); pg8::StaticOrder S; S.init(MP, 1024, gridDim.x, blockIdx.x);
      pg8::Gemm g2{WSP(bf16_t, OFF_PB + PB_STRIDE), WSP(bf16_t, OFF_WP1T), MP, 1024, 256};
      EpiPle E2{WSP(float, OFF_H), WSP(bf16_t, OFF_MIX), nullptr, nullptr, WSP(float, OFF_SS2)}; pg8::gemm_phase(LL, g2, S, E2); }
    { GETP(); SfPle f{WSP(float, OFF_H), WSP(bf16_t, OFF_MIX), nullptr, nullptr, WSP(float, OFF_SS2)}; sgemm<2>(WSP(bf16_t, OFF_PB + PB_STRIDE), WSP(bf16_t, OFF_WP1T), 256, 32, 256, f, L); }
    xcd_barrier(xb);
    { GETP(); phase_final(P); }
}

extern "C" void kernel_launch(void* const* d_in, const int* in_sizes, int n_in, void* d_out, int out_size, void* d_ws, size_t ws_size, hipStream_t stream) {
    static int grid = 0;
    if (grid == 0) {
        if (n_in != 32 || ws_size < WS_END) { fprintf(stderr, "kernel_launch: need 32 inputs and %zu bytes of workspace (got %d, %zu)\n", (size_t)WS_END, n_in, ws_size); grid = -1; return; }
        int dev = 0, cus = 0, per_cu = 0;
        (void)hipGetDevice(&dev); (void)hipDeviceGetAttribute(&cus, hipDeviceAttributeMultiprocessorCount, dev);
        if (hipFuncSetAttribute((const void*)fwd_kernel, hipFuncAttributeMaxDynamicSharedMemorySize, LDS_BYTES) != hipSuccess) { fprintf(stderr, "kernel_launch: hipFuncSetAttribute failed\n"); grid = -1; return; }
        if (hipOccupancyMaxActiveBlocksPerMultiprocessor(&per_cu, (const void*)fwd_kernel, 512, LDS_BYTES) != hipSuccess || per_cu < 1) { fprintf(stderr, "kernel_launch: occupancy query says %d\n", per_cu); per_cu = 1; }
        (void)hipGetLastError();
        grid = cus;
    }
    if (grid < 0) return;
    Params p{};
    for (int i = 0; i < 32; ++i) p.in[i] = (const float*)d_in[i];
    p.out = (float*)d_out; p.ws = (unsigned char*)d_ws;
    if (hipMemsetAsync((char*)d_ws + OFF_BAR, 0, 16384, stream) != hipSuccess) { fprintf(stderr, "kernel_launch: memset of barrier words failed\n"); return; }
    void* args[] = {&p};
    hipError_t e = hipLaunchCooperativeKernel((const void*)fwd_kernel, dim3(grid), dim3(512), args, LDS_BYTES, stream);
    if (e != hipSuccess) fprintf(stderr, "cooperative launch failed: %s (grid %d)\n", hipGetErrorString(e), grid);
}
```

```cpp
#include <hip/hip_runtime.h>
#include <hip/hip_cooperative_groups.h>
#include <cstdio>
namespace cg = cooperative_groups;

#define LAS __attribute__((address_space(3)))
#define DI __device__ __forceinline__
typedef unsigned short bf16_t;
typedef short bf16x8 __attribute__((ext_vector_type(8)));
typedef float f32x4 __attribute__((ext_vector_type(4)));
typedef float f32x16 __attribute__((ext_vector_type(16)));

constexpr int MP = 16384, MS = 128, MV = MP + MS, MPAD = 16640;
constexpr int DM = 1024, INAB = 4624, N0 = 4608, INC = 8192;
constexpr float EPSF = 1e-6f;
constexpr size_t O_Y = 0, O_AHP = 16908288, O_ACP = 16916480, O_BSP = 16941056, O_BCP = 17989632, O_CP = 18026496,
                 O_AHS = 20123648, O_ACS = 20254720, O_BSS = 20647936, O_BCS = 37425152, O_CS = 38014976;
constexpr size_t al256(size_t x) { return (x + 255) & ~size_t(255); }
constexpr size_t OFF_CTL = 0;
constexpr size_t OFF_BAR = 256;
constexpr size_t OFF_SS1 = 256 + 16384;
constexpr size_t OFF_SS2 = OFF_SS1 + al256((size_t)MPAD * 4);
constexpr size_t OFF_SSB = OFF_SS2 + al256((size_t)MPAD * 4);
constexpr size_t OFF_DT  = OFF_SSB + al256((size_t)MPAD * 8);
constexpr size_t OFF_W0T = OFF_DT + al256((size_t)MV * 16 * 4);
constexpr size_t OFF_WO0T = OFF_W0T + (size_t)(N0 + 256) * 1024 * 2;
constexpr size_t OFF_WG0T = OFF_WO0T + (size_t)1024 * 2048 * 2;
constexpr size_t OFF_WP0T = OFF_WG0T + (size_t)1024 * 1024 * 2;
constexpr size_t OFF_W1T  = OFF_WP0T + (size_t)1024 * 256 * 2;
constexpr size_t OFF_WO1T = OFF_W1T + (size_t)INC * 1024 * 2;
constexpr size_t OFF_WG1T = OFF_WO1T + (size_t)1024 * 2048 * 2;
constexpr size_t OFF_WP1T = OFF_WG1T + (size_t)1024 * 1024 * 2;
constexpr size_t OFF_WRT  = OFF_WP1T + (size_t)1024 * 256 * 2;
constexpr size_t OFF_WIT  = OFF_WRT + (size_t)128 * 1024 * 2;
constexpr size_t OFF_XN   = OFF_WIT + (size_t)128 * 1024 * 2;
constexpr size_t OFF_MIX  = OFF_XN + (size_t)MPAD * 1024 * 2;
constexpr size_t OFF_H    = OFF_MIX + (size_t)MPAD * 2048 * 2;
constexpr size_t OFF_U    = OFF_H + al256((size_t)MV * 1024 * 4);
constexpr size_t OFF_HB   = OFF_U;
constexpr size_t OFF_PB   = OFF_U + al256((size_t)MV * INC * 2);
constexpr size_t PB_STRIDE = (size_t)MPAD * 256 * 2;
constexpr size_t WS_END   = OFF_PB + 2 * PB_STRIDE;
constexpr int LDS_BYTES = 160 * 1024;

struct Params { const float* in[32]; float* out; unsigned char* ws; };
#define WSP(T, off) ((T*)(P.ws + (off)))

typedef __bf16 bf16v2_t __attribute__((ext_vector_type(2)));
typedef float f32v2_t __attribute__((ext_vector_type(2)));
DI unsigned pack2(float lo, float hi) { f32v2_t v = {lo, hi}; bf16v2_t b = __builtin_convertvector(v, bf16v2_t); return __builtin_bit_cast(unsigned, b); }
DI bf16_t f2bf(float f) { return __builtin_bit_cast(bf16_t, (__bf16)f); }
DI float bf2f(bf16_t b) { return __uint_as_float(((unsigned)b) << 16); }
DI float bflo(unsigned w) { return __uint_as_float(w << 16); }
DI float bfhi(unsigned w) { return __uint_as_float(w & 0xFFFF0000u); }
DI float frcp(float x) { return __builtin_amdgcn_rcpf(x); }
DI float sigm(float x) { return frcp(1.f + __expf(-x)); }
DI float silu(float x) { return x * frcp(1.f + __expf(-x)); }
DI float softplus(float x) { return x > 20.f ? x : log1pf(__expf(x)); }
DI float wave_sum(float v) { for (int o = 32; o > 0; o >>= 1) v += __shfl_xor(v, o); return v; }
DI int otid() { int t = threadIdx.x; asm volatile("" : "+v"(t)); return t; }
DI void lds_barrier() { asm volatile("s_waitcnt lgkmcnt(0)" ::: "memory"); __builtin_amdgcn_s_barrier(); asm volatile("" ::: "memory"); }
DI int crow(int reg, int hh) { return (reg & 3) + 8 * (reg >> 2) + 4 * hh; }
DI void ld4bf(const bf16_t* p, float (&o)[4]) { uint2 w = *(const uint2*)p; o[0] = bflo(w.x); o[1] = bfhi(w.x); o[2] = bflo(w.y); o[3] = bfhi(w.y); }
typedef unsigned u32x2 __attribute__((ext_vector_type(2)));
typedef unsigned u32x4 __attribute__((ext_vector_type(4)));
DI u32x2 pack4v(float a, float b, float c, float d) { u32x2 r; r.x = pack2(a, b); r.y = pack2(c, d); return r; }
DI uint2 pack4(float a, float b, float c, float d) { uint2 r; r.x = pack2(a, b); r.y = pack2(c, d); return r; }
#define MFMA32(a, b, c) __builtin_amdgcn_mfma_f32_32x32x16_bf16((a), (b), (c), 0, 0, 0)
#define MFMA16(a, b, c) __builtin_amdgcn_mfma_f32_16x16x32_bf16((a), (b), (c), 0, 0, 0)
DI bf16x8 ldfrag(const bf16_t* base, int ld, int row0, int k0, int lane) { return *(const bf16x8*)(base + (row0 + (lane & 31)) * ld + k0 + 8 * (lane >> 5)); }
DI bf16x8 ldfrag16(const bf16_t* base, int ld, int row0, int k0, int lane) { return *(const bf16x8*)(base + (row0 + (lane & 15)) * ld + k0 + 8 * (lane >> 4)); }

namespace pg8 {
constexpr int BM = 256, BK = 64, HALF = 128, HTB = HALF * BK * 2, STAGE_BYTES = 8 * HTB, NXCD = 8, WGM = 8;
DI int lds_byte(int r, int c) { const int st = (r >> 4) * 2 + (c >> 5), rr = r & 15, cc = c & 31, ob = rr * 64 + cc * 2; return st * 1024 + (ob ^ (((ob >> 9) & 1) << 5)); }
DI void stage_rc(int b, int& R, int& C) { const int st = b / 1024, sb = b % 1024, swz = sb ^ (((sb >> 9) & 1) << 5); R = (st >> 1) * 16 + swz / 64; C = (st & 1) * 32 + (swz % 64) / 2; }
DI int perm32(int rho) { const int n = rho >> 4, i = rho & 15; return 8 * (i >> 2) + 4 * n + (i & 3); }
struct Unit { int pm, pn; };
struct Gemm { const bf16_t* A; const bf16_t* Bt; int M, N, K; };
struct StaticOrder {
    int nM, nN, nwg, G, c;
    DI void init(int M, int N, int G_, int c_) { nM = M / BM; nN = N / BM; nwg = nM * nN; G = G_; c = c_; }
    DI bool next(int i, Unit& u) const {
        const long L = (long)i * G + c; if (L >= nwg) return false;
        int wgid = (int)L; { const int q = nwg / NXCD, r = nwg % NXCD, xcd = wgid % NXCD, off = wgid / NXCD; wgid = (xcd < r ? xcd * (q + 1) : r * (q + 1) + (xcd - r) * q) + off; }
        const int nig = WGM * nN, gid = wgid / nig, fm = gid * WGM, gsz = (nM - fm) < WGM ? (nM - fm) : WGM;
        u.pm = fm + ((wgid % nig) % gsz); u.pn = (wgid % nig) / gsz; return true;
    }
};

template <class Epi>
DI void gemm_phase(LAS unsigned char* lds, const Gemm g, const StaticOrder& S, const Epi& E) {
    const int tid = otid(), wid = __builtin_amdgcn_readfirstlane(tid >> 6), lane = tid & 63, wr = wid >> 2, wc = wid & 3, fr = lane & 15, fq = lane >> 4;
    const int K = g.K, nt = K / BK;
    unsigned voffA[2], voffB[2];
#pragma unroll
    for (int i = 0; i < 2; ++i) { int R, C; stage_rc(tid * 16 + i * 8192, R, C); const int Rb = Epi::PERM ? ((R & ~31) + perm32(R & 31)) : R;
        voffA[i] = (unsigned)(R * K + C) * 2u; voffB[i] = (unsigned)(Rb * K + C) * 2u; }
    const size_t kstep = (size_t)(BK * 2);
    const size_t hstep = (size_t)HALF * K * 2;
    const size_t tstep = 2 * hstep;
    const unsigned ldsw = (unsigned)wid * 1024u;
    const int aoff = lds_byte(wr * 64 + fr, fq * 8), boff = lds_byte(wc * 32 + fr, fq * 8);
#define PG8_SA(b, h) (((b) * 2 + (h)) * HTB)
#define PG8_SB(b, h) ((4 + (b) * 2 + (h)) * HTB)
#define PG8_STAGE(bufoff, gbase, voff) do { _Pragma("unroll") for (int _i = 0; _i < 2; ++_i) \
        __builtin_amdgcn_global_load_lds((const unsigned*)((const char*)(gbase) + (voff)[_i]), (LAS unsigned*)(lds + (bufoff) + ldsw + _i * 8192), 16, 0, 0); } while (0)
#define PG8_LDA(dst, b, h) do { _Pragma("unroll") for (int m = 0; m < 4; ++m) _Pragma("unroll") for (int k = 0; k < 2; ++k) dst[m][k] = *(const LAS bf16x8*)(lds + PG8_SA(b, h) + aoff + m * 2048 + k * 1024); } while (0)
#define PG8_LDB(dst, b, h) do { _Pragma("unroll") for (int n = 0; n < 2; ++n) _Pragma("unroll") for (int k = 0; k < 2; ++k) dst[n][k] = *(const LAS bf16x8*)(lds + PG8_SB(b, h) + boff + n * 2048 + k * 1024); } while (0)
#define PG8_MMA(ai, bj, At, Bt) do { __builtin_amdgcn_s_setprio(1); _Pragma("unroll") for (int m = 0; m < 4; ++m) _Pragma("unroll") for (int n = 0; n < 2; ++n) _Pragma("unroll") for (int k = 0; k < 2; ++k) \
        acc[ai][bj][m][n] = __builtin_amdgcn_mfma_f32_16x16x32_bf16(Bt[n][k], At[m][k], acc[ai][bj][m][n], 0, 0, 0); __builtin_amdgcn_s_setprio(0); } while (0)
#define PG8_WAIT_V(n) asm volatile("s_waitcnt vmcnt(" #n ")" ::: "memory")
#define PG8_WAIT_L(n) asm volatile("s_waitcnt lgkmcnt(" #n ")" ::: "memory")
#define PG8_BAR __builtin_amdgcn_s_barrier()
#define PG8_SCHED __builtin_amdgcn_sched_barrier(0)
    Unit cur, nxt; int ui = 0;
    if (!S.next(0, cur)) return;
    f32x4 acc[2][2][4][2];
#pragma unroll
    for (int a = 0; a < 2; ++a)
#pragma unroll
        for (int b = 0; b < 2; ++b)
#pragma unroll
            for (int m = 0; m < 4; ++m)
#pragma unroll
                for (int n = 0; n < 2; ++n) acc[a][b][m][n] = (f32x4){0.f, 0.f, 0.f, 0.f};
    bf16x8 At[4][2], B0[2][2], B1[2][2];
    const char* cA = (const char*)g.A + (size_t)cur.pm * tstep; const char* cB = (const char*)g.Bt + (size_t)cur.pn * tstep;
    PG8_STAGE(PG8_SB(0, 0), cB, voffB); PG8_STAGE(PG8_SA(0, 0), cA, voffA); PG8_STAGE(PG8_SB(0, 1), cB + hstep, voffB); PG8_STAGE(PG8_SA(0, 1), cA + hstep, voffA);
    if (wr == 1) PG8_BAR;
    PG8_WAIT_V(4); PG8_BAR;
    PG8_STAGE(PG8_SB(1, 0), cB + kstep, voffB); PG8_STAGE(PG8_SA(1, 0), cA + kstep, voffA); PG8_STAGE(PG8_SB(1, 1), cB + hstep + kstep, voffB);
    PG8_WAIT_V(6); PG8_BAR;
    for (;;) {
        const bool has_next = S.next(ui + 1, nxt);
        const char* nA = has_next ? (const char*)g.A + (size_t)nxt.pm * tstep : cA; const char* nB = has_next ? (const char*)g.Bt + (size_t)nxt.pn * tstep : cB;
        for (int t = 0; t < nt; t += 2) {
            const bool last = (t == nt - 2);
            const char* a1 = cA + (size_t)(t + 1) * kstep;
            const char* a2 = last ? nA : cA + (size_t)(t + 2) * kstep; const char* b2 = last ? nB : cB + (size_t)(t + 2) * kstep;
            const char* a3 = a2 + kstep; const char* b3 = b2 + kstep;
            PG8_LDB(B0, 0, 0); PG8_SCHED; PG8_LDA(At, 0, 0); PG8_STAGE(PG8_SA(1, 1), a1 + hstep, voffA);
            PG8_WAIT_L(8); PG8_BAR; PG8_WAIT_L(0); PG8_MMA(0, 0, At, B0); PG8_BAR; PG8_SCHED;
            PG8_LDB(B1, 0, 1); PG8_STAGE(PG8_SB(0, 0), b2, voffB);
            PG8_BAR; PG8_WAIT_L(0); PG8_MMA(0, 1, At, B1); PG8_BAR;
            PG8_LDA(At, 0, 1); PG8_STAGE(PG8_SA(0, 0), a2, voffA);
            PG8_BAR; PG8_WAIT_L(0); PG8_MMA(1, 0, At, B0); PG8_BAR; PG8_SCHED;
            PG8_STAGE(PG8_SB(0, 1), b2 + hstep, voffB);
            PG8_WAIT_V(6); PG8_BAR; PG8_MMA(1, 1, At, B1); PG8_BAR;
            PG8_LDB(B0, 1, 0); PG8_SCHED; PG8_LDA(At, 1, 0); PG8_STAGE(PG8_SA(0, 1), a2 + hstep, voffA);
            PG8_WAIT_L(8); PG8_BAR; PG8_WAIT_L(0); PG8_MMA(0, 0, At, B0); PG8_BAR; PG8_SCHED;
            PG8_LDB(B1, 1, 1); PG8_STAGE(PG8_SB(1, 0), b3, voffB);
            PG8_BAR; PG8_WAIT_L(0); PG8_MMA(0, 1, At, B1); PG8_BAR;
            PG8_LDA(At, 1, 1); PG8_STAGE(PG8_SA(1, 0), a3, voffA);
            PG8_BAR; PG8_WAIT_L(0); PG8_MMA(1, 0, At, B0); PG8_BAR; PG8_SCHED;
            PG8_STAGE(PG8_SB(1, 1), b3 + hstep, voffB);
            PG8_WAIT_V(6); PG8_BAR; PG8_MMA(1, 1, At, B1); PG8_BAR;
        }
        E(acc, cur, wr, wc, fr, fq);
        if (!has_next) break;
#pragma unroll
        for (int a = 0; a < 2; ++a)
#pragma unroll
            for (int b = 0; b < 2; ++b)
#pragma unroll
                for (int m = 0; m < 4; ++m)
#pragma unroll
                    for (int n = 0; n < 2; ++n) acc[a][b][m][n] = (f32x4){0.f, 0.f, 0.f, 0.f};
        cur = nxt; cA = nA; cB = nB; ++ui;
    }
    PG8_WAIT_V(0);
    if (wr == 0) PG8_BAR;
    PG8_BAR;
#undef PG8_SA
#undef PG8_SB
#undef PG8_STAGE
#undef PG8_LDA
#undef PG8_LDB
#undef PG8_MMA
#undef PG8_WAIT_V
#undef PG8_WAIT_L
#undef PG8_BAR
#undef PG8_SCHED
}
}

struct EpiStoreBf16 {
    static constexpr bool PERM = true;
    bf16_t* O; int ldc; const float* ss; float* DT;
    DI void operator()(const f32x4 (&acc)[2][2][4][2], const pg8::Unit& u, int wr, int wc, int fr, int fq) const {
        const int row0 = u.pm * 256 + wr * 64 + fr, col0 = u.pn * 256 + wc * 32 + 8 * fq;
        if (u.pn * 256 >= ldc) {
            if (wc == 0 && fq < 2) {
#pragma unroll
                for (int ai = 0; ai < 2; ++ai)
#pragma unroll
                    for (int m = 0; m < 4; ++m) { const int row = row0 + ai * 128 + m * 16;
                        if (row < MV) { *(f32x4*)(DT + (size_t)row * 16 + 8 * fq) = acc[ai][0][m][0]; *(f32x4*)(DT + (size_t)row * 16 + 8 * fq + 4) = acc[ai][0][m][1]; } }
            }
            return;
        }
#pragma unroll
        for (int ai = 0; ai < 2; ++ai)
#pragma unroll
            for (int m = 0; m < 4; ++m) {
                const int row = row0 + ai * 128 + m * 16;
                if (row < MV) {
                    const float sc = ss ? rsqrtf(ss[row] * (1.f / 1024.f) + EPSF) : 1.f;
                    bf16_t* rp = O + (size_t)row * ldc + col0;
#pragma unroll
                    for (int bj = 0; bj < 2; ++bj) {
                        const f32x4 v0 = acc[ai][bj][m][0] * sc, v1 = acc[ai][bj][m][1] * sc;
                        uint4 w; w.x = pack2(v0[0], v0[1]); w.y = pack2(v0[2], v0[3]); w.z = pack2(v1[0], v1[1]); w.w = pack2(v1[2], v1[3]);
                        *(uint4*)(rp + bj * 128) = w;
                    }
                }
            }
    }
};
struct EpiResid {
    static constexpr bool PERM = false;
    const float* rp_prompt; const float* rp_sample;
    float* H; bf16_t* HB;
    DI void operator()(const f32x4 (&acc)[2][2][4][2], const pg8::Unit& u, int wr, int wc, int fr, int fq) const {
        const int row0 = u.pm * 256 + wr * 64 + fr, col0 = u.pn * 256 + wc * 32 + 4 * fq;
#pragma unroll
        for (int ai = 0; ai < 2; ++ai)
#pragma unroll
            for (int m = 0; m < 4; ++m) {
                const int row = row0 + ai * 128 + m * 16;
                if (row < MV) {
                    const float* rs = (row < MP ? rp_prompt + (size_t)row * 1024 : rp_sample + (size_t)(row - MP) * 1024) + col0;
                    float* hp = H + (size_t)row * 1024 + col0; bf16_t* bp = HB + (size_t)row * 1024 + col0;
#pragma unroll
                    for (int bj = 0; bj < 2; ++bj)
#pragma unroll
                        for (int n = 0; n < 2; ++n) {
                            const int co = bj * 128 + n * 16;
                            const f32x4 v = acc[ai][bj][m][n] + *(const f32x4*)(rs + co);
                            *(f32x4*)(hp + co) = v; *(uint2*)(bp + co) = pack4(v[0], v[1], v[2], v[3]);
                        }
                }
            }
    }
};
struct EpiGate {
    static constexpr bool PERM = false;
    bf16_t* Gt;
    DI void operator()(const f32x4 (&acc)[2][2][4][2], const pg8::Unit& u, int wr, int wc, int fr, int fq) const {
        const int row0 = u.pm * 256 + wr * 64 + fr, col0 = u.pn * 256 + wc * 32 + 4 * fq;
#pragma unroll
        for (int ai = 0; ai < 2; ++ai)
#pragma unroll
            for (int m = 0; m < 4; ++m) {
                const int row = row0 + ai * 128 + m * 16;
                if (row < MV) {
                    bf16_t* gp = Gt + (size_t)row * 1024 + col0;
#pragma unroll
                    for (int bj = 0; bj < 2; ++bj)
#pragma unroll
                        for (int n = 0; n < 2; ++n) {
                            const f32x4 a = acc[ai][bj][m][n];
                            *(uint2*)(gp + bj * 128 + n * 16) = pack4(sigm(a[0]), sigm(a[1]), sigm(a[2]), sigm(a[3]));
                        }
                }
            }
    }
};
struct EpiPle {
    static constexpr bool PERM = false;
    float* H; const bf16_t* Gt; bf16_t* XN; const float* nw; float* SS;
    DI void operator()(const f32x4 (&acc)[2][2][4][2], const pg8::Unit& u, int wr, int wc, int fr, int fq) const {
        const int row0 = u.pm * 256 + wr * 64 + fr, col0 = u.pn * 256 + wc * 32 + 4 * fq;
#pragma unroll
        for (int ai = 0; ai < 2; ++ai)
#pragma unroll
            for (int m = 0; m < 4; ++m) {
                const int row = row0 + ai * 128 + m * 16;
                float ssum = 0.f;
                if (row < MV) {
                    float* hp = H + (size_t)row * 1024 + col0; const bf16_t* gp = Gt + (size_t)row * 1024 + col0;
#pragma unroll
                    for (int bj = 0; bj < 2; ++bj)
#pragma unroll
                        for (int n = 0; n < 2; ++n) {
                            const int co = bj * 128 + n * 16;
                            float gq[4]; ld4bf(gp + co, gq); const f32x4 v = *(const f32x4*)(hp + co) + (f32x4){gq[0], gq[1], gq[2], gq[3]} * acc[ai][bj][m][n];
                            *(f32x4*)(hp + co) = v;
                            ssum += v[0] * v[0] + v[1] * v[1] + v[2] * v[2] + v[3] * v[3];
                            if (XN) { const f32x4 w = *(const f32x4*)(nw + col0 + co); *(uint2*)(XN + (size_t)row * 1024 + col0 + co) = pack4(v[0] * w[0], v[1] * w[1], v[2] * w[2], v[3] * w[3]); }
                        }
                }
                ssum += __shfl_xor(ssum, 16); ssum += __shfl_xor(ssum, 32);
                if (fq == 0 && row < MV) atomicAdd(SS + row, ssum);
            }
    }
};

template <int KS, class F>
DI void sgemm(const bf16_t* A, const bf16_t* Bt, int K, int ncolt, int nwg_main, const F& f, unsigned char* L) {
    constexpr int RT = 8 / KS, NRS = 128 / (16 * RT);
    const int tid = otid(), lane = tid & 63, wid = __builtin_amdgcn_readfirstlane(tid >> 6), rt = wid % RT, ks = wid / RT;
    const int G = gridDim.x, off = nwg_main % G, Kh = K / KS;
    int li = blockIdx.x, nl = G;
    if (off != 0) { if ((int)blockIdx.x < off) return; li = blockIdx.x - off; nl = G - off; }
    float* red = (float*)L;
    for (int t = li; t < ncolt * NRS; t += nl) {
        const int ct = t / NRS, rs = t % NRS;
        const bf16_t* ap = A + (size_t)(MP + rs * 16 * RT + rt * 16 + (lane & 15)) * K + ks * Kh + 8 * (lane >> 4);
        const bf16_t* bp0 = Bt + (size_t)(ct * 32 + (lane & 15)) * K + ks * Kh + 8 * (lane >> 4);
        const bf16_t* bp1 = bp0 + (size_t)16 * K;
        f32x4 acc0 = {0.f, 0.f, 0.f, 0.f}, acc1 = {0.f, 0.f, 0.f, 0.f};
        bf16x8 a0[4], a1[4], p0[4], p1[4], q0[4], q1[4];
#define SG_LOAD(av, pv, qv, kk) do { _Pragma("unroll") for (int q_ = 0; q_ < 4; ++q_) { av[q_] = *(const bf16x8*)(ap + (kk) + q_ * 32); pv[q_] = *(const bf16x8*)(bp0 + (kk) + q_ * 32); qv[q_] = *(const bf16x8*)(bp1 + (kk) + q_ * 32); } } while (0)
#define SG_MMA(av, pv, qv) do { _Pragma("unroll") for (int q_ = 0; q_ < 4; ++q_) { acc0 = MFMA16(av[q_], pv[q_], acc0); acc1 = MFMA16(av[q_], qv[q_], acc1); } } while (0)
        SG_LOAD(a0, p0, q0, 0);
        for (int k0 = 0; k0 < Kh; k0 += 256) {
            if (k0 + 128 < Kh) SG_LOAD(a1, p1, q1, k0 + 128);
            SG_MMA(a0, p0, q0);
            if (k0 + 256 < Kh) SG_LOAD(a0, p0, q0, k0 + 256);
            if (k0 + 128 < Kh) SG_MMA(a1, p1, q1);
        }
#undef SG_LOAD
#undef SG_MMA
        if (ks > 0) { float* rp = red + (((ks - 1) * RT + rt) * 64 + lane) * 8; *(f32x4*)rp = acc0; *(f32x4*)(rp + 4) = acc1; }
        lds_barrier();
        if (ks == 0) {
#pragma unroll
            for (int j = 0; j < KS - 1; ++j) { const float* rp = red + ((j * RT + rt) * 64 + lane) * 8; acc0 += *(const f32x4*)rp; acc1 += *(const f32x4*)(rp + 4); }
#pragma unroll
            for (int reg = 0; reg < 4; ++reg) {
                const int row = MP + rs * 16 * RT + rt * 16 + (lane >> 4) * 4 + reg, col = ct * 32 + (lane & 15);
                f(row, col, acc0[reg], lane); f(row, col + 16, acc1[reg], lane);
            }
        }
        lds_barrier();
    }
}
struct SfU { bf16_t* O; int ldc; const float* ss; float* DT;
    DI void operator()(int row, int col, float v, int) const {
        if (col >= ldc) { if (col < ldc + 16) DT[(size_t)row * 16 + col - ldc] = v; return; }
        const float sc = ss ? rsqrtf(ss[row] * (1.f / 1024.f) + EPSF) : 1.f; O[(size_t)row * ldc + col] = f2bf(v * sc); } };
struct SfResid { const float* rs; float* H; bf16_t* HB;
    DI void operator()(int row, int col, float v, int) const { const float h = rs[(size_t)(row - MP) * 1024 + col] + v; H[(size_t)row * 1024 + col] = h; HB[(size_t)row * 1024 + col] = f2bf(h); } };
struct SfGate { bf16_t* Gt; DI void operator()(int row, int col, float v, int) const { Gt[(size_t)row * 1024 + col] = f2bf(sigm(v)); } };
struct SfPle { float* H; const bf16_t* Gt; bf16_t* XN; const float* nw; float* SS;
    DI void operator()(int row, int col, float v, int lane) const {
        const size_t o = (size_t)row * 1024 + col; const float h = H[o] + bf2f(Gt[o]) * v; H[o] = h;
        if (XN) XN[o] = f2bf(h * nw[col]);
        float ss = h * h; ss += __shfl_xor(ss, 1); ss += __shfl_xor(ss, 2); ss += __shfl_xor(ss, 4); ss += __shfl_xor(ss, 8);
        if ((lane & 15) == 0) atomicAdd(SS + row, ss); } };

DI void transpose_tile_w(const float* src, int lds_, bf16_t* dst, int ldd, int k0, int n0, int nvalid, float* tile, int lane) {
    const float* sp = src + (size_t)k0 * lds_ + n0 + lane;
#pragma unroll
    for (int bt = 0; bt < 4; ++bt) {
        float v[16];
#pragma unroll
        for (int r = 0; r < 16; ++r) v[r] = (lane < nvalid) ? sp[(size_t)(bt * 16 + r) * lds_] : 0.f;
#pragma unroll
        for (int r = 0; r < 16; ++r) tile[(bt * 16 + r) * 65 + lane] = v[r];
    }
    const int koct = lane & 7;
#pragma unroll
    for (int p = 0; p < 8; ++p) {
        const int nn = (lane >> 3) + 8 * p;
        const float* tp = tile + (koct * 8) * 65 + nn;
        uint4 w;
        w.x = pack2(tp[0], tp[65]); w.y = pack2(tp[2 * 65], tp[3 * 65]); w.z = pack2(tp[4 * 65], tp[5 * 65]); w.w = pack2(tp[6 * 65], tp[7 * 65]);
        *(uint4*)(dst + (size_t)(n0 + nn) * ldd + k0 + koct * 8) = w;
    }
}
DI void transpose_job(const float* src, int lds_, bf16_t* dst, int ldd, int K, int N, int nvalid_last, int& base, float* tile, int gw, int nwv, int lane) {
    const int ntn = (N + 63) / 64, nt = (K / 64) * ntn;
    const int first = (gw - (base % nwv) + nwv) % nwv;
    for (int t = first; t < nt; t += nwv) { const int tn = t % ntn; transpose_tile_w(src, lds_, dst, ldd, (t / ntn) * 64, tn * 64, (tn == ntn - 1) ? nvalid_last : 64, tile, lane); }
    base += nt;
}
DI void l1_weight_tile(const Params& P, int t, float* tile, int lane) {
    if (t < 2048) transpose_tile_w(P.in[26], INC, WSP(bf16_t, OFF_W1T), 1024, (t >> 7) * 64, (t & 127) * 64, 64, tile, lane);
    else if (t < 2560) { t -= 2048; transpose_tile_w(P.in[29], 1024, WSP(bf16_t, OFF_WO1T), 2048, (t >> 4) * 64, (t & 15) * 64, 64, tile, lane); }
    else if (t < 2816) { t -= 2560; transpose_tile_w(P.in[31] + 1024 * 1024, 1024, WSP(bf16_t, OFF_WG1T), 1024, (t >> 4) * 64, (t & 15) * 64, 64, tile, lane); }
    else if (t < 2880) { t -= 2816; transpose_tile_w(P.in[30] + 256 * 1024, 1024, WSP(bf16_t, OFF_WP1T), 256, (t >> 4) * 64, (t & 15) * 64, 64, tile, lane); }
    else if (t < 3392) { t -= 2880; transpose_tile_w(P.in[25], 1024, WSP(bf16_t, OFF_WO0T), 2048, (t >> 4) * 64, (t & 15) * 64, 64, tile, lane); }
    else if (t < 3648) { t -= 3392; transpose_tile_w(P.in[31], 1024, WSP(bf16_t, OFF_WG0T), 1024, (t >> 4) * 64, (t & 15) * 64, 64, tile, lane); }
    else { t -= 3648; transpose_tile_w(P.in[30], 1024, WSP(bf16_t, OFF_WP0T), 256, (t >> 4) * 64, (t & 15) * 64, 64, tile, lane); }
}
DI void phase_prep(const Params& P, unsigned char* L) {
    const int tid = otid(), lane = tid & 63, wid = tid >> 6;
    const int gw = blockIdx.x * 8 + wid, nwv = gridDim.x * 8;
    { float* z = WSP(float, OFF_SS1); const int n = (int)((OFF_DT - OFF_SS1) / 4);
      for (int i = blockIdx.x * 512 + tid; i < n; i += gridDim.x * 512) z[i] = 0.f;
      if (blockIdx.x == 0 && tid < 64) WSP(unsigned, OFF_CTL)[tid] = 0u; }
    { float* tile = (float*)L + wid * (64 * 65); int base = 0;
      transpose_job(P.in[11], INAB, WSP(bf16_t, OFF_W0T), 1024, 1024, N0, 64, base, tile, gw, nwv, lane);
      transpose_job(P.in[11] + N0, INAB, WSP(bf16_t, OFF_W0T) + (size_t)N0 * 1024, 1024, 1024, 16, 16, base, tile, gw, nwv, lane);
      transpose_job(P.in[14], 128, WSP(bf16_t, OFF_WRT), 1024, 1024, 128, 64, base, tile, gw, nwv, lane);
      transpose_job(P.in[16], 128, WSP(bf16_t, OFF_WIT), 1024, 1024, 128, 64, base, tile, gw, nwv, lane); }
    { const float* nwp = P.in[9]; bf16_t* XN = WSP(bf16_t, OFF_XN);
      f32x4 w4[4];
#pragma unroll
      for (int i = 0; i < 4; ++i) w4[i] = *(const f32x4*)(nwp + lane * 4 + 256 * i);
      for (int r0 = gw * 2; r0 < MV; r0 += nwv * 2) {
          f32x4 x[2][4];
#pragma unroll
          for (int q = 0; q < 2; ++q) { const int r = r0 + q; const float* src = r < MP ? P.in[0] + (size_t)r * 1024 : P.in[1] + (size_t)(r - MP) * 1024;
#pragma unroll
              for (int i = 0; i < 4; ++i) x[q][i] = *(const f32x4*)(src + lane * 4 + 256 * i); }
#pragma unroll
          for (int q = 0; q < 2; ++q) {
              float ss = 0.f;
#pragma unroll
              for (int i = 0; i < 4; ++i) ss += x[q][i][0] * x[q][i][0] + x[q][i][1] * x[q][i][1] + x[q][i][2] * x[q][i][2] + x[q][i][3] * x[q][i][3];
              ss = wave_sum(ss); const float rstd = rsqrtf(ss * (1.f / 1024.f) + EPSF);
#pragma unroll
              for (int i = 0; i < 4; ++i) { const f32x4 v = x[q][i] * rstd * w4[i]; *(uint2*)(XN + (size_t)(r0 + q) * 1024 + lane * 4 + 256 * i) = pack4(v[0], v[1], v[2], v[3]); }
          }
      } }
}
DI void convert_p_chunk(const Params& P, int layer, int chunk, int tid) {
    bf16_t* PB = WSP(bf16_t, OFF_PB + (size_t)layer * PB_STRIDE);
    const float* pp = P.in[2] + (size_t)layer * MP * 256; const float* ps = P.in[3] + (size_t)layer * MS * 256;
#pragma unroll 4
    for (int j = 0; j < 16; ++j) {
        const int i = chunk * 8192 + j * 512 + tid;
        if (i < MV * 64) {
            const int row = i >> 6, c4 = (i & 63) * 4;
            const f32x4 v = *(const f32x4*)((row < MP ? pp + (size_t)row * 256 : ps + (size_t)(row - MP) * 256) + c4);
            *(uint2*)(PB + (size_t)row * 256 + c4) = pack4(v[0], v[1], v[2], v[3]);
        }
    }
}

constexpr size_t OFF_XT = OFF_XN;
constexpr size_t OFF_CN = OFF_H;
constexpr size_t OFF_BN = OFF_CN + (size_t)MP * 256 * 2;
constexpr size_t OFF_BT = OFF_BN + (size_t)MP * 256 * 2;
DI void phase_convbc(const Params& P, unsigned char* L) {
    const bf16_t* U = WSP(bf16_t, OFF_U);
    bf16_t* XT = WSP(bf16_t, OFF_XT); bf16_t* CN = WSP(bf16_t, OFF_CN); bf16_t* CBG = WSP(bf16_t, OFF_BN); bf16_t* BT = WSP(bf16_t, OFF_BT);
    const int tid = otid();
    for (int task = blockIdx.x; task < 256; task += gridDim.x) {
        const int b = task >> 5, c = (task >> 1) & 15, g = task & 1, lane = tid & 63, wid = tid >> 6, hh = lane >> 5, l31 = lane & 31;
        bf16_t* Cs = (bf16_t*)L; bf16_t* Bs = Cs + 128 * 136;
        const int quad = tid & 63, isC = quad >> 5, n0 = (quad & 31) * 4, cch = 1024 + isC * 256 + g * 128 + n0, t0 = (tid >> 6) * 16, tg0 = c * 128 + t0;
        const size_t tile = ((size_t)((b * 16 + c) * 2 + g)) * 128 * 128;
        float cw[4][4], cbias[4];
#pragma unroll
        for (int kk = 0; kk < 4; ++kk) { const f32x4 w = *(const f32x4*)(P.in[19] + kk * 1536 + cch); cw[kk][0] = w[0]; cw[kk][1] = w[1]; cw[kk][2] = w[2]; cw[kk][3] = w[3]; }
        { const f32x4 w = *(const f32x4*)(P.in[20] + cch); cbias[0] = w[0]; cbias[1] = w[1]; cbias[2] = w[2]; cbias[3] = w[3]; }
        const unsigned voff = (unsigned)((b * 2048 + tg0) * N0 + 3072 + cch);
        u32x2 raw[19];
#pragma unroll
        for (int j = 0; j < 19; ++j) raw[j] = (tg0 + j - 3 >= 0) ? *(const u32x2*)((U + (j - 3) * N0) + voff) : (u32x2){0u, 0u};
        lds_barrier();
        unsigned bt[4][8];
#pragma unroll
        for (int j = 0; j < 16; j += 2) {
            float y[2][4];
#pragma unroll
            for (int q = 0; q < 2; ++q) {
                const float x0[4] = {bflo(raw[j + q].x), bfhi(raw[j + q].x), bflo(raw[j + q].y), bfhi(raw[j + q].y)};
                const float x1[4] = {bflo(raw[j + q + 1].x), bfhi(raw[j + q + 1].x), bflo(raw[j + q + 1].y), bfhi(raw[j + q + 1].y)};
                const float x2[4] = {bflo(raw[j + q + 2].x), bfhi(raw[j + q + 2].x), bflo(raw[j + q + 2].y), bfhi(raw[j + q + 2].y)};
                const float x3[4] = {bflo(raw[j + q + 3].x), bfhi(raw[j + q + 3].x), bflo(raw[j + q + 3].y), bfhi(raw[j + q + 3].y)};
#pragma unroll
                for (int e = 0; e < 4; ++e) y[q][e] = silu(cbias[e] + cw[0][e] * x0[e] + cw[1][e] * x1[e] + cw[2][e] * x2[e] + cw[3][e] * x3[e]);
                const u32x2 pk = pack4v(y[q][0], y[q][1], y[q][2], y[q][3]);
                *(u32x2*)((isC ? Cs : Bs) + (t0 + j + q) * 136 + n0) = pk;
                if (isC) *(u32x2*)(CN + tile + (size_t)(t0 + j + q) * 128 + n0) = pk;
            }
#pragma unroll
            for (int e = 0; e < 4; ++e) bt[e][j >> 1] = pack2(y[0][e], y[1][e]);
        }
        if (!isC) {
#pragma unroll
            for (int e = 0; e < 4; ++e) { bf16_t* dp = BT + tile + (size_t)(n0 + e) * 128 + t0;
                *(u32x4*)dp = (u32x4){bt[e][0], bt[e][1], bt[e][2], bt[e][3]}; *(u32x4*)(dp + 8) = (u32x4){bt[e][4], bt[e][5], bt[e][6], bt[e][7]}; }
        }
        lds_barrier();
        const int rb = (wid >> 1) * 32, cb0 = (wid & 1) * 64;
        f32x16 cbA[2];
#pragma unroll
        for (int i = 0; i < 16; ++i) { cbA[0][i] = 0.f; cbA[1][i] = 0.f; }
#pragma unroll
        for (int ks = 0; ks < 8; ++ks) {
            const bf16x8 a = ldfrag(Cs, 136, rb, ks * 16, lane);
            cbA[0] = MFMA32(a, ldfrag(Bs, 136, cb0, ks * 16, lane), cbA[0]);
            cbA[1] = MFMA32(a, ldfrag(Bs, 136, cb0 + 32, ks * 16, lane), cbA[1]);
        }
#pragma unroll
        for (int j = 0; j < 2; ++j)
#pragma unroll
            for (int reg = 0; reg < 16; ++reg) CBG[tile + (size_t)(rb + crow(reg, hh)) * 128 + cb0 + j * 32 + l31] = f2bf(cbA[j][reg]);
        lds_barrier();
    }
    for (int idx = blockIdx.x * 512 + tid; idx < 2048 * 256; idx += gridDim.x * 512) {
        const int quad = idx & 255, tgp = idx >> 8, b = tgp >> 8, t0 = (tgp & 255) * 8, cch = quad * 4;
        float cw[4][4], cbias[4];
#pragma unroll
        for (int kk = 0; kk < 4; ++kk) { const f32x4 w = *(const f32x4*)(P.in[19] + kk * 1536 + cch); cw[kk][0] = w[0]; cw[kk][1] = w[1]; cw[kk][2] = w[2]; cw[kk][3] = w[3]; }
        { const f32x4 w = *(const f32x4*)(P.in[20] + cch); cbias[0] = w[0]; cbias[1] = w[1]; cbias[2] = w[2]; cbias[3] = w[3]; }
        const unsigned voff = (unsigned)((b * 2048 + t0) * N0 + 3072 + cch);
        u32x2 raw[11];
#pragma unroll
        for (int j = 0; j < 11; ++j) raw[j] = (t0 + j - 3 >= 0) ? *(const u32x2*)((U + (j - 3) * N0) + voff) : (u32x2){0u, 0u};
        float y[8][4];
#pragma unroll
        for (int j = 0; j < 8; ++j) {
            const float x0[4] = {bflo(raw[j].x), bfhi(raw[j].x), bflo(raw[j].y), bfhi(raw[j].y)};
            const float x1[4] = {bflo(raw[j + 1].x), bfhi(raw[j + 1].x), bflo(raw[j + 1].y), bfhi(raw[j + 1].y)};
            const float x2[4] = {bflo(raw[j + 2].x), bfhi(raw[j + 2].x), bflo(raw[j + 2].y), bfhi(raw[j + 2].y)};
            const float x3[4] = {bflo(raw[j + 3].x), bfhi(raw[j + 3].x), bflo(raw[j + 3].y), bfhi(raw[j + 3].y)};
#pragma unroll
            for (int e = 0; e < 4; ++e) y[j][e] = silu(cbias[e] + cw[0][e] * x0[e] + cw[1][e] * x1[e] + cw[2][e] * x2[e] + cw[3][e] * x3[e]);
        }
        const int c = t0 >> 7, tl = t0 & 127;
#pragma unroll
        for (int e = 0; e < 4; ++e) *(u32x4*)(XT + ((size_t)((b * 16 + c) * 1024 + cch + e)) * 128 + tl) = (u32x4){pack2(y[0][e], y[1][e]), pack2(y[2][e], y[3][e]), pack2(y[4][e], y[5][e]), pack2(y[6][e], y[7][e])};
    }
}
DI void ssd_prompt_item(const Params& P, unsigned char* L, int item) {
    const int b = item >> 4, h = item & 15, g = h >> 3;
    const int tid0 = otid(), wid = tid0 >> 6;
    bf16_t* Cs = (bf16_t*)L;
    bf16_t* Ws = Cs + 128 * 136;
    bf16_t* BsT = Ws + 128 * 136;
    bf16_t* XsT = BsT + 128 * 136;
    bf16_t* St = XsT + 64 * 136;
    bf16_t* XwT = St + 64 * 136;
    float* dtvB = (float*)(XwT + 64 * 136); float* acsB = dtvB + 256; float* wvB = acsB + 256;
    const bf16_t* U = WSP(bf16_t, OFF_U); const float* DT = WSP(float, OFF_DT); bf16_t* MIX = WSP(bf16_t, OFF_MIX); float* SSB = WSP(float, OFF_SSB);
    const float a_neg = -__expf(P.in[22][h]), dtb = P.in[21][h], Dh = P.in[23][h];
    f32x16 accS;
#pragma unroll
    for (int i = 0; i < 16; ++i) accS[i] = 0.f;
    lds_barrier();
    for (int i = tid0; i < 64 * 136; i += 512) St[i] = 0;
    float dtr0 = 0.f, dtr1 = 0.f;
#define SSD_DTLOAD(cc) do { if (wid == 0) { const float* dp_ = DT + (size_t)(b * 2048 + (cc) * 128 + (tid0 & 63)) * 16 + h; dtr0 = dp_[0]; dtr1 = dp_[64 * 16]; } } while (0)
#define SSD_SCAN(buf) do { if (wid == 0) { const int ln_ = tid0 & 63; const float d0_ = softplus(dtr0 + dtb), d1_ = softplus(dtr1 + dtb); float v0_ = d0_ * a_neg, v1_ = d1_ * a_neg; \
        _Pragma("unroll") for (int o_ = 1; o_ < 64; o_ <<= 1) { const float n0_ = __shfl_up(v0_, o_), n1_ = __shfl_up(v1_, o_); if (ln_ >= o_) { v0_ += n0_; v1_ += n1_; } } \
        v1_ += __shfl(v0_, 63); const float al_ = __shfl(v1_, 63); \
        dtvB[(buf) * 128 + ln_] = d0_; dtvB[(buf) * 128 + 64 + ln_] = d1_; acsB[(buf) * 128 + ln_] = v0_; acsB[(buf) * 128 + 64 + ln_] = v1_; \
        wvB[(buf) * 128 + ln_] = __expf(al_ - v0_) * d0_; wvB[(buf) * 128 + 64 + ln_] = __expf(al_ - v1_) * d1_; } } while (0)
    SSD_DTLOAD(0); SSD_SCAN(0); SSD_DTLOAD(1);
    u32x4 tC[4], tB[4], tT[4], tX[2];
    for (int c = 0; c < 16; ++c) {
        const int row0 = b * 2048 + c * 128;
        lds_barrier();
        int zv = 0; asm volatile("" : "+v"(zv));
        const int tid = tid0 + zv, lane = tid & 63, hh = lane >> 5, l31 = lane & 31;
        const int prow = tid >> 4, pcol = (tid & 15) * 8;
        const float* dtv = dtvB + (c & 1) * 128; const float* acs = acsB + (c & 1) * 128; const float* wv = wvB + (c & 1) * 128;
        if (c + 1 < 16) { SSD_SCAN((c + 1) & 1); if (c + 2 < 16) SSD_DTLOAD(c + 2); }
        if (c == 0) {
            const size_t tb_ = ((size_t)((b * 16 + c) * 2 + g)) * 128 * 128 + (size_t)prow * 128 + pcol;
            const u32x4* pc = (const u32x4*)(WSP(bf16_t, OFF_CN) + tb_); const u32x4* pb = (const u32x4*)(WSP(bf16_t, OFF_BN) + tb_); const u32x4* pt = (const u32x4*)(WSP(bf16_t, OFF_BT) + tb_);
            const u32x4* px = (const u32x4*)(WSP(bf16_t, OFF_XT) + ((size_t)((b * 16 + c) * 1024 + h * 64 + prow)) * 128 + pcol);
#pragma unroll
            for (int i = 0; i < 4; ++i) { tC[i] = pc[i * 512]; tB[i] = pb[i * 512]; tT[i] = pt[i * 512]; }
            tX[0] = px[0]; tX[1] = px[512];
        }
        const float a_last = acs[127];
        float asv[8], dsv[8];
        { const f32x4 a0 = *(const f32x4*)(acs + pcol), a1 = *(const f32x4*)(acs + pcol + 4), d0 = *(const f32x4*)(dtv + pcol), d1 = *(const f32x4*)(dtv + pcol + 4);
#pragma unroll
          for (int q = 0; q < 4; ++q) { asv[q] = a0[q]; asv[q + 4] = a1[q]; dsv[q] = d0[q]; dsv[q + 4] = d1[q]; } }
#pragma unroll
        for (int i = 0; i < 4; ++i) {
            *(u32x4*)(Cs + (prow + 32 * i) * 136 + pcol) = tC[i]; *(u32x4*)(BsT + (prow + 32 * i) * 136 + pcol) = tT[i];
            {
                const int t = prow + 32 * i; const float at = acs[t];
                const unsigned cw_[4] = {tB[i].x, tB[i].y, tB[i].z, tB[i].w};
                float wv_[8];
#pragma unroll
                for (int q = 0; q < 8; ++q) { const int sidx = pcol + q; const float cbv = (q & 1) ? bfhi(cw_[q >> 1]) : bflo(cw_[q >> 1]);
                    wv_[q] = (sidx <= t) ? cbv * __expf(at - asv[q]) * dsv[q] : 0.f; }
                *(u32x4*)(Ws + t * 136 + pcol) = (u32x4){pack2(wv_[0], wv_[1]), pack2(wv_[2], wv_[3]), pack2(wv_[4], wv_[5]), pack2(wv_[6], wv_[7])};
            }
        }
        *(u32x4*)(XsT + prow * 136 + pcol) = tX[0]; *(u32x4*)(XsT + (prow + 32) * 136 + pcol) = tX[1];
        {
            const f32x4 w0 = *(const f32x4*)(wv + pcol), w1 = *(const f32x4*)(wv + pcol + 4);
            u32x4 oa, ob; const u32x4 xa = tX[0], xb_ = tX[1];
            oa.x = pack2(bflo(xa.x) * w0[0], bfhi(xa.x) * w0[1]); oa.y = pack2(bflo(xa.y) * w0[2], bfhi(xa.y) * w0[3]); oa.z = pack2(bflo(xa.z) * w1[0], bfhi(xa.z) * w1[1]); oa.w = pack2(bflo(xa.w) * w1[2], bfhi(xa.w) * w1[3]);
            ob.x = pack2(bflo(xb_.x) * w0[0], bfhi(xb_.x) * w0[1]); ob.y = pack2(bflo(xb_.y) * w0[2], bfhi(xb_.y) * w0[3]); ob.z = pack2(bflo(xb_.z) * w1[0], bfhi(xb_.z) * w1[1]); ob.w = pack2(bflo(xb_.w) * w1[2], bfhi(xb_.w) * w1[3]);
            *(u32x4*)(XwT + prow * 136 + pcol) = oa; *(u32x4*)(XwT + (prow + 32) * 136 + pcol) = ob;
        }
        if (c + 1 < 16) {
            const size_t tb_ = ((size_t)((b * 16 + c + 1) * 2 + g)) * 128 * 128 + (size_t)prow * 128 + pcol;
            const u32x4* pc = (const u32x4*)(WSP(bf16_t, OFF_CN) + tb_); const u32x4* pb = (const u32x4*)(WSP(bf16_t, OFF_BN) + tb_); const u32x4* pt = (const u32x4*)(WSP(bf16_t, OFF_BT) + tb_);
            const u32x4* px = (const u32x4*)(WSP(bf16_t, OFF_XT) + ((size_t)((b * 16 + c + 1) * 1024 + h * 64 + prow)) * 128 + pcol);
#pragma unroll
            for (int i = 0; i < 4; ++i) { tC[i] = pc[i * 512]; tB[i] = pb[i * 512]; tT[i] = pt[i * 512]; }
            tX[0] = px[0]; tX[1] = px[512];
        }
        bf16_t zr[16];
        {
            const unsigned zoff = (unsigned)((row0 + (wid >> 1) * 32 + 4 * hh) * N0 + 2048 + h * 64 + (wid & 1) * 32 + l31);
#pragma unroll
            for (int reg = 0; reg < 16; ++reg) zr[reg] = (U + ((reg & 3) + 8 * (reg >> 2)) * N0)[zoff];
        }
        lds_barrier();
        {
            const int tb = (wid >> 1) * 32, pb = (wid & 1) * 32;
            f32x16 y;
#pragma unroll
            for (int i = 0; i < 16; ++i) y[i] = 0.f;
#pragma unroll
            for (int ks = 0; ks < 8; ++ks) y = MFMA32(ldfrag(Cs, 136, tb, ks * 16, lane), ldfrag(St, 136, pb, ks * 16, lane), y);
            f32x16 y2;
#pragma unroll
            for (int i = 0; i < 16; ++i) y2[i] = 0.f;
#pragma unroll
            for (int ks = 0; ks < 8; ++ks) y2 = MFMA32(ldfrag(Ws, 136, tb, ks * 16, lane), ldfrag(XsT, 136, pb, ks * 16, lane), y2);
#pragma unroll
            for (int reg = 0; reg < 16; ++reg) y[reg] = y[reg] * __expf(acs[tb + crow(reg, hh)]) + y2[reg];
            const int p = pb + l31, ch = h * 64 + p; const float nwv = P.in[24][ch];
#pragma unroll
            for (int reg = 0; reg < 16; ++reg) {
                const int t = tb + crow(reg, hh); const size_t row = (size_t)(row0 + t);
                const float xv = bf2f(XsT[p * 136 + t]); const float z = bf2f(zr[reg]);
                const float yy = (y[reg] + Dh * xv) * silu(z);
                float ss = yy * yy;
                ss += __shfl_xor(ss, 1); ss += __shfl_xor(ss, 2); ss += __shfl_xor(ss, 4); ss += __shfl_xor(ss, 8); ss += __shfl_xor(ss, 16);
                if (l31 == 0) atomicAdd(SSB + row * 2 + g, ss);
                MIX[row * 2048 + 1024 + ch] = f2bf(yy * nwv);
            }
            lds_barrier();
            const int pb2 = (wid >> 2) * 32, nb = (wid & 3) * 32;
            const float ea = __expf(a_last);
#pragma unroll
            for (int reg = 0; reg < 16; ++reg) accS[reg] *= ea;
#pragma unroll
            for (int ks = 0; ks < 8; ++ks) accS = MFMA32(ldfrag(XwT, 136, pb2, ks * 16, lane), ldfrag(BsT, 136, nb, ks * 16, lane), accS);
#pragma unroll
            for (int reg = 0; reg < 16; ++reg) St[(pb2 + crow(reg, hh)) * 136 + nb + l31] = f2bf(accS[reg]);
        }
    }
    {
        const int lane = tid0 & 63, hh = lane >> 5, l31 = lane & 31;
        const int pb2 = (wid >> 2) * 32, nb = (wid & 3) * 32;
        float* o = P.out + O_BSP + (size_t)(b * 16 + h) * 64 * 128;
#pragma unroll
        for (int reg = 0; reg < 16; ++reg) o[(pb2 + crow(reg, hh)) * 128 + nb + l31] = accS[reg];
    }
}
#undef SSD_DTLOAD
#undef SSD_SCAN
DI void ssd_sample_item(const Params& P, unsigned char* L, int item) {
    const int b = item >> 4, h = item & 15, g = h >> 3, tid = otid(), lane = tid & 63;
    float* xs = (float*)L; float* Bv = xs + 64; float* Cv = Bv + 128; float* yv = Cv + 128;
    const bf16_t* U = WSP(bf16_t, OFF_U); bf16_t* MIX = WSP(bf16_t, OFF_MIX); float* SSB = WSP(float, OFF_SSB);
    const size_t row = (size_t)(MP + b);
    __syncthreads();
    if (tid < 320) {
        int cc; if (tid < 64) cc = h * 64 + tid; else if (tid < 192) cc = 1024 + g * 128 + (tid - 64); else cc = 1280 + g * 128 + (tid - 192);
        const float* buf = P.in[7] + (size_t)b * 3 * 1536 + cc;
        const float v = P.in[20][cc] + P.in[19][cc] * buf[0] + P.in[19][1536 + cc] * buf[1536] + P.in[19][2 * 1536 + cc] * buf[2 * 1536] + P.in[19][3 * 1536 + cc] * bf2f(U[row * N0 + 3072 + cc]);
        xs[tid] = silu(v);
    }
    const float dt = softplus(WSP(float, OFF_DT)[row * 16 + h] + P.in[21][h]);
    const float dA = __expf(-dt * __expf(P.in[22][h]));
    __syncthreads();
    const float* s0 = P.in[6] + (size_t)(b * 16 + h) * 64 * 128; float* s1 = P.out + O_BSS + (size_t)(b * 16 + h) * 64 * 128;
    const int n4 = (tid & 31) * 4;
    const f32x4 Bq = *(const f32x4*)(Bv + n4), Cq = *(const f32x4*)(Cv + n4);
#pragma unroll
    for (int j = 0; j < 4; ++j) {
        const int p = (tid >> 5) + 16 * j;
        const f32x4 s = *(const f32x4*)(s0 + p * 128 + n4);
        const float dx = dt * xs[p];
        const f32x4 sn = s * dA + Bq * dx;
        *(f32x4*)(s1 + p * 128 + n4) = sn;
        float yp = sn[0] * Cq[0] + sn[1] * Cq[1] + sn[2] * Cq[2] + sn[3] * Cq[3];
        yp += __shfl_xor(yp, 1); yp += __shfl_xor(yp, 2); yp += __shfl_xor(yp, 4); yp += __shfl_xor(yp, 8); yp += __shfl_xor(yp, 16);
        if ((tid & 31) == 0) yv[p] = yp;
    }
    __syncthreads();
    if (tid < 64) {
        const int ch = h * 64 + tid;
        const float yy = (yv[tid] + P.in[23][h] * xs[tid]) * silu(bf2f(U[row * N0 + 2048 + ch]));
        const float ss = wave_sum(yy * yy);
        if (lane == 0) atomicAdd(SSB + row * 2 + g, ss);
        MIX[row * 2048 + 1024 + ch] = f2bf(yy * P.in[24][ch]);
    }
}
DI void ssd_sample_item4(const Params& P, unsigned char* L, int item) {
    const int b = item >> 2, tid = otid(), gi = tid >> 7, lt = tid & 127, h = (item & 3) * 4 + gi, g = h >> 3;
    float* xs = (float*)L + gi * 512; float* Bv = xs + 64; float* Cv = Bv + 128; float* yv = Cv + 128;
    const bf16_t* U = WSP(bf16_t, OFF_U); bf16_t* MIX = WSP(bf16_t, OFF_MIX); float* SSB = WSP(float, OFF_SSB);
    const size_t row = (size_t)(MP + b);
    __syncthreads();
#pragma unroll
    for (int ps = 0; ps < 3; ++ps) {
        const int idx = lt + 128 * ps;
        if (idx < 320) {
            int cc; if (idx < 64) cc = h * 64 + idx; else if (idx < 192) cc = 1024 + g * 128 + (idx - 64); else cc = 1280 + g * 128 + (idx - 192);
            const float* buf = P.in[7] + (size_t)b * 3 * 1536 + cc;
            const float v = P.in[20][cc] + P.in[19][cc] * buf[0] + P.in[19][1536 + cc] * buf[1536] + P.in[19][2 * 1536 + cc] * buf[2 * 1536] + P.in[19][3 * 1536 + cc] * bf2f(U[row * N0 + 3072 + cc]);
            xs[idx] = silu(v);
        }
    }
    const float dt = softplus(WSP(float, OFF_DT)[row * 16 + h] + P.in[21][h]);
    const float dA = __expf(-dt * __expf(P.in[22][h]));
    __syncthreads();
    const float* s0 = P.in[6] + (size_t)(b * 16 + h) * 64 * 128; float* s1 = P.out + O_BSS + (size_t)(b * 16 + h) * 64 * 128;
    const int n4 = (lt & 31) * 4;
    const f32x4 Bq = *(const f32x4*)(Bv + n4), Cq = *(const f32x4*)(Cv + n4);
    f32x4 sv[16];
#pragma unroll
    for (int j = 0; j < 16; ++j) sv[j] = *(const f32x4*)(s0 + ((lt >> 5) + 4 * j) * 128 + n4);
#pragma unroll
    for (int j = 0; j < 16; ++j) {
        const int p = (lt >> 5) + 4 * j;
        const f32x4 sn = sv[j] * dA + Bq * (dt * xs[p]);
        *(f32x4*)(s1 + p * 128 + n4) = sn;
        float yp = sn[0] * Cq[0] + sn[1] * Cq[1] + sn[2] * Cq[2] + sn[3] * Cq[3];
        yp += __shfl_xor(yp, 1); yp += __shfl_xor(yp, 2); yp += __shfl_xor(yp, 4); yp += __shfl_xor(yp, 8); yp += __shfl_xor(yp, 16);
        if ((lt & 31) == 0) yv[p] = yp;
    }
    __syncthreads();
    if (lt < 64) {
        const int ch = h * 64 + lt;
        const float yy = (yv[lt] + P.in[23][h] * xs[lt]) * silu(bf2f(U[row * N0 + 2048 + ch]));
        const float ss = wave_sum(yy * yy);
        if (lt == 0) atomicAdd(SSB + row * 2 + g, ss);
        MIX[row * 2048 + 1024 + ch] = f2bf(yy * P.in[24][ch]);
    }
}
template <bool SAMPLE>
DI void rglru_item(const Params& P, unsigned char* L, int item) {
    const int tid0 = otid(), wid = tid0 >> 6;
    const int b = SAMPLE ? 0 : (item >> 4), k = (item >> 1) & 7, dh = item & 1;
    bf16_t* Xs = (bf16_t*)L;
    bf16_t* Wg = Xs + 128 * 136;
    float* Aa = (float*)(Wg + 128 * 136);
    float* Uu = Aa + 128 * 64; float* segA = Uu + 128 * 64; float* segH = segA + 512; float* hc = segH + 512;
    const bf16_t* U = WSP(bf16_t, OFF_U); bf16_t* MIX = WSP(bf16_t, OFF_MIX);
    lds_barrier();
    {
        const bf16_t* WRT = WSP(bf16_t, OFF_WRT); const bf16_t* WIT = WSP(bf16_t, OFF_WIT);
#pragma unroll
        for (int i = 0; i < 4; ++i) {
            const int chk = tid0 + i * 512, r = chk >> 4, c8 = (chk & 15) * 8;
            const bf16_t* src = (r < 64 ? WRT + (size_t)(dh * 64 + r) * 1024 : WIT + (size_t)(dh * 64 + r - 64) * 1024) + k * 128 + c8;
            *(u32x4*)(Wg + r * 136 + c8) = *(const u32x4*)src;
        }
        if (tid0 < 64) hc[tid0] = 0.f;
    }
    float sp[4], br[4], bi[4];
#pragma unroll
    for (int ct = 0; ct < 4; ++ct) { const int chd = k * 128 + dh * 64 + ct * 16 + (tid0 & 15); sp[ct] = softplus(-P.in[18][chd]); br[ct] = P.in[15][chd]; bi[ct] = P.in[17][chd]; }
    const int ch0 = k * 128 + (tid0 & 31) * 4;
    float cw[4][4], cbias[4];
#pragma unroll
    for (int kk = 0; kk < 4; ++kk)
#pragma unroll
        for (int e = 0; e < 4; ++e) cw[kk][e] = P.in[12][kk * 1024 + ch0 + e];
#pragma unroll
    for (int e = 0; e < 4; ++e) cbias[e] = P.in[13][ch0 + e];
    u32x2 raw[11];
#define RG_LOAD(tl_) do { const int tg_ = (tl_) * 128 + (tid0 >> 5) * 8; const unsigned vo_ = (unsigned)((b * 2048 + tg_) * N0 + ch0); \
        _Pragma("unroll") for (int j = 0; j < 11; ++j) raw[j] = (tg_ + j - 3 >= 0) ? *(const u32x2*)((U + (j - 3) * N0) + vo_) : (u32x2){0u, 0u}; } while (0)
    if (!SAMPLE) RG_LOAD(0);
    const int ntiles = SAMPLE ? 1 : 16;
    for (int tile = 0; tile < ntiles; ++tile) {
        const int row0 = SAMPLE ? MP : b * 2048 + tile * 128;
        lds_barrier();
        int zv = 0; asm volatile("" : "+v"(zv));
        const int tid = tid0 + zv, lane = tid & 63, quad = tid & 31, seg = tid >> 5;
        const int sd = tid & 63, sseg = wid, sch = k * 128 + dh * 64 + sd;
        bf16_t gt[16];
        if (!SAMPLE) {
            const unsigned goff = (unsigned)((row0 + sseg * 16) * N0 + 1024 + sch);
#pragma unroll
            for (int t = 0; t < 16; ++t) gt[t] = (U + t * N0)[goff];
        }
        if (SAMPLE) {
#pragma unroll
            for (int t = 0; t < 8; ++t) {
                const int bb = seg * 8 + t;
                const float* buf = P.in[5] + (size_t)bb * 3 * 1024 + ch0;
                const f32x4 p0 = *(const f32x4*)buf, p1 = *(const f32x4*)(buf + 1024), p2 = *(const f32x4*)(buf + 2048);
                float cur[4]; ld4bf(U + (size_t)(MP + bb) * N0 + ch0, cur);
                float y[4];
#pragma unroll
                for (int e = 0; e < 4; ++e) y[e] = cbias[e] + cw[0][e] * p0[e] + cw[1][e] * p1[e] + cw[2][e] * p2[e] + cw[3][e] * cur[e];
                *(u32x2*)(Xs + bb * 136 + quad * 4) = pack4v(y[0], y[1], y[2], y[3]);
            }
        } else {
#pragma unroll
            for (int j = 0; j < 8; ++j) {
                const float x0[4] = {bflo(raw[j].x), bfhi(raw[j].x), bflo(raw[j].y), bfhi(raw[j].y)};
                const float x1[4] = {bflo(raw[j + 1].x), bfhi(raw[j + 1].x), bflo(raw[j + 1].y), bfhi(raw[j + 1].y)};
                const float x2[4] = {bflo(raw[j + 2].x), bfhi(raw[j + 2].x), bflo(raw[j + 2].y), bfhi(raw[j + 2].y)};
                const float x3[4] = {bflo(raw[j + 3].x), bfhi(raw[j + 3].x), bflo(raw[j + 3].y), bfhi(raw[j + 3].y)};
                float y[4];
#pragma unroll
                for (int e = 0; e < 4; ++e) y[e] = cbias[e] + cw[0][e] * x0[e] + cw[1][e] * x1[e] + cw[2][e] * x2[e] + cw[3][e] * x3[e];
                *(u32x2*)(Xs + (seg * 8 + j) * 136 + quad * 4) = pack4v(y[0], y[1], y[2], y[3]);
            }
            if (tile + 1 < 16) RG_LOAD(tile + 1);
        }
        lds_barrier();
        {
            f32x4 acc[8];
#pragma unroll
            for (int i = 0; i < 8; ++i) acc[i] = (f32x4){0.f, 0.f, 0.f, 0.f};
#pragma unroll
            for (int ks = 0; ks < 4; ++ks) {
                const bf16x8 a = ldfrag16(Xs, 136, wid * 16, ks * 32, lane);
#pragma unroll
                for (int tl = 0; tl < 8; ++tl) acc[tl] = MFMA16(a, ldfrag16(Wg, 136, tl * 16, ks * 32, lane), acc[tl]);
            }
#pragma unroll
            for (int ct = 0; ct < 4; ++ct)
#pragma unroll
                for (int reg = 0; reg < 4; ++reg) {
                    const int t = wid * 16 + (lane >> 4) * 4 + reg, d = ct * 16 + (lane & 15);
                    const float r = sigm(acc[ct][reg] + br[ct]), gi = sigm(acc[4 + ct][reg] + bi[ct]);
                    const float a = __expf(-8.f * r * sp[ct]);
                    const float uu = __builtin_amdgcn_sqrtf(fmaxf(1.f - a * a, 0.f)) * gi * bf2f(Xs[t * 136 + dh * 64 + d]);
                    if (SAMPLE) {
                        const int chd = k * 128 + dh * 64 + d;
                        const float hn = a * P.in[4][(size_t)t * 1024 + chd] + uu;
                        P.out[O_AHS + (size_t)t * 1024 + chd] = hn;
                        const float gv = bf2f(U[(size_t)(MP + t) * N0 + 1024 + chd]);
                        MIX[(size_t)(MP + t) * 2048 + chd] = f2bf(hn * silu(gv));
                    } else { Aa[t * 64 + d] = a; Uu[t * 64 + d] = uu; }
                }
        }
        if (!SAMPLE) {
            lds_barrier();
            float av[16], uv[16], Ap = 1.f, Hp = 0.f;
#pragma unroll
            for (int t = 0; t < 16; ++t) { av[t] = Aa[(sseg * 16 + t) * 64 + sd]; uv[t] = Uu[(sseg * 16 + t) * 64 + sd]; Hp = av[t] * Hp + uv[t]; Ap *= av[t]; }
            segA[sseg * 64 + sd] = Ap; segH[sseg * 64 + sd] = Hp;
            lds_barrier();
            float hin = hc[sd];
            for (int s2 = 0; s2 < sseg; ++s2) hin = segA[s2 * 64 + sd] * hin + segH[s2 * 64 + sd];
            const unsigned moff = (unsigned)((row0 + sseg * 16) * 2048 + sch);
#pragma unroll
            for (int t = 0; t < 16; ++t) {
                hin = av[t] * hin + uv[t];
                (MIX + t * 2048)[moff] = f2bf(hin * silu(bf2f(gt[t])));
            }
            lds_barrier();
            if (sseg == 7) hc[sd] = hin;
        }
    }
#undef RG_LOAD
    if (!SAMPLE) { lds_barrier(); if (tid0 < 64) P.out[O_AHP + (size_t)b * 1024 + k * 128 + dh * 64 + tid0] = hc[tid0]; }
}
DI void phase_mix0(const Params& P, unsigned char* L) {
    const int tid = otid(), bid = blockIdx.x, G = gridDim.x;
    { const bf16_t* U = WSP(bf16_t, OFF_U);
      for (int i = bid * 512 + tid; i < 8 * 3 * 1024; i += G * 512) { const int c = i & 1023, j = (i >> 10) % 3, b = i / 3072; P.out[O_ACP + i] = bf2f(U[(size_t)(b * 2048 + 2045 + j) * N0 + c]); }
      for (int i = bid * 512 + tid; i < 8 * 3 * 1536; i += G * 512) { const int c = i % 1536, j = (i / 1536) % 3, b = i / 4608; P.out[O_BCP + i] = bf2f(U[(size_t)(b * 2048 + 2045 + j) * N0 + 3072 + c]); }
      for (int i = bid * 512 + tid; i < 128 * 3 * 1024; i += G * 512) { const int c = i & 1023, j = (i >> 10) % 3, b = i / 3072; P.out[O_ACS + i] = j < 2 ? P.in[5][(size_t)(b * 3 + j + 1) * 1024 + c] : bf2f(U[(size_t)(MP + b) * N0 + c]); }
      for (int i = bid * 512 + tid; i < 128 * 3 * 1536; i += G * 512) { const int c = i % 1536, j = (i / 1536) % 3, b = i / 4608; P.out[O_BCS + i] = j < 2 ? P.in[7][(size_t)(b * 3 + j + 1) * 1536 + c] : bf2f(U[(size_t)(MP + b) * N0 + 3072 + c]); } }
    if (bid < 128) { const int x = bid & 7, j = bid >> 3; rglru_item<false>(P, L, (x + 8 * (j >> 1)) * 2 + (j & 1)); }
    else if (bid < 256) { const int x = bid & 7, j = (bid - 128) >> 3, grp = x + 8 * (j >> 3); ssd_prompt_item(P, L, (grp >> 1) * 16 + (grp & 1) * 8 + (j & 7)); }
    unsigned* ctr = WSP(unsigned, OFF_CTL);
    unsigned* bc = (unsigned*)(L + LDS_BYTES - 16);
    for (;;) {
        __syncthreads();
        if (tid == 0) bc[0] = atomicAdd(ctr, 1u);
        __syncthreads();
        const unsigned it = bc[0];
        if (it >= 16u + 512u) break;
        if (it < 16u) rglru_item<true>(P, L, (int)it); else ssd_sample_item4(P, L, (int)(it - 16u));
    }
    for (;;) {
        __syncthreads();
        if (tid == 0) bc[0] = atomicAdd(ctr + 32, 1u);
        __syncthreads();
        const unsigned q = bc[0];
        if (q >= 256u + 104u + 130u) break;
        if (q < 256u) l1_weight_tile(P, (int)q * 8 + (tid >> 6), (float*)L + (tid >> 6) * (64 * 65), tid & 63);
        else if (q < 360u) l1_weight_tile(P, 2880 + ((int)q - 256) * 8 + (tid >> 6), (float*)L + (tid >> 6) * (64 * 65), tid & 63);
        else convert_p_chunk(P, 0, (int)q - 360, tid);
    }
}
DI void phase_norm0(const Params& P) {
    bf16_t* MIX = WSP(bf16_t, OFF_MIX); const float* SSB = WSP(float, OFF_SSB);
    for (int i = blockIdx.x * 512 + threadIdx.x; i < MV * 128; i += gridDim.x * 512) {
        const int row = i >> 7, c8 = (i & 127) * 8, g = c8 >> 9;
        const float sc = rsqrtf(SSB[(size_t)row * 2 + g] * (1.f / 512.f) + EPSF);
        uint4* p = (uint4*)(MIX + (size_t)row * 2048 + 1024 + c8); uint4 w = *p;
        w.x = pack2(bflo(w.x) * sc, bfhi(w.x) * sc); w.y = pack2(bflo(w.y) * sc, bfhi(w.y) * sc); w.z = pack2(bflo(w.z) * sc, bfhi(w.z) * sc); w.w = pack2(bflo(w.w) * sc, bfhi(w.w) * sc);
        *p = w;
    }
}

DI void hgrn_prompt_item(const Params& P, unsigned char* L, int item) {
    const int b = item >> 4, h = item & 15;
    const int tid = otid(), lane = tid & 63, wid = tid >> 6, hh = lane >> 5, l31 = lane & 31;
    bf16_t* Qs = (bf16_t*)L;
    bf16_t* Ks = Qs + 64 * 136;
    bf16_t* KsT = Ks + 64 * 136;
    bf16_t* VsT = KsT + 128 * 72;
    bf16_t* SsT = VsT + 128 * 72;
    bf16_t* As = SsT + 128 * 136;
    float* Gseg = (float*)(As + 64 * 72);
    float* E1 = Gseg + 16 * 128; float* E2 = E1 + 128;
    float* Of = E2 + 128;
    const bf16_t* U = WSP(bf16_t, OFF_U); bf16_t* MIX = WSP(bf16_t, OFF_MIX);
    const int kq = tid & 31, ts = tid >> 5;
    float lb[4];
#pragma unroll
    for (int e = 0; e < 4; ++e) { const int ch = h * 128 + kq * 4 + e; lb[e] = sigm(P.in[27][2048 + ch] - P.in[27][ch]); }
    const int kb = (wid >> 1) * 32, vb0 = (wid & 1) * 64;
    f32x16 accS[2];
#pragma unroll
    for (int i = 0; i < 16; ++i) { accS[0][i] = 0.f; accS[1][i] = 0.f; }
    uint2 rq[4], rf[4], rv[4];
#define HG_LOAD(cc) do { _Pragma("unroll") for (int i = 0; i < 4; ++i) { const bf16_t* bp = U + (size_t)(b * 2048 + (cc) * 64 + ts * 4 + i) * INC + h * 128 + kq * 4; \
        rq[i] = *(const uint2*)bp; rf[i] = *(const uint2*)(bp + 2048); rv[i] = *(const uint2*)(bp + 4096); } } while (0)
    HG_LOAD(0);
    lds_barrier();
    for (int c = 0; c < 32; ++c) {
        u32x4 gpre0, gpre1;
        { const bf16_t* gp = U + (size_t)(b * 2048 + c * 64 + (tid >> 3)) * INC + 6144 + h * 128 + (tid & 7) * 16; gpre0 = *(const u32x4*)gp; gpre1 = *(const u32x4*)(gp + 8); }
        float kk[4][4], cs[4][4];
#pragma unroll
        for (int i = 0; i < 4; ++i) {
            const float fx[4] = {bflo(rf[i].x), bfhi(rf[i].x), bflo(rf[i].y), bfhi(rf[i].y)};
#pragma unroll
            for (int e = 0; e < 4; ++e) {
                const float sg = sigm(fx[e]); const float kv = (1.f - lb[e]) * (1.f - sg);
                kk[i][e] = kv; const float gl = __logf(1.f - kv);
                cs[i][e] = (i == 0 ? 0.f : cs[i - 1][e]) + gl;
            }
        }
        *(f32x4*)(Gseg + ts * 128 + kq * 4) = (f32x4){cs[3][0], cs[3][1], cs[3][2], cs[3][3]};
        lds_barrier();
        f32x4 off = {0.f, 0.f, 0.f, 0.f}, gmid = off, glast = off;
        {
            const int swid = __builtin_amdgcn_readfirstlane(tid >> 6);
            f32x4 pre = {0.f, 0.f, 0.f, 0.f};
#pragma unroll
            for (int s = 0; s < 16; ++s) {
                const f32x4 v = *(const f32x4*)(Gseg + s * 128 + kq * 4);
                if (s == 2 * swid) off = pre;
                if (s == 8) gmid = pre;
                pre += v;
            }
            glast = pre;
            if (ts & 1) off += *(const f32x4*)(Gseg + (ts - 1) * 128 + kq * 4);
        }
        {
            float qt[4][4], kt[4][4], vt[4][4];
#pragma unroll
            for (int i = 0; i < 4; ++i) {
                const float q[4] = {bflo(rq[i].x), bfhi(rq[i].x), bflo(rq[i].y), bfhi(rq[i].y)};
                vt[i][0] = bflo(rv[i].x); vt[i][1] = bfhi(rv[i].x); vt[i][2] = bflo(rv[i].y); vt[i][3] = bfhi(rv[i].y);
#pragma unroll
                for (int e = 0; e < 4; ++e) { const float Gv = off[e] + cs[i][e]; const float ex = __expf(Gv - gmid[e]); qt[i][e] = q[e] * 0.08838834764831845f * ex; kt[i][e] = kk[i][e] * frcp(ex); }
                *(uint2*)(Qs + (ts * 4 + i) * 136 + kq * 4) = pack4(qt[i][0], qt[i][1], qt[i][2], qt[i][3]);
                *(uint2*)(Ks + (ts * 4 + i) * 136 + kq * 4) = pack4(kt[i][0], kt[i][1], kt[i][2], kt[i][3]);
            }
#pragma unroll
            for (int e = 0; e < 4; ++e) {
                *(uint2*)(KsT + (kq * 4 + e) * 72 + ts * 4) = pack4(kt[0][e], kt[1][e], kt[2][e], kt[3][e]);
                *(uint2*)(VsT + (kq * 4 + e) * 72 + ts * 4) = pack4(vt[0][e], vt[1][e], vt[2][e], vt[3][e]);
            }
            if (ts == 0) {
#pragma unroll
                for (int e = 0; e < 4; ++e) { E1[kq * 4 + e] = __expf(gmid[e]); E2[kq * 4 + e] = __expf(glast[e] - gmid[e]); }
            }
        }
        if (c + 1 < 32) HG_LOAD(c + 1);
        lds_barrier();
#pragma unroll
        for (int j = 0; j < 2; ++j) {
#pragma unroll
            for (int reg = 0; reg < 16; ++reg) accS[j][reg] *= E1[kb + crow(reg, hh)];
            const int v = vb0 + j * 32 + l31;
#pragma unroll
            for (int rg = 0; rg < 4; ++rg) *(uint2*)(SsT + v * 136 + kb + 8 * rg + 4 * hh) = pack4(accS[j][4 * rg], accS[j][4 * rg + 1], accS[j][4 * rg + 2], accS[j][4 * rg + 3]);
        }
        if (wid < 4) {
            const int tb = (wid >> 1) * 32, sb = (wid & 1) * 32;
            f32x16 aa;
#pragma unroll
            for (int i = 0; i < 16; ++i) aa[i] = 0.f;
#pragma unroll
            for (int ks = 0; ks < 8; ++ks) aa = MFMA32(ldfrag(Qs, 136, tb, ks * 16, lane), ldfrag(Ks, 136, sb, ks * 16, lane), aa);
            const int s = sb + l31;
#pragma unroll
            for (int reg = 0; reg < 16; ++reg) { const int t = tb + crow(reg, hh); As[t * 72 + s] = f2bf(s <= t ? aa[reg] : 0.f); }
        }
        lds_barrier();
        const int tb2 = (wid >> 2) * 32, vb2 = (wid & 3) * 32;
        f32x16 o, o2;
#pragma unroll
        for (int i = 0; i < 16; ++i) { o[i] = 0.f; o2[i] = 0.f; }
#pragma unroll
        for (int ks = 0; ks < 8; ++ks) o = MFMA32(ldfrag(Qs, 136, tb2, ks * 16, lane), ldfrag(SsT, 136, vb2, ks * 16, lane), o);
#pragma unroll
        for (int ks = 0; ks < 4; ++ks) o2 = MFMA32(ldfrag(As, 72, tb2, ks * 16, lane), ldfrag(VsT, 72, vb2, ks * 16, lane), o2);
#pragma unroll
        for (int i = 0; i < 16; ++i) o[i] += o2[i];
#pragma unroll
        for (int j = 0; j < 2; ++j) {
#pragma unroll
            for (int ks = 0; ks < 4; ++ks) accS[j] = MFMA32(ldfrag(KsT, 72, kb, ks * 16, lane), ldfrag(VsT, 72, vb0 + j * 32, ks * 16, lane), accS[j]);
#pragma unroll
            for (int reg = 0; reg < 16; ++reg) accS[j][reg] *= E2[kb + crow(reg, hh)];
        }
#pragma unroll
        for (int reg = 0; reg < 16; ++reg) Of[(tb2 + crow(reg, hh)) * 132 + vb2 + l31] = o[reg];
        lds_barrier();
        {
            const int t = tid >> 3, vs = tid & 7;
            const size_t row = (size_t)(b * 2048 + c * 64 + t);
            f32x4 ov[4]; float ss = 0.f;
#pragma unroll
            for (int i = 0; i < 4; ++i) { ov[i] = *(const f32x4*)(Of + t * 132 + vs * 16 + i * 4); ss += ov[i][0] * ov[i][0] + ov[i][1] * ov[i][1] + ov[i][2] * ov[i][2] + ov[i][3] * ov[i][3]; }
            ss += __shfl_xor(ss, 1); ss += __shfl_xor(ss, 2); ss += __shfl_xor(ss, 4);
            const float rstd = rsqrtf(ss * (1.f / 128.f) + EPSF);
            const float* nwp = P.in[28] + h * 128 + vs * 16;
            const unsigned gw[8] = {gpre0.x, gpre0.y, gpre0.z, gpre0.w, gpre1.x, gpre1.y, gpre1.z, gpre1.w};
            unsigned ow[8];
#pragma unroll
            for (int i = 0; i < 4; ++i) {
                const f32x4 w = *(const f32x4*)(nwp + i * 4);
                ow[2 * i] = pack2(ov[i][0] * rstd * w[0] * silu(bflo(gw[2 * i])), ov[i][1] * rstd * w[1] * silu(bfhi(gw[2 * i])));
                ow[2 * i + 1] = pack2(ov[i][2] * rstd * w[2] * silu(bflo(gw[2 * i + 1])), ov[i][3] * rstd * w[3] * silu(bfhi(gw[2 * i + 1])));
            }
            bf16_t* op = MIX + row * 2048 + h * 128 + vs * 16;
            *(uint4*)op = make_uint4(ow[0], ow[1], ow[2], ow[3]); *(uint4*)(op + 8) = make_uint4(ow[4], ow[5], ow[6], ow[7]);
        }
    }
#undef HG_LOAD
    float* so = P.out + O_CP + (size_t)(b * 16 + h) * 128 * 128;
#pragma unroll
    for (int j = 0; j < 2; ++j)
#pragma unroll
        for (int reg = 0; reg < 16; ++reg) so[(kb + crow(reg, hh)) * 128 + vb0 + j * 32 + l31] = accS[j][reg];
}
DI void hgrn_sample_item(const Params& P, unsigned char* L, int item) {
    const int b = item >> 4, h = item & 15, tid = otid(), lane = tid & 63;
    float* qv = (float*)L; float* egv = qv + 128; float* kkv = egv + 128; float* vv = kkv + 128; float* part = vv + 128; float* red = part + 16 * 128;
    const bf16_t* U = WSP(bf16_t, OFF_U); bf16_t* MIX = WSP(bf16_t, OFF_MIX);
    const size_t row = (size_t)(MP + b); const bf16_t* ub = U + row * INC + h * 128;
    __syncthreads();
    if (tid < 128) {
        const int ch = h * 128 + tid;
        const float lbv = sigm(P.in[27][2048 + ch] - P.in[27][ch]);
        const float sg = sigm(bf2f(ub[2048 + tid])); const float kv = (1.f - lbv) * (1.f - sg);
        qv[tid] = bf2f(ub[tid]) * 0.08838834764831845f; egv[tid] = 1.f - kv; kkv[tid] = kv;
    } else if (tid < 256) vv[tid - 128] = bf2f(ub[4096 + tid - 128]);
    __syncthreads();
    const float* s0 = P.in[8] + (size_t)(b * 16 + h) * 128 * 128; float* s1 = P.out + O_CS + (size_t)(b * 16 + h) * 128 * 128;
    const int v4 = (tid & 31) * 4; const f32x4 vq = *(const f32x4*)(vv + v4);
    f32x4 op = {0.f, 0.f, 0.f, 0.f};
#pragma unroll
    for (int j = 0; j < 8; ++j) {
        const int k = (tid >> 5) + 16 * j;
        const f32x4 s = *(const f32x4*)(s0 + k * 128 + v4);
        const f32x4 sn = s * egv[k] + vq * kkv[k];
        *(f32x4*)(s1 + k * 128 + v4) = sn;
        op += sn * qv[k];
    }
    *(f32x4*)(part + (tid >> 5) * 128 + v4) = op;
    __syncthreads();
    float o = 0.f;
    if (tid < 128) {
#pragma unroll
        for (int i = 0; i < 16; ++i) o += part[i * 128 + tid];
        const float ss = wave_sum(o * o);
        if (lane == 0) red[tid >> 6] = ss;
    }
    __syncthreads();
    if (tid < 128) {
        const float rstd = rsqrtf((red[0] + red[1]) * (1.f / 128.f) + EPSF);
        const int ch = h * 128 + tid;
        MIX[row * 2048 + ch] = f2bf(o * rstd * P.in[28][ch] * silu(bf2f(ub[6144 + tid])));
    }
}
DI void phase_mix1(const Params& P, unsigned char* L) {
    const int tid = otid(), bid = blockIdx.x;
    if (bid < 128) hgrn_prompt_item(P, L, bid);
    else { const int nb = gridDim.x - 128; for (int it = bid - 128; it < 2048; it += nb) hgrn_sample_item(P, L, it); }
    unsigned* ctr = WSP(unsigned, OFF_CTL) + 48;
    unsigned* bc = (unsigned*)(L + LDS_BYTES - 16);
    for (;;) {
        __syncthreads();
        if (tid == 0) bc[0] = atomicAdd(ctr, 1u);
        __syncthreads();
        const unsigned q = bc[0];
        if (q >= 104u + 130u) break;
        if (q < 104u) l1_weight_tile(P, 2048 + (int)q * 8 + (tid >> 6), (float*)L + (tid >> 6) * (64 * 65), tid & 63);
        else convert_p_chunk(P, 1, (int)q - 104, tid);
    }
}
DI void phase_final(const Params& P) {
    const int lane = threadIdx.x & 63, gw = blockIdx.x * 8 + (threadIdx.x >> 6), nwv = gridDim.x * 8;
    const float* H = WSP(float, OFF_H); const float* SS = WSP(float, OFF_SS2); const float* nf = P.in[10];
    f32x4 w4[4];
#pragma unroll
    for (int i = 0; i < 4; ++i) w4[i] = *(const f32x4*)(nf + lane * 4 + 256 * i);
    for (int r0 = gw * 4; r0 < MV; r0 += nwv * 4) {
        f32x4 v[4][4]; float rs[4];
#pragma unroll
        for (int q = 0; q < 4; ++q) { rs[q] = SS[r0 + q];
#pragma unroll
            for (int i = 0; i < 4; ++i) v[q][i] = *(const f32x4*)(H + (size_t)(r0 + q) * 1024 + lane * 4 + 256 * i); }
#pragma unroll
        for (int q = 0; q < 4; ++q) { const float rstd = rsqrtf(rs[q] * (1.f / 1024.f) + EPSF);
#pragma unroll
            for (int i = 0; i < 4; ++i) __builtin_nontemporal_store(v[q][i] * rstd * w4[i], (f32x4*)(P.out + O_Y + (size_t)(r0 + q) * 1024 + lane * 4 + 256 * i)); }
    }
}

#define XB_TMO      128
#define XB_XCNT(j)  (256  + 64 * (j))
#define XB_XSUB(j)  (1280 + 64 * (j))
#define XB_XGEN(j)  (2304 + 64 * (j))
#define XB_TOP      3328
#define XB_TOPGEN   3392
#define XCD_BAR_WORDS 3456
#define XB_SPIN_CAP (1u << 18)

__device__ __forceinline__ unsigned xb_ld(unsigned* p)              { return __hip_atomic_load(p, __ATOMIC_RELAXED, __HIP_MEMORY_SCOPE_AGENT); }
__device__ __forceinline__ unsigned xb_add(unsigned* p, unsigned v) { return __hip_atomic_fetch_add(p, v, __ATOMIC_RELAXED, __HIP_MEMORY_SCOPE_AGENT); }
__device__ __forceinline__ unsigned xb_xcc_id() { return (unsigned)__builtin_amdgcn_s_getreg((3 << 11) | 20) & 0xFu; }
#define XB_SPIN(cond, bar) do { unsigned _sp = 0; while (cond) { __builtin_amdgcn_s_sleep(1); \
    if ((++_sp & 255u) == 0u) { if (xb_ld(&(bar)[XB_TMO])) break; if (_sp > XB_SPIN_CAP) { atomicAdd(&(bar)[XB_TMO], 1u); break; } } } } while (0)

struct XcdBarrier {
    unsigned* bar; unsigned x;
    volatile LAS unsigned* st;
};

__device__ __forceinline__ XcdBarrier xcd_barrier_post(unsigned* bar, volatile LAS unsigned* st) {
    XcdBarrier b; b.bar = bar; b.x = xb_xcc_id(); b.st = st;
    if (threadIdx.x == 0) (void)xb_add(&bar[XB_XCNT(b.x)], 1u);
    return b;
}
__device__ __forceinline__ void xcd_barrier_complete(unsigned* bar, unsigned x, unsigned& nloc, unsigned& nx) {
    const unsigned G = gridDim.x * gridDim.y * gridDim.z;
    unsigned sum, cnt, mine, sp = 0u;
    for (;;) {
        sum = 0u; cnt = 0u; mine = 0u;
#pragma unroll
        for (unsigned j = 0; j < 16; ++j) { const unsigned c = xb_ld(&bar[XB_XCNT(j)]); sum += c; cnt += (c > 0u) ? 1u : 0u; mine = (j == x) ? c : mine; }
        if (sum == G) break;
        __builtin_amdgcn_s_sleep(1);
        if ((++sp & 255u) == 0u) { if (xb_ld(&bar[XB_TMO])) break; if (sp > XB_SPIN_CAP) { atomicAdd(&bar[XB_TMO], 1u); break; } }
    }
    nloc = mine > 0u ? mine : 1u; nx = cnt > 0u ? cnt : 1u;
}

__device__ __forceinline__ void xcd_barrier(const XcdBarrier& b) {
    asm volatile("s_waitcnt vmcnt(0)" ::: "memory");
    __syncthreads();
    if (threadIdx.x == 0) {
        unsigned* bar = b.bar;
        __builtin_amdgcn_s_waitcnt(0);
        unsigned nloc = b.st[0], nx = b.st[1];
        if (nloc == 0u) { xcd_barrier_complete(bar, b.x, nloc, nx); b.st[0] = nloc; b.st[1] = nx; }
        const unsigned old = xb_add(&bar[XB_XSUB(b.x)], 1u);
        const unsigned gen = old / nloc;
        if (old + 1u == (gen + 1u) * nloc) {
            __builtin_amdgcn_fence(__ATOMIC_RELEASE, "agent");
            asm volatile("s_waitcnt vmcnt(0)" ::: "memory");
            const unsigned og = xb_add(&bar[XB_TOP], 1u);
            const unsigned tg = og / nx;
            if (og + 1u == (tg + 1u) * nx) xb_add(&bar[XB_TOPGEN], 1u);
            else XB_SPIN(xb_ld(&bar[XB_TOPGEN]) == tg, bar);
            __builtin_amdgcn_fence(__ATOMIC_ACQUIRE, "agent");
            xb_add(&bar[XB_XGEN(b.x)], 1u);
            asm volatile("s_waitcnt vmcnt(0)" ::: "memory");
        } else {
            XB_SPIN(xb_ld(&bar[XB_XGEN(b.x)]) == gen, bar);
            __builtin_amdgcn_fence(__ATOMIC_ACQUIRE, "agent");
            asm volatile("s_waitcnt vmcnt(0)" ::: "memory");
        }
    }
    __syncthreads();
}


#ifndef PHM
#define PHM 0xFFFF
#endif
typedef const __attribute__((address_space(4))) Params* ParamsK;
DI Params getp() {
    ParamsK pp = (ParamsK)__builtin_amdgcn_kernarg_segment_ptr(); asm volatile("" : "+s"(pp));
    Params P;
#pragma unroll
    for (int i = 0; i < 32; ++i) P.in[i] = pp->in[i];
    P.out = pp->out; P.ws = pp->ws; return P;
}
#define GETP() const Params P = getp()
__global__ void __launch_bounds__(512, 2) fwd_kernel(Params Parg) {
    extern __shared__ __attribute__((aligned(16))) unsigned char lds[];
    cg::grid_group grid = cg::this_grid();
    unsigned char* L = (unsigned char*)lds;
    LAS unsigned char* LL = (LAS unsigned char*)lds;
    volatile LAS unsigned* xst = (volatile LAS unsigned*)(LL + LDS_BYTES - 32);
    if (threadIdx.x < 2) xst[threadIdx.x] = 0u;
    __syncthreads();
    XcdBarrier xb;
    { GETP(); xb = xcd_barrier_post(WSP(unsigned, OFF_BAR), xst); }
    if (PHM & 1) { GETP(); phase_prep(P, L); }
    if (gridDim.y == 0xFFFFu) grid.sync();
    xcd_barrier(xb);
    if (PHM & 2) { GETP(); pg8::StaticOrder S; S.init(MP, N0 + 256, gridDim.x, blockIdx.x); pg8::Gemm g{WSP(bf16_t, OFF_XN), WSP(bf16_t, OFF_W0T), MP, N0 + 256, 1024};
      EpiStoreBf16 E{WSP(bf16_t, OFF_U), N0, nullptr, WSP(float, OFF_DT)}; pg8::gemm_phase(LL, g, S, E); }
    { GETP(); SfU f{WSP(bf16_t, OFF_U), N0, nullptr, WSP(float, OFF_DT)}; sgemm<4>(WSP(bf16_t, OFF_XN), WSP(bf16_t, OFF_W0T), 1024, 145, 64 * 19, f, L); }
    xcd_barrier(xb);
    { GETP(); phase_convbc(P, L); }
    xcd_barrier(xb);
    if (PHM & 4) { GETP(); phase_mix0(P, L); }
    xcd_barrier(xb);
    { GETP(); phase_norm0(P); }
    xcd_barrier(xb);
    if (PHM & 8) { GETP(); pg8::StaticOrder S; S.init(MP, 1024, gridDim.x, blockIdx.x); pg8::Gemm g{WSP(bf16_t, OFF_MIX), WSP(bf16_t, OFF_WO0T), MP, 1024, 2048};
      EpiResid E{P.in[0], P.in[1], WSP(float, OFF_H), WSP(bf16_t, OFF_HB)}; pg8::gemm_phase(LL, g, S, E); }
    { GETP(); SfResid f{P.in[1], WSP(float, OFF_H), WSP(bf16_t, OFF_HB)}; sgemm<4>(WSP(bf16_t, OFF_MIX), WSP(bf16_t, OFF_WO0T), 2048, 32, 256, f, L); }
    xcd_barrier(xb);
    if (PHM & 16) { GETP(); pg8::StaticOrder S; S.init(MP, 1024, gridDim.x, blockIdx.x);
      pg8::Gemm g1{WSP(bf16_t, OFF_HB), WSP(bf16_t, OFF_WG0T), MP, 1024, 1024}; EpiGate E1{WSP(bf16_t, OFF_MIX)}; pg8::gemm_phase(LL, g1, S, E1); }
    { GETP(); SfGate f{WSP(bf16_t, OFF_MIX)};   sgemm<2>(WSP(bf16_t, OFF_HB), WSP(bf16_t, OFF_WG0T), 1024, 32, 256, f, L); }
    if (PHM & 16) { GETP(); pg8::StaticOrder S; S.init(MP, 1024, gridDim.x, blockIdx.x);
      pg8::Gemm g2{WSP(bf16_t, OFF_PB), WSP(bf16_t, OFF_WP0T), MP, 1024, 256};
      EpiPle E2{WSP(float, OFF_H), WSP(bf16_t, OFF_MIX), WSP(bf16_t, OFF_XN), P.in[9] + 1024, WSP(float, OFF_SS1)}; pg8::gemm_phase(LL, g2, S, E2); }
    { GETP(); SfPle f{WSP(float, OFF_H), WSP(bf16_t, OFF_MIX), WSP(bf16_t, OFF_XN), P.in[9] + 1024, WSP(float, OFF_SS1)}; sgemm<2>(WSP(bf16_t, OFF_PB), WSP(bf16_t, OFF_WP0T), 256, 32, 256, f, L); }
    xcd_barrier(xb);
    if (PHM & 32) { GETP(); pg8::StaticOrder S; S.init(MP, INC, gridDim.x, blockIdx.x); pg8::Gemm g{WSP(bf16_t, OFF_XN), WSP(bf16_t, OFF_W1T), MP, INC, 1024};
      EpiStoreBf16 E{WSP(bf16_t, OFF_U), INC, WSP(float, OFF_SS1), nullptr}; pg8::gemm_phase(LL, g, S, E); }
    { GETP(); SfU f{WSP(bf16_t, OFF_U), INC, WSP(float, OFF_SS1), nullptr}; sgemm<4>(WSP(bf16_t, OFF_XN), WSP(bf16_t, OFF_W1T), 1024, 256, 64 * 32, f, L); }
    xcd_barrier(xb);
    if (PHM & 64) { GETP(); phase_mix1(P, L); }
    xcd_barrier(xb);
    if (PHM & 128) { GETP(); pg8::StaticOrder S; S.init(MP, 1024, gridDim.x, blockIdx.x); pg8::Gemm g{WSP(bf16_t, OFF_MIX), WSP(bf16_t, OFF_WO1T), MP, 1024, 2048};
      EpiResid E{WSP(float, OFF_H), WSP(float, OFF_H) + (size_t)MP * 1024, WSP(float, OFF_H), WSP(bf16_t, OFF_HB)}; pg8::gemm_phase(LL, g, S, E); }
    { GETP(); SfResid f{WSP(float, OFF_H) + (size_t)MP * 1024, WSP(float, OFF_H), WSP(bf16_t, OFF_HB)}; sgemm<4>(WSP(bf16_t, OFF_MIX), WSP(bf16_t, OFF_WO1T), 2048, 32, 256, f, L); }
    xcd_barrier(xb);
    if (PHM & 256) { GETP(); pg8::StaticOrder S; S.init(MP, 1024, gridDim.x, blockIdx.x);
      pg8::Gemm g1{WSP(bf16_t, OFF_HB), WSP(bf16_t, OFF_WG1T), MP, 1024, 1024}; EpiGate E1{WSP(bf16_t, OFF_MIX)}; pg8::gemm_phase(LL, g1, S, E1); }
    { GETP(); SfGate f{WSP(bf16_t, OFF_MIX)};   sgemm<2>(WSP(bf16_t, OFF_HB), WSP(bf16_t, OFF_WG1T), 1024, 32, 256, f, L); }
    if (PHM & 256) { GETP(); pg8::StaticOrder S; S.init(MP, 1024, gridDim.x, blockIdx.x);
      pg8::Gemm g2{WSP(bf16_t, OFF_PB + PB_STRIDE), WSP(bf16_t, OFF_WP1T), MP, 1024, 256};
      EpiPle E2{WSP(float, OFF_H), WSP(bf16_t, OFF_MIX), nullptr, nullptr, WSP(float, OFF_SS2)}; pg8::gemm_phase(LL, g2, S, E2); }
    { GETP(); SfPle f{WSP(float, OFF_H), WSP(bf16_t, OFF_MIX), nullptr, nullptr, WSP(float, OFF_SS2)}; sgemm<2>(WSP(bf16_t, OFF_PB + PB_STRIDE), WSP(bf16_t, OFF_WP1T), 256, 32, 256, f, L); }
    xcd_barrier(xb);
    { GETP(); phase_final(P); }
}

extern "C" void kernel_launch(void* const* d_in, const int* in_sizes, int n_in, void* d_out, int out_size, void* d_ws, size_t ws_size, hipStream_t stream) {
    static int grid = 0;
    if (grid == 0) {
        if (n_in != 32 || ws_size < WS_END) { fprintf(stderr, "kernel_launch: need 32 inputs and %zu bytes of workspace (got %d, %zu)\n", (size_t)WS_END, n_in, ws_size); grid = -1; return; }
        int dev = 0, cus = 0, per_cu = 0;
        (void)hipGetDevice(&dev); (void)hipDeviceGetAttribute(&cus, hipDeviceAttributeMultiprocessorCount, dev);
        if (hipFuncSetAttribute((const void*)fwd_kernel, hipFuncAttributeMaxDynamicSharedMemorySize, LDS_BYTES) != hipSuccess) { fprintf(stderr, "kernel_launch: hipFuncSetAttribute failed\n"); grid = -1; return; }
        if (hipOccupancyMaxActiveBlocksPerMultiprocessor(&per_cu, (const void*)fwd_kernel, 512, LDS_BYTES) != hipSuccess || per_cu < 1) { fprintf(stderr, "kernel_launch: occupancy query says %d\n", per_cu); per_cu = 1; }
        (void)hipGetLastError();
        grid = cus;
    }
    if (grid < 0) return;
    Params p{};
    for (int i = 0; i < 32; ++i) p.in[i] = (const float*)d_in[i];
    p.out = (float*)d_out; p.ws = (unsigned char*)d_ws;
    if (hipMemsetAsync((char*)d_ws + OFF_BAR, 0, 16384, stream) != hipSuccess) { fprintf(stderr, "kernel_launch: memset of barrier words failed\n"); return; }
    void* args[] = {&p};
    hipError_t e = hipLaunchCooperativeKernel((const void*)fwd_kernel, dim3(grid), dim3(512), args, LDS_BYTES, stream);
    if (e != hipSuccess) fprintf(stderr, "cooperative launch failed: %s (grid %d)\n", hipGetErrorString(e), grid);
}
```

```cpp
#include <hip/hip_runtime.h>
#include <hip/hip_cooperative_groups.h>
#include <cstdio>
namespace cg = cooperative_groups;

#define LAS __attribute__((address_space(3)))
#define DI __device__ __forceinline__
typedef unsigned short bf16_t;
typedef short bf16x8 __attribute__((ext_vector_type(8)));
typedef float f32x4 __attribute__((ext_vector_type(4)));
typedef float f32x16 __attribute__((ext_vector_type(16)));

constexpr int MP = 16384, MS = 128, MV = MP + MS, MPAD = 16640;
constexpr int DM = 1024, INAB = 4624, N0 = 4608, INC = 8192;
constexpr float EPSF = 1e-6f;
constexpr size_t O_Y = 0, O_AHP = 16908288, O_ACP = 16916480, O_BSP = 16941056, O_BCP = 17989632, O_CP = 18026496,
                 O_AHS = 20123648, O_ACS = 20254720, O_BSS = 20647936, O_BCS = 37425152, O_CS = 38014976;
constexpr size_t al256(size_t x) { return (x + 255) & ~size_t(255); }
constexpr size_t OFF_CTL = 0;
constexpr size_t OFF_BAR = 256;
constexpr size_t OFF_SS1 = 256 + 16384;
constexpr size_t OFF_SS2 = OFF_SS1 + al256((size_t)MPAD * 4);
constexpr size_t OFF_SSB = OFF_SS2 + al256((size_t)MPAD * 4);
constexpr size_t OFF_DT  = OFF_SSB + al256((size_t)MPAD * 8);
constexpr size_t OFF_W0T = OFF_DT + al256((size_t)MV * 16 * 4);
constexpr size_t OFF_WO0T = OFF_W0T + (size_t)(N0 + 256) * 1024 * 2;
constexpr size_t OFF_WG0T = OFF_WO0T + (size_t)1024 * 2048 * 2;
constexpr size_t OFF_WP0T = OFF_WG0T + (size_t)1024 * 1024 * 2;
constexpr size_t OFF_W1T  = OFF_WP0T + (size_t)1024 * 256 * 2;
constexpr size_t OFF_WO1T = OFF_W1T + (size_t)INC * 1024 * 2;
constexpr size_t OFF_WG1T = OFF_WO1T + (size_t)1024 * 2048 * 2;
constexpr size_t OFF_WP1T = OFF_WG1T + (size_t)1024 * 1024 * 2;
constexpr size_t OFF_WRT  = OFF_WP1T + (size_t)1024 * 256 * 2;
constexpr size_t OFF_WIT  = OFF_WRT + (size_t)128 * 1024 * 2;
constexpr size_t OFF_XN   = OFF_WIT + (size_t)128 * 1024 * 2;
constexpr size_t OFF_MIX  = OFF_XN + (size_t)MPAD * 1024 * 2;
constexpr size_t OFF_H    = OFF_MIX + (size_t)MPAD * 2048 * 2;
constexpr size_t OFF_U    = OFF_H + al256((size_t)MV * 1024 * 4);
constexpr size_t OFF_HB   = OFF_U;
constexpr size_t OFF_PB   = OFF_U + al256((size_t)MV * INC * 2);
constexpr size_t PB_STRIDE = (size_t)MPAD * 256 * 2;
constexpr size_t WS_END   = OFF_PB + 2 * PB_STRIDE;
constexpr int LDS_BYTES = 160 * 1024;

struct Params { const float* in[32]; float* out; unsigned char* ws; };
#define WSP(T, off) ((T*)(P.ws + (off)))

typedef __bf16 bf16v2_t __attribute__((ext_vector_type(2)));
typedef float f32v2_t __attribute__((ext_vector_type(2)));
DI unsigned pack2(float lo, float hi) { f32v2_t v = {lo, hi}; bf16v2_t b = __builtin_convertvector(v, bf16v2_t); return __builtin_bit_cast(unsigned, b); }
DI bf16_t f2bf(float f) { return __builtin_bit_cast(bf16_t, (__bf16)f); }
DI float bf2f(bf16_t b) { return __uint_as_float(((unsigned)b) << 16); }
DI float bflo(unsigned w) { return __uint_as_float(w << 16); }
DI float bfhi(unsigned w) { return __uint_as_float(w & 0xFFFF0000u); }
DI float frcp(float x) { return __builtin_amdgcn_rcpf(x); }
DI float sigm(float x) { return frcp(1.f + __expf(-x)); }
DI float silu(float x) { return x * frcp(1.f + __expf(-x)); }
DI float softplus(float x) { return x > 20.f ? x : log1pf(__expf(x)); }
DI float wave_sum(float v) { for (int o = 32; o > 0; o >>= 1) v += __shfl_xor(v, o); return v; }
DI int otid() { int t = threadIdx.x; asm volatile("" : "+v"(t)); return t; }
DI void lds_barrier() { asm volatile("s_waitcnt lgkmcnt(0)" ::: "memory"); __builtin_amdgcn_s_barrier(); asm volatile("" ::: "memory"); }
DI int crow(int reg, int hh) { return (reg & 3) + 8 * (reg >> 2) + 4 * hh; }
DI void ld4bf(const bf16_t* p, float (&o)[4]) { uint2 w = *(const uint2*)p; o[0] = bflo(w.x); o[1] = bfhi(w.x); o[2] = bflo(w.y); o[3] = bfhi(w.y); }
typedef unsigned u32x2 __attribute__((ext_vector_type(2)));
typedef unsigned u32x4 __attribute__((ext_vector_type(4)));
DI u32x2 pack4v(float a, float b, float c, float d) { u32x2 r; r.x = pack2(a, b); r.y = pack2(c, d); return r; }
DI uint2 pack4(float a, float b, float c, float d) { uint2 r; r.x = pack2(a, b); r.y = pack2(c, d); return r; }
#define MFMA32(a, b, c) __builtin_amdgcn_mfma_f32_32x32x16_bf16((a), (b), (c), 0, 0, 0)
#define MFMA16(a, b, c) __builtin_amdgcn_mfma_f32_16x16x32_bf16((a), (b), (c), 0, 0, 0)
DI bf16x8 ldfrag(const bf16_t* base, int ld, int row0, int k0, int lane) { return *(const bf16x8*)(base + (row0 + (lane & 31)) * ld + k0 + 8 * (lane >> 5)); }
DI bf16x8 ldfrag16(const bf16_t* base, int ld, int row0, int k0, int lane) { return *(const bf16x8*)(base + (row0 + (lane & 15)) * ld + k0 + 8 * (lane >> 4)); }

namespace pg8 {
constexpr int BM = 256, BK = 64, HALF = 128, HTB = HALF * BK * 2, STAGE_BYTES = 8 * HTB, NXCD = 8, WGM = 8;
DI int lds_byte(int r, int c) { const int st = (r >> 4) * 2 + (c >> 5), rr = r & 15, cc = c & 31, ob = rr * 64 + cc * 2; return st * 1024 + (ob ^ (((ob >> 9) & 1) << 5)); }
DI void stage_rc(int b, int& R, int& C) { const int st = b / 1024, sb = b % 1024, swz = sb ^ (((sb >> 9) & 1) << 5); R = (st >> 1) * 16 + swz / 64; C = (st & 1) * 32 + (swz % 64) / 2; }
DI int perm32(int rho) { const int n = rho >> 4, i = rho & 15; return 8 * (i >> 2) + 4 * n + (i & 3); }
struct Unit { int pm, pn; };
struct Gemm { const bf16_t* A; const bf16_t* Bt; int M, N, K; };
struct StaticOrder {
    int nM, nN, nwg, G, c;
    DI void init(int M, int N, int G_, int c_) { nM = M / BM; nN = N / BM; nwg = nM * nN; G = G_; c = c_; }
    DI bool next(int i, Unit& u) const {
        const long L = (long)i * G + c; if (L >= nwg) return false;
        int wgid = (int)L; { const int q = nwg / NXCD, r = nwg % NXCD, xcd = wgid % NXCD, off = wgid / NXCD; wgid = (xcd < r ? xcd * (q + 1) : r * (q + 1) + (xcd - r) * q) + off; }
        const int nig = WGM * nN, gid = wgid / nig, fm = gid * WGM, gsz = (nM - fm) < WGM ? (nM - fm) : WGM;
        u.pm = fm + ((wgid % nig) % gsz); u.pn = (wgid % nig) / gsz; return true;
    }
};

template <class Epi>
DI void gemm_phase(LAS unsigned char* lds, const Gemm g, const StaticOrder& S, const Epi& E) {
    const int tid = otid(), wid = __builtin_amdgcn_readfirstlane(tid >> 6), lane = tid & 63, wr = wid >> 2, wc = wid & 3, fr = lane & 15, fq = lane >> 4;
    const int K = g.K, nt = K / BK;
    unsigned voffA[2], voffB[2];
#pragma unroll
    for (int i = 0; i < 2; ++i) { int R, C; stage_rc(tid * 16 + i * 8192, R, C); const int Rb = Epi::PERM ? ((R & ~31) + perm32(R & 31)) : R;
        voffA[i] = (unsigned)(R * K + C) * 2u; voffB[i] = (unsigned)(Rb * K + C) * 2u; }
    const size_t kstep = (size_t)(BK * 2);
    const size_t hstep = (size_t)HALF * K * 2;
    const size_t tstep = 2 * hstep;
    const unsigned ldsw = (unsigned)wid * 1024u;
    const int aoff = lds_byte(wr * 64 + fr, fq * 8), boff = lds_byte(wc * 32 + fr, fq * 8);
#define PG8_SA(b, h) (((b) * 2 + (h)) * HTB)
#define PG8_SB(b, h) ((4 + (b) * 2 + (h)) * HTB)
#define PG8_STAGE(bufoff, gbase, voff) do { _Pragma("unroll") for (int _i = 0; _i < 2; ++_i) \
        __builtin_amdgcn_global_load_lds((const unsigned*)((const char*)(gbase) + (voff)[_i]), (LAS unsigned*)(lds + (bufoff) + ldsw + _i * 8192), 16, 0, 0); } while (0)
#define PG8_LDA(dst, b, h) do { _Pragma("unroll") for (int m = 0; m < 4; ++m) _Pragma("unroll") for (int k = 0; k < 2; ++k) dst[m][k] = *(const LAS bf16x8*)(lds + PG8_SA(b, h) + aoff + m * 2048 + k * 1024); } while (0)
#define PG8_LDB(dst, b, h) do { _Pragma("unroll") for (int n = 0; n < 2; ++n) _Pragma("unroll") for (int k = 0; k < 2; ++k) dst[n][k] = *(const LAS bf16x8*)(lds + PG8_SB(b, h) + boff + n * 2048 + k * 1024); } while (0)
#define PG8_MMA(ai, bj, At, Bt) do { __builtin_amdgcn_s_setprio(1); _Pragma("unroll") for (int m = 0; m < 4; ++m) _Pragma("unroll") for (int n = 0; n < 2; ++n) _Pragma("unroll") for (int k = 0; k < 2; ++k) \
        acc[ai][bj][m][n] = __builtin_amdgcn_mfma_f32_16x16x32_bf16(Bt[n][k], At[m][k], acc[ai][bj][m][n], 0, 0, 0); __builtin_amdgcn_s_setprio(0); } while (0)
#define PG8_WAIT_V(n) asm volatile("s_waitcnt vmcnt(" #n ")" ::: "memory")
#define PG8_WAIT_L(n) asm volatile("s_waitcnt lgkmcnt(" #n ")" ::: "memory")
#define PG8_BAR __builtin_amdgcn_s_barrier()
#define PG8_SCHED __builtin_amdgcn_sched_barrier(0)
    Unit cur, nxt; int ui = 0;
    if (!S.next(0, cur)) return;
    f32x4 acc[2][2][4][2];
#pragma unroll
    for (int a = 0; a < 2; ++a)
#pragma unroll
        for (int b = 0; b < 2; ++b)
#pragma unroll
            for (int m = 0; m < 4; ++m)
#pragma unroll
                for (int n = 0; n < 2; ++n) acc[a][b][m][n] = (f32x4){0.f, 0.f, 0.f, 0.f};
    bf16x8 At[4][2], B0[2][2], B1[2][2];
    const char* cA = (const char*)g.A + (size_t)cur.pm * tstep; const char* cB = (const char*)g.Bt + (size_t)cur.pn * tstep;
    PG8_STAGE(PG8_SB(0, 0), cB, voffB); PG8_STAGE(PG8_SA(0, 0), cA, voffA); PG8_STAGE(PG8_SB(0, 1), cB + hstep, voffB); PG8_STAGE(PG8_SA(0, 1), cA + hstep, voffA);
    if (wr == 1) PG8_BAR;
    PG8_WAIT_V(4); PG8_BAR;
    PG8_STAGE(PG8_SB(1, 0), cB + kstep, voffB); PG8_STAGE(PG8_SA(1, 0), cA + kstep, voffA); PG8_STAGE(PG8_SB(1, 1), cB + hstep + kstep, voffB);
    PG8_WAIT_V(6); PG8_BAR;
    for (;;) {
        const bool has_next = S.next(ui + 1, nxt);
        const char* nA = has_next ? (const char*)g.A + (size_t)nxt.pm * tstep : cA; const char* nB = has_next ? (const char*)g.Bt + (size_t)nxt.pn * tstep : cB;
        for (int t = 0; t < nt; t += 2) {
            const bool last = (t == nt - 2);
            const char* a1 = cA + (size_t)(t + 1) * kstep;
            const char* a2 = last ? nA : cA + (size_t)(t + 2) * kstep; const char* b2 = last ? nB : cB + (size_t)(t + 2) * kstep;
            const char* a3 = a2 + kstep; const char* b3 = b2 + kstep;
            PG8_LDB(B0, 0, 0); PG8_SCHED; PG8_LDA(At, 0, 0); PG8_STAGE(PG8_SA(1, 1), a1 + hstep, voffA);
            PG8_WAIT_L(8); PG8_BAR; PG8_WAIT_L(0); PG8_MMA(0, 0, At, B0); PG8_BAR; PG8_SCHED;
            PG8_LDB(B1, 0, 1); PG8_STAGE(PG8_SB(0, 0), b2, voffB);
            PG8_BAR; PG8_WAIT_L(0); PG8_MMA(0, 1, At, B1); PG8_BAR;
            PG8_LDA(At, 0, 1); PG8_STAGE(PG8_SA(0, 0), a2, voffA);
            PG8_BAR; PG8_WAIT_L(0); PG8_MMA(1, 0, At, B0); PG8_BAR; PG8_SCHED;
            PG8_STAGE(PG8_SB(0, 1), b2 + hstep, voffB);
            PG8_WAIT_V(6); PG8_BAR; PG8_MMA(1, 1, At, B1); PG8_BAR;
            PG8_LDB(B0, 1, 0); PG8_SCHED; PG8_LDA(At, 1, 0); PG8_STAGE(PG8_SA(0, 1), a2 + hstep, voffA);
            PG8_WAIT_L(8); PG8_BAR; PG8_WAIT_L(0); PG8_MMA(0, 0, At, B0); PG8_BAR; PG8_SCHED;
            PG8_LDB(B1, 1, 1); PG8_STAGE(PG8_SB(1, 0), b3, voffB);
            PG8_BAR; PG8_WAIT_L(0); PG8_MMA(0, 1, At, B1); PG8_BAR;
            PG8_LDA(At, 1, 1); PG8_STAGE(PG8_SA(1, 0), a3, voffA);
            PG8_BAR; PG8_WAIT_L(0); PG8_MMA(1, 0, At, B0); PG8_BAR; PG8_SCHED;
            PG8_STAGE(PG8_SB(1, 1), b3 + hstep, voffB);
            PG8_WAIT_V(6); PG8_BAR; PG8_MMA(1, 1, At, B1); PG8_BAR;
        }
        E(acc, cur, wr, wc, fr, fq);
        if (!has_next) break;
#pragma unroll
        for (int a = 0; a < 2; ++a)
#pragma unroll
            for (int b = 0; b < 2; ++b)
#pragma unroll
                for (int m = 0; m < 4; ++m)
#pragma unroll
                    for (int n = 0; n < 2; ++n) acc[a][b][m][n] = (f32x4){0.f, 0.f, 0.f, 0.f};
        cur = nxt; cA = nA; cB = nB; ++ui;
    }
    PG8_WAIT_V(0);
    if (wr == 0) PG8_BAR;
    PG8_BAR;
#undef PG8_SA
#undef PG8_SB
#undef PG8_STAGE
#undef PG8_LDA
#undef PG8_LDB
#undef PG8_MMA
#undef PG8_WAIT_V
#undef PG8_WAIT_L
#undef PG8_BAR
#undef PG8_SCHED
}
}

struct EpiStoreBf16 {
    static constexpr bool PERM = true;
    bf16_t* O; int ldc; const float* ss; float* DT;
    DI void operator()(const f32x4 (&acc)[2][2][4][2], const pg8::Unit& u, int wr, int wc, int fr, int fq) const {
        const int row0 = u.pm * 256 + wr * 64 + fr, col0 = u.pn * 256 + wc * 32 + 8 * fq;
        if (u.pn * 256 >= ldc) {
            if (wc == 0 && fq < 2) {
#pragma unroll
                for (int ai = 0; ai < 2; ++ai)
#pragma unroll
                    for (int m = 0; m < 4; ++m) { const int row = row0 + ai * 128 + m * 16;
                        if (row < MV) { *(f32x4*)(DT + (size_t)row * 16 + 8 * fq) = acc[ai][0][m][0]; *(f32x4*)(DT + (size_t)row * 16 + 8 * fq + 4) = acc[ai][0][m][1]; } }
            }
            return;
        }
#pragma unroll
        for (int ai = 0; ai < 2; ++ai)
#pragma unroll
            for (int m = 0; m < 4; ++m) {
                const int row = row0 + ai * 128 + m * 16;
                if (row < MV) {
                    const float sc = ss ? rsqrtf(ss[row] * (1.f / 1024.f) + EPSF) : 1.f;
                    bf16_t* rp = O + (size_t)row * ldc + col0;
#pragma unroll
                    for (int bj = 0; bj < 2; ++bj) {
                        const f32x4 v0 = acc[ai][bj][m][0] * sc, v1 = acc[ai][bj][m][1] * sc;
                        uint4 w; w.x = pack2(v0[0], v0[1]); w.y = pack2(v0[2], v0[3]); w.z = pack2(v1[0], v1[1]); w.w = pack2(v1[2], v1[3]);
                        *(uint4*)(rp + bj * 128) = w;
                    }
                }
            }
    }
};
struct EpiResid {
    static constexpr bool PERM = false;
    const float* rp_prompt; const float* rp_sample;
    float* H; bf16_t* HB;
    DI void operator()(const f32x4 (&acc)[2][2][4][2], const pg8::Unit& u, int wr, int wc, int fr, int fq) const {
        const int row0 = u.pm * 256 + wr * 64 + fr, col0 = u.pn * 256 + wc * 32 + 4 * fq;
#pragma unroll
        for (int ai = 0; ai < 2; ++ai)
#pragma unroll
            for (int m = 0; m < 4; ++m) {
                const int row = row0 + ai * 128 + m * 16;
                if (row < MV) {
                    const float* rs = (row < MP ? rp_prompt + (size_t)row * 1024 : rp_sample + (size_t)(row - MP) * 1024) + col0;
                    float* hp = H + (size_t)row * 1024 + col0; bf16_t* bp = HB + (size_t)row * 1024 + col0;
#pragma unroll
                    for (int bj = 0; bj < 2; ++bj)
#pragma unroll
                        for (int n = 0; n < 2; ++n) {
                            const int co = bj * 128 + n * 16;
                            const f32x4 v = acc[ai][bj][m][n] + *(const f32x4*)(rs + co);
                            *(f32x4*)(hp + co) = v; *(uint2*)(bp + co) = pack4(v[0], v[1], v[2], v[3]);
                        }
                }
            }
    }
};
struct EpiGate {
    static constexpr bool PERM = false;
    bf16_t* Gt;
    DI void operator()(const f32x4 (&acc)[2][2][4][2], const pg8::Unit& u, int wr, int wc, int fr, int fq) const {
        const int row0 = u.pm * 256 + wr * 64 + fr, col0 = u.pn * 256 + wc * 32 + 4 * fq;
#pragma unroll
        for (int ai = 0; ai < 2; ++ai)
#pragma unroll
            for (int m = 0; m < 4; ++m) {
                const int row = row0 + ai * 128 + m * 16;
                if (row < MV) {
                    bf16_t* gp = Gt + (size_t)row * 1024 + col0;
#pragma unroll
                    for (int bj = 0; bj < 2; ++bj)
#pragma unroll
                        for (int n = 0; n < 2; ++n) {
                            const f32x4 a = acc[ai][bj][m][n];
                            *(uint2*)(gp + bj * 128 + n * 16) = pack4(sigm(a[0]), sigm(a[1]), sigm(a[2]), sigm(a[3]));
                        }
                }
            }
    }
};
struct EpiPle {
    static constexpr bool PERM = false;
    float* H; const bf16_t* Gt; bf16_t* XN; const float* nw; float* SS;
    DI void operator()(const f32x4 (&acc)[2][2][4][2], const pg8::Unit& u, int wr, int wc, int fr, int fq) const {
        const int row0 = u.pm * 256 + wr * 64 + fr, col0 = u.pn * 256 + wc * 32 + 4 * fq;
#pragma unroll
        for (int ai = 0; ai < 2; ++ai)
#pragma unroll
            for (int m = 0; m < 4; ++m) {
                const int row = row0 + ai * 128 + m * 16;
                float ssum = 0.f;
                if (row < MV) {
                    float* hp = H + (size_t)row * 1024 + col0; const bf16_t* gp = Gt + (size_t)row * 1024 + col0;
#pragma unroll
                    for (int bj = 0; bj < 2; ++bj)
#pragma unroll
                        for (int n = 0; n < 2; ++n) {
                            const int co = bj * 128 + n * 16;
                            float gq[4]; ld4bf(gp + co, gq); const f32x4 v = *(const f32x4*)(hp + co) + (f32x4){gq[0], gq[1], gq[2], gq[3]} * acc[ai][bj][m][n];
                            *(f32x4*)(hp + co) = v;
                            ssum += v[0] * v[0] + v[1] * v[1] + v[2] * v[2] + v[3] * v[3];
                            if (XN) { const f32x4 w = *(const f32x4*)(nw + col0 + co); *(uint2*)(XN + (size_t)row * 1024 + col0 + co) = pack4(v[0] * w[0], v[1] * w[1], v[2] * w[2], v[3] * w[3]); }
                        }
                }
                ssum += __shfl_xor(ssum, 16); ssum += __shfl_xor(ssum, 32);
                if (fq == 0 && row < MV) atomicAdd(SS + row, ssum);
            }
    }
};

template <int KS, class F>
DI void sgemm(const bf16_t* A, const bf16_t* Bt, int K, int ncolt, int nwg_main, const F& f, unsigned char* L) {
    constexpr int RT = 8 / KS, NRS = 128 / (16 * RT);
    const int tid = otid(), lane = tid & 63, wid = __builtin_amdgcn_readfirstlane(tid >> 6), rt = wid % RT, ks = wid / RT;
    const int G = gridDim.x, off = nwg_main % G, Kh = K / KS;
    int li = blockIdx.x, nl = G;
    if (off != 0) { if ((int)blockIdx.x < off) return; li = blockIdx.x - off; nl = G - off; }
    float* red = (float*)L;
    for (int t = li; t < ncolt * NRS; t += nl) {
        const int ct = t / NRS, rs = t % NRS;
        const bf16_t* ap = A + (size_t)(MP + rs * 16 * RT + rt * 16 + (lane & 15)) * K + ks * Kh + 8 * (lane >> 4);
        const bf16_t* bp0 = Bt + (size_t)(ct * 32 + (lane & 15)) * K + ks * Kh + 8 * (lane >> 4);
        const bf16_t* bp1 = bp0 + (size_t)16 * K;
        f32x4 acc0 = {0.f, 0.f, 0.f, 0.f}, acc1 = {0.f, 0.f, 0.f, 0.f};
        bf16x8 a0[4], a1[4], p0[4], p1[4], q0[4], q1[4];
#define SG_LOAD(av, pv, qv, kk) do { _Pragma("unroll") for (int q_ = 0; q_ < 4; ++q_) { av[q_] = *(const bf16x8*)(ap + (kk) + q_ * 32); pv[q_] = *(const bf16x8*)(bp0 + (kk) + q_ * 32); qv[q_] = *(const bf16x8*)(bp1 + (kk) + q_ * 32); } } while (0)
#define SG_MMA(av, pv, qv) do { _Pragma("unroll") for (int q_ = 0; q_ < 4; ++q_) { acc0 = MFMA16(av[q_], pv[q_], acc0); acc1 = MFMA16(av[q_], qv[q_], acc1); } } while (0)
        SG_LOAD(a0, p0, q0, 0);
        for (int k0 = 0; k0 < Kh; k0 += 256) {
            if (k0 + 128 < Kh) SG_LOAD(a1, p1, q1, k0 + 128);
            SG_MMA(a0, p0, q0);
            if (k0 + 256 < Kh) SG_LOAD(a0, p0, q0, k0 + 256);
            if (k0 + 128 < Kh) SG_MMA(a1, p1, q1);
        }
#undef SG_LOAD
#undef SG_MMA
        if (ks > 0) { float* rp = red + (((ks - 1) * RT + rt) * 64 + lane) * 8; *(f32x4*)rp = acc0; *(f32x4*)(rp + 4) = acc1; }
        lds_barrier();
        if (ks == 0) {
#pragma unroll
            for (int j = 0; j < KS - 1; ++j) { const float* rp = red + ((j * RT + rt) * 64 + lane) * 8; acc0 += *(const f32x4*)rp; acc1 += *(const f32x4*)(rp + 4); }
#pragma unroll
            for (int reg = 0; reg < 4; ++reg) {
                const int row = MP + rs * 16 * RT + rt * 16 + (lane >> 4) * 4 + reg, col = ct * 32 + (lane & 15);
                f(row, col, acc0[reg], lane); f(row, col + 16, acc1[reg], lane);
            }
        }
        lds_barrier();
    }
}
struct SfU { bf16_t* O; int ldc; const float* ss; float* DT;
    DI void operator()(int row, int col, float v, int) const {
        if (col >= ldc) { if (col < ldc + 16) DT[(size_t)row * 16 + col - ldc] = v; return; }
        const float sc = ss ? rsqrtf(ss[row] * (1.f / 1024.f) + EPSF) : 1.f; O[(size_t)row * ldc + col] = f2bf(v * sc); } };
struct SfResid { const float* rs; float* H; bf16_t* HB;
    DI void operator()(int row, int col, float v, int) const { const float h = rs[(size_t)(row - MP) * 1024 + col] + v; H[(size_t)row * 1024 + col] = h; HB[(size_t)row * 1024 + col] = f2bf(h); } };
struct SfGate { bf16_t* Gt; DI void operator()(int row, int col, float v, int) const { Gt[(size_t)row * 1024 + col] = f2bf(sigm(v)); } };
struct SfPle { float* H; const bf16_t* Gt; bf16_t* XN; const float* nw; float* SS;
    DI void operator()(int row, int col, float v, int lane) const {
        const size_t o = (size_t)row * 1024 + col; const float h = H[o] + bf2f(Gt[o]) * v; H[o] = h;
        if (XN) XN[o] = f2bf(h * nw[col]);
        float ss = h * h; ss += __shfl_xor(ss, 1); ss += __shfl_xor(ss, 2); ss += __shfl_xor(ss, 4); ss += __shfl_xor(ss, 8);
        if ((lane & 15) == 0) atomicAdd(SS + row, ss); } };

DI void transpose_tile_w(const float* src, int lds_, bf16_t* dst, int ldd, int k0, int n0, int nvalid, float* tile, int lane) {
    const float* sp = src + (size_t)k0 * lds_ + n0 + lane;
#pragma unroll
    for (int bt = 0; bt < 4; ++bt) {
        float v[16];
#pragma unroll
        for (int r = 0; r < 16; ++r) v[r] = (lane < nvalid) ? sp[(size_t)(bt * 16 + r) * lds_] : 0.f;
#pragma unroll
        for (int r = 0; r < 16; ++r) tile[(bt * 16 + r) * 65 + lane] = v[r];
    }
    const int koct = lane & 7;
#pragma unroll
    for (int p = 0; p < 8; ++p) {
        const int nn = (lane >> 3) + 8 * p;
        const float* tp = tile + (koct * 8) * 65 + nn;
        uint4 w;
        w.x = pack2(tp[0], tp[65]); w.y = pack2(tp[2 * 65], tp[3 * 65]); w.z = pack2(tp[4 * 65], tp[5 * 65]); w.w = pack2(tp[6 * 65], tp[7 * 65]);
        *(uint4*)(dst + (size_t)(n0 + nn) * ldd + k0 + koct * 8) = w;
    }
}
DI void transpose_job(const float* src, int lds_, bf16_t* dst, int ldd, int K, int N, int nvalid_last, int& base, float* tile, int gw, int nwv, int lane) {
    const int ntn = (N + 63) / 64, nt = (K / 64) * ntn;
    const int first = (gw - (base % nwv) + nwv) % nwv;
    for (int t = first; t < nt; t += nwv) { const int tn = t % ntn; transpose_tile_w(src, lds_, dst, ldd, (t / ntn) * 64, tn * 64, (tn == ntn - 1) ? nvalid_last : 64, tile, lane); }
    base += nt;
}
DI void l1_weight_tile(const Params& P, int t, float* tile, int lane) {
    if (t < 2048) transpose_tile_w(P.in[26], INC, WSP(bf16_t, OFF_W1T), 1024, (t >> 7) * 64, (t & 127) * 64, 64, tile, lane);
    else if (t < 2560) { t -= 2048; transpose_tile_w(P.in[29], 1024, WSP(bf16_t, OFF_WO1T), 2048, (t >> 4) * 64, (t & 15) * 64, 64, tile, lane); }
    else if (t < 2816) { t -= 2560; transpose_tile_w(P.in[31] + 1024 * 1024, 1024, WSP(bf16_t, OFF_WG1T), 1024, (t >> 4) * 64, (t & 15) * 64, 64, tile, lane); }
    else if (t < 2880) { t -= 2816; transpose_tile_w(P.in[30] + 256 * 1024, 1024, WSP(bf16_t, OFF_WP1T), 256, (t >> 4) * 64, (t & 15) * 64, 64, tile, lane); }
    else if (t < 3392) { t -= 2880; transpose_tile_w(P.in[25], 1024, WSP(bf16_t, OFF_WO0T), 2048, (t >> 4) * 64, (t & 15) * 64, 64, tile, lane); }
    else if (t < 3648) { t -= 3392; transpose_tile_w(P.in[31], 1024, WSP(bf16_t, OFF_WG0T), 1024, (t >> 4) * 64, (t & 15) * 64, 64, tile, lane); }
    else { t -= 3648; transpose_tile_w(P.in[30], 1024, WSP(bf16_t, OFF_WP0T), 256, (t >> 4) * 64, (t & 15) * 64, 64, tile, lane); }
}
DI void phase_prep(const Params& P, unsigned char* L) {
    const int tid = otid(), lane = tid & 63, wid = tid >> 6;
    const int gw = blockIdx.x * 8 + wid, nwv = gridDim.x * 8;
    { float* z = WSP(float, OFF_SS1); const int n = (int)((OFF_DT - OFF_SS1) / 4);
      for (int i = blockIdx.x * 512 + tid; i < n; i += gridDim.x * 512) z[i] = 0.f;
      if (blockIdx.x == 0 && tid < 64) WSP(unsigned, OFF_CTL)[tid] = 0u; }
    { float* tile = (float*)L + wid * (64 * 65); int base = 0;
      transpose_job(P.in[11], INAB, WSP(bf16_t, OFF_W0T), 1024, 1024, N0, 64, base, tile, gw, nwv, lane);
      transpose_job(P.in[11] + N0, INAB, WSP(bf16_t, OFF_W0T) + (size_t)N0 * 1024, 1024, 1024, 16, 16, base, tile, gw, nwv, lane);
      transpose_job(P.in[14], 128, WSP(bf16_t, OFF_WRT), 1024, 1024, 128, 64, base, tile, gw, nwv, lane);
      transpose_job(P.in[16], 128, WSP(bf16_t, OFF_WIT), 1024, 1024, 128, 64, base, tile, gw, nwv, lane); }
    { const float* nwp = P.in[9]; bf16_t* XN = WSP(bf16_t, OFF_XN);
      f32x4 w4[4];
#pragma unroll
      for (int i = 0; i < 4; ++i) w4[i] = *(const f32x4*)(nwp + lane * 4 + 256 * i);
      for (int r0 = gw * 2; r0 < MV; r0 += nwv * 2) {
          f32x4 x[2][4];
#pragma unroll
          for (int q = 0; q < 2; ++q) { const int r = r0 + q; const float* src = r < MP ? P.in[0] + (size_t)r * 1024 : P.in[1] + (size_t)(r - MP) * 1024;
#pragma unroll
              for (int i = 0; i < 4; ++i) x[q][i] = *(const f32x4*)(src + lane * 4 + 256 * i); }
#pragma unroll
          for (int q = 0; q < 2; ++q) {
              float ss = 0.f;
#pragma unroll
              for (int i = 0; i < 4; ++i) ss += x[q][i][0] * x[q][i][0] + x[q][i][1] * x[q][i][1] + x[q][i][2] * x[q][i][2] + x[q][i][3] * x[q][i][3];
              ss = wave_sum(ss); const float rstd = rsqrtf(ss * (1.f / 1024.f) + EPSF);
#pragma unroll
              for (int i = 0; i < 4; ++i) { const f32x4 v = x[q][i] * rstd * w4[i]; *(uint2*)(XN + (size_t)(r0 + q) * 1024 + lane * 4 + 256 * i) = pack4(v[0], v[1], v[2], v[3]); }
          }
      } }
}
DI void convert_p_chunk(const Params& P, int layer, int chunk, int tid) {
    bf16_t* PB = WSP(bf16_t, OFF_PB + (size_t)layer * PB_STRIDE);
    const float* pp = P.in[2] + (size_t)layer * MP * 256; const float* ps = P.in[3] + (size_t)layer * MS * 256;
#pragma unroll 4
    for (int j = 0; j < 16; ++j) {
        const int i = chunk * 8192 + j * 512 + tid;
        if (i < MV * 64) {
            const int row = i >> 6, c4 = (i & 63) * 4;
            const f32x4 v = *(const f32x4*)((row < MP ? pp + (size_t)row * 256 : ps + (size_t)(row - MP) * 256) + c4);
            *(uint2*)(PB + (size_t)row * 256 + c4) = pack4(v[0], v[1], v[2], v[3]);
        }
    }
}

constexpr size_t OFF_XT = OFF_XN;
constexpr size_t OFF_CN = OFF_H;
constexpr size_t OFF_BN = OFF_CN + (size_t)MP * 256 * 2;
constexpr size_t OFF_BT = OFF_BN + (size_t)MP * 256 * 2;
DI void phase_convbc(const Params& P, unsigned char* L) {
    const bf16_t* U = WSP(bf16_t, OFF_U);
    bf16_t* XT = WSP(bf16_t, OFF_XT); bf16_t* CN = WSP(bf16_t, OFF_CN); bf16_t* CBG = WSP(bf16_t, OFF_BN); bf16_t* BT = WSP(bf16_t, OFF_BT);
    const int tid = otid();
    for (int task = blockIdx.x; task < 256; task += gridDim.x) {
        const int b = task >> 5, c = (task >> 1) & 15, g = task & 1, lane = tid & 63, wid = tid >> 6, hh = lane >> 5, l31 = lane & 31;
        bf16_t* Cs = (bf16_t*)L; bf16_t* Bs = Cs + 128 * 136;
        const int quad = tid & 63, isC = quad >> 5, n0 = (quad & 31) * 4, cch = 1024 + isC * 256 + g * 128 + n0, t0 = (tid >> 6) * 16, tg0 = c * 128 + t0;
        const size_t tile = ((size_t)((b * 16 + c) * 2 + g)) * 128 * 128;
        float cw[4][4], cbias[4];
#pragma unroll
        for (int kk = 0; kk < 4; ++kk) { const f32x4 w = *(const f32x4*)(P.in[19] + kk * 1536 + cch); cw[kk][0] = w[0]; cw[kk][1] = w[1]; cw[kk][2] = w[2]; cw[kk][3] = w[3]; }
        { const f32x4 w = *(const f32x4*)(P.in[20] + cch); cbias[0] = w[0]; cbias[1] = w[1]; cbias[2] = w[2]; cbias[3] = w[3]; }
        const unsigned voff = (unsigned)((b * 2048 + tg0) * N0 + 3072 + cch);
        u32x2 raw[19];
#pragma unroll
        for (int j = 0; j < 19; ++j) raw[j] = (tg0 + j - 3 >= 0) ? *(const u32x2*)((U + (j - 3) * N0) + voff) : (u32x2){0u, 0u};
        lds_barrier();
        unsigned bt[4][8];
#pragma unroll
        for (int j = 0; j < 16; j += 2) {
            float y[2][4];
#pragma unroll
            for (int q = 0; q < 2; ++q) {
                const float x0[4] = {bflo(raw[j + q].x), bfhi(raw[j + q].x), bflo(raw[j + q].y), bfhi(raw[j + q].y)};
                const float x1[4] = {bflo(raw[j + q + 1].x), bfhi(raw[j + q + 1].x), bflo(raw[j + q + 1].y), bfhi(raw[j + q + 1].y)};
                const float x2[4] = {bflo(raw[j + q + 2].x), bfhi(raw[j + q + 2].x), bflo(raw[j + q + 2].y), bfhi(raw[j + q + 2].y)};
                const float x3[4] = {bflo(raw[j + q + 3].x), bfhi(raw[j + q + 3].x), bflo(raw[j + q + 3].y), bfhi(raw[j + q + 3].y)};
#pragma unroll
                for (int e = 0; e < 4; ++e) y[q][e] = silu(cbias[e] + cw[0][e] * x0[e] + cw[1][e] * x1[e] + cw[2][e] * x2[e] + cw[3][e] * x3[e]);
                const u32x2 pk = pack4v(y[q][0], y[q][1], y[q][2], y[q][3]);
                *(u32x2*)((isC ? Cs : Bs) + (t0 + j + q) * 136 + n0) = pk;
                if (isC) *(u32x2*)(CN + tile + (size_t)(t0 + j + q) * 128 + n0) = pk;
            }
#pragma unroll
            for (int e = 0; e < 4; ++e) bt[e][j >> 1] = pack2(y[0][e], y[1][e]);
        }
        if (!isC) {
#pragma unroll
            for (int e = 0; e < 4; ++e) { bf16_t* dp = BT + tile + (size_t)(n0 + e) * 128 + t0;
                *(u32x4*)dp = (u32x4){bt[e][0], bt[e][1], bt[e][2], bt[e][3]}; *(u32x4*)(dp + 8) = (u32x4){bt[e][4], bt[e][5], bt[e][6], bt[e][7]}; }
        }
        lds_barrier();
        const int rb = (wid >> 1) * 32, cb0 = (wid & 1) * 64;
        f32x16 cbA[2];
#pragma unroll
        for (int i = 0; i < 16; ++i) { cbA[0][i] = 0.f; cbA[1][i] = 0.f; }
#pragma unroll
        for (int ks = 0; ks < 8; ++ks) {
            const bf16x8 a = ldfrag(Cs, 136, rb, ks * 16, lane);
            cbA[0] = MFMA32(a, ldfrag(Bs, 136, cb0, ks * 16, lane), cbA[0]);
            cbA[1] = MFMA32(a, ldfrag(Bs, 136, cb0 + 32, ks * 16, lane), cbA[1]);
        }
#pragma unroll
        for (int j = 0; j < 2; ++j)
#pragma unroll
            for (int reg = 0; reg < 16; ++reg) CBG[tile + (size_t)(rb + crow(reg, hh)) * 128 + cb0 + j * 32 + l31] = f2bf(cbA[j][reg]);
        lds_barrier();
    }
    for (int idx = blockIdx.x * 512 + tid; idx < 2048 * 256; idx += gridDim.x * 512) {
        const int quad = idx & 255, tgp = idx >> 8, b = tgp >> 8, t0 = (tgp & 255) * 8, cch = quad * 4;
        float cw[4][4], cbias[4];
#pragma unroll
        for (int kk = 0; kk < 4; ++kk) { const f32x4 w = *(const f32x4*)(P.in[19] + kk * 1536 + cch); cw[kk][0] = w[0]; cw[kk][1] = w[1]; cw[kk][2] = w[2]; cw[kk][3] = w[3]; }
        { const f32x4 w = *(const f32x4*)(P.in[20] + cch); cbias[0] = w[0]; cbias[1] = w[1]; cbias[2] = w[2]; cbias[3] = w[3]; }
        const unsigned voff = (unsigned)((b * 2048 + t0) * N0 + 3072 + cch);
        u32x2 raw[11];
#pragma unroll
        for (int j = 0; j < 11; ++j) raw[j] = (t0 + j - 3 >= 0) ? *(const u32x2*)((U + (j - 3) * N0) + voff) : (u32x2){0u, 0u};
        float y[8][4];
#pragma unroll
        for (int j = 0; j < 8; ++j) {
            const float x0[4] = {bflo(raw[j].x), bfhi(raw[j].x), bflo(raw[j].y), bfhi(raw[j].y)};
            const float x1[4] = {bflo(raw[j + 1].x), bfhi(raw[j + 1].x), bflo(raw[j + 1].y), bfhi(raw[j + 1].y)};
            const float x2[4] = {bflo(raw[j + 2].x), bfhi(raw[j + 2].x), bflo(raw[j + 2].y), bfhi(raw[j + 2].y)};
            const float x3[4] = {bflo(raw[j + 3].x), bfhi(raw[j + 3].x), bflo(raw[j + 3].y), bfhi(raw[j + 3].y)};
#pragma unroll
            for (int e = 0; e < 4; ++e) y[j][e] = silu(cbias[e] + cw[0][e] * x0[e] + cw[1][e] * x1[e] + cw[2][e] * x2[e] + cw[3][e] * x3[e]);
        }
        const int c = t0 >> 7, tl = t0 & 127;
#pragma unroll
        for (int e = 0; e < 4; ++e) *(u32x4*)(XT + ((size_t)((b * 16 + c) * 1024 + cch + e)) * 128 + tl) = (u32x4){pack2(y[0][e], y[1][e]), pack2(y[2][e], y[3][e]), pack2(y[4][e], y[5][e]), pack2(y[6][e], y[7][e])};
    }
}
DI void ssd_prompt_item(const Params& P, unsigned char* L, int item) {
    const int b = item >> 4, h = item & 15, g = h >> 3;
    const int tid0 = otid(), wid = tid0 >> 6;
    bf16_t* Cs = (bf16_t*)L;
    bf16_t* Ws = Cs + 128 * 136;
    bf16_t* BsT = Ws + 128 * 136;
    bf16_t* XsT = BsT + 128 * 136;
    bf16_t* St = XsT + 64 * 136;
    bf16_t* XwT = St + 64 * 136;
    float* dtvB = (float*)(XwT + 64 * 136); float* acsB = dtvB + 256; float* wvB = acsB + 256;
    const bf16_t* U = WSP(bf16_t, OFF_U); const float* DT = WSP(float, OFF_DT); bf16_t* MIX = WSP(bf16_t, OFF_MIX); float* SSB = WSP(float, OFF_SSB);
    const float a_neg = -__expf(P.in[22][h]), dtb = P.in[21][h], Dh = P.in[23][h];
    f32x16 accS;
#pragma unroll
    for (int i = 0; i < 16; ++i) accS[i] = 0.f;
    lds_barrier();
    for (int i = tid0; i < 64 * 136; i += 512) St[i] = 0;
    float dtr0 = 0.f, dtr1 = 0.f;
#define SSD_DTLOAD(cc) do { if (wid == 0) { const float* dp_ = DT + (size_t)(b * 2048 + (cc) * 128 + (tid0 & 63)) * 16 + h; dtr0 = dp_[0]; dtr1 = dp_[64 * 16]; } } while (0)
#define SSD_SCAN(buf) do { if (wid == 0) { const int ln_ = tid0 & 63; const float d0_ = softplus(dtr0 + dtb), d1_ = softplus(dtr1 + dtb); float v0_ = d0_ * a_neg, v1_ = d1_ * a_neg; \
        _Pragma("unroll") for (int o_ = 1; o_ < 64; o_ <<= 1) { const float n0_ = __shfl_up(v0_, o_), n1_ = __shfl_up(v1_, o_); if (ln_ >= o_) { v0_ += n0_; v1_ += n1_; } } \
        v1_ += __shfl(v0_, 63); const float al_ = __shfl(v1_, 63); \
        dtvB[(buf) * 128 + ln_] = d0_; dtvB[(buf) * 128 + 64 + ln_] = d1_; acsB[(buf) * 128 + ln_] = v0_; acsB[(buf) * 128 + 64 + ln_] = v1_; \
        wvB[(buf) * 128 + ln_] = __expf(al_ - v0_) * d0_; wvB[(buf) * 128 + 64 + ln_] = __expf(al_ - v1_) * d1_; } } while (0)
    SSD_DTLOAD(0); SSD_SCAN(0); SSD_DTLOAD(1);
    u32x4 tC[4], tB[4], tT[4], tX[2];
    for (int c = 0; c < 16; ++c) {
        const int row0 = b * 2048 + c * 128;
        lds_barrier();
        int zv = 0; asm volatile("" : "+v"(zv));
        const int tid = tid0 + zv, lane = tid & 63, hh = lane >> 5, l31 = lane & 31;
        const int prow = tid >> 4, pcol = (tid & 15) * 8;
        const float* dtv = dtvB + (c & 1) * 128; const float* acs = acsB + (c & 1) * 128; const float* wv = wvB + (c & 1) * 128;
        if (c + 1 < 16) { SSD_SCAN((c + 1) & 1); if (c + 2 < 16) SSD_DTLOAD(c + 2); }
        if (c == 0) {
            const size_t tb_ = ((size_t)((b * 16 + c) * 2 + g)) * 128 * 128 + (size_t)prow * 128 + pcol;
            const u32x4* pc = (const u32x4*)(WSP(bf16_t, OFF_CN) + tb_); const u32x4* pb = (const u32x4*)(WSP(bf16_t, OFF_BN) + tb_); const u32x4* pt = (const u32x4*)(WSP(bf16_t, OFF_BT) + tb_);
            const u32x4* px = (const u32x4*)(WSP(bf16_t, OFF_XT) + ((size_t)((b * 16 + c) * 1024 + h * 64 + prow)) * 128 + pcol);
#pragma unroll
            for (int i = 0; i < 4; ++i) { tC[i] = pc[i * 512]; tB[i] = pb[i * 512]; tT[i] = pt[i * 512]; }
            tX[0] = px[0]; tX[1] = px[512];
        }
        const float a_last = acs[127];
        float asv[8], dsv[8];
        { const f32x4 a0 = *(const f32x4*)(acs + pcol), a1 = *(const f32x4*)(acs + pcol + 4), d0 = *(const f32x4*)(dtv + pcol), d1 = *(const f32x4*)(dtv + pcol + 4);
#pragma unroll
          for (int q = 0; q < 4; ++q) { asv[q] = a0[q]; asv[q + 4] = a1[q]; dsv[q] = d0[q]; dsv[q + 4] = d1[q]; } }
#pragma unroll
        for (int i = 0; i < 4; ++i) {
            *(u32x4*)(Cs + (prow + 32 * i) * 136 + pcol) = tC[i]; *(u32x4*)(BsT + (prow + 32 * i) * 136 + pcol) = tT[i];
            {
                const int t = prow + 32 * i; const float at = acs[t];
                const unsigned cw_[4] = {tB[i].x, tB[i].y, tB[i].z, tB[i].w};
                float wv_[8];
#pragma unroll
                for (int q = 0; q < 8; ++q) { const int sidx = pcol + q; const float cbv = (q & 1) ? bfhi(cw_[q >> 1]) : bflo(cw_[q >> 1]);
                    wv_[q] = (sidx <= t) ? cbv * __expf(at - asv[q]) * dsv[q] : 0.f; }
                *(u32x4*)(Ws + t * 136 + pcol) = (u32x4){pack2(wv_[0], wv_[1]), pack2(wv_[2], wv_[3]), pack2(wv_[4], wv_[5]), pack2(wv_[6], wv_[7])};
            }
        }
        *(u32x4*)(XsT + prow * 136 + pcol) = tX[0]; *(u32x4*)(XsT + (prow + 32) * 136 + pcol) = tX[1];
        {
            const f32x4 w0 = *(const f32x4*)(wv + pcol), w1 = *(const f32x4*)(wv + pcol + 4);
            u32x4 oa, ob; const u32x4 xa = tX[0], xb_ = tX[1];
            oa.x = pack2(bflo(xa.x) * w0[0], bfhi(xa.x) * w0[1]); oa.y = pack2(bflo(xa.y) * w0[2], bfhi(xa.y) * w0[3]); oa.z = pack2(bflo(xa.z) * w1[0], bfhi(xa.z) * w1[1]); oa.w = pack2(bflo(xa.w) * w1[2], bfhi(xa.w) * w1[3]);
            ob.x = pack2(bflo(xb_.x) * w0[0], bfhi(xb_.x) * w0[1]); ob.y = pack2(bflo(xb_.y) * w0[2], bfhi(xb_.y) * w0[3]); ob.z = pack2(bflo(xb_.z) * w1[0], bfhi(xb_.z) * w1[1]); ob.w = pack2(bflo(xb_.w) * w1[2], bfhi(xb_.w) * w1[3]);
            *(u32x4*)(XwT + prow * 136 + pcol) = oa; *(u32x4*)(XwT + (prow + 32) * 136 + pcol) = ob;
        }
        if (c + 1 < 16) {
            const size_t tb_ = ((size_t)((b * 16 + c + 1) * 2 + g)) * 128 * 128 + (size_t)prow * 128 + pcol;
            const u32x4* pc = (const u32x4*)(WSP(bf16_t, OFF_CN) + tb_); const u32x4* pb = (const u32x4*)(WSP(bf16_t, OFF_BN) + tb_); const u32x4* pt = (const u32x4*)(WSP(bf16_t, OFF_BT) + tb_);
            const u32x4* px = (const u32x4*)(WSP(bf16_t, OFF_XT) + ((size_t)((b * 16 + c + 1) * 1024 + h * 64 + prow)) * 128 + pcol);
#pragma unroll
            for (int i = 0; i < 4; ++i) { tC[i] = pc[i * 512]; tB[i] = pb[i * 512]; tT[i] = pt[i * 512]; }
            tX[0] = px[0]; tX[1] = px[512];
        }
        bf16_t zr[16];
        {
            const unsigned zoff = (unsigned)((row0 + (wid >> 1) * 32 + 4 * hh) * N0 + 2048 + h * 64 + (wid & 1) * 32 + l31);
#pragma unroll
            for (int reg = 0; reg < 16; ++reg) zr[reg] = (U + ((reg & 3) + 8 * (reg >> 2)) * N0)[zoff];
        }
        lds_barrier();
        {
            const int tb = (wid >> 1) * 32, pb = (wid & 1) * 32;
            f32x16 y;
#pragma unroll
            for (int i = 0; i < 16; ++i) y[i] = 0.f;
#pragma unroll
            for (int ks = 0; ks < 8; ++ks) y = MFMA32(ldfrag(Cs, 136, tb, ks * 16, lane), ldfrag(St, 136, pb, ks * 16, lane), y);
            f32x16 y2;
#pragma unroll
            for (int i = 0; i < 16; ++i) y2[i] = 0.f;
#pragma unroll
            for (int ks = 0; ks < 8; ++ks) y2 = MFMA32(ldfrag(Ws, 136, tb, ks * 16, lane), ldfrag(XsT, 136, pb, ks * 16, lane), y2);
#pragma unroll
            for (int reg = 0; reg < 16; ++reg) y[reg] = y[reg] * __expf(acs[tb + crow(reg, hh)]) + y2[reg];
            const int p = pb + l31, ch = h * 64 + p; const float nwv = P.in[24][ch];
#pragma unroll
            for (int reg = 0; reg < 16; ++reg) {
                const int t = tb + crow(reg, hh); const size_t row = (size_t)(row0 + t);
                const float xv = bf2f(XsT[p * 136 + t]); const float z = bf2f(zr[reg]);
                const float yy = (y[reg] + Dh * xv) * silu(z);
                float ss = yy * yy;
                ss += __shfl_xor(ss, 1); ss += __shfl_xor(ss, 2); ss += __shfl_xor(ss, 4); ss += __shfl_xor(ss, 8); ss += __shfl_xor(ss, 16);
                if (l31 == 0) atomicAdd(SSB + row * 2 + g, ss);
                MIX[row * 2048 + 1024 + ch] = f2bf(yy * nwv);
            }
            lds_barrier();
            const int pb2 = (wid >> 2) * 32, nb = (wid & 3) * 32;
            const float ea = __expf(a_last);
#pragma unroll
            for (int reg = 0; reg < 16; ++reg) accS[reg] *= ea;
#pragma unroll
            for (int ks = 0; ks < 8; ++ks) accS = MFMA32(ldfrag(XwT, 136, pb2, ks * 16, lane), ldfrag(BsT, 136, nb, ks * 16, lane), accS);
#pragma unroll
            for (int reg = 0; reg < 16; ++reg) St[(pb2 + crow(reg, hh)) * 136 + nb + l31] = f2bf(accS[reg]);
        }
    }
    {
        const int lane = tid0 & 63, hh = lane >> 5, l31 = lane & 31;
        const int pb2 = (wid >> 2) * 32, nb = (wid & 3) * 32;
        float* o = P.out + O_BSP + (size_t)(b * 16 + h) * 64 * 128;
#pragma unroll
        for (int reg = 0; reg < 16; ++reg) o[(pb2 + crow(reg, hh)) * 128 + nb + l31] = accS[reg];
    }
}
#undef SSD_DTLOAD
#undef SSD_SCAN
DI void ssd_sample_item(const Params& P, unsigned char* L, int item) {
    const int b = item >> 4, h = item & 15, g = h >> 3, tid = otid(), lane = tid & 63;
    float* xs = (float*)L; float* Bv = xs + 64; float* Cv = Bv + 128; float* yv = Cv + 128;
    const bf16_t* U = WSP(bf16_t, OFF_U); bf16_t* MIX = WSP(bf16_t, OFF_MIX); float* SSB = WSP(float, OFF_SSB);
    const size_t row = (size_t)(MP + b);
    __syncthreads();
    if (tid < 320) {
        int cc; if (tid < 64) cc = h * 64 + tid; else if (tid < 192) cc = 1024 + g * 128 + (tid - 64); else cc = 1280 + g * 128 + (tid - 192);
        const float* buf = P.in[7] + (size_t)b * 3 * 1536 + cc;
        const float v = P.in[20][cc] + P.in[19][cc] * buf[0] + P.in[19][1536 + cc] * buf[1536] + P.in[19][2 * 1536 + cc] * buf[2 * 1536] + P.in[19][3 * 1536 + cc] * bf2f(U[row * N0 + 3072 + cc]);
        xs[tid] = silu(v);
    }
    const float dt = softplus(WSP(float, OFF_DT)[row * 16 + h] + P.in[21][h]);
    const float dA = __expf(-dt * __expf(P.in[22][h]));
    __syncthreads();
    const float* s0 = P.in[6] + (size_t)(b * 16 + h) * 64 * 128; float* s1 = P.out + O_BSS + (size_t)(b * 16 + h) * 64 * 128;
    const int n4 = (tid & 31) * 4;
    const f32x4 Bq = *(const f32x4*)(Bv + n4), Cq = *(const f32x4*)(Cv + n4);
#pragma unroll
    for (int j = 0; j < 4; ++j) {
        const int p = (tid >> 5) + 16 * j;
        const f32x4 s = *(const f32x4*)(s0 + p * 128 + n4);
        const float dx = dt * xs[p];
        const f32x4 sn = s * dA + Bq * dx;
        *(f32x4*)(s1 + p * 128 + n4) = sn;
        float yp = sn[0] * Cq[0] + sn[1] * Cq[1] + sn[2] * Cq[2] + sn[3] * Cq[3];
        yp += __shfl_xor(yp, 1); yp += __shfl_xor(yp, 2); yp += __shfl_xor(yp, 4); yp += __shfl_xor(yp, 8); yp += __shfl_xor(yp, 16);
        if ((tid & 31) == 0) yv[p] = yp;
    }
    __syncthreads();
    if (tid < 64) {
        const int ch = h * 64 + tid;
        const float yy = (yv[tid] + P.in[23][h] * xs[tid]) * silu(bf2f(U[row * N0 + 2048 + ch]));
        const float ss = wave_sum(yy * yy);
        if (lane == 0) atomicAdd(SSB + row * 2 + g, ss);
        MIX[row * 2048 + 1024 + ch] = f2bf(yy * P.in[24][ch]);
    }
}
DI void ssd_sample_item4(const Params& P, unsigned char* L, int item) {
    const int b = item >> 2, tid = otid(), gi = tid >> 7, lt = tid & 127, h = (item & 3) * 4 + gi, g = h >> 3;
    float* xs = (float*)L + gi * 512; float* Bv = xs + 64; float* Cv = Bv + 128; float* yv = Cv + 128;
    const bf16_t* U = WSP(bf16_t, OFF_U); bf16_t* MIX = WSP(bf16_t, OFF_MIX); float* SSB = WSP(float, OFF_SSB);
    const size_t row = (size_t)(MP + b);
    __syncthreads();
#pragma unroll
    for (int ps = 0; ps < 3; ++ps) {
        const int idx = lt + 128 * ps;
        if (idx < 320) {
            int cc; if (idx < 64) cc = h * 64 + idx; else if (idx < 192) cc = 1024 + g * 128 + (idx - 64); else cc = 1280 + g * 128 + (idx - 192);
            const float* buf = P.in[7] + (size_t)b * 3 * 1536 + cc;
            const float v = P.in[20][cc] + P.in[19][cc] * buf[0] + P.in[19][1536 + cc] * buf[1536] + P.in[19][2 * 1536 + cc] * buf[2 * 1536] + P.in[19][3 * 1536 + cc] * bf2f(U[row * N0 + 3072 + cc]);
            xs[idx] = silu(v);
        }
    }
    const float dt = softplus(WSP(float, OFF_DT)[row * 16 + h] + P.in[21][h]);
    const float dA = __expf(-dt * __expf(P.in[22][h]));
    __syncthreads();
    const float* s0 = P.in[6] + (size_t)(b * 16 + h) * 64 * 128; float* s1 = P.out + O_BSS + (size_t)(b * 16 + h) * 64 * 128;
    const int n4 = (lt & 31) * 4;
    const f32x4 Bq = *(const f32x4*)(Bv + n4), Cq = *(const f32x4*)(Cv + n4);
    f32x4 sv[16];
#pragma unroll
    for (int j = 0; j < 16; ++j) sv[j] = *(const f32x4*)(s0 + ((lt >> 5) + 4 * j) * 128 + n4);
#pragma unroll
    for (int j = 0; j < 16; ++j) {
        const int p = (lt >> 5) + 4 * j;
        const f32x4 sn = sv[j] * dA + Bq * (dt * xs[p]);
        *(f32x4*)(s1 + p * 128 + n4) = sn;
        float yp = sn[0] * Cq[0] + sn[1] * Cq[1] + sn[2] * Cq[2] + sn[3] * Cq[3];
        yp += __shfl_xor(yp, 1); yp += __shfl_xor(yp, 2); yp += __shfl_xor(yp, 4); yp += __shfl_xor(yp, 8); yp += __shfl_xor(yp, 16);
        if ((lt & 31) == 0) yv[p] = yp;
    }
    __syncthreads();
    if (lt < 64) {
        const int ch = h * 64 + lt;
        const float yy = (yv[lt] + P.in[23][h] * xs[lt]) * silu(bf2f(U[row * N0 + 2048 + ch]));
        const float ss = wave_sum(yy * yy);
        if (lt == 0) atomicAdd(SSB + row * 2 + g, ss);
        MIX[row * 2048 + 1024 + ch] = f2bf(yy * P.in[24][ch]);
    }
}
template <bool SAMPLE>
DI void rglru_item(const Params& P, unsigned char* L, int item) {
    const int tid0 = otid(), wid = tid0 >> 6;
    const int b = SAMPLE ? 0 : (item >> 4), k = (item >> 1) & 7, dh = item & 1;
    bf16_t* Xs = (bf16_t*)L;
    bf16_t* Wg = Xs + 128 * 136;
    float* Aa = (float*)(Wg + 128 * 136);
    float* Uu = Aa + 128 * 64; float* segA = Uu + 128 * 64; float* segH = segA + 512; float* hc = segH + 512;
    const bf16_t* U = WSP(bf16_t, OFF_U); bf16_t* MIX = WSP(bf16_t, OFF_MIX);
    lds_barrier();
    {
        const bf16_t* WRT = WSP(bf16_t, OFF_WRT); const bf16_t* WIT = WSP(bf16_t, OFF_WIT);
#pragma unroll
        for (int i = 0; i < 4; ++i) {
            const int chk = tid0 + i * 512, r = chk >> 4, c8 = (chk & 15) * 8;
            const bf16_t* src = (r < 64 ? WRT + (size_t)(dh * 64 + r) * 1024 : WIT + (size_t)(dh * 64 + r - 64) * 1024) + k * 128 + c8;
            *(u32x4*)(Wg + r * 136 + c8) = *(const u32x4*)src;
        }
        if (tid0 < 64) hc[tid0] = 0.f;
    }
    float sp[4], br[4], bi[4];
#pragma unroll
    for (int ct = 0; ct < 4; ++ct) { const int chd = k * 128 + dh * 64 + ct * 16 + (tid0 & 15); sp[ct] = softplus(-P.in[18][chd]); br[ct] = P.in[15][chd]; bi[ct] = P.in[17][chd]; }
    const int ch0 = k * 128 + (tid0 & 31) * 4;
    float cw[4][4], cbias[4];
#pragma unroll
    for (int kk = 0; kk < 4; ++kk)
#pragma unroll
        for (int e = 0; e < 4; ++e) cw[kk][e] = P.in[12][kk * 1024 + ch0 + e];
#pragma unroll
    for (int e = 0; e < 4; ++e) cbias[e] = P.in[13][ch0 + e];
    u32x2 raw[11];
#define RG_LOAD(tl_) do { const int tg_ = (tl_) * 128 + (tid0 >> 5) * 8; const unsigned vo_ = (unsigned)((b * 2048 + tg_) * N0 + ch0); \
        _Pragma("unroll") for (int j = 0; j < 11; ++j) raw[j] = (tg_ + j - 3 >= 0) ? *(const u32x2*)((U + (j - 3) * N0) + vo_) : (u32x2){0u, 0u}; } while (0)
    if (!SAMPLE) RG_LOAD(0);
    const int ntiles = SAMPLE ? 1 : 16;
    for (int tile = 0; tile < ntiles; ++tile) {
        const int row0 = SAMPLE ? MP : b * 2048 + tile * 128;
        lds_barrier();
        int zv = 0; asm volatile("" : "+v"(zv));
        const int tid = tid0 + zv, lane = tid & 63, quad = tid & 31, seg = tid >> 5;
        const int sd = tid & 63, sseg = wid, sch = k * 128 + dh * 64 + sd;
        bf16_t gt[16];
        if (!SAMPLE) {
            const unsigned goff = (unsigned)((row0 + sseg * 16) * N0 + 1024 + sch);
#pragma unroll
            for (int t = 0; t < 16; ++t) gt[t] = (U + t * N0)[goff];
        }
        if (SAMPLE) {
#pragma unroll
            for (int t = 0; t < 8; ++t) {
                const int bb = seg * 8 + t;
                const float* buf = P.in[5] + (size_t)bb * 3 * 1024 + ch0;
                const f32x4 p0 = *(const f32x4*)buf, p1 = *(const f32x4*)(buf + 1024), p2 = *(const f32x4*)(buf + 2048);
                float cur[4]; ld4bf(U + (size_t)(MP + bb) * N0 + ch0, cur);
                float y[4];
#pragma unroll
                for (int e = 0; e < 4; ++e) y[e] = cbias[e] + cw[0][e] * p0[e] + cw[1][e] * p1[e] + cw[2][e] * p2[e] + cw[3][e] * cur[e];
                *(u32x2*)(Xs + bb * 136 + quad * 4) = pack4v(y[0], y[1], y[2], y[3]);
            }
        } else {
#pragma unroll
            for (int j = 0; j < 8; ++j) {
                const float x0[4] = {bflo(raw[j].x), bfhi(raw[j].x), bflo(raw[j].y), bfhi(raw[j].y)};
                const float x1[4] = {bflo(raw[j + 1].x), bfhi(raw[j + 1].x), bflo(raw[j + 1].y), bfhi(raw[j + 1].y)};
                const float x2[4] = {bflo(raw[j + 2].x), bfhi(raw[j + 2].x), bflo(raw[j + 2].y), bfhi(raw[j + 2].y)};
                const float x3[4] = {bflo(raw[j + 3].x), bfhi(raw[j + 3].x), bflo(raw[j + 3].y), bfhi(raw[j + 3].y)};
                float y[4];
#pragma unroll
                for (int e = 0; e < 4; ++e) y[e] = cbias[e] + cw[0][e] * x0[e] + cw[1][e] * x1[e] + cw[2][e] * x2[e] + cw[3][e] * x3[e];
                *(u32x2*)(Xs + (seg * 8 + j) * 136 + quad * 4) = pack4v(y[0], y[1], y[2], y[3]);
            }
            if (tile + 1 < 16) RG_LOAD(tile + 1);
        }
        lds_barrier();
        {
            f32x4 acc[8];
#pragma unroll
            for (int i = 0; i < 8; ++i) acc[i] = (f32x4){0.f, 0.f, 0.f, 0.f};
#pragma unroll
            for (int ks = 0; ks < 4; ++ks) {
                const bf16x8 a = ldfrag16(Xs, 136, wid * 16, ks * 32, lane);
#pragma unroll
                for (int tl = 0; tl < 8; ++tl) acc[tl] = MFMA16(a, ldfrag16(Wg, 136, tl * 16, ks * 32, lane), acc[tl]);
            }
#pragma unroll
            for (int ct = 0; ct < 4; ++ct)
#pragma unroll
                for (int reg = 0; reg < 4; ++reg) {
                    const int t = wid * 16 + (lane >> 4) * 4 + reg, d = ct * 16 + (lane & 15);
                    const float r = sigm(acc[ct][reg] + br[ct]), gi = sigm(acc[4 + ct][reg] + bi[ct]);
                    const float a = __expf(-8.f * r * sp[ct]);
                    const float uu = __builtin_amdgcn_sqrtf(fmaxf(1.f - a * a, 0.f)) * gi * bf2f(Xs[t * 136 + dh * 64 + d]);
                    if (SAMPLE) {
                        const int chd = k * 128 + dh * 64 + d;
                        const float hn = a * P.in[4][(size_t)t * 1024 + chd] + uu;
                        P.out[O_AHS + (size_t)t * 1024 + chd] = hn;
                        const float gv = bf2f(U[(size_t)(MP + t) * N0 + 1024 + chd]);
                        MIX[(size_t)(MP + t) * 2048 + chd] = f2bf(hn * silu(gv));
                    } else { Aa[t * 64 + d] = a; Uu[t * 64 + d] = uu; }
                }
        }
        if (!SAMPLE) {
            lds_barrier();
            float av[16], uv[16], Ap = 1.f, Hp = 0.f;
#pragma unroll
            for (int t = 0; t < 16; ++t) { av[t] = Aa[(sseg * 16 + t) * 64 + sd]; uv[t] = Uu[(sseg * 16 + t) * 64 + sd]; Hp = av[t] * Hp + uv[t]; Ap *= av[t]; }
            segA[sseg * 64 + sd] = Ap; segH[sseg * 64 + sd] = Hp;
            lds_barrier();
            float hin = hc[sd];
            for (int s2 = 0; s2 < sseg; ++s2) hin = segA[s2 * 64 + sd] * hin + segH[s2 * 64 + sd];
            const unsigned moff = (unsigned)((row0 + sseg * 16) * 2048 + sch);
#pragma unroll
            for (int t = 0; t < 16; ++t) {
                hin = av[t] * hin + uv[t];
                (MIX + t * 2048)[moff] = f2bf(hin * silu(bf2f(gt[t])));
            }
            lds_barrier();
            if (sseg == 7) hc[sd] = hin;
        }
    }
#undef RG_LOAD
    if (!SAMPLE) { lds_barrier(); if (tid0 < 64) P.out[O_AHP + (size_t)b * 1024 + k * 128 + dh * 64 + tid0] = hc[tid0]; }
}
DI void phase_mix0(const Params& P, unsigned char* L) {
    const int tid = otid(), bid = blockIdx.x, G = gridDim.x;
    { const bf16_t* U = WSP(bf16_t, OFF_U);
      for (int i = bid * 512 + tid; i < 8 * 3 * 1024; i += G * 512) { const int c = i & 1023, j = (i >> 10) % 3, b = i / 3072; P.out[O_ACP + i] = bf2f(U[(size_t)(b * 2048 + 2045 + j) * N0 + c]); }
      for (int i = bid * 512 + tid; i < 8 * 3 * 1536; i += G * 512) { const int c = i % 1536, j = (i / 1536) % 3, b = i / 4608; P.out[O_BCP + i] = bf2f(U[(size_t)(b * 2048 + 2045 + j) * N0 + 3072 + c]); }
      for (int i = bid * 512 + tid; i < 128 * 3 * 1024; i += G * 512) { const int c = i & 1023, j = (i >> 10) % 3, b = i / 3072; P.out[O_ACS + i] = j < 2 ? P.in[5][(size_t)(b * 3 + j + 1) * 1024 + c] : bf2f(U[(size_t)(MP + b) * N0 + c]); }
      for (int i = bid * 512 + tid; i < 128 * 3 * 1536; i += G * 512) { const int c = i % 1536, j = (i / 1536) % 3, b = i / 4608; P.out[O_BCS + i] = j < 2 ? P.in[7][(size_t)(b * 3 + j + 1) * 1536 + c] : bf2f(U[(size_t)(MP + b) * N0 + 3072 + c]); } }
    if (bid < 128) { const int x = bid & 7, j = bid >> 3; rglru_item<false>(P, L, (x + 8 * (j >> 1)) * 2 + (j & 1)); }
    else if (bid < 256) { const int x = bid & 7, j = (bid - 128) >> 3, grp = x + 8 * (j >> 3); ssd_prompt_item(P, L, (grp >> 1) * 16 + (grp & 1) * 8 + (j & 7)); }
    unsigned* ctr = WSP(unsigned, OFF_CTL);
    unsigned* bc = (unsigned*)(L + LDS_BYTES - 16);
    for (;;) {
        __syncthreads();
        if (tid == 0) bc[0] = atomicAdd(ctr, 1u);
        __syncthreads();
        const unsigned it = bc[0];
        if (it >= 16u + 512u) break;
        if (it < 16u) rglru_item<true>(P, L, (int)it); else ssd_sample_item4(P, L, (int)(it - 16u));
    }
    for (;;) {
        __syncthreads();
        if (tid == 0) bc[0] = atomicAdd(ctr + 32, 1u);
        __syncthreads();
        const unsigned q = bc[0];
        if (q >= 256u + 104u + 130u) break;
        if (q < 256u) l1_weight_tile(P, (int)q * 8 + (tid >> 6), (float*)L + (tid >> 6) * (64 * 65), tid & 63);
        else if (q < 360u) l1_weight_tile(P, 2880 + ((int)q - 256) * 8 + (tid >> 6), (float*)L + (tid >> 6) * (64 * 65), tid & 63);
        else convert_p_chunk(P, 0, (int)q - 360, tid);
    }
}
DI void phase_norm0(const Params& P) {
    bf16_t* MIX = WSP(bf16_t, OFF_MIX); const float* SSB = WSP(float, OFF_SSB);
    for (int i = blockIdx.x * 512 + threadIdx.x; i < MV * 128; i += gridDim.x * 512) {
        const int row = i >> 7, c8 = (i & 127) * 8, g = c8 >> 9;
        const float sc = rsqrtf(SSB[(size_t)row * 2 + g] * (1.f / 512.f) + EPSF);
        uint4* p = (uint4*)(MIX + (size_t)row * 2048 + 1024 + c8); uint4 w = *p;
        w.x = pack2(bflo(w.x) * sc, bfhi(w.x) * sc); w.y = pack2(bflo(w.y) * sc, bfhi(w.y) * sc); w.z = pack2(bflo(w.z) * sc, bfhi(w.z) * sc); w.w = pack2(bflo(w.w) * sc, bfhi(w.w) * sc);
        *p = w;
    }
}

DI void hgrn_prompt_item(const Params& P, unsigned char* L, int item) {
    const int b = item >> 4, h = item & 15;
    const int tid = otid(), lane = tid & 63, wid = tid >> 6, hh = lane >> 5, l31 = lane & 31;
    bf16_t* Qs = (bf16_t*)L;
    bf16_t* Ks = Qs + 64 * 136;
    bf16_t* KsT = Ks + 64 * 136;
    bf16_t* VsT = KsT + 128 * 72;
    bf16_t* SsT = VsT + 128 * 72;
    bf16_t* As = SsT + 128 * 136;
    float* Gseg = (float*)(As + 64 * 72);
    float* E1 = Gseg + 16 * 128; float* E2 = E1 + 128;
    float* Of = E2 + 128;
    const bf16_t* U = WSP(bf16_t, OFF_U); bf16_t* MIX = WSP(bf16_t, OFF_MIX);
    const int kq = tid & 31, ts = tid >> 5;
    float lb[4];
#pragma unroll
    for (int e = 0; e < 4; ++e) { const int ch = h * 128 + kq * 4 + e; lb[e] = sigm(P.in[27][2048 + ch] - P.in[27][ch]); }
    const int kb = (wid >> 1) * 32, vb0 = (wid & 1) * 64;
    f32x16 accS[2];
#pragma unroll
    for (int i = 0; i < 16; ++i) { accS[0][i] = 0.f; accS[1][i] = 0.f; }
    uint2 rq[4], rf[4], rv[4];
#define HG_LOAD(cc) do { _Pragma("unroll") for (int i = 0; i < 4; ++i) { const bf16_t* bp = U + (size_t)(b * 2048 + (cc) * 64 + ts * 4 + i) * INC + h * 128 + kq * 4; \
        rq[i] = *(const uint2*)bp; rf[i] = *(const uint2*)(bp + 2048); rv[i] = *(const uint2*)(bp + 4096); } } while (0)
    HG_LOAD(0);
    lds_barrier();
    float kk[4][4], cs[4][4];
    {
#pragma unroll
        for (int i = 0; i < 4; ++i) {
            const float fx[4] = {bflo(rf[i].x), bfhi(rf[i].x), bflo(rf[i].y), bfhi(rf[i].y)};
#pragma unroll
            for (int e = 0; e < 4; ++e) {
                const float sg = sigm(fx[e]); const float kv = (1.f - lb[e]) * (1.f - sg);
                kk[i][e] = kv; const float gl = __logf(1.f - kv);
                cs[i][e] = (i == 0 ? 0.f : cs[i - 1][e]) + gl;
            }
        }
        *(f32x4*)(Gseg + ts * 128 + kq * 4) = (f32x4){cs[3][0], cs[3][1], cs[3][2], cs[3][3]};
    }
    lds_barrier();
    for (int c = 0; c < 32; ++c) {
        u32x4 gpre0, gpre1;
        { const bf16_t* gp = U + (size_t)(b * 2048 + c * 64 + (tid >> 3)) * INC + 6144 + h * 128 + (tid & 7) * 16; gpre0 = *(const u32x4*)gp; gpre1 = *(const u32x4*)(gp + 8); }
        f32x4 off = {0.f, 0.f, 0.f, 0.f}, gmid = off, glast = off;
        {
            const int swid = __builtin_amdgcn_readfirstlane(tid >> 6);
            f32x4 pre = {0.f, 0.f, 0.f, 0.f};
#pragma unroll
            for (int s = 0; s < 16; ++s) {
                const f32x4 v = *(const f32x4*)(Gseg + s * 128 + kq * 4);
                if (s == 2 * swid) off = pre;
                if (s == 8) gmid = pre;
                pre += v;
            }
            glast = pre;
            if (ts & 1) off += *(const f32x4*)(Gseg + (ts - 1) * 128 + kq * 4);
        }
        {
            float qt[4][4], kt[4][4], vt[4][4];
#pragma unroll
            for (int i = 0; i < 4; ++i) {
                const float q[4] = {bflo(rq[i].x), bfhi(rq[i].x), bflo(rq[i].y), bfhi(rq[i].y)};
                vt[i][0] = bflo(rv[i].x); vt[i][1] = bfhi(rv[i].x); vt[i][2] = bflo(rv[i].y); vt[i][3] = bfhi(rv[i].y);
#pragma unroll
                for (int e = 0; e < 4; ++e) { const float Gv = off[e] + cs[i][e]; const float ex = __expf(Gv - gmid[e]); qt[i][e] = q[e] * 0.08838834764831845f * ex; kt[i][e] = kk[i][e] * frcp(ex); }
                *(uint2*)(Qs + (ts * 4 + i) * 136 + kq * 4) = pack4(qt[i][0], qt[i][1], qt[i][2], qt[i][3]);
                *(uint2*)(Ks + (ts * 4 + i) * 136 + kq * 4) = pack4(kt[i][0], kt[i][1], kt[i][2], kt[i][3]);
            }
#pragma unroll
            for (int e = 0; e < 4; ++e) {
                *(uint2*)(KsT + (kq * 4 + e) * 72 + ts * 4) = pack4(kt[0][e], kt[1][e], kt[2][e], kt[3][e]);
                *(uint2*)(VsT + (kq * 4 + e) * 72 + ts * 4) = pack4(vt[0][e], vt[1][e], vt[2][e], vt[3][e]);
            }
            if (ts == 0) {
#pragma unroll
                for (int e = 0; e < 4; ++e) { E1[kq * 4 + e] = __expf(gmid[e]); E2[kq * 4 + e] = __expf(glast[e] - gmid[e]); }
            }
        }
        if (c + 1 < 32) HG_LOAD(c + 1);
        lds_barrier();
#pragma unroll
        for (int j = 0; j < 2; ++j) {
#pragma unroll
            for (int reg = 0; reg < 16; ++reg) accS[j][reg] *= E1[kb + crow(reg, hh)];
            const int v = vb0 + j * 32 + l31;
#pragma unroll
            for (int rg = 0; rg < 4; ++rg) *(uint2*)(SsT + v * 136 + kb + 8 * rg + 4 * hh) = pack4(accS[j][4 * rg], accS[j][4 * rg + 1], accS[j][4 * rg + 2], accS[j][4 * rg + 3]);
        }
        if (wid < 4) {
            const int tb = (wid >> 1) * 32, sb = (wid & 1) * 32;
            f32x16 aa;
#pragma unroll
            for (int i = 0; i < 16; ++i) aa[i] = 0.f;
#pragma unroll
            for (int ks = 0; ks < 8; ++ks) aa = MFMA32(ldfrag(Qs, 136, tb, ks * 16, lane), ldfrag(Ks, 136, sb, ks * 16, lane), aa);
            const int s = sb + l31;
#pragma unroll
            for (int reg = 0; reg < 16; ++reg) { const int t = tb + crow(reg, hh); As[t * 72 + s] = f2bf(s <= t ? aa[reg] : 0.f); }
        }
        lds_barrier();
        const int tb2 = (wid >> 2) * 32, vb2 = (wid & 3) * 32;
        f32x16 o, o2;
#pragma unroll
        for (int i = 0; i < 16; ++i) { o[i] = 0.f; o2[i] = 0.f; }
#pragma unroll
        for (int ks = 0; ks < 8; ++ks) o = MFMA32(ldfrag(Qs, 136, tb2, ks * 16, lane), ldfrag(SsT, 136, vb2, ks * 16, lane), o);
#pragma unroll
        for (int ks = 0; ks < 4; ++ks) o2 = MFMA32(ldfrag(As, 72, tb2, ks * 16, lane), ldfrag(VsT, 72, vb2, ks * 16, lane), o2);
#pragma unroll
        for (int i = 0; i < 16; ++i) o[i] += o2[i];
#pragma unroll
        for (int j = 0; j < 2; ++j) {
#pragma unroll
            for (int ks = 0; ks < 4; ++ks) accS[j] = MFMA32(ldfrag(KsT, 72, kb, ks * 16, lane), ldfrag(VsT, 72, vb0 + j * 32, ks * 16, lane), accS[j]);
#pragma unroll
            for (int reg = 0; reg < 16; ++reg) accS[j][reg] *= E2[kb + crow(reg, hh)];
        }
#pragma unroll
        for (int reg = 0; reg < 16; ++reg) Of[(tb2 + crow(reg, hh)) * 132 + vb2 + l31] = o[reg];
        if (c + 1 < 32) {
#pragma unroll
        for (int i = 0; i < 4; ++i) {
            const float fx[4] = {bflo(rf[i].x), bfhi(rf[i].x), bflo(rf[i].y), bfhi(rf[i].y)};
#pragma unroll
            for (int e = 0; e < 4; ++e) {
                const float sg = sigm(fx[e]); const float kv = (1.f - lb[e]) * (1.f - sg);
                kk[i][e] = kv; const float gl = __logf(1.f - kv);
                cs[i][e] = (i == 0 ? 0.f : cs[i - 1][e]) + gl;
            }
        }
        *(f32x4*)(Gseg + ts * 128 + kq * 4) = (f32x4){cs[3][0], cs[3][1], cs[3][2], cs[3][3]};
        }
        lds_barrier();
        {
            const int t = tid >> 3, vs = tid & 7;
            const size_t row = (size_t)(b * 2048 + c * 64 + t);
            f32x4 ov[4]; float ss = 0.f;
#pragma unroll
            for (int i = 0; i < 4; ++i) { ov[i] = *(const f32x4*)(Of + t * 132 + vs * 16 + i * 4); ss += ov[i][0] * ov[i][0] + ov[i][1] * ov[i][1] + ov[i][2] * ov[i][2] + ov[i][3] * ov[i][3]; }
            ss += __shfl_xor(ss, 1); ss += __shfl_xor(ss, 2); ss += __shfl_xor(ss, 4);
            const float rstd = rsqrtf(ss * (1.f / 128.f) + EPSF);
            const float* nwp = P.in[28] + h * 128 + vs * 16;
            const unsigned gw[8] = {gpre0.x, gpre0.y, gpre0.z, gpre0.w, gpre1.x, gpre1.y, gpre1.z, gpre1.w};
            unsigned ow[8];
#pragma unroll
            for (int i = 0; i < 4; ++i) {
                const f32x4 w = *(const f32x4*)(nwp + i * 4);
                ow[2 * i] = pack2(ov[i][0] * rstd * w[0] * silu(bflo(gw[2 * i])), ov[i][1] * rstd * w[1] * silu(bfhi(gw[2 * i])));
                ow[2 * i + 1] = pack2(ov[i][2] * rstd * w[2] * silu(bflo(gw[2 * i + 1])), ov[i][3] * rstd * w[3] * silu(bfhi(gw[2 * i + 1])));
            }
            bf16_t* op = MIX + row * 2048 + h * 128 + vs * 16;
            *(uint4*)op = make_uint4(ow[0], ow[1], ow[2], ow[3]); *(uint4*)(op + 8) = make_uint4(ow[4], ow[5], ow[6], ow[7]);
        }
    }
#undef HG_LOAD
    float* so = P.out + O_CP + (size_t)(b * 16 + h) * 128 * 128;
#pragma unroll
    for (int j = 0; j < 2; ++j)
#pragma unroll
        for (int reg = 0; reg < 16; ++reg) so[(kb + crow(reg, hh)) * 128 + vb0 + j * 32 + l31] = accS[j][reg];
}
DI void hgrn_sample_item(const Params& P, unsigned char* L, int item) {
    const int b = item >> 4, h = item & 15, tid = otid(), lane = tid & 63;
    float* qv = (float*)L; float* egv = qv + 128; float* kkv = egv + 128; float* vv = kkv + 128; float* part = vv + 128; float* red = part + 16 * 128;
    const bf16_t* U = WSP(bf16_t, OFF_U); bf16_t* MIX = WSP(bf16_t, OFF_MIX);
    const size_t row = (size_t)(MP + b); const bf16_t* ub = U + row * INC + h * 128;
    __syncthreads();
    if (tid < 128) {
        const int ch = h * 128 + tid;
        const float lbv = sigm(P.in[27][2048 + ch] - P.in[27][ch]);
        const float sg = sigm(bf2f(ub[2048 + tid])); const float kv = (1.f - lbv) * (1.f - sg);
        qv[tid] = bf2f(ub[tid]) * 0.08838834764831845f; egv[tid] = 1.f - kv; kkv[tid] = kv;
    } else if (tid < 256) vv[tid - 128] = bf2f(ub[4096 + tid - 128]);
    __syncthreads();
    const float* s0 = P.in[8] + (size_t)(b * 16 + h) * 128 * 128; float* s1 = P.out + O_CS + (size_t)(b * 16 + h) * 128 * 128;
    const int v4 = (tid & 31) * 4; const f32x4 vq = *(const f32x4*)(vv + v4);
    f32x4 op = {0.f, 0.f, 0.f, 0.f};
#pragma unroll
    for (int j = 0; j < 8; ++j) {
        const int k = (tid >> 5) + 16 * j;
        const f32x4 s = *(const f32x4*)(s0 + k * 128 + v4);
        const f32x4 sn = s * egv[k] + vq * kkv[k];
        *(f32x4*)(s1 + k * 128 + v4) = sn;
        op += sn * qv[k];
    }
    *(f32x4*)(part + (tid >> 5) * 128 + v4) = op;
    __syncthreads();
    float o = 0.f;
    if (tid < 128) {
#pragma unroll
        for (int i = 0; i < 16; ++i) o += part[i * 128 + tid];
        const float ss = wave_sum(o * o);
        if (lane == 0) red[tid >> 6] = ss;
    }
    __syncthreads();
    if (tid < 128) {
        const float rstd = rsqrtf((red[0] + red[1]) * (1.f / 128.f) + EPSF);
        const int ch = h * 128 + tid;
        MIX[row * 2048 + ch] = f2bf(o * rstd * P.in[28][ch] * silu(bf2f(ub[6144 + tid])));
    }
}
DI void phase_mix1(const Params& P, unsigned char* L) {
    const int tid = otid(), bid = blockIdx.x;
    if (bid < 128) hgrn_prompt_item(P, L, bid);
    else { const int nb = gridDim.x - 128; for (int it = bid - 128; it < 2048; it += nb) hgrn_sample_item(P, L, it); }
    unsigned* ctr = WSP(unsigned, OFF_CTL) + 48;
    unsigned* bc = (unsigned*)(L + LDS_BYTES - 16);
    for (;;) {
        __syncthreads();
        if (tid == 0) bc[0] = atomicAdd(ctr, 1u);
        __syncthreads();
        const unsigned q = bc[0];
        if (q >= 104u + 130u) break;
        if (q < 104u) l1_weight_tile(P, 2048 + (int)q * 8 + (tid >> 6), (float*)L + (tid >> 6) * (64 * 65), tid & 63);
        else convert_p_chunk(P, 1, (int)q - 104, tid);
    }
}
DI void phase_final(const Params& P) {
    const int lane = threadIdx.x & 63, gw = blockIdx.x * 8 + (threadIdx.x >> 6), nwv = gridDim.x * 8;
    const float* H = WSP(float, OFF_H); const float* SS = WSP(float, OFF_SS2); const float* nf = P.in[10];
    f32x4 w4[4];
#pragma unroll
    for (int i = 0; i < 4; ++i) w4[i] = *(const f32x4*)(nf + lane * 4 + 256 * i);
    for (int r0 = gw * 4; r0 < MV; r0 += nwv * 4) {
        f32x4 v[4][4]; float rs[4];
#pragma unroll
        for (int q = 0; q < 4; ++q) { rs[q] = SS[r0 + q];
#pragma unroll
            for (int i = 0; i < 4; ++i) v[q][i] = *(const f32x4*)(H + (size_t)(r0 + q) * 1024 + lane * 4 + 256 * i); }
#pragma unroll
        for (int q = 0; q < 4; ++q) { const float rstd = rsqrtf(rs[q] * (1.f / 1024.f) + EPSF);
#pragma unroll
            for (int i = 0; i < 4; ++i) __builtin_nontemporal_store(v[q][i] * rstd * w4[i], (f32x4*)(P.out + O_Y + (size_t)(r0 + q) * 1024 + lane * 4 + 256 * i)); }
    }
}

#define XB_TMO      128
#define XB_XCNT(j)  (256  + 64 * (j))
#define XB_XSUB(j)  (1280 + 64 * (j))
#define XB_XGEN(j)  (2304 + 64 * (j))
#define XB_TOP      3328
#define XB_TOPGEN   3392
#define XCD_BAR_WORDS 3456
#define XB_SPIN_CAP (1u << 18)

__device__ __forceinline__ unsigned xb_ld(unsigned* p)              { return __hip_atomic_load(p, __ATOMIC_RELAXED, __HIP_MEMORY_SCOPE_AGENT); }
__device__ __forceinline__ unsigned xb_add(unsigned* p, unsigned v) { return __hip_atomic_fetch_add(p, v, __ATOMIC_RELAXED, __HIP_MEMORY_SCOPE_AGENT); }
__device__ __forceinline__ unsigned xb_xcc_id() { return (unsigned)__builtin_amdgcn_s_getreg((3 << 11) | 20) & 0xFu; }
#define XB_SPIN(cond, bar) do { unsigned _sp = 0; while (cond) { __builtin_amdgcn_s_sleep(1); \
    if ((++_sp & 255u) == 0u) { if (xb_ld(&(bar)[XB_TMO])) break; if (_sp > XB_SPIN_CAP) { atomicAdd(&(bar)[XB_TMO], 1u); break; } } } } while (0)

struct XcdBarrier {
    unsigned* bar; unsigned x;
    volatile LAS unsigned* st;
};

__device__ __forceinline__ XcdBarrier xcd_barrier_post(unsigned* bar, volatile LAS unsigned* st) {
    XcdBarrier b; b.bar = bar; b.x = xb_xcc_id(); b.st = st;
    if (threadIdx.x == 0) (void)xb_add(&bar[XB_XCNT(b.x)], 1u);
    return b;
}
__device__ __forceinline__ void xcd_barrier_complete(unsigned* bar, unsigned x, unsigned& nloc, unsigned& nx) {
    const unsigned G = gridDim.x * gridDim.y * gridDim.z;
    unsigned sum, cnt, mine, sp = 0u;
    for (;;) {
        sum = 0u; cnt = 0u; mine = 0u;
#pragma unroll
        for (unsigned j = 0; j < 16; ++j) { const unsigned c = xb_ld(&bar[XB_XCNT(j)]); sum += c; cnt += (c > 0u) ? 1u : 0u; mine = (j == x) ? c : mine; }
        if (sum == G) break;
        __builtin_amdgcn_s_sleep(1);
        if ((++sp & 255u) == 0u) { if (xb_ld(&bar[XB_TMO])) break; if (sp > XB_SPIN_CAP) { atomicAdd(&bar[XB_TMO], 1u); break; } }
    }
    nloc = mine > 0u ? mine : 1u; nx = cnt > 0u ? cnt : 1u;
}

__device__ __forceinline__ void xcd_barrier(const XcdBarrier& b) {
    asm volatile("s_waitcnt vmcnt(0)" ::: "memory");
    __syncthreads();
    if (threadIdx.x == 0) {
        unsigned* bar = b.bar;
        __builtin_amdgcn_s_waitcnt(0);
        unsigned nloc = b.st[0], nx = b.st[1];
        if (nloc == 0u) { xcd_barrier_complete(bar, b.x, nloc, nx); b.st[0] = nloc; b.st[1] = nx; }
        const unsigned old = xb_add(&bar[XB_XSUB(b.x)], 1u);
        const unsigned gen = old / nloc;
        if (old + 1u == (gen + 1u) * nloc) {
            __builtin_amdgcn_fence(__ATOMIC_RELEASE, "agent");
            asm volatile("s_waitcnt vmcnt(0)" ::: "memory");
            const unsigned og = xb_add(&bar[XB_TOP], 1u);
            const unsigned tg = og / nx;
            if (og + 1u == (tg + 1u) * nx) xb_add(&bar[XB_TOPGEN], 1u);
            else XB_SPIN(xb_ld(&bar[XB_TOPGEN]) == tg, bar);
            __builtin_amdgcn_fence(__ATOMIC_ACQUIRE, "agent");
            xb_add(&bar[XB_XGEN(b.x)], 1u);
            asm volatile("s_waitcnt vmcnt(0)" ::: "memory");
        } else {
            XB_SPIN(xb_ld(&bar[XB_XGEN(b.x)]) == gen, bar);
            __builtin_amdgcn_fence(__ATOMIC_ACQUIRE, "agent");
            asm volatile("s_waitcnt vmcnt(0)" ::: "memory");
        }
    }
    __syncthreads();
}


#ifndef PHM
#define PHM 0xFFFF
#endif
typedef const __attribute__((address_space(4))) Params* ParamsK;
DI Params getp() {
    ParamsK pp = (ParamsK)__builtin_amdgcn_kernarg_segment_ptr(); asm volatile("" : "+s"(pp));
    Params P;
#pragma unroll
    for (int i = 0; i < 32; ++i) P.in[i] = pp->in[i];
    P.out = pp->out; P.ws = pp->ws; return P;
}
#define GETP() const Params P = getp()
__global__ void __launch_bounds__(512, 2) fwd_kernel(Params Parg) {
    extern __shared__ __attribute__((aligned(16))) unsigned char lds[];
    cg::grid_group grid = cg::this_grid();
    unsigned char* L = (unsigned char*)lds;
    LAS unsigned char* LL = (LAS unsigned char*)lds;
    volatile LAS unsigned* xst = (volatile LAS unsigned*)(LL + LDS_BYTES - 32);
    if (threadIdx.x < 2) xst[threadIdx.x] = 0u;
    __syncthreads();
    XcdBarrier xb;
    { GETP(); xb = xcd_barrier_post(WSP(unsigned, OFF_BAR), xst); }
    if (PHM & 1) { GETP(); phase_prep(P, L); }
    if (gridDim.y == 0xFFFFu) grid.sync();
    xcd_barrier(xb);
    if (PHM & 2) { GETP(); pg8::StaticOrder S; S.init(MP, N0 + 256, gridDim.x, blockIdx.x); pg8::Gemm g{WSP(bf16_t, OFF_XN), WSP(bf16_t, OFF_W0T), MP, N0 + 256, 1024};
      EpiStoreBf16 E{WSP(bf16_t, OFF_U), N0, nullptr, WSP(float, OFF_DT)}; pg8::gemm_phase(LL, g, S, E); }
    { GETP(); SfU f{WSP(bf16_t, OFF_U), N0, nullptr, WSP(float, OFF_DT)}; sgemm<4>(WSP(bf16_t, OFF_XN), WSP(bf16_t, OFF_W0T), 1024, 145, 64 * 19, f, L); }
    xcd_barrier(xb);
    { GETP(); phase_convbc(P, L); }
    xcd_barrier(xb);
    if (PHM & 4) { GETP(); phase_mix0(P, L); }
    xcd_barrier(xb);
    { GETP(); phase_norm0(P); }
    xcd_barrier(xb);
    if (PHM & 8) { GETP(); pg8::StaticOrder S; S.init(MP, 1024, gridDim.x, blockIdx.x); pg8::Gemm g{WSP(bf16_t, OFF_MIX), WSP(bf16_t, OFF_WO0T), MP, 1024, 2048};
      EpiResid E{P.in[0], P.in[1], WSP(float, OFF_H), WSP(bf16_t, OFF_HB)}; pg8::gemm_phase(LL, g, S, E); }
    { GETP(); SfResid f{P.in[1], WSP(float, OFF_H), WSP(bf16_t, OFF_HB)}; sgemm<4>(WSP(bf16_t, OFF_MIX), WSP(bf16_t, OFF_WO0T), 2048, 32, 256, f, L); }
    xcd_barrier(xb);
    if (PHM & 16) { GETP(); pg8::StaticOrder S; S.init(MP, 1024, gridDim.x, blockIdx.x);
      pg8::Gemm g1{WSP(bf16_t, OFF_HB), WSP(bf16_t, OFF_WG0T), MP, 1024, 1024}; EpiGate E1{WSP(bf16_t, OFF_MIX)}; pg8::gemm_phase(LL, g1, S, E1); }
    { GETP(); SfGate f{WSP(bf16_t, OFF_MIX)};   sgemm<2>(WSP(bf16_t, OFF_HB), WSP(bf16_t, OFF_WG0T), 1024, 32, 256, f, L); }
    if (PHM & 16) { GETP(); pg8::StaticOrder S; S.init(MP, 1024, gridDim.x, blockIdx.x);
      pg8::Gemm g2{WSP(bf16_t, OFF_PB), WSP(bf16_t, OFF_WP0T), MP, 1024, 256};
      EpiPle E2{WSP(float, OFF_H), WSP(bf16_t, OFF_MIX), WSP(bf16_t, OFF_XN), P.in[9] + 1024, WSP(float, OFF_SS1)}; pg8::gemm_phase(LL, g2, S, E2); }
    { GETP(); SfPle f{WSP(float, OFF_H), WSP(bf16_t, OFF_MIX), WSP(bf16_t, OFF_XN), P.in[9] + 1024, WSP(float, OFF_SS1)}; sgemm<2>(WSP(bf16_t, OFF_PB), WSP(bf16_t, OFF_WP0T), 256, 32, 256, f, L); }
    xcd_barrier(xb);
    if (PHM & 32) { GETP(); pg8::StaticOrder S; S.init(MP, INC, gridDim.x, blockIdx.x); pg8::Gemm g{WSP(bf16_t, OFF_XN), WSP(bf16_t, OFF_W1T), MP, INC, 1024};
      EpiStoreBf16 E{WSP(bf16_t, OFF_U), INC, WSP(float, OFF_SS1), nullptr}; pg8::gemm_phase(LL, g, S, E); }
    { GETP(); SfU f{WSP(bf16_t, OFF_U), INC, WSP(float, OFF_SS1), nullptr}; sgemm<4>(WSP(bf16_t, OFF_XN), WSP(bf16_t, OFF_W1T), 1024, 256, 64 * 32, f, L); }
    xcd_barrier(xb);
    if (PHM & 64) { GETP(); phase_mix1(P, L); }
    xcd_barrier(xb);
    if (PHM & 128) { GETP(); pg8::StaticOrder S; S.init(MP, 1024, gridDim.x, blockIdx.x); pg8::Gemm g{WSP(bf16_t, OFF_MIX), WSP(bf16_t, OFF_WO1T), MP, 1024, 2048};
      EpiResid E{WSP(float, OFF_H), WSP(float, OFF_H) + (size_t)MP * 1024, WSP(float, OFF_H), WSP(bf16_t, OFF_HB)}; pg8::gemm_phase(LL, g, S, E); }
    { GETP(); SfResid f{WSP(float, OFF_H) + (size_t)MP * 1024, WSP(float, OFF_H), WSP(bf16_t, OFF_HB)}; sgemm<4>(WSP(bf16_t, OFF_MIX), WSP(bf16_t, OFF_WO1T), 2048, 32, 256, f, L); }
    xcd_barrier(xb);
    if (PHM & 256) { GETP(); pg8::StaticOrder S; S.init(MP, 1024, gridDim.x, blockIdx.x);
      pg8::Gemm g1{WSP(bf16_t, OFF_HB), WSP(bf16_t, OFF_WG1T), MP, 1024, 1024}; EpiGate E1{WSP(bf16_t, OFF_MIX)}; pg8::gemm_phase(LL, g1, S, E1); }
    { GETP(); SfGate f{WSP(bf16_t, OFF_MIX)};   sgemm<2>(WSP(bf16_t, OFF_HB), WSP(bf16_t, OFF_WG1T), 1024, 32, 256, f, L); }
    if (PHM & 256) { GETP(); pg8::StaticOrder S; S.init(MP, 1024, gridDim.x, blockIdx.x);
      pg8::Gemm g2{WSP(bf16_t, OFF_PB + PB_STRIDE), WSP(bf16_t, OFF_WP1T), MP, 1024, 256};
      EpiPle E2{WSP(float, OFF_H), WSP(bf16_t, OFF_MIX), nullptr, nullptr, WSP(float, OFF_SS2)}; pg8::gemm_phase(LL, g2, S, E2); }
    { GETP(); SfPle f{WSP(float, OFF_H), WSP(bf16_t, OFF_MIX), nullptr, nullptr, WSP(float, OFF_SS2)}; sgemm<2>(WSP(bf16_t, OFF_PB + PB_STRIDE), WSP(bf16_t, OFF_WP1T), 256, 32, 256, f, L); }
    xcd_barrier(xb);
    { GETP(); phase_final(P); }
}

extern "C" void kernel_launch(void* const* d_in, const int* in_sizes, int n_in, void* d_out, int out_size, void* d_ws, size_t ws_size, hipStream_t stream) {
    static int grid = 0;
    if (grid == 0) {
        if (n_in != 32 || ws_size < WS_END) { fprintf(stderr, "kernel_launch: need 32 inputs and %zu bytes of workspace (got %d, %zu)\n", (size_t)WS_END, n_in, ws_size); grid = -1; return; }
        int dev = 0, cus = 0, per_cu = 0;
        (void)hipGetDevice(&dev); (void)hipDeviceGetAttribute(&cus, hipDeviceAttributeMultiprocessorCount, dev);
        if (hipFuncSetAttribute((const void*)fwd_kernel, hipFuncAttributeMaxDynamicSharedMemorySize, LDS_BYTES) != hipSuccess) { fprintf(stderr, "kernel_launch: hipFuncSetAttribute failed\n"); grid = -1; return; }
        if (hipOccupancyMaxActiveBlocksPerMultiprocessor(&per_cu, (const void*)fwd_kernel, 512, LDS_BYTES) != hipSuccess || per_cu < 1) { fprintf(stderr, "kernel_launch: occupancy query says %d\n", per_cu); per_cu = 1; }
        (void)hipGetLastError();
        grid = cus;
    }
    if (grid < 0) return;
    Params p{};
    for (int i = 0; i < 32; ++i) p.in[i] = (const float*)d_in[i];
    p.out = (float*)d_out; p.ws = (unsigned char*)d_ws;
    if (hipMemsetAsync((char*)d_ws + OFF_BAR, 0, 16384, stream) != hipSuccess) { fprintf(stderr, "kernel_launch: memset of barrier words failed\n"); return; }
    void* args[] = {&p};
    hipError_t e = hipLaunchCooperativeKernel((const void*)fwd_kernel, dim3(grid), dim3(512), args, LDS_BYTES, stream);
    if (e != hipSuccess) fprintf(stderr, "cooperative launch failed: %s (grid %d)\n", hipGetErrorString(e), grid);
}
```

```cpp
#include <hip/hip_runtime.h>
#include <hip/hip_cooperative_groups.h>
#include <cstdio>
namespace cg = cooperative_groups;

#define LAS __attribute__((address_space(3)))
#define DI __device__ __forceinline__
typedef unsigned short bf16_t;
typedef short bf16x8 __attribute__((ext_vector_type(8)));
typedef float f32x4 __attribute__((ext_vector_type(4)));
typedef float f32x16 __attribute__((ext_vector_type(16)));

constexpr int MP = 16384, MS = 128, MV = MP + MS, MPAD = 16640;
constexpr int DM = 1024, INAB = 4624, N0 = 4608, INC = 8192;
constexpr float EPSF = 1e-6f;
constexpr size_t O_Y = 0, O_AHP = 16908288, O_ACP = 16916480, O_BSP = 16941056, O_BCP = 17989632, O_CP = 18026496,
                 O_AHS = 20123648, O_ACS = 20254720, O_BSS = 20647936, O_BCS = 37425152, O_CS = 38014976;
constexpr size_t al256(size_t x) { return (x + 255) & ~size_t(255); }
constexpr size_t OFF_CTL = 0;
constexpr size_t OFF_BAR = 256;
constexpr size_t OFF_SS1 = 256 + 16384;
constexpr size_t OFF_SS2 = OFF_SS1 + al256((size_t)MPAD * 4);
constexpr size_t OFF_SSB = OFF_SS2 + al256((size_t)MPAD * 4);
constexpr size_t OFF_DT  = OFF_SSB + al256((size_t)MPAD * 8);
constexpr size_t OFF_W0T = OFF_DT + al256((size_t)MV * 16 * 4);
constexpr size_t OFF_WO0T = OFF_W0T + (size_t)(N0 + 256) * 1024 * 2;
constexpr size_t OFF_WG0T = OFF_WO0T + (size_t)1024 * 2048 * 2;
constexpr size_t OFF_WP0T = OFF_WG0T + (size_t)1024 * 1024 * 2;
constexpr size_t OFF_W1T  = OFF_WP0T + (size_t)1024 * 256 * 2;
constexpr size_t OFF_WO1T = OFF_W1T + (size_t)INC * 1024 * 2;
constexpr size_t OFF_WG1T = OFF_WO1T + (size_t)1024 * 2048 * 2;
constexpr size_t OFF_WP1T = OFF_WG1T + (size_t)1024 * 1024 * 2;
constexpr size_t OFF_WRT  = OFF_WP1T + (size_t)1024 * 256 * 2;
constexpr size_t OFF_WIT  = OFF_WRT + (size_t)128 * 1024 * 2;
constexpr size_t OFF_XN   = OFF_WIT + (size_t)128 * 1024 * 2;
constexpr size_t OFF_MIX  = OFF_XN + (size_t)MPAD * 1024 * 2;
constexpr size_t OFF_H    = OFF_MIX + (size_t)MPAD * 2048 * 2;
constexpr size_t OFF_U    = OFF_H + al256((size_t)MV * 1024 * 4);
constexpr size_t OFF_HB   = OFF_U;
constexpr size_t OFF_PB   = OFF_U + al256((size_t)MV * INC * 2);
constexpr size_t PB_STRIDE = (size_t)MPAD * 256 * 2;
constexpr size_t WS_END   = OFF_PB + 2 * PB_STRIDE;
constexpr int LDS_BYTES = 160 * 1024;

struct Params { const float* in[32]; float* out; unsigned char* ws; };
#define WSP(T, off) ((T*)(P.ws + (off)))

typedef __bf16 bf16v2_t __attribute__((ext_vector_type(2)));
typedef float f32v2_t __attribute__((ext_vector_type(2)));
DI unsigned pack2(float lo, float hi) { f32v2_t v = {lo, hi}; bf16v2_t b = __builtin_convertvector(v, bf16v2_t); return __builtin_bit_cast(unsigned, b); }
DI bf16_t f2bf(float f) { return __builtin_bit_cast(bf16_t, (__bf16)f); }
DI float bf2f(bf16_t b) { return __uint_as_float(((unsigned)b) << 16); }
DI float bflo(unsigned w) { return __uint_as_float(w << 16); }
DI float bfhi(unsigned w) { return __uint_as_float(w & 0xFFFF0000u); }
DI float frcp(float x) { return __builtin_amdgcn_rcpf(x); }
DI float sigm(float x) { return frcp(1.f + __expf(-x)); }
DI float silu(float x) { return x * frcp(1.f + __expf(-x)); }
DI float softplus(float x) { return x > 20.f ? x : log1pf(__expf(x)); }
DI float wave_sum(float v) { for (int o = 32; o > 0; o >>= 1) v += __shfl_xor(v, o); return v; }
DI int otid() { int t = threadIdx.x; asm volatile("" : "+v"(t)); return t; }
DI void lds_barrier() { asm volatile("s_waitcnt lgkmcnt(0)" ::: "memory"); __builtin_amdgcn_s_barrier(); asm volatile("" ::: "memory"); }
DI int crow(int reg, int hh) { return (reg & 3) + 8 * (reg >> 2) + 4 * hh; }
DI void ld4bf(const bf16_t* p, float (&o)[4]) { uint2 w = *(const uint2*)p; o[0] = bflo(w.x); o[1] = bfhi(w.x); o[2] = bflo(w.y); o[3] = bfhi(w.y); }
typedef unsigned u32x2 __attribute__((ext_vector_type(2)));
typedef unsigned u32x4 __attribute__((ext_vector_type(4)));
DI u32x2 pack4v(float a, float b, float c, float d) { u32x2 r; r.x = pack2(a, b); r.y = pack2(c, d); return r; }
DI uint2 pack4(float a, float b, float c, float d) { uint2 r; r.x = pack2(a, b); r.y = pack2(c, d); return r; }
#define MFMA32(a, b, c) __builtin_amdgcn_mfma_f32_32x32x16_bf16((a), (b), (c), 0, 0, 0)
#define MFMA16(a, b, c) __builtin_amdgcn_mfma_f32_16x16x32_bf16((a), (b), (c), 0, 0, 0)
DI bf16x8 ldfrag(const bf16_t* base, int ld, int row0, int k0, int lane) { return *(const bf16x8*)(base + (row0 + (lane & 31)) * ld + k0 + 8 * (lane >> 5)); }
DI bf16x8 ldfrag16(const bf16_t* base, int ld, int row0, int k0, int lane) { return *(const bf16x8*)(base + (row0 + (lane & 15)) * ld + k0 + 8 * (lane >> 4)); }

namespace pg8 {
constexpr int BM = 256, BK = 64, HALF = 128, HTB = HALF * BK * 2, STAGE_BYTES = 8 * HTB, NXCD = 8, WGM = 8;
DI int lds_byte(int r, int c) { const int st = (r >> 4) * 2 + (c >> 5), rr = r & 15, cc = c & 31, ob = rr * 64 + cc * 2; return st * 1024 + (ob ^ (((ob >> 9) & 1) << 5)); }
DI void stage_rc(int b, int& R, int& C) { const int st = b / 1024, sb = b % 1024, swz = sb ^ (((sb >> 9) & 1) << 5); R = (st >> 1) * 16 + swz / 64; C = (st & 1) * 32 + (swz % 64) / 2; }
DI int perm32(int rho) { const int n = rho >> 4, i = rho & 15; return 8 * (i >> 2) + 4 * n + (i & 3); }
struct Unit { int pm, pn; };
struct Gemm { const bf16_t* A; const bf16_t* Bt; int M, N, K; };
struct StaticOrder {
    int nM, nN, nwg, G, c;
    DI void init(int M, int N, int G_, int c_) { nM = M / BM; nN = N / BM; nwg = nM * nN; G = G_; c = c_; }
    DI bool next(int i, Unit& u) const {
        const long L = (long)i * G + c; if (L >= nwg) return false;
        int wgid = (int)L; { const int q = nwg / NXCD, r = nwg % NXCD, xcd = wgid % NXCD, off = wgid / NXCD; wgid = (xcd < r ? xcd * (q + 1) : r * (q + 1) + (xcd - r) * q) + off; }
        const int nig = WGM * nN, gid = wgid / nig, fm = gid * WGM, gsz = (nM - fm) < WGM ? (nM - fm) : WGM;
        u.pm = fm + ((wgid % nig) % gsz); u.pn = (wgid % nig) / gsz; return true;
    }
};

template <class Epi>
DI void gemm_phase(LAS unsigned char* lds, const Gemm g, const StaticOrder& S, const Epi& E) {
    const int tid = otid(), wid = __builtin_amdgcn_readfirstlane(tid >> 6), lane = tid & 63, wr = wid >> 2, wc = wid & 3, fr = lane & 15, fq = lane >> 4;
    const int K = g.K, nt = K / BK;
    unsigned voffA[2], voffB[2];
#pragma unroll
    for (int i = 0; i < 2; ++i) { int R, C; stage_rc(tid * 16 + i * 8192, R, C); const int Rb = Epi::PERM ? ((R & ~31) + perm32(R & 31)) : R;
        voffA[i] = (unsigned)(R * K + C) * 2u; voffB[i] = (unsigned)(Rb * K + C) * 2u; }
    const size_t kstep = (size_t)(BK * 2);
    const size_t hstep = (size_t)HALF * K * 2;
    const size_t tstep = 2 * hstep;
    const unsigned ldsw = (unsigned)wid * 1024u;
    const int aoff = lds_byte(wr * 64 + fr, fq * 8), boff = lds_byte(wc * 32 + fr, fq * 8);
#define PG8_SA(b, h) (((b) * 2 + (h)) * HTB)
#define PG8_SB(b, h) ((4 + (b) * 2 + (h)) * HTB)
#define PG8_STAGE(bufoff, gbase, voff) do { _Pragma("unroll") for (int _i = 0; _i < 2; ++_i) \
        __builtin_amdgcn_global_load_lds((const unsigned*)((const char*)(gbase) + (voff)[_i]), (LAS unsigned*)(lds + (bufoff) + ldsw + _i * 8192), 16, 0, 0); } while (0)
#define PG8_LDA(dst, b, h) do { _Pragma("unroll") for (int m = 0; m < 4; ++m) _Pragma("unroll") for (int k = 0; k < 2; ++k) dst[m][k] = *(const LAS bf16x8*)(lds + PG8_SA(b, h) + aoff + m * 2048 + k * 1024); } while (0)
#define PG8_LDB(dst, b, h) do { _Pragma("unroll") for (int n = 0; n < 2; ++n) _Pragma("unroll") for (int k = 0; k < 2; ++k) dst[n][k] = *(const LAS bf16x8*)(lds + PG8_SB(b, h) + boff + n * 2048 + k * 1024); } while (0)
#define PG8_MMA(ai, bj, At, Bt) do { __builtin_amdgcn_s_setprio(1); _Pragma("unroll") for (int m = 0; m < 4; ++m) _Pragma("unroll") for (int n = 0; n < 2; ++n) _Pragma("unroll") for (int k = 0; k < 2; ++k) \
        acc[ai][bj][m][n] = __builtin_amdgcn_mfma_f32_16x16x32_bf16(Bt[n][k], At[m][k], acc[ai][bj][m][n], 0, 0, 0); __builtin_amdgcn_s_setprio(0); } while (0)
#define PG8_WAIT_V(n) asm volatile("s_waitcnt vmcnt(" #n ")" ::: "memory")
#define PG8_WAIT_L(n) asm volatile("s_waitcnt lgkmcnt(" #n ")" ::: "memory")
#define PG8_BAR __builtin_amdgcn_s_barrier()
#define PG8_SCHED __builtin_amdgcn_sched_barrier(0)
    Unit cur, nxt; int ui = 0;
    if (!S.next(0, cur)) return;
    f32x4 acc[2][2][4][2];
#pragma unroll
    for (int a = 0; a < 2; ++a)
#pragma unroll
        for (int b = 0; b < 2; ++b)
#pragma unroll
            for (int m = 0; m < 4; ++m)
#pragma unroll
                for (int n = 0; n < 2; ++n) acc[a][b][m][n] = (f32x4){0.f, 0.f, 0.f, 0.f};
    bf16x8 At[4][2], B0[2][2], B1[2][2];
    const char* cA = (const char*)g.A + (size_t)cur.pm * tstep; const char* cB = (const char*)g.Bt + (size_t)cur.pn * tstep;
    PG8_STAGE(PG8_SB(0, 0), cB, voffB); PG8_STAGE(PG8_SA(0, 0), cA, voffA); PG8_STAGE(PG8_SB(0, 1), cB + hstep, voffB); PG8_STAGE(PG8_SA(0, 1), cA + hstep, voffA);
    if (wr == 1) PG8_BAR;
    PG8_WAIT_V(4); PG8_BAR;
    PG8_STAGE(PG8_SB(1, 0), cB + kstep, voffB); PG8_STAGE(PG8_SA(1, 0), cA + kstep, voffA); PG8_STAGE(PG8_SB(1, 1), cB + hstep + kstep, voffB);
    PG8_WAIT_V(6); PG8_BAR;
    for (;;) {
        const bool has_next = S.next(ui + 1, nxt);
        const char* nA = has_next ? (const char*)g.A + (size_t)nxt.pm * tstep : cA; const char* nB = has_next ? (const char*)g.Bt + (size_t)nxt.pn * tstep : cB;
        for (int t = 0; t < nt; t += 2) {
            const bool last = (t == nt - 2);
            const char* a1 = cA + (size_t)(t + 1) * kstep;
            const char* a2 = last ? nA : cA + (size_t)(t + 2) * kstep; const char* b2 = last ? nB : cB + (size_t)(t + 2) * kstep;
            const char* a3 = a2 + kstep; const char* b3 = b2 + kstep;
            PG8_LDB(B0, 0, 0); PG8_SCHED; PG8_LDA(At, 0, 0); PG8_STAGE(PG8_SA(1, 1), a1 + hstep, voffA);
            PG8_WAIT_L(8); PG8_BAR; PG8_WAIT_L(0); PG8_MMA(0, 0, At, B0); PG8_BAR; PG8_SCHED;
            PG8_LDB(B1, 0, 1); PG8_STAGE(PG8_SB(0, 0), b2, voffB);
            PG8_BAR; PG8_WAIT_L(0); PG8_MMA(0, 1, At, B1); PG8_BAR;
            PG8_LDA(At, 0, 1); PG8_STAGE(PG8_SA(0, 0), a2, voffA);
            PG8_BAR; PG8_WAIT_L(0); PG8_MMA(1, 0, At, B0); PG8_BAR; PG8_SCHED;
            PG8_STAGE(PG8_SB(0, 1), b2 + hstep, voffB);
            PG8_WAIT_V(6); PG8_BAR; PG8_MMA(1, 1, At, B1); PG8_BAR;
            PG8_LDB(B0, 1, 0); PG8_SCHED; PG8_LDA(At, 1, 0); PG8_STAGE(PG8_SA(0, 1), a2 + hstep, voffA);
            PG8_WAIT_L(8); PG8_BAR; PG8_WAIT_L(0); PG8_MMA(0, 0, At, B0); PG8_BAR; PG8_SCHED;
            PG8_LDB(B1, 1, 1); PG8_STAGE(PG8_SB(1, 0), b3, voffB);
            PG8_BAR; PG8_WAIT_L(0); PG8_MMA(0, 1, At, B1); PG8_BAR;
            PG8_LDA(At, 1, 1); PG8_STAGE(PG8_SA(1, 0), a3, voffA);
            PG8_BAR; PG8_WAIT_L(0); PG8_MMA(1, 0, At, B0); PG8_BAR; PG8_SCHED;
            PG8_STAGE(PG8_SB(1, 1), b3 + hstep, voffB);
            PG8_WAIT_V(6); PG8_BAR; PG8_MMA(1, 1, At, B1); PG8_BAR;
        }
        E(acc, cur, wr, wc, fr, fq);
        if (!has_next) break;
#pragma unroll
        for (int a = 0; a < 2; ++a)
#pragma unroll
            for (int b = 0; b < 2; ++b)
#pragma unroll
                for (int m = 0; m < 4; ++m)
#pragma unroll
                    for (int n = 0; n < 2; ++n) acc[a][b][m][n] = (f32x4){0.f, 0.f, 0.f, 0.f};
        cur = nxt; cA = nA; cB = nB; ++ui;
    }
    PG8_WAIT_V(0);
    if (wr == 0) PG8_BAR;
    PG8_BAR;
#undef PG8_SA
#undef PG8_SB
#undef PG8_STAGE
#undef PG8_LDA
#undef PG8_LDB
#undef PG8_MMA
#undef PG8_WAIT_V
#undef PG8_WAIT_L
#undef PG8_BAR
#undef PG8_SCHED
}
}

struct EpiStoreBf16 {
    static constexpr bool PERM = true;
    bf16_t* O; int ldc; const float* ss; float* DT;
    DI void operator()(const f32x4 (&acc)[2][2][4][2], const pg8::Unit& u, int wr, int wc, int fr, int fq) const {
        const int row0 = u.pm * 256 + wr * 64 + fr, col0 = u.pn * 256 + wc * 32 + 8 * fq;
        if (u.pn * 256 >= ldc) {
            if (wc == 0 && fq < 2) {
#pragma unroll
                for (int ai = 0; ai < 2; ++ai)
#pragma unroll
                    for (int m = 0; m < 4; ++m) { const int row = row0 + ai * 128 + m * 16;
                        if (row < MV) { *(f32x4*)(DT + (size_t)row * 16 + 8 * fq) = acc[ai][0][m][0]; *(f32x4*)(DT + (size_t)row * 16 + 8 * fq + 4) = acc[ai][0][m][1]; } }
            }
            return;
        }
#pragma unroll
        for (int ai = 0; ai < 2; ++ai)
#pragma unroll
            for (int m = 0; m < 4; ++m) {
                const int row = row0 + ai * 128 + m * 16;
                if (row < MV) {
                    const float sc = ss ? rsqrtf(ss[row] * (1.f / 1024.f) + EPSF) : 1.f;
                    bf16_t* rp = O + (size_t)row * ldc + col0;
#pragma unroll
                    for (int bj = 0; bj < 2; ++bj) {
                        const f32x4 v0 = acc[ai][bj][m][0] * sc, v1 = acc[ai][bj][m][1] * sc;
                        uint4 w; w.x = pack2(v0[0], v0[1]); w.y = pack2(v0[2], v0[3]); w.z = pack2(v1[0], v1[1]); w.w = pack2(v1[2], v1[3]);
                        *(uint4*)(rp + bj * 128) = w;
                    }
                }
            }
    }
};
struct EpiResid {
    static constexpr bool PERM = false;
    const float* rp_prompt; const float* rp_sample;
    float* H; bf16_t* HB;
    DI void operator()(const f32x4 (&acc)[2][2][4][2], const pg8::Unit& u, int wr, int wc, int fr, int fq) const {
        const int row0 = u.pm * 256 + wr * 64 + fr, col0 = u.pn * 256 + wc * 32 + 4 * fq;
#pragma unroll
        for (int ai = 0; ai < 2; ++ai)
#pragma unroll
            for (int m = 0; m < 4; ++m) {
                const int row = row0 + ai * 128 + m * 16;
                if (row < MV) {
                    const float* rs = (row < MP ? rp_prompt + (size_t)row * 1024 : rp_sample + (size_t)(row - MP) * 1024) + col0;
                    float* hp = H + (size_t)row * 1024 + col0; bf16_t* bp = HB + (size_t)row * 1024 + col0;
#pragma unroll
                    for (int bj = 0; bj < 2; ++bj)
#pragma unroll
                        for (int n = 0; n < 2; ++n) {
                            const int co = bj * 128 + n * 16;
                            const f32x4 v = acc[ai][bj][m][n] + *(const f32x4*)(rs + co);
                            *(f32x4*)(hp + co) = v; *(uint2*)(bp + co) = pack4(v[0], v[1], v[2], v[3]);
                        }
                }
            }
    }
};
struct EpiGate {
    static constexpr bool PERM = false;
    bf16_t* Gt;
    DI void operator()(const f32x4 (&acc)[2][2][4][2], const pg8::Unit& u, int wr, int wc, int fr, int fq) const {
        const int row0 = u.pm * 256 + wr * 64 + fr, col0 = u.pn * 256 + wc * 32 + 4 * fq;
#pragma unroll
        for (int ai = 0; ai < 2; ++ai)
#pragma unroll
            for (int m = 0; m < 4; ++m) {
                const int row = row0 + ai * 128 + m * 16;
                if (row < MV) {
                    bf16_t* gp = Gt + (size_t)row * 1024 + col0;
#pragma unroll
                    for (int bj = 0; bj < 2; ++bj)
#pragma unroll
                        for (int n = 0; n < 2; ++n) {
                            const f32x4 a = acc[ai][bj][m][n];
                            *(uint2*)(gp + bj * 128 + n * 16) = pack4(sigm(a[0]), sigm(a[1]), sigm(a[2]), sigm(a[3]));
                        }
                }
            }
    }
};
struct EpiPle {
    static constexpr bool PERM = false;
    float* H; const bf16_t* Gt; bf16_t* XN; const float* nw; float* SS;
    DI void operator()(const f32x4 (&acc)[2][2][4][2], const pg8::Unit& u, int wr, int wc, int fr, int fq) const {
        const int row0 = u.pm * 256 + wr * 64 + fr, col0 = u.pn * 256 + wc * 32 + 4 * fq;
#pragma unroll
        for (int ai = 0; ai < 2; ++ai)
#pragma unroll
            for (int m = 0; m < 4; ++m) {
                const int row = row0 + ai * 128 + m * 16;
                float ssum = 0.f;
                if (row < MV) {
                    float* hp = H + (size_t)row * 1024 + col0; const bf16_t* gp = Gt + (size_t)row * 1024 + col0;
#pragma unroll
                    for (int bj = 0; bj < 2; ++bj)
#pragma unroll
                        for (int n = 0; n < 2; ++n) {
                            const int co = bj * 128 + n * 16;
                            float gq[4]; ld4bf(gp + co, gq); const f32x4 v = *(const f32x4*)(hp + co) + (f32x4){gq[0], gq[1], gq[2], gq[3]} * acc[ai][bj][m][n];
                            *(f32x4*)(hp + co) = v;
                            ssum += v[0] * v[0] + v[1] * v[1] + v[2] * v[2] + v[3] * v[3];
                            if (XN) { const f32x4 w = *(const f32x4*)(nw + col0 + co); *(uint2*)(XN + (size_t)row * 1024 + col0 + co) = pack4(v[0] * w[0], v[1] * w[1], v[2] * w[2], v[3] * w[3]); }
                        }
                }
                ssum += __shfl_xor(ssum, 16); ssum += __shfl_xor(ssum, 32);
                if (fq == 0 && row < MV) atomicAdd(SS + row, ssum);
            }
    }
};

template <int KS, class F>
DI void sgemm(const bf16_t* A, const bf16_t* Bt, int K, int ncolt, int nwg_main, const F& f, unsigned char* L) {
    constexpr int RT = 8 / KS, NRS = 128 / (16 * RT);
    const int tid = otid(), lane = tid & 63, wid = __builtin_amdgcn_readfirstlane(tid >> 6), rt = wid % RT, ks = wid / RT;
    const int G = gridDim.x, off = nwg_main % G, Kh = K / KS;
    int li = blockIdx.x, nl = G;
    if (off != 0) { if ((int)blockIdx.x < off) return; li = blockIdx.x - off; nl = G - off; }
    float* red = (float*)L;
    for (int t = li; t < ncolt * NRS; t += nl) {
        const int ct = t / NRS, rs = t % NRS;
        const bf16_t* ap = A + (size_t)(MP + rs * 16 * RT + rt * 16 + (lane & 15)) * K + ks * Kh + 8 * (lane >> 4);
        const bf16_t* bp0 = Bt + (size_t)(ct * 32 + (lane & 15)) * K + ks * Kh + 8 * (lane >> 4);
        const bf16_t* bp1 = bp0 + (size_t)16 * K;
        f32x4 acc0 = {0.f, 0.f, 0.f, 0.f}, acc1 = {0.f, 0.f, 0.f, 0.f};
        bf16x8 a0[4], a1[4], p0[4], p1[4], q0[4], q1[4];
#define SG_LOAD(av, pv, qv, kk) do { _Pragma("unroll") for (int q_ = 0; q_ < 4; ++q_) { av[q_] = *(const bf16x8*)(ap + (kk) + q_ * 32); pv[q_] = *(const bf16x8*)(bp0 + (kk) + q_ * 32); qv[q_] = *(const bf16x8*)(bp1 + (kk) + q_ * 32); } } while (0)
#define SG_MMA(av, pv, qv) do { _Pragma("unroll") for (int q_ = 0; q_ < 4; ++q_) { acc0 = MFMA16(av[q_], pv[q_], acc0); acc1 = MFMA16(av[q_], qv[q_], acc1); } } while (0)
        SG_LOAD(a0, p0, q0, 0);
        for (int k0 = 0; k0 < Kh; k0 += 256) {
            if (k0 + 128 < Kh) SG_LOAD(a1, p1, q1, k0 + 128);
            SG_MMA(a0, p0, q0);
            if (k0 + 256 < Kh) SG_LOAD(a0, p0, q0, k0 + 256);
            if (k0 + 128 < Kh) SG_MMA(a1, p1, q1);
        }
#undef SG_LOAD
#undef SG_MMA
        if (ks > 0) { float* rp = red + (((ks - 1) * RT + rt) * 64 + lane) * 8; *(f32x4*)rp = acc0; *(f32x4*)(rp + 4) = acc1; }
        lds_barrier();
        if (ks == 0) {
#pragma unroll
            for (int j = 0; j < KS - 1; ++j) { const float* rp = red + ((j * RT + rt) * 64 + lane) * 8; acc0 += *(const f32x4*)rp; acc1 += *(const f32x4*)(rp + 4); }
#pragma unroll
            for (int reg = 0; reg < 4; ++reg) {
                const int row = MP + rs * 16 * RT + rt * 16 + (lane >> 4) * 4 + reg, col = ct * 32 + (lane & 15);
                f(row, col, acc0[reg], lane); f(row, col + 16, acc1[reg], lane);
            }
        }
        lds_barrier();
    }
}
struct SfU { bf16_t* O; int ldc; const float* ss; float* DT;
    DI void operator()(int row, int col, float v, int) const {
        if (col >= ldc) { if (col < ldc + 16) DT[(size_t)row * 16 + col - ldc] = v; return; }
        const float sc = ss ? rsqrtf(ss[row] * (1.f / 1024.f) + EPSF) : 1.f; O[(size_t)row * ldc + col] = f2bf(v * sc); } };
struct SfResid { const float* rs; float* H; bf16_t* HB;
    DI void operator()(int row, int col, float v, int) const { const float h = rs[(size_t)(row - MP) * 1024 + col] + v; H[(size_t)row * 1024 + col] = h; HB[(size_t)row * 1024 + col] = f2bf(h); } };
struct SfGate { bf16_t* Gt; DI void operator()(int row, int col, float v, int) const { Gt[(size_t)row * 1024 + col] = f2bf(sigm(v)); } };
struct SfPle { float* H; const bf16_t* Gt; bf16_t* XN; const float* nw; float* SS;
    DI void operator()(int row, int col, float v, int lane) const {
        const size_t o = (size_t)row * 1024 + col; const float h = H[o] + bf2f(Gt[o]) * v; H[o] = h;
        if (XN) XN[o] = f2bf(h * nw[col]);
        float ss = h * h; ss += __shfl_xor(ss, 1); ss += __shfl_xor(ss, 2); ss += __shfl_xor(ss, 4); ss += __shfl_xor(ss, 8);
        if ((lane & 15) == 0) atomicAdd(SS + row, ss); } };

DI void transpose_tile_w(const float* src, int lds_, bf16_t* dst, int ldd, int k0, int n0, int nvalid, float* tile, int lane) {
    const float* sp = src + (size_t)k0 * lds_ + n0 + lane;
#pragma unroll
    for (int bt = 0; bt < 4; ++bt) {
        float v[16];
#pragma unroll
        for (int r = 0; r < 16; ++r) v[r] = (lane < nvalid) ? sp[(size_t)(bt * 16 + r) * lds_] : 0.f;
#pragma unroll
        for (int r = 0; r < 16; ++r) tile[(bt * 16 + r) * 65 + lane] = v[r];
    }
    const int koct = lane & 7;
#pragma unroll
    for (int p = 0; p < 8; ++p) {
        const int nn = (lane >> 3) + 8 * p;
        const float* tp = tile + (koct * 8) * 65 + nn;
        uint4 w;
        w.x = pack2(tp[0], tp[65]); w.y = pack2(tp[2 * 65], tp[3 * 65]); w.z = pack2(tp[4 * 65], tp[5 * 65]); w.w = pack2(tp[6 * 65], tp[7 * 65]);
        *(uint4*)(dst + (size_t)(n0 + nn) * ldd + k0 + koct * 8) = w;
    }
}
DI void transpose_job(const float* src, int lds_, bf16_t* dst, int ldd, int K, int N, int nvalid_last, int& base, float* tile, int gw, int nwv, int lane) {
    const int ntn = (N + 63) / 64, nt = (K / 64) * ntn;
    const int first = (gw - (base % nwv) + nwv) % nwv;
    for (int t = first; t < nt; t += nwv) { const int tn = t % ntn; transpose_tile_w(src, lds_, dst, ldd, (t / ntn) * 64, tn * 64, (tn == ntn - 1) ? nvalid_last : 64, tile, lane); }
    base += nt;
}
DI void l1_weight_tile(const Params& P, int t, float* tile, int lane) {
    if (t < 2048) transpose_tile_w(P.in[26], INC, WSP(bf16_t, OFF_W1T), 1024, (t >> 7) * 64, (t & 127) * 64, 64, tile, lane);
    else if (t < 2560) { t -= 2048; transpose_tile_w(P.in[29], 1024, WSP(bf16_t, OFF_WO1T), 2048, (t >> 4) * 64, (t & 15) * 64, 64, tile, lane); }
    else if (t < 2816) { t -= 2560; transpose_tile_w(P.in[31] + 1024 * 1024, 1024, WSP(bf16_t, OFF_WG1T), 1024, (t >> 4) * 64, (t & 15) * 64, 64, tile, lane); }
    else if (t < 2880) { t -= 2816; transpose_tile_w(P.in[30] + 256 * 1024, 1024, WSP(bf16_t, OFF_WP1T), 256, (t >> 4) * 64, (t & 15) * 64, 64, tile, lane); }
    else if (t < 3392) { t -= 2880; transpose_tile_w(P.in[25], 1024, WSP(bf16_t, OFF_WO0T), 2048, (t >> 4) * 64, (t & 15) * 64, 64, tile, lane); }
    else if (t < 3648) { t -= 3392; transpose_tile_w(P.in[31], 1024, WSP(bf16_t, OFF_WG0T), 1024, (t >> 4) * 64, (t & 15) * 64, 64, tile, lane); }
    else { t -= 3648; transpose_tile_w(P.in[30], 1024, WSP(bf16_t, OFF_WP0T), 256, (t >> 4) * 64, (t & 15) * 64, 64, tile, lane); }
}
DI void phase_prep(const Params& P, unsigned char* L) {
    const int tid = otid(), lane = tid & 63, wid = tid >> 6;
    const int gw = blockIdx.x * 8 + wid, nwv = gridDim.x * 8;
    { float* z = WSP(float, OFF_SS1); const int n = (int)((OFF_DT - OFF_SS1) / 4);
      for (int i = blockIdx.x * 512 + tid; i < n; i += gridDim.x * 512) z[i] = 0.f;
      if (blockIdx.x == 0 && tid < 64) WSP(unsigned, OFF_CTL)[tid] = 0u; }
    { float* tile = (float*)L + wid * (64 * 65); int base = 0;
      transpose_job(P.in[11], INAB, WSP(bf16_t, OFF_W0T), 1024, 1024, N0, 64, base, tile, gw, nwv, lane);
      transpose_job(P.in[11] + N0, INAB, WSP(bf16_t, OFF_W0T) + (size_t)N0 * 1024, 1024, 1024, 16, 16, base, tile, gw, nwv, lane);
      transpose_job(P.in[14], 128, WSP(bf16_t, OFF_WRT), 1024, 1024, 128, 64, base, tile, gw, nwv, lane);
      transpose_job(P.in[16], 128, WSP(bf16_t, OFF_WIT), 1024, 1024, 128, 64, base, tile, gw, nwv, lane); }
    { const float* nwp = P.in[9]; bf16_t* XN = WSP(bf16_t, OFF_XN);
      f32x4 w4[4];
#pragma unroll
      for (int i = 0; i < 4; ++i) w4[i] = *(const f32x4*)(nwp + lane * 4 + 256 * i);
      for (int r0 = gw * 2; r0 < MV; r0 += nwv * 2) {
          f32x4 x[2][4];
#pragma unroll
          for (int q = 0; q < 2; ++q) { const int r = r0 + q; const float* src = r < MP ? P.in[0] + (size_t)r * 1024 : P.in[1] + (size_t)(r - MP) * 1024;
#pragma unroll
              for (int i = 0; i < 4; ++i) x[q][i] = *(const f32x4*)(src + lane * 4 + 256 * i); }
#pragma unroll
          for (int q = 0; q < 2; ++q) {
              float ss = 0.f;
#pragma unroll
              for (int i = 0; i < 4; ++i) ss += x[q][i][0] * x[q][i][0] + x[q][i][1] * x[q][i][1] + x[q][i][2] * x[q][i][2] + x[q][i][3] * x[q][i][3];
              ss = wave_sum(ss); const float rstd = rsqrtf(ss * (1.f / 1024.f) + EPSF);
#pragma unroll
              for (int i = 0; i < 4; ++i) { const f32x4 v = x[q][i] * rstd * w4[i]; *(uint2*)(XN + (size_t)(r0 + q) * 1024 + lane * 4 + 256 * i) = pack4(v[0], v[1], v[2], v[3]); }
          }
      } }
}
DI void convert_p_chunk(const Params& P, int layer, int chunk, int tid) {
    bf16_t* PB = WSP(bf16_t, OFF_PB + (size_t)layer * PB_STRIDE);
    const float* pp = P.in[2] + (size_t)layer * MP * 256; const float* ps = P.in[3] + (size_t)layer * MS * 256;
#pragma unroll 4
    for (int j = 0; j < 16; ++j) {
        const int i = chunk * 8192 + j * 512 + tid;
        if (i < MV * 64) {
            const int row = i >> 6, c4 = (i & 63) * 4;
            const f32x4 v = *(const f32x4*)((row < MP ? pp + (size_t)row * 256 : ps + (size_t)(row - MP) * 256) + c4);
            *(uint2*)(PB + (size_t)row * 256 + c4) = pack4(v[0], v[1], v[2], v[3]);
        }
    }
}

constexpr size_t OFF_XT = OFF_XN;
constexpr size_t OFF_CN = OFF_H;
constexpr size_t OFF_BN = OFF_CN + (size_t)MP * 256 * 2;
constexpr size_t OFF_BT = OFF_BN + (size_t)MP * 256 * 2;
DI void phase_convbc(const Params& P, unsigned char* L) {
    const bf16_t* U = WSP(bf16_t, OFF_U);
    bf16_t* XT = WSP(bf16_t, OFF_XT); bf16_t* CN = WSP(bf16_t, OFF_CN); bf16_t* CBG = WSP(bf16_t, OFF_BN); bf16_t* BT = WSP(bf16_t, OFF_BT);
    const int tid = otid();
    for (int task = blockIdx.x; task < 256; task += gridDim.x) {
        const int b = task >> 5, c = (task >> 1) & 15, g = task & 1, lane = tid & 63, wid = tid >> 6, hh = lane >> 5, l31 = lane & 31;
        bf16_t* Cs = (bf16_t*)L; bf16_t* Bs = Cs + 128 * 136;
        const int quad = tid & 63, isC = quad >> 5, n0 = (quad & 31) * 4, cch = 1024 + isC * 256 + g * 128 + n0, t0 = (tid >> 6) * 16, tg0 = c * 128 + t0;
        const size_t tile = ((size_t)((b * 16 + c) * 2 + g)) * 128 * 128;
        float cw[4][4], cbias[4];
#pragma unroll
        for (int kk = 0; kk < 4; ++kk) { const f32x4 w = *(const f32x4*)(P.in[19] + kk * 1536 + cch); cw[kk][0] = w[0]; cw[kk][1] = w[1]; cw[kk][2] = w[2]; cw[kk][3] = w[3]; }
        { const f32x4 w = *(const f32x4*)(P.in[20] + cch); cbias[0] = w[0]; cbias[1] = w[1]; cbias[2] = w[2]; cbias[3] = w[3]; }
        const unsigned voff = (unsigned)((b * 2048 + tg0) * N0 + 3072 + cch);
        u32x2 raw[19];
#pragma unroll
        for (int j = 0; j < 19; ++j) raw[j] = (tg0 + j - 3 >= 0) ? *(const u32x2*)((U + (j - 3) * N0) + voff) : (u32x2){0u, 0u};
        lds_barrier();
        unsigned bt[4][8];
#pragma unroll
        for (int j = 0; j < 16; j += 2) {
            float y[2][4];
#pragma unroll
            for (int q = 0; q < 2; ++q) {
                const float x0[4] = {bflo(raw[j + q].x), bfhi(raw[j + q].x), bflo(raw[j + q].y), bfhi(raw[j + q].y)};
                const float x1[4] = {bflo(raw[j + q + 1].x), bfhi(raw[j + q + 1].x), bflo(raw[j + q + 1].y), bfhi(raw[j + q + 1].y)};
                const float x2[4] = {bflo(raw[j + q + 2].x), bfhi(raw[j + q + 2].x), bflo(raw[j + q + 2].y), bfhi(raw[j + q + 2].y)};
                const float x3[4] = {bflo(raw[j + q + 3].x), bfhi(raw[j + q + 3].x), bflo(raw[j + q + 3].y), bfhi(raw[j + q + 3].y)};
#pragma unroll
                for (int e = 0; e < 4; ++e) y[q][e] = silu(cbias[e] + cw[0][e] * x0[e] + cw[1][e] * x1[e] + cw[2][e] * x2[e] + cw[3][e] * x3[e]);
                const u32x2 pk = pack4v(y[q][0], y[q][1], y[q][2], y[q][3]);
                *(u32x2*)((isC ? Cs : Bs) + (t0 + j + q) * 136 + n0) = pk;
                if (isC) *(u32x2*)(CN + tile + (size_t)(t0 + j + q) * 128 + n0) = pk;
            }
#pragma unroll
            for (int e = 0; e < 4; ++e) bt[e][j >> 1] = pack2(y[0][e], y[1][e]);
        }
        if (!isC) {
#pragma unroll
            for (int e = 0; e < 4; ++e) { bf16_t* dp = BT + tile + (size_t)(n0 + e) * 128 + t0;
                *(u32x4*)dp = (u32x4){bt[e][0], bt[e][1], bt[e][2], bt[e][3]}; *(u32x4*)(dp + 8) = (u32x4){bt[e][4], bt[e][5], bt[e][6], bt[e][7]}; }
        }
        lds_barrier();
        const int rb = (wid >> 1) * 32, cb0 = (wid & 1) * 64;
        f32x16 cbA[2];
#pragma unroll
        for (int i = 0; i < 16; ++i) { cbA[0][i] = 0.f; cbA[1][i] = 0.f; }
#pragma unroll
        for (int ks = 0; ks < 8; ++ks) {
            const bf16x8 a = ldfrag(Cs, 136, rb, ks * 16, lane);
            cbA[0] = MFMA32(a, ldfrag(Bs, 136, cb0, ks * 16, lane), cbA[0]);
            cbA[1] = MFMA32(a, ldfrag(Bs, 136, cb0 + 32, ks * 16, lane), cbA[1]);
        }
#pragma unroll
        for (int j = 0; j < 2; ++j)
#pragma unroll
            for (int reg = 0; reg < 16; ++reg) CBG[tile + (size_t)(rb + crow(reg, hh)) * 128 + cb0 + j * 32 + l31] = f2bf(cbA[j][reg]);
        lds_barrier();
    }
    for (int idx = blockIdx.x * 512 + tid; idx < 2048 * 256; idx += gridDim.x * 512) {
        const int quad = idx & 255, tgp = idx >> 8, b = tgp >> 8, t0 = (tgp & 255) * 8, cch = quad * 4;
        float cw[4][4], cbias[4];
#pragma unroll
        for (int kk = 0; kk < 4; ++kk) { const f32x4 w = *(const f32x4*)(P.in[19] + kk * 1536 + cch); cw[kk][0] = w[0]; cw[kk][1] = w[1]; cw[kk][2] = w[2]; cw[kk][3] = w[3]; }
        { const f32x4 w = *(const f32x4*)(P.in[20] + cch); cbias[0] = w[0]; cbias[1] = w[1]; cbias[2] = w[2]; cbias[3] = w[3]; }
        const unsigned voff = (unsigned)((b * 2048 + t0) * N0 + 3072 + cch);
        u32x2 raw[11];
#pragma unroll
        for (int j = 0; j < 11; ++j) raw[j] = (t0 + j - 3 >= 0) ? *(const u32x2*)((U + (j - 3) * N0) + voff) : (u32x2){0u, 0u};
        float y[8][4];
#pragma unroll
        for (int j = 0; j < 8; ++j) {
            const float x0[4] = {bflo(raw[j].x), bfhi(raw[j].x), bflo(raw[j].y), bfhi(raw[j].y)};
            const float x1[4] = {bflo(raw[j + 1].x), bfhi(raw[j + 1].x), bflo(raw[j + 1].y), bfhi(raw[j + 1].y)};
            const float x2[4] = {bflo(raw[j + 2].x), bfhi(raw[j + 2].x), bflo(raw[j + 2].y), bfhi(raw[j + 2].y)};
            const float x3[4] = {bflo(raw[j + 3].x), bfhi(raw[j + 3].x), bflo(raw[j + 3].y), bfhi(raw[j + 3].y)};
#pragma unroll
            for (int e = 0; e < 4; ++e) y[j][e] = silu(cbias[e] + cw[0][e] * x0[e] + cw[1][e] * x1[e] + cw[2][e] * x2[e] + cw[3][e] * x3[e]);
        }
        const int c = t0 >> 7, tl = t0 & 127;
#pragma unroll
        for (int e = 0; e < 4; ++e) *(u32x4*)(XT + ((size_t)((b * 16 + c) * 1024 + cch + e)) * 128 + tl) = (u32x4){pack2(y[0][e], y[1][e]), pack2(y[2][e], y[3][e]), pack2(y[4][e], y[5][e]), pack2(y[6][e], y[7][e])};
    }
}
DI void ssd_prompt_item(const Params& P, unsigned char* L, int item) {
    const int b = item >> 4, h = item & 15, g = h >> 3;
    const int tid0 = otid(), wid = tid0 >> 6;
    bf16_t* Cs = (bf16_t*)L;
    bf16_t* Ws = Cs + 128 * 136;
    bf16_t* BsT = Ws + 128 * 136;
    bf16_t* XsT = BsT + 128 * 136;
    bf16_t* St = XsT + 64 * 136;
    bf16_t* XwT = St + 64 * 136;
    float* dtvB = (float*)(XwT + 64 * 136); float* acsB = dtvB + 256; float* wvB = acsB + 256;
    const bf16_t* U = WSP(bf16_t, OFF_U); const float* DT = WSP(float, OFF_DT); bf16_t* MIX = WSP(bf16_t, OFF_MIX); float* SSB = WSP(float, OFF_SSB);
    const float a_neg = -__expf(P.in[22][h]), dtb = P.in[21][h], Dh = P.in[23][h];
    f32x16 accS;
#pragma unroll
    for (int i = 0; i < 16; ++i) accS[i] = 0.f;
    lds_barrier();
    for (int i = tid0; i < 64 * 136; i += 512) St[i] = 0;
    float dtr0 = 0.f, dtr1 = 0.f;
#define SSD_DTLOAD(cc) do { if (wid == 0) { const float* dp_ = DT + (size_t)(b * 2048 + (cc) * 128 + (tid0 & 63)) * 16 + h; dtr0 = dp_[0]; dtr1 = dp_[64 * 16]; } } while (0)
#define SSD_SCAN(buf) do { if (wid == 0) { const int ln_ = tid0 & 63; const float d0_ = softplus(dtr0 + dtb), d1_ = softplus(dtr1 + dtb); float v0_ = d0_ * a_neg, v1_ = d1_ * a_neg; \
        _Pragma("unroll") for (int o_ = 1; o_ < 64; o_ <<= 1) { const float n0_ = __shfl_up(v0_, o_), n1_ = __shfl_up(v1_, o_); if (ln_ >= o_) { v0_ += n0_; v1_ += n1_; } } \
        v1_ += __shfl(v0_, 63); const float al_ = __shfl(v1_, 63); \
        dtvB[(buf) * 128 + ln_] = d0_; dtvB[(buf) * 128 + 64 + ln_] = d1_; acsB[(buf) * 128 + ln_] = v0_; acsB[(buf) * 128 + 64 + ln_] = v1_; \
        wvB[(buf) * 128 + ln_] = __expf(al_ - v0_) * d0_; wvB[(buf) * 128 + 64 + ln_] = __expf(al_ - v1_) * d1_; } } while (0)
    SSD_DTLOAD(0); SSD_SCAN(0); SSD_DTLOAD(1);
    u32x4 tC[4], tB[4], tT[4], tX[2];
    for (int c = 0; c < 16; ++c) {
        const int row0 = b * 2048 + c * 128;
        lds_barrier();
        int zv = 0; asm volatile("" : "+v"(zv));
        const int tid = tid0 + zv, lane = tid & 63, hh = lane >> 5, l31 = lane & 31;
        const int prow = tid >> 4, pcol = (tid & 15) * 8;
        const float* dtv = dtvB + (c & 1) * 128; const float* acs = acsB + (c & 1) * 128; const float* wv = wvB + (c & 1) * 128;
        if (c + 1 < 16) { SSD_SCAN((c + 1) & 1); if (c + 2 < 16) SSD_DTLOAD(c + 2); }
        if (c == 0) {
            const size_t tb_ = ((size_t)((b * 16 + c) * 2 + g)) * 128 * 128 + (size_t)prow * 128 + pcol;
            const u32x4* pc = (const u32x4*)(WSP(bf16_t, OFF_CN) + tb_); const u32x4* pb = (const u32x4*)(WSP(bf16_t, OFF_BN) + tb_); const u32x4* pt = (const u32x4*)(WSP(bf16_t, OFF_BT) + tb_);
            const u32x4* px = (const u32x4*)(WSP(bf16_t, OFF_XT) + ((size_t)((b * 16 + c) * 1024 + h * 64 + prow)) * 128 + pcol);
#pragma unroll
            for (int i = 0; i < 4; ++i) { tC[i] = pc[i * 512]; tB[i] = pb[i * 512]; tT[i] = pt[i * 512]; }
            tX[0] = px[0]; tX[1] = px[512];
        }
        const float a_last = acs[127];
        float asv[8], dsv[8];
        { const f32x4 a0 = *(const f32x4*)(acs + pcol), a1 = *(const f32x4*)(acs + pcol + 4), d0 = *(const f32x4*)(dtv + pcol), d1 = *(const f32x4*)(dtv + pcol + 4);
#pragma unroll
          for (int q = 0; q < 4; ++q) { asv[q] = a0[q]; asv[q + 4] = a1[q]; dsv[q] = d0[q]; dsv[q + 4] = d1[q]; } }
#pragma unroll
        for (int i = 0; i < 4; ++i) {
            *(u32x4*)(Cs + (prow + 32 * i) * 136 + pcol) = tC[i]; *(u32x4*)(BsT + (prow + 32 * i) * 136 + pcol) = tT[i];
            {
                const int t = prow + 32 * i; const float at = acs[t];
                const unsigned cw_[4] = {tB[i].x, tB[i].y, tB[i].z, tB[i].w};
                float wv_[8];
#pragma unroll
                for (int q = 0; q < 8; ++q) { const int sidx = pcol + q; const float cbv = (q & 1) ? bfhi(cw_[q >> 1]) : bflo(cw_[q >> 1]);
                    wv_[q] = (sidx <= t) ? cbv * __expf(at - asv[q]) * dsv[q] : 0.f; }
                *(u32x4*)(Ws + t * 136 + pcol) = (u32x4){pack2(wv_[0], wv_[1]), pack2(wv_[2], wv_[3]), pack2(wv_[4], wv_[5]), pack2(wv_[6], wv_[7])};
            }
        }
        *(u32x4*)(XsT + prow * 136 + pcol) = tX[0]; *(u32x4*)(XsT + (prow + 32) * 136 + pcol) = tX[1];
        {
            const f32x4 w0 = *(const f32x4*)(wv + pcol), w1 = *(const f32x4*)(wv + pcol + 4);
            u32x4 oa, ob; const u32x4 xa = tX[0], xb_ = tX[1];
            oa.x = pack2(bflo(xa.x) * w0[0], bfhi(xa.x) * w0[1]); oa.y = pack2(bflo(xa.y) * w0[2], bfhi(xa.y) * w0[3]); oa.z = pack2(bflo(xa.z) * w1[0], bfhi(xa.z) * w1[1]); oa.w = pack2(bflo(xa.w) * w1[2], bfhi(xa.w) * w1[3]);
            ob.x = pack2(bflo(xb_.x) * w0[0], bfhi(xb_.x) * w0[1]); ob.y = pack2(bflo(xb_.y) * w0[2], bfhi(xb_.y) * w0[3]); ob.z = pack2(bflo(xb_.z) * w1[0], bfhi(xb_.z) * w1[1]); ob.w = pack2(bflo(xb_.w) * w1[2], bfhi(xb_.w) * w1[3]);
            *(u32x4*)(XwT + prow * 136 + pcol) = oa; *(u32x4*)(XwT + (prow + 32) * 136 + pcol) = ob;
        }
        if (c + 1 < 16) {
            const size_t tb_ = ((size_t)((b * 16 + c + 1) * 2 + g)) * 128 * 128 + (size_t)prow * 128 + pcol;
            const u32x4* pc = (const u32x4*)(WSP(bf16_t, OFF_CN) + tb_); const u32x4* pb = (const u32x4*)(WSP(bf16_t, OFF_BN) + tb_); const u32x4* pt = (const u32x4*)(WSP(bf16_t, OFF_BT) + tb_);
            const u32x4* px = (const u32x4*)(WSP(bf16_t, OFF_XT) + ((size_t)((b * 16 + c + 1) * 1024 + h * 64 + prow)) * 128 + pcol);
#pragma unroll
            for (int i = 0; i < 4; ++i) { tC[i] = pc[i * 512]; tB[i] = pb[i * 512]; tT[i] = pt[i * 512]; }
            tX[0] = px[0]; tX[1] = px[512];
        }
        bf16_t zr[16];
        {
            const unsigned zoff = (unsigned)((row0 + (wid >> 1) * 32 + 4 * hh) * N0 + 2048 + h * 64 + (wid & 1) * 32 + l31);
#pragma unroll
            for (int reg = 0; reg < 16; ++reg) zr[reg] = (U + ((reg & 3) + 8 * (reg >> 2)) * N0)[zoff];
        }
        lds_barrier();
        {
            const int tb = (wid >> 1) * 32, pb = (wid & 1) * 32;
            f32x16 y;
#pragma unroll
            for (int i = 0; i < 16; ++i) y[i] = 0.f;
#pragma unroll
            for (int ks = 0; ks < 8; ++ks) y = MFMA32(ldfrag(Cs, 136, tb, ks * 16, lane), ldfrag(St, 136, pb, ks * 16, lane), y);
            f32x16 y2;
#pragma unroll
            for (int i = 0; i < 16; ++i) y2[i] = 0.f;
#pragma unroll
            for (int ks = 0; ks < 8; ++ks) y2 = MFMA32(ldfrag(Ws, 136, tb, ks * 16, lane), ldfrag(XsT, 136, pb, ks * 16, lane), y2);
#pragma unroll
            for (int reg = 0; reg < 16; ++reg) y[reg] = y[reg] * __expf(acs[tb + crow(reg, hh)]) + y2[reg];
            const int p = pb + l31, ch = h * 64 + p; const float nwv = P.in[24][ch];
            float sq[16];
#pragma unroll
            for (int reg = 0; reg < 16; ++reg) {
                const int t = tb + crow(reg, hh); const size_t row = (size_t)(row0 + t);
                const float xv = bf2f(XsT[p * 136 + t]); const float z = bf2f(zr[reg]);
                const float yy = (y[reg] + Dh * xv) * silu(z);
                sq[reg] = yy * yy;
                MIX[row * 2048 + 1024 + ch] = f2bf(yy * nwv);
            }
#define SSD_RSTEP(m, n) do { const bool up_ = (l31 & (m)) != 0; _Pragma("unroll") for (int i_ = 0; i_ < (n); ++i_) { const float snd_ = up_ ? sq[i_] : sq[i_ + (n)]; const float kp_ = up_ ? sq[i_ + (n)] : sq[i_]; sq[i_] = kp_ + __shfl_xor(snd_, (m)); } } while (0)
            SSD_RSTEP(16, 8); SSD_RSTEP(8, 4); SSD_RSTEP(4, 2); SSD_RSTEP(2, 1);
#undef SSD_RSTEP
            sq[0] += __shfl_xor(sq[0], 1);
            if ((l31 & 1) == 0) atomicAdd(SSB + (size_t)(row0 + tb + crow(l31 >> 1, hh)) * 2 + g, sq[0]);
            lds_barrier();
            const int pb2 = (wid >> 2) * 32, nb = (wid & 3) * 32;
            const float ea = __expf(a_last);
#pragma unroll
            for (int reg = 0; reg < 16; ++reg) accS[reg] *= ea;
#pragma unroll
            for (int ks = 0; ks < 8; ++ks) accS = MFMA32(ldfrag(XwT, 136, pb2, ks * 16, lane), ldfrag(BsT, 136, nb, ks * 16, lane), accS);
#pragma unroll
            for (int reg = 0; reg < 16; ++reg) St[(pb2 + crow(reg, hh)) * 136 + nb + l31] = f2bf(accS[reg]);
        }
    }
    {
        const int lane = tid0 & 63, hh = lane >> 5, l31 = lane & 31;
        const int pb2 = (wid >> 2) * 32, nb = (wid & 3) * 32;
        float* o = P.out + O_BSP + (size_t)(b * 16 + h) * 64 * 128;
#pragma unroll
        for (int reg = 0; reg < 16; ++reg) o[(pb2 + crow(reg, hh)) * 128 + nb + l31] = accS[reg];
    }
}
#undef SSD_DTLOAD
#undef SSD_SCAN
DI void ssd_sample_item(const Params& P, unsigned char* L, int item) {
    const int b = item >> 4, h = item & 15, g = h >> 3, tid = otid(), lane = tid & 63;
    float* xs = (float*)L; float* Bv = xs + 64; float* Cv = Bv + 128; float* yv = Cv + 128;
    const bf16_t* U = WSP(bf16_t, OFF_U); bf16_t* MIX = WSP(bf16_t, OFF_MIX); float* SSB = WSP(float, OFF_SSB);
    const size_t row = (size_t)(MP + b);
    __syncthreads();
    if (tid < 320) {
        int cc; if (tid < 64) cc = h * 64 + tid; else if (tid < 192) cc = 1024 + g * 128 + (tid - 64); else cc = 1280 + g * 128 + (tid - 192);
        const float* buf = P.in[7] + (size_t)b * 3 * 1536 + cc;
        const float v = P.in[20][cc] + P.in[19][cc] * buf[0] + P.in[19][1536 + cc] * buf[1536] + P.in[19][2 * 1536 + cc] * buf[2 * 1536] + P.in[19][3 * 1536 + cc] * bf2f(U[row * N0 + 3072 + cc]);
        xs[tid] = silu(v);
    }
    const float dt = softplus(WSP(float, OFF_DT)[row * 16 + h] + P.in[21][h]);
    const float dA = __expf(-dt * __expf(P.in[22][h]));
    __syncthreads();
    const float* s0 = P.in[6] + (size_t)(b * 16 + h) * 64 * 128; float* s1 = P.out + O_BSS + (size_t)(b * 16 + h) * 64 * 128;
    const int n4 = (tid & 31) * 4;
    const f32x4 Bq = *(const f32x4*)(Bv + n4), Cq = *(const f32x4*)(Cv + n4);
#pragma unroll
    for (int j = 0; j < 4; ++j) {
        const int p = (tid >> 5) + 16 * j;
        const f32x4 s = *(const f32x4*)(s0 + p * 128 + n4);
        const float dx = dt * xs[p];
        const f32x4 sn = s * dA + Bq * dx;
        *(f32x4*)(s1 + p * 128 + n4) = sn;
        float yp = sn[0] * Cq[0] + sn[1] * Cq[1] + sn[2] * Cq[2] + sn[3] * Cq[3];
        yp += __shfl_xor(yp, 1); yp += __shfl_xor(yp, 2); yp += __shfl_xor(yp, 4); yp += __shfl_xor(yp, 8); yp += __shfl_xor(yp, 16);
        if ((tid & 31) == 0) yv[p] = yp;
    }
    __syncthreads();
    if (tid < 64) {
        const int ch = h * 64 + tid;
        const float yy = (yv[tid] + P.in[23][h] * xs[tid]) * silu(bf2f(U[row * N0 + 2048 + ch]));
        const float ss = wave_sum(yy * yy);
        if (lane == 0) atomicAdd(SSB + row * 2 + g, ss);
        MIX[row * 2048 + 1024 + ch] = f2bf(yy * P.in[24][ch]);
    }
}
DI void ssd_sample_item4(const Params& P, unsigned char* L, int item) {
    const int b = item >> 2, tid = otid(), gi = tid >> 7, lt = tid & 127, h = (item & 3) * 4 + gi, g = h >> 3;
    float* xs = (float*)L + gi * 512; float* Bv = xs + 64; float* Cv = Bv + 128; float* yv = Cv + 128;
    const bf16_t* U = WSP(bf16_t, OFF_U); bf16_t* MIX = WSP(bf16_t, OFF_MIX); float* SSB = WSP(float, OFF_SSB);
    const size_t row = (size_t)(MP + b);
    __syncthreads();
#pragma unroll
    for (int ps = 0; ps < 3; ++ps) {
        const int idx = lt + 128 * ps;
        if (idx < 320) {
            int cc; if (idx < 64) cc = h * 64 + idx; else if (idx < 192) cc = 1024 + g * 128 + (idx - 64); else cc = 1280 + g * 128 + (idx - 192);
            const float* buf = P.in[7] + (size_t)b * 3 * 1536 + cc;
            const float v = P.in[20][cc] + P.in[19][cc] * buf[0] + P.in[19][1536 + cc] * buf[1536] + P.in[19][2 * 1536 + cc] * buf[2 * 1536] + P.in[19][3 * 1536 + cc] * bf2f(U[row * N0 + 3072 + cc]);
            xs[idx] = silu(v);
        }
    }
    const float dt = softplus(WSP(float, OFF_DT)[row * 16 + h] + P.in[21][h]);
    const float dA = __expf(-dt * __expf(P.in[22][h]));
    __syncthreads();
    const float* s0 = P.in[6] + (size_t)(b * 16 + h) * 64 * 128; float* s1 = P.out + O_BSS + (size_t)(b * 16 + h) * 64 * 128;
    const int n4 = (lt & 31) * 4;
    const f32x4 Bq = *(const f32x4*)(Bv + n4), Cq = *(const f32x4*)(Cv + n4);
    f32x4 sv[16];
#pragma unroll
    for (int j = 0; j < 16; ++j) sv[j] = *(const f32x4*)(s0 + ((lt >> 5) + 4 * j) * 128 + n4);
#pragma unroll
    for (int j = 0; j < 16; ++j) {
        const int p = (lt >> 5) + 4 * j;
        const f32x4 sn = sv[j] * dA + Bq * (dt * xs[p]);
        *(f32x4*)(s1 + p * 128 + n4) = sn;
        float yp = sn[0] * Cq[0] + sn[1] * Cq[1] + sn[2] * Cq[2] + sn[3] * Cq[3];
        yp += __shfl_xor(yp, 1); yp += __shfl_xor(yp, 2); yp += __shfl_xor(yp, 4); yp += __shfl_xor(yp, 8); yp += __shfl_xor(yp, 16);
        if ((lt & 31) == 0) yv[p] = yp;
    }
    __syncthreads();
    if (lt < 64) {
        const int ch = h * 64 + lt;
        const float yy = (yv[lt] + P.in[23][h] * xs[lt]) * silu(bf2f(U[row * N0 + 2048 + ch]));
        const float ss = wave_sum(yy * yy);
        if (lt == 0) atomicAdd(SSB + row * 2 + g, ss);
        MIX[row * 2048 + 1024 + ch] = f2bf(yy * P.in[24][ch]);
    }
}
template <bool SAMPLE>
DI void rglru_item(const Params& P, unsigned char* L, int item) {
    const int tid0 = otid(), wid = tid0 >> 6;
    const int b = SAMPLE ? 0 : (item >> 4), k = (item >> 1) & 7, dh = item & 1;
    bf16_t* Xs = (bf16_t*)L;
    bf16_t* Wg = Xs + 128 * 136;
    float* Aa = (float*)(Wg + 128 * 136);
    float* Uu = Aa + 128 * 64; float* segA = Uu + 128 * 64; float* segH = segA + 512; float* hc = segH + 512;
    const bf16_t* U = WSP(bf16_t, OFF_U); bf16_t* MIX = WSP(bf16_t, OFF_MIX);
    lds_barrier();
    {
        const bf16_t* WRT = WSP(bf16_t, OFF_WRT); const bf16_t* WIT = WSP(bf16_t, OFF_WIT);
#pragma unroll
        for (int i = 0; i < 4; ++i) {
            const int chk = tid0 + i * 512, r = chk >> 4, c8 = (chk & 15) * 8;
            const bf16_t* src = (r < 64 ? WRT + (size_t)(dh * 64 + r) * 1024 : WIT + (size_t)(dh * 64 + r - 64) * 1024) + k * 128 + c8;
            *(u32x4*)(Wg + r * 136 + c8) = *(const u32x4*)src;
        }
        if (tid0 < 64) hc[tid0] = 0.f;
    }
    float sp[4], br[4], bi[4];
#pragma unroll
    for (int ct = 0; ct < 4; ++ct) { const int chd = k * 128 + dh * 64 + ct * 16 + (tid0 & 15); sp[ct] = softplus(-P.in[18][chd]); br[ct] = P.in[15][chd]; bi[ct] = P.in[17][chd]; }
    const int ch0 = k * 128 + (tid0 & 31) * 4;
    float cw[4][4], cbias[4];
#pragma unroll
    for (int kk = 0; kk < 4; ++kk)
#pragma unroll
        for (int e = 0; e < 4; ++e) cw[kk][e] = P.in[12][kk * 1024 + ch0 + e];
#pragma unroll
    for (int e = 0; e < 4; ++e) cbias[e] = P.in[13][ch0 + e];
    u32x2 raw[11];
#define RG_LOAD(tl_) do { const int tg_ = (tl_) * 128 + (tid0 >> 5) * 8; const unsigned vo_ = (unsigned)((b * 2048 + tg_) * N0 + ch0); \
        _Pragma("unroll") for (int j = 0; j < 11; ++j) raw[j] = (tg_ + j - 3 >= 0) ? *(const u32x2*)((U + (j - 3) * N0) + vo_) : (u32x2){0u, 0u}; } while (0)
    if (!SAMPLE) RG_LOAD(0);
    const int ntiles = SAMPLE ? 1 : 16;
    for (int tile = 0; tile < ntiles; ++tile) {
        const int row0 = SAMPLE ? MP : b * 2048 + tile * 128;
        lds_barrier();
        int zv = 0; asm volatile("" : "+v"(zv));
        const int tid = tid0 + zv, lane = tid & 63, quad = tid & 31, seg = tid >> 5;
        const int sd = tid & 63, sseg = wid, sch = k * 128 + dh * 64 + sd;
        bf16_t gt[16];
        if (!SAMPLE) {
            const unsigned goff = (unsigned)((row0 + sseg * 16) * N0 + 1024 + sch);
#pragma unroll
            for (int t = 0; t < 16; ++t) gt[t] = (U + t * N0)[goff];
        }
        if (SAMPLE) {
#pragma unroll
            for (int t = 0; t < 8; ++t) {
                const int bb = seg * 8 + t;
                const float* buf = P.in[5] + (size_t)bb * 3 * 1024 + ch0;
                const f32x4 p0 = *(const f32x4*)buf, p1 = *(const f32x4*)(buf + 1024), p2 = *(const f32x4*)(buf + 2048);
                float cur[4]; ld4bf(U + (size_t)(MP + bb) * N0 + ch0, cur);
                float y[4];
#pragma unroll
                for (int e = 0; e < 4; ++e) y[e] = cbias[e] + cw[0][e] * p0[e] + cw[1][e] * p1[e] + cw[2][e] * p2[e] + cw[3][e] * cur[e];
                *(u32x2*)(Xs + bb * 136 + quad * 4) = pack4v(y[0], y[1], y[2], y[3]);
            }
        } else {
#pragma unroll
            for (int j = 0; j < 8; ++j) {
                const float x0[4] = {bflo(raw[j].x), bfhi(raw[j].x), bflo(raw[j].y), bfhi(raw[j].y)};
                const float x1[4] = {bflo(raw[j + 1].x), bfhi(raw[j + 1].x), bflo(raw[j + 1].y), bfhi(raw[j + 1].y)};
                const float x2[4] = {bflo(raw[j + 2].x), bfhi(raw[j + 2].x), bflo(raw[j + 2].y), bfhi(raw[j + 2].y)};
                const float x3[4] = {bflo(raw[j + 3].x), bfhi(raw[j + 3].x), bflo(raw[j + 3].y), bfhi(raw[j + 3].y)};
                float y[4];
#pragma unroll
                for (int e = 0; e < 4; ++e) y[e] = cbias[e] + cw[0][e] * x0[e] + cw[1][e] * x1[e] + cw[2][e] * x2[e] + cw[3][e] * x3[e];
                *(u32x2*)(Xs + (seg * 8 + j) * 136 + quad * 4) = pack4v(y[0], y[1], y[2], y[3]);
            }
            if (tile + 1 < 16) RG_LOAD(tile + 1);
        }
        lds_barrier();
        {
            f32x4 acc[8];
#pragma unroll
            for (int i = 0; i < 8; ++i) acc[i] = (f32x4){0.f, 0.f, 0.f, 0.f};
#pragma unroll
            for (int ks = 0; ks < 4; ++ks) {
                const bf16x8 a = ldfrag16(Xs, 136, wid * 16, ks * 32, lane);
#pragma unroll
                for (int tl = 0; tl < 8; ++tl) acc[tl] = MFMA16(a, ldfrag16(Wg, 136, tl * 16, ks * 32, lane), acc[tl]);
            }
#pragma unroll
            for (int ct = 0; ct < 4; ++ct)
#pragma unroll
                for (int reg = 0; reg < 4; ++reg) {
                    const int t = wid * 16 + (lane >> 4) * 4 + reg, d = ct * 16 + (lane & 15);
                    const float r = sigm(acc[ct][reg] + br[ct]), gi = sigm(acc[4 + ct][reg] + bi[ct]);
                    const float a = __expf(-8.f * r * sp[ct]);
                    const float uu = __builtin_amdgcn_sqrtf(fmaxf(1.f - a * a, 0.f)) * gi * bf2f(Xs[t * 136 + dh * 64 + d]);
                    if (SAMPLE) {
                        const int chd = k * 128 + dh * 64 + d;
                        const float hn = a * P.in[4][(size_t)t * 1024 + chd] + uu;
                        P.out[O_AHS + (size_t)t * 1024 + chd] = hn;
                        const float gv = bf2f(U[(size_t)(MP + t) * N0 + 1024 + chd]);
                        MIX[(size_t)(MP + t) * 2048 + chd] = f2bf(hn * silu(gv));
                    } else { Aa[t * 64 + d] = a; Uu[t * 64 + d] = uu; }
                }
        }
        if (!SAMPLE) {
            lds_barrier();
            float av[16], uv[16], Ap = 1.f, Hp = 0.f;
#pragma unroll
            for (int t = 0; t < 16; ++t) { av[t] = Aa[(sseg * 16 + t) * 64 + sd]; uv[t] = Uu[(sseg * 16 + t) * 64 + sd]; Hp = av[t] * Hp + uv[t]; Ap *= av[t]; }
            segA[sseg * 64 + sd] = Ap; segH[sseg * 64 + sd] = Hp;
            lds_barrier();
            float hin = hc[sd];
            for (int s2 = 0; s2 < sseg; ++s2) hin = segA[s2 * 64 + sd] * hin + segH[s2 * 64 + sd];
            const unsigned moff = (unsigned)((row0 + sseg * 16) * 2048 + sch);
#pragma unroll
            for (int t = 0; t < 16; ++t) {
                hin = av[t] * hin + uv[t];
                (MIX + t * 2048)[moff] = f2bf(hin * silu(bf2f(gt[t])));
            }
            lds_barrier();
            if (sseg == 7) hc[sd] = hin;
        }
    }
#undef RG_LOAD
    if (!SAMPLE) { lds_barrier(); if (tid0 < 64) P.out[O_AHP + (size_t)b * 1024 + k * 128 + dh * 64 + tid0] = hc[tid0]; }
}
DI void phase_mix0(const Params& P, unsigned char* L) {
    const int tid = otid(), bid = blockIdx.x, G = gridDim.x;
    { const bf16_t* U = WSP(bf16_t, OFF_U);
      for (int i = bid * 512 + tid; i < 8 * 3 * 1024; i += G * 512) { const int c = i & 1023, j = (i >> 10) % 3, b = i / 3072; P.out[O_ACP + i] = bf2f(U[(size_t)(b * 2048 + 2045 + j) * N0 + c]); }
      for (int i = bid * 512 + tid; i < 8 * 3 * 1536; i += G * 512) { const int c = i % 1536, j = (i / 1536) % 3, b = i / 4608; P.out[O_BCP + i] = bf2f(U[(size_t)(b * 2048 + 2045 + j) * N0 + 3072 + c]); }
      for (int i = bid * 512 + tid; i < 128 * 3 * 1024; i += G * 512) { const int c = i & 1023, j = (i >> 10) % 3, b = i / 3072; P.out[O_ACS + i] = j < 2 ? P.in[5][(size_t)(b * 3 + j + 1) * 1024 + c] : bf2f(U[(size_t)(MP + b) * N0 + c]); }
      for (int i = bid * 512 + tid; i < 128 * 3 * 1536; i += G * 512) { const int c = i % 1536, j = (i / 1536) % 3, b = i / 4608; P.out[O_BCS + i] = j < 2 ? P.in[7][(size_t)(b * 3 + j + 1) * 1536 + c] : bf2f(U[(size_t)(MP + b) * N0 + 3072 + c]); } }
    if (bid < 128) { const int x = bid & 7, j = bid >> 3; rglru_item<false>(P, L, (x + 8 * (j >> 1)) * 2 + (j & 1)); }
    else if (bid < 256) { const int x = bid & 7, j = (bid - 128) >> 3, grp = x + 8 * (j >> 3); ssd_prompt_item(P, L, (grp >> 1) * 16 + (grp & 1) * 8 + (j & 7)); }
    unsigned* ctr = WSP(unsigned, OFF_CTL);
    unsigned* bc = (unsigned*)(L + LDS_BYTES - 16);
    for (;;) {
        __syncthreads();
        if (tid == 0) bc[0] = atomicAdd(ctr, 1u);
        __syncthreads();
        const unsigned it = bc[0];
        if (it >= 16u + 512u) break;
        if (it < 16u) rglru_item<true>(P, L, (int)it); else ssd_sample_item4(P, L, (int)(it - 16u));
    }
    for (;;) {
        __syncthreads();
        if (tid == 0) bc[0] = atomicAdd(ctr + 32, 1u);
        __syncthreads();
        const unsigned q = bc[0];
        if (q >= 256u + 104u + 130u) break;
        if (q < 256u) l1_weight_tile(P, (int)q * 8 + (tid >> 6), (float*)L + (tid >> 6) * (64 * 65), tid & 63);
        else if (q < 360u) l1_weight_tile(P, 2880 + ((int)q - 256) * 8 + (tid >> 6), (float*)L + (tid >> 6) * (64 * 65), tid & 63);
        else convert_p_chunk(P, 0, (int)q - 360, tid);
    }
}
DI void phase_norm0(const Params& P) {
    bf16_t* MIX = WSP(bf16_t, OFF_MIX); const float* SSB = WSP(float, OFF_SSB);
    for (int i = blockIdx.x * 512 + threadIdx.x; i < MV * 128; i += gridDim.x * 512) {
        const int row = i >> 7, c8 = (i & 127) * 8, g = c8 >> 9;
        const float sc = rsqrtf(SSB[(size_t)row * 2 + g] * (1.f / 512.f) + EPSF);
        uint4* p = (uint4*)(MIX + (size_t)row * 2048 + 1024 + c8); uint4 w = *p;
        w.x = pack2(bflo(w.x) * sc, bfhi(w.x) * sc); w.y = pack2(bflo(w.y) * sc, bfhi(w.y) * sc); w.z = pack2(bflo(w.z) * sc, bfhi(w.z) * sc); w.w = pack2(bflo(w.w) * sc, bfhi(w.w) * sc);
        *p = w;
    }
}

DI void hgrn_prompt_item(const Params& P, unsigned char* L, int item) {
    const int b = item >> 4, h = item & 15;
    const int tid = otid(), lane = tid & 63, wid = tid >> 6, hh = lane >> 5, l31 = lane & 31;
    bf16_t* Qs = (bf16_t*)L;
    bf16_t* Ks = Qs + 64 * 136;
    bf16_t* KsT = Ks + 64 * 136;
    bf16_t* VsT = KsT + 128 * 72;
    bf16_t* SsT = VsT + 128 * 72;
    bf16_t* As = SsT + 128 * 136;
    float* Gseg = (float*)(As + 64 * 72);
    float* E1 = Gseg + 16 * 128; float* E2 = E1 + 128;
    float* Of = E2 + 128;
    const bf16_t* U = WSP(bf16_t, OFF_U); bf16_t* MIX = WSP(bf16_t, OFF_MIX);
    const int kq = tid & 31, ts = tid >> 5;
    float lb[4];
#pragma unroll
    for (int e = 0; e < 4; ++e) { const int ch = h * 128 + kq * 4 + e; lb[e] = sigm(P.in[27][2048 + ch] - P.in[27][ch]); }
    const int kb = (wid >> 1) * 32, vb0 = (wid & 1) * 64;
    f32x16 accS[2];
#pragma unroll
    for (int i = 0; i < 16; ++i) { accS[0][i] = 0.f; accS[1][i] = 0.f; }
    uint2 rq[4], rf[4], rv[4];
#define HG_LOAD(cc) do { _Pragma("unroll") for (int i = 0; i < 4; ++i) { const bf16_t* bp = U + (size_t)(b * 2048 + (cc) * 64 + ts * 4 + i) * INC + h * 128 + kq * 4; \
        rq[i] = *(const uint2*)bp; rf[i] = *(const uint2*)(bp + 2048); rv[i] = *(const uint2*)(bp + 4096); } } while (0)
    HG_LOAD(0);
    lds_barrier();
    float kk[4][4], cs[4][4];
    {
#pragma unroll
        for (int i = 0; i < 4; ++i) {
            const float fx[4] = {bflo(rf[i].x), bfhi(rf[i].x), bflo(rf[i].y), bfhi(rf[i].y)};
#pragma unroll
            for (int e = 0; e < 4; ++e) {
                const float sg = sigm(fx[e]); const float kv = (1.f - lb[e]) * (1.f - sg);
                kk[i][e] = kv; const float gl = __logf(1.f - kv);
                cs[i][e] = (i == 0 ? 0.f : cs[i - 1][e]) + gl;
            }
        }
        *(f32x4*)(Gseg + ts * 128 + kq * 4) = (f32x4){cs[3][0], cs[3][1], cs[3][2], cs[3][3]};
    }
    lds_barrier();
    for (int c = 0; c < 32; ++c) {
        u32x4 gpre0, gpre1;
        { const bf16_t* gp = U + (size_t)(b * 2048 + c * 64 + (tid >> 3)) * INC + 6144 + h * 128 + (tid & 7) * 16; gpre0 = *(const u32x4*)gp; gpre1 = *(const u32x4*)(gp + 8); }
        f32x4 off = {0.f, 0.f, 0.f, 0.f}, gmid = off, glast = off;
        {
            const int swid = __builtin_amdgcn_readfirstlane(tid >> 6);
            f32x4 pre = {0.f, 0.f, 0.f, 0.f};
#pragma unroll
            for (int s = 0; s < 16; ++s) {
                const f32x4 v = *(const f32x4*)(Gseg + s * 128 + kq * 4);
                if (s == 2 * swid) off = pre;
                if (s == 8) gmid = pre;
                pre += v;
            }
            glast = pre;
            if (ts & 1) off += *(const f32x4*)(Gseg + (ts - 1) * 128 + kq * 4);
        }
        {
            float qt[4][4], kt[4][4], vt[4][4];
#pragma unroll
            for (int i = 0; i < 4; ++i) {
                const float q[4] = {bflo(rq[i].x), bfhi(rq[i].x), bflo(rq[i].y), bfhi(rq[i].y)};
                vt[i][0] = bflo(rv[i].x); vt[i][1] = bfhi(rv[i].x); vt[i][2] = bflo(rv[i].y); vt[i][3] = bfhi(rv[i].y);
#pragma unroll
                for (int e = 0; e < 4; ++e) { const float Gv = off[e] + cs[i][e]; const float ex = __expf(Gv - gmid[e]); qt[i][e] = q[e] * 0.08838834764831845f * ex; kt[i][e] = kk[i][e] * frcp(ex); }
                *(uint2*)(Qs + (ts * 4 + i) * 136 + kq * 4) = pack4(qt[i][0], qt[i][1], qt[i][2], qt[i][3]);
                *(uint2*)(Ks + (ts * 4 + i) * 136 + kq * 4) = pack4(kt[i][0], kt[i][1], kt[i][2], kt[i][3]);
            }
#pragma unroll
            for (int e = 0; e < 4; ++e) {
                *(uint2*)(KsT + (kq * 4 + e) * 72 + ts * 4) = pack4(kt[0][e], kt[1][e], kt[2][e], kt[3][e]);
                *(uint2*)(VsT + (kq * 4 + e) * 72 + ts * 4) = pack4(vt[0][e], vt[1][e], vt[2][e], vt[3][e]);
            }
            if (ts == 0) {
#pragma unroll
                for (int e = 0; e < 4; ++e) { E1[kq * 4 + e] = __expf(gmid[e]); E2[kq * 4 + e] = __expf(glast[e] - gmid[e]); }
            }
        }
        if (c + 1 < 32) HG_LOAD(c + 1);
        lds_barrier();
#pragma unroll
        for (int j = 0; j < 2; ++j) {
#pragma unroll
            for (int reg = 0; reg < 16; ++reg) accS[j][reg] *= E1[kb + crow(reg, hh)];
            const int v = vb0 + j * 32 + l31;
#pragma unroll
            for (int rg = 0; rg < 4; ++rg) *(uint2*)(SsT + v * 136 + kb + 8 * rg + 4 * hh) = pack4(accS[j][4 * rg], accS[j][4 * rg + 1], accS[j][4 * rg + 2], accS[j][4 * rg + 3]);
        }
        if (wid < 4) {
            const int tb = (wid >> 1) * 32, sb = (wid & 1) * 32;
            f32x16 aa;
#pragma unroll
            for (int i = 0; i < 16; ++i) aa[i] = 0.f;
#pragma unroll
            for (int ks = 0; ks < 8; ++ks) aa = MFMA32(ldfrag(Qs, 136, tb, ks * 16, lane), ldfrag(Ks, 136, sb, ks * 16, lane), aa);
            const int s = sb + l31;
#pragma unroll
            for (int reg = 0; reg < 16; ++reg) { const int t = tb + crow(reg, hh); As[t * 72 + s] = f2bf(s <= t ? aa[reg] : 0.f); }
        }
        lds_barrier();
        const int tb2 = (wid >> 2) * 32, vb2 = (wid & 3) * 32;
        f32x16 o, o2;
#pragma unroll
        for (int i = 0; i < 16; ++i) { o[i] = 0.f; o2[i] = 0.f; }
#pragma unroll
        for (int ks = 0; ks < 8; ++ks) o = MFMA32(ldfrag(Qs, 136, tb2, ks * 16, lane), ldfrag(SsT, 136, vb2, ks * 16, lane), o);
#pragma unroll
        for (int ks = 0; ks < 4; ++ks) o2 = MFMA32(ldfrag(As, 72, tb2, ks * 16, lane), ldfrag(VsT, 72, vb2, ks * 16, lane), o2);
#pragma unroll
        for (int i = 0; i < 16; ++i) o[i] += o2[i];
#pragma unroll
        for (int j = 0; j < 2; ++j) {
#pragma unroll
            for (int ks = 0; ks < 4; ++ks) accS[j] = MFMA32(ldfrag(KsT, 72, kb, ks * 16, lane), ldfrag(VsT, 72, vb0 + j * 32, ks * 16, lane), accS[j]);
#pragma unroll
            for (int reg = 0; reg < 16; ++reg) accS[j][reg] *= E2[kb + crow(reg, hh)];
        }
#pragma unroll
        for (int reg = 0; reg < 16; ++reg) Of[(tb2 + crow(reg, hh)) * 132 + vb2 + l31] = o[reg];
        if (c + 1 < 32) {
#pragma unroll
        for (int i = 0; i < 4; ++i) {
            const float fx[4] = {bflo(rf[i].x), bfhi(rf[i].x), bflo(rf[i].y), bfhi(rf[i].y)};
#pragma unroll
            for (int e = 0; e < 4; ++e) {
                const float sg = sigm(fx[e]); const float kv = (1.f - lb[e]) * (1.f - sg);
                kk[i][e] = kv; const float gl = __logf(1.f - kv);
                cs[i][e] = (i == 0 ? 0.f : cs[i - 1][e]) + gl;
            }
        }
        *(f32x4*)(Gseg + ts * 128 + kq * 4) = (f32x4){cs[3][0], cs[3][1], cs[3][2], cs[3][3]};
        }
        lds_barrier();
        {
            const int t = tid >> 3, vs = tid & 7;
            const size_t row = (size_t)(b * 2048 + c * 64 + t);
            f32x4 ov[4]; float ss = 0.f;
#pragma unroll
            for (int i = 0; i < 4; ++i) { ov[i] = *(const f32x4*)(Of + t * 132 + vs * 16 + i * 4); ss += ov[i][0] * ov[i][0] + ov[i][1] * ov[i][1] + ov[i][2] * ov[i][2] + ov[i][3] * ov[i][3]; }
            ss += __shfl_xor(ss, 1); ss += __shfl_xor(ss, 2); ss += __shfl_xor(ss, 4);
            const float rstd = rsqrtf(ss * (1.f / 128.f) + EPSF);
            const float* nwp = P.in[28] + h * 128 + vs * 16;
            const unsigned gw[8] = {gpre0.x, gpre0.y, gpre0.z, gpre0.w, gpre1.x, gpre1.y, gpre1.z, gpre1.w};
            unsigned ow[8];
#pragma unroll
            for (int i = 0; i < 4; ++i) {
                const f32x4 w = *(const f32x4*)(nwp + i * 4);
                ow[2 * i] = pack2(ov[i][0] * rstd * w[0] * silu(bflo(gw[2 * i])), ov[i][1] * rstd * w[1] * silu(bfhi(gw[2 * i])));
                ow[2 * i + 1] = pack2(ov[i][2] * rstd * w[2] * silu(bflo(gw[2 * i + 1])), ov[i][3] * rstd * w[3] * silu(bfhi(gw[2 * i + 1])));
            }
            bf16_t* op = MIX + row * 2048 + h * 128 + vs * 16;
            *(uint4*)op = make_uint4(ow[0], ow[1], ow[2], ow[3]); *(uint4*)(op + 8) = make_uint4(ow[4], ow[5], ow[6], ow[7]);
        }
    }
#undef HG_LOAD
    float* so = P.out + O_CP + (size_t)(b * 16 + h) * 128 * 128;
#pragma unroll
    for (int j = 0; j < 2; ++j)
#pragma unroll
        for (int reg = 0; reg < 16; ++reg) so[(kb + crow(reg, hh)) * 128 + vb0 + j * 32 + l31] = accS[j][reg];
}
DI void hgrn_sample_item(const Params& P, unsigned char* L, int item) {
    const int b = item >> 4, h = item & 15, tid = otid(), lane = tid & 63;
    float* qv = (float*)L; float* egv = qv + 128; float* kkv = egv + 128; float* vv = kkv + 128; float* part = vv + 128; float* red = part + 16 * 128;
    const bf16_t* U = WSP(bf16_t, OFF_U); bf16_t* MIX = WSP(bf16_t, OFF_MIX);
    const size_t row = (size_t)(MP + b); const bf16_t* ub = U + row * INC + h * 128;
    __syncthreads();
    if (tid < 128) {
        const int ch = h * 128 + tid;
        const float lbv = sigm(P.in[27][2048 + ch] - P.in[27][ch]);
        const float sg = sigm(bf2f(ub[2048 + tid])); const float kv = (1.f - lbv) * (1.f - sg);
        qv[tid] = bf2f(ub[tid]) * 0.08838834764831845f; egv[tid] = 1.f - kv; kkv[tid] = kv;
    } else if (tid < 256) vv[tid - 128] = bf2f(ub[4096 + tid - 128]);
    __syncthreads();
    const float* s0 = P.in[8] + (size_t)(b * 16 + h) * 128 * 128; float* s1 = P.out + O_CS + (size_t)(b * 16 + h) * 128 * 128;
    const int v4 = (tid & 31) * 4; const f32x4 vq = *(const f32x4*)(vv + v4);
    f32x4 op = {0.f, 0.f, 0.f, 0.f};
#pragma unroll
    for (int j = 0; j < 8; ++j) {
        const int k = (tid >> 5) + 16 * j;
        const f32x4 s = *(const f32x4*)(s0 + k * 128 + v4);
        const f32x4 sn = s * egv[k] + vq * kkv[k];
        *(f32x4*)(s1 + k * 128 + v4) = sn;
        op += sn * qv[k];
    }
    *(f32x4*)(part + (tid >> 5) * 128 + v4) = op;
    __syncthreads();
    float o = 0.f;
    if (tid < 128) {
#pragma unroll
        for (int i = 0; i < 16; ++i) o += part[i * 128 + tid];
        const float ss = wave_sum(o * o);
        if (lane == 0) red[tid >> 6] = ss;
    }
    __syncthreads();
    if (tid < 128) {
        const float rstd = rsqrtf((red[0] + red[1]) * (1.f / 128.f) + EPSF);
        const int ch = h * 128 + tid;
        MIX[row * 2048 + ch] = f2bf(o * rstd * P.in[28][ch] * silu(bf2f(ub[6144 + tid])));
    }
}
DI void phase_mix1(const Params& P, unsigned char* L) {
    const int tid = otid(), bid = blockIdx.x;
    if (bid < 128) hgrn_prompt_item(P, L, bid);
    else { const int nb = gridDim.x - 128; for (int it = bid - 128; it < 2048; it += nb) hgrn_sample_item(P, L, it); }
    unsigned* ctr = WSP(unsigned, OFF_CTL) + 48;
    unsigned* bc = (unsigned*)(L + LDS_BYTES - 16);
    for (;;) {
        __syncthreads();
        if (tid == 0) bc[0] = atomicAdd(ctr, 1u);
        __syncthreads();
        const unsigned q = bc[0];
        if (q >= 104u + 130u) break;
        if (q < 104u) l1_weight_tile(P, 2048 + (int)q * 8 + (tid >> 6), (float*)L + (tid >> 6) * (64 * 65), tid & 63);
        else convert_p_chunk(P, 1, (int)q - 104, tid);
    }
}
DI void phase_final(const Params& P) {
    const int lane = threadIdx.x & 63, gw = blockIdx.x * 8 + (threadIdx.x >> 6), nwv = gridDim.x * 8;
    const float* H = WSP(float, OFF_H); const float* SS = WSP(float, OFF_SS2); const float* nf = P.in[10];
    f32x4 w4[4];
#pragma unroll
    for (int i = 0; i < 4; ++i) w4[i] = *(const f32x4*)(nf + lane * 4 + 256 * i);
    for (int r0 = gw * 4; r0 < MV; r0 += nwv * 4) {
        f32x4 v[4][4]; float rs[4];
#pragma unroll
        for (int q = 0; q < 4; ++q) { rs[q] = SS[r0 + q];
#pragma unroll
            for (int i = 0; i < 4; ++i) v[q][i] = *(const f32x4*)(H + (size_t)(r0 + q) * 1024 + lane * 4 + 256 * i); }
#pragma unroll
        for (int q = 0; q < 4; ++q) { const float rstd = rsqrtf(rs[q] * (1.f / 1024.f) + EPSF);
#pragma unroll
            for (int i = 0; i < 4; ++i) __builtin_nontemporal_store(v[q][i] * rstd * w4[i], (f32x4*)(P.out + O_Y + (size_t)(r0 + q) * 1024 + lane * 4 + 256 * i)); }
    }
}

#define XB_TMO      128
#define XB_XCNT(j)  (256  + 64 * (j))
#define XB_XSUB(j)  (1280 + 64 * (j))
#define XB_XGEN(j)  (2304 + 64 * (j))
#define XB_TOP      3328
#define XB_TOPGEN   3392
#define XCD_BAR_WORDS 3456
#define XB_SPIN_CAP (1u << 18)

__device__ __forceinline__ unsigned xb_ld(unsigned* p)              { return __hip_atomic_load(p, __ATOMIC_RELAXED, __HIP_MEMORY_SCOPE_AGENT); }
__device__ __forceinline__ unsigned xb_add(unsigned* p, unsigned v) { return __hip_atomic_fetch_add(p, v, __ATOMIC_RELAXED, __HIP_MEMORY_SCOPE_AGENT); }
__device__ __forceinline__ unsigned xb_xcc_id() { return (unsigned)__builtin_amdgcn_s_getreg((3 << 11) | 20) & 0xFu; }
#define XB_SPIN(cond, bar) do { unsigned _sp = 0; while (cond) { __builtin_amdgcn_s_sleep(1); \
    if ((++_sp & 255u) == 0u) { if (xb_ld(&(bar)[XB_TMO])) break; if (_sp > XB_SPIN_CAP) { atomicAdd(&(bar)[XB_TMO], 1u); break; } } } } while (0)

struct XcdBarrier {
    unsigned* bar; unsigned x;
    volatile LAS unsigned* st;
};

__device__ __forceinline__ XcdBarrier xcd_barrier_post(unsigned* bar, volatile LAS unsigned* st) {
    XcdBarrier b; b.bar = bar; b.x = xb_xcc_id(); b.st = st;
    if (threadIdx.x == 0) (void)xb_add(&bar[XB_XCNT(b.x)], 1u);
    return b;
}
__device__ __forceinline__ void xcd_barrier_complete(unsigned* bar, unsigned x, unsigned& nloc, unsigned& nx) {
    const unsigned G = gridDim.x * gridDim.y * gridDim.z;
    unsigned sum, cnt, mine, sp = 0u;
    for (;;) {
        sum = 0u; cnt = 0u; mine = 0u;
#pragma unroll
        for (unsigned j = 0; j < 16; ++j) { const unsigned c = xb_ld(&bar[XB_XCNT(j)]); sum += c; cnt += (c > 0u) ? 1u : 0u; mine = (j == x) ? c : mine; }
        if (sum == G) break;
        __builtin_amdgcn_s_sleep(1);
        if ((++sp & 255u) == 0u) { if (xb_ld(&bar[XB_TMO])) break; if (sp > XB_SPIN_CAP) { atomicAdd(&bar[XB_TMO], 1u); break; } }
    }
    nloc = mine > 0u ? mine : 1u; nx = cnt > 0u ? cnt : 1u;
}

__device__ __forceinline__ void xcd_barrier(const XcdBarrier& b) {
    asm volatile("s_waitcnt vmcnt(0)" ::: "memory");
    __syncthreads();
    if (threadIdx.x == 0) {
        unsigned* bar = b.bar;
        __builtin_amdgcn_s_waitcnt(0);
        unsigned nloc = b.st[0], nx = b.st[1];
        if (nloc == 0u) { xcd_barrier_complete(bar, b.x, nloc, nx); b.st[0] = nloc; b.st[1] = nx; }
        const unsigned old = xb_add(&bar[XB_XSUB(b.x)], 1u);
        const unsigned gen = old / nloc;
        if (old + 1u == (gen + 1u) * nloc) {
            __builtin_amdgcn_fence(__ATOMIC_RELEASE, "agent");
            asm volatile("s_waitcnt vmcnt(0)" ::: "memory");
            const unsigned og = xb_add(&bar[XB_TOP], 1u);
            const unsigned tg = og / nx;
            if (og + 1u == (tg + 1u) * nx) xb_add(&bar[XB_TOPGEN], 1u);
            else XB_SPIN(xb_ld(&bar[XB_TOPGEN]) == tg, bar);
            __builtin_amdgcn_fence(__ATOMIC_ACQUIRE, "agent");
            xb_add(&bar[XB_XGEN(b.x)], 1u);
            asm volatile("s_waitcnt vmcnt(0)" ::: "memory");
        } else {
            XB_SPIN(xb_ld(&bar[XB_XGEN(b.x)]) == gen, bar);
            __builtin_amdgcn_fence(__ATOMIC_ACQUIRE, "agent");
            asm volatile("s_waitcnt vmcnt(0)" ::: "memory");
        }
    }
    __syncthreads();
}


#ifndef PHM
#define PHM 0xFFFF
#endif
typedef const __attribute__((address_space(4))) Params* ParamsK;
DI Params getp() {
    ParamsK pp = (ParamsK)__builtin_amdgcn_kernarg_segment_ptr(); asm volatile("" : "+s"(pp));
    Params P;
#pragma unroll
    for (int i = 0; i < 32; ++i) P.in[i] = pp->in[i];
    P.out = pp->out; P.ws = pp->ws; return P;
}
#define GETP() const Params P = getp()
__global__ void __launch_bounds__(512, 2) fwd_kernel(Params Parg) {
    extern __shared__ __attribute__((aligned(16))) unsigned char lds[];
    cg::grid_group grid = cg::this_grid();
    unsigned char* L = (unsigned char*)lds;
    LAS unsigned char* LL = (LAS unsigned char*)lds;
    volatile LAS unsigned* xst = (volatile LAS unsigned*)(LL + LDS_BYTES - 32);
    if (threadIdx.x < 2) xst[threadIdx.x] = 0u;
    __syncthreads();
    XcdBarrier xb;
    { GETP(); xb = xcd_barrier_post(WSP(unsigned, OFF_BAR), xst); }
    if (PHM & 1) { GETP(); phase_prep(P, L); }
    if (gridDim.y == 0xFFFFu) grid.sync();
    xcd_barrier(xb);
    if (PHM & 2) { GETP(); pg8::StaticOrder S; S.init(MP, N0 + 256, gridDim.x, blockIdx.x); pg8::Gemm g{WSP(bf16_t, OFF_XN), WSP(bf16_t, OFF_W0T), MP, N0 + 256, 1024};
      EpiStoreBf16 E{WSP(bf16_t, OFF_U), N0, nullptr, WSP(float, OFF_DT)}; pg8::gemm_phase(LL, g, S, E); }
    { GETP(); SfU f{WSP(bf16_t, OFF_U), N0, nullptr, WSP(float, OFF_DT)}; sgemm<4>(WSP(bf16_t, OFF_XN), WSP(bf16_t, OFF_W0T), 1024, 145, 64 * 19, f, L); }
    xcd_barrier(xb);
    { GETP(); phase_convbc(P, L); }
    xcd_barrier(xb);
    if (PHM & 4) { GETP(); phase_mix0(P, L); }
    xcd_barrier(xb);
    { GETP(); phase_norm0(P); }
    xcd_barrier(xb);
    if (PHM & 8) { GETP(); pg8::StaticOrder S; S.init(MP, 1024, gridDim.x, blockIdx.x); pg8::Gemm g{WSP(bf16_t, OFF_MIX), WSP(bf16_t, OFF_WO0T), MP, 1024, 2048};
      EpiResid E{P.in[0], P.in[1], WSP(float, OFF_H), WSP(bf16_t, OFF_HB)}; pg8::gemm_phase(LL, g, S, E); }
    { GETP(); SfResid f{P.in[1], WSP(float, OFF_H), WSP(bf16_t, OFF_HB)}; sgemm<4>(WSP(bf16_t, OFF_MIX), WSP(bf16_t, OFF_WO0T), 2048, 32, 256, f, L); }
    xcd_barrier(xb);
    if (PHM & 16) { GETP(); pg8::StaticOrder S; S.init(MP, 1024, gridDim.x, blockIdx.x);
      pg8::Gemm g1{WSP(bf16_t, OFF_HB), WSP(bf16_t, OFF_WG0T), MP, 1024, 1024}; EpiGate E1{WSP(bf16_t, OFF_MIX)}; pg8::gemm_phase(LL, g1, S, E1); }
    { GETP(); SfGate f{WSP(bf16_t, OFF_MIX)};   sgemm<2>(WSP(bf16_t, OFF_HB), WSP(bf16_t, OFF_WG0T), 1024, 32, 256, f, L); }
    if (PHM & 16) { GETP(); pg8::StaticOrder S; S.init(MP, 1024, gridDim.x, blockIdx.x);
      pg8::Gemm g2{WSP(bf16_t, OFF_PB), WSP(bf16_t, OFF_WP0T), MP, 1024, 256};
      EpiPle E2{WSP(float, OFF_H), WSP(bf16_t, OFF_MIX), WSP(bf16_t, OFF_XN), P.in[9] + 1024, WSP(float, OFF_SS1)}; pg8::gemm_phase(LL, g2, S, E2); }
    { GETP(); SfPle f{WSP(float, OFF_H), WSP(bf16_t, OFF_MIX), WSP(bf16_t, OFF_XN), P.in[9] + 1024, WSP(float, OFF_SS1)}; sgemm<2>(WSP(bf16_t, OFF_PB), WSP(bf16_t, OFF_WP0T), 256, 32, 256, f, L); }
    xcd_barrier(xb);
    if (PHM & 32) { GETP(); pg8::StaticOrder S; S.init(MP, INC, gridDim.x, blockIdx.x); pg8::Gemm g{WSP(bf16_t, OFF_XN), WSP(bf16_t, OFF_W1T), MP, INC, 1024};
      EpiStoreBf16 E{WSP(bf16_t, OFF_U), INC, WSP(float, OFF_SS1), nullptr}; pg8::gemm_phase(LL, g, S, E); }
    { GETP(); SfU f{WSP(bf16_t, OFF_U), INC, WSP(float, OFF_SS1), nullptr}; sgemm<4>(WSP(bf16_t, OFF_XN), WSP(bf16_t, OFF_W1T), 1024, 256, 64 * 32, f, L); }
    xcd_barrier(xb);
    if (PHM & 64) { GETP(); phase_mix1(P, L); }
    xcd_barrier(xb);
    if (PHM & 128) { GETP(); pg8::StaticOrder S; S.init(MP, 1024, gridDim.x, blockIdx.x); pg8::Gemm g{WSP(bf16_t, OFF_MIX), WSP(bf16_t, OFF_WO1T), MP, 1024, 2048};
      EpiResid E{WSP(float, OFF_H), WSP(float, OFF_H) + (size_t)MP * 1024, WSP(float, OFF_H), WSP(bf16_t, OFF_HB)}; pg8::gemm_phase(LL, g, S, E); }
    { GETP(); SfResid f{WSP(float, OFF_H) + (size_t)MP * 1024, WSP(float, OFF_H), WSP(bf16_t, OFF_HB)}; sgemm<4>(WSP(bf16_t, OFF_MIX), WSP(bf16_t, OFF_WO1T), 2048, 32, 256, f, L); }
    xcd_barrier(xb);
    if (PHM & 256) { GETP(); pg8::StaticOrder S; S.init(MP, 1024, gridDim.x, blockIdx.x);
      pg8::Gemm g1{WSP(bf16_t, OFF_HB), WSP(bf16_t, OFF_WG1T), MP, 1024, 1024}; EpiGate E1{WSP(bf16_t, OFF_MIX)}; pg8::gemm_phase(LL, g1, S, E1); }
    { GETP(); SfGate f{WSP(bf16_t, OFF_MIX)};   sgemm<2>(WSP(bf16_t, OFF_HB), WSP(bf16_t, OFF_WG1T), 1024, 32, 256, f, L); }
    if (PHM & 256) { GETP(); pg8::StaticOrder S; S.init(MP, 1024, gridDim.x, blockIdx.x);
      pg8::Gemm g2{WSP(bf16_t, OFF_PB + PB_STRIDE), WSP(bf16_t, OFF_WP1T), MP, 1024, 256};
      EpiPle E2{WSP(float, OFF_H), WSP(bf16_t, OFF_MIX), nullptr, nullptr, WSP(float, OFF_SS2)}; pg8::gemm_phase(LL, g2, S, E2); }
    { GETP(); SfPle f{WSP(float, OFF_H), WSP(bf16_t, OFF_MIX), nullptr, nullptr, WSP(float, OFF_SS2)}; sgemm<2>(WSP(bf16_t, OFF_PB + PB_STRIDE), WSP(bf16_t, OFF_WP1T), 256, 32, 256, f, L); }
    xcd_barrier(xb);
    { GETP(); phase_final(P); }
}

extern "C" void kernel_launch(void* const* d_in, const int* in_sizes, int n_in, void* d_out, int out_size, void* d_ws, size_t ws_size, hipStream_t stream) {
    static int grid = 0;
    if (grid == 0) {
        if (n_in != 32 || ws_size < WS_END) { fprintf(stderr, "kernel_launch: need 32 inputs and %zu bytes of workspace (got %d, %zu)\n", (size_t)WS_END, n_in, ws_size); grid = -1; return; }
        int dev = 0, cus = 0, per_cu = 0;
        (void)hipGetDevice(&dev); (void)hipDeviceGetAttribute(&cus, hipDeviceAttributeMultiprocessorCount, dev);
        if (hipFuncSetAttribute((const void*)fwd_kernel, hipFuncAttributeMaxDynamicSharedMemorySize, LDS_BYTES) != hipSuccess) { fprintf(stderr, "kernel_launch: hipFuncSetAttribute failed\n"); grid = -1; return; }
        if (hipOccupancyMaxActiveBlocksPerMultiprocessor(&per_cu, (const void*)fwd_kernel, 512, LDS_BYTES) != hipSuccess || per_cu < 1) { fprintf(stderr, "kernel_launch: occupancy query says %d\n", per_cu); per_cu = 1; }
        (void)hipGetLastError();
        grid = cus;
    }
    if (grid < 0) return;
    Params p{};
    for (int i = 0; i < 32; ++i) p.in[i] = (const float*)d_in[i];
    p.out = (float*)d_out; p.ws = (unsigned char*)d_ws;
    if (hipMemsetAsync((char*)d_ws + OFF_BAR, 0, 16384, stream) != hipSuccess) { fprintf(stderr, "kernel_launch: memset of barrier words failed\n"); return; }
    void* args[] = {&p};
    hipError_t e = hipLaunchCooperativeKernel((const void*)fwd_kernel, dim3(grid), dim3(512), args, LDS_BYTES, stream);
    if (e != hipSuccess) fprintf(stderr, "cooperative launch failed: %s (grid %d)\n", hipGetErrorString(e), grid);
}
```

```cpp
#include <hip/hip_runtime.h>
#include <hip/hip_cooperative_groups.h>
#include <cstdio>
namespace cg = cooperative_groups;

#define LAS __attribute__((address_space(3)))
#define DI __device__ __forceinline__
typedef unsigned short bf16_t;
typedef short bf16x8 __attribute__((ext_vector_type(8)));
typedef float f32x4 __attribute__((ext_vector_type(4)));
typedef float f32x16 __attribute__((ext_vector_type(16)));

constexpr int MP = 16384, MS = 128, MV = MP + MS, MPAD = 16640;
constexpr int DM = 1024, INAB = 4624, N0 = 4608, INC = 8192;
constexpr float EPSF = 1e-6f;
constexpr size_t O_Y = 0, O_AHP = 16908288, O_ACP = 16916480, O_BSP = 16941056, O_BCP = 17989632, O_CP = 18026496,
                 O_AHS = 20123648, O_ACS = 20254720, O_BSS = 20647936, O_BCS = 37425152, O_CS = 38014976;
constexpr size_t al256(size_t x) { return (x + 255) & ~size_t(255); }
constexpr size_t OFF_CTL = 0;
constexpr size_t OFF_BAR = 256;
constexpr size_t OFF_SS1 = 256 + 16384;
constexpr size_t OFF_SS2 = OFF_SS1 + al256((size_t)MPAD * 4);
constexpr size_t OFF_SSB = OFF_SS2 + al256((size_t)MPAD * 4);
constexpr size_t OFF_DT  = OFF_SSB + al256((size_t)MPAD * 8);
constexpr size_t OFF_W0T = OFF_DT + al256((size_t)MV * 16 * 4);
constexpr size_t OFF_WO0T = OFF_W0T + (size_t)(N0 + 256) * 1024 * 2;
constexpr size_t OFF_WG0T = OFF_WO0T + (size_t)1024 * 2048 * 2;
constexpr size_t OFF_WP0T = OFF_WG0T + (size_t)1024 * 1024 * 2;
constexpr size_t OFF_W1T  = OFF_WP0T + (size_t)1024 * 256 * 2;
constexpr size_t OFF_WO1T = OFF_W1T + (size_t)INC * 1024 * 2;
constexpr size_t OFF_WG1T = OFF_WO1T + (size_t)1024 * 2048 * 2;
constexpr size_t OFF_WP1T = OFF_WG1T + (size_t)1024 * 1024 * 2;
constexpr size_t OFF_WRT  = OFF_WP1T + (size_t)1024 * 256 * 2;
constexpr size_t OFF_WIT  = OFF_WRT + (size_t)128 * 1024 * 2;
constexpr size_t OFF_XN   = OFF_WIT + (size_t)128 * 1024 * 2;
constexpr size_t OFF_MIX  = OFF_XN + (size_t)MPAD * 1024 * 2;
constexpr size_t OFF_H    = OFF_MIX + (size_t)MPAD * 2048 * 2;
constexpr size_t OFF_U    = OFF_H + al256((size_t)MV * 1024 * 4);
constexpr size_t OFF_HB   = OFF_U;
constexpr size_t OFF_PB   = OFF_U + al256((size_t)MV * INC * 2);
constexpr size_t PB_STRIDE = (size_t)MPAD * 256 * 2;
constexpr size_t WS_END   = OFF_PB + 2 * PB_STRIDE;
constexpr int LDS_BYTES = 160 * 1024;

struct Params { const float* in[32]; float* out; unsigned char* ws; };
#define WSP(T, off) ((T*)(P.ws + (off)))

typedef __bf16 bf16v2_t __attribute__((ext_vector_type(2)));
typedef float f32v2_t __attribute__((ext_vector_type(2)));
DI unsigned pack2(float lo, float hi) { f32v2_t v = {lo, hi}; bf16v2_t b = __builtin_convertvector(v, bf16v2_t); return __builtin_bit_cast(unsigned, b); }
DI bf16_t f2bf(float f) { return __builtin_bit_cast(bf16_t, (__bf16)f); }
DI float bf2f(bf16_t b) { return __uint_as_float(((unsigned)b) << 16); }
DI float bflo(unsigned w) { return __uint_as_float(w << 16); }
DI float bfhi(unsigned w) { return __uint_as_float(w & 0xFFFF0000u); }
DI float frcp(float x) { return __builtin_amdgcn_rcpf(x); }
DI float sigm(float x) { return frcp(1.f + __expf(-x)); }
DI float silu(float x) { return x * frcp(1.f + __expf(-x)); }
DI float softplus(float x) { return x > 20.f ? x : log1pf(__expf(x)); }
DI float wave_sum(float v) { for (int o = 32; o > 0; o >>= 1) v += __shfl_xor(v, o); return v; }
DI int otid() { int t = threadIdx.x; asm volatile("" : "+v"(t)); return t; }
DI void lds_barrier() { asm volatile("s_waitcnt lgkmcnt(0)" ::: "memory"); __builtin_amdgcn_s_barrier(); asm volatile("" ::: "memory"); }
DI int crow(int reg, int hh) { return (reg & 3) + 8 * (reg >> 2) + 4 * hh; }
DI void ld4bf(const bf16_t* p, float (&o)[4]) { uint2 w = *(const uint2*)p; o[0] = bflo(w.x); o[1] = bfhi(w.x); o[2] = bflo(w.y); o[3] = bfhi(w.y); }
typedef unsigned u32x2 __attribute__((ext_vector_type(2)));
typedef unsigned u32x4 __attribute__((ext_vector_type(4)));
DI u32x2 pack4v(float a, float b, float c, float d) { u32x2 r; r.x = pack2(a, b); r.y = pack2(c, d); return r; }
DI uint2 pack4(float a, float b, float c, float d) { uint2 r; r.x = pack2(a, b); r.y = pack2(c, d); return r; }
#define MFMA32(a, b, c) __builtin_amdgcn_mfma_f32_32x32x16_bf16((a), (b), (c), 0, 0, 0)
#define MFMA16(a, b, c) __builtin_amdgcn_mfma_f32_16x16x32_bf16((a), (b), (c), 0, 0, 0)
DI bf16x8 ldfrag(const bf16_t* base, int ld, int row0, int k0, int lane) { return *(const bf16x8*)(base + (row0 + (lane & 31)) * ld + k0 + 8 * (lane >> 5)); }
DI bf16x8 ldfrag_sw72(const bf16_t* base, int row0, int k0, int lane) { const int row = row0 + (lane & 31); return *(const bf16x8*)(base + row * 72 + ((k0 + 8 * (lane >> 5)) ^ (((row >> 4) & 7) * 8))); }
DI bf16x8 ldfrag16(const bf16_t* base, int ld, int row0, int k0, int lane) { return *(const bf16x8*)(base + (row0 + (lane & 15)) * ld + k0 + 8 * (lane >> 4)); }

namespace pg8 {
constexpr int BM = 256, BK = 64, HALF = 128, HTB = HALF * BK * 2, STAGE_BYTES = 8 * HTB, NXCD = 8, WGM = 8;
DI int lds_byte(int r, int c) { const int st = (r >> 4) * 2 + (c >> 5), rr = r & 15, cc = c & 31, ob = rr * 64 + cc * 2; return st * 1024 + (ob ^ (((ob >> 9) & 1) << 5)); }
DI void stage_rc(int b, int& R, int& C) { const int st = b / 1024, sb = b % 1024, swz = sb ^ (((sb >> 9) & 1) << 5); R = (st >> 1) * 16 + swz / 64; C = (st & 1) * 32 + (swz % 64) / 2; }
DI int perm32(int rho) { const int n = rho >> 4, i = rho & 15; return 8 * (i >> 2) + 4 * n + (i & 3); }
struct Unit { int pm, pn; };
struct Gemm { const bf16_t* A; const bf16_t* Bt; int M, N, K; };
struct StaticOrder {
    int nM, nN, nwg, G, c;
    DI void init(int M, int N, int G_, int c_) { nM = M / BM; nN = N / BM; nwg = nM * nN; G = G_; c = c_; }
    DI bool next(int i, Unit& u) const {
        const long L = (long)i * G + c; if (L >= nwg) return false;
        int wgid = (int)L; { const int q = nwg / NXCD, r = nwg % NXCD, xcd = wgid % NXCD, off = wgid / NXCD; wgid = (xcd < r ? xcd * (q + 1) : r * (q + 1) + (xcd - r) * q) + off; }
        const int nig = WGM * nN, gid = wgid / nig, fm = gid * WGM, gsz = (nM - fm) < WGM ? (nM - fm) : WGM;
        u.pm = fm + ((wgid % nig) % gsz); u.pn = (wgid % nig) / gsz; return true;
    }
};

template <class Epi>
DI void gemm_phase(LAS unsigned char* lds, const Gemm g, const StaticOrder& S, const Epi& E) {
    const int tid = otid(), wid = __builtin_amdgcn_readfirstlane(tid >> 6), lane = tid & 63, wr = wid >> 2, wc = wid & 3, fr = lane & 15, fq = lane >> 4;
    const int K = g.K, nt = K / BK;
    unsigned voffA[2], voffB[2];
#pragma unroll
    for (int i = 0; i < 2; ++i) { int R, C; stage_rc(tid * 16 + i * 8192, R, C); const int Rb = Epi::PERM ? ((R & ~31) + perm32(R & 31)) : R;
        voffA[i] = (unsigned)(R * K + C) * 2u; voffB[i] = (unsigned)(Rb * K + C) * 2u; }
    const size_t kstep = (size_t)(BK * 2);
    const size_t hstep = (size_t)HALF * K * 2;
    const size_t tstep = 2 * hstep;
    const unsigned ldsw = (unsigned)wid * 1024u;
    const int aoff = lds_byte(wr * 64 + fr, fq * 8), boff = lds_byte(wc * 32 + fr, fq * 8);
#define PG8_SA(b, h) (((b) * 2 + (h)) * HTB)
#define PG8_SB(b, h) ((4 + (b) * 2 + (h)) * HTB)
#define PG8_STAGE(bufoff, gbase, voff) do { _Pragma("unroll") for (int _i = 0; _i < 2; ++_i) \
        __builtin_amdgcn_global_load_lds((const unsigned*)((const char*)(gbase) + (voff)[_i]), (LAS unsigned*)(lds + (bufoff) + ldsw + _i * 8192), 16, 0, 0); } while (0)
#define PG8_LDA(dst, b, h) do { _Pragma("unroll") for (int m = 0; m < 4; ++m) _Pragma("unroll") for (int k = 0; k < 2; ++k) dst[m][k] = *(const LAS bf16x8*)(lds + PG8_SA(b, h) + aoff + m * 2048 + k * 1024); } while (0)
#define PG8_LDB(dst, b, h) do { _Pragma("unroll") for (int n = 0; n < 2; ++n) _Pragma("unroll") for (int k = 0; k < 2; ++k) dst[n][k] = *(const LAS bf16x8*)(lds + PG8_SB(b, h) + boff + n * 2048 + k * 1024); } while (0)
#define PG8_MMA(ai, bj, At, Bt) do { __builtin_amdgcn_s_setprio(1); _Pragma("unroll") for (int m = 0; m < 4; ++m) _Pragma("unroll") for (int n = 0; n < 2; ++n) _Pragma("unroll") for (int k = 0; k < 2; ++k) \
        acc[ai][bj][m][n] = __builtin_amdgcn_mfma_f32_16x16x32_bf16(Bt[n][k], At[m][k], acc[ai][bj][m][n], 0, 0, 0); __builtin_amdgcn_s_setprio(0); } while (0)
#define PG8_WAIT_V(n) asm volatile("s_waitcnt vmcnt(" #n ")" ::: "memory")
#define PG8_WAIT_L(n) asm volatile("s_waitcnt lgkmcnt(" #n ")" ::: "memory")
#define PG8_BAR __builtin_amdgcn_s_barrier()
#define PG8_SCHED __builtin_amdgcn_sched_barrier(0)
    Unit cur, nxt; int ui = 0;
    if (!S.next(0, cur)) return;
    f32x4 acc[2][2][4][2];
#pragma unroll
    for (int a = 0; a < 2; ++a)
#pragma unroll
        for (int b = 0; b < 2; ++b)
#pragma unroll
            for (int m = 0; m < 4; ++m)
#pragma unroll
                for (int n = 0; n < 2; ++n) acc[a][b][m][n] = (f32x4){0.f, 0.f, 0.f, 0.f};
    bf16x8 At[4][2], B0[2][2], B1[2][2];
    const char* cA = (const char*)g.A + (size_t)cur.pm * tstep; const char* cB = (const char*)g.Bt + (size_t)cur.pn * tstep;
    PG8_STAGE(PG8_SB(0, 0), cB, voffB); PG8_STAGE(PG8_SA(0, 0), cA, voffA); PG8_STAGE(PG8_SB(0, 1), cB + hstep, voffB); PG8_STAGE(PG8_SA(0, 1), cA + hstep, voffA);
    if (wr == 1) PG8_BAR;
    PG8_WAIT_V(4); PG8_BAR;
    PG8_STAGE(PG8_SB(1, 0), cB + kstep, voffB); PG8_STAGE(PG8_SA(1, 0), cA + kstep, voffA); PG8_STAGE(PG8_SB(1, 1), cB + hstep + kstep, voffB);
    PG8_WAIT_V(6); PG8_BAR;
    for (;;) {
        const bool has_next = S.next(ui + 1, nxt);
        const char* nA = has_next ? (const char*)g.A + (size_t)nxt.pm * tstep : cA; const char* nB = has_next ? (const char*)g.Bt + (size_t)nxt.pn * tstep : cB;
        for (int t = 0; t < nt; t += 2) {
            const bool last = (t == nt - 2);
            const char* a1 = cA + (size_t)(t + 1) * kstep;
            const char* a2 = last ? nA : cA + (size_t)(t + 2) * kstep; const char* b2 = last ? nB : cB + (size_t)(t + 2) * kstep;
            const char* a3 = a2 + kstep; const char* b3 = b2 + kstep;
            PG8_LDB(B0, 0, 0); PG8_SCHED; PG8_LDA(At, 0, 0); PG8_STAGE(PG8_SA(1, 1), a1 + hstep, voffA);
            PG8_WAIT_L(8); PG8_BAR; PG8_WAIT_L(0); PG8_MMA(0, 0, At, B0); PG8_BAR; PG8_SCHED;
            PG8_LDB(B1, 0, 1); PG8_STAGE(PG8_SB(0, 0), b2, voffB);
            PG8_BAR; PG8_WAIT_L(0); PG8_MMA(0, 1, At, B1); PG8_BAR;
            PG8_LDA(At, 0, 1); PG8_STAGE(PG8_SA(0, 0), a2, voffA);
            PG8_BAR; PG8_WAIT_L(0); PG8_MMA(1, 0, At, B0); PG8_BAR; PG8_SCHED;
            PG8_STAGE(PG8_SB(0, 1), b2 + hstep, voffB);
            PG8_WAIT_V(6); PG8_BAR; PG8_MMA(1, 1, At, B1); PG8_BAR;
            PG8_LDB(B0, 1, 0); PG8_SCHED; PG8_LDA(At, 1, 0); PG8_STAGE(PG8_SA(0, 1), a2 + hstep, voffA);
            PG8_WAIT_L(8); PG8_BAR; PG8_WAIT_L(0); PG8_MMA(0, 0, At, B0); PG8_BAR; PG8_SCHED;
            PG8_LDB(B1, 1, 1); PG8_STAGE(PG8_SB(1, 0), b3, voffB);
            PG8_BAR; PG8_WAIT_L(0); PG8_MMA(0, 1, At, B1); PG8_BAR;
            PG8_LDA(At, 1, 1); PG8_STAGE(PG8_SA(1, 0), a3, voffA);
            PG8_BAR; PG8_WAIT_L(0); PG8_MMA(1, 0, At, B0); PG8_BAR; PG8_SCHED;
            PG8_STAGE(PG8_SB(1, 1), b3 + hstep, voffB);
            PG8_WAIT_V(6); PG8_BAR; PG8_MMA(1, 1, At, B1); PG8_BAR;
        }
        E(acc, cur, wr, wc, fr, fq);
        if (!has_next) break;
#pragma unroll
        for (int a = 0; a < 2; ++a)
#pragma unroll
            for (int b = 0; b < 2; ++b)
#pragma unroll
                for (int m = 0; m < 4; ++m)
#pragma unroll
                    for (int n = 0; n < 2; ++n) acc[a][b][m][n] = (f32x4){0.f, 0.f, 0.f, 0.f};
        cur = nxt; cA = nA; cB = nB; ++ui;
    }
    PG8_WAIT_V(0);
    if (wr == 0) PG8_BAR;
    PG8_BAR;
#undef PG8_SA
#undef PG8_SB
#undef PG8_STAGE
#undef PG8_LDA
#undef PG8_LDB
#undef PG8_MMA
#undef PG8_WAIT_V
#undef PG8_WAIT_L
#undef PG8_BAR
#undef PG8_SCHED
}
}

struct EpiStoreBf16 {
    static constexpr bool PERM = true;
    bf16_t* O; int ldc; const float* ss; float* DT;
    DI void operator()(const f32x4 (&acc)[2][2][4][2], const pg8::Unit& u, int wr, int wc, int fr, int fq) const {
        const int row0 = u.pm * 256 + wr * 64 + fr, col0 = u.pn * 256 + wc * 32 + 8 * fq;
        if (u.pn * 256 >= ldc) {
            if (wc == 0 && fq < 2) {
#pragma unroll
                for (int ai = 0; ai < 2; ++ai)
#pragma unroll
                    for (int m = 0; m < 4; ++m) { const int row = row0 + ai * 128 + m * 16;
                        if (row < MV) { *(f32x4*)(DT + (size_t)row * 16 + 8 * fq) = acc[ai][0][m][0]; *(f32x4*)(DT + (size_t)row * 16 + 8 * fq + 4) = acc[ai][0][m][1]; } }
            }
            return;
        }
#pragma unroll
        for (int ai = 0; ai < 2; ++ai)
#pragma unroll
            for (int m = 0; m < 4; ++m) {
                const int row = row0 + ai * 128 + m * 16;
                if (row < MV) {
                    const float sc = ss ? rsqrtf(ss[row] * (1.f / 1024.f) + EPSF) : 1.f;
                    bf16_t* rp = O + (size_t)row * ldc + col0;
#pragma unroll
                    for (int bj = 0; bj < 2; ++bj) {
                        const f32x4 v0 = acc[ai][bj][m][0] * sc, v1 = acc[ai][bj][m][1] * sc;
                        uint4 w; w.x = pack2(v0[0], v0[1]); w.y = pack2(v0[2], v0[3]); w.z = pack2(v1[0], v1[1]); w.w = pack2(v1[2], v1[3]);
                        *(uint4*)(rp + bj * 128) = w;
                    }
                }
            }
    }
};
struct EpiResid {
    static constexpr bool PERM = false;
    const float* rp_prompt; const float* rp_sample;
    float* H; bf16_t* HB;
    DI void operator()(const f32x4 (&acc)[2][2][4][2], const pg8::Unit& u, int wr, int wc, int fr, int fq) const {
        const int row0 = u.pm * 256 + wr * 64 + fr, col0 = u.pn * 256 + wc * 32 + 4 * fq;
#pragma unroll
        for (int ai = 0; ai < 2; ++ai)
#pragma unroll
            for (int m = 0; m < 4; ++m) {
                const int row = row0 + ai * 128 + m * 16;
                if (row < MV) {
                    const float* rs = (row < MP ? rp_prompt + (size_t)row * 1024 : rp_sample + (size_t)(row - MP) * 1024) + col0;
                    float* hp = H + (size_t)row * 1024 + col0; bf16_t* bp = HB + (size_t)row * 1024 + col0;
#pragma unroll
                    for (int bj = 0; bj < 2; ++bj)
#pragma unroll
                        for (int n = 0; n < 2; ++n) {
                            const int co = bj * 128 + n * 16;
                            const f32x4 v = acc[ai][bj][m][n] + *(const f32x4*)(rs + co);
                            *(f32x4*)(hp + co) = v; *(uint2*)(bp + co) = pack4(v[0], v[1], v[2], v[3]);
                        }
                }
            }
    }
};
struct EpiGate {
    static constexpr bool PERM = false;
    bf16_t* Gt;
    DI void operator()(const f32x4 (&acc)[2][2][4][2], const pg8::Unit& u, int wr, int wc, int fr, int fq) const {
        const int row0 = u.pm * 256 + wr * 64 + fr, col0 = u.pn * 256 + wc * 32 + 4 * fq;
#pragma unroll
        for (int ai = 0; ai < 2; ++ai)
#pragma unroll
            for (int m = 0; m < 4; ++m) {
                const int row = row0 + ai * 128 + m * 16;
                if (row < MV) {
                    bf16_t* gp = Gt + (size_t)row * 1024 + col0;
#pragma unroll
                    for (int bj = 0; bj < 2; ++bj)
#pragma unroll
                        for (int n = 0; n < 2; ++n) {
                            const f32x4 a = acc[ai][bj][m][n];
                            *(uint2*)(gp + bj * 128 + n * 16) = pack4(sigm(a[0]), sigm(a[1]), sigm(a[2]), sigm(a[3]));
                        }
                }
            }
    }
};
struct EpiPle {
    static constexpr bool PERM = false;
    float* H; const bf16_t* Gt; bf16_t* XN; const float* nw; float* SS;
    DI void operator()(const f32x4 (&acc)[2][2][4][2], const pg8::Unit& u, int wr, int wc, int fr, int fq) const {
        const int row0 = u.pm * 256 + wr * 64 + fr, col0 = u.pn * 256 + wc * 32 + 4 * fq;
#pragma unroll
        for (int ai = 0; ai < 2; ++ai)
#pragma unroll
            for (int m = 0; m < 4; ++m) {
                const int row = row0 + ai * 128 + m * 16;
                float ssum = 0.f;
                if (row < MV) {
                    float* hp = H + (size_t)row * 1024 + col0; const bf16_t* gp = Gt + (size_t)row * 1024 + col0;
#pragma unroll
                    for (int bj = 0; bj < 2; ++bj)
#pragma unroll
                        for (int n = 0; n < 2; ++n) {
                            const int co = bj * 128 + n * 16;
                            float gq[4]; ld4bf(gp + co, gq); const f32x4 v = *(const f32x4*)(hp + co) + (f32x4){gq[0], gq[1], gq[2], gq[3]} * acc[ai][bj][m][n];
                            *(f32x4*)(hp + co) = v;
                            ssum += v[0] * v[0] + v[1] * v[1] + v[2] * v[2] + v[3] * v[3];
                            if (XN) { const f32x4 w = *(const f32x4*)(nw + col0 + co); *(uint2*)(XN + (size_t)row * 1024 + col0 + co) = pack4(v[0] * w[0], v[1] * w[1], v[2] * w[2], v[3] * w[3]); }
                        }
                }
                ssum += __shfl_xor(ssum, 16); ssum += __shfl_xor(ssum, 32);
                if (fq == 0 && row < MV) atomicAdd(SS + row, ssum);
            }
    }
};

template <int KS, class F>
DI void sgemm(const bf16_t* A, const bf16_t* Bt, int K, int ncolt, int nwg_main, const F& f, unsigned char* L) {
    constexpr int RT = 8 / KS, NRS = 128 / (16 * RT);
    const int tid = otid(), lane = tid & 63, wid = __builtin_amdgcn_readfirstlane(tid >> 6), rt = wid % RT, ks = wid / RT;
    const int G = gridDim.x, off = nwg_main % G, Kh = K / KS;
    int li = blockIdx.x, nl = G;
    if (off != 0) { if ((int)blockIdx.x < off) return; li = blockIdx.x - off; nl = G - off; }
    float* red = (float*)L;
    for (int t = li; t < ncolt * NRS; t += nl) {
        const int ct = t / NRS, rs = t % NRS;
        const bf16_t* ap = A + (size_t)(MP + rs * 16 * RT + rt * 16 + (lane & 15)) * K + ks * Kh + 8 * (lane >> 4);
        const bf16_t* bp0 = Bt + (size_t)(ct * 32 + (lane & 15)) * K + ks * Kh + 8 * (lane >> 4);
        const bf16_t* bp1 = bp0 + (size_t)16 * K;
        f32x4 acc0 = {0.f, 0.f, 0.f, 0.f}, acc1 = {0.f, 0.f, 0.f, 0.f};
        bf16x8 a0[4], a1[4], p0[4], p1[4], q0[4], q1[4];
#define SG_LOAD(av, pv, qv, kk) do { _Pragma("unroll") for (int q_ = 0; q_ < 4; ++q_) { av[q_] = *(const bf16x8*)(ap + (kk) + q_ * 32); pv[q_] = *(const bf16x8*)(bp0 + (kk) + q_ * 32); qv[q_] = *(const bf16x8*)(bp1 + (kk) + q_ * 32); } } while (0)
#define SG_MMA(av, pv, qv) do { _Pragma("unroll") for (int q_ = 0; q_ < 4; ++q_) { acc0 = MFMA16(av[q_], pv[q_], acc0); acc1 = MFMA16(av[q_], qv[q_], acc1); } } while (0)
        SG_LOAD(a0, p0, q0, 0);
        for (int k0 = 0; k0 < Kh; k0 += 256) {
            if (k0 + 128 < Kh) SG_LOAD(a1, p1, q1, k0 + 128);
            SG_MMA(a0, p0, q0);
            if (k0 + 256 < Kh) SG_LOAD(a0, p0, q0, k0 + 256);
            if (k0 + 128 < Kh) SG_MMA(a1, p1, q1);
        }
#undef SG_LOAD
#undef SG_MMA
        if (ks > 0) { float* rp = red + (((ks - 1) * RT + rt) * 64 + lane) * 8; *(f32x4*)rp = acc0; *(f32x4*)(rp + 4) = acc1; }
        lds_barrier();
        if (ks == 0) {
#pragma unroll
            for (int j = 0; j < KS - 1; ++j) { const float* rp = red + ((j * RT + rt) * 64 + lane) * 8; acc0 += *(const f32x4*)rp; acc1 += *(const f32x4*)(rp + 4); }
#pragma unroll
            for (int reg = 0; reg < 4; ++reg) {
                const int row = MP + rs * 16 * RT + rt * 16 + (lane >> 4) * 4 + reg, col = ct * 32 + (lane & 15);
                f(row, col, acc0[reg], lane); f(row, col + 16, acc1[reg], lane);
            }
        }
        lds_barrier();
    }
}
struct SfU { bf16_t* O; int ldc; const float* ss; float* DT;
    DI void operator()(int row, int col, float v, int) const {
        if (col >= ldc) { if (col < ldc + 16) DT[(size_t)row * 16 + col - ldc] = v; return; }
        const float sc = ss ? rsqrtf(ss[row] * (1.f / 1024.f) + EPSF) : 1.f; O[(size_t)row * ldc + col] = f2bf(v * sc); } };
struct SfResid { const float* rs; float* H; bf16_t* HB;
    DI void operator()(int row, int col, float v, int) const { const float h = rs[(size_t)(row - MP) * 1024 + col] + v; H[(size_t)row * 1024 + col] = h; HB[(size_t)row * 1024 + col] = f2bf(h); } };
struct SfGate { bf16_t* Gt; DI void operator()(int row, int col, float v, int) const { Gt[(size_t)row * 1024 + col] = f2bf(sigm(v)); } };
struct SfPle { float* H; const bf16_t* Gt; bf16_t* XN; const float* nw; float* SS;
    DI void operator()(int row, int col, float v, int lane) const {
        const size_t o = (size_t)row * 1024 + col; const float h = H[o] + bf2f(Gt[o]) * v; H[o] = h;
        if (XN) XN[o] = f2bf(h * nw[col]);
        float ss = h * h; ss += __shfl_xor(ss, 1); ss += __shfl_xor(ss, 2); ss += __shfl_xor(ss, 4); ss += __shfl_xor(ss, 8);
        if ((lane & 15) == 0) atomicAdd(SS + row, ss); } };

DI void transpose_tile_w(const float* src, int lds_, bf16_t* dst, int ldd, int k0, int n0, int nvalid, float* tile, int lane) {
    const float* sp = src + (size_t)k0 * lds_ + n0 + lane;
#pragma unroll
    for (int bt = 0; bt < 4; ++bt) {
        float v[16];
#pragma unroll
        for (int r = 0; r < 16; ++r) v[r] = (lane < nvalid) ? sp[(size_t)(bt * 16 + r) * lds_] : 0.f;
#pragma unroll
        for (int r = 0; r < 16; ++r) tile[(bt * 16 + r) * 65 + lane] = v[r];
    }
    const int koct = lane & 7;
#pragma unroll
    for (int p = 0; p < 8; ++p) {
        const int nn = (lane >> 3) + 8 * p;
        const float* tp = tile + (koct * 8) * 65 + nn;
        uint4 w;
        w.x = pack2(tp[0], tp[65]); w.y = pack2(tp[2 * 65], tp[3 * 65]); w.z = pack2(tp[4 * 65], tp[5 * 65]); w.w = pack2(tp[6 * 65], tp[7 * 65]);
        *(uint4*)(dst + (size_t)(n0 + nn) * ldd + k0 + koct * 8) = w;
    }
}
DI void transpose_job(const float* src, int lds_, bf16_t* dst, int ldd, int K, int N, int nvalid_last, int& base, float* tile, int gw, int nwv, int lane) {
    const int ntn = (N + 63) / 64, nt = (K / 64) * ntn;
    const int first = (gw - (base % nwv) + nwv) % nwv;
    for (int t = first; t < nt; t += nwv) { const int tn = t % ntn; transpose_tile_w(src, lds_, dst, ldd, (t / ntn) * 64, tn * 64, (tn == ntn - 1) ? nvalid_last : 64, tile, lane); }
    base += nt;
}
DI void l1_weight_tile(const Params& P, int t, float* tile, int lane) {
    if (t < 2048) transpose_tile_w(P.in[26], INC, WSP(bf16_t, OFF_W1T), 1024, (t >> 7) * 64, (t & 127) * 64, 64, tile, lane);
    else if (t < 2560) { t -= 2048; transpose_tile_w(P.in[29], 1024, WSP(bf16_t, OFF_WO1T), 2048, (t >> 4) * 64, (t & 15) * 64, 64, tile, lane); }
    else if (t < 2816) { t -= 2560; transpose_tile_w(P.in[31] + 1024 * 1024, 1024, WSP(bf16_t, OFF_WG1T), 1024, (t >> 4) * 64, (t & 15) * 64, 64, tile, lane); }
    else if (t < 2880) { t -= 2816; transpose_tile_w(P.in[30] + 256 * 1024, 1024, WSP(bf16_t, OFF_WP1T), 256, (t >> 4) * 64, (t & 15) * 64, 64, tile, lane); }
    else if (t < 3392) { t -= 2880; transpose_tile_w(P.in[25], 1024, WSP(bf16_t, OFF_WO0T), 2048, (t >> 4) * 64, (t & 15) * 64, 64, tile, lane); }
    else if (t < 3648) { t -= 3392; transpose_tile_w(P.in[31], 1024, WSP(bf16_t, OFF_WG0T), 1024, (t >> 4) * 64, (t & 15) * 64, 64, tile, lane); }
    else { t -= 3648; transpose_tile_w(P.in[30], 1024, WSP(bf16_t, OFF_WP0T), 256, (t >> 4) * 64, (t & 15) * 64, 64, tile, lane); }
}
DI void phase_prep(const Params& P, unsigned char* L) {
    const int tid = otid(), lane = tid & 63, wid = tid >> 6;
    const int gw = blockIdx.x * 8 + wid, nwv = gridDim.x * 8;
    { float* z = WSP(float, OFF_SS1); const int n = (int)((OFF_DT - OFF_SS1) / 4);
      for (int i = blockIdx.x * 512 + tid; i < n; i += gridDim.x * 512) z[i] = 0.f;
      if (blockIdx.x == 0 && tid < 64) WSP(unsigned, OFF_CTL)[tid] = 0u; }
    { float* tile = (float*)L + wid * (64 * 65); int base = 0;
      transpose_job(P.in[11], INAB, WSP(bf16_t, OFF_W0T), 1024, 1024, N0, 64, base, tile, gw, nwv, lane);
      transpose_job(P.in[11] + N0, INAB, WSP(bf16_t, OFF_W0T) + (size_t)N0 * 1024, 1024, 1024, 16, 16, base, tile, gw, nwv, lane);
      transpose_job(P.in[14], 128, WSP(bf16_t, OFF_WRT), 1024, 1024, 128, 64, base, tile, gw, nwv, lane);
      transpose_job(P.in[16], 128, WSP(bf16_t, OFF_WIT), 1024, 1024, 128, 64, base, tile, gw, nwv, lane); }
    { const float* nwp = P.in[9]; bf16_t* XN = WSP(bf16_t, OFF_XN);
      f32x4 w4[4];
#pragma unroll
      for (int i = 0; i < 4; ++i) w4[i] = *(const f32x4*)(nwp + lane * 4 + 256 * i);
      for (int r0 = gw * 2; r0 < MV; r0 += nwv * 2) {
          f32x4 x[2][4];
#pragma unroll
          for (int q = 0; q < 2; ++q) { const int r = r0 + q; const float* src = r < MP ? P.in[0] + (size_t)r * 1024 : P.in[1] + (size_t)(r - MP) * 1024;
#pragma unroll
              for (int i = 0; i < 4; ++i) x[q][i] = *(const f32x4*)(src + lane * 4 + 256 * i); }
#pragma unroll
          for (int q = 0; q < 2; ++q) {
              float ss = 0.f;
#pragma unroll
              for (int i = 0; i < 4; ++i) ss += x[q][i][0] * x[q][i][0] + x[q][i][1] * x[q][i][1] + x[q][i][2] * x[q][i][2] + x[q][i][3] * x[q][i][3];
              ss = wave_sum(ss); const float rstd = rsqrtf(ss * (1.f / 1024.f) + EPSF);
#pragma unroll
              for (int i = 0; i < 4; ++i) { const f32x4 v = x[q][i] * rstd * w4[i]; *(uint2*)(XN + (size_t)(r0 + q) * 1024 + lane * 4 + 256 * i) = pack4(v[0], v[1], v[2], v[3]); }
          }
      } }
}
DI void convert_p_chunk(const Params& P, int layer, int chunk, int tid) {
    bf16_t* PB = WSP(bf16_t, OFF_PB + (size_t)layer * PB_STRIDE);
    const float* pp = P.in[2] + (size_t)layer * MP * 256; const float* ps = P.in[3] + (size_t)layer * MS * 256;
#pragma unroll 4
    for (int j = 0; j < 16; ++j) {
        const int i = chunk * 8192 + j * 512 + tid;
        if (i < MV * 64) {
            const int row = i >> 6, c4 = (i & 63) * 4;
            const f32x4 v = *(const f32x4*)((row < MP ? pp + (size_t)row * 256 : ps + (size_t)(row - MP) * 256) + c4);
            *(uint2*)(PB + (size_t)row * 256 + c4) = pack4(v[0], v[1], v[2], v[3]);
        }
    }
}

constexpr size_t OFF_XT = OFF_XN;
constexpr size_t OFF_CN = OFF_H;
constexpr size_t OFF_BN = OFF_CN + (size_t)MP * 256 * 2;
constexpr size_t OFF_BT = OFF_BN + (size_t)MP * 256 * 2;
DI void phase_convbc(const Params& P, unsigned char* L) {
    const bf16_t* U = WSP(bf16_t, OFF_U);
    bf16_t* XT = WSP(bf16_t, OFF_XT); bf16_t* CN = WSP(bf16_t, OFF_CN); bf16_t* CBG = WSP(bf16_t, OFF_BN); bf16_t* BT = WSP(bf16_t, OFF_BT);
    const int tid = otid();
    for (int task = blockIdx.x; task < 256; task += gridDim.x) {
        const int b = task >> 5, c = (task >> 1) & 15, g = task & 1, lane = tid & 63, wid = tid >> 6, hh = lane >> 5, l31 = lane & 31;
        bf16_t* Cs = (bf16_t*)L; bf16_t* Bs = Cs + 128 * 136;
        const int quad = tid & 63, isC = quad >> 5, n0 = (quad & 31) * 4, cch = 1024 + isC * 256 + g * 128 + n0, t0 = (tid >> 6) * 16, tg0 = c * 128 + t0;
        const size_t tile = ((size_t)((b * 16 + c) * 2 + g)) * 128 * 128;
        float cw[4][4], cbias[4];
#pragma unroll
        for (int kk = 0; kk < 4; ++kk) { const f32x4 w = *(const f32x4*)(P.in[19] + kk * 1536 + cch); cw[kk][0] = w[0]; cw[kk][1] = w[1]; cw[kk][2] = w[2]; cw[kk][3] = w[3]; }
        { const f32x4 w = *(const f32x4*)(P.in[20] + cch); cbias[0] = w[0]; cbias[1] = w[1]; cbias[2] = w[2]; cbias[3] = w[3]; }
        const unsigned voff = (unsigned)((b * 2048 + tg0) * N0 + 3072 + cch);
        u32x2 raw[19];
#pragma unroll
        for (int j = 0; j < 19; ++j) raw[j] = (tg0 + j - 3 >= 0) ? *(const u32x2*)((U + (j - 3) * N0) + voff) : (u32x2){0u, 0u};
        lds_barrier();
        unsigned bt[4][8];
#pragma unroll
        for (int j = 0; j < 16; j += 2) {
            float y[2][4];
#pragma unroll
            for (int q = 0; q < 2; ++q) {
                const float x0[4] = {bflo(raw[j + q].x), bfhi(raw[j + q].x), bflo(raw[j + q].y), bfhi(raw[j + q].y)};
                const float x1[4] = {bflo(raw[j + q + 1].x), bfhi(raw[j + q + 1].x), bflo(raw[j + q + 1].y), bfhi(raw[j + q + 1].y)};
                const float x2[4] = {bflo(raw[j + q + 2].x), bfhi(raw[j + q + 2].x), bflo(raw[j + q + 2].y), bfhi(raw[j + q + 2].y)};
                const float x3[4] = {bflo(raw[j + q + 3].x), bfhi(raw[j + q + 3].x), bflo(raw[j + q + 3].y), bfhi(raw[j + q + 3].y)};
#pragma unroll
                for (int e = 0; e < 4; ++e) y[q][e] = silu(cbias[e] + cw[0][e] * x0[e] + cw[1][e] * x1[e] + cw[2][e] * x2[e] + cw[3][e] * x3[e]);
                const u32x2 pk = pack4v(y[q][0], y[q][1], y[q][2], y[q][3]);
                *(u32x2*)((isC ? Cs : Bs) + (t0 + j + q) * 136 + n0) = pk;
                if (isC) *(u32x2*)(CN + tile + (size_t)(t0 + j + q) * 128 + n0) = pk;
            }
#pragma unroll
            for (int e = 0; e < 4; ++e) bt[e][j >> 1] = pack2(y[0][e], y[1][e]);
        }
        if (!isC) {
#pragma unroll
            for (int e = 0; e < 4; ++e) { bf16_t* dp = BT + tile + (size_t)(n0 + e) * 128 + t0;
                *(u32x4*)dp = (u32x4){bt[e][0], bt[e][1], bt[e][2], bt[e][3]}; *(u32x4*)(dp + 8) = (u32x4){bt[e][4], bt[e][5], bt[e][6], bt[e][7]}; }
        }
        lds_barrier();
        const int rb = (wid >> 1) * 32, cb0 = (wid & 1) * 64;
        f32x16 cbA[2];
#pragma unroll
        for (int i = 0; i < 16; ++i) { cbA[0][i] = 0.f; cbA[1][i] = 0.f; }
#pragma unroll
        for (int ks = 0; ks < 8; ++ks) {
            const bf16x8 a = ldfrag(Cs, 136, rb, ks * 16, lane);
            cbA[0] = MFMA32(a, ldfrag(Bs, 136, cb0, ks * 16, lane), cbA[0]);
            cbA[1] = MFMA32(a, ldfrag(Bs, 136, cb0 + 32, ks * 16, lane), cbA[1]);
        }
#pragma unroll
        for (int j = 0; j < 2; ++j)
#pragma unroll
            for (int reg = 0; reg < 16; ++reg) CBG[tile + (size_t)(rb + crow(reg, hh)) * 128 + cb0 + j * 32 + l31] = f2bf(cbA[j][reg]);
        lds_barrier();
    }
    for (int idx = blockIdx.x * 512 + tid; idx < 2048 * 256; idx += gridDim.x * 512) {
        const int quad = idx & 255, tgp = idx >> 8, b = tgp >> 8, t0 = (tgp & 255) * 8, cch = quad * 4;
        float cw[4][4], cbias[4];
#pragma unroll
        for (int kk = 0; kk < 4; ++kk) { const f32x4 w = *(const f32x4*)(P.in[19] + kk * 1536 + cch); cw[kk][0] = w[0]; cw[kk][1] = w[1]; cw[kk][2] = w[2]; cw[kk][3] = w[3]; }
        { const f32x4 w = *(const f32x4*)(P.in[20] + cch); cbias[0] = w[0]; cbias[1] = w[1]; cbias[2] = w[2]; cbias[3] = w[3]; }
        const unsigned voff = (unsigned)((b * 2048 + t0) * N0 + 3072 + cch);
        u32x2 raw[11];
#pragma unroll
        for (int j = 0; j < 11; ++j) raw[j] = (t0 + j - 3 >= 0) ? *(const u32x2*)((U + (j - 3) * N0) + voff) : (u32x2){0u, 0u};
        float y[8][4];
#pragma unroll
        for (int j = 0; j < 8; ++j) {
            const float x0[4] = {bflo(raw[j].x), bfhi(raw[j].x), bflo(raw[j].y), bfhi(raw[j].y)};
            const float x1[4] = {bflo(raw[j + 1].x), bfhi(raw[j + 1].x), bflo(raw[j + 1].y), bfhi(raw[j + 1].y)};
            const float x2[4] = {bflo(raw[j + 2].x), bfhi(raw[j + 2].x), bflo(raw[j + 2].y), bfhi(raw[j + 2].y)};
            const float x3[4] = {bflo(raw[j + 3].x), bfhi(raw[j + 3].x), bflo(raw[j + 3].y), bfhi(raw[j + 3].y)};
#pragma unroll
            for (int e = 0; e < 4; ++e) y[j][e] = silu(cbias[e] + cw[0][e] * x0[e] + cw[1][e] * x1[e] + cw[2][e] * x2[e] + cw[3][e] * x3[e]);
        }
        const int c = t0 >> 7, tl = t0 & 127;
#pragma unroll
        for (int e = 0; e < 4; ++e) *(u32x4*)(XT + ((size_t)((b * 16 + c) * 1024 + cch + e)) * 128 + tl) = (u32x4){pack2(y[0][e], y[1][e]), pack2(y[2][e], y[3][e]), pack2(y[4][e], y[5][e]), pack2(y[6][e], y[7][e])};
    }
}
DI void ssd_prompt_item(const Params& P, unsigned char* L, int item) {
    const int b = item >> 4, h = item & 15, g = h >> 3;
    const int tid0 = otid(), wid = tid0 >> 6;
    bf16_t* Cs = (bf16_t*)L;
    bf16_t* Ws = Cs + 128 * 136;
    bf16_t* BsT = Ws + 128 * 136;
    bf16_t* XsT = BsT + 128 * 136;
    bf16_t* St = XsT + 64 * 136;
    bf16_t* XwT = St + 64 * 136;
    float* dtvB = (float*)(XwT + 64 * 136); float* acsB = dtvB + 256; float* wvB = acsB + 256;
    const bf16_t* U = WSP(bf16_t, OFF_U); const float* DT = WSP(float, OFF_DT); bf16_t* MIX = WSP(bf16_t, OFF_MIX); float* SSB = WSP(float, OFF_SSB);
    const float a_neg = -__expf(P.in[22][h]), dtb = P.in[21][h], Dh = P.in[23][h];
    f32x16 accS;
#pragma unroll
    for (int i = 0; i < 16; ++i) accS[i] = 0.f;
    lds_barrier();
    for (int i = tid0; i < 64 * 136; i += 512) St[i] = 0;
    float dtr0 = 0.f, dtr1 = 0.f;
#define SSD_DTLOAD(cc) do { if (wid == 0) { const float* dp_ = DT + (size_t)(b * 2048 + (cc) * 128 + (tid0 & 63)) * 16 + h; dtr0 = dp_[0]; dtr1 = dp_[64 * 16]; } } while (0)
#define SSD_SCAN(buf) do { if (wid == 0) { const int ln_ = tid0 & 63; const float d0_ = softplus(dtr0 + dtb), d1_ = softplus(dtr1 + dtb); float v0_ = d0_ * a_neg, v1_ = d1_ * a_neg; \
        _Pragma("unroll") for (int o_ = 1; o_ < 64; o_ <<= 1) { const float n0_ = __shfl_up(v0_, o_), n1_ = __shfl_up(v1_, o_); if (ln_ >= o_) { v0_ += n0_; v1_ += n1_; } } \
        v1_ += __shfl(v0_, 63); const float al_ = __shfl(v1_, 63); \
        dtvB[(buf) * 128 + ln_] = d0_; dtvB[(buf) * 128 + 64 + ln_] = d1_; acsB[(buf) * 128 + ln_] = v0_; acsB[(buf) * 128 + 64 + ln_] = v1_; \
        wvB[(buf) * 128 + ln_] = __expf(al_ - v0_) * d0_; wvB[(buf) * 128 + 64 + ln_] = __expf(al_ - v1_) * d1_; } } while (0)
    SSD_DTLOAD(0); SSD_SCAN(0); SSD_DTLOAD(1);
    u32x4 tC[4], tB[4], tT[4], tX[2];
    for (int c = 0; c < 16; ++c) {
        const int row0 = b * 2048 + c * 128;
        lds_barrier();
        int zv = 0; asm volatile("" : "+v"(zv));
        const int tid = tid0 + zv, lane = tid & 63, hh = lane >> 5, l31 = lane & 31;
        const int prow = tid >> 4, pcol = (tid & 15) * 8;
        const float* dtv = dtvB + (c & 1) * 128; const float* acs = acsB + (c & 1) * 128; const float* wv = wvB + (c & 1) * 128;
        if (c + 1 < 16) { SSD_SCAN((c + 1) & 1); if (c + 2 < 16) SSD_DTLOAD(c + 2); }
        if (c == 0) {
            const size_t tb_ = ((size_t)((b * 16 + c) * 2 + g)) * 128 * 128 + (size_t)prow * 128 + pcol;
            const u32x4* pc = (const u32x4*)(WSP(bf16_t, OFF_CN) + tb_); const u32x4* pb = (const u32x4*)(WSP(bf16_t, OFF_BN) + tb_); const u32x4* pt = (const u32x4*)(WSP(bf16_t, OFF_BT) + tb_);
            const u32x4* px = (const u32x4*)(WSP(bf16_t, OFF_XT) + ((size_t)((b * 16 + c) * 1024 + h * 64 + prow)) * 128 + pcol);
#pragma unroll
            for (int i = 0; i < 4; ++i) { tC[i] = pc[i * 512]; tB[i] = pb[i * 512]; tT[i] = pt[i * 512]; }
            tX[0] = px[0]; tX[1] = px[512];
        }
        const float a_last = acs[127];
        float asv[8], dsv[8];
        { const f32x4 a0 = *(const f32x4*)(acs + pcol), a1 = *(const f32x4*)(acs + pcol + 4), d0 = *(const f32x4*)(dtv + pcol), d1 = *(const f32x4*)(dtv + pcol + 4);
#pragma unroll
          for (int q = 0; q < 4; ++q) { asv[q] = a0[q]; asv[q + 4] = a1[q]; dsv[q] = d0[q]; dsv[q + 4] = d1[q]; } }
#pragma unroll
        for (int i = 0; i < 4; ++i) {
            *(u32x4*)(Cs + (prow + 32 * i) * 136 + pcol) = tC[i]; *(u32x4*)(BsT + (prow + 32 * i) * 136 + pcol) = tT[i];
            {
                const int t = prow + 32 * i; const float at = acs[t];
                const unsigned cw_[4] = {tB[i].x, tB[i].y, tB[i].z, tB[i].w};
                float wv_[8];
#pragma unroll
                for (int q = 0; q < 8; ++q) { const int sidx = pcol + q; const float cbv = (q & 1) ? bfhi(cw_[q >> 1]) : bflo(cw_[q >> 1]);
                    wv_[q] = (sidx <= t) ? cbv * __expf(at - asv[q]) * dsv[q] : 0.f; }
                *(u32x4*)(Ws + t * 136 + pcol) = (u32x4){pack2(wv_[0], wv_[1]), pack2(wv_[2], wv_[3]), pack2(wv_[4], wv_[5]), pack2(wv_[6], wv_[7])};
            }
        }
        *(u32x4*)(XsT + prow * 136 + pcol) = tX[0]; *(u32x4*)(XsT + (prow + 32) * 136 + pcol) = tX[1];
        {
            const f32x4 w0 = *(const f32x4*)(wv + pcol), w1 = *(const f32x4*)(wv + pcol + 4);
            u32x4 oa, ob; const u32x4 xa = tX[0], xb_ = tX[1];
            oa.x = pack2(bflo(xa.x) * w0[0], bfhi(xa.x) * w0[1]); oa.y = pack2(bflo(xa.y) * w0[2], bfhi(xa.y) * w0[3]); oa.z = pack2(bflo(xa.z) * w1[0], bfhi(xa.z) * w1[1]); oa.w = pack2(bflo(xa.w) * w1[2], bfhi(xa.w) * w1[3]);
            ob.x = pack2(bflo(xb_.x) * w0[0], bfhi(xb_.x) * w0[1]); ob.y = pack2(bflo(xb_.y) * w0[2], bfhi(xb_.y) * w0[3]); ob.z = pack2(bflo(xb_.z) * w1[0], bfhi(xb_.z) * w1[1]); ob.w = pack2(bflo(xb_.w) * w1[2], bfhi(xb_.w) * w1[3]);
            *(u32x4*)(XwT + prow * 136 + pcol) = oa; *(u32x4*)(XwT + (prow + 32) * 136 + pcol) = ob;
        }
        if (c + 1 < 16) {
            const size_t tb_ = ((size_t)((b * 16 + c + 1) * 2 + g)) * 128 * 128 + (size_t)prow * 128 + pcol;
            const u32x4* pc = (const u32x4*)(WSP(bf16_t, OFF_CN) + tb_); const u32x4* pb = (const u32x4*)(WSP(bf16_t, OFF_BN) + tb_); const u32x4* pt = (const u32x4*)(WSP(bf16_t, OFF_BT) + tb_);
            const u32x4* px = (const u32x4*)(WSP(bf16_t, OFF_XT) + ((size_t)((b * 16 + c + 1) * 1024 + h * 64 + prow)) * 128 + pcol);
#pragma unroll
            for (int i = 0; i < 4; ++i) { tC[i] = pc[i * 512]; tB[i] = pb[i * 512]; tT[i] = pt[i * 512]; }
            tX[0] = px[0]; tX[1] = px[512];
        }
        bf16_t zr[16];
        {
            const unsigned zoff = (unsigned)((row0 + (wid >> 1) * 32 + 4 * hh) * N0 + 2048 + h * 64 + (wid & 1) * 32 + l31);
#pragma unroll
            for (int reg = 0; reg < 16; ++reg) zr[reg] = (U + ((reg & 3) + 8 * (reg >> 2)) * N0)[zoff];
        }
        lds_barrier();
        {
            const int tb = (wid >> 1) * 32, pb = (wid & 1) * 32;
            f32x16 y;
#pragma unroll
            for (int i = 0; i < 16; ++i) y[i] = 0.f;
#pragma unroll
            for (int ks = 0; ks < 8; ++ks) y = MFMA32(ldfrag(Cs, 136, tb, ks * 16, lane), ldfrag(St, 136, pb, ks * 16, lane), y);
            f32x16 y2;
#pragma unroll
            for (int i = 0; i < 16; ++i) y2[i] = 0.f;
#pragma unroll
            for (int ks = 0; ks < 8; ++ks) y2 = MFMA32(ldfrag(Ws, 136, tb, ks * 16, lane), ldfrag(XsT, 136, pb, ks * 16, lane), y2);
#pragma unroll
            for (int reg = 0; reg < 16; ++reg) y[reg] = y[reg] * __expf(acs[tb + crow(reg, hh)]) + y2[reg];
            const int p = pb + l31, ch = h * 64 + p; const float nwv = P.in[24][ch];
            float sq[16];
#pragma unroll
            for (int reg = 0; reg < 16; ++reg) {
                const int t = tb + crow(reg, hh); const size_t row = (size_t)(row0 + t);
                const float xv = bf2f(XsT[p * 136 + t]); const float z = bf2f(zr[reg]);
                const float yy = (y[reg] + Dh * xv) * silu(z);
                sq[reg] = yy * yy;
                MIX[row * 2048 + 1024 + ch] = f2bf(yy * nwv);
            }
#define SSD_RSTEP(m, n) do { const bool up_ = (l31 & (m)) != 0; _Pragma("unroll") for (int i_ = 0; i_ < (n); ++i_) { const float snd_ = up_ ? sq[i_] : sq[i_ + (n)]; const float kp_ = up_ ? sq[i_ + (n)] : sq[i_]; sq[i_] = kp_ + __shfl_xor(snd_, (m)); } } while (0)
            SSD_RSTEP(16, 8); SSD_RSTEP(8, 4); SSD_RSTEP(4, 2); SSD_RSTEP(2, 1);
#undef SSD_RSTEP
            sq[0] += __shfl_xor(sq[0], 1);
            if ((l31 & 1) == 0) atomicAdd(SSB + (size_t)(row0 + tb + crow(l31 >> 1, hh)) * 2 + g, sq[0]);
            lds_barrier();
            const int pb2 = (wid >> 2) * 32, nb = (wid & 3) * 32;
            const float ea = __expf(a_last);
#pragma unroll
            for (int reg = 0; reg < 16; ++reg) accS[reg] *= ea;
#pragma unroll
            for (int ks = 0; ks < 8; ++ks) accS = MFMA32(ldfrag(XwT, 136, pb2, ks * 16, lane), ldfrag(BsT, 136, nb, ks * 16, lane), accS);
#pragma unroll
            for (int reg = 0; reg < 16; ++reg) St[(pb2 + crow(reg, hh)) * 136 + nb + l31] = f2bf(accS[reg]);
        }
    }
    {
        const int lane = tid0 & 63, hh = lane >> 5, l31 = lane & 31;
        const int pb2 = (wid >> 2) * 32, nb = (wid & 3) * 32;
        float* o = P.out + O_BSP + (size_t)(b * 16 + h) * 64 * 128;
#pragma unroll
        for (int reg = 0; reg < 16; ++reg) o[(pb2 + crow(reg, hh)) * 128 + nb + l31] = accS[reg];
    }
}
#undef SSD_DTLOAD
#undef SSD_SCAN
DI void ssd_sample_item(const Params& P, unsigned char* L, int item) {
    const int b = item >> 4, h = item & 15, g = h >> 3, tid = otid(), lane = tid & 63;
    float* xs = (float*)L; float* Bv = xs + 64; float* Cv = Bv + 128; float* yv = Cv + 128;
    const bf16_t* U = WSP(bf16_t, OFF_U); bf16_t* MIX = WSP(bf16_t, OFF_MIX); float* SSB = WSP(float, OFF_SSB);
    const size_t row = (size_t)(MP + b);
    __syncthreads();
    if (tid < 320) {
        int cc; if (tid < 64) cc = h * 64 + tid; else if (tid < 192) cc = 1024 + g * 128 + (tid - 64); else cc = 1280 + g * 128 + (tid - 192);
        const float* buf = P.in[7] + (size_t)b * 3 * 1536 + cc;
        const float v = P.in[20][cc] + P.in[19][cc] * buf[0] + P.in[19][1536 + cc] * buf[1536] + P.in[19][2 * 1536 + cc] * buf[2 * 1536] + P.in[19][3 * 1536 + cc] * bf2f(U[row * N0 + 3072 + cc]);
        xs[tid] = silu(v);
    }
    const float dt = softplus(WSP(float, OFF_DT)[row * 16 + h] + P.in[21][h]);
    const float dA = __expf(-dt * __expf(P.in[22][h]));
    __syncthreads();
    const float* s0 = P.in[6] + (size_t)(b * 16 + h) * 64 * 128; float* s1 = P.out + O_BSS + (size_t)(b * 16 + h) * 64 * 128;
    const int n4 = (tid & 31) * 4;
    const f32x4 Bq = *(const f32x4*)(Bv + n4), Cq = *(const f32x4*)(Cv + n4);
#pragma unroll
    for (int j = 0; j < 4; ++j) {
        const int p = (tid >> 5) + 16 * j;
        const f32x4 s = *(const f32x4*)(s0 + p * 128 + n4);
        const float dx = dt * xs[p];
        const f32x4 sn = s * dA + Bq * dx;
        *(f32x4*)(s1 + p * 128 + n4) = sn;
        float yp = sn[0] * Cq[0] + sn[1] * Cq[1] + sn[2] * Cq[2] + sn[3] * Cq[3];
        yp += __shfl_xor(yp, 1); yp += __shfl_xor(yp, 2); yp += __shfl_xor(yp, 4); yp += __shfl_xor(yp, 8); yp += __shfl_xor(yp, 16);
        if ((tid & 31) == 0) yv[p] = yp;
    }
    __syncthreads();
    if (tid < 64) {
        const int ch = h * 64 + tid;
        const float yy = (yv[tid] + P.in[23][h] * xs[tid]) * silu(bf2f(U[row * N0 + 2048 + ch]));
        const float ss = wave_sum(yy * yy);
        if (lane == 0) atomicAdd(SSB + row * 2 + g, ss);
        MIX[row * 2048 + 1024 + ch] = f2bf(yy * P.in[24][ch]);
    }
}
DI void ssd_sample_item4(const Params& P, unsigned char* L, int item) {
    const int b = item >> 2, tid = otid(), gi = tid >> 7, lt = tid & 127, h = (item & 3) * 4 + gi, g = h >> 3;
    float* xs = (float*)L + gi * 512; float* Bv = xs + 64; float* Cv = Bv + 128; float* yv = Cv + 128;
    const bf16_t* U = WSP(bf16_t, OFF_U); bf16_t* MIX = WSP(bf16_t, OFF_MIX); float* SSB = WSP(float, OFF_SSB);
    const size_t row = (size_t)(MP + b);
    __syncthreads();
#pragma unroll
    for (int ps = 0; ps < 3; ++ps) {
        const int idx = lt + 128 * ps;
        if (idx < 320) {
            int cc; if (idx < 64) cc = h * 64 + idx; else if (idx < 192) cc = 1024 + g * 128 + (idx - 64); else cc = 1280 + g * 128 + (idx - 192);
            const float* buf = P.in[7] + (size_t)b * 3 * 1536 + cc;
            const float v = P.in[20][cc] + P.in[19][cc] * buf[0] + P.in[19][1536 + cc] * buf[1536] + P.in[19][2 * 1536 + cc] * buf[2 * 1536] + P.in[19][3 * 1536 + cc] * bf2f(U[row * N0 + 3072 + cc]);
            xs[idx] = silu(v);
        }
    }
    const float dt = softplus(WSP(float, OFF_DT)[row * 16 + h] + P.in[21][h]);
    const float dA = __expf(-dt * __expf(P.in[22][h]));
    __syncthreads();
    const float* s0 = P.in[6] + (size_t)(b * 16 + h) * 64 * 128; float* s1 = P.out + O_BSS + (size_t)(b * 16 + h) * 64 * 128;
    const int n4 = (lt & 31) * 4;
    const f32x4 Bq = *(const f32x4*)(Bv + n4), Cq = *(const f32x4*)(Cv + n4);
    f32x4 sv[16];
#pragma unroll
    for (int j = 0; j < 16; ++j) sv[j] = *(const f32x4*)(s0 + ((lt >> 5) + 4 * j) * 128 + n4);
#pragma unroll
    for (int j = 0; j < 16; ++j) {
        const int p = (lt >> 5) + 4 * j;
        const f32x4 sn = sv[j] * dA + Bq * (dt * xs[p]);
        *(f32x4*)(s1 + p * 128 + n4) = sn;
        float yp = sn[0] * Cq[0] + sn[1] * Cq[1] + sn[2] * Cq[2] + sn[3] * Cq[3];
        yp += __shfl_xor(yp, 1); yp += __shfl_xor(yp, 2); yp += __shfl_xor(yp, 4); yp += __shfl_xor(yp, 8); yp += __shfl_xor(yp, 16);
        if ((lt & 31) == 0) yv[p] = yp;
    }
    __syncthreads();
    if (lt < 64) {
        const int ch = h * 64 + lt;
        const float yy = (yv[lt] + P.in[23][h] * xs[lt]) * silu(bf2f(U[row * N0 + 2048 + ch]));
        const float ss = wave_sum(yy * yy);
        if (lt == 0) atomicAdd(SSB + row * 2 + g, ss);
        MIX[row * 2048 + 1024 + ch] = f2bf(yy * P.in[24][ch]);
    }
}
template <bool SAMPLE>
DI void rglru_item(const Params& P, unsigned char* L, int item) {
    const int tid0 = otid(), wid = tid0 >> 6;
    const int b = SAMPLE ? 0 : (item >> 4), k = (item >> 1) & 7, dh = item & 1;
    bf16_t* Xs = (bf16_t*)L;
    bf16_t* Wg = Xs + 128 * 136;
    float* Aa = (float*)(Wg + 128 * 136);
    float* Uu = Aa + 128 * 64; float* segA = Uu + 128 * 64; float* segH = segA + 512; float* hc = segH + 512;
    const bf16_t* U = WSP(bf16_t, OFF_U); bf16_t* MIX = WSP(bf16_t, OFF_MIX);
    lds_barrier();
    {
        const bf16_t* WRT = WSP(bf16_t, OFF_WRT); const bf16_t* WIT = WSP(bf16_t, OFF_WIT);
#pragma unroll
        for (int i = 0; i < 4; ++i) {
            const int chk = tid0 + i * 512, r = chk >> 4, c8 = (chk & 15) * 8;
            const bf16_t* src = (r < 64 ? WRT + (size_t)(dh * 64 + r) * 1024 : WIT + (size_t)(dh * 64 + r - 64) * 1024) + k * 128 + c8;
            *(u32x4*)(Wg + r * 136 + c8) = *(const u32x4*)src;
        }
        if (tid0 < 64) hc[tid0] = 0.f;
    }
    float sp[4], br[4], bi[4];
#pragma unroll
    for (int ct = 0; ct < 4; ++ct) { const int chd = k * 128 + dh * 64 + ct * 16 + (tid0 & 15); sp[ct] = softplus(-P.in[18][chd]); br[ct] = P.in[15][chd]; bi[ct] = P.in[17][chd]; }
    const int ch0 = k * 128 + (tid0 & 31) * 4;
    float cw[4][4], cbias[4];
#pragma unroll
    for (int kk = 0; kk < 4; ++kk)
#pragma unroll
        for (int e = 0; e < 4; ++e) cw[kk][e] = P.in[12][kk * 1024 + ch0 + e];
#pragma unroll
    for (int e = 0; e < 4; ++e) cbias[e] = P.in[13][ch0 + e];
    u32x2 raw[11];
#define RG_LOAD(tl_) do { const int tg_ = (tl_) * 128 + (tid0 >> 5) * 8; const unsigned vo_ = (unsigned)((b * 2048 + tg_) * N0 + ch0); \
        _Pragma("unroll") for (int j = 0; j < 11; ++j) raw[j] = (tg_ + j - 3 >= 0) ? *(const u32x2*)((U + (j - 3) * N0) + vo_) : (u32x2){0u, 0u}; } while (0)
    if (!SAMPLE) RG_LOAD(0);
    const int ntiles = SAMPLE ? 1 : 16;
    for (int tile = 0; tile < ntiles; ++tile) {
        const int row0 = SAMPLE ? MP : b * 2048 + tile * 128;
        lds_barrier();
        int zv = 0; asm volatile("" : "+v"(zv));
        const int tid = tid0 + zv, lane = tid & 63, quad = tid & 31, seg = tid >> 5;
        const int sd = tid & 63, sseg = wid, sch = k * 128 + dh * 64 + sd;
        bf16_t gt[16];
        if (!SAMPLE) {
            const unsigned goff = (unsigned)((row0 + sseg * 16) * N0 + 1024 + sch);
#pragma unroll
            for (int t = 0; t < 16; ++t) gt[t] = (U + t * N0)[goff];
        }
        if (SAMPLE) {
#pragma unroll
            for (int t = 0; t < 8; ++t) {
                const int bb = seg * 8 + t;
                const float* buf = P.in[5] + (size_t)bb * 3 * 1024 + ch0;
                const f32x4 p0 = *(const f32x4*)buf, p1 = *(const f32x4*)(buf + 1024), p2 = *(const f32x4*)(buf + 2048);
                float cur[4]; ld4bf(U + (size_t)(MP + bb) * N0 + ch0, cur);
                float y[4];
#pragma unroll
                for (int e = 0; e < 4; ++e) y[e] = cbias[e] + cw[0][e] * p0[e] + cw[1][e] * p1[e] + cw[2][e] * p2[e] + cw[3][e] * cur[e];
                *(u32x2*)(Xs + bb * 136 + quad * 4) = pack4v(y[0], y[1], y[2], y[3]);
            }
        } else {
#pragma unroll
            for (int j = 0; j < 8; ++j) {
                const float x0[4] = {bflo(raw[j].x), bfhi(raw[j].x), bflo(raw[j].y), bfhi(raw[j].y)};
                const float x1[4] = {bflo(raw[j + 1].x), bfhi(raw[j + 1].x), bflo(raw[j + 1].y), bfhi(raw[j + 1].y)};
                const float x2[4] = {bflo(raw[j + 2].x), bfhi(raw[j + 2].x), bflo(raw[j + 2].y), bfhi(raw[j + 2].y)};
                const float x3[4] = {bflo(raw[j + 3].x), bfhi(raw[j + 3].x), bflo(raw[j + 3].y), bfhi(raw[j + 3].y)};
                float y[4];
#pragma unroll
                for (int e = 0; e < 4; ++e) y[e] = cbias[e] + cw[0][e] * x0[e] + cw[1][e] * x1[e] + cw[2][e] * x2[e] + cw[3][e] * x3[e];
                *(u32x2*)(Xs + (seg * 8 + j) * 136 + quad * 4) = pack4v(y[0], y[1], y[2], y[3]);
            }
            if (tile + 1 < 16) RG_LOAD(tile + 1);
        }
        lds_barrier();
        {
            f32x4 acc[8];
#pragma unroll
            for (int i = 0; i < 8; ++i) acc[i] = (f32x4){0.f, 0.f, 0.f, 0.f};
#pragma unroll
            for (int ks = 0; ks < 4; ++ks) {
                const bf16x8 a = ldfrag16(Xs, 136, wid * 16, ks * 32, lane);
#pragma unroll
                for (int tl = 0; tl < 8; ++tl) acc[tl] = MFMA16(a, ldfrag16(Wg, 136, tl * 16, ks * 32, lane), acc[tl]);
            }
#pragma unroll
            for (int ct = 0; ct < 4; ++ct)
#pragma unroll
                for (int reg = 0; reg < 4; ++reg) {
                    const int t = wid * 16 + (lane >> 4) * 4 + reg, d = ct * 16 + (lane & 15);
                    const float r = sigm(acc[ct][reg] + br[ct]), gi = sigm(acc[4 + ct][reg] + bi[ct]);
                    const float a = __expf(-8.f * r * sp[ct]);
                    const float uu = __builtin_amdgcn_sqrtf(fmaxf(1.f - a * a, 0.f)) * gi * bf2f(Xs[t * 136 + dh * 64 + d]);
                    if (SAMPLE) {
                        const int chd = k * 128 + dh * 64 + d;
                        const float hn = a * P.in[4][(size_t)t * 1024 + chd] + uu;
                        P.out[O_AHS + (size_t)t * 1024 + chd] = hn;
                        const float gv = bf2f(U[(size_t)(MP + t) * N0 + 1024 + chd]);
                        MIX[(size_t)(MP + t) * 2048 + chd] = f2bf(hn * silu(gv));
                    } else { Aa[t * 64 + d] = a; Uu[t * 64 + d] = uu; }
                }
        }
        if (!SAMPLE) {
            lds_barrier();
            float av[16], uv[16], Ap = 1.f, Hp = 0.f;
#pragma unroll
            for (int t = 0; t < 16; ++t) { av[t] = Aa[(sseg * 16 + t) * 64 + sd]; uv[t] = Uu[(sseg * 16 + t) * 64 + sd]; Hp = av[t] * Hp + uv[t]; Ap *= av[t]; }
            segA[sseg * 64 + sd] = Ap; segH[sseg * 64 + sd] = Hp;
            lds_barrier();
            float hin = hc[sd];
            for (int s2 = 0; s2 < sseg; ++s2) hin = segA[s2 * 64 + sd] * hin + segH[s2 * 64 + sd];
            const unsigned moff = (unsigned)((row0 + sseg * 16) * 2048 + sch);
#pragma unroll
            for (int t = 0; t < 16; ++t) {
                hin = av[t] * hin + uv[t];
                (MIX + t * 2048)[moff] = f2bf(hin * silu(bf2f(gt[t])));
            }
            lds_barrier();
            if (sseg == 7) hc[sd] = hin;
        }
    }
#undef RG_LOAD
    if (!SAMPLE) { lds_barrier(); if (tid0 < 64) P.out[O_AHP + (size_t)b * 1024 + k * 128 + dh * 64 + tid0] = hc[tid0]; }
}
DI void phase_mix0(const Params& P, unsigned char* L) {
    const int tid = otid(), bid = blockIdx.x, G = gridDim.x;
    { const bf16_t* U = WSP(bf16_t, OFF_U);
      for (int i = bid * 512 + tid; i < 8 * 3 * 1024; i += G * 512) { const int c = i & 1023, j = (i >> 10) % 3, b = i / 3072; P.out[O_ACP + i] = bf2f(U[(size_t)(b * 2048 + 2045 + j) * N0 + c]); }
      for (int i = bid * 512 + tid; i < 8 * 3 * 1536; i += G * 512) { const int c = i % 1536, j = (i / 1536) % 3, b = i / 4608; P.out[O_BCP + i] = bf2f(U[(size_t)(b * 2048 + 2045 + j) * N0 + 3072 + c]); }
      for (int i = bid * 512 + tid; i < 128 * 3 * 1024; i += G * 512) { const int c = i & 1023, j = (i >> 10) % 3, b = i / 3072; P.out[O_ACS + i] = j < 2 ? P.in[5][(size_t)(b * 3 + j + 1) * 1024 + c] : bf2f(U[(size_t)(MP + b) * N0 + c]); }
      for (int i = bid * 512 + tid; i < 128 * 3 * 1536; i += G * 512) { const int c = i % 1536, j = (i / 1536) % 3, b = i / 4608; P.out[O_BCS + i] = j < 2 ? P.in[7][(size_t)(b * 3 + j + 1) * 1536 + c] : bf2f(U[(size_t)(MP + b) * N0 + 3072 + c]); } }
    if (bid < 128) { const int x = bid & 7, j = bid >> 3; rglru_item<false>(P, L, (x + 8 * (j >> 1)) * 2 + (j & 1)); }
    else if (bid < 256) { const int x = bid & 7, j = (bid - 128) >> 3, grp = x + 8 * (j >> 3); ssd_prompt_item(P, L, (grp >> 1) * 16 + (grp & 1) * 8 + (j & 7)); }
    unsigned* ctr = WSP(unsigned, OFF_CTL);
    unsigned* bc = (unsigned*)(L + LDS_BYTES - 16);
    for (;;) {
        __syncthreads();
        if (tid == 0) bc[0] = atomicAdd(ctr, 1u);
        __syncthreads();
        const unsigned it = bc[0];
        if (it >= 16u + 512u) break;
        if (it < 16u) rglru_item<true>(P, L, (int)it); else ssd_sample_item4(P, L, (int)(it - 16u));
    }
    for (;;) {
        __syncthreads();
        if (tid == 0) bc[0] = atomicAdd(ctr + 32, 1u);
        __syncthreads();
        const unsigned q = bc[0];
        if (q >= 256u + 104u + 130u) break;
        if (q < 256u) l1_weight_tile(P, (int)q * 8 + (tid >> 6), (float*)L + (tid >> 6) * (64 * 65), tid & 63);
        else if (q < 360u) l1_weight_tile(P, 2880 + ((int)q - 256) * 8 + (tid >> 6), (float*)L + (tid >> 6) * (64 * 65), tid & 63);
        else convert_p_chunk(P, 0, (int)q - 360, tid);
    }
}
DI void phase_norm0(const Params& P) {
    bf16_t* MIX = WSP(bf16_t, OFF_MIX); const float* SSB = WSP(float, OFF_SSB);
    for (int i = blockIdx.x * 512 + threadIdx.x; i < MV * 128; i += gridDim.x * 512) {
        const int row = i >> 7, c8 = (i & 127) * 8, g = c8 >> 9;
        const float sc = rsqrtf(SSB[(size_t)row * 2 + g] * (1.f / 512.f) + EPSF);
        uint4* p = (uint4*)(MIX + (size_t)row * 2048 + 1024 + c8); uint4 w = *p;
        w.x = pack2(bflo(w.x) * sc, bfhi(w.x) * sc); w.y = pack2(bflo(w.y) * sc, bfhi(w.y) * sc); w.z = pack2(bflo(w.z) * sc, bfhi(w.z) * sc); w.w = pack2(bflo(w.w) * sc, bfhi(w.w) * sc);
        *p = w;
    }
}

DI void hgrn_prompt_item(const Params& P, unsigned char* L, int item) {
    const int b = item >> 4, h = item & 15;
    const int tid = otid(), lane = tid & 63, wid = tid >> 6, hh = lane >> 5, l31 = lane & 31;
    bf16_t* Qs = (bf16_t*)L;
    bf16_t* Ks = Qs + 64 * 136;
    bf16_t* KsT = Ks + 64 * 136;
    bf16_t* VsT = KsT + 128 * 72;
    bf16_t* SsT = VsT + 128 * 72;
    bf16_t* As = SsT + 128 * 136;
    float* Gseg = (float*)(As + 64 * 72);
    float* E1 = Gseg + 16 * 128; float* E2 = E1 + 128;
    float* Of = E2 + 128;
    const bf16_t* U = WSP(bf16_t, OFF_U); bf16_t* MIX = WSP(bf16_t, OFF_MIX);
    const int kq = tid & 31, ts = tid >> 5;
    float lb[4];
#pragma unroll
    for (int e = 0; e < 4; ++e) { const int ch = h * 128 + kq * 4 + e; lb[e] = sigm(P.in[27][2048 + ch] - P.in[27][ch]); }
    const int kb = (wid >> 1) * 32, vb0 = (wid & 1) * 64;
    f32x16 accS[2];
#pragma unroll
    for (int i = 0; i < 16; ++i) { accS[0][i] = 0.f; accS[1][i] = 0.f; }
    uint2 rq[4], rf[4], rv[4];
#define HG_LOAD(cc) do { _Pragma("unroll") for (int i = 0; i < 4; ++i) { const bf16_t* bp = U + (size_t)(b * 2048 + (cc) * 64 + ts * 4 + i) * INC + h * 128 + kq * 4; \
        rq[i] = *(const uint2*)bp; rf[i] = *(const uint2*)(bp + 2048); rv[i] = *(const uint2*)(bp + 4096); } } while (0)
    HG_LOAD(0);
    lds_barrier();
    float kk[4][4], cs[4][4];
    {
#pragma unroll
        for (int i = 0; i < 4; ++i) {
            const float fx[4] = {bflo(rf[i].x), bfhi(rf[i].x), bflo(rf[i].y), bfhi(rf[i].y)};
#pragma unroll
            for (int e = 0; e < 4; ++e) {
                const float sg = sigm(fx[e]); const float kv = (1.f - lb[e]) * (1.f - sg);
                kk[i][e] = kv; const float gl = __logf(1.f - kv);
                cs[i][e] = (i == 0 ? 0.f : cs[i - 1][e]) + gl;
            }
        }
        *(f32x4*)(Gseg + ts * 128 + kq * 4) = (f32x4){cs[3][0], cs[3][1], cs[3][2], cs[3][3]};
    }
    lds_barrier();
    for (int c = 0; c < 32; ++c) {
        u32x4 gpre0, gpre1;
        { const bf16_t* gp = U + (size_t)(b * 2048 + c * 64 + (tid >> 3)) * INC + 6144 + h * 128 + (tid & 7) * 16; gpre0 = *(const u32x4*)gp; gpre1 = *(const u32x4*)(gp + 8); }
        f32x4 off = {0.f, 0.f, 0.f, 0.f}, gmid = off, glast = off;
        {
            const int swid = __builtin_amdgcn_readfirstlane(tid >> 6);
            f32x4 pre = {0.f, 0.f, 0.f, 0.f};
#pragma unroll
            for (int s = 0; s < 16; ++s) {
                const f32x4 v = *(const f32x4*)(Gseg + s * 128 + kq * 4);
                if (s == 2 * swid) off = pre;
                if (s == 8) gmid = pre;
                pre += v;
            }
            glast = pre;
            if (ts & 1) off += *(const f32x4*)(Gseg + (ts - 1) * 128 + kq * 4);
        }
        {
            float qt[4][4], kt[4][4], vt[4][4];
#pragma unroll
            for (int i = 0; i < 4; ++i) {
                const float q[4] = {bflo(rq[i].x), bfhi(rq[i].x), bflo(rq[i].y), bfhi(rq[i].y)};
                vt[i][0] = bflo(rv[i].x); vt[i][1] = bfhi(rv[i].x); vt[i][2] = bflo(rv[i].y); vt[i][3] = bfhi(rv[i].y);
#pragma unroll
                for (int e = 0; e < 4; ++e) { const float Gv = off[e] + cs[i][e]; const float ex = __expf(Gv - gmid[e]); qt[i][e] = q[e] * 0.08838834764831845f * ex; kt[i][e] = kk[i][e] * frcp(ex); }
                *(uint2*)(Qs + (ts * 4 + i) * 136 + kq * 4) = pack4(qt[i][0], qt[i][1], qt[i][2], qt[i][3]);
                *(uint2*)(Ks + (ts * 4 + i) * 136 + kq * 4) = pack4(kt[i][0], kt[i][1], kt[i][2], kt[i][3]);
            }
#pragma unroll
            for (int e = 0; e < 4; ++e) {
                *(uint2*)(KsT + (kq * 4 + e) * 72 + ((ts * 4) ^ (((kq >> 2) & 7) * 8))) = pack4(kt[0][e], kt[1][e], kt[2][e], kt[3][e]);
                *(uint2*)(VsT + (kq * 4 + e) * 72 + ((ts * 4) ^ (((kq >> 2) & 7) * 8))) = pack4(vt[0][e], vt[1][e], vt[2][e], vt[3][e]);
            }
            if (ts == 0) {
#pragma unroll
                for (int e = 0; e < 4; ++e) { E1[kq * 4 + e] = __expf(gmid[e]); E2[kq * 4 + e] = __expf(glast[e] - gmid[e]); }
            }
        }
        if (c + 1 < 32) HG_LOAD(c + 1);
        lds_barrier();
#pragma unroll
        for (int j = 0; j < 2; ++j) {
#pragma unroll
            for (int reg = 0; reg < 16; ++reg) accS[j][reg] *= E1[kb + crow(reg, hh)];
            const int v = vb0 + j * 32 + l31;
#pragma unroll
            for (int rg = 0; rg < 4; ++rg) *(uint2*)(SsT + v * 136 + kb + 8 * rg + 4 * hh) = pack4(accS[j][4 * rg], accS[j][4 * rg + 1], accS[j][4 * rg + 2], accS[j][4 * rg + 3]);
        }
        if (wid < 4) {
            const int tb = (wid >> 1) * 32, sb = (wid & 1) * 32;
            f32x16 aa;
#pragma unroll
            for (int i = 0; i < 16; ++i) aa[i] = 0.f;
#pragma unroll
            for (int ks = 0; ks < 8; ++ks) aa = MFMA32(ldfrag(Qs, 136, tb, ks * 16, lane), ldfrag(Ks, 136, sb, ks * 16, lane), aa);
            const int s = sb + l31;
#pragma unroll
            for (int reg = 0; reg < 16; ++reg) { const int t = tb + crow(reg, hh); As[t * 72 + s] = f2bf(s <= t ? aa[reg] : 0.f); }
        }
        lds_barrier();
        const int tb2 = (wid >> 2) * 32, vb2 = (wid & 3) * 32;
        f32x16 o, o2;
#pragma unroll
        for (int i = 0; i < 16; ++i) { o[i] = 0.f; o2[i] = 0.f; }
#pragma unroll
        for (int ks = 0; ks < 8; ++ks) o = MFMA32(ldfrag(Qs, 136, tb2, ks * 16, lane), ldfrag(SsT, 136, vb2, ks * 16, lane), o);
#pragma unroll
        for (int ks = 0; ks < 4; ++ks) o2 = MFMA32(ldfrag(As, 72, tb2, ks * 16, lane), ldfrag_sw72(VsT, vb2, ks * 16, lane), o2);
#pragma unroll
        for (int i = 0; i < 16; ++i) o[i] += o2[i];
#pragma unroll
        for (int j = 0; j < 2; ++j) {
#pragma unroll
            for (int ks = 0; ks < 4; ++ks) accS[j] = MFMA32(ldfrag_sw72(KsT, kb, ks * 16, lane), ldfrag_sw72(VsT, vb0 + j * 32, ks * 16, lane), accS[j]);
#pragma unroll
            for (int reg = 0; reg < 16; ++reg) accS[j][reg] *= E2[kb + crow(reg, hh)];
        }
#pragma unroll
        for (int reg = 0; reg < 16; ++reg) Of[(tb2 + crow(reg, hh)) * 132 + vb2 + l31] = o[reg];
        if (c + 1 < 32) {
#pragma unroll
        for (int i = 0; i < 4; ++i) {
            const float fx[4] = {bflo(rf[i].x), bfhi(rf[i].x), bflo(rf[i].y), bfhi(rf[i].y)};
#pragma unroll
            for (int e = 0; e < 4; ++e) {
                const float sg = sigm(fx[e]); const float kv = (1.f - lb[e]) * (1.f - sg);
                kk[i][e] = kv; const float gl = __logf(1.f - kv);
                cs[i][e] = (i == 0 ? 0.f : cs[i - 1][e]) + gl;
            }
        }
        *(f32x4*)(Gseg + ts * 128 + kq * 4) = (f32x4){cs[3][0], cs[3][1], cs[3][2], cs[3][3]};
        }
        lds_barrier();
        {
            const int t = tid >> 3, vs = tid & 7;
            const size_t row = (size_t)(b * 2048 + c * 64 + t);
            f32x4 ov[4]; float ss = 0.f;
#pragma unroll
            for (int i = 0; i < 4; ++i) { ov[i] = *(const f32x4*)(Of + t * 132 + vs * 16 + i * 4); ss += ov[i][0] * ov[i][0] + ov[i][1] * ov[i][1] + ov[i][2] * ov[i][2] + ov[i][3] * ov[i][3]; }
            ss += __shfl_xor(ss, 1); ss += __shfl_xor(ss, 2); ss += __shfl_xor(ss, 4);
            const float rstd = rsqrtf(ss * (1.f / 128.f) + EPSF);
            const float* nwp = P.in[28] + h * 128 + vs * 16;
            const unsigned gw[8] = {gpre0.x, gpre0.y, gpre0.z, gpre0.w, gpre1.x, gpre1.y, gpre1.z, gpre1.w};
            unsigned ow[8];
#pragma unroll
            for (int i = 0; i < 4; ++i) {
                const f32x4 w = *(const f32x4*)(nwp + i * 4);
                ow[2 * i] = pack2(ov[i][0] * rstd * w[0] * silu(bflo(gw[2 * i])), ov[i][1] * rstd * w[1] * silu(bfhi(gw[2 * i])));
                ow[2 * i + 1] = pack2(ov[i][2] * rstd * w[2] * silu(bflo(gw[2 * i + 1])), ov[i][3] * rstd * w[3] * silu(bfhi(gw[2 * i + 1])));
            }
            bf16_t* op = MIX + row * 2048 + h * 128 + vs * 16;
            *(uint4*)op = make_uint4(ow[0], ow[1], ow[2], ow[3]); *(uint4*)(op + 8) = make_uint4(ow[4], ow[5], ow[6], ow[7]);
        }
    }
#undef HG_LOAD
    float* so = P.out + O_CP + (size_t)(b * 16 + h) * 128 * 128;
#pragma unroll
    for (int j = 0; j < 2; ++j)
#pragma unroll
        for (int reg = 0; reg < 16; ++reg) so[(kb + crow(reg, hh)) * 128 + vb0 + j * 32 + l31] = accS[j][reg];
}
DI void hgrn_sample_item(const Params& P, unsigned char* L, int item) {
    const int b = item >> 4, h = item & 15, tid = otid(), lane = tid & 63;
    float* qv = (float*)L; float* egv = qv + 128; float* kkv = egv + 128; float* vv = kkv + 128; float* part = vv + 128; float* red = part + 16 * 128;
    const bf16_t* U = WSP(bf16_t, OFF_U); bf16_t* MIX = WSP(bf16_t, OFF_MIX);
    const size_t row = (size_t)(MP + b); const bf16_t* ub = U + row * INC + h * 128;
    __syncthreads();
    if (tid < 128) {
        const int ch = h * 128 + tid;
        const float lbv = sigm(P.in[27][2048 + ch] - P.in[27][ch]);
        const float sg = sigm(bf2f(ub[2048 + tid])); const float kv = (1.f - lbv) * (1.f - sg);
        qv[tid] = bf2f(ub[tid]) * 0.08838834764831845f; egv[tid] = 1.f - kv; kkv[tid] = kv;
    } else if (tid < 256) vv[tid - 128] = bf2f(ub[4096 + tid - 128]);
    __syncthreads();
    const float* s0 = P.in[8] + (size_t)(b * 16 + h) * 128 * 128; float* s1 = P.out + O_CS + (size_t)(b * 16 + h) * 128 * 128;
    const int v4 = (tid & 31) * 4; const f32x4 vq = *(const f32x4*)(vv + v4);
    f32x4 op = {0.f, 0.f, 0.f, 0.f};
#pragma unroll
    for (int j = 0; j < 8; ++j) {
        const int k = (tid >> 5) + 16 * j;
        const f32x4 s = *(const f32x4*)(s0 + k * 128 + v4);
        const f32x4 sn = s * egv[k] + vq * kkv[k];
        *(f32x4*)(s1 + k * 128 + v4) = sn;
        op += sn * qv[k];
    }
    *(f32x4*)(part + (tid >> 5) * 128 + v4) = op;
    __syncthreads();
    float o = 0.f;
    if (tid < 128) {
#pragma unroll
        for (int i = 0; i < 16; ++i) o += part[i * 128 + tid];
        const float ss = wave_sum(o * o);
        if (lane == 0) red[tid >> 6] = ss;
    }
    __syncthreads();
    if (tid < 128) {
        const float rstd = rsqrtf((red[0] + red[1]) * (1.f / 128.f) + EPSF);
        const int ch = h * 128 + tid;
        MIX[row * 2048 + ch] = f2bf(o * rstd * P.in[28][ch] * silu(bf2f(ub[6144 + tid])));
    }
}
DI void phase_mix1(const Params& P, unsigned char* L) {
    const int tid = otid(), bid = blockIdx.x;
    if (bid < 128) hgrn_prompt_item(P, L, bid);
    else { const int nb = gridDim.x - 128; for (int it = bid - 128; it < 2048; it += nb) hgrn_sample_item(P, L, it); }
    unsigned* ctr = WSP(unsigned, OFF_CTL) + 48;
    unsigned* bc = (unsigned*)(L + LDS_BYTES - 16);
    for (;;) {
        __syncthreads();
        if (tid == 0) bc[0] = atomicAdd(ctr, 1u);
        __syncthreads();
        const unsigned q = bc[0];
        if (q >= 104u + 130u) break;
        if (q < 104u) l1_weight_tile(P, 2048 + (int)q * 8 + (tid >> 6), (float*)L + (tid >> 6) * (64 * 65), tid & 63);
        else convert_p_chunk(P, 1, (int)q - 104, tid);
    }
}
DI void phase_final(const Params& P) {
    const int lane = threadIdx.x & 63, gw = blockIdx.x * 8 + (threadIdx.x >> 6), nwv = gridDim.x * 8;
    const float* H = WSP(float, OFF_H); const float* SS = WSP(float, OFF_SS2); const float* nf = P.in[10];
    f32x4 w4[4];
#pragma unroll
    for (int i = 0; i < 4; ++i) w4[i] = *(const f32x4*)(nf + lane * 4 + 256 * i);
    for (int r0 = gw * 4; r0 < MV; r0 += nwv * 4) {
        f32x4 v[4][4]; float rs[4];
#pragma unroll
        for (int q = 0; q < 4; ++q) { rs[q] = SS[r0 + q];
#pragma unroll
            for (int i = 0; i < 4; ++i) v[q][i] = *(const f32x4*)(H + (size_t)(r0 + q) * 1024 + lane * 4 + 256 * i); }
#pragma unroll
        for (int q = 0; q < 4; ++q) { const float rstd = rsqrtf(rs[q] * (1.f / 1024.f) + EPSF);
#pragma unroll
            for (int i = 0; i < 4; ++i) __builtin_nontemporal_store(v[q][i] * rstd * w4[i], (f32x4*)(P.out + O_Y + (size_t)(r0 + q) * 1024 + lane * 4 + 256 * i)); }
    }
}

#define XB_TMO      128
#define XB_XCNT(j)  (256  + 64 * (j))
#define XB_XSUB(j)  (1280 + 64 * (j))
#define XB_XGEN(j)  (2304 + 64 * (j))
#define XB_TOP      3328
#define XB_TOPGEN   3392
#define XCD_BAR_WORDS 3456
#define XB_SPIN_CAP (1u << 18)

__device__ __forceinline__ unsigned xb_ld(unsigned* p)              { return __hip_atomic_load(p, __ATOMIC_RELAXED, __HIP_MEMORY_SCOPE_AGENT); }
__device__ __forceinline__ unsigned xb_add(unsigned* p, unsigned v) { return __hip_atomic_fetch_add(p, v, __ATOMIC_RELAXED, __HIP_MEMORY_SCOPE_AGENT); }
__device__ __forceinline__ unsigned xb_xcc_id() { return (unsigned)__builtin_amdgcn_s_getreg((3 << 11) | 20) & 0xFu; }
#define XB_SPIN(cond, bar) do { unsigned _sp = 0; while (cond) { __builtin_amdgcn_s_sleep(1); \
    if ((++_sp & 255u) == 0u) { if (xb_ld(&(bar)[XB_TMO])) break; if (_sp > XB_SPIN_CAP) { atomicAdd(&(bar)[XB_TMO], 1u); break; } } } } while (0)

struct XcdBarrier {
    unsigned* bar; unsigned x;
    volatile LAS unsigned* st;
};

__device__ __forceinline__ XcdBarrier xcd_barrier_post(unsigned* bar, volatile LAS unsigned* st) {
    XcdBarrier b; b.bar = bar; b.x = xb_xcc_id(); b.st = st;
    if (threadIdx.x == 0) (void)xb_add(&bar[XB_XCNT(b.x)], 1u);
    return b;
}
__device__ __forceinline__ void xcd_barrier_complete(unsigned* bar, unsigned x, unsigned& nloc, unsigned& nx) {
    const unsigned G = gridDim.x * gridDim.y * gridDim.z;
    unsigned sum, cnt, mine, sp = 0u;
    for (;;) {
        sum = 0u; cnt = 0u; mine = 0u;
#pragma unroll
        for (unsigned j = 0; j < 16; ++j) { const unsigned c = xb_ld(&bar[XB_XCNT(j)]); sum += c; cnt += (c > 0u) ? 1u : 0u; mine = (j == x) ? c : mine; }
        if (sum == G) break;
        __builtin_amdgcn_s_sleep(1);
        if ((++sp & 255u) == 0u) { if (xb_ld(&bar[XB_TMO])) break; if (sp > XB_SPIN_CAP) { atomicAdd(&bar[XB_TMO], 1u); break; } }
    }
    nloc = mine > 0u ? mine : 1u; nx = cnt > 0u ? cnt : 1u;
}

__device__ __forceinline__ void xcd_barrier(const XcdBarrier& b) {
    asm volatile("s_waitcnt vmcnt(0)" ::: "memory");
    __syncthreads();
    if (threadIdx.x == 0) {
        unsigned* bar = b.bar;
        __builtin_amdgcn_s_waitcnt(0);
        unsigned nloc = b.st[0], nx = b.st[1];
        if (nloc == 0u) { xcd_barrier_complete(bar, b.x, nloc, nx); b.st[0] = nloc; b.st[1] = nx; }
        const unsigned old = xb_add(&bar[XB_XSUB(b.x)], 1u);
        const unsigned gen = old / nloc;
        if (old + 1u == (gen + 1u) * nloc) {
            __builtin_amdgcn_fence(__ATOMIC_RELEASE, "agent");
            asm volatile("s_waitcnt vmcnt(0)" ::: "memory");
            const unsigned og = xb_add(&bar[XB_TOP], 1u);
            const unsigned tg = og / nx;
            if (og + 1u == (tg + 1u) * nx) xb_add(&bar[XB_TOPGEN], 1u);
            else XB_SPIN(xb_ld(&bar[XB_TOPGEN]) == tg, bar);
            __builtin_amdgcn_fence(__ATOMIC_ACQUIRE, "agent");
            xb_add(&bar[XB_XGEN(b.x)], 1u);
            asm volatile("s_waitcnt vmcnt(0)" ::: "memory");
        } else {
            XB_SPIN(xb_ld(&bar[XB_XGEN(b.x)]) == gen, bar);
            __builtin_amdgcn_fence(__ATOMIC_ACQUIRE, "agent");
            asm volatile("s_waitcnt vmcnt(0)" ::: "memory");
        }
    }
    __syncthreads();
}


#ifndef PHM
#define PHM 0xFFFF
#endif
typedef const __attribute__((address_space(4))) Params* ParamsK;
DI Params getp() {
    ParamsK pp = (ParamsK)__builtin_amdgcn_kernarg_segment_ptr(); asm volatile("" : "+s"(pp));
    Params P;
#pragma unroll
    for (int i = 0; i < 32; ++i) P.in[i] = pp->in[i];
    P.out = pp->out; P.ws = pp->ws; return P;
}
#define GETP() const Params P = getp()
__global__ void __launch_bounds__(512, 2) fwd_kernel(Params Parg) {
    extern __shared__ __attribute__((aligned(16))) unsigned char lds[];
    cg::grid_group grid = cg::this_grid();
    unsigned char* L = (unsigned char*)lds;
    LAS unsigned char* LL = (LAS unsigned char*)lds;
    volatile LAS unsigned* xst = (volatile LAS unsigned*)(LL + LDS_BYTES - 32);
    if (threadIdx.x < 2) xst[threadIdx.x] = 0u;
    __syncthreads();
    XcdBarrier xb;
    { GETP(); xb = xcd_barrier_post(WSP(unsigned, OFF_BAR), xst); }
    if (PHM & 1) { GETP(); phase_prep(P, L); }
    if (gridDim.y == 0xFFFFu) grid.sync();
    xcd_barrier(xb);
    if (PHM & 2) { GETP(); pg8::StaticOrder S; S.init(MP, N0 + 256, gridDim.x, blockIdx.x); pg8::Gemm g{WSP(bf16_t, OFF_XN), WSP(bf16_t, OFF_W0T), MP, N0 + 256, 1024};
      EpiStoreBf16 E{WSP(bf16_t, OFF_U), N0, nullptr, WSP(float, OFF_DT)}; pg8::gemm_phase(LL, g, S, E); }
    { GETP(); SfU f{WSP(bf16_t, OFF_U), N0, nullptr, WSP(float, OFF_DT)}; sgemm<4>(WSP(bf16_t, OFF_XN), WSP(bf16_t, OFF_W0T), 1024, 145, 64 * 19, f, L); }
    xcd_barrier(xb);
    { GETP(); phase_convbc(P, L); }
    xcd_barrier(xb);
    if (PHM & 4) { GETP(); phase_mix0(P, L); }
    xcd_barrier(xb);
    { GETP(); phase_norm0(P); }
    xcd_barrier(xb);
    if (PHM & 8) { GETP(); pg8::StaticOrder S; S.init(MP, 1024, gridDim.x, blockIdx.x); pg8::Gemm g{WSP(bf16_t, OFF_MIX), WSP(bf16_t, OFF_WO0T), MP, 1024, 2048};
      EpiResid E{P.in[0], P.in[1], WSP(float, OFF_H), WSP(bf16_t, OFF_HB)}; pg8::gemm_phase(LL, g, S, E); }
    { GETP(); SfResid f{P.in[1], WSP(float, OFF_H), WSP(bf16_t, OFF_HB)}; sgemm<4>(WSP(bf16_t, OFF_MIX), WSP(bf16_t, OFF_WO0T), 2048, 32, 256, f, L); }
    xcd_barrier(xb);
    if (PHM & 16) { GETP(); pg8::StaticOrder S; S.init(MP, 1024, gridDim.x, blockIdx.x);
      pg8::Gemm g1{WSP(bf16_t, OFF_HB), WSP(bf16_t, OFF_WG0T), MP, 1024, 1024}; EpiGate E1{WSP(bf16_t, OFF_MIX)}; pg8::gemm_phase(LL, g1, S, E1); }
    { GETP(); SfGate f{WSP(bf16_t, OFF_MIX)};   sgemm<2>(WSP(bf16_t, OFF_HB), WSP(bf16_t, OFF_WG0T), 1024, 32, 256, f, L); }
    if (PHM & 16) { GETP(); pg8::StaticOrder S; S.init(MP, 1024, gridDim.x, blockIdx.x);
      pg8::Gemm g2{WSP(bf16_t, OFF_PB), WSP(bf16_t, OFF_WP0T), MP, 1024, 256};
      EpiPle E2{WSP(float, OFF_H), WSP(bf16_t, OFF_MIX), WSP(bf16_t, OFF_XN), P.in[9] + 1024, WSP(float, OFF_SS1)}; pg8::gemm_phase(LL, g2, S, E2); }
    { GETP(); SfPle f{WSP(float, OFF_H), WSP(bf16_t, OFF_MIX), WSP(bf16_t, OFF_XN), P.in[9] + 1024, WSP(float, OFF_SS1)}; sgemm<2>(WSP(bf16_t, OFF_PB), WSP(bf16_t, OFF_WP0T), 256, 32, 256, f, L); }
    xcd_barrier(xb);
    if (PHM & 32) { GETP(); pg8::StaticOrder S; S.init(MP, INC, gridDim.x, blockIdx.x); pg8::Gemm g{WSP(bf16_t, OFF_XN), WSP(bf16_t, OFF_W1T), MP, INC, 1024};
      EpiStoreBf16 E{WSP(bf16_t, OFF_U), INC, WSP(float, OFF_SS1), nullptr}; pg8::gemm_phase(LL, g, S, E); }
    { GETP(); SfU f{WSP(bf16_t, OFF_U), INC, WSP(float, OFF_SS1), nullptr}; sgemm<4>(WSP(bf16_t, OFF_XN), WSP(bf16_t, OFF_W1T), 1024, 256, 64 * 32, f, L); }
    xcd_barrier(xb);
    if (PHM & 64) { GETP(); phase_mix1(P, L); }
    xcd_barrier(xb);
    if (PHM & 128) { GETP(); pg8::StaticOrder S; S.init(MP, 1024, gridDim.x, blockIdx.x); pg8::Gemm g{WSP(bf16_t, OFF_MIX), WSP(bf16_t, OFF_WO1T), MP, 1024, 2048};
      EpiResid E{WSP(float, OFF_H), WSP(float, OFF_H) + (size_t)MP * 1024, WSP(float, OFF_H), WSP(bf16_t, OFF_HB)}; pg8::gemm_phase(LL, g, S, E); }
    { GETP(); SfResid f{WSP(float, OFF_H) + (size_t)MP * 1024, WSP(float, OFF_H), WSP(bf16_t, OFF_HB)}; sgemm<4>(WSP(bf16_t, OFF_MIX), WSP(bf16_t, OFF_WO1T), 2048, 32, 256, f, L); }
    xcd_barrier(xb);
    if (PHM & 256) { GETP(); pg8::StaticOrder S; S.init(MP, 1024, gridDim.x, blockIdx.x);
      pg8::Gemm g1{WSP(bf16_t, OFF_HB), WSP(bf16_t, OFF_WG1T), MP, 1024, 1024}; EpiGate E1{WSP(bf16_t, OFF_MIX)}; pg8::gemm_phase(LL, g1, S, E1); }
    { GETP(); SfGate f{WSP(bf16_t, OFF_MIX)};   sgemm<2>(WSP(bf16_t, OFF_HB), WSP(bf16_t, OFF_WG1T), 1024, 32, 256, f, L); }
    if (PHM & 256) { GETP(); pg8::StaticOrder S; S.init(MP, 1024, gridDim.x, blockIdx.x);
      pg8::Gemm g2{WSP(bf16_t, OFF_PB + PB_STRIDE), WSP(bf16_t, OFF_WP1T), MP, 1024, 256};
      EpiPle E2{WSP(float, OFF_H), WSP(bf16_t, OFF_MIX), nullptr, nullptr, WSP(float, OFF_SS2)}; pg8::gemm_phase(LL, g2, S, E2); }
    { GETP(); SfPle f{WSP(float, OFF_H), WSP(bf16_t, OFF_MIX), nullptr, nullptr, WSP(float, OFF_SS2)}; sgemm<2>(WSP(bf16_t, OFF_PB + PB_STRIDE), WSP(bf16_t, OFF_WP1T), 256, 32, 256, f, L); }
    xcd_barrier(xb);
    { GETP(); phase_final(P); }
}

extern "C" void kernel_launch(void* const* d_in, const int* in_sizes, int n_in, void* d_out, int out_size, void* d_ws, size_t ws_size, hipStream_t stream) {
    static int grid = 0;
    if (grid == 0) {
        if (n_in != 32 || ws_size < WS_END) { fprintf(stderr, "kernel_launch: need 32 inputs and %zu bytes of workspace (got %d, %zu)\n", (size_t)WS_END, n_in, ws_size); grid = -1; return; }
        int dev = 0, cus = 0, per_cu = 0;
        (void)hipGetDevice(&dev); (void)hipDeviceGetAttribute(&cus, hipDeviceAttributeMultiprocessorCount, dev);
        if (hipFuncSetAttribute((const void*)fwd_kernel, hipFuncAttributeMaxDynamicSharedMemorySize, LDS_BYTES) != hipSuccess) { fprintf(stderr, "kernel_launch: hipFuncSetAttribute failed\n"); grid = -1; return; }
        if (hipOccupancyMaxActiveBlocksPerMultiprocessor(&per_cu, (const void*)fwd_kernel, 512, LDS_BYTES) != hipSuccess || per_cu < 1) { fprintf(stderr, "kernel_launch: occupancy query says %d\n", per_cu); per_cu = 1; }
        (void)hipGetLastError();
        grid = cus;
    }
    if (grid < 0) return;
    Params p{};
    for (int i = 0; i < 32; ++i) p.in[i] = (const float*)d_in[i];
    p.out = (float*)d_out; p.ws = (unsigned char*)d_ws;
    if (hipMemsetAsync((char*)d_ws + OFF_BAR, 0, 16384, stream) != hipSuccess) { fprintf(stderr, "kernel_launch: memset of barrier words failed\n"); return; }
    void* args[] = {&p};
    hipError_t e = hipLaunchCooperativeKernel((const void*)fwd_kernel, dim3(grid), dim3(512), args, LDS_BYTES, stream);
    if (e != hipSuccess) fprintf(stderr, "cooperative launch failed: %s (grid %d)\n", hipGetErrorString(e), grid);
}
```

```cpp
#include <hip/hip_runtime.h>
#include <hip/hip_cooperative_groups.h>
#include <cstdio>
namespace cg = cooperative_groups;

#define LAS __attribute__((address_space(3)))
#define DI __device__ __forceinline__
typedef unsigned short bf16_t;
typedef short bf16x8 __attribute__((ext_vector_type(8)));
typedef float f32x4 __attribute__((ext_vector_type(4)));
typedef float f32x16 __attribute__((ext_vector_type(16)));

constexpr int MP = 16384, MS = 128, MV = MP + MS, MPAD = 16640;
constexpr int DM = 1024, INAB = 4624, N0 = 4608, INC = 8192;
constexpr float EPSF = 1e-6f;
constexpr size_t O_Y = 0, O_AHP = 16908288, O_ACP = 16916480, O_BSP = 16941056, O_BCP = 17989632, O_CP = 18026496,
                 O_AHS = 20123648, O_ACS = 20254720, O_BSS = 20647936, O_BCS = 37425152, O_CS = 38014976;
constexpr size_t al256(size_t x) { return (x + 255) & ~size_t(255); }
constexpr size_t OFF_CTL = 0;
constexpr size_t OFF_BAR = 256;
constexpr size_t OFF_SS1 = 256 + 16384;
constexpr size_t OFF_SS2 = OFF_SS1 + al256((size_t)MPAD * 4);
constexpr size_t OFF_SSB = OFF_SS2 + al256((size_t)MPAD * 4);
constexpr size_t OFF_DT  = OFF_SSB + al256((size_t)MPAD * 8);
constexpr size_t OFF_W0T = OFF_DT + al256((size_t)MV * 16 * 4);
constexpr size_t OFF_WO0T = OFF_W0T + (size_t)(N0 + 256) * 1024 * 2;
constexpr size_t OFF_WG0T = OFF_WO0T + (size_t)1024 * 2048 * 2;
constexpr size_t OFF_WP0T = OFF_WG0T + (size_t)1024 * 1024 * 2;
constexpr size_t OFF_W1T  = OFF_WP0T + (size_t)1024 * 256 * 2;
constexpr size_t OFF_WO1T = OFF_W1T + (size_t)INC * 1024 * 2;
constexpr size_t OFF_WG1T = OFF_WO1T + (size_t)1024 * 2048 * 2;
constexpr size_t OFF_WP1T = OFF_WG1T + (size_t)1024 * 1024 * 2;
constexpr size_t OFF_WRT  = OFF_WP1T + (size_t)1024 * 256 * 2;
constexpr size_t OFF_WIT  = OFF_WRT + (size_t)128 * 1024 * 2;
constexpr size_t OFF_XN   = OFF_WIT + (size_t)128 * 1024 * 2;
constexpr size_t OFF_MIX  = OFF_XN + (size_t)MPAD * 1024 * 2;
constexpr size_t OFF_H    = OFF_MIX + (size_t)MPAD * 2048 * 2;
constexpr size_t OFF_U    = OFF_H + al256((size_t)MV * 1024 * 4);
constexpr size_t OFF_HB   = OFF_U;
constexpr size_t OFF_PB   = OFF_U + al256((size_t)MV * INC * 2);
constexpr size_t PB_STRIDE = (size_t)MPAD * 256 * 2;
constexpr size_t WS_END   = OFF_PB + 2 * PB_STRIDE;
constexpr int LDS_BYTES = 160 * 1024;

struct Params { const float* in[32]; float* out; unsigned char* ws; };
#define WSP(T, off) ((T*)(P.ws + (off)))

typedef __bf16 bf16v2_t __attribute__((ext_vector_type(2)));
typedef float f32v2_t __attribute__((ext_vector_type(2)));
DI unsigned pack2(float lo, float hi) { f32v2_t v = {lo, hi}; bf16v2_t b = __builtin_convertvector(v, bf16v2_t); return __builtin_bit_cast(unsigned, b); }
DI bf16_t f2bf(float f) { return __builtin_bit_cast(bf16_t, (__bf16)f); }
DI float bf2f(bf16_t b) { return __uint_as_float(((unsigned)b) << 16); }
DI float bflo(unsigned w) { return __uint_as_float(w << 16); }
DI float bfhi(unsigned w) { return __uint_as_float(w & 0xFFFF0000u); }
DI float frcp(float x) { return __builtin_amdgcn_rcpf(x); }
DI float sigm(float x) { return frcp(1.f + __expf(-x)); }
DI float silu(float x) { return x * frcp(1.f + __expf(-x)); }
DI float softplus(float x) { return x > 20.f ? x : log1pf(__expf(x)); }
DI float wave_sum(float v) { for (int o = 32; o > 0; o >>= 1) v += __shfl_xor(v, o); return v; }
DI int otid() { int t = threadIdx.x; asm volatile("" : "+v"(t)); return t; }
DI void lds_barrier() { asm volatile("s_waitcnt lgkmcnt(0)" ::: "memory"); __builtin_amdgcn_s_barrier(); asm volatile("" ::: "memory"); }
DI int crow(int reg, int hh) { return (reg & 3) + 8 * (reg >> 2) + 4 * hh; }
DI void ld4bf(const bf16_t* p, float (&o)[4]) { uint2 w = *(const uint2*)p; o[0] = bflo(w.x); o[1] = bfhi(w.x); o[2] = bflo(w.y); o[3] = bfhi(w.y); }
typedef unsigned u32x2 __attribute__((ext_vector_type(2)));
typedef unsigned u32x4 __attribute__((ext_vector_type(4)));
DI u32x2 pack4v(float a, float b, float c, float d) { u32x2 r; r.x = pack2(a, b); r.y = pack2(c, d); return r; }
DI uint2 pack4(float a, float b, float c, float d) { uint2 r; r.x = pack2(a, b); r.y = pack2(c, d); return r; }
#define MFMA32(a, b, c) __builtin_amdgcn_mfma_f32_32x32x16_bf16((a), (b), (c), 0, 0, 0)
#define MFMA16(a, b, c) __builtin_amdgcn_mfma_f32_16x16x32_bf16((a), (b), (c), 0, 0, 0)
DI bf16x8 ldfrag(const bf16_t* base, int ld, int row0, int k0, int lane) { return *(const bf16x8*)(base + (row0 + (lane & 31)) * ld + k0 + 8 * (lane >> 5)); }
DI bf16x8 ldfrag_sw72(const bf16_t* base, int row0, int k0, int lane) { const int row = row0 + (lane & 31); return *(const bf16x8*)(base + row * 72 + ((k0 + 8 * (lane >> 5)) ^ (((row >> 4) & 7) * 8))); }
DI bf16x8 ldfrag16(const bf16_t* base, int ld, int row0, int k0, int lane) { return *(const bf16x8*)(base + (row0 + (lane & 15)) * ld + k0 + 8 * (lane >> 4)); }

namespace pg8 {
constexpr int BM = 256, BK = 64, HALF = 128, HTB = HALF * BK * 2, STAGE_BYTES = 8 * HTB, NXCD = 8, WGM = 8;
DI int lds_byte(int r, int c) { const int st = (r >> 4) * 2 + (c >> 5), rr = r & 15, cc = c & 31, ob = rr * 64 + cc * 2; return st * 1024 + (ob ^ (((ob >> 9) & 1) << 5)); }
DI void stage_rc(int b, int& R, int& C) { const int st = b / 1024, sb = b % 1024, swz = sb ^ (((sb >> 9) & 1) << 5); R = (st >> 1) * 16 + swz / 64; C = (st & 1) * 32 + (swz % 64) / 2; }
DI int perm32(int rho) { const int n = rho >> 4, i = rho & 15; return 8 * (i >> 2) + 4 * n + (i & 3); }
struct Unit { int pm, pn; };
struct Gemm { const bf16_t* A; const bf16_t* Bt; int M, N, K; };
struct StaticOrder {
    int nM, nN, nwg, G, c;
    DI void init(int M, int N, int G_, int c_) { nM = M / BM; nN = N / BM; nwg = nM * nN; G = G_; c = c_; }
    DI bool next(int i, Unit& u) const {
        const long L = (long)i * G + c; if (L >= nwg) return false;
        int wgid = (int)L; { const int q = nwg / NXCD, r = nwg % NXCD, xcd = wgid % NXCD, off = wgid / NXCD; wgid = (xcd < r ? xcd * (q + 1) : r * (q + 1) + (xcd - r) * q) + off; }
        const int nig = WGM * nN, gid = wgid / nig, fm = gid * WGM, gsz = (nM - fm) < WGM ? (nM - fm) : WGM;
        u.pm = fm + ((wgid % nig) % gsz); u.pn = (wgid % nig) / gsz; return true;
    }
};

template <class Epi>
DI void gemm_phase(LAS unsigned char* lds, const Gemm g, const StaticOrder& S, const Epi& E) {
    const int tid = otid(), wid = __builtin_amdgcn_readfirstlane(tid >> 6), lane = tid & 63, wr = wid >> 2, wc = wid & 3, fr = lane & 15, fq = lane >> 4;
    const int K = g.K, nt = K / BK;
    unsigned voffA[2], voffB[2];
#pragma unroll
    for (int i = 0; i < 2; ++i) { int R, C; stage_rc(tid * 16 + i * 8192, R, C); const int Rb = Epi::PERM ? ((R & ~31) + perm32(R & 31)) : R;
        voffA[i] = (unsigned)(R * K + C) * 2u; voffB[i] = (unsigned)(Rb * K + C) * 2u; }
    const size_t kstep = (size_t)(BK * 2);
    const size_t hstep = (size_t)HALF * K * 2;
    const size_t tstep = 2 * hstep;
    const unsigned ldsw = (unsigned)wid * 1024u;
    const int aoff = lds_byte(wr * 64 + fr, fq * 8), boff = lds_byte(wc * 32 + fr, fq * 8);
#define PG8_SA(b, h) (((b) * 2 + (h)) * HTB)
#define PG8_SB(b, h) ((4 + (b) * 2 + (h)) * HTB)
#define PG8_STAGE(bufoff, gbase, voff) do { _Pragma("unroll") for (int _i = 0; _i < 2; ++_i) \
        __builtin_amdgcn_global_load_lds((const unsigned*)((const char*)(gbase) + (voff)[_i]), (LAS unsigned*)(lds + (bufoff) + ldsw + _i * 8192), 16, 0, 0); } while (0)
#define PG8_LDA(dst, b, h) do { _Pragma("unroll") for (int m = 0; m < 4; ++m) _Pragma("unroll") for (int k = 0; k < 2; ++k) dst[m][k] = *(const LAS bf16x8*)(lds + PG8_SA(b, h) + aoff + m * 2048 + k * 1024); } while (0)
#define PG8_LDB(dst, b, h) do { _Pragma("unroll") for (int n = 0; n < 2; ++n) _Pragma("unroll") for (int k = 0; k < 2; ++k) dst[n][k] = *(const LAS bf16x8*)(lds + PG8_SB(b, h) + boff + n * 2048 + k * 1024); } while (0)
#define PG8_MMA(ai, bj, At, Bt) do { __builtin_amdgcn_s_setprio(1); _Pragma("unroll") for (int m = 0; m < 4; ++m) _Pragma("unroll") for (int n = 0; n < 2; ++n) _Pragma("unroll") for (int k = 0; k < 2; ++k) \
        acc[ai][bj][m][n] = __builtin_amdgcn_mfma_f32_16x16x32_bf16(Bt[n][k], At[m][k], acc[ai][bj][m][n], 0, 0, 0); __builtin_amdgcn_s_setprio(0); } while (0)
#define PG8_WAIT_V(n) asm volatile("s_waitcnt vmcnt(" #n ")" ::: "memory")
#define PG8_WAIT_L(n) asm volatile("s_waitcnt lgkmcnt(" #n ")" ::: "memory")
#define PG8_BAR __builtin_amdgcn_s_barrier()
#define PG8_SCHED __builtin_amdgcn_sched_barrier(0)
    Unit cur, nxt; int ui = 0;
    if (!S.next(0, cur)) return;
    f32x4 acc[2][2][4][2];
#pragma unroll
    for (int a = 0; a < 2; ++a)
#pragma unroll
        for (int b = 0; b < 2; ++b)
#pragma unroll
            for (int m = 0; m < 4; ++m)
#pragma unroll
                for (int n = 0; n < 2; ++n) acc[a][b][m][n] = (f32x4){0.f, 0.f, 0.f, 0.f};
    bf16x8 At[4][2], B0[2][2], B1[2][2];
    const char* cA = (const char*)g.A + (size_t)cur.pm * tstep; const char* cB = (const char*)g.Bt + (size_t)cur.pn * tstep;
    PG8_STAGE(PG8_SB(0, 0), cB, voffB); PG8_STAGE(PG8_SA(0, 0), cA, voffA); PG8_STAGE(PG8_SB(0, 1), cB + hstep, voffB); PG8_STAGE(PG8_SA(0, 1), cA + hstep, voffA);
    if (wr == 1) PG8_BAR;
    PG8_WAIT_V(4); PG8_BAR;
    PG8_STAGE(PG8_SB(1, 0), cB + kstep, voffB); PG8_STAGE(PG8_SA(1, 0), cA + kstep, voffA); PG8_STAGE(PG8_SB(1, 1), cB + hstep + kstep, voffB);
    PG8_WAIT_V(6); PG8_BAR;
    for (;;) {
        const bool has_next = S.next(ui + 1, nxt);
        const char* nA = has_next ? (const char*)g.A + (size_t)nxt.pm * tstep : cA; const char* nB = has_next ? (const char*)g.Bt + (size_t)nxt.pn * tstep : cB;
        for (int t = 0; t < nt; t += 2) {
            const bool last = (t == nt - 2);
            const char* a1 = cA + (size_t)(t + 1) * kstep;
            const char* a2 = last ? nA : cA + (size_t)(t + 2) * kstep; const char* b2 = last ? nB : cB + (size_t)(t + 2) * kstep;
            const char* a3 = a2 + kstep; const char* b3 = b2 + kstep;
            PG8_LDB(B0, 0, 0); PG8_SCHED; PG8_LDA(At, 0, 0); PG8_STAGE(PG8_SA(1, 1), a1 + hstep, voffA);
            PG8_WAIT_L(8); PG8_BAR; PG8_WAIT_L(0); PG8_MMA(0, 0, At, B0); PG8_BAR; PG8_SCHED;
            PG8_LDB(B1, 0, 1); PG8_STAGE(PG8_SB(0, 0), b2, voffB);
            PG8_BAR; PG8_WAIT_L(0); PG8_MMA(0, 1, At, B1); PG8_BAR;
            PG8_LDA(At, 0, 1); PG8_STAGE(PG8_SA(0, 0), a2, voffA);
            PG8_BAR; PG8_WAIT_L(0); PG8_MMA(1, 0, At, B0); PG8_BAR; PG8_SCHED;
            PG8_STAGE(PG8_SB(0, 1), b2 + hstep, voffB);
            PG8_WAIT_V(6); PG8_BAR; PG8_MMA(1, 1, At, B1); PG8_BAR;
            PG8_LDB(B0, 1, 0); PG8_SCHED; PG8_LDA(At, 1, 0); PG8_STAGE(PG8_SA(0, 1), a2 + hstep, voffA);
            PG8_WAIT_L(8); PG8_BAR; PG8_WAIT_L(0); PG8_MMA(0, 0, At, B0); PG8_BAR; PG8_SCHED;
            PG8_LDB(B1, 1, 1); PG8_STAGE(PG8_SB(1, 0), b3, voffB);
            PG8_BAR; PG8_WAIT_L(0); PG8_MMA(0, 1, At, B1); PG8_BAR;
            PG8_LDA(At, 1, 1); PG8_STAGE(PG8_SA(1, 0), a3, voffA);
            PG8_BAR; PG8_WAIT_L(0); PG8_MMA(1, 0, At, B0); PG8_BAR; PG8_SCHED;
            PG8_STAGE(PG8_SB(1, 1), b3 + hstep, voffB);
            PG8_WAIT_V(6); PG8_BAR; PG8_MMA(1, 1, At, B1); PG8_BAR;
        }
        E(acc, cur, wr, wc, fr, fq);
        if (!has_next) break;
#pragma unroll
        for (int a = 0; a < 2; ++a)
#pragma unroll
            for (int b = 0; b < 2; ++b)
#pragma unroll
                for (int m = 0; m < 4; ++m)
#pragma unroll
                    for (int n = 0; n < 2; ++n) acc[a][b][m][n] = (f32x4){0.f, 0.f, 0.f, 0.f};
        cur = nxt; cA = nA; cB = nB; ++ui;
    }
    PG8_WAIT_V(0);
    if (wr == 0) PG8_BAR;
    PG8_BAR;
#undef PG8_SA
#undef PG8_SB
#undef PG8_STAGE
#undef PG8_LDA
#undef PG8_LDB
#undef PG8_MMA
#undef PG8_WAIT_V
#undef PG8_WAIT_L
#undef PG8_BAR
#undef PG8_SCHED
}
}

struct EpiStoreBf16 {
    static constexpr bool PERM = true;
    bf16_t* O; int ldc; const float* ss; float* DT;
    DI void operator()(const f32x4 (&acc)[2][2][4][2], const pg8::Unit& u, int wr, int wc, int fr, int fq) const {
        const int row0 = u.pm * 256 + wr * 64 + fr, col0 = u.pn * 256 + wc * 32 + 8 * fq;
        if (u.pn * 256 >= ldc) {
            if (wc == 0 && fq < 2) {
#pragma unroll
                for (int ai = 0; ai < 2; ++ai)
#pragma unroll
                    for (int m = 0; m < 4; ++m) { const int row = row0 + ai * 128 + m * 16;
                        if (row < MV) { *(f32x4*)(DT + (size_t)row * 16 + 8 * fq) = acc[ai][0][m][0]; *(f32x4*)(DT + (size_t)row * 16 + 8 * fq + 4) = acc[ai][0][m][1]; } }
            }
            return;
        }
#pragma unroll
        for (int ai = 0; ai < 2; ++ai)
#pragma unroll
            for (int m = 0; m < 4; ++m) {
                const int row = row0 + ai * 128 + m * 16;
                if (row < MV) {
                    const float sc = ss ? rsqrtf(ss[row] * (1.f / 1024.f) + EPSF) : 1.f;
                    bf16_t* rp = O + (size_t)row * ldc + col0;
#pragma unroll
                    for (int bj = 0; bj < 2; ++bj) {
                        const f32x4 v0 = acc[ai][bj][m][0] * sc, v1 = acc[ai][bj][m][1] * sc;
                        uint4 w; w.x = pack2(v0[0], v0[1]); w.y = pack2(v0[2], v0[3]); w.z = pack2(v1[0], v1[1]); w.w = pack2(v1[2], v1[3]);
                        *(uint4*)(rp + bj * 128) = w;
                    }
                }
            }
    }
};
struct EpiResid {
    static constexpr bool PERM = false;
    const float* rp_prompt; const float* rp_sample;
    float* H; bf16_t* HB;
    DI void operator()(const f32x4 (&acc)[2][2][4][2], const pg8::Unit& u, int wr, int wc, int fr, int fq) const {
        const int row0 = u.pm * 256 + wr * 64 + fr, col0 = u.pn * 256 + wc * 32 + 4 * fq;
#pragma unroll
        for (int ai = 0; ai < 2; ++ai)
#pragma unroll
            for (int m = 0; m < 4; ++m) {
                const int row = row0 + ai * 128 + m * 16;
                if (row < MV) {
                    const float* rs = (row < MP ? rp_prompt + (size_t)row * 1024 : rp_sample + (size_t)(row - MP) * 1024) + col0;
                    float* hp = H + (size_t)row * 1024 + col0; bf16_t* bp = HB + (size_t)row * 1024 + col0;
#pragma unroll
                    for (int bj = 0; bj < 2; ++bj)
#pragma unroll
                        for (int n = 0; n < 2; ++n) {
                            const int co = bj * 128 + n * 16;
                            const f32x4 v = acc[ai][bj][m][n] + *(const f32x4*)(rs + co);
                            *(f32x4*)(hp + co) = v; *(uint2*)(bp + co) = pack4(v[0], v[1], v[2], v[3]);
                        }
                }
            }
    }
};
struct EpiGate {
    static constexpr bool PERM = false;
    bf16_t* Gt;
    DI void operator()(const f32x4 (&acc)[2][2][4][2], const pg8::Unit& u, int wr, int wc, int fr, int fq) const {
        const int row0 = u.pm * 256 + wr * 64 + fr, col0 = u.pn * 256 + wc * 32 + 4 * fq;
#pragma unroll
        for (int ai = 0; ai < 2; ++ai)
#pragma unroll
            for (int m = 0; m < 4; ++m) {
                const int row = row0 + ai * 128 + m * 16;
                if (row < MV) {
                    bf16_t* gp = Gt + (size_t)row * 1024 + col0;
#pragma unroll
                    for (int bj = 0; bj < 2; ++bj)
#pragma unroll
                        for (int n = 0; n < 2; ++n) {
                            const f32x4 a = acc[ai][bj][m][n];
                            *(uint2*)(gp + bj * 128 + n * 16) = pack4(sigm(a[0]), sigm(a[1]), sigm(a[2]), sigm(a[3]));
                        }
                }
            }
    }
};
struct EpiPle {
    static constexpr bool PERM = false;
    float* H; const bf16_t* Gt; bf16_t* XN; const float* nw; float* SS;
    DI void operator()(const f32x4 (&acc)[2][2][4][2], const pg8::Unit& u, int wr, int wc, int fr, int fq) const {
        const int row0 = u.pm * 256 + wr * 64 + fr, col0 = u.pn * 256 + wc * 32 + 4 * fq;
#pragma unroll
        for (int ai = 0; ai < 2; ++ai)
#pragma unroll
            for (int m = 0; m < 4; ++m) {
                const int row = row0 + ai * 128 + m * 16;
                float ssum = 0.f;
                if (row < MV) {
                    float* hp = H + (size_t)row * 1024 + col0; const bf16_t* gp = Gt + (size_t)row * 1024 + col0;
#pragma unroll
                    for (int bj = 0; bj < 2; ++bj)
#pragma unroll
                        for (int n = 0; n < 2; ++n) {
                            const int co = bj * 128 + n * 16;
                            float gq[4]; ld4bf(gp + co, gq); const f32x4 v = *(const f32x4*)(hp + co) + (f32x4){gq[0], gq[1], gq[2], gq[3]} * acc[ai][bj][m][n];
                            *(f32x4*)(hp + co) = v;
                            ssum += v[0] * v[0] + v[1] * v[1] + v[2] * v[2] + v[3] * v[3];
                            if (XN) { const f32x4 w = *(const f32x4*)(nw + col0 + co); *(uint2*)(XN + (size_t)row * 1024 + col0 + co) = pack4(v[0] * w[0], v[1] * w[1], v[2] * w[2], v[3] * w[3]); }
                        }
                }
                ssum += __shfl_xor(ssum, 16); ssum += __shfl_xor(ssum, 32);
                if (fq == 0 && row < MV) atomicAdd(SS + row, ssum);
            }
    }
};

template <int KS, class F>
DI void sgemm(const bf16_t* A, const bf16_t* Bt, int K, int ncolt, int nwg_main, const F& f, unsigned char* L) {
    constexpr int RT = 8 / KS, NRS = 128 / (16 * RT);
    const int tid = otid(), lane = tid & 63, wid = __builtin_amdgcn_readfirstlane(tid >> 6), rt = wid % RT, ks = wid / RT;
    const int G = gridDim.x, off = nwg_main % G, Kh = K / KS;
    int li = blockIdx.x, nl = G;
    if (off != 0) { if ((int)blockIdx.x < off) return; li = blockIdx.x - off; nl = G - off; }
    float* red = (float*)L;
    for (int t = li; t < ncolt * NRS; t += nl) {
        const int ct = t / NRS, rs = t % NRS;
        const bf16_t* ap = A + (size_t)(MP + rs * 16 * RT + rt * 16 + (lane & 15)) * K + ks * Kh + 8 * (lane >> 4);
        const bf16_t* bp0 = Bt + (size_t)(ct * 32 + (lane & 15)) * K + ks * Kh + 8 * (lane >> 4);
        const bf16_t* bp1 = bp0 + (size_t)16 * K;
        f32x4 acc0 = {0.f, 0.f, 0.f, 0.f}, acc1 = {0.f, 0.f, 0.f, 0.f};
        bf16x8 a0[4], a1[4], p0[4], p1[4], q0[4], q1[4];
#define SG_LOAD(av, pv, qv, kk) do { _Pragma("unroll") for (int q_ = 0; q_ < 4; ++q_) { av[q_] = *(const bf16x8*)(ap + (kk) + q_ * 32); pv[q_] = *(const bf16x8*)(bp0 + (kk) + q_ * 32); qv[q_] = *(const bf16x8*)(bp1 + (kk) + q_ * 32); } } while (0)
#define SG_MMA(av, pv, qv) do { _Pragma("unroll") for (int q_ = 0; q_ < 4; ++q_) { acc0 = MFMA16(av[q_], pv[q_], acc0); acc1 = MFMA16(av[q_], qv[q_], acc1); } } while (0)
        SG_LOAD(a0, p0, q0, 0);
        for (int k0 = 0; k0 < Kh; k0 += 256) {
            if (k0 + 128 < Kh) SG_LOAD(a1, p1, q1, k0 + 128);
            SG_MMA(a0, p0, q0);
            if (k0 + 256 < Kh) SG_LOAD(a0, p0, q0, k0 + 256);
            if (k0 + 128 < Kh) SG_MMA(a1, p1, q1);
        }
#undef SG_LOAD
#undef SG_MMA
        if (ks > 0) { float* rp = red + (((ks - 1) * RT + rt) * 64 + lane) * 8; *(f32x4*)rp = acc0; *(f32x4*)(rp + 4) = acc1; }
        lds_barrier();
        if (ks == 0) {
#pragma unroll
            for (int j = 0; j < KS - 1; ++j) { const float* rp = red + ((j * RT + rt) * 64 + lane) * 8; acc0 += *(const f32x4*)rp; acc1 += *(const f32x4*)(rp + 4); }
#pragma unroll
            for (int reg = 0; reg < 4; ++reg) {
                const int row = MP + rs * 16 * RT + rt * 16 + (lane >> 4) * 4 + reg, col = ct * 32 + (lane & 15);
                f(row, col, acc0[reg], lane); f(row, col + 16, acc1[reg], lane);
            }
        }
        lds_barrier();
    }
}
struct SfU { bf16_t* O; int ldc; const float* ss; float* DT;
    DI void operator()(int row, int col, float v, int) const {
        if (col >= ldc) { if (col < ldc + 16) DT[(size_t)row * 16 + col - ldc] = v; return; }
        const float sc = ss ? rsqrtf(ss[row] * (1.f / 1024.f) + EPSF) : 1.f; O[(size_t)row * ldc + col] = f2bf(v * sc); } };
struct SfResid { const float* rs; float* H; bf16_t* HB;
    DI void operator()(int row, int col, float v, int) const { const float h = rs[(size_t)(row - MP) * 1024 + col] + v; H[(size_t)row * 1024 + col] = h; HB[(size_t)row * 1024 + col] = f2bf(h); } };
struct SfGate { bf16_t* Gt; DI void operator()(int row, int col, float v, int) const { Gt[(size_t)row * 1024 + col] = f2bf(sigm(v)); } };
struct SfPle { float* H; const bf16_t* Gt; bf16_t* XN; const float* nw; float* SS;
    DI void operator()(int row, int col, float v, int lane) const {
        const size_t o = (size_t)row * 1024 + col; const float h = H[o] + bf2f(Gt[o]) * v; H[o] = h;
        if (XN) XN[o] = f2bf(h * nw[col]);
        float ss = h * h; ss += __shfl_xor(ss, 1); ss += __shfl_xor(ss, 2); ss += __shfl_xor(ss, 4); ss += __shfl_xor(ss, 8);
        if ((lane & 15) == 0) atomicAdd(SS + row, ss); } };

DI void transpose_tile_w(const float* src, int lds_, bf16_t* dst, int ldd, int k0, int n0, int nvalid, float* tile, int lane) {
    const float* sp = src + (size_t)k0 * lds_ + n0 + lane;
#pragma unroll
    for (int bt = 0; bt < 4; ++bt) {
        float v[16];
#pragma unroll
        for (int r = 0; r < 16; ++r) v[r] = (lane < nvalid) ? sp[(size_t)(bt * 16 + r) * lds_] : 0.f;
#pragma unroll
        for (int r = 0; r < 16; ++r) tile[(bt * 16 + r) * 65 + lane] = v[r];
    }
    const int koct = lane & 7;
#pragma unroll
    for (int p = 0; p < 8; ++p) {
        const int nn = (lane >> 3) + 8 * p;
        const float* tp = tile + (koct * 8) * 65 + nn;
        uint4 w;
        w.x = pack2(tp[0], tp[65]); w.y = pack2(tp[2 * 65], tp[3 * 65]); w.z = pack2(tp[4 * 65], tp[5 * 65]); w.w = pack2(tp[6 * 65], tp[7 * 65]);
        *(uint4*)(dst + (size_t)(n0 + nn) * ldd + k0 + koct * 8) = w;
    }
}
DI void transpose_job(const float* src, int lds_, bf16_t* dst, int ldd, int K, int N, int nvalid_last, int& base, float* tile, int gw, int nwv, int lane) {
    const int ntn = (N + 63) / 64, nt = (K / 64) * ntn;
    const int first = (gw - (base % nwv) + nwv) % nwv;
    for (int t = first; t < nt; t += nwv) { const int tn = t % ntn; transpose_tile_w(src, lds_, dst, ldd, (t / ntn) * 64, tn * 64, (tn == ntn - 1) ? nvalid_last : 64, tile, lane); }
    base += nt;
}
DI void l1_weight_tile(const Params& P, int t, float* tile, int lane) {
    if (t < 2048) transpose_tile_w(P.in[26], INC, WSP(bf16_t, OFF_W1T), 1024, (t >> 7) * 64, (t & 127) * 64, 64, tile, lane);
    else if (t < 2560) { t -= 2048; transpose_tile_w(P.in[29], 1024, WSP(bf16_t, OFF_WO1T), 2048, (t >> 4) * 64, (t & 15) * 64, 64, tile, lane); }
    else if (t < 2816) { t -= 2560; transpose_tile_w(P.in[31] + 1024 * 1024, 1024, WSP(bf16_t, OFF_WG1T), 1024, (t >> 4) * 64, (t & 15) * 64, 64, tile, lane); }
    else if (t < 2880) { t -= 2816; transpose_tile_w(P.in[30] + 256 * 1024, 1024, WSP(bf16_t, OFF_WP1T), 256, (t >> 4) * 64, (t & 15) * 64, 64, tile, lane); }
    else if (t < 3392) { t -= 2880; transpose_tile_w(P.in[25], 1024, WSP(bf16_t, OFF_WO0T), 2048, (t >> 4) * 64, (t & 15) * 64, 64, tile, lane); }
    else if (t < 3648) { t -= 3392; transpose_tile_w(P.in[31], 1024, WSP(bf16_t, OFF_WG0T), 1024, (t >> 4) * 64, (t & 15) * 64, 64, tile, lane); }
    else { t -= 3648; transpose_tile_w(P.in[30], 1024, WSP(bf16_t, OFF_WP0T), 256, (t >> 4) * 64, (t & 15) * 64, 64, tile, lane); }
}
DI void phase_prep(const Params& P, unsigned char* L) {
    const int tid = otid(), lane = tid & 63, wid = tid >> 6;
    const int gw = blockIdx.x * 8 + wid, nwv = gridDim.x * 8;
    { float* z = WSP(float, OFF_SS1); const int n = (int)((OFF_DT - OFF_SS1) / 4);
      for (int i = blockIdx.x * 512 + tid; i < n; i += gridDim.x * 512) z[i] = 0.f;
      if (blockIdx.x == 0 && tid < 64) WSP(unsigned, OFF_CTL)[tid] = 0u; }
    { float* tile = (float*)L + wid * (64 * 65); int base = 0;
      transpose_job(P.in[11], INAB, WSP(bf16_t, OFF_W0T), 1024, 1024, N0, 64, base, tile, gw, nwv, lane);
      transpose_job(P.in[11] + N0, INAB, WSP(bf16_t, OFF_W0T) + (size_t)N0 * 1024, 1024, 1024, 16, 16, base, tile, gw, nwv, lane);
      transpose_job(P.in[14], 128, WSP(bf16_t, OFF_WRT), 1024, 1024, 128, 64, base, tile, gw, nwv, lane);
      transpose_job(P.in[16], 128, WSP(bf16_t, OFF_WIT), 1024, 1024, 128, 64, base, tile, gw, nwv, lane); }
    { const float* nwp = P.in[9]; bf16_t* XN = WSP(bf16_t, OFF_XN);
      f32x4 w4[4];
#pragma unroll
      for (int i = 0; i < 4; ++i) w4[i] = *(const f32x4*)(nwp + lane * 4 + 256 * i);
      for (int r0 = gw * 2; r0 < MV; r0 += nwv * 2) {
          f32x4 x[2][4];
#pragma unroll
          for (int q = 0; q < 2; ++q) { const int r = r0 + q; const float* src = r < MP ? P.in[0] + (size_t)r * 1024 : P.in[1] + (size_t)(r - MP) * 1024;
#pragma unroll
              for (int i = 0; i < 4; ++i) x[q][i] = *(const f32x4*)(src + lane * 4 + 256 * i); }
#pragma unroll
          for (int q = 0; q < 2; ++q) {
              float ss = 0.f;
#pragma unroll
              for (int i = 0; i < 4; ++i) ss += x[q][i][0] * x[q][i][0] + x[q][i][1] * x[q][i][1] + x[q][i][2] * x[q][i][2] + x[q][i][3] * x[q][i][3];
              ss = wave_sum(ss); const float rstd = rsqrtf(ss * (1.f / 1024.f) + EPSF);
#pragma unroll
              for (int i = 0; i < 4; ++i) { const f32x4 v = x[q][i] * rstd * w4[i]; *(uint2*)(XN + (size_t)(r0 + q) * 1024 + lane * 4 + 256 * i) = pack4(v[0], v[1], v[2], v[3]); }
          }
      } }
}
DI void convert_p_chunk(const Params& P, int layer, int chunk, int tid) {
    bf16_t* PB = WSP(bf16_t, OFF_PB + (size_t)layer * PB_STRIDE);
    const float* pp = P.in[2] + (size_t)layer * MP * 256; const float* ps = P.in[3] + (size_t)layer * MS * 256;
#pragma unroll 4
    for (int j = 0; j < 16; ++j) {
        const int i = chunk * 8192 + j * 512 + tid;
        if (i < MV * 64) {
            const int row = i >> 6, c4 = (i & 63) * 4;
            const f32x4 v = *(const f32x4*)((row < MP ? pp + (size_t)row * 256 : ps + (size_t)(row - MP) * 256) + c4);
            *(uint2*)(PB + (size_t)row * 256 + c4) = pack4(v[0], v[1], v[2], v[3]);
        }
    }
}

constexpr size_t OFF_XT = OFF_XN;
constexpr size_t OFF_CN = OFF_H;
constexpr size_t OFF_BN = OFF_CN + (size_t)MP * 256 * 2;
constexpr size_t OFF_BT = OFF_BN + (size_t)MP * 256 * 2;
DI void phase_convbc(const Params& P, unsigned char* L) {
    const bf16_t* U = WSP(bf16_t, OFF_U);
    bf16_t* XT = WSP(bf16_t, OFF_XT); bf16_t* CN = WSP(bf16_t, OFF_CN); bf16_t* CBG = WSP(bf16_t, OFF_BN); bf16_t* BT = WSP(bf16_t, OFF_BT);
    const int tid = otid();
    for (int task = blockIdx.x; task < 256; task += gridDim.x) {
        const int b = task >> 5, c = (task >> 1) & 15, g = task & 1, lane = tid & 63, wid = tid >> 6, hh = lane >> 5, l31 = lane & 31;
        bf16_t* Cs = (bf16_t*)L; bf16_t* Bs = Cs + 128 * 136;
        const int quad = tid & 63, isC = quad >> 5, n0 = (quad & 31) * 4, cch = 1024 + isC * 256 + g * 128 + n0, t0 = (tid >> 6) * 16, tg0 = c * 128 + t0;
        const size_t tile = ((size_t)((b * 16 + c) * 2 + g)) * 128 * 128;
        float cw[4][4], cbias[4];
#pragma unroll
        for (int kk = 0; kk < 4; ++kk) { const f32x4 w = *(const f32x4*)(P.in[19] + kk * 1536 + cch); cw[kk][0] = w[0]; cw[kk][1] = w[1]; cw[kk][2] = w[2]; cw[kk][3] = w[3]; }
        { const f32x4 w = *(const f32x4*)(P.in[20] + cch); cbias[0] = w[0]; cbias[1] = w[1]; cbias[2] = w[2]; cbias[3] = w[3]; }
        const unsigned voff = (unsigned)((b * 2048 + tg0) * N0 + 3072 + cch);
        u32x2 raw[19];
#pragma unroll
        for (int j = 0; j < 19; ++j) raw[j] = (tg0 + j - 3 >= 0) ? *(const u32x2*)((U + (j - 3) * N0) + voff) : (u32x2){0u, 0u};
        lds_barrier();
        unsigned bt[4][8];
#pragma unroll
        for (int j = 0; j < 16; j += 2) {
            float y[2][4];
#pragma unroll
            for (int q = 0; q < 2; ++q) {
                const float x0[4] = {bflo(raw[j + q].x), bfhi(raw[j + q].x), bflo(raw[j + q].y), bfhi(raw[j + q].y)};
                const float x1[4] = {bflo(raw[j + q + 1].x), bfhi(raw[j + q + 1].x), bflo(raw[j + q + 1].y), bfhi(raw[j + q + 1].y)};
                const float x2[4] = {bflo(raw[j + q + 2].x), bfhi(raw[j + q + 2].x), bflo(raw[j + q + 2].y), bfhi(raw[j + q + 2].y)};
                const float x3[4] = {bflo(raw[j + q + 3].x), bfhi(raw[j + q + 3].x), bflo(raw[j + q + 3].y), bfhi(raw[j + q + 3].y)};
#pragma unroll
                for (int e = 0; e < 4; ++e) y[q][e] = silu(cbias[e] + cw[0][e] * x0[e] + cw[1][e] * x1[e] + cw[2][e] * x2[e] + cw[3][e] * x3[e]);
                const u32x2 pk = pack4v(y[q][0], y[q][1], y[q][2], y[q][3]);
                *(u32x2*)((isC ? Cs : Bs) + (t0 + j + q) * 136 + n0) = pk;
                if (isC) *(u32x2*)(CN + tile + (size_t)(t0 + j + q) * 128 + n0) = pk;
            }
#pragma unroll
            for (int e = 0; e < 4; ++e) bt[e][j >> 1] = pack2(y[0][e], y[1][e]);
        }
        if (!isC) {
#pragma unroll
            for (int e = 0; e < 4; ++e) { bf16_t* dp = BT + tile + (size_t)(n0 + e) * 128 + t0;
                *(u32x4*)dp = (u32x4){bt[e][0], bt[e][1], bt[e][2], bt[e][3]}; *(u32x4*)(dp + 8) = (u32x4){bt[e][4], bt[e][5], bt[e][6], bt[e][7]}; }
        }
        lds_barrier();
        const int rb = (wid >> 1) * 32, cb0 = (wid & 1) * 64;
        f32x16 cbA[2];
#pragma unroll
        for (int i = 0; i < 16; ++i) { cbA[0][i] = 0.f; cbA[1][i] = 0.f; }
#pragma unroll
        for (int ks = 0; ks < 8; ++ks) {
            const bf16x8 a = ldfrag(Cs, 136, rb, ks * 16, lane);
            cbA[0] = MFMA32(a, ldfrag(Bs, 136, cb0, ks * 16, lane), cbA[0]);
            cbA[1] = MFMA32(a, ldfrag(Bs, 136, cb0 + 32, ks * 16, lane), cbA[1]);
        }
#pragma unroll
        for (int j = 0; j < 2; ++j)
#pragma unroll
            for (int reg = 0; reg < 16; ++reg) CBG[tile + (size_t)(rb + crow(reg, hh)) * 128 + cb0 + j * 32 + l31] = f2bf(cbA[j][reg]);
        lds_barrier();
    }
    for (int idx = blockIdx.x * 512 + tid; idx < 2048 * 256; idx += gridDim.x * 512) {
        const int quad = idx & 255, tgp = idx >> 8, b = tgp >> 8, t0 = (tgp & 255) * 8, cch = quad * 4;
        float cw[4][4], cbias[4];
#pragma unroll
        for (int kk = 0; kk < 4; ++kk) { const f32x4 w = *(const f32x4*)(P.in[19] + kk * 1536 + cch); cw[kk][0] = w[0]; cw[kk][1] = w[1]; cw[kk][2] = w[2]; cw[kk][3] = w[3]; }
        { const f32x4 w = *(const f32x4*)(P.in[20] + cch); cbias[0] = w[0]; cbias[1] = w[1]; cbias[2] = w[2]; cbias[3] = w[3]; }
        const unsigned voff = (unsigned)((b * 2048 + t0) * N0 + 3072 + cch);
        u32x2 raw[11];
#pragma unroll
        for (int j = 0; j < 11; ++j) raw[j] = (t0 + j - 3 >= 0) ? *(const u32x2*)((U + (j - 3) * N0) + voff) : (u32x2){0u, 0u};
        float y[8][4];
#pragma unroll
        for (int j = 0; j < 8; ++j) {
            const float x0[4] = {bflo(raw[j].x), bfhi(raw[j].x), bflo(raw[j].y), bfhi(raw[j].y)};
            const float x1[4] = {bflo(raw[j + 1].x), bfhi(raw[j + 1].x), bflo(raw[j + 1].y), bfhi(raw[j + 1].y)};
            const float x2[4] = {bflo(raw[j + 2].x), bfhi(raw[j + 2].x), bflo(raw[j + 2].y), bfhi(raw[j + 2].y)};
            const float x3[4] = {bflo(raw[j + 3].x), bfhi(raw[j + 3].x), bflo(raw[j + 3].y), bfhi(raw[j + 3].y)};
#pragma unroll
            for (int e = 0; e < 4; ++e) y[j][e] = silu(cbias[e] + cw[0][e] * x0[e] + cw[1][e] * x1[e] + cw[2][e] * x2[e] + cw[3][e] * x3[e]);
        }
        const int c = t0 >> 7, tl = t0 & 127;
#pragma unroll
        for (int e = 0; e < 4; ++e) *(u32x4*)(XT + ((size_t)((b * 16 + c) * 1024 + cch + e)) * 128 + tl) = (u32x4){pack2(y[0][e], y[1][e]), pack2(y[2][e], y[3][e]), pack2(y[4][e], y[5][e]), pack2(y[6][e], y[7][e])};
    }
}
DI void ssd_prompt_item(const Params& P, unsigned char* L, int item) {
    const int b = item >> 4, h = item & 15, g = h >> 3;
    const int tid0 = otid(), wid = tid0 >> 6;
    bf16_t* Cs = (bf16_t*)L;
    bf16_t* Ws = Cs + 128 * 136;
    bf16_t* BsT = Ws + 128 * 136;
    bf16_t* XsT = BsT + 128 * 136;
    bf16_t* St = XsT + 64 * 136;
    bf16_t* XwT = St + 64 * 136;
    float* dtvB = (float*)(XwT + 64 * 136); float* acsB = dtvB + 256; float* wvB = acsB + 256;
    const bf16_t* U = WSP(bf16_t, OFF_U); const float* DT = WSP(float, OFF_DT); bf16_t* MIX = WSP(bf16_t, OFF_MIX); float* SSB = WSP(float, OFF_SSB);
    const float a_neg = -__expf(P.in[22][h]), dtb = P.in[21][h], Dh = P.in[23][h];
    f32x16 accS;
#pragma unroll
    for (int i = 0; i < 16; ++i) accS[i] = 0.f;
    lds_barrier();
    for (int i = tid0; i < 64 * 136; i += 512) St[i] = 0;
    float dtr0 = 0.f, dtr1 = 0.f;
#define SSD_DTLOAD(cc) do { if (wid == 0) { const float* dp_ = DT + (size_t)(b * 2048 + (cc) * 128 + (tid0 & 63)) * 16 + h; dtr0 = dp_[0]; dtr1 = dp_[64 * 16]; } } while (0)
#define SSD_SCAN(buf) do { if (wid == 0) { const int ln_ = tid0 & 63; const float d0_ = softplus(dtr0 + dtb), d1_ = softplus(dtr1 + dtb); float v0_ = d0_ * a_neg, v1_ = d1_ * a_neg; \
        _Pragma("unroll") for (int o_ = 1; o_ < 64; o_ <<= 1) { const float n0_ = __shfl_up(v0_, o_), n1_ = __shfl_up(v1_, o_); if (ln_ >= o_) { v0_ += n0_; v1_ += n1_; } } \
        v1_ += __shfl(v0_, 63); const float al_ = __shfl(v1_, 63); \
        dtvB[(buf) * 128 + ln_] = d0_; dtvB[(buf) * 128 + 64 + ln_] = d1_; acsB[(buf) * 128 + ln_] = v0_; acsB[(buf) * 128 + 64 + ln_] = v1_; \
        wvB[(buf) * 128 + ln_] = __expf(al_ - v0_) * d0_; wvB[(buf) * 128 + 64 + ln_] = __expf(al_ - v1_) * d1_; } } while (0)
    SSD_DTLOAD(0); SSD_SCAN(0); SSD_DTLOAD(1);
    u32x4 tC[4], tB[4], tT[4], tX[2];
    for (int c = 0; c < 16; ++c) {
        const int row0 = b * 2048 + c * 128;
        lds_barrier();
        int zv = 0; asm volatile("" : "+v"(zv));
        const int tid = tid0 + zv, lane = tid & 63, hh = lane >> 5, l31 = lane & 31;
        const int prow = tid >> 4, pcol = (tid & 15) * 8;
        const float* dtv = dtvB + (c & 1) * 128; const float* acs = acsB + (c & 1) * 128; const float* wv = wvB + (c & 1) * 128;
        if (c + 1 < 16) { SSD_SCAN((c + 1) & 1); if (c + 2 < 16) SSD_DTLOAD(c + 2); }
        if (c == 0) {
            const size_t tb_ = ((size_t)((b * 16 + c) * 2 + g)) * 128 * 128 + (size_t)prow * 128 + pcol;
            const u32x4* pc = (const u32x4*)(WSP(bf16_t, OFF_CN) + tb_); const u32x4* pb = (const u32x4*)(WSP(bf16_t, OFF_BN) + tb_); const u32x4* pt = (const u32x4*)(WSP(bf16_t, OFF_BT) + tb_);
            const u32x4* px = (const u32x4*)(WSP(bf16_t, OFF_XT) + ((size_t)((b * 16 + c) * 1024 + h * 64 + prow)) * 128 + pcol);
#pragma unroll
            for (int i = 0; i < 4; ++i) { tC[i] = pc[i * 512]; tB[i] = pb[i * 512]; tT[i] = pt[i * 512]; }
            tX[0] = px[0]; tX[1] = px[512];
        }
        const float a_last = acs[127];
        float asv[8], dsv[8];
        { const f32x4 a0 = *(const f32x4*)(acs + pcol), a1 = *(const f32x4*)(acs + pcol + 4), d0 = *(const f32x4*)(dtv + pcol), d1 = *(const f32x4*)(dtv + pcol + 4);
#pragma unroll
          for (int q = 0; q < 4; ++q) { asv[q] = a0[q]; asv[q + 4] = a1[q]; dsv[q] = d0[q]; dsv[q + 4] = d1[q]; } }
#pragma unroll
        for (int i = 0; i < 4; ++i) {
            *(u32x4*)(Cs + (prow + 32 * i) * 136 + pcol) = tC[i]; *(u32x4*)(BsT + (prow + 32 * i) * 136 + pcol) = tT[i];
            {
                const int t = prow + 32 * i; const float at = acs[t];
                const unsigned cw_[4] = {tB[i].x, tB[i].y, tB[i].z, tB[i].w};
                float wv_[8];
#pragma unroll
                for (int q = 0; q < 8; ++q) { const int sidx = pcol + q; const float cbv = (q & 1) ? bfhi(cw_[q >> 1]) : bflo(cw_[q >> 1]);
                    wv_[q] = (sidx <= t) ? cbv * __expf(at - asv[q]) * dsv[q] : 0.f; }
                *(u32x4*)(Ws + t * 136 + pcol) = (u32x4){pack2(wv_[0], wv_[1]), pack2(wv_[2], wv_[3]), pack2(wv_[4], wv_[5]), pack2(wv_[6], wv_[7])};
            }
        }
        *(u32x4*)(XsT + prow * 136 + pcol) = tX[0]; *(u32x4*)(XsT + (prow + 32) * 136 + pcol) = tX[1];
        {
            const f32x4 w0 = *(const f32x4*)(wv + pcol), w1 = *(const f32x4*)(wv + pcol + 4);
            u32x4 oa, ob; const u32x4 xa = tX[0], xb_ = tX[1];
            oa.x = pack2(bflo(xa.x) * w0[0], bfhi(xa.x) * w0[1]); oa.y = pack2(bflo(xa.y) * w0[2], bfhi(xa.y) * w0[3]); oa.z = pack2(bflo(xa.z) * w1[0], bfhi(xa.z) * w1[1]); oa.w = pack2(bflo(xa.w) * w1[2], bfhi(xa.w) * w1[3]);
            ob.x = pack2(bflo(xb_.x) * w0[0], bfhi(xb_.x) * w0[1]); ob.y = pack2(bflo(xb_.y) * w0[2], bfhi(xb_.y) * w0[3]); ob.z = pack2(bflo(xb_.z) * w1[0], bfhi(xb_.z) * w1[1]); ob.w = pack2(bflo(xb_.w) * w1[2], bfhi(xb_.w) * w1[3]);
            *(u32x4*)(XwT + prow * 136 + pcol) = oa; *(u32x4*)(XwT + (prow + 32) * 136 + pcol) = ob;
        }
        if (c + 1 < 16) {
            const size_t tb_ = ((size_t)((b * 16 + c + 1) * 2 + g)) * 128 * 128 + (size_t)prow * 128 + pcol;
            const u32x4* pc = (const u32x4*)(WSP(bf16_t, OFF_CN) + tb_); const u32x4* pb = (const u32x4*)(WSP(bf16_t, OFF_BN) + tb_); const u32x4* pt = (const u32x4*)(WSP(bf16_t, OFF_BT) + tb_);
            const u32x4* px = (const u32x4*)(WSP(bf16_t, OFF_XT) + ((size_t)((b * 16 + c + 1) * 1024 + h * 64 + prow)) * 128 + pcol);
#pragma unroll
            for (int i = 0; i < 4; ++i) { tC[i] = pc[i * 512]; tB[i] = pb[i * 512]; tT[i] = pt[i * 512]; }
            tX[0] = px[0]; tX[1] = px[512];
        }
        bf16_t zr[16];
        {
            const unsigned zoff = (unsigned)((row0 + (wid >> 1) * 32 + 4 * hh) * N0 + 2048 + h * 64 + (wid & 1) * 32 + l31);
#pragma unroll
            for (int reg = 0; reg < 16; ++reg) zr[reg] = (U + ((reg & 3) + 8 * (reg >> 2)) * N0)[zoff];
        }
        lds_barrier();
        {
            const int tb = (wid >> 1) * 32, pb = (wid & 1) * 32;
            f32x16 y;
#pragma unroll
            for (int i = 0; i < 16; ++i) y[i] = 0.f;
#pragma unroll
            for (int ks = 0; ks < 8; ++ks) y = MFMA32(ldfrag(Cs, 136, tb, ks * 16, lane), ldfrag(St, 136, pb, ks * 16, lane), y);
            f32x16 y2;
#pragma unroll
            for (int i = 0; i < 16; ++i) y2[i] = 0.f;
#pragma unroll
            for (int ks = 0; ks < 8; ++ks) y2 = MFMA32(ldfrag(Ws, 136, tb, ks * 16, lane), ldfrag(XsT, 136, pb, ks * 16, lane), y2);
#pragma unroll
            for (int reg = 0; reg < 16; ++reg) y[reg] = y[reg] * __expf(acs[tb + crow(reg, hh)]) + y2[reg];
            const int p = pb + l31, ch = h * 64 + p; const float nwv = P.in[24][ch];
            float sq[16];
#pragma unroll
            for (int reg = 0; reg < 16; ++reg) {
                const int t = tb + crow(reg, hh); const size_t row = (size_t)(row0 + t);
                const float xv = bf2f(XsT[p * 136 + t]); const float z = bf2f(zr[reg]);
                const float yy = (y[reg] + Dh * xv) * silu(z);
                sq[reg] = yy * yy;
                MIX[row * 2048 + 1024 + ch] = f2bf(yy * nwv);
            }
#define SSD_RSTEP(m, n) do { const bool up_ = (l31 & (m)) != 0; _Pragma("unroll") for (int i_ = 0; i_ < (n); ++i_) { const float snd_ = up_ ? sq[i_] : sq[i_ + (n)]; const float kp_ = up_ ? sq[i_ + (n)] : sq[i_]; sq[i_] = kp_ + __shfl_xor(snd_, (m)); } } while (0)
            SSD_RSTEP(16, 8); SSD_RSTEP(8, 4); SSD_RSTEP(4, 2); SSD_RSTEP(2, 1);
#undef SSD_RSTEP
            sq[0] += __shfl_xor(sq[0], 1);
            if ((l31 & 1) == 0) atomicAdd(SSB + (size_t)(row0 + tb + crow(l31 >> 1, hh)) * 2 + g, sq[0]);
            lds_barrier();
            const int pb2 = (wid >> 2) * 32, nb = (wid & 3) * 32;
            const float ea = __expf(a_last);
#pragma unroll
            for (int reg = 0; reg < 16; ++reg) accS[reg] *= ea;
#pragma unroll
            for (int ks = 0; ks < 8; ++ks) accS = MFMA32(ldfrag(XwT, 136, pb2, ks * 16, lane), ldfrag(BsT, 136, nb, ks * 16, lane), accS);
#pragma unroll
            for (int reg = 0; reg < 16; ++reg) St[(pb2 + crow(reg, hh)) * 136 + nb + l31] = f2bf(accS[reg]);
        }
    }
    {
        const int lane = tid0 & 63, hh = lane >> 5, l31 = lane & 31;
        const int pb2 = (wid >> 2) * 32, nb = (wid & 3) * 32;
        float* o = P.out + O_BSP + (size_t)(b * 16 + h) * 64 * 128;
#pragma unroll
        for (int reg = 0; reg < 16; ++reg) o[(pb2 + crow(reg, hh)) * 128 + nb + l31] = accS[reg];
    }
}
#undef SSD_DTLOAD
#undef SSD_SCAN
DI void ssd_sample_item(const Params& P, unsigned char* L, int item) {
    const int b = item >> 4, h = item & 15, g = h >> 3, tid = otid(), lane = tid & 63;
    float* xs = (float*)L; float* Bv = xs + 64; float* Cv = Bv + 128; float* yv = Cv + 128;
    const bf16_t* U = WSP(bf16_t, OFF_U); bf16_t* MIX = WSP(bf16_t, OFF_MIX); float* SSB = WSP(float, OFF_SSB);
    const size_t row = (size_t)(MP + b);
    __syncthreads();
    if (tid < 320) {
        int cc; if (tid < 64) cc = h * 64 + tid; else if (tid < 192) cc = 1024 + g * 128 + (tid - 64); else cc = 1280 + g * 128 + (tid - 192);
        const float* buf = P.in[7] + (size_t)b * 3 * 1536 + cc;
        const float v = P.in[20][cc] + P.in[19][cc] * buf[0] + P.in[19][1536 + cc] * buf[1536] + P.in[19][2 * 1536 + cc] * buf[2 * 1536] + P.in[19][3 * 1536 + cc] * bf2f(U[row * N0 + 3072 + cc]);
        xs[tid] = silu(v);
    }
    const float dt = softplus(WSP(float, OFF_DT)[row * 16 + h] + P.in[21][h]);
    const float dA = __expf(-dt * __expf(P.in[22][h]));
    __syncthreads();
    const float* s0 = P.in[6] + (size_t)(b * 16 + h) * 64 * 128; float* s1 = P.out + O_BSS + (size_t)(b * 16 + h) * 64 * 128;
    const int n4 = (tid & 31) * 4;
    const f32x4 Bq = *(const f32x4*)(Bv + n4), Cq = *(const f32x4*)(Cv + n4);
#pragma unroll
    for (int j = 0; j < 4; ++j) {
        const int p = (tid >> 5) + 16 * j;
        const f32x4 s = *(const f32x4*)(s0 + p * 128 + n4);
        const float dx = dt * xs[p];
        const f32x4 sn = s * dA + Bq * dx;
        *(f32x4*)(s1 + p * 128 + n4) = sn;
        float yp = sn[0] * Cq[0] + sn[1] * Cq[1] + sn[2] * Cq[2] + sn[3] * Cq[3];
        yp += __shfl_xor(yp, 1); yp += __shfl_xor(yp, 2); yp += __shfl_xor(yp, 4); yp += __shfl_xor(yp, 8); yp += __shfl_xor(yp, 16);
        if ((tid & 31) == 0) yv[p] = yp;
    }
    __syncthreads();
    if (tid < 64) {
        const int ch = h * 64 + tid;
        const float yy = (yv[tid] + P.in[23][h] * xs[tid]) * silu(bf2f(U[row * N0 + 2048 + ch]));
        const float ss = wave_sum(yy * yy);
        if (lane == 0) atomicAdd(SSB + row * 2 + g, ss);
        MIX[row * 2048 + 1024 + ch] = f2bf(yy * P.in[24][ch]);
    }
}
DI void ssd_sample_item4(const Params& P, unsigned char* L, int item) {
    const int b = item >> 2, tid = otid(), gi = tid >> 7, lt = tid & 127, h = (item & 3) * 4 + gi, g = h >> 3;
    float* xs = (float*)L + gi * 512; float* Bv = xs + 64; float* Cv = Bv + 128; float* yv = Cv + 128;
    const bf16_t* U = WSP(bf16_t, OFF_U); bf16_t* MIX = WSP(bf16_t, OFF_MIX); float* SSB = WSP(float, OFF_SSB);
    const size_t row = (size_t)(MP + b);
    __syncthreads();
#pragma unroll
    for (int ps = 0; ps < 3; ++ps) {
        const int idx = lt + 128 * ps;
        if (idx < 320) {
            int cc; if (idx < 64) cc = h * 64 + idx; else if (idx < 192) cc = 1024 + g * 128 + (idx - 64); else cc = 1280 + g * 128 + (idx - 192);
            const float* buf = P.in[7] + (size_t)b * 3 * 1536 + cc;
            const float v = P.in[20][cc] + P.in[19][cc] * buf[0] + P.in[19][1536 + cc] * buf[1536] + P.in[19][2 * 1536 + cc] * buf[2 * 1536] + P.in[19][3 * 1536 + cc] * bf2f(U[row * N0 + 3072 + cc]);
            xs[idx] = silu(v);
        }
    }
    const float dt = softplus(WSP(float, OFF_DT)[row * 16 + h] + P.in[21][h]);
    const float dA = __expf(-dt * __expf(P.in[22][h]));
    __syncthreads();
    const float* s0 = P.in[6] + (size_t)(b * 16 + h) * 64 * 128; float* s1 = P.out + O_BSS + (size_t)(b * 16 + h) * 64 * 128;
    const int n4 = (lt & 31) * 4;
    const f32x4 Bq = *(const f32x4*)(Bv + n4), Cq = *(const f32x4*)(Cv + n4);
    f32x4 sv[16];
#pragma unroll
    for (int j = 0; j < 16; ++j) sv[j] = *(const f32x4*)(s0 + ((lt >> 5) + 4 * j) * 128 + n4);
#pragma unroll
    for (int j = 0; j < 16; ++j) {
        const int p = (lt >> 5) + 4 * j;
        const f32x4 sn = sv[j] * dA + Bq * (dt * xs[p]);
        *(f32x4*)(s1 + p * 128 + n4) = sn;
        float yp = sn[0] * Cq[0] + sn[1] * Cq[1] + sn[2] * Cq[2] + sn[3] * Cq[3];
        yp += __shfl_xor(yp, 1); yp += __shfl_xor(yp, 2); yp += __shfl_xor(yp, 4); yp += __shfl_xor(yp, 8); yp += __shfl_xor(yp, 16);
        if ((lt & 31) == 0) yv[p] = yp;
    }
    __syncthreads();
    if (lt < 64) {
        const int ch = h * 64 + lt;
        const float yy = (yv[lt] + P.in[23][h] * xs[lt]) * silu(bf2f(U[row * N0 + 2048 + ch]));
        const float ss = wave_sum(yy * yy);
        if (lt == 0) atomicAdd(SSB + row * 2 + g, ss);
        MIX[row * 2048 + 1024 + ch] = f2bf(yy * P.in[24][ch]);
    }
}
template <bool SAMPLE>
DI void rglru_item(const Params& P, unsigned char* L, int item) {
    const int tid0 = otid(), wid = tid0 >> 6;
    const int b = SAMPLE ? 0 : (item >> 4), k = (item >> 1) & 7, dh = item & 1;
    bf16_t* Xs = (bf16_t*)L;
    bf16_t* Wg = Xs + 128 * 136;
    float* Aa = (float*)(Wg + 128 * 136);
    float* Uu = Aa + 128 * 64; float* segA = Uu + 128 * 64; float* segH = segA + 512; float* hc = segH + 512;
    const bf16_t* U = WSP(bf16_t, OFF_U); bf16_t* MIX = WSP(bf16_t, OFF_MIX);
    lds_barrier();
    {
        const bf16_t* WRT = WSP(bf16_t, OFF_WRT); const bf16_t* WIT = WSP(bf16_t, OFF_WIT);
#pragma unroll
        for (int i = 0; i < 4; ++i) {
            const int chk = tid0 + i * 512, r = chk >> 4, c8 = (chk & 15) * 8;
            const bf16_t* src = (r < 64 ? WRT + (size_t)(dh * 64 + r) * 1024 : WIT + (size_t)(dh * 64 + r - 64) * 1024) + k * 128 + c8;
            *(u32x4*)(Wg + r * 136 + c8) = *(const u32x4*)src;
        }
        if (tid0 < 64) hc[tid0] = 0.f;
    }
    float sp[4], br[4], bi[4];
#pragma unroll
    for (int ct = 0; ct < 4; ++ct) { const int chd = k * 128 + dh * 64 + ct * 16 + (tid0 & 15); sp[ct] = softplus(-P.in[18][chd]); br[ct] = P.in[15][chd]; bi[ct] = P.in[17][chd]; }
    const int ch0 = k * 128 + (tid0 & 31) * 4;
    float cw[4][4], cbias[4];
#pragma unroll
    for (int kk = 0; kk < 4; ++kk)
#pragma unroll
        for (int e = 0; e < 4; ++e) cw[kk][e] = P.in[12][kk * 1024 + ch0 + e];
#pragma unroll
    for (int e = 0; e < 4; ++e) cbias[e] = P.in[13][ch0 + e];
    u32x2 raw[11];
#define RG_LOAD(tl_) do { const int tg_ = (tl_) * 128 + (tid0 >> 5) * 8; const unsigned vo_ = (unsigned)((b * 2048 + tg_) * N0 + ch0); \
        _Pragma("unroll") for (int j = 0; j < 11; ++j) raw[j] = (tg_ + j - 3 >= 0) ? *(const u32x2*)((U + (j - 3) * N0) + vo_) : (u32x2){0u, 0u}; } while (0)
    if (!SAMPLE) RG_LOAD(0);
    const int ntiles = SAMPLE ? 1 : 16;
    for (int tile = 0; tile < ntiles; ++tile) {
        const int row0 = SAMPLE ? MP : b * 2048 + tile * 128;
        lds_barrier();
        int zv = 0; asm volatile("" : "+v"(zv));
        const int tid = tid0 + zv, lane = tid & 63, quad = tid & 31, seg = tid >> 5;
        const int sd = tid & 63, sseg = wid, sch = k * 128 + dh * 64 + sd;
        bf16_t gt[16];
        if (!SAMPLE) {
            const unsigned goff = (unsigned)((row0 + sseg * 16) * N0 + 1024 + sch);
#pragma unroll
            for (int t = 0; t < 16; ++t) gt[t] = (U + t * N0)[goff];
        }
        if (SAMPLE) {
#pragma unroll
            for (int t = 0; t < 8; ++t) {
                const int bb = seg * 8 + t;
                const float* buf = P.in[5] + (size_t)bb * 3 * 1024 + ch0;
                const f32x4 p0 = *(const f32x4*)buf, p1 = *(const f32x4*)(buf + 1024), p2 = *(const f32x4*)(buf + 2048);
                float cur[4]; ld4bf(U + (size_t)(MP + bb) * N0 + ch0, cur);
                float y[4];
#pragma unroll
                for (int e = 0; e < 4; ++e) y[e] = cbias[e] + cw[0][e] * p0[e] + cw[1][e] * p1[e] + cw[2][e] * p2[e] + cw[3][e] * cur[e];
                *(u32x2*)(Xs + bb * 136 + quad * 4) = pack4v(y[0], y[1], y[2], y[3]);
            }
        } else {
#pragma unroll
            for (int j = 0; j < 8; ++j) {
                const float x0[4] = {bflo(raw[j].x), bfhi(raw[j].x), bflo(raw[j].y), bfhi(raw[j].y)};
                const float x1[4] = {bflo(raw[j + 1].x), bfhi(raw[j + 1].x), bflo(raw[j + 1].y), bfhi(raw[j + 1].y)};
                const float x2[4] = {bflo(raw[j + 2].x), bfhi(raw[j + 2].x), bflo(raw[j + 2].y), bfhi(raw[j + 2].y)};
                const float x3[4] = {bflo(raw[j + 3].x), bfhi(raw[j + 3].x), bflo(raw[j + 3].y), bfhi(raw[j + 3].y)};
                float y[4];
#pragma unroll
                for (int e = 0; e < 4; ++e) y[e] = cbias[e] + cw[0][e] * x0[e] + cw[1][e] * x1[e] + cw[2][e] * x2[e] + cw[3][e] * x3[e];
                *(u32x2*)(Xs + (seg * 8 + j) * 136 + quad * 4) = pack4v(y[0], y[1], y[2], y[3]);
            }
            if (tile + 1 < 16) RG_LOAD(tile + 1);
        }
        lds_barrier();
        {
            f32x4 acc[8];
#pragma unroll
            for (int i = 0; i < 8; ++i) acc[i] = (f32x4){0.f, 0.f, 0.f, 0.f};
#pragma unroll
            for (int ks = 0; ks < 4; ++ks) {
                const bf16x8 a = ldfrag16(Xs, 136, wid * 16, ks * 32, lane);
#pragma unroll
                for (int tl = 0; tl < 8; ++tl) acc[tl] = MFMA16(a, ldfrag16(Wg, 136, tl * 16, ks * 32, lane), acc[tl]);
            }
#pragma unroll
            for (int ct = 0; ct < 4; ++ct)
#pragma unroll
                for (int reg = 0; reg < 4; ++reg) {
                    const int t = wid * 16 + (lane >> 4) * 4 + reg, d = ct * 16 + (lane & 15);
                    const float r = sigm(acc[ct][reg] + br[ct]), gi = sigm(acc[4 + ct][reg] + bi[ct]);
                    const float a = __expf(-8.f * r * sp[ct]);
                    const float uu = __builtin_amdgcn_sqrtf(fmaxf(1.f - a * a, 0.f)) * gi * bf2f(Xs[t * 136 + dh * 64 + d]);
                    if (SAMPLE) {
                        const int chd = k * 128 + dh * 64 + d;
                        const float hn = a * P.in[4][(size_t)t * 1024 + chd] + uu;
                        P.out[O_AHS + (size_t)t * 1024 + chd] = hn;
                        const float gv = bf2f(U[(size_t)(MP + t) * N0 + 1024 + chd]);
                        MIX[(size_t)(MP + t) * 2048 + chd] = f2bf(hn * silu(gv));
                    } else { Aa[t * 64 + d] = a; Uu[t * 64 + d] = uu; }
                }
        }
        if (!SAMPLE) {
            lds_barrier();
            float av[16], uv[16], Ap = 1.f, Hp = 0.f;
#pragma unroll
            for (int t = 0; t < 16; ++t) { av[t] = Aa[(sseg * 16 + t) * 64 + sd]; uv[t] = Uu[(sseg * 16 + t) * 64 + sd]; Hp = av[t] * Hp + uv[t]; Ap *= av[t]; }
            segA[sseg * 64 + sd] = Ap; segH[sseg * 64 + sd] = Hp;
            lds_barrier();
            float hin = hc[sd];
            for (int s2 = 0; s2 < sseg; ++s2) hin = segA[s2 * 64 + sd] * hin + segH[s2 * 64 + sd];
            const unsigned moff = (unsigned)((row0 + sseg * 16) * 2048 + sch);
#pragma unroll
            for (int t = 0; t < 16; ++t) {
                hin = av[t] * hin + uv[t];
                (MIX + t * 2048)[moff] = f2bf(hin * silu(bf2f(gt[t])));
            }
            lds_barrier();
            if (sseg == 7) hc[sd] = hin;
        }
    }
#undef RG_LOAD
    if (!SAMPLE) { lds_barrier(); if (tid0 < 64) P.out[O_AHP + (size_t)b * 1024 + k * 128 + dh * 64 + tid0] = hc[tid0]; }
}
DI void phase_mix0(const Params& P, unsigned char* L) {
    const int tid = otid(), bid = blockIdx.x, G = gridDim.x;
    { const bf16_t* U = WSP(bf16_t, OFF_U);
      for (int i = bid * 512 + tid; i < 8 * 3 * 1024; i += G * 512) { const int c = i & 1023, j = (i >> 10) % 3, b = i / 3072; P.out[O_ACP + i] = bf2f(U[(size_t)(b * 2048 + 2045 + j) * N0 + c]); }
      for (int i = bid * 512 + tid; i < 8 * 3 * 1536; i += G * 512) { const int c = i % 1536, j = (i / 1536) % 3, b = i / 4608; P.out[O_BCP + i] = bf2f(U[(size_t)(b * 2048 + 2045 + j) * N0 + 3072 + c]); }
      for (int i = bid * 512 + tid; i < 128 * 3 * 1024; i += G * 512) { const int c = i & 1023, j = (i >> 10) % 3, b = i / 3072; P.out[O_ACS + i] = j < 2 ? P.in[5][(size_t)(b * 3 + j + 1) * 1024 + c] : bf2f(U[(size_t)(MP + b) * N0 + c]); }
      for (int i = bid * 512 + tid; i < 128 * 3 * 1536; i += G * 512) { const int c = i % 1536, j = (i / 1536) % 3, b = i / 4608; P.out[O_BCS + i] = j < 2 ? P.in[7][(size_t)(b * 3 + j + 1) * 1536 + c] : bf2f(U[(size_t)(MP + b) * N0 + 3072 + c]); } }
    if (bid < 128) { const int x = bid & 7, j = bid >> 3; rglru_item<false>(P, L, (x + 8 * (j >> 1)) * 2 + (j & 1)); }
    else if (bid < 256) { const int x = bid & 7, j = (bid - 128) >> 3, grp = x + 8 * (j >> 3); ssd_prompt_item(P, L, (grp >> 1) * 16 + (grp & 1) * 8 + (j & 7)); }
    unsigned* ctr = WSP(unsigned, OFF_CTL);
    unsigned* bc = (unsigned*)(L + LDS_BYTES - 16);
    for (;;) {
        __syncthreads();
        if (tid == 0) bc[0] = atomicAdd(ctr, 1u);
        __syncthreads();
        const unsigned it = bc[0];
        if (it >= 16u + 512u) break;
        if (it < 16u) rglru_item<true>(P, L, (int)it); else ssd_sample_item4(P, L, (int)(it - 16u));
    }
    for (;;) {
        __syncthreads();
        if (tid == 0) bc[0] = atomicAdd(ctr + 32, 1u);
        __syncthreads();
        const unsigned q = bc[0];
        if (q >= 256u + 104u + 130u) break;
        if (q < 256u) l1_weight_tile(P, (int)q * 8 + (tid >> 6), (float*)L + (tid >> 6) * (64 * 65), tid & 63);
        else if (q < 360u) l1_weight_tile(P, 2880 + ((int)q - 256) * 8 + (tid >> 6), (float*)L + (tid >> 6) * (64 * 65), tid & 63);
        else convert_p_chunk(P, 0, (int)q - 360, tid);
    }
}
DI void phase_norm0(const Params& P) {
    bf16_t* MIX = WSP(bf16_t, OFF_MIX); const float* SSB = WSP(float, OFF_SSB);
    for (int i = blockIdx.x * 512 + threadIdx.x; i < MV * 128; i += gridDim.x * 512) {
        const int row = i >> 7, c8 = (i & 127) * 8, g = c8 >> 9;
        const float sc = rsqrtf(SSB[(size_t)row * 2 + g] * (1.f / 512.f) + EPSF);
        uint4* p = (uint4*)(MIX + (size_t)row * 2048 + 1024 + c8); uint4 w = *p;
        w.x = pack2(bflo(w.x) * sc, bfhi(w.x) * sc); w.y = pack2(bflo(w.y) * sc, bfhi(w.y) * sc); w.z = pack2(bflo(w.z) * sc, bfhi(w.z) * sc); w.w = pack2(bflo(w.w) * sc, bfhi(w.w) * sc);
        *p = w;
    }
}

DI void hgrn_prompt_item(const Params& P, unsigned char* L, int item) {
    const int b = item >> 4, h = item & 15;
    const int tid = otid(), lane = tid & 63, wid = tid >> 6, hh = lane >> 5, l31 = lane & 31;
    bf16_t* Qs = (bf16_t*)L;
    bf16_t* Ks = Qs + 64 * 136;
    bf16_t* KsT = Ks + 64 * 136;
    bf16_t* VsT = KsT + 128 * 72;
    bf16_t* SsT = VsT + 128 * 72;
    bf16_t* As = SsT + 128 * 136;
    float* Gseg = (float*)(As + 64 * 72);
    float* E1 = Gseg + 16 * 128; float* E2 = E1 + 128;
    float* Of = E2 + 128;
    const bf16_t* U = WSP(bf16_t, OFF_U); bf16_t* MIX = WSP(bf16_t, OFF_MIX);
    const int kq = tid & 31, ts = tid >> 5;
    float lb[4];
#pragma unroll
    for (int e = 0; e < 4; ++e) { const int ch = h * 128 + kq * 4 + e; lb[e] = sigm(P.in[27][2048 + ch] - P.in[27][ch]); }
    const int kb = (wid >> 1) * 32, vb0 = (wid & 1) * 64;
    f32x16 accS[2];
#pragma unroll
    for (int i = 0; i < 16; ++i) { accS[0][i] = 0.f; accS[1][i] = 0.f; }
    uint2 rq[4], rf[4], rv[4];
#define HG_LOAD(cc) do { _Pragma("unroll") for (int i = 0; i < 4; ++i) { const bf16_t* bp = U + (size_t)(b * 2048 + (cc) * 64 + ts * 4 + i) * INC + h * 128 + kq * 4; \
        rq[i] = *(const uint2*)bp; rf[i] = *(const uint2*)(bp + 2048); rv[i] = *(const uint2*)(bp + 4096); } } while (0)
    HG_LOAD(0);
    lds_barrier();
    float kk[4][4], cs[4][4];
    {
#pragma unroll
        for (int i = 0; i < 4; ++i) {
            const float fx[4] = {bflo(rf[i].x), bfhi(rf[i].x), bflo(rf[i].y), bfhi(rf[i].y)};
#pragma unroll
            for (int e = 0; e < 4; ++e) {
                const float sg = sigm(fx[e]); const float kv = (1.f - lb[e]) * (1.f - sg);
                kk[i][e] = kv; const float gl = __logf(1.f - kv);
                cs[i][e] = (i == 0 ? 0.f : cs[i - 1][e]) + gl;
            }
        }
        *(f32x4*)(Gseg + ts * 128 + kq * 4) = (f32x4){cs[3][0], cs[3][1], cs[3][2], cs[3][3]};
    }
    lds_barrier();
    for (int c = 0; c < 32; ++c) {
        u32x4 gpre0, gpre1;
        { const bf16_t* gp = U + (size_t)(b * 2048 + c * 64 + (tid >> 3)) * INC + 6144 + h * 128 + (tid & 7) * 16; gpre0 = *(const u32x4*)gp; gpre1 = *(const u32x4*)(gp + 8); }
        f32x4 off = {0.f, 0.f, 0.f, 0.f}, gmid = off, glast = off;
        {
            const int swid = __builtin_amdgcn_readfirstlane(tid >> 6);
            f32x4 pre = {0.f, 0.f, 0.f, 0.f};
#pragma unroll
            for (int s = 0; s < 16; ++s) {
                const f32x4 v = *(const f32x4*)(Gseg + s * 128 + kq * 4);
                if (s == 2 * swid) off = pre;
                if (s == 8) gmid = pre;
                pre += v;
            }
            glast = pre;
            if (ts & 1) off += *(const f32x4*)(Gseg + (ts - 1) * 128 + kq * 4);
        }
        {
            float qt[4][4], kt[4][4], vt[4][4];
#pragma unroll
            for (int i = 0; i < 4; ++i) {
                const float q[4] = {bflo(rq[i].x), bfhi(rq[i].x), bflo(rq[i].y), bfhi(rq[i].y)};
                vt[i][0] = bflo(rv[i].x); vt[i][1] = bfhi(rv[i].x); vt[i][2] = bflo(rv[i].y); vt[i][3] = bfhi(rv[i].y);
#pragma unroll
                for (int e = 0; e < 4; ++e) { const float Gv = off[e] + cs[i][e]; const float ex = __expf(Gv - gmid[e]); qt[i][e] = q[e] * 0.08838834764831845f * ex; kt[i][e] = kk[i][e] * frcp(ex); }
                *(uint2*)(Qs + (ts * 4 + i) * 136 + kq * 4) = pack4(qt[i][0], qt[i][1], qt[i][2], qt[i][3]);
                *(uint2*)(Ks + (ts * 4 + i) * 136 + kq * 4) = pack4(kt[i][0], kt[i][1], kt[i][2], kt[i][3]);
            }
#pragma unroll
            for (int e = 0; e < 4; ++e) {
                *(uint2*)(KsT + (kq * 4 + e) * 72 + ((ts * 4) ^ (((kq >> 2) & 7) * 8))) = pack4(kt[0][e], kt[1][e], kt[2][e], kt[3][e]);
                *(uint2*)(VsT + (kq * 4 + e) * 72 + ((ts * 4) ^ (((kq >> 2) & 7) * 8))) = pack4(vt[0][e], vt[1][e], vt[2][e], vt[3][e]);
            }
            if (ts == 0) {
#pragma unroll
                for (int e = 0; e < 4; ++e) { E1[kq * 4 + e] = __expf(gmid[e]); E2[kq * 4 + e] = __expf(glast[e] - gmid[e]); }
            }
        }
        if (c + 1 < 32) HG_LOAD(c + 1);
        lds_barrier();
#pragma unroll
        for (int j = 0; j < 2; ++j) {
#pragma unroll
            for (int reg = 0; reg < 16; ++reg) accS[j][reg] *= E1[kb + crow(reg, hh)];
            const int v = vb0 + j * 32 + l31;
#pragma unroll
            for (int rg = 0; rg < 4; ++rg) *(uint2*)(SsT + v * 136 + kb + 8 * rg + 4 * hh) = pack4(accS[j][4 * rg], accS[j][4 * rg + 1], accS[j][4 * rg + 2], accS[j][4 * rg + 3]);
        }
        if (wid < 4) {
            const int tb = (wid >> 1) * 32, sb = (wid & 1) * 32;
            f32x16 aa;
#pragma unroll
            for (int i = 0; i < 16; ++i) aa[i] = 0.f;
#pragma unroll
            for (int ks = 0; ks < 8; ++ks) aa = MFMA32(ldfrag(Qs, 136, tb, ks * 16, lane), ldfrag(Ks, 136, sb, ks * 16, lane), aa);
            const int s = sb + l31;
#pragma unroll
            for (int reg = 0; reg < 16; ++reg) { const int t = tb + crow(reg, hh); As[t * 72 + s] = f2bf(s <= t ? aa[reg] : 0.f); }
        }
        lds_barrier();
        const int tb2 = (wid >> 2) * 32, vb2 = (wid & 3) * 32;
        f32x16 o, o2;
#pragma unroll
        for (int i = 0; i < 16; ++i) { o[i] = 0.f; o2[i] = 0.f; }
#pragma unroll
        for (int ks = 0; ks < 8; ++ks) o = MFMA32(ldfrag(Qs, 136, tb2, ks * 16, lane), ldfrag(SsT, 136, vb2, ks * 16, lane), o);
#pragma unroll
        for (int ks = 0; ks < 4; ++ks) o2 = MFMA32(ldfrag(As, 72, tb2, ks * 16, lane), ldfrag_sw72(VsT, vb2, ks * 16, lane), o2);
#pragma unroll
        for (int i = 0; i < 16; ++i) o[i] += o2[i];
#pragma unroll
        for (int j = 0; j < 2; ++j) {
#pragma unroll
            for (int ks = 0; ks < 4; ++ks) accS[j] = MFMA32(ldfrag_sw72(KsT, kb, ks * 16, lane), ldfrag_sw72(VsT, vb0 + j * 32, ks * 16, lane), accS[j]);
#pragma unroll
            for (int reg = 0; reg < 16; ++reg) accS[j][reg] *= E2[kb + crow(reg, hh)];
        }
#pragma unroll
        for (int reg = 0; reg < 16; ++reg) Of[(tb2 + crow(reg, hh)) * 132 + vb2 + l31] = o[reg];
        if (c + 1 < 32) {
#pragma unroll
        for (int i = 0; i < 4; ++i) {
            const float fx[4] = {bflo(rf[i].x), bfhi(rf[i].x), bflo(rf[i].y), bfhi(rf[i].y)};
#pragma unroll
            for (int e = 0; e < 4; ++e) {
                const float sg = sigm(fx[e]); const float kv = (1.f - lb[e]) * (1.f - sg);
                kk[i][e] = kv; const float gl = __logf(1.f - kv);
                cs[i][e] = (i == 0 ? 0.f : cs[i - 1][e]) + gl;
            }
        }
        *(f32x4*)(Gseg + ts * 128 + kq * 4) = (f32x4){cs[3][0], cs[3][1], cs[3][2], cs[3][3]};
        }
        lds_barrier();
        {
            const int t = tid >> 3, vs = tid & 7;
            const size_t row = (size_t)(b * 2048 + c * 64 + t);
            f32x4 ov[4]; float ss = 0.f;
#pragma unroll
            for (int i = 0; i < 4; ++i) { ov[i] = *(const f32x4*)(Of + t * 132 + vs * 16 + i * 4); ss += ov[i][0] * ov[i][0] + ov[i][1] * ov[i][1] + ov[i][2] * ov[i][2] + ov[i][3] * ov[i][3]; }
            ss += __shfl_xor(ss, 1); ss += __shfl_xor(ss, 2); ss += __shfl_xor(ss, 4);
            const float rstd = rsqrtf(ss * (1.f / 128.f) + EPSF);
            const float* nwp = P.in[28] + h * 128 + vs * 16;
            const unsigned gw[8] = {gpre0.x, gpre0.y, gpre0.z, gpre0.w, gpre1.x, gpre1.y, gpre1.z, gpre1.w};
            unsigned ow[8];
#pragma unroll
            for (int i = 0; i < 4; ++i) {
                const f32x4 w = *(const f32x4*)(nwp + i * 4);
                ow[2 * i] = pack2(ov[i][0] * rstd * w[0] * silu(bflo(gw[2 * i])), ov[i][1] * rstd * w[1] * silu(bfhi(gw[2 * i])));
                ow[2 * i + 1] = pack2(ov[i][2] * rstd * w[2] * silu(bflo(gw[2 * i + 1])), ov[i][3] * rstd * w[3] * silu(bfhi(gw[2 * i + 1])));
            }
            bf16_t* op = MIX + row * 2048 + h * 128 + vs * 16;
            *(uint4*)op = make_uint4(ow[0], ow[1], ow[2], ow[3]); *(uint4*)(op + 8) = make_uint4(ow[4], ow[5], ow[6], ow[7]);
        }
    }
#undef HG_LOAD
    float* so = P.out + O_CP + (size_t)(b * 16 + h) * 128 * 128;
#pragma unroll
    for (int j = 0; j < 2; ++j)
#pragma unroll
        for (int reg = 0; reg < 16; ++reg) so[(kb + crow(reg, hh)) * 128 + vb0 + j * 32 + l31] = accS[j][reg];
}
DI void hgrn_sample_item(const Params& P, unsigned char* L, int item) {
    const int b = item >> 4, h = item & 15, tid = otid(), lane = tid & 63;
    float* qv = (float*)L; float* egv = qv + 128; float* kkv = egv + 128; float* vv = kkv + 128; float* part = vv + 128; float* red = part + 16 * 128;
    const bf16_t* U = WSP(bf16_t, OFF_U); bf16_t* MIX = WSP(bf16_t, OFF_MIX);
    const size_t row = (size_t)(MP + b); const bf16_t* ub = U + row * INC + h * 128;
    __syncthreads();
    if (tid < 128) {
        const int ch = h * 128 + tid;
        const float lbv = sigm(P.in[27][2048 + ch] - P.in[27][ch]);
        const float sg = sigm(bf2f(ub[2048 + tid])); const float kv = (1.f - lbv) * (1.f - sg);
        qv[tid] = bf2f(ub[tid]) * 0.08838834764831845f; egv[tid] = 1.f - kv; kkv[tid] = kv;
    } else if (tid < 256) vv[tid - 128] = bf2f(ub[4096 + tid - 128]);
    __syncthreads();
    const float* s0 = P.in[8] + (size_t)(b * 16 + h) * 128 * 128; float* s1 = P.out + O_CS + (size_t)(b * 16 + h) * 128 * 128;
    const int v4 = (tid & 31) * 4; const f32x4 vq = *(const f32x4*)(vv + v4);
    f32x4 op = {0.f, 0.f, 0.f, 0.f};
#pragma unroll
    for (int j = 0; j < 8; ++j) {
        const int k = (tid >> 5) + 16 * j;
        const f32x4 s = *(const f32x4*)(s0 + k * 128 + v4);
        const f32x4 sn = s * egv[k] + vq * kkv[k];
        *(f32x4*)(s1 + k * 128 + v4) = sn;
        op += sn * qv[k];
    }
    *(f32x4*)(part + (tid >> 5) * 128 + v4) = op;
    __syncthreads();
    float o = 0.f;
    if (tid < 128) {
#pragma unroll
        for (int i = 0; i < 16; ++i) o += part[i * 128 + tid];
        const float ss = wave_sum(o * o);
        if (lane == 0) red[tid >> 6] = ss;
    }
    __syncthreads();
    if (tid < 128) {
        const float rstd = rsqrtf((red[0] + red[1]) * (1.f / 128.f) + EPSF);
        const int ch = h * 128 + tid;
        MIX[row * 2048 + ch] = f2bf(o * rstd * P.in[28][ch] * silu(bf2f(ub[6144 + tid])));
    }
}
DI void phase_mix1(const Params& P, unsigned char* L) {
    const int tid = otid(), bid = blockIdx.x;
    if (bid < 128) hgrn_prompt_item(P, L, bid);
    else { const int nb = gridDim.x - 128; for (int it = bid - 128; it < 2048; it += nb) hgrn_sample_item(P, L, it); }
    unsigned* ctr = WSP(unsigned, OFF_CTL) + 48;
    unsigned* bc = (unsigned*)(L + LDS_BYTES - 16);
    for (;;) {
        __syncthreads();
        if (tid == 0) bc[0] = atomicAdd(ctr, 1u);
        __syncthreads();
        const unsigned q = bc[0];
        if (q >= 104u + 130u) break;
        if (q < 104u) l1_weight_tile(P, 2048 + (int)q * 8 + (tid >> 6), (float*)L + (tid >> 6) * (64 * 65), tid & 63);
        else convert_p_chunk(P, 1, (int)q - 104, tid);
    }
}
DI void phase_final(const Params& P) {
    const int lane = threadIdx.x & 63, gw = blockIdx.x * 8 + (threadIdx.x >> 6), nwv = gridDim.x * 8;
    const float* H = WSP(float, OFF_H); const float* SS = WSP(float, OFF_SS2); const float* nf = P.in[10];
    f32x4 w4[4];
#pragma unroll
    for (int i = 0; i < 4; ++i) w4[i] = *(const f32x4*)(nf + lane * 4 + 256 * i);
    for (int r0 = gw * 4; r0 < MV; r0 += nwv * 4) {
        f32x4 v[4][4]; float rs[4];
#pragma unroll
        for (int q = 0; q < 4; ++q) { rs[q] = SS[r0 + q];
#pragma unroll
            for (int i = 0; i < 4; ++i) v[q][i] = *(const f32x4*)(H + (size_t)(r0 + q) * 1024 + lane * 4 + 256 * i); }
#pragma unroll
        for (int q = 0; q < 4; ++q) { const float rstd = rsqrtf(rs[q] * (1.f / 1024.f) + EPSF);
#pragma unroll
            for (int i = 0; i < 4; ++i) __builtin_nontemporal_store(v[q][i] * rstd * w4[i], (f32x4*)(P.out + O_Y + (size_t)(r0 + q) * 1024 + lane * 4 + 256 * i)); }
    }
}

#define XB_TMO      128
#define XB_XCNT(j)  (256  + 64 * (j))
#define XB_XSUB(j)  (1280 + 64 * (j))
#define XB_XGEN(j)  (2304 + 64 * (j))
#define XB_TOP      3328
#define XB_TOPGEN   3392
#define XCD_BAR_WORDS 3456
#define XB_SPIN_CAP (1u << 18)

__device__ __forceinline__ unsigned xb_ld(unsigned* p)              { return __hip_atomic_load(p, __ATOMIC_RELAXED, __HIP_MEMORY_SCOPE_AGENT); }
__device__ __forceinline__ unsigned xb_add(unsigned* p, unsigned v) { return __hip_atomic_fetch_add(p, v, __ATOMIC_RELAXED, __HIP_MEMORY_SCOPE_AGENT); }
__device__ __forceinline__ unsigned xb_xcc_id() { return (unsigned)__builtin_amdgcn_s_getreg((3 << 11) | 20) & 0xFu; }
#define XB_SPIN(cond, bar) do { unsigned _sp = 0; while (cond) { __builtin_amdgcn_s_sleep(1); \
    if ((++_sp & 255u) == 0u) { if (xb_ld(&(bar)[XB_TMO])) break; if (_sp > XB_SPIN_CAP) { atomicAdd(&(bar)[XB_TMO], 1u); break; } } } } while (0)

struct XcdBarrier {
    unsigned* bar; unsigned x;
    volatile LAS unsigned* st;
};

__device__ __forceinline__ XcdBarrier xcd_barrier_post(unsigned* bar, volatile LAS unsigned* st) {
    XcdBarrier b; b.bar = bar; b.x = xb_xcc_id(); b.st = st;
    if (threadIdx.x == 0) (void)xb_add(&bar[XB_XCNT(b.x)], 1u);
    return b;
}
__device__ __forceinline__ void xcd_barrier_complete(unsigned* bar, unsigned x, unsigned& nloc, unsigned& nx) {
    const unsigned G = gridDim.x * gridDim.y * gridDim.z;
    unsigned sum, cnt, mine, sp = 0u;
    for (;;) {
        sum = 0u; cnt = 0u; mine = 0u;
#pragma unroll
        for (unsigned j = 0; j < 16; ++j) { const unsigned c = xb_ld(&bar[XB_XCNT(j)]); sum += c; cnt += (c > 0u) ? 1u : 0u; mine = (j == x) ? c : mine; }
        if (sum == G) break;
        __builtin_amdgcn_s_sleep(1);
        if ((++sp & 255u) == 0u) { if (xb_ld(&bar[XB_TMO])) break; if (sp > XB_SPIN_CAP) { atomicAdd(&bar[XB_TMO], 1u); break; } }
    }
    nloc = mine > 0u ? mine : 1u; nx = cnt > 0u ? cnt : 1u;
}

__device__ __forceinline__ void xcd_barrier(const XcdBarrier& b) {
    asm volatile("s_waitcnt vmcnt(0)" ::: "memory");
    __syncthreads();
    if (threadIdx.x == 0) {
        unsigned* bar = b.bar;
        __builtin_amdgcn_s_waitcnt(0);
        unsigned nloc = b.st[0], nx = b.st[1];
        if (nloc == 0u) { xcd_barrier_complete(bar, b.x, nloc, nx); b.st[0] = nloc; b.st[1] = nx; }
        const unsigned old = xb_add(&bar[XB_XSUB(b.x)], 1u);
        const unsigned gen = old / nloc;
        if (old + 1u == (gen + 1u) * nloc) {
            __builtin_amdgcn_fence(__ATOMIC_RELEASE, "agent");
            asm volatile("s_waitcnt vmcnt(0)" ::: "memory");
            const unsigned og = xb_add(&bar[XB_TOP], 1u);
            const unsigned tg = og / nx;
            if (og + 1u == (tg + 1u) * nx) xb_add(&bar[XB_TOPGEN], 1u);
            else XB_SPIN(xb_ld(&bar[XB_TOPGEN]) == tg, bar);
            __builtin_amdgcn_fence(__ATOMIC_ACQUIRE, "agent");
            xb_add(&bar[XB_XGEN(b.x)], 1u);
            asm volatile("s_waitcnt vmcnt(0)" ::: "memory");
        } else {
            XB_SPIN(xb_ld(&bar[XB_XGEN(b.x)]) == gen, bar);
            __builtin_amdgcn_fence(__ATOMIC_ACQUIRE, "agent");
            asm volatile("s_waitcnt vmcnt(0)" ::: "memory");
        }
    }
    __syncthreads();
}


#ifndef PHM
#define PHM 0xFFFF
#endif
typedef const __attribute__((address_space(4))) Params* ParamsK;
DI Params getp() {
    ParamsK pp = (ParamsK)__builtin_amdgcn_kernarg_segment_ptr(); asm volatile("" : "+s"(pp));
    Params P;
#pragma unroll
    for (int i = 0; i < 32; ++i) P.in[i] = pp->in[i];
    P.out = pp->out; P.ws = pp->ws; return P;
}
#define GETP() const Params P = getp()
__global__ void __launch_bounds__(512, 2) fwd_kernel(Params Parg) {
    extern __shared__ __attribute__((aligned(16))) unsigned char lds[];
    cg::grid_group grid = cg::this_grid();
    unsigned char* L = (unsigned char*)lds;
    LAS unsigned char* LL = (LAS unsigned char*)lds;
    volatile LAS unsigned* xst = (volatile LAS unsigned*)(LL + LDS_BYTES - 32);
    if (threadIdx.x < 2) xst[threadIdx.x] = 0u;
    __syncthreads();
    XcdBarrier xb;
    { GETP(); xb = xcd_barrier_post(WSP(unsigned, OFF_BAR), xst); }
    if (PHM & 1) { GETP(); phase_prep(P, L); }
    if (gridDim.y == 0xFFFFu) grid.sync();
    xcd_barrier(xb);
    if (PHM & 2) { GETP(); pg8::StaticOrder S; S.init(MP, N0 + 256, gridDim.x, blockIdx.x); pg8::Gemm g{WSP(bf16_t, OFF_XN), WSP(bf16_t, OFF_W0T), MP, N0 + 256, 1024};
      EpiStoreBf16 E{WSP(bf16_t, OFF_U), N0, nullptr, WSP(float, OFF_DT)}; pg8::gemm_phase(LL, g, S, E); }
    { GETP(); SfU f{WSP(bf16_t, OFF_U), N0, nullptr, WSP(float, OFF_DT)}; sgemm<2>(WSP(bf16_t, OFF_XN), WSP(bf16_t, OFF_W0T), 1024, 145, 64 * 19, f, L); }
    xcd_barrier(xb);
    { GETP(); phase_convbc(P, L); }
    xcd_barrier(xb);
    if (PHM & 4) { GETP(); phase_mix0(P, L); }
    xcd_barrier(xb);
    { GETP(); phase_norm0(P); }
    xcd_barrier(xb);
    if (PHM & 8) { GETP(); pg8::StaticOrder S; S.init(MP, 1024, gridDim.x, blockIdx.x); pg8::Gemm g{WSP(bf16_t, OFF_MIX), WSP(bf16_t, OFF_WO0T), MP, 1024, 2048};
      EpiResid E{P.in[0], P.in[1], WSP(float, OFF_H), WSP(bf16_t, OFF_HB)}; pg8::gemm_phase(LL, g, S, E); }
    { GETP(); SfResid f{P.in[1], WSP(float, OFF_H), WSP(bf16_t, OFF_HB)}; sgemm<4>(WSP(bf16_t, OFF_MIX), WSP(bf16_t, OFF_WO0T), 2048, 32, 256, f, L); }
    xcd_barrier(xb);
    if (PHM & 16) { GETP(); pg8::StaticOrder S; S.init(MP, 1024, gridDim.x, blockIdx.x);
      pg8::Gemm g1{WSP(bf16_t, OFF_HB), WSP(bf16_t, OFF_WG0T), MP, 1024, 1024}; EpiGate E1{WSP(bf16_t, OFF_MIX)}; pg8::gemm_phase(LL, g1, S, E1); }
    { GETP(); SfGate f{WSP(bf16_t, OFF_MIX)};   sgemm<2>(WSP(bf16_t, OFF_HB), WSP(bf16_t, OFF_WG0T), 1024, 32, 256, f, L); }
    if (PHM & 16) { GETP(); pg8::StaticOrder S; S.init(MP, 1024, gridDim.x, blockIdx.x);
      pg8::Gemm g2{WSP(bf16_t, OFF_PB), WSP(bf16_t, OFF_WP0T), MP, 1024, 256};
      EpiPle E2{WSP(float, OFF_H), WSP(bf16_t, OFF_MIX), WSP(bf16_t, OFF_XN), P.in[9] + 1024, WSP(float, OFF_SS1)}; pg8::gemm_phase(LL, g2, S, E2); }
    { GETP(); SfPle f{WSP(float, OFF_H), WSP(bf16_t, OFF_MIX), WSP(bf16_t, OFF_XN), P.in[9] + 1024, WSP(float, OFF_SS1)}; sgemm<2>(WSP(bf16_t, OFF_PB), WSP(bf16_t, OFF_WP0T), 256, 32, 256, f, L); }
    xcd_barrier(xb);
    if (PHM & 32) { GETP(); pg8::StaticOrder S; S.init(MP, INC, gridDim.x, blockIdx.x); pg8::Gemm g{WSP(bf16_t, OFF_XN), WSP(bf16_t, OFF_W1T), MP, INC, 1024};
      EpiStoreBf16 E{WSP(bf16_t, OFF_U), INC, WSP(float, OFF_SS1), nullptr}; pg8::gemm_phase(LL, g, S, E); }
    { GETP(); SfU f{WSP(bf16_t, OFF_U), INC, WSP(float, OFF_SS1), nullptr}; sgemm<2>(WSP(bf16_t, OFF_XN), WSP(bf16_t, OFF_W1T), 1024, 256, 64 * 32, f, L); }
    xcd_barrier(xb);
    if (PHM & 64) { GETP(); phase_mix1(P, L); }
    xcd_barrier(xb);
    if (PHM & 128) { GETP(); pg8::StaticOrder S; S.init(MP, 1024, gridDim.x, blockIdx.x); pg8::Gemm g{WSP(bf16_t, OFF_MIX), WSP(bf16_t, OFF_WO1T), MP, 1024, 2048};
      EpiResid E{WSP(float, OFF_H), WSP(float, OFF_H) + (size_t)MP * 1024, WSP(float, OFF_H), WSP(bf16_t, OFF_HB)}; pg8::gemm_phase(LL, g, S, E); }
    { GETP(); SfResid f{WSP(float, OFF_H) + (size_t)MP * 1024, WSP(float, OFF_H), WSP(bf16_t, OFF_HB)}; sgemm<4>(WSP(bf16_t, OFF_MIX), WSP(bf16_t, OFF_WO1T), 2048, 32, 256, f, L); }
    xcd_barrier(xb);
    if (PHM & 256) { GETP(); pg8::StaticOrder S; S.init(MP, 1024, gridDim.x, blockIdx.x);
      pg8::Gemm g1{WSP(bf16_t, OFF_HB), WSP(bf16_t, OFF_WG1T), MP, 1024, 1024}; EpiGate E1{WSP(bf16_t, OFF_MIX)}; pg8::gemm_phase(LL, g1, S, E1); }
    { GETP(); SfGate f{WSP(bf16_t, OFF_MIX)};   sgemm<2>(WSP(bf16_t, OFF_HB), WSP(bf16_t, OFF_WG1T), 1024, 32, 256, f, L); }
    if (PHM & 256) { GETP(); pg8::StaticOrder S; S.init(MP, 1024, gridDim.x, blockIdx.x);
      pg8::Gemm g2{WSP(bf16_t, OFF_PB + PB_STRIDE), WSP(bf16_t, OFF_WP1T), MP, 1024, 256};
      EpiPle E2{WSP(float, OFF_H), WSP(bf16_t, OFF_MIX), nullptr, nullptr, WSP(float, OFF_SS2)}; pg8::gemm_phase(LL, g2, S, E2); }
    { GETP(); SfPle f{WSP(float, OFF_H), WSP(bf16_t, OFF_MIX), nullptr, nullptr, WSP(float, OFF_SS2)}; sgemm<2>(WSP(bf16_t, OFF_PB + PB_STRIDE), WSP(bf16_t, OFF_WP1T), 256, 32, 256, f, L); }
    xcd_barrier(xb);
    { GETP(); phase_final(P); }
}

extern "C" void kernel_launch(void* const* d_in, const int* in_sizes, int n_in, void* d_out, int out_size, void* d_ws, size_t ws_size, hipStream_t stream) {
    static int grid = 0;
    if (grid == 0) {
        if (n_in != 32 || ws_size < WS_END) { fprintf(stderr, "kernel_launch: need 32 inputs and %zu bytes of workspace (got %d, %zu)\n", (size_t)WS_END, n_in, ws_size); grid = -1; return; }
        int dev = 0, cus = 0, per_cu = 0;
        (void)hipGetDevice(&dev); (void)hipDeviceGetAttribute(&cus, hipDeviceAttributeMultiprocessorCount, dev);
        if (hipFuncSetAttribute((const void*)fwd_kernel, hipFuncAttributeMaxDynamicSharedMemorySize, LDS_BYTES) != hipSuccess) { fprintf(stderr, "kernel_launch: hipFuncSetAttribute failed\n"); grid = -1; return; }
        if (hipOccupancyMaxActiveBlocksPerMultiprocessor(&per_cu, (const void*)fwd_kernel, 512, LDS_BYTES) != hipSuccess || per_cu < 1) { fprintf(stderr, "kernel_launch: occupancy query says %d\n", per_cu); per_cu = 1; }
        (void)hipGetLastError();
        grid = cus;
    }
    if (grid < 0) return;
    Params p{};
    for (int i = 0; i < 32; ++i) p.in[i] = (const float*)d_in[i];
    p.out = (float*)d_out; p.ws = (unsigned char*)d_ws;
    if (hipMemsetAsync((char*)d_ws + OFF_BAR, 0, 16384, stream) != hipSuccess) { fprintf(stderr, "kernel_launch: memset of barrier words failed\n"); return; }
    void* args[] = {&p};
    hipError_t e = hipLaunchCooperativeKernel((const void*)fwd_kernel, dim3(grid), dim3(512), args, LDS_BYTES, stream);
    if (e != hipSuccess) fprintf(stderr, "cooperative launch failed: %s (grid %d)\n", hipGetErrorString(e), grid);
}
```
